# Optimizing an MI355X kernel written in HIP

```python
import math
import jax, jax.numpy as jnp
from jax import lax
import numpy as np

D_MODEL = 1024
BATCH = 2
SEQ = 8192
DEPTH = 1

SSD_HEADDIM = 64
SSD_HEADS = 24
SSD_INNER = SSD_HEADS * SSD_HEADDIM
SSD_GROUPS = 4
SSD_STATE = 128
SSD_CONV = 5
SSD_CHUNK = 128
SSD_BC = 2 * SSD_GROUPS * SSD_STATE
XBC_DIM = SSD_INNER + SSD_BC
S5_GROUP = 16
S5_WIDTH = 768
S5_GROUPS = S5_WIDTH // S5_GROUP
S5_STATE = 64
N_BRANCHES = 2
IN_COLS = SSD_INNER + XBC_DIM + 2 * SSD_HEADS + S5_WIDTH + N_BRANCHES * D_MODEL
SPLITS = (SSD_INNER, SSD_INNER + XBC_DIM, SSD_INNER + XBC_DIM + 2 * SSD_HEADS,
          SSD_INNER + XBC_DIM + 2 * SSD_HEADS + S5_WIDTH)
N_EXPERTS = 16
EXPERT_FF = 2816
CAPACITY_FACTOR = 2
DEEPNORM_ALPHA = (2.0 * DEPTH) ** 0.25
DEEPNORM_BETA = (8.0 * DEPTH) ** -0.25
LN_EPS = 1e-5
RMS_EPS = 1e-5
F32 = jnp.float32

kernel_name = "hybrid_ssd_s5_ec_moe_deepnorm"


def _layer_norm(x, g, b):
    xf = x.astype(F32)
    mu = jnp.mean(xf, -1, keepdims=True)
    var = jnp.mean(jnp.square(xf - mu), -1, keepdims=True)
    return ((xf - mu) * lax.rsqrt(var + LN_EPS) * g.astype(F32) + b.astype(F32)).astype(x.dtype)


def _dwconv_centred(x, w, b):
    k = w.shape[0]
    y = lax.conv_general_dilated(x, w[:, None, :].astype(x.dtype), window_strides=(1,),
                                 padding=[(k // 2, k // 2)],
                                 dimension_numbers=('NWC', 'WIO', 'NWC'),
                                 feature_group_count=x.shape[-1])
    return y + b.astype(x.dtype)


def _ssd_scan(xh, dt, a, bm, cm):
    bsz, l, h, p = xh.shape
    g, n = bm.shape[-2:]
    hg = h // g
    q = SSD_CHUNK
    c = l // q
    xdt = (xh.astype(F32) * dt[..., None]).reshape(bsz, c, q, g, hg, p)
    bc = bm.astype(F32).reshape(bsz, c, q, g, n)
    cc = cm.astype(F32).reshape(bsz, c, q, g, n)
    cs = jnp.cumsum((dt * a).reshape(bsz, c, q, g, hg), axis=2)
    seg = cs[:, :, :, None] - cs[:, :, None, :]
    mask = jnp.tril(jnp.ones((q, q), bool))[None, None, :, :, None, None]
    decay = jnp.where(mask, jnp.exp(jnp.where(mask, seg, 0.0)), 0.0)
    cb = jnp.einsum('bcqgn,bcsgn->bcqsg', cc, bc)
    wts = cb[..., None] * decay
    y_diag = jnp.einsum('bcqsgh,bcsghp->bcqghp', wts, xdt)
    last = cs[:, :, -1:]
    xw = xdt * jnp.exp(last - cs)[..., None]
    states = jnp.einsum('bcsgn,bcsghp->bcghpn', bc, xw)
    chunk_decay = jnp.exp(last[:, :, 0])

    def step(carry, inp):
        st, dec = inp
        return carry * dec[..., None, None] + st, carry

    init = jnp.zeros((bsz, g, hg, p, n), F32)
    _, prev = lax.scan(step, init, (jnp.moveaxis(states, 1, 0), jnp.moveaxis(chunk_decay, 1, 0)))
    prev = jnp.moveaxis(prev, 0, 1)
    y_off = jnp.einsum('bcqgn,bcghpn->bcqghp', cc, prev) * jnp.exp(cs)[..., None]
    return (y_diag + y_off).reshape(bsz, l, h, p)


def _ssd_branch(z, xbc, dt_raw, conv_w, conv_b, a_log_f, a_log_b, dt_bias_f, dt_bias_b,
                d_skip, norm_g, w_out):
    bsz, l, _ = z.shape
    xbc = jax.nn.silu(_dwconv_centred(xbc, conv_w, conv_b))
    xs, bm, cm = jnp.split(xbc, [SSD_INNER, SSD_INNER + SSD_BC // 2], axis=-1)
    xh = xs.reshape(bsz, l, SSD_HEADS, SSD_HEADDIM)
    bm = bm.reshape(bsz, l, SSD_GROUPS, SSD_STATE)
    cm = cm.reshape(bsz, l, SSD_GROUPS, SSD_STATE)
    dt_f_raw, dt_b_raw = jnp.split(dt_raw.astype(F32), 2, axis=-1)
    dt_f = jax.nn.softplus(dt_f_raw + dt_bias_f.astype(F32))
    dt_b = jax.nn.softplus(dt_b_raw + dt_bias_b.astype(F32))
    a_f = -jnp.exp(a_log_f.astype(F32))
    a_b = -jnp.exp(a_log_b.astype(F32))
    flip = lambda t: jnp.flip(t, axis=1)
    y_f = _ssd_scan(xh, dt_f, a_f, bm, cm)
    y_b = flip(_ssd_scan(flip(xh), flip(dt_b), a_b, flip(bm), flip(cm)))
    y = y_f + y_b + xh.astype(F32) * d_skip.astype(F32)[:, None]
    y = y.reshape(bsz, l, SSD_INNER) * jax.nn.silu(z.astype(F32))
    y = y.reshape(bsz, l, SSD_GROUPS, SSD_INNER // SSD_GROUPS)
    y = y * lax.rsqrt(jnp.mean(y * y, -1, keepdims=True) + RMS_EPS)
    y = y.reshape(bsz, l, SSD_INNER) * norm_g.astype(F32)
    return y.astype(z.dtype) @ w_out


def _s5_direction(ug, a_re, a_im, log_step, b_re, b_im):
    lam = lax.complex(a_re.astype(F32), a_im.astype(F32))
    step = jnp.exp(log_step.astype(F32))[:, None]
    a_bar = jnp.exp(lam * step)
    b_bar = ((a_bar - 1.0) / lam)[..., None] * lax.complex(b_re.astype(F32), b_im.astype(F32))
    bu = jnp.einsum('blgk,gpk->blgp', ug.astype(F32).astype(jnp.complex64), b_bar)
    a_seq = jnp.broadcast_to(a_bar, (1, ug.shape[1]) + a_bar.shape)

    def combine(e1, e2):
        a1, b1 = e1
        a2, b2 = e2
        return a2 * a1, a2 * b1 + b2

    _, states = lax.associative_scan(combine, (a_seq, bu), axis=1)
    return states


def _s5_branch(u, a_re_f, a_im_f, log_step_f, a_re_b, a_im_b, log_step_b,
               b_re, b_im, c_re, c_im, d_skip, w_glu_a, w_glu_b):
    bsz, l, _ = u.shape
    ug = u.reshape(bsz, l, S5_GROUPS, S5_GROUP)
    s_f = _s5_direction(ug, a_re_f, a_im_f, log_step_f, b_re, b_im)
    s_b = jnp.flip(_s5_direction(jnp.flip(ug, 1), a_re_b, a_im_b, log_step_b, b_re, b_im), 1)
    c = lax.complex(c_re.astype(F32), c_im.astype(F32))
    y = jnp.real(jnp.einsum('blgp,gkp->blgk', s_f + s_b, c)).reshape(bsz, l, S5_WIDTH)
    y = y + u.astype(F32) * d_skip.astype(F32)
    y = jax.nn.gelu(y).astype(u.dtype)
    return (y @ w_glu_a) * jax.nn.sigmoid(y @ w_glu_b)


def _expert_choice_ffn(x, w_router, w_e1, w_e3, w_e2):
    bsz, n, d = x.shape
    cap = CAPACITY_FACTOR * n // N_EXPERTS
    aff = jax.nn.softmax((x @ w_router).astype(F32), axis=-1)
    gate, idx = lax.top_k(jnp.swapaxes(aff, 1, 2), cap)
    xin = jax.vmap(lambda xb, ib: xb[ib])(x, idx)
    hid = jax.nn.silu(jnp.einsum('becd,edf->becf', xin, w_e1)) * jnp.einsum('becd,edf->becf', xin, w_e3)
    y = jnp.einsum('becf,efd->becd', hid, w_e2) * gate[..., None].astype(x.dtype)
    flat_idx = (idx + (jnp.arange(bsz, dtype=idx.dtype) * n)[:, None, None]).reshape(-1)
    out = jax.ops.segment_sum(y.reshape(-1, d), flat_idx, num_segments=bsz * n)
    return out.reshape(bsz, n, d)


def _layer(h, w_in, conv_w, conv_b, ssd_a_log_f, ssd_a_log_b, ssd_dt_bias_f, ssd_dt_bias_b,
           ssd_d, ssd_norm_g, w_out_ssd, s5_a_re_f, s5_a_im_f, s5_log_step_f, s5_a_re_b,
           s5_a_im_b, s5_log_step_b, s5_b_re, s5_b_im, s5_c_re, s5_c_im, s5_d, w_glu_a, w_glu_b,
           w_o, ln1_g, ln1_b, w_router, w_e1, w_e3, w_e2, ln2_g, ln2_b):
    proj = h @ w_in
    z, xbc, dt_raw, u, gates = jnp.split(proj, SPLITS, axis=-1)
    y_a = _ssd_branch(z, xbc, dt_raw, conv_w, conv_b, ssd_a_log_f, ssd_a_log_b,
                      ssd_dt_bias_f, ssd_dt_bias_b, ssd_d, ssd_norm_g, w_out_ssd)
    y_b = _s5_branch(u, s5_a_re_f, s5_a_im_f, s5_log_step_f, s5_a_re_b, s5_a_im_b, s5_log_step_b,
                     s5_b_re, s5_b_im, s5_c_re, s5_c_im, s5_d, w_glu_a, w_glu_b)
    g_a, g_b = jnp.split(gates, 2, axis=-1)
    mix = jax.nn.sigmoid(g_a) * y_a + jax.nn.sigmoid(g_b) * y_b
    h = _layer_norm(DEEPNORM_ALPHA * h + mix @ w_o, ln1_g, ln1_b)
    h = _layer_norm(DEEPNORM_ALPHA * h + _expert_choice_ffn(h, w_router, w_e1, w_e3, w_e2), ln2_g, ln2_b)
    return h


def setup_inputs(seed: int = 0) -> dict:
    key = jax.random.key(seed)
    ks = iter(jax.random.split(key, 48))
    L_ = DEPTH

    def nrm(shape, scale):
        return jax.random.normal(next(ks), (L_,) + shape, F32) * scale

    def unif(shape, lo, hi):
        return jax.random.uniform(next(ks), (L_,) + shape, F32, lo, hi)

    def dt_bias():
        dt = jnp.exp(unif((SSD_HEADS,), math.log(1e-3), math.log(1e-1)))
        return dt + jnp.log(-jnp.expm1(-dt))

    a_im_base = jnp.pi * jnp.arange(S5_STATE, dtype=F32)
    inp = {}
    inp["x"] = jax.random.normal(next(ks), (BATCH, SEQ, D_MODEL), F32)
    inp["w_in"] = nrm((D_MODEL, IN_COLS), D_MODEL ** -0.5)
    inp["conv_w"] = nrm((SSD_CONV, XBC_DIM), SSD_CONV ** -0.5)
    inp["conv_b"] = nrm((XBC_DIM,), 0.01)
    inp["ssd_a_log_f"] = jnp.log(unif((SSD_HEADS,), 1.0, 16.0))
    inp["ssd_a_log_b"] = jnp.log(unif((SSD_HEADS,), 1.0, 16.0))
    inp["ssd_dt_bias_f"] = dt_bias()
    inp["ssd_dt_bias_b"] = dt_bias()
    inp["ssd_d"] = 1.0 + nrm((SSD_HEADS,), 0.1)
    inp["ssd_norm_g"] = 1.0 + nrm((SSD_INNER,), 0.02)
    inp["w_out_ssd"] = nrm((SSD_INNER, D_MODEL), SSD_INNER ** -0.5)
    inp["s5_a_re_f"] = -0.5 + nrm((S5_GROUPS, S5_STATE), 0.01)
    inp["s5_a_im_f"] = a_im_base + nrm((S5_GROUPS, S5_STATE), 0.01)
    inp["s5_log_step_f"] = unif((S5_GROUPS,), math.log(1e-3), math.log(1e-1))
    inp["s5_a_re_b"] = -0.5 + nrm((S5_GROUPS, S5_STATE), 0.01)
    inp["s5_a_im_b"] = a_im_base + nrm((S5_GROUPS, S5_STATE), 0.01)
    inp["s5_log_step_b"] = unif((S5_GROUPS,), math.log(1e-3), math.log(1e-1))
    inp["s5_b_re"] = nrm((S5_GROUPS, S5_STATE, S5_GROUP), (2 * S5_GROUP) ** -0.5)
    inp["s5_b_im"] = nrm((S5_GROUPS, S5_STATE, S5_GROUP), (2 * S5_GROUP) ** -0.5)
    inp["s5_c_re"] = nrm((S5_GROUPS, S5_GROUP, S5_STATE), S5_STATE ** -0.5)
    inp["s5_c_im"] = nrm((S5_GROUPS, S5_GROUP, S5_STATE), S5_STATE ** -0.5)
    inp["s5_d"] = nrm((S5_WIDTH,), 1.0)
    inp["w_glu_a"] = nrm((S5_WIDTH, D_MODEL), S5_WIDTH ** -0.5)
    inp["w_glu_b"] = nrm((S5_WIDTH, D_MODEL), S5_WIDTH ** -0.5)
    inp["w_o"] = nrm((D_MODEL, D_MODEL), DEEPNORM_BETA * D_MODEL ** -0.5)
    inp["ln1_g"] = 1.0 + nrm((D_MODEL,), 0.02)
    inp["ln1_b"] = nrm((D_MODEL,), 0.02)
    inp["w_router"] = nrm((D_MODEL, N_EXPERTS), D_MODEL ** -0.5)
    inp["w_e1"] = nrm((N_EXPERTS, D_MODEL, EXPERT_FF), D_MODEL ** -0.5)
    inp["w_e3"] = nrm((N_EXPERTS, D_MODEL, EXPERT_FF), D_MODEL ** -0.5)
    inp["w_e2"] = nrm((N_EXPERTS, EXPERT_FF, D_MODEL), DEEPNORM_BETA * EXPERT_FF ** -0.5)
    inp["ln2_g"] = 1.0 + nrm((D_MODEL,), 0.02)
    inp["ln2_b"] = nrm((D_MODEL,), 0.02)
    return inp


def reference(x, w_in, conv_w, conv_b, ssd_a_log_f, ssd_a_log_b, ssd_dt_bias_f, ssd_dt_bias_b,
              ssd_d, ssd_norm_g, w_out_ssd, s5_a_re_f, s5_a_im_f, s5_log_step_f, s5_a_re_b,
              s5_a_im_b, s5_log_step_b, s5_b_re, s5_b_im, s5_c_re, s5_c_im, s5_d, w_glu_a, w_glu_b,
              w_o, ln1_g, ln1_b, w_router, w_e1, w_e3, w_e2, ln2_g, ln2_b):
    h = x
    for i in range(DEPTH):
        h = _layer(h, w_in[i], conv_w[i], conv_b[i], ssd_a_log_f[i], ssd_a_log_b[i],
                   ssd_dt_bias_f[i], ssd_dt_bias_b[i], ssd_d[i], ssd_norm_g[i], w_out_ssd[i],
                   s5_a_re_f[i], s5_a_im_f[i], s5_log_step_f[i], s5_a_re_b[i], s5_a_im_b[i],
                   s5_log_step_b[i], s5_b_re[i], s5_b_im[i], s5_c_re[i], s5_c_im[i], s5_d[i],
                   w_glu_a[i], w_glu_b[i], w_o[i], ln1_g[i], ln1_b[i], w_router[i], w_e1[i],
                   w_e3[i], w_e2[i], ln2_g[i], ln2_b[i])
    return h
```

```cpp
#include <hip/hip_runtime.h>
#include <cstdio>
#include <cstdint>
namespace pg8 {
#define PG8_LAS __attribute__((address_space(3)))
typedef unsigned short bf16_t;
typedef short bf16x8 __attribute__((ext_vector_type(8)));
typedef float f32x4 __attribute__((ext_vector_type(4)));
typedef unsigned u32x4 __attribute__((ext_vector_type(4)));
constexpr int BM = 256, BK = 64, HALF = 128, HTB = HALF * BK * 2  , STAGE_BYTES = 8 * HTB, NXCD = 8, WGM = 8;

__host__ __device__ __forceinline__ int lds_byte(int r, int c) { const int st = (r >> 4) * 2 + (c >> 5), rr = r & 15, cc = c & 31, ob = rr * 64 + cc * 2; return st * 1024 + (ob ^ (((ob >> 9) & 1) << 5)); }
__host__ __device__ __forceinline__ void stage_rc(int b, int& R, int& C) { const int st = b / 1024, sb = b % 1024, swz = sb ^ (((sb >> 9) & 1) << 5); R = (st >> 1) * 16 + swz / 64; C = (st & 1) * 32 + (swz % 64) / 2; }
__host__ __device__ __forceinline__ int perm32(int rho) { const int n = rho >> 4, i = rho & 15; return 8 * (i >> 2) + 4 * n + (i & 3); }

struct Unit { int pm, pn; };
struct Gemm { const bf16_t* A; const bf16_t* Bt; int M, N, K; };

struct StaticOrder {
    int nM, nN, nwg, G, c;
    __host__ __device__ void init(int M, int N, int G_, int c_) { nM = M / BM; nN = N / BM; nwg = nM * nN; G = G_; c = c_; }
    __host__ __device__ bool next(int i, Unit& u) const {
        const long L = (long)i * G + c; if (L >= nwg) return false;
        int wgid = (int)L; { const int q = nwg / NXCD, r = nwg % NXCD, xcd = wgid % NXCD, off = wgid / NXCD; wgid = (xcd < r ? xcd * (q + 1) : r * (q + 1) + (xcd - r) * q) + off; }
        const int nig = WGM * nN, gid = wgid / nig, fm = gid * WGM, gsz = (nM - fm) < WGM ? (nM - fm) : WGM;
        u.pm = fm + ((wgid % nig) % gsz); u.pn = (wgid % nig) / gsz; return true;
    }
    __device__ __forceinline__ void a_ready(const Unit&) const {}
    __device__ __forceinline__ void done(const Unit&) const {}
};

__device__ __forceinline__ unsigned cvt_pk_bf16(float lo, float hi) { unsigned r; asm volatile("v_cvt_pk_bf16_f32 %0, %1, %2" : "=v"(r) : "v"(lo), "v"(hi)); return r; }
typedef float f32x2 __attribute__((ext_vector_type(2)));
__device__ __forceinline__ f32x2 gelu_pk(f32x2 v) {
    const f32x2 av = __builtin_elementwise_abs(v), d = av * 0.2316418882f + 1.0f;
    f32x2 t; t.x = __builtin_amdgcn_rcpf(d.x); t.y = __builtin_amdgcn_rcpf(d.y);
    f32x2 q = t * 0.5307027145f + (-0.7265760135f); q = q * t + 0.7107068705f; q = q * t + (-0.142248368f); q = q * t + 0.127414796f; q = q * t;
    const f32x2 s = (v * v) * (-0.72134752044f);
    f32x2 e; e.x = __builtin_amdgcn_exp2f(s.x); e.y = __builtin_amdgcn_exp2f(s.y);
    const f32x2 m = v * (q * e), r = v - m;
    f32x2 o; o.x = v.x < 0.f ? m.x : r.x; o.y = v.y < 0.f ? m.y : r.y; return o;
}


__device__ __forceinline__ float fsigmoid(float x) { return __builtin_amdgcn_rcpf(1.0f + __expf(-x)); }
__device__ __forceinline__ float fsilu(float x) { return x * fsigmoid(x); }
__device__ __forceinline__ float bf_lo(unsigned w) { return __uint_as_float(w << 16); }
__device__ __forceinline__ float bf_hi(unsigned w) { return __uint_as_float(w & 0xffff0000u); }
typedef unsigned u32x2 __attribute__((ext_vector_type(2)));

struct EpiIn {
    static constexpr bool PERM = true, AFTER_DRAIN = false;
    bf16_t *Z, *XBC, *U, *GT; float* DT; const float *dtb_f, *dtb_b;
    __device__ __forceinline__ void operator()(const f32x4 (&acc)[2][2][4][2], const Unit& u, int wr, int wc, int fr, int fq) const {
        const int row0 = u.pm * BM + wr * 64 + fr; const int pn = u.pn;
        if (pn == 16) {
            if (wc < 2) {
#pragma unroll
                for (int n = 0; n < 2; ++n) { const int col = wc * 32 + 8 * fq + 4 * n;
                    if (col < 48) { f32x4 bv;
#pragma unroll
                        for (int j = 0; j < 4; ++j) { const int cc = col + j; bv[j] = cc < 24 ? dtb_f[cc] : dtb_b[cc - 24]; }
#pragma unroll
                        for (int ai = 0; ai < 2; ++ai)
#pragma unroll
                            for (int m = 0; m < 4; ++m) { f32x4 v = acc[ai][0][m][n] + bv;
#pragma unroll
                                for (int j = 0; j < 4; ++j) { const float x = v[j]; v[j] = fmaxf(x, 0.f) + log1pf(__expf(-fabsf(x))); }
                                *(f32x4*)(DT + (size_t)(row0 + ai * HALF + m * 16) * 48 + col) = v; } } }
            }
            return;
        }
        int mode, ldc, colt; bf16_t* base;
        if (pn < 6) { mode = 1; base = Z; ldc = 1536; colt = pn * BM; }
        else if (pn < 16) { mode = 0; base = XBC; ldc = 2560; colt = (pn - 6) * BM; }
        else if (pn < 20) { mode = 0; base = U; ldc = 768; colt = (pn - 17) * BM; }
        else { mode = 2; base = GT; ldc = 2048; colt = (pn - 20) * BM; }
        const int col0 = colt + wc * 32 + 8 * fq;
#pragma unroll
        for (int ai = 0; ai < 2; ++ai)
#pragma unroll
            for (int m = 0; m < 4; ++m) { bf16_t* rowp = base + (size_t)(row0 + ai * HALF + m * 16) * ldc + col0;
#pragma unroll
                for (int bj = 0; bj < 2; ++bj) { f32x4 v0 = acc[ai][bj][m][0], v1 = acc[ai][bj][m][1];
                    if (mode == 1) {
#pragma unroll
                        for (int j = 0; j < 4; ++j) { v0[j] = fsilu(v0[j]); v1[j] = fsilu(v1[j]); } }
                    else if (mode == 2) {
#pragma unroll
                        for (int j = 0; j < 4; ++j) { v0[j] = fsigmoid(v0[j]); v1[j] = fsigmoid(v1[j]); } }
                    u32x4 w; w.x = cvt_pk_bf16(v0[0], v0[1]); w.y = cvt_pk_bf16(v0[2], v0[3]); w.z = cvt_pk_bf16(v1[0], v1[1]); w.w = cvt_pk_bf16(v1[2], v1[3]);
                    *(u32x4*)(rowp + bj * HALF) = w; } }
    }
};
struct EpiSsdOut {
    static constexpr bool PERM = false, AFTER_DRAIN = false;
    float* YA; const bf16_t* GT;
    __device__ __forceinline__ void operator()(const f32x4 (&acc)[2][2][4][2], const Unit& u, int wr, int wc, int fr, int fq) const {
        const int row0 = u.pm * BM + wr * 64 + fr, col0 = u.pn * BM + wc * 32 + 4 * fq;
#pragma unroll
        for (int ai = 0; ai < 2; ++ai)
#pragma unroll
            for (int m = 0; m < 4; ++m) { const size_t r = (size_t)(row0 + ai * HALF + m * 16);
#pragma unroll
                for (int bj = 0; bj < 2; ++bj)
#pragma unroll
                    for (int n = 0; n < 2; ++n) { const int c = col0 + bj * HALF + n * 16; const u32x2 g = *(const u32x2*)(GT + r * 2048 + c);
                        f32x4 v = acc[ai][bj][m][n]; v[0] *= bf_lo(g.x); v[1] *= bf_hi(g.x); v[2] *= bf_lo(g.y); v[3] *= bf_hi(g.y);
                        *(f32x4*)(YA + r * 1024 + c) = v; } }
    }
};
struct EpiGlu {
    static constexpr bool PERM = true, AFTER_DRAIN = false;
    bf16_t* MIX; const float* YA; const bf16_t* GT;
    __device__ __forceinline__ void operator()(const f32x4 (&acc)[2][2][4][2], const Unit& u, int wr, int wc, int fr, int fq) const {
        const int row0 = u.pm * BM + wr * 64 + fr, col0 = u.pn * HALF + wc * 32 + 8 * fq;
#pragma unroll
        for (int ai = 0; ai < 2; ++ai)
#pragma unroll
            for (int m = 0; m < 4; ++m) { const size_t r = (size_t)(row0 + ai * HALF + m * 16);
                const u32x4 g = *(const u32x4*)(GT + r * 2048 + 1024 + col0); const f32x4 y0 = *(const f32x4*)(YA + r * 1024 + col0), y1 = *(const f32x4*)(YA + r * 1024 + col0 + 4);
                f32x4 a0 = acc[ai][0][m][0], a1 = acc[ai][0][m][1]; const f32x4 b0 = acc[ai][1][m][0], b1 = acc[ai][1][m][1];
#pragma unroll
                for (int j = 0; j < 4; ++j) { a0[j] *= fsigmoid(b0[j]); a1[j] *= fsigmoid(b1[j]); }
                a0[0] = a0[0] * bf_lo(g.x) + y0[0]; a0[1] = a0[1] * bf_hi(g.x) + y0[1]; a0[2] = a0[2] * bf_lo(g.y) + y0[2]; a0[3] = a0[3] * bf_hi(g.y) + y0[3];
                a1[0] = a1[0] * bf_lo(g.z) + y1[0]; a1[1] = a1[1] * bf_hi(g.z) + y1[1]; a1[2] = a1[2] * bf_lo(g.w) + y1[2]; a1[3] = a1[3] * bf_hi(g.w) + y1[3];
                u32x4 w; w.x = cvt_pk_bf16(a0[0], a0[1]); w.y = cvt_pk_bf16(a0[2], a0[3]); w.z = cvt_pk_bf16(a1[0], a1[1]); w.w = cvt_pk_bf16(a1[2], a1[3]);
                *(u32x4*)(MIX + r * 1024 + col0) = w; }
    }
};
struct EpiWo {
    static constexpr bool PERM = false, AFTER_DRAIN = false;
    float* HP; const float* X; float alpha;
    __device__ __forceinline__ void operator()(const f32x4 (&acc)[2][2][4][2], const Unit& u, int wr, int wc, int fr, int fq) const {
        const int row0 = u.pm * BM + wr * 64 + fr, col0 = u.pn * BM + wc * 32 + 4 * fq;
#pragma unroll
        for (int ai = 0; ai < 2; ++ai)
#pragma unroll
            for (int m = 0; m < 4; ++m) { const size_t r = (size_t)(row0 + ai * HALF + m * 16);
#pragma unroll
                for (int bj = 0; bj < 2; ++bj)
#pragma unroll
                    for (int n = 0; n < 2; ++n) { const int c = col0 + bj * HALF + n * 16; const f32x4 xv = *(const f32x4*)(X + r * 1024 + c);
                        *(f32x4*)(HP + r * 1024 + c) = acc[ai][bj][m][n] + xv * alpha; } }
    }
};
struct EpiMoe1 {
    static constexpr bool PERM = true, AFTER_DRAIN = false;
    bf16_t* HID;
    __device__ __forceinline__ void operator()(const f32x4 (&acc)[2][2][4][2], const Unit& u, int wr, int wc, int fr, int fq) const {
        const int row0 = u.pm * BM + wr * 64 + fr, col0 = (u.pn % 22) * HALF + wc * 32 + 8 * fq;
#pragma unroll
        for (int ai = 0; ai < 2; ++ai)
#pragma unroll
            for (int m = 0; m < 4; ++m) { const size_t r = (size_t)(row0 + ai * HALF + m * 16);
                f32x4 a0 = acc[ai][0][m][0], a1 = acc[ai][0][m][1]; const f32x4 b0 = acc[ai][1][m][0], b1 = acc[ai][1][m][1];
#pragma unroll
                for (int j = 0; j < 4; ++j) { a0[j] = fsilu(a0[j]) * b0[j]; a1[j] = fsilu(a1[j]) * b1[j]; }
                u32x4 w; w.x = cvt_pk_bf16(a0[0], a0[1]); w.y = cvt_pk_bf16(a0[2], a0[3]); w.z = cvt_pk_bf16(a1[0], a1[1]); w.w = cvt_pk_bf16(a1[2], a1[3]);
                *(u32x4*)(HID + r * 2816 + col0) = w; }
    }
};
struct EpiMoe2 {
    static constexpr bool PERM = true, AFTER_DRAIN = false;
    bf16_t* Y;
    __device__ __forceinline__ void operator()(const f32x4 (&acc)[2][2][4][2], const Unit& u, int wr, int wc, int fr, int fq) const {
        const int row0 = u.pm * BM + wr * 64 + fr, col0 = (u.pn & 3) * BM + wc * 32 + 8 * fq;
#pragma unroll
        for (int ai = 0; ai < 2; ++ai)
#pragma unroll
            for (int m = 0; m < 4; ++m) { bf16_t* rowp = Y + (size_t)(row0 + ai * HALF + m * 16) * 1024 + col0;
#pragma unroll
                for (int bj = 0; bj < 2; ++bj) { const f32x4 v0 = acc[ai][bj][m][0], v1 = acc[ai][bj][m][1];
                    u32x4 w; w.x = cvt_pk_bf16(v0[0], v0[1]); w.y = cvt_pk_bf16(v0[2], v0[3]); w.z = cvt_pk_bf16(v1[0], v1[1]); w.w = cvt_pk_bf16(v1[2], v1[3]);
                    *(u32x4*)(rowp + bj * HALF) = w; } }
    }
};
struct MoeOrder1 {
    int G, c;
    __device__ __forceinline__ bool next(int i, Unit& u) const {
        if (G == 256) { if (i >= 11) return false; const int x = c & 7, j = c >> 3, q = x * 44 + i * 4 + (j >> 3); u.pm = (q / 22) * 8 + (j & 7); u.pn = q; return true; }
        const long L = (long)i * G + c; if (L >= 2816) return false; const int e = (int)(L / 176), r = (int)(L % 176); u.pm = e * 8 + (r & 7); u.pn = e * 22 + (r >> 3); return true;
    }
    __device__ __forceinline__ void a_ready(const Unit&) const {}
    __device__ __forceinline__ void done(const Unit&) const {}
};
struct MoeOrder2 {
    int G, c;
    __device__ __forceinline__ bool next(int i, Unit& u) const {
        if (G == 256) { if (i >= 2) return false; const int x = c & 7, j = c >> 3, e = 2 * x + i; u.pm = e * 8 + (j & 7); u.pn = e * 4 + (j >> 3); return true; }
        const long L = (long)i * G + c; if (L >= 512) return false; const int e = (int)(L / 32), r = (int)(L % 32); u.pm = e * 8 + (r & 7); u.pn = e * 4 + (r >> 3); return true;
    }
    __device__ __forceinline__ void a_ready(const Unit&) const {}
    __device__ __forceinline__ void done(const Unit&) const {}
};
template <class Epi, class Sched, bool ALIGN_EPI = false, bool SP2 = false>
__device__ __forceinline__ void gemm_phase(PG8_LAS unsigned char* lds, const Gemm g, const Sched& S, const Epi& E) {
    const int tid = threadIdx.x, wid = __builtin_amdgcn_readfirstlane(tid >> 6), lane = tid & 63, wr = wid >> 2, wc = wid & 3, fr = lane & 15, fq = lane >> 4;
    const int K = g.K, nt = K / BK;
    unsigned voffA[2], voffB[2];
#pragma unroll
    for (int i = 0; i < 2; ++i) { int R, C; stage_rc(tid * 16 + i * 8192, R, C); const int Rb = Epi::PERM ? ((R & ~31) + perm32(R & 31)) : R;
        voffA[i] = (unsigned)(R * K + C) * 2u; voffB[i] = (unsigned)(Rb * K + C) * 2u; }
    const size_t kstep = (size_t)(BK * 2);
    const size_t hstep = (size_t)HALF * K * 2;
    const size_t tstep = 2 * hstep;
    const unsigned ldsw = (unsigned)wid * 1024u;
    const int aoff = lds_byte(wr * 64 + fr, fq * 8), boff = lds_byte(wc * 32 + fr, fq * 8);
#define PG8_SA(b, h) (((b) * 2 + (h)) * HTB)
#define PG8_SB(b, h) ((4 + (b) * 2 + (h)) * HTB)
#define PG8_STAGE(bufoff, gbase, voff) do { _Pragma("unroll") for (int _i = 0; _i < 2; ++_i) \
        __builtin_amdgcn_global_load_lds((const unsigned*)((const char*)(gbase) + (voff)[_i]), (PG8_LAS unsigned*)(lds + (bufoff) + ldsw + _i * 8192), 16, 0, 0); } while (0)
#define PG8_LDA(dst, b, h) do { _Pragma("unroll") for (int m = 0; m < 4; ++m) _Pragma("unroll") for (int k = 0; k < 2; ++k) dst[m][k] = *(const PG8_LAS bf16x8*)(lds + PG8_SA(b, h) + aoff + m * 2048 + k * 1024); } while (0)
#define PG8_LDB(dst, b, h) do { _Pragma("unroll") for (int n = 0; n < 2; ++n) _Pragma("unroll") for (int k = 0; k < 2; ++k) dst[n][k] = *(const PG8_LAS bf16x8*)(lds + PG8_SB(b, h) + boff + n * 2048 + k * 1024); } while (0)
#define PG8_MMA(ai, bj, At, Bt) do { __builtin_amdgcn_s_setprio(1); _Pragma("unroll") for (int m = 0; m < 4; ++m) _Pragma("unroll") for (int n = 0; n < 2; ++n) _Pragma("unroll") for (int k = 0; k < 2; ++k) \
        acc[ai][bj][m][n] = __builtin_amdgcn_mfma_f32_16x16x32_bf16(Bt[n][k], At[m][k], acc[ai][bj][m][n], 0, 0, 0); __builtin_amdgcn_s_setprio(0); } while (0)
#define PG8_WAIT_V(n) asm volatile("s_waitcnt vmcnt(" #n ")" ::: "memory")
#define PG8_WAIT_L(n) asm volatile("s_waitcnt lgkmcnt(" #n ")" ::: "memory")
#define PG8_BAR __builtin_amdgcn_s_barrier()
#define PG8_SCHED __builtin_amdgcn_sched_barrier(0)
    Unit cur, nxt; int ui = 0;
    if (!S.next(0, cur)) return;
    f32x4 acc[2][2][4][2];
#pragma unroll
    for (int a = 0; a < 2; ++a)
#pragma unroll
        for (int b = 0; b < 2; ++b)
#pragma unroll
            for (int m = 0; m < 4; ++m)
#pragma unroll
                for (int n = 0; n < 2; ++n) acc[a][b][m][n] = (f32x4){0.f, 0.f, 0.f, 0.f};
    bf16x8 At[4][2], B0[2][2], B1[2][2];
    const char* cA = (const char*)g.A + (size_t)cur.pm * tstep; const char* cB = (const char*)g.Bt + (size_t)cur.pn * tstep;
    S.a_ready(cur);
    if constexpr (SP2) {
        PG8_STAGE(PG8_SB(0, 0), cB, voffB); PG8_STAGE(PG8_SB(0, 1), cB + hstep, voffB); PG8_STAGE(PG8_SA(0, 0), cA, voffA); PG8_STAGE(PG8_SA(0, 1), cA + hstep, voffA);
        if (wr == 1) PG8_BAR;
        PG8_WAIT_V(2); PG8_BAR;
        PG8_STAGE(PG8_SB(1, 0), cB + kstep, voffB); PG8_STAGE(PG8_SA(1, 0), cA + kstep, voffA); PG8_STAGE(PG8_SB(1, 1), cB + hstep + kstep, voffB);
        PG8_WAIT_V(6); PG8_BAR;
    } else {
        PG8_STAGE(PG8_SB(0, 0), cB, voffB); PG8_STAGE(PG8_SA(0, 0), cA, voffA); PG8_STAGE(PG8_SB(0, 1), cB + hstep, voffB); PG8_STAGE(PG8_SA(0, 1), cA + hstep, voffA);
        if (wr == 1) PG8_BAR;
        PG8_WAIT_V(4); PG8_BAR;
        PG8_STAGE(PG8_SB(1, 0), cB + kstep, voffB); PG8_STAGE(PG8_SA(1, 0), cA + kstep, voffA); PG8_STAGE(PG8_SB(1, 1), cB + hstep + kstep, voffB);
        PG8_WAIT_V(6); PG8_BAR;
    }
    for (;;) {
        const bool has_next = S.next(ui + 1, nxt);
        const char* nA = has_next ? (const char*)g.A + (size_t)nxt.pm * tstep : cA; const char* nB = has_next ? (const char*)g.Bt + (size_t)nxt.pn * tstep : cB;
        for (int t = 0; t < nt; t += 2) {
            const bool last = (t == nt - 2);
            const char* a1 = cA + (size_t)(t + 1) * kstep;
            const char* a2 = last ? nA : cA + (size_t)(t + 2) * kstep; const char* b2 = last ? nB : cB + (size_t)(t + 2) * kstep;
            const char* a3 = a2 + kstep; const char* b3 = b2 + kstep;
            if (last && has_next) S.a_ready(nxt);
            if constexpr (SP2) {
            PG8_LDB(B0, 0, 0); PG8_LDB(B1, 0, 1); PG8_SCHED; PG8_LDA(At, 0, 0); PG8_STAGE(PG8_SA(1, 1), a1 + hstep, voffA);
            PG8_WAIT_V(8); PG8_WAIT_L(0); PG8_BAR; PG8_MMA(0, 0, At, B0); PG8_MMA(0, 1, At, B1); PG8_BAR; PG8_SCHED;
            PG8_LDA(At, 0, 1); PG8_STAGE(PG8_SB(0, 0), b2, voffB); PG8_STAGE(PG8_SB(0, 1), b2 + hstep, voffB); PG8_STAGE(PG8_SA(0, 0), a2, voffA);
            PG8_WAIT_V(8); PG8_WAIT_L(0); PG8_BAR; PG8_MMA(1, 0, At, B0); PG8_MMA(1, 1, At, B1); PG8_BAR; PG8_SCHED;
            PG8_LDB(B0, 1, 0); PG8_LDB(B1, 1, 1); PG8_SCHED; PG8_LDA(At, 1, 0); PG8_STAGE(PG8_SA(0, 1), a2 + hstep, voffA);
            PG8_WAIT_V(8); PG8_WAIT_L(0); PG8_BAR; PG8_MMA(0, 0, At, B0); PG8_MMA(0, 1, At, B1); PG8_BAR; PG8_SCHED;
            PG8_LDA(At, 1, 1); PG8_STAGE(PG8_SB(1, 0), b3, voffB); PG8_STAGE(PG8_SB(1, 1), b3 + hstep, voffB); PG8_STAGE(PG8_SA(1, 0), a3, voffA);
            PG8_WAIT_V(8); PG8_WAIT_L(0); PG8_BAR; PG8_MMA(1, 0, At, B0); PG8_MMA(1, 1, At, B1); PG8_BAR; PG8_SCHED;
            } else {
            PG8_LDB(B0, 0, 0); PG8_SCHED; PG8_LDA(At, 0, 0); PG8_STAGE(PG8_SA(1, 1), a1 + hstep, voffA);
            PG8_WAIT_L(8); PG8_BAR; PG8_WAIT_L(0); PG8_MMA(0, 0, At, B0); PG8_BAR; PG8_SCHED;
            PG8_LDB(B1, 0, 1); PG8_STAGE(PG8_SB(0, 0), b2, voffB);
            PG8_BAR; PG8_WAIT_L(0); PG8_MMA(0, 1, At, B1); PG8_BAR;
            PG8_LDA(At, 0, 1); PG8_STAGE(PG8_SA(0, 0), a2, voffA);
            PG8_BAR; PG8_WAIT_L(0); PG8_MMA(1, 0, At, B0); PG8_BAR; PG8_SCHED;
            PG8_STAGE(PG8_SB(0, 1), b2 + hstep, voffB);
            PG8_WAIT_V(6); PG8_BAR; PG8_MMA(1, 1, At, B1); PG8_BAR;
            PG8_LDB(B0, 1, 0); PG8_SCHED; PG8_LDA(At, 1, 0); PG8_STAGE(PG8_SA(0, 1), a2 + hstep, voffA);
            PG8_WAIT_L(8); PG8_BAR; PG8_WAIT_L(0); PG8_MMA(0, 0, At, B0); PG8_BAR; PG8_SCHED;
            PG8_LDB(B1, 1, 1); PG8_STAGE(PG8_SB(1, 0), b3, voffB);
            PG8_BAR; PG8_WAIT_L(0); PG8_MMA(0, 1, At, B1); PG8_BAR;
            PG8_LDA(At, 1, 1); PG8_STAGE(PG8_SA(1, 0), a3, voffA);
            PG8_BAR; PG8_WAIT_L(0); PG8_MMA(1, 0, At, B0); PG8_BAR; PG8_SCHED;
            PG8_STAGE(PG8_SB(1, 1), b3 + hstep, voffB);
            PG8_WAIT_V(6); PG8_BAR; PG8_MMA(1, 1, At, B1); PG8_BAR;
            }
        }
        if constexpr (ALIGN_EPI) { if (wr == 0) PG8_BAR; }
        if constexpr (!Epi::AFTER_DRAIN) { E(acc, cur, wr, wc, fr, fq); S.done(cur); }
        if (!has_next) break;
#pragma unroll
        for (int a = 0; a < 2; ++a)
#pragma unroll
            for (int b = 0; b < 2; ++b)
#pragma unroll
                for (int m = 0; m < 4; ++m)
#pragma unroll
                    for (int n = 0; n < 2; ++n) acc[a][b][m][n] = (f32x4){0.f, 0.f, 0.f, 0.f};
        cur = nxt; cA = nA; cB = nB; ++ui;
        if constexpr (ALIGN_EPI) { if (wr == 1) PG8_BAR; }
    }
    PG8_WAIT_V(0);
    if constexpr (!ALIGN_EPI) { if (wr == 0) PG8_BAR; }
    PG8_BAR;
    if constexpr (Epi::AFTER_DRAIN) { E.fused(acc, cur, wr, wc, fr, fq, lds, wid, lane); S.done(cur); }
#undef PG8_SA
#undef PG8_SB
#undef PG8_STAGE
#undef PG8_LDA
#undef PG8_LDB
#undef PG8_MMA
#undef PG8_WAIT_V
#undef PG8_WAIT_L
#undef PG8_BAR
#undef PG8_SCHED
}
}
#ifndef PG8_SP2
#define PG8_SP2 true
#endif
#ifndef PG8_ALIGN
#define PG8_ALIGN true
#endif

constexpr int NWAVES = 8, NTHR = 512;
constexpr int D = 1024, NB = 2, T = 8192, M = NB * T;
constexpr int SSD_H = 24, SSD_P = 64, SSD_IN = 1536, SSD_G = 4, SSD_N = 128, XBC = 2560, INCOLS = 6960, NIN_PAD = 7168;
constexpr int S5_W = 768, S5_G = 48, S5_P = 64, S5_K = 16;
constexpr int NE = 16, FF = 2816, CAP = 1024, MROWS = NE * NB * CAP;
constexpr float LN_EPS = 1e-5f, RMS_EPS = 1e-5f;
constexpr float ALPHA = 1.189207115002721f;

constexpr size_t MiB = 1u << 20;
constexpr size_t WS_CTL = 0, CTL_ZERO_BYTES = 64 * 1024;
constexpr size_t WS_WIN = 1 * MiB, WS_WOUT = 15 * MiB, WS_WGLU = 18 * MiB, WS_WO = 21 * MiB, WS_W1 = 23 * MiB, WS_W2 = 199 * MiB, WS_ACT = 287 * MiB;
constexpr size_t A_XB = WS_ACT + 0 * MiB;
constexpr size_t A_Z = WS_ACT + 32 * MiB;
constexpr size_t A_XBC = WS_ACT + 80 * MiB;
constexpr size_t A_GT = WS_ACT + 160 * MiB;
constexpr size_t A_U = WS_ACT + 224 * MiB;
constexpr size_t A_DT = WS_ACT + 248 * MiB;
constexpr size_t A_XS = WS_ACT + 251 * MiB;
constexpr size_t A_BM = WS_ACT + 299 * MiB;
constexpr size_t A_CM = WS_ACT + 315 * MiB;
constexpr size_t A_YF = WS_ACT + 80 * MiB;
constexpr size_t A_YB = WS_ACT + 369 * MiB;
constexpr size_t A_Y5F = WS_ACT + 128 * MiB;
constexpr size_t A_Y5B = WS_ACT + 0 * MiB;
constexpr size_t A_YA = WS_ACT + 0 * MiB;
constexpr size_t A_MIX = WS_ACT + 224 * MiB;
constexpr size_t A_HP = WS_ACT + 256 * MiB;
constexpr size_t A_H = WS_ACT + 349 * MiB;
constexpr size_t A_HB = WS_ACT + 0 * MiB;
constexpr size_t A_AFF = WS_ACT + 413 * MiB;
constexpr size_t A_IDX = A_AFF + 512 * 1024;
constexpr size_t A_SEL = A_AFF + 1 * MiB;
constexpr size_t A_GATE = A_AFF + 2 * MiB;
constexpr size_t A_XIN = WS_ACT + 32 * MiB;
constexpr size_t A_HID = WS_ACT + 96 * MiB;
constexpr size_t A_YE = WS_ACT + 272 * MiB;
constexpr size_t WS_END = 704 * MiB;
static_assert(A_GATE + 1 * MiB <= WS_END && A_H + 64 * MiB <= A_AFF && A_YE + 64 * MiB <= A_H && A_HID + 176 * MiB <= A_YE && A_XIN + 64 * MiB <= A_HID, "d_ws map (late phases)");
static_assert(A_YB + 48 * MiB <= WS_END && A_CM + 16 * MiB <= A_YB && A_Y5F + 24 * MiB <= A_GT && A_YF + 48 * MiB <= A_Y5F && A_Y5B + 24 * MiB <= A_Z, "d_ws map (early phases)");
constexpr int CW_BAR = 1024;

constexpr int RING_BYTES = 131072;
constexpr int MISC_OFF = RING_BYTES;
constexpr int LDS_BYTES = 147456;

#define GAS __attribute__((address_space(1)))
#define LAS __attribute__((address_space(3)))
typedef unsigned short bf16;
typedef unsigned v4u __attribute__((ext_vector_type(4)));
typedef unsigned v2u __attribute__((ext_vector_type(2)));
typedef float f32x4 __attribute__((ext_vector_type(4)));
#define LDS_WAIT() asm volatile("s_waitcnt lgkmcnt(0)" ::: "memory")
__device__ __forceinline__ unsigned f2bf(float f) { unsigned u = __builtin_bit_cast(unsigned, f); return (u + 0x7fffu + ((u >> 16) & 1u)) >> 16; }
__device__ __forceinline__ unsigned pk2(float lo, float hi) { return f2bf(lo) | (f2bf(hi) << 16); }
__device__ __forceinline__ float bflo(unsigned w) { return __uint_as_float(w << 16); }
__device__ __forceinline__ float bfhi(unsigned w) { return __uint_as_float(w & 0xffff0000u); }
__device__ __forceinline__ float wave_sum(float v) {
#pragma unroll
    for (int o = 1; o < 64; o <<= 1) v += __shfl_xor(v, o);
    return v;
}
#define XB_TMO      128
#define XB_XCNT(j)  (256  + 64 * (j))
#define XB_XSUB(j)  (1280 + 64 * (j))
#define XB_XGEN(j)  (2304 + 64 * (j))
#define XB_TOP      3328
#define XB_TOPGEN   3392
#define XCD_BAR_WORDS 3456
#define XB_SPIN_CAP (1u << 18)

__device__ __forceinline__ unsigned xb_ld(unsigned* p)              { return __hip_atomic_load(p, __ATOMIC_RELAXED, __HIP_MEMORY_SCOPE_AGENT); }
__device__ __forceinline__ unsigned xb_add(unsigned* p, unsigned v) { return __hip_atomic_fetch_add(p, v, __ATOMIC_RELAXED, __HIP_MEMORY_SCOPE_AGENT); }
__device__ __forceinline__ unsigned xb_xcc_id() { return (unsigned)__builtin_amdgcn_s_getreg((3 << 11) | 20) & 0xFu; }
#define XB_SPIN(cond, bar) do { unsigned _sp = 0; while (cond) { __builtin_amdgcn_s_sleep(1); \
    if ((++_sp & 255u) == 0u) { if (xb_ld(&(bar)[XB_TMO])) break; if (_sp > XB_SPIN_CAP) { atomicAdd(&(bar)[XB_TMO], 1u); break; } } } } while (0)

struct XcdBarrier {
    unsigned* bar; unsigned x;
    volatile LAS unsigned* st;
};

__device__ __forceinline__ XcdBarrier xcd_barrier_post(unsigned* bar, volatile LAS unsigned* st) {
    XcdBarrier b; b.bar = bar; b.x = xb_xcc_id(); b.st = st;
    if (threadIdx.x == 0) (void)xb_add(&bar[XB_XCNT(b.x)], 1u);
    return b;
}
__device__ __forceinline__ void xcd_barrier_complete(unsigned* bar, unsigned x, unsigned& nloc, unsigned& nx) {
    const unsigned G = gridDim.x * gridDim.y * gridDim.z;
    unsigned sum, cnt, mine, sp = 0u;
    for (;;) {
        sum = 0u; cnt = 0u; mine = 0u;
#pragma unroll
        for (unsigned j = 0; j < 16; ++j) { const unsigned c = xb_ld(&bar[XB_XCNT(j)]); sum += c; cnt += (c > 0u) ? 1u : 0u; mine = (j == x) ? c : mine; }
        if (sum == G) break;
        __builtin_amdgcn_s_sleep(1);
        if ((++sp & 255u) == 0u) { if (xb_ld(&bar[XB_TMO])) break; if (sp > XB_SPIN_CAP) { atomicAdd(&bar[XB_TMO], 1u); break; } }
    }
    nloc = mine > 0u ? mine : 1u; nx = cnt > 0u ? cnt : 1u;
}

__device__ __forceinline__ void xcd_barrier(const XcdBarrier& b) {
    asm volatile("s_waitcnt vmcnt(0)" ::: "memory");
    __syncthreads();
    if (threadIdx.x == 0) {
        unsigned* bar = b.bar;
        __builtin_amdgcn_s_waitcnt(0);
        unsigned nloc = b.st[0], nx = b.st[1];
        if (nloc == 0u) { xcd_barrier_complete(bar, b.x, nloc, nx); b.st[0] = nloc; b.st[1] = nx; }
        const unsigned old = xb_add(&bar[XB_XSUB(b.x)], 1u);
        const unsigned gen = old / nloc;
        if (old + 1u == (gen + 1u) * nloc) {
            __builtin_amdgcn_fence(__ATOMIC_RELEASE, "agent");
            asm volatile("s_waitcnt vmcnt(0)" ::: "memory");
            const unsigned og = xb_add(&bar[XB_TOP], 1u);
            const unsigned tg = og / nx;
            if (og + 1u == (tg + 1u) * nx) xb_add(&bar[XB_TOPGEN], 1u);
            else XB_SPIN(xb_ld(&bar[XB_TOPGEN]) == tg, bar);
            __builtin_amdgcn_fence(__ATOMIC_ACQUIRE, "agent");
            xb_add(&bar[XB_XGEN(b.x)], 1u);
            asm volatile("s_waitcnt vmcnt(0)" ::: "memory");
        } else {
            XB_SPIN(xb_ld(&bar[XB_XGEN(b.x)]) == gen, bar);
            __builtin_amdgcn_fence(__ATOMIC_ACQUIRE, "agent");
            asm volatile("s_waitcnt vmcnt(0)" ::: "memory");
        }
    }
    __syncthreads();
}

struct Frame {
    LAS unsigned char* lds;
    int tid, lane, wave, bid, G;
    const float* const* in; float* out; unsigned char* ws;
};
#define WSP(T_, off) ((T_*)(F.ws + (off)))

__device__ __forceinline__ void tr_item(const float* W, int ldw, int col0, int ncols, int K, bf16* WT, int drow, LAS float* scr, int k0, int n0, int lane) {
    const int nl = lane & 31; const bool okc = (n0 + nl) < ncols;
#pragma unroll 8
    for (int i = 0; i < 32; ++i) { const int kk = 2 * i + (lane >> 5); scr[kk * 33 + nl] = okc ? W[(size_t)(k0 + kk) * ldw + col0 + n0 + nl] : 0.f; }
    LDS_WAIT(); asm volatile("" ::: "memory");
    const int c = lane & 7;
#pragma unroll
    for (int j = 0; j < 4; ++j) { const int n = (lane >> 3) + 8 * j; const LAS float* s = scr + (8 * c) * 33 + n;
        v4u o; o.x = pk2(s[0 * 33], s[1 * 33]); o.y = pk2(s[2 * 33], s[3 * 33]); o.z = pk2(s[4 * 33], s[5 * 33]); o.w = pk2(s[6 * 33], s[7 * 33]);
        if (n0 + n < ncols) *(v4u*)(WT + (size_t)(drow + n) * K + k0 + 8 * c) = o; }
    LDS_WAIT(); asm volatile("" ::: "memory");
}
struct TrJob { const float* W; int ldw, col0, ncols, K; bf16* WT; int drow0, interleave; };
__device__ __forceinline__ int tr_job_items(const TrJob& j) { return (j.K / 64) * ((j.ncols + 31) / 32); }
__device__ __forceinline__ void tr_job_item(const TrJob& j, int item, LAS float* scr, int lane) {
    const int nblk = (j.ncols + 31) / 32, kb = item / nblk, nb = item % nblk, n0 = nb * 32;
    const int drow = j.interleave ? j.drow0 + (n0 >> 7) * 256 + (n0 & 127) : j.drow0 + n0;
    tr_item(j.W, j.ldw, j.col0, j.ncols, j.K, j.WT, drow, scr, kb * 64, n0, lane);
}
__device__ __forceinline__ void p0_prologue(Frame& F) {
    LAS float* scr = (LAS float*)(F.lds + F.wave * 8704);
    const int gw = F.bid * NWAVES + F.wave, NGW = F.G * NWAVES;
    { const f32x4* x4 = (const f32x4*)F.in[0]; v4u* o = WSP(v4u, A_XB); const int n8 = M * D / 8;
      for (int i = F.bid * NTHR + F.tid; i < n8; i += F.G * NTHR) { const f32x4 a = x4[2 * i], b = x4[2 * i + 1]; v4u w; w.x = pk2(a.x, a.y); w.y = pk2(a.z, a.w); w.z = pk2(b.x, b.y); w.w = pk2(b.z, b.w); o[i] = w; } }
    {
        bf16* WIN = WSP(bf16, WS_WIN); bf16* WOUT = WSP(bf16, WS_WOUT); bf16* WGLU = WSP(bf16, WS_WGLU); bf16* WO = WSP(bf16, WS_WO);
        const TrJob jobs[8] = {
            {F.in[1], INCOLS, 0, 4096, D, WIN, 0, 0}, {F.in[1], INCOLS, 4096, 48, D, WIN, 4096, 0}, {F.in[1], INCOLS, 4144, 768, D, WIN, 4352, 0}, {F.in[1], INCOLS, 4912, 2048, D, WIN, 5120, 0},
            {F.in[10], D, 0, D, SSD_IN, WOUT, 0, 0}, {F.in[22], D, 0, D, S5_W, WGLU, 0, 1}, {F.in[23], D, 0, D, S5_W, WGLU, 128, 1}, {F.in[24], D, 0, D, D, WO, 0, 0} };
        int base = 0;
#pragma unroll
        for (int q = 0; q < 8; ++q) { const int n = tr_job_items(jobs[q]);
            int it0 = (gw - base) % NGW; if (it0 < 0) it0 += NGW;
            for (int it = it0; it < n; it += NGW) tr_job_item(jobs[q], it, scr, F.lane);
            base += n; }
    }
    {
        bf16* W1 = WSP(bf16, WS_W1); bf16* W2 = WSP(bf16, WS_W2);
        constexpr int I13 = (D / 64) * (FF / 32), I2 = (FF / 64) * (D / 32);
        for (int it = gw; it < NE * (2 * I13 + I2); it += NGW) {
            const int e = it / (2 * I13 + I2); int r = it % (2 * I13 + I2);
            if (r < I13) { const TrJob j{F.in[28] + (size_t)e * D * FF, FF, 0, FF, D, W1 + (size_t)e * 2 * FF * D, 0, 1}; tr_job_item(j, r, scr, F.lane); continue; } r -= I13;
            if (r < I13) { const TrJob j{F.in[29] + (size_t)e * D * FF, FF, 0, FF, D, W1 + (size_t)e * 2 * FF * D, 128, 1}; tr_job_item(j, r, scr, F.lane); continue; } r -= I13;
            const TrJob j{F.in[30] + (size_t)e * FF * D, D, 0, D, FF, W2 + (size_t)e * D * FF, 0, 0}; tr_job_item(j, r, scr, F.lane);
        }
    }
}

__device__ __forceinline__ void unpack8(const v4u w, float (&f)[8]) { f[0] = bflo(w.x); f[1] = bfhi(w.x); f[2] = bflo(w.y); f[3] = bfhi(w.y); f[4] = bflo(w.z); f[5] = bfhi(w.z); f[6] = bflo(w.w); f[7] = bfhi(w.w); }
__device__ __forceinline__ void p2_conv(Frame& F) {
    const bf16* xbc = WSP(bf16, A_XBC); bf16* XS = WSP(bf16, A_XS); bf16* BMp = WSP(bf16, A_BM); bf16* CMp = WSP(bf16, A_CM);
    const float* cw = F.in[2]; const float* cb = F.in[3];
    constexpr int RUN = 32, NCG = XBC / 8, NITEM = (M / RUN) * NCG;
    for (int item = F.bid * NTHR + F.tid; item < NITEM; item += F.G * NTHR) {
        const int cg = item % NCG, r = item / NCG, ch = cg * 8, m0 = r * RUN, tb = m0 % T;
        float w[5][8], bias[8];
#pragma unroll
        for (int k = 0; k < 5; ++k) { const f32x4 a = *(const f32x4*)(cw + k * XBC + ch), b = *(const f32x4*)(cw + k * XBC + ch + 4); w[k][0] = a.x; w[k][1] = a.y; w[k][2] = a.z; w[k][3] = a.w; w[k][4] = b.x; w[k][5] = b.y; w[k][6] = b.z; w[k][7] = b.w; }
        { const f32x4 a = *(const f32x4*)(cb + ch), b = *(const f32x4*)(cb + ch + 4); bias[0] = a.x; bias[1] = a.y; bias[2] = a.z; bias[3] = a.w; bias[4] = b.x; bias[5] = b.y; bias[6] = b.z; bias[7] = b.w; }
        bf16* dst; int ldd, dc;
        if (ch < SSD_IN) { dst = XS; ldd = SSD_IN; dc = ch; } else if (ch < SSD_IN + 512) { dst = BMp; ldd = 512; dc = ch - SSD_IN; } else { dst = CMp; ldd = 512; dc = ch - SSD_IN - 512; }
        const v4u zero4 = {0u, 0u, 0u, 0u};
        v4u win[5];
        const bf16* src = xbc + (size_t)m0 * XBC + ch;
        win[0] = (tb - 2 >= 0) ? *(const v4u*)(src - 2 * XBC) : zero4;
        win[1] = (tb - 1 >= 0) ? *(const v4u*)(src - 1 * XBC) : zero4;
        win[2] = *(const v4u*)(src);
        win[3] = *(const v4u*)(src + XBC);
        for (int i = 0; i < RUN; ++i) {
            win[4] = (tb + i + 2 < T) ? *(const v4u*)(src + (size_t)(i + 2) * XBC) : zero4;
            float acc[8];
#pragma unroll
            for (int j = 0; j < 8; ++j) acc[j] = bias[j];
#pragma unroll
            for (int k = 0; k < 5; ++k) { float f[8]; unpack8(win[k], f);
#pragma unroll
                for (int j = 0; j < 8; ++j) acc[j] += w[k][j] * f[j]; }
#pragma unroll
            for (int j = 0; j < 8; ++j) acc[j] = acc[j] * __builtin_amdgcn_rcpf(1.0f + __expf(-acc[j]));
            v4u o; o.x = pk2(acc[0], acc[1]); o.y = pk2(acc[2], acc[3]); o.z = pk2(acc[4], acc[5]); o.w = pk2(acc[6], acc[7]);
            *(v4u*)(dst + (size_t)(m0 + i) * ldd + dc) = o;
            win[0] = win[1]; win[1] = win[2]; win[2] = win[3]; win[3] = win[4];
        }
    }
}

__device__ __forceinline__ void ssd_naive(Frame& F, int blk) {
    const int dir = blk & 1, h = (blk >> 1) % SSD_H, b = blk / (2 * SSD_H), g = h / 6;
    const float a = -__expf((dir ? F.in[5] : F.in[4])[h]);
    const bf16* XS = WSP(bf16, A_XS); const bf16* BMp = WSP(bf16, A_BM); const bf16* CMp = WSP(bf16, A_CM); const float* DT = WSP(float, A_DT);
    bf16* YO = dir ? WSP(bf16, A_YB) : WSP(bf16, A_YF);
    LAS float* Bs = (LAS float*)(F.lds); LAS float* Cs = Bs + 64 * 128; LAS float* Xs = Cs + 64 * 128; LAS float* Ys = Xs + 64 * 64; LAS float* Ds = Ys + 64 * 64;
    const int tid = F.tid, p = tid >> 3, nq = tid & 7;
    float hs[16];
#pragma unroll
    for (int i = 0; i < 16; ++i) hs[i] = 0.f;
    for (int c = 0; c < T / 64; ++c) {
        const int tbase = dir ? (T - 64 * (c + 1)) : 64 * c; const size_t mb = (size_t)b * T + tbase;
        { const int idx = tid * 16, row = idx >> 7, col = idx & 127;
          const v4u b0 = *(const v4u*)(BMp + (mb + row) * 512 + g * 128 + col), b1 = *(const v4u*)(BMp + (mb + row) * 512 + g * 128 + col + 8);
          const v4u c0 = *(const v4u*)(CMp + (mb + row) * 512 + g * 128 + col), c1 = *(const v4u*)(CMp + (mb + row) * 512 + g * 128 + col + 8);
          float f[8];
          unpack8(b0, f);
#pragma unroll
          for (int j = 0; j < 8; ++j) Bs[idx + j] = f[j];
          unpack8(b1, f);
#pragma unroll
          for (int j = 0; j < 8; ++j) Bs[idx + 8 + j] = f[j];
          unpack8(c0, f);
#pragma unroll
          for (int j = 0; j < 8; ++j) Cs[idx + j] = f[j];
          unpack8(c1, f);
#pragma unroll
          for (int j = 0; j < 8; ++j) Cs[idx + 8 + j] = f[j];
          const int xi = tid * 8, xr = xi >> 6, xc = xi & 63;
          const v4u x0 = *(const v4u*)(XS + (mb + xr) * SSD_IN + h * 64 + xc); unpack8(x0, f);
#pragma unroll
          for (int j = 0; j < 8; ++j) Xs[xi + j] = f[j];
          if (tid < 64) Ds[tid] = DT[(mb + tid) * 48 + dir * 24 + h]; }
        __syncthreads();
        for (int jj = 0; jj < 64; ++jj) {
            const int tl = dir ? 63 - jj : jj;
            const float dt = Ds[tl], da = __expf(dt * a), dtx = dt * Xs[tl * 64 + p];
            const LAS float* Bv = Bs + tl * 128 + nq * 16; const LAS float* Cv = Cs + tl * 128 + nq * 16;
            float acc = 0.f;
#pragma unroll
            for (int i = 0; i < 16; ++i) { hs[i] = hs[i] * da + dtx * Bv[i]; acc += hs[i] * Cv[i]; }
            acc += __shfl_xor(acc, 1); acc += __shfl_xor(acc, 2); acc += __shfl_xor(acc, 4);
            if (nq == 0) Ys[tl * 64 + p] = acc;
        }
        __syncthreads();
        { const int xi = tid * 8, xr = xi >> 6, xc = xi & 63; const LAS float* s = Ys + xi;
          v4u o; o.x = pk2(s[0], s[1]); o.y = pk2(s[2], s[3]); o.z = pk2(s[4], s[5]); o.w = pk2(s[6], s[7]);
          *(v4u*)(YO + (mb + xr) * SSD_IN + h * 64 + xc) = o; }
        __syncthreads();
    }
}
__device__ __forceinline__ void s5_naive(Frame& F, int seq) {
    const int dir = seq & 1, g = (seq >> 1) % S5_G, b = seq / (2 * S5_G), lane = F.lane;
    const float are = (dir ? F.in[14] : F.in[11])[g * 64 + lane], aim = (dir ? F.in[15] : F.in[12])[g * 64 + lane], step = __expf((dir ? F.in[16] : F.in[13])[g]);
    const float zr = are * step, zi = aim * step;
    const float er = expf(zr), cs = cosf(zi), sn = sinf(zi), abr = er * cs, abi = er * sn;
    const float sh = sinf(0.5f * zi), dr = expm1f(zr) * cs - 2.f * sh * sh, di = abi;
    const float den = 1.0f / (are * are + aim * aim), qr = (dr * are + di * aim) * den, qi = (di * are - dr * aim) * den;
    float bbr[16], bbi[16], cr[16], ci[16];
#pragma unroll
    for (int k = 0; k < 16; ++k) { const float br = F.in[17][(size_t)(g * 64 + lane) * 16 + k], bi = F.in[18][(size_t)(g * 64 + lane) * 16 + k];
        bbr[k] = qr * br - qi * bi; bbi[k] = qr * bi + qi * br;
        cr[k] = F.in[19][(size_t)(g * 16 + k) * 64 + lane]; ci[k] = F.in[20][(size_t)(g * 16 + k) * 64 + lane]; }
    const bf16* U = WSP(bf16, A_U); bf16* YO = dir ? WSP(bf16, A_Y5B) : WSP(bf16, A_Y5F);
    LAS unsigned* us = (LAS unsigned*)(F.lds + F.wave * 2048);
    float sr = 0.f, si = 0.f;
    for (int c = 0; c < T / 64; ++c) {
        const int tbase = dir ? (T - 64 * (c + 1)) : 64 * c; const size_t mb = (size_t)b * T + tbase;
        { const v4u u0 = *(const v4u*)(U + (mb + lane) * S5_W + g * 16), u1 = *(const v4u*)(U + (mb + lane) * S5_W + g * 16 + 8);
          *(LAS v4u*)(us + lane * 8) = u0; *(LAS v4u*)(us + lane * 8 + 4) = u1; }
        LDS_WAIT(); asm volatile("" ::: "memory");
        for (int jj = 0; jj < 64; ++jj) {
            const int tl = dir ? 63 - jj : jj;
            const v4u u0 = *(const LAS v4u*)(us + tl * 8), u1 = *(const LAS v4u*)(us + tl * 8 + 4);
            float uf[16]; { float f[8]; unpack8(u0, f);
#pragma unroll
                for (int j = 0; j < 8; ++j) uf[j] = f[j];
                unpack8(u1, f);
#pragma unroll
                for (int j = 0; j < 8; ++j) uf[8 + j] = f[j]; }
            float bur = 0.f, bui = 0.f;
#pragma unroll
            for (int k = 0; k < 16; ++k) { bur += bbr[k] * uf[k]; bui += bbi[k] * uf[k]; }
            const float nsr = abr * sr - abi * si + bur, nsi = abr * si + abi * sr + bui; sr = nsr; si = nsi;
            float v[16];
#pragma unroll
            for (int k = 0; k < 16; ++k) v[k] = cr[k] * sr - ci[k] * si;
            { const bool hi = lane & 32;
#pragma unroll
              for (int k = 0; k < 8; ++k) { const float keep = hi ? v[k + 8] : v[k], send = hi ? v[k] : v[k + 8]; v[k] = keep + __shfl_xor(send, 32); } }
            { const bool hi = lane & 16;
#pragma unroll
              for (int k = 0; k < 4; ++k) { const float keep = hi ? v[k + 4] : v[k], send = hi ? v[k] : v[k + 4]; v[k] = keep + __shfl_xor(send, 16); } }
            { const bool hi = lane & 8;
#pragma unroll
              for (int k = 0; k < 2; ++k) { const float keep = hi ? v[k + 2] : v[k], send = hi ? v[k] : v[k + 2]; v[k] = keep + __shfl_xor(send, 8); } }
            { const bool hi = lane & 4; const float keep = hi ? v[1] : v[0], send = hi ? v[0] : v[1]; v[0] = keep + __shfl_xor(send, 4); }
            v[0] += __shfl_xor(v[0], 2); v[0] += __shfl_xor(v[0], 1);
            if ((lane & 3) == 0) YO[(mb + tl) * S5_W + g * 16 + (lane >> 2)] = (bf16)f2bf(v[0]);
        }
        LDS_WAIT(); asm volatile("" ::: "memory");
    }
}

__device__ __forceinline__ float gelu_tanh(float x) { const float u = 0.7978845608028654f * (x + 0.044715f * x * x * x); const float e = __expf(2.f * u); const float th = 1.f - 2.f * __builtin_amdgcn_rcpf(e + 1.f); return 0.5f * x * (1.f + th); }
__device__ __forceinline__ void p4_combine(Frame& F) {
    const int gw = F.bid * NWAVES + F.wave, NGW = F.G * NWAVES, lane = F.lane;
    bf16* YF = WSP(bf16, A_YF); const bf16* YB = WSP(bf16, A_YB); const bf16* XS = WSP(bf16, A_XS); const bf16* Z = WSP(bf16, A_Z);
    const float* dsk = F.in[8]; const float* ng = F.in[9];
    for (int m = gw; m < M; m += NGW) {
#pragma unroll 1
        for (int gi = 0; gi < SSD_G; ++gi) {
            const int ch = gi * 384 + lane * 8; float y[8]; float ss = 0.f;
            if (lane < 48) {
                const size_t o = (size_t)m * SSD_IN + ch; float a[8], bb[8], x[8], z[8];
                unpack8(*(const v4u*)(YF + o), a); unpack8(*(const v4u*)(YB + o), bb); unpack8(*(const v4u*)(XS + o), x); unpack8(*(const v4u*)(Z + o), z);
                const float dk = dsk[ch >> 6];
#pragma unroll
                for (int j = 0; j < 8; ++j) { y[j] = (a[j] + bb[j] + x[j] * dk) * z[j]; ss += y[j] * y[j]; }
            }
            ss = wave_sum(ss);
            const float r = 1.0f / sqrtf(ss * (1.0f / 384.0f) + RMS_EPS);
            if (lane < 48) {
                const f32x4 g0 = *(const f32x4*)(ng + ch), g1 = *(const f32x4*)(ng + ch + 4);
                v4u o; o.x = pk2(y[0] * r * g0.x, y[1] * r * g0.y); o.y = pk2(y[2] * r * g0.z, y[3] * r * g0.w); o.z = pk2(y[4] * r * g1.x, y[5] * r * g1.y); o.w = pk2(y[6] * r * g1.z, y[7] * r * g1.w);
                *(v4u*)(YF + (size_t)m * SSD_IN + ch) = o;
            }
        }
    }
    bf16* Y5F = WSP(bf16, A_Y5F); const bf16* Y5B = WSP(bf16, A_Y5B); const bf16* U = WSP(bf16, A_U); const float* d5 = F.in[21];
    constexpr int N8 = M * S5_W / 8;
    for (int i = F.bid * NTHR + F.tid; i < N8; i += F.G * NTHR) {
        const int ch = (i % (S5_W / 8)) * 8; float a[8], bb[8], u[8];
        unpack8(*(const v4u*)(Y5F + (size_t)i * 8), a); unpack8(*(const v4u*)(Y5B + (size_t)i * 8), bb); unpack8(*(const v4u*)(U + (size_t)i * 8), u);
        const f32x4 d0 = *(const f32x4*)(d5 + ch), d1 = *(const f32x4*)(d5 + ch + 4); const float dd[8] = {d0.x, d0.y, d0.z, d0.w, d1.x, d1.y, d1.z, d1.w};
        float y[8];
#pragma unroll
        for (int j = 0; j < 8; ++j) y[j] = gelu_tanh(a[j] + bb[j] + u[j] * dd[j]);
        v4u o; o.x = pk2(y[0], y[1]); o.y = pk2(y[2], y[3]); o.z = pk2(y[4], y[5]); o.w = pk2(y[6], y[7]);
        *(v4u*)(Y5F + (size_t)i * 8) = o;
    }
}

__device__ __forceinline__ void p8_ln_router(Frame& F) {
    const int gw = F.bid * NWAVES + F.wave, NGW = F.G * NWAVES, lane = F.lane;
    LAS float* wr = (LAS float*)F.lds;
    for (int i = F.tid; i < D * NE; i += NTHR) wr[(i & 15) * D + (i >> 4)] = F.in[27][i];
    __syncthreads();
    const float* HP = WSP(float, A_HP); float* H = WSP(float, A_H); bf16* HB = WSP(bf16, A_HB); float* AFF = WSP(float, A_AFF);
    const float* g1 = F.in[25]; const float* b1 = F.in[26];
    for (int m = gw; m < M; m += NGW) {
        const f32x4* xr = (const f32x4*)(HP + (size_t)m * D) + lane;
        f32x4 v[4]; float s = 0.f;
#pragma unroll
        for (int j = 0; j < 4; ++j) { v[j] = xr[64 * j]; s += (v[j].x + v[j].y) + (v[j].z + v[j].w); }
        const float mean = wave_sum(s) * (1.f / D); float s2 = 0.f;
#pragma unroll
        for (int j = 0; j < 4; ++j) { v[j] = v[j] - mean; s2 += (v[j].x * v[j].x + v[j].y * v[j].y) + (v[j].z * v[j].z + v[j].w * v[j].w); }
        const float rstd = 1.f / sqrtf(wave_sum(s2) * (1.f / D) + LN_EPS);
        float lg[16];
#pragma unroll
        for (int e = 0; e < 16; ++e) lg[e] = 0.f;
#pragma unroll
        for (int j = 0; j < 4; ++j) { const int c = 4 * lane + 256 * j; const f32x4 gg = *(const f32x4*)(g1 + c), bb = *(const f32x4*)(b1 + c);
            v[j] = v[j] * rstd * gg + bb;
            *((f32x4*)(H + (size_t)m * D) + lane + 64 * j) = v[j];
            v2u hb; hb.x = pk2(v[j].x, v[j].y); hb.y = pk2(v[j].z, v[j].w); *((v2u*)(HB + (size_t)m * D) + lane + 64 * j) = hb;
#pragma unroll
            for (int e = 0; e < 16; ++e) { const f32x4 w4 = *(const LAS f32x4*)(wr + e * D + c); lg[e] += (v[j].x * w4.x + v[j].y * w4.y) + (v[j].z * w4.z + v[j].w * w4.w); }
            asm volatile("" ::: "memory"); }
        { const bool hi = lane & 32;
#pragma unroll
          for (int k = 0; k < 8; ++k) { const float keep = hi ? lg[k + 8] : lg[k], send = hi ? lg[k] : lg[k + 8]; lg[k] = keep + __shfl_xor(send, 32); } }
        { const bool hi = lane & 16;
#pragma unroll
          for (int k = 0; k < 4; ++k) { const float keep = hi ? lg[k + 4] : lg[k], send = hi ? lg[k] : lg[k + 4]; lg[k] = keep + __shfl_xor(send, 16); } }
        { const bool hi = lane & 8;
#pragma unroll
          for (int k = 0; k < 2; ++k) { const float keep = hi ? lg[k + 2] : lg[k], send = hi ? lg[k] : lg[k + 2]; lg[k] = keep + __shfl_xor(send, 8); } }
        { const bool hi = lane & 4; const float keep = hi ? lg[1] : lg[0], send = hi ? lg[0] : lg[1]; lg[0] = keep + __shfl_xor(send, 4); }
        float lo = lg[0]; lo += __shfl_xor(lo, 2); lo += __shfl_xor(lo, 1);
        float mx = lo;
#pragma unroll
        for (int o = 4; o < 64; o <<= 1) mx = fmaxf(mx, __shfl_xor(mx, o));
        const float ex = expf(lo - mx); float sum = ex;
#pragma unroll
        for (int o = 4; o < 64; o <<= 1) sum += __shfl_xor(sum, o);
        if ((lane & 3) == 0) { const int e = lane >> 2, b = m / T, t = m % T; AFF[((size_t)b * NE + e) * T + t] = ex / sum; }
    }
}

__device__ __forceinline__ unsigned block_excl_scan(unsigned v, LAS unsigned* wsum  , int lane, int wave, unsigned& total) {
    unsigned inc = v;
#pragma unroll
    for (int o = 1; o < 64; o <<= 1) { const unsigned t = __shfl_up(inc, o); if (lane >= o) inc += t; }
    __syncthreads();
    if (lane == 63) wsum[wave] = inc;
    __syncthreads();
    unsigned off = 0, tot = 0;
#pragma unroll
    for (int w = 0; w < 8; ++w) { const unsigned s = wsum[w]; if (w < wave) off += s; tot += s; }
    total = tot; return off + inc - v;
}
__device__ __forceinline__ void p9_topk(Frame& F, int be) {
    const int b = be >> 4, e = be & 15, tid = F.tid;
    const float* av = WSP(float, A_AFF) + (size_t)be * T;
    int* IDX = WSP(int, A_IDX); int* SEL = WSP(int, A_SEL); float* GATE = WSP(float, A_GATE);
    LAS unsigned* hist = (LAS unsigned*)F.lds; LAS unsigned* shv = hist + 256; LAS unsigned* wsum = hist + 272;
    unsigned key[16];
#pragma unroll
    for (int q = 0; q < 4; ++q) { const v4u k4 = *(const v4u*)(av + tid * 16 + 4 * q); key[4 * q] = k4.x; key[4 * q + 1] = k4.y; key[4 * q + 2] = k4.z; key[4 * q + 3] = k4.w; }
    unsigned prefix = 0, pmask = 0, krem = CAP;
    for (int pass = 0; pass < 4; ++pass) {
        const int shift = 24 - 8 * pass;
        if (tid < 256) hist[tid] = 0u;
        __syncthreads();
#pragma unroll
        for (int i = 0; i < 16; ++i) if ((key[i] & pmask) == prefix) (void)__hip_atomic_fetch_add(&hist[(key[i] >> shift) & 255u], 1u, __ATOMIC_RELAXED, __HIP_MEMORY_SCOPE_WORKGROUP);
        __syncthreads();
        if (tid < 256) { unsigned above = 0; for (int d = tid + 1; d < 256; ++d) above += hist[d]; const unsigned mine = hist[tid];
            if (above < krem && krem <= above + mine) { shv[0] = (unsigned)tid; shv[1] = krem - above; } }
        __syncthreads();
        prefix |= shv[0] << shift; pmask |= 255u << shift; krem = shv[1];
        __syncthreads();
    }
    const unsigned Tk = prefix;
    unsigned cg = 0, ce = 0;
#pragma unroll
    for (int i = 0; i < 16; ++i) { cg += key[i] > Tk; ce += key[i] == Tk; }
    unsigned totg, tote;
    unsigned pg = block_excl_scan(cg, wsum, F.lane, F.wave, totg);
    unsigned pe = block_excl_scan(ce, wsum + 8, F.lane, F.wave, tote);
#pragma unroll
    for (int i = 0; i < 16; ++i) {
        const int t = tid * 16 + i; int slot = -1;
        if (key[i] > Tk) slot = (int)(pg++);
        else if (key[i] == Tk) { if (pe < krem) slot = (int)(totg + pe); ++pe; }
        const size_t m = (size_t)b * T + t;
        SEL[m * NE + e] = slot; GATE[m * NE + e] = __uint_as_float(key[i]);
        if (slot >= 0) IDX[(e * NB + b) * CAP + slot] = (int)m;
    }
}
__device__ __forceinline__ void p10_gather(Frame& F) {
    const int gw = F.bid * NWAVES + F.wave, NGW = F.G * NWAVES, lane = F.lane;
    const int* IDX = WSP(int, A_IDX); const bf16* HB = WSP(bf16, A_HB); bf16* XIN = WSP(bf16, A_XIN);
    for (int r = gw; r < MROWS; r += NGW) { const int m = IDX[r];
        const v4u* s = (const v4u*)(HB + (size_t)m * D); v4u* d = (v4u*)(XIN + (size_t)r * D);
        const v4u a = s[lane], bq = s[lane + 64]; d[lane] = a; d[lane + 64] = bq; }
}
__device__ __forceinline__ void p13_final(Frame& F) {
    const int gw = F.bid * NWAVES + F.wave, NGW = F.G * NWAVES, lane = F.lane;
    const float* H = WSP(float, A_H); const int* SEL = WSP(int, A_SEL); const float* GATE = WSP(float, A_GATE); const bf16* YE = WSP(bf16, A_YE);
    const float* g2 = F.in[31]; const float* b2 = F.in[32];
    for (int m = gw; m < M; m += NGW) {
        const int b = m / T;
        const int sl = SEL[(size_t)m * NE + (lane & 15)]; const float gt = GATE[(size_t)m * NE + (lane & 15)];
        f32x4 v[4];
#pragma unroll
        for (int j = 0; j < 4; ++j) v[j] = *((const f32x4*)(H + (size_t)m * D) + lane + 64 * j) * ALPHA;
#pragma unroll 1
        for (int e = 0; e < NE; ++e) {
            const int s = __shfl(sl, e); const float gv = __shfl(gt, e);
            if (s >= 0) { const bf16* yr = YE + ((size_t)(e * NB + b) * CAP + s) * D;
#pragma unroll
                for (int j = 0; j < 4; ++j) { const v2u w = *((const v2u*)yr + lane + 64 * j); v[j].x += gv * bflo(w.x); v[j].y += gv * bfhi(w.x); v[j].z += gv * bflo(w.y); v[j].w += gv * bfhi(w.y); } }
        }
        float s = 0.f;
#pragma unroll
        for (int j = 0; j < 4; ++j) s += (v[j].x + v[j].y) + (v[j].z + v[j].w);
        const float mean = wave_sum(s) * (1.f / D); float s2 = 0.f;
#pragma unroll
        for (int j = 0; j < 4; ++j) { v[j] = v[j] - mean; s2 += (v[j].x * v[j].x + v[j].y * v[j].y) + (v[j].z * v[j].z + v[j].w * v[j].w); }
        const float rstd = 1.f / sqrtf(wave_sum(s2) * (1.f / D) + LN_EPS);
#pragma unroll
        for (int j = 0; j < 4; ++j) { const int c = 4 * lane + 256 * j; const f32x4 gg = *(const f32x4*)(g2 + c), bb = *(const f32x4*)(b2 + c);
            *((f32x4*)(F.out + (size_t)m * D) + lane + 64 * j) = v[j] * rstd * gg + bb; }
    }
}

constexpr int N_PHASES = 14;
struct Args { const float* in[33]; float* out; unsigned char* ws; int ph_lo, ph_hi; };
__global__ void __launch_bounds__(NTHR, 2) fwd(Args args) {
    extern __shared__ __attribute__((aligned(16))) unsigned char lds[];
    Frame F;
    F.lds = (LAS unsigned char*)lds;
    F.tid = threadIdx.x; F.lane = F.tid & 63; F.wave = __builtin_amdgcn_readfirstlane(F.tid >> 6);
    F.bid = blockIdx.x; F.G = gridDim.x;
    F.in = args.in;
    F.out = args.out; F.ws = args.ws;
    volatile LAS unsigned* MISC = (volatile LAS unsigned*)(F.lds + MISC_OFF);
    if (F.tid < 64) MISC[F.tid] = 0u;
    __syncthreads();
    const int lo = args.ph_lo, hi = args.ph_hi;
    const bool single = (hi - lo) > 1;
    XcdBarrier bar; bar.bar = (unsigned*)(F.ws + WS_CTL) + CW_BAR; bar.x = 0; bar.st = nullptr;
    if (single) bar = xcd_barrier_post((unsigned*)(F.ws + WS_CTL) + CW_BAR, MISC + 8);
#ifndef PH_MASK
#define PH_MASK 0x3fff
#endif
#define IN(k) (((PH_MASK >> (k)) & 1) && lo <= (k) && (k) < hi)
#define SEAM(k) do { if (IN(k) && IN((k) + 1)) xcd_barrier(bar); } while (0)

    if (IN(0)) { p0_prologue(F); } SEAM(0);
    if (IN(1)) {
        pg8::Gemm g{WSP(pg8::bf16_t, A_XB), WSP(pg8::bf16_t, WS_WIN), M, NIN_PAD, D}; pg8::StaticOrder S; S.init(M, NIN_PAD, F.G, F.bid);
        pg8::EpiIn E{WSP(pg8::bf16_t, A_Z), WSP(pg8::bf16_t, A_XBC), WSP(pg8::bf16_t, A_U), WSP(pg8::bf16_t, A_GT), WSP(float, A_DT), F.in[6], F.in[7]};
        pg8::gemm_phase<pg8::EpiIn, pg8::StaticOrder, PG8_ALIGN, PG8_SP2>(F.lds, g, S, E);
    } SEAM(1);
    if (IN(2)) { p2_conv(F); } SEAM(2);
    if (IN(3)) {
        if (F.bid < 96) ssd_naive(F, F.bid);
        else if (F.bid < 120) s5_naive(F, (F.bid - 96) * 8 + F.wave);
    } SEAM(3);
    if (IN(4)) { p4_combine(F); } SEAM(4);
    if (IN(5)) {
        pg8::Gemm g{WSP(pg8::bf16_t, A_YF), WSP(pg8::bf16_t, WS_WOUT), M, D, SSD_IN}; pg8::StaticOrder S; S.init(M, D, F.G, F.bid);
        pg8::EpiSsdOut E{WSP(float, A_YA), WSP(pg8::bf16_t, A_GT)};
        pg8::gemm_phase<pg8::EpiSsdOut, pg8::StaticOrder, PG8_ALIGN, PG8_SP2>(F.lds, g, S, E);
    } SEAM(5);
    if (IN(6)) {
        pg8::Gemm g{WSP(pg8::bf16_t, A_Y5F), WSP(pg8::bf16_t, WS_WGLU), M, 2 * D, S5_W}; pg8::StaticOrder S; S.init(M, 2 * D, F.G, F.bid);
        pg8::EpiGlu E{WSP(pg8::bf16_t, A_MIX), WSP(float, A_YA), WSP(pg8::bf16_t, A_GT)};
        pg8::gemm_phase<pg8::EpiGlu, pg8::StaticOrder, PG8_ALIGN, PG8_SP2>(F.lds, g, S, E);
    } SEAM(6);
    if (IN(7)) {
        pg8::Gemm g{WSP(pg8::bf16_t, A_MIX), WSP(pg8::bf16_t, WS_WO), M, D, D}; pg8::StaticOrder S; S.init(M, D, F.G, F.bid);
        pg8::EpiWo E{WSP(float, A_HP), F.in[0], ALPHA};
        pg8::gemm_phase<pg8::EpiWo, pg8::StaticOrder, PG8_ALIGN, PG8_SP2>(F.lds, g, S, E);
    } SEAM(7);
    if (IN(8)) { p8_ln_router(F); } SEAM(8);
    if (IN(9)) { if (F.bid < NB * NE) p9_topk(F, F.bid); } SEAM(9);
    if (IN(10)) { p10_gather(F); } SEAM(10);
    if (IN(11)) {
        pg8::Gemm g{WSP(pg8::bf16_t, A_XIN), WSP(pg8::bf16_t, WS_W1), MROWS, NE * 2 * FF, D}; pg8::MoeOrder1 S{F.G, F.bid};
        pg8::EpiMoe1 E{WSP(pg8::bf16_t, A_HID)};
        pg8::gemm_phase<pg8::EpiMoe1, pg8::MoeOrder1, PG8_ALIGN, PG8_SP2>(F.lds, g, S, E);
    } SEAM(11);
    if (IN(12)) {
        pg8::Gemm g{WSP(pg8::bf16_t, A_HID), WSP(pg8::bf16_t, WS_W2), MROWS, NE * D, FF}; pg8::MoeOrder2 S{F.G, F.bid};
        pg8::EpiMoe2 E{WSP(pg8::bf16_t, A_YE)};
        pg8::gemm_phase<pg8::EpiMoe2, pg8::MoeOrder2, PG8_ALIGN, PG8_SP2>(F.lds, g, S, E);
    } SEAM(12);
    if (IN(13)) { p13_final(F); }
#undef IN
#undef SEAM
}

#ifndef MK_ONE_LAUNCH
#define MK_ONE_LAUNCH 1
#endif
extern "C" void kernel_launch(void* const* d_in, const int* in_sizes, int n_in, void* d_out, int out_size, void* d_ws, size_t ws_size, hipStream_t stream) {
    static int grid = 0;
    if (grid == 0) {
        if (n_in != 33 || in_sizes[0] != M * D || out_size != M * D || ws_size < WS_END) { fprintf(stderr, "kernel_launch: unexpected problem (n_in %d, in0 %d, out %d, ws %zu < %zu)\n", n_in, n_in > 0 ? in_sizes[0] : -1, out_size, ws_size, (size_t)WS_END); grid = -1; return; }
        int dev = 0, cus = 0, per_cu = 0;
        if (hipGetDevice(&dev) != hipSuccess || hipDeviceGetAttribute(&cus, hipDeviceAttributeMultiprocessorCount, dev) != hipSuccess) { grid = -1; return; }
        if (hipFuncSetAttribute((const void*)fwd, hipFuncAttributeMaxDynamicSharedMemorySize, LDS_BYTES) != hipSuccess) { fprintf(stderr, "kernel_launch: hipFuncSetAttribute failed\n"); grid = -1; return; }
        if (hipOccupancyMaxActiveBlocksPerMultiprocessor(&per_cu, (const void*)fwd, NTHR, LDS_BYTES) != hipSuccess || per_cu < 1) fprintf(stderr, "kernel_launch: occupancy query reports %d blocks per CU\n", per_cu);
        (void)hipGetLastError();
        grid = cus;
    }
    if (grid < 0) return;
    (void)hipMemsetAsync((char*)d_ws + WS_CTL, 0, CTL_ZERO_BYTES, stream);
    Args a{};
    for (int i = 0; i < 33; ++i) a.in[i] = (const float*)d_in[i];
    a.out = (float*)d_out; a.ws = (unsigned char*)d_ws;
#if MK_ONE_LAUNCH
    a.ph_lo = 0; a.ph_hi = N_PHASES;
    hipLaunchKernelGGL(fwd, dim3(grid), dim3(NTHR), LDS_BYTES, stream, a);
#else
    for (int p = 0; p < N_PHASES; ++p) { a.ph_lo = p; a.ph_hi = p + 1; hipLaunchKernelGGL(fwd, dim3(grid), dim3(NTHR), LDS_BYTES, stream, a); }
#endif
}
```

```cpp
#include <hip/hip_runtime.h>
#include <cstdio>
#include <cstdint>
namespace pg8 {
#define PG8_LAS __attribute__((address_space(3)))
typedef unsigned short bf16_t;
typedef short bf16x8 __attribute__((ext_vector_type(8)));
typedef float f32x4 __attribute__((ext_vector_type(4)));
typedef unsigned u32x4 __attribute__((ext_vector_type(4)));
constexpr int BM = 256, BK = 64, HALF = 128, HTB = HALF * BK * 2  , STAGE_BYTES = 8 * HTB, NXCD = 8, WGM = 8;

__host__ __device__ __forceinline__ int lds_byte(int r, int c) { const int st = (r >> 4) * 2 + (c >> 5), rr = r & 15, cc = c & 31, ob = rr * 64 + cc * 2; return st * 1024 + (ob ^ (((ob >> 9) & 1) << 5)); }
__host__ __device__ __forceinline__ void stage_rc(int b, int& R, int& C) { const int st = b / 1024, sb = b % 1024, swz = sb ^ (((sb >> 9) & 1) << 5); R = (st >> 1) * 16 + swz / 64; C = (st & 1) * 32 + (swz % 64) / 2; }
__host__ __device__ __forceinline__ int perm32(int rho) { const int n = rho >> 4, i = rho & 15; return 8 * (i >> 2) + 4 * n + (i & 3); }

struct Unit { int pm, pn; };
struct Gemm { const bf16_t* A; const bf16_t* Bt; int M, N, K, lda, ldb; };

struct StaticOrder {
    int nM, nN, nwg, G, c;
    __host__ __device__ void init(int M, int N, int G_, int c_) { nM = M / BM; nN = N / BM; nwg = nM * nN; G = G_; c = c_; }
    __host__ __device__ bool next(int i, Unit& u) const {
        const long L = (long)i * G + c; if (L >= nwg) return false;
        int wgid = (int)L; { const int q = nwg / NXCD, r = nwg % NXCD, xcd = wgid % NXCD, off = wgid / NXCD; wgid = (xcd < r ? xcd * (q + 1) : r * (q + 1) + (xcd - r) * q) + off; }
        const int nig = WGM * nN, gid = wgid / nig, fm = gid * WGM, gsz = (nM - fm) < WGM ? (nM - fm) : WGM;
        u.pm = fm + ((wgid % nig) % gsz); u.pn = (wgid % nig) / gsz; return true;
    }
    __device__ __forceinline__ void a_ready(const Unit&) const {}
    __device__ __forceinline__ void done(const Unit&) const {}
};

__device__ __forceinline__ unsigned cvt_pk_bf16(float lo, float hi) { unsigned r; asm volatile("v_cvt_pk_bf16_f32 %0, %1, %2" : "=v"(r) : "v"(lo), "v"(hi)); return r; }
typedef float f32x2 __attribute__((ext_vector_type(2)));
__device__ __forceinline__ f32x2 gelu_pk(f32x2 v) {
    const f32x2 av = __builtin_elementwise_abs(v), d = av * 0.2316418882f + 1.0f;
    f32x2 t; t.x = __builtin_amdgcn_rcpf(d.x); t.y = __builtin_amdgcn_rcpf(d.y);
    f32x2 q = t * 0.5307027145f + (-0.7265760135f); q = q * t + 0.7107068705f; q = q * t + (-0.142248368f); q = q * t + 0.127414796f; q = q * t;
    const f32x2 s = (v * v) * (-0.72134752044f);
    f32x2 e; e.x = __builtin_amdgcn_exp2f(s.x); e.y = __builtin_amdgcn_exp2f(s.y);
    const f32x2 m = v * (q * e), r = v - m;
    f32x2 o; o.x = v.x < 0.f ? m.x : r.x; o.y = v.y < 0.f ? m.y : r.y; return o;
}


__device__ __forceinline__ float fsigmoid(float x) { return __builtin_amdgcn_rcpf(1.0f + __expf(-x)); }
__device__ __forceinline__ float fsilu(float x) { return x * fsigmoid(x); }
__device__ __forceinline__ float bf_lo(unsigned w) { return __uint_as_float(w << 16); }
__device__ __forceinline__ float bf_hi(unsigned w) { return __uint_as_float(w & 0xffff0000u); }
typedef unsigned u32x2 __attribute__((ext_vector_type(2)));

struct EpiIn {
    static constexpr bool PERM = true, AFTER_DRAIN = false;
    bf16_t *Z, *XBC, *UC, *GT; float* DT; const float *dtb_f, *dtb_b;
    __device__ __forceinline__ void operator()(const f32x4 (&acc)[2][2][4][2], const Unit& u, int wr, int wc, int fr, int fq) const {
        const int row0 = u.pm * BM + wr * 64 + fr; const int pn = u.pn;
        if (pn == 16) {
            if (wc < 2) {
#pragma unroll
                for (int n = 0; n < 2; ++n) { const int col = wc * 32 + 8 * fq + 4 * n;
                    if (col < 48) { f32x4 bv;
#pragma unroll
                        for (int j = 0; j < 4; ++j) { const int cc = col + j; bv[j] = cc < 24 ? dtb_f[cc] : dtb_b[cc - 24]; }
#pragma unroll
                        for (int ai = 0; ai < 2; ++ai)
#pragma unroll
                            for (int m = 0; m < 4; ++m) { f32x4 v = acc[ai][0][m][n] + bv;
#pragma unroll
                                for (int j = 0; j < 4; ++j) { const float x = v[j]; v[j] = fmaxf(x, 0.f) + log1pf(__expf(-fabsf(x))); }
                                *(f32x4*)(DT + (size_t)(row0 + ai * HALF + m * 16) * 48 + col) = v; } } }
            }
            return;
        }
        int mode, ldc, colt; bf16_t* base;
        if (pn < 6) { mode = 1; base = Z; ldc = 1536; colt = pn * BM; }
        else if (pn < 16) { mode = 0; base = XBC; ldc = 2560; colt = (pn - 6) * BM; }
        else if (pn < 20) {
            const int uc = (pn - 17) * BM + wc * 32 + 8 * fq, g0 = uc >> 4, j0 = uc & 15;
#pragma unroll
            for (int ai = 0; ai < 2; ++ai)
#pragma unroll
                for (int m = 0; m < 4; ++m) { const int r = row0 + ai * HALF + m * 16, cl = r >> 5, s = r & 31;
#pragma unroll
                    for (int bj = 0; bj < 2; ++bj) { const f32x4 v0 = acc[ai][bj][m][0], v1 = acc[ai][bj][m][1];
                        u32x4 w; w.x = cvt_pk_bf16(v0[0], v0[1]); w.y = cvt_pk_bf16(v0[2], v0[3]); w.z = cvt_pk_bf16(v1[0], v1[1]); w.w = cvt_pk_bf16(v1[2], v1[3]);
                        *(u32x4*)(UC + ((size_t)((g0 + 8 * bj) * 512 + cl) * 768 + s * 16 + j0)) = w; } }
            return; }
        else { mode = 2; base = GT; ldc = 2048; colt = (pn - 20) * BM; }
        const int col0 = colt + wc * 32 + 8 * fq;
#pragma unroll
        for (int ai = 0; ai < 2; ++ai)
#pragma unroll
            for (int m = 0; m < 4; ++m) { bf16_t* rowp = base + (size_t)(row0 + ai * HALF + m * 16) * ldc + col0;
#pragma unroll
                for (int bj = 0; bj < 2; ++bj) { f32x4 v0 = acc[ai][bj][m][0], v1 = acc[ai][bj][m][1];
                    if (mode == 1) {
#pragma unroll
                        for (int j = 0; j < 4; ++j) { v0[j] = fsilu(v0[j]); v1[j] = fsilu(v1[j]); } }
                    else if (mode == 2) {
#pragma unroll
                        for (int j = 0; j < 4; ++j) { v0[j] = fsigmoid(v0[j]); v1[j] = fsigmoid(v1[j]); } }
                    u32x4 w; w.x = cvt_pk_bf16(v0[0], v0[1]); w.y = cvt_pk_bf16(v0[2], v0[3]); w.z = cvt_pk_bf16(v1[0], v1[1]); w.w = cvt_pk_bf16(v1[2], v1[3]);
                    *(u32x4*)(rowp + bj * HALF) = w; } }
    }
};
struct EpiSsdOut {
    static constexpr bool PERM = false, AFTER_DRAIN = false;
    float* YA; const bf16_t* GT;
    __device__ __forceinline__ void operator()(const f32x4 (&acc)[2][2][4][2], const Unit& u, int wr, int wc, int fr, int fq) const {
        const int row0 = u.pm * BM + wr * 64 + fr, col0 = u.pn * BM + wc * 32 + 4 * fq;
#pragma unroll
        for (int ai = 0; ai < 2; ++ai)
#pragma unroll
            for (int m = 0; m < 4; ++m) { const size_t r = (size_t)(row0 + ai * HALF + m * 16);
#pragma unroll
                for (int bj = 0; bj < 2; ++bj)
#pragma unroll
                    for (int n = 0; n < 2; ++n) { const int c = col0 + bj * HALF + n * 16; const u32x2 g = *(const u32x2*)(GT + r * 2048 + c);
                        f32x4 v = acc[ai][bj][m][n]; v[0] *= bf_lo(g.x); v[1] *= bf_hi(g.x); v[2] *= bf_lo(g.y); v[3] *= bf_hi(g.y);
                        *(f32x4*)(YA + r * 1024 + c) = v; } }
    }
};
struct EpiGlu {
    static constexpr bool PERM = true, AFTER_DRAIN = false;
    bf16_t* MIX; const float* YA; const bf16_t* GT;
    __device__ __forceinline__ void operator()(const f32x4 (&acc)[2][2][4][2], const Unit& u, int wr, int wc, int fr, int fq) const {
        const int row0 = u.pm * BM + wr * 64 + fr, col0 = u.pn * HALF + wc * 32 + 8 * fq;
#pragma unroll
        for (int ai = 0; ai < 2; ++ai)
#pragma unroll
            for (int m = 0; m < 4; ++m) { const size_t r = (size_t)(row0 + ai * HALF + m * 16);
                const u32x4 g = *(const u32x4*)(GT + r * 2048 + 1024 + col0); const f32x4 y0 = *(const f32x4*)(YA + r * 1024 + col0), y1 = *(const f32x4*)(YA + r * 1024 + col0 + 4);
                f32x4 a0 = acc[ai][0][m][0], a1 = acc[ai][0][m][1]; const f32x4 b0 = acc[ai][1][m][0], b1 = acc[ai][1][m][1];
#pragma unroll
                for (int j = 0; j < 4; ++j) { a0[j] *= fsigmoid(b0[j]); a1[j] *= fsigmoid(b1[j]); }
                a0[0] = a0[0] * bf_lo(g.x) + y0[0]; a0[1] = a0[1] * bf_hi(g.x) + y0[1]; a0[2] = a0[2] * bf_lo(g.y) + y0[2]; a0[3] = a0[3] * bf_hi(g.y) + y0[3];
                a1[0] = a1[0] * bf_lo(g.z) + y1[0]; a1[1] = a1[1] * bf_hi(g.z) + y1[1]; a1[2] = a1[2] * bf_lo(g.w) + y1[2]; a1[3] = a1[3] * bf_hi(g.w) + y1[3];
                u32x4 w; w.x = cvt_pk_bf16(a0[0], a0[1]); w.y = cvt_pk_bf16(a0[2], a0[3]); w.z = cvt_pk_bf16(a1[0], a1[1]); w.w = cvt_pk_bf16(a1[2], a1[3]);
                *(u32x4*)(MIX + r * 1024 + col0) = w; }
    }
};
struct EpiWo {
    static constexpr bool PERM = false, AFTER_DRAIN = false;
    float* HP; const float* X; float alpha;
    __device__ __forceinline__ void operator()(const f32x4 (&acc)[2][2][4][2], const Unit& u, int wr, int wc, int fr, int fq) const {
        const int row0 = u.pm * BM + wr * 64 + fr, col0 = u.pn * BM + wc * 32 + 4 * fq;
#pragma unroll
        for (int ai = 0; ai < 2; ++ai)
#pragma unroll
            for (int m = 0; m < 4; ++m) { const size_t r = (size_t)(row0 + ai * HALF + m * 16);
#pragma unroll
                for (int bj = 0; bj < 2; ++bj)
#pragma unroll
                    for (int n = 0; n < 2; ++n) { const int c = col0 + bj * HALF + n * 16; const f32x4 xv = *(const f32x4*)(X + r * 1024 + c);
                        *(f32x4*)(HP + r * 1024 + c) = acc[ai][bj][m][n] + xv * alpha; } }
    }
};
struct EpiMoe1 {
    static constexpr bool PERM = true, AFTER_DRAIN = false;
    bf16_t* HID;
    __device__ __forceinline__ void operator()(const f32x4 (&acc)[2][2][4][2], const Unit& u, int wr, int wc, int fr, int fq) const {
        const int row0 = u.pm * BM + wr * 64 + fr, col0 = (u.pn % 22) * HALF + wc * 32 + 8 * fq;
#pragma unroll
        for (int ai = 0; ai < 2; ++ai)
#pragma unroll
            for (int m = 0; m < 4; ++m) { const size_t r = (size_t)(row0 + ai * HALF + m * 16);
                f32x4 a0 = acc[ai][0][m][0], a1 = acc[ai][0][m][1]; const f32x4 b0 = acc[ai][1][m][0], b1 = acc[ai][1][m][1];
#pragma unroll
                for (int j = 0; j < 4; ++j) { a0[j] = fsilu(a0[j]) * b0[j]; a1[j] = fsilu(a1[j]) * b1[j]; }
                u32x4 w; w.x = cvt_pk_bf16(a0[0], a0[1]); w.y = cvt_pk_bf16(a0[2], a0[3]); w.z = cvt_pk_bf16(a1[0], a1[1]); w.w = cvt_pk_bf16(a1[2], a1[3]);
                *(u32x4*)(HID + r * 2816 + col0) = w; }
    }
};
struct EpiMoe2 {
    static constexpr bool PERM = true, AFTER_DRAIN = false;
    bf16_t* Y;
    __device__ __forceinline__ void operator()(const f32x4 (&acc)[2][2][4][2], const Unit& u, int wr, int wc, int fr, int fq) const {
        const int row0 = u.pm * BM + wr * 64 + fr, col0 = (u.pn & 3) * BM + wc * 32 + 8 * fq;
#pragma unroll
        for (int ai = 0; ai < 2; ++ai)
#pragma unroll
            for (int m = 0; m < 4; ++m) { bf16_t* rowp = Y + (size_t)(row0 + ai * HALF + m * 16) * 1024 + col0;
#pragma unroll
                for (int bj = 0; bj < 2; ++bj) { const f32x4 v0 = acc[ai][bj][m][0], v1 = acc[ai][bj][m][1];
                    u32x4 w; w.x = cvt_pk_bf16(v0[0], v0[1]); w.y = cvt_pk_bf16(v0[2], v0[3]); w.z = cvt_pk_bf16(v1[0], v1[1]); w.w = cvt_pk_bf16(v1[2], v1[3]);
                    *(u32x4*)(rowp + bj * HALF) = w; } }
    }
};

struct EpiS5a {
    static constexpr bool PERM = false, AFTER_DRAIN = false;
    float* SLOC;
    __device__ __forceinline__ void operator()(const f32x4 (&acc)[2][2][4][2], const Unit& u, int wr, int wc, int fr, int fq) const {
        const int row0 = u.pm * BM + wr * 64 + fr, col0 = wc * 32 + 4 * fq;
#pragma unroll
        for (int ai = 0; ai < 2; ++ai)
#pragma unroll
            for (int m = 0; m < 4; ++m) { float* rowp = SLOC + (size_t)(row0 + ai * HALF + m * 16) * 256 + col0;
#pragma unroll
                for (int bj = 0; bj < 2; ++bj)
#pragma unroll
                    for (int n = 0; n < 2; ++n) *(f32x4*)(rowp + bj * HALF + n * 16) = acc[ai][bj][m][n]; }
    }
};
__device__ __forceinline__ float gelu_tanh_f(float x) { const float uu = 0.7978845608028654f * (x + 0.044715f * x * x * x); const float e = __expf(2.f * uu); return 0.5f * x * (2.f - 2.f * __builtin_amdgcn_rcpf(e + 1.f)); }
struct EpiS5c {
    static constexpr bool PERM = true, AFTER_DRAIN = false;
    bf16_t* GY; const bf16_t* UC; const float* d5;
    __device__ __forceinline__ void operator()(const f32x4 (&acc)[2][2][4][2], const Unit& u, int wr, int wc, int fr, int fq) const {
        const int g = u.pm >> 1, cl0 = (u.pm & 1) * BM + wr * 64 + fr, nl0 = (u.pn & 1) * BM + wc * 32 + 8 * fq;
        const int k0 = nl0 & 15; const f32x4 d0 = *(const f32x4*)(d5 + g * 16 + k0), d1 = *(const f32x4*)(d5 + g * 16 + k0 + 4);
#pragma unroll
        for (int ai = 0; ai < 2; ++ai)
#pragma unroll
            for (int m = 0; m < 4; ++m) { const int cl = cl0 + ai * HALF + m * 16;
#pragma unroll
                for (int bj = 0; bj < 2; ++bj) { const int nl = nl0 + bj * HALF, t = nl >> 4;
                    const u32x4 uw = *(const u32x4*)(UC + ((size_t)(g * 512 + cl) * 768 + nl));
                    f32x4 v0 = acc[ai][bj][m][0], v1 = acc[ai][bj][m][1];
                    v0[0] += bf_lo(uw.x) * d0[0]; v0[1] += bf_hi(uw.x) * d0[1]; v0[2] += bf_lo(uw.y) * d0[2]; v0[3] += bf_hi(uw.y) * d0[3];
                    v1[0] += bf_lo(uw.z) * d1[0]; v1[1] += bf_hi(uw.z) * d1[1]; v1[2] += bf_lo(uw.w) * d1[2]; v1[3] += bf_hi(uw.w) * d1[3];
#pragma unroll
                    for (int j = 0; j < 4; ++j) { v0[j] = gelu_tanh_f(v0[j]); v1[j] = gelu_tanh_f(v1[j]); }
                    u32x4 w; w.x = cvt_pk_bf16(v0[0], v0[1]); w.y = cvt_pk_bf16(v0[2], v0[3]); w.z = cvt_pk_bf16(v1[0], v1[1]); w.w = cvt_pk_bf16(v1[2], v1[3]);
                    *(u32x4*)(GY + (size_t)(cl * 32 + t) * 768 + g * 16 + k0) = w; } }
    }
};
struct S5aOrder {
    int c, lo;
    __device__ __forceinline__ bool next(int i, Unit& u) const { if (i > 0 || c < lo || c >= lo + 96) return false; u.pm = c - lo; u.pn = (c - lo) >> 1; return true; }
    __device__ __forceinline__ void a_ready(const Unit&) const {}
    __device__ __forceinline__ void done(const Unit&) const {}
};
struct S5cOrder {
    int G, c;
    __device__ __forceinline__ bool next(int i, Unit& u) const { const int L = i * G + c; if (L >= 192) return false; const int g = L >> 2; u.pm = 2 * g + (L & 1); u.pn = 2 * g + ((L >> 1) & 1); return true; }
    __device__ __forceinline__ void a_ready(const Unit&) const {}
    __device__ __forceinline__ void done(const Unit&) const {}
};
struct MoeOrder1 {
    int G, c;
    __device__ __forceinline__ bool next(int i, Unit& u) const {
        if (G == 256) { if (i >= 11) return false; const int x = c & 7, j = c >> 3, q = x * 44 + i * 4 + (j >> 3); u.pm = (q / 22) * 8 + (j & 7); u.pn = q; return true; }
        const long L = (long)i * G + c; if (L >= 2816) return false; const int e = (int)(L / 176), r = (int)(L % 176); u.pm = e * 8 + (r & 7); u.pn = e * 22 + (r >> 3); return true;
    }
    __device__ __forceinline__ void a_ready(const Unit&) const {}
    __device__ __forceinline__ void done(const Unit&) const {}
};
struct MoeOrder2 {
    int G, c;
    __device__ __forceinline__ bool next(int i, Unit& u) const {
        if (G == 256) { if (i >= 2) return false; const int x = c & 7, j = c >> 3, e = 2 * x + i; u.pm = e * 8 + (j & 7); u.pn = e * 4 + (j >> 3); return true; }
        const long L = (long)i * G + c; if (L >= 512) return false; const int e = (int)(L / 32), r = (int)(L % 32); u.pm = e * 8 + (r & 7); u.pn = e * 4 + (r >> 3); return true;
    }
    __device__ __forceinline__ void a_ready(const Unit&) const {}
    __device__ __forceinline__ void done(const Unit&) const {}
};
template <class Epi, class Sched, bool ALIGN_EPI = false, bool SP2 = false>
__device__ __forceinline__ void gemm_phase(PG8_LAS unsigned char* lds, const Gemm g, const Sched& S, const Epi& E) {
    const int tid = threadIdx.x, wid = __builtin_amdgcn_readfirstlane(tid >> 6), lane = tid & 63, wr = wid >> 2, wc = wid & 3, fr = lane & 15, fq = lane >> 4;
    const int K = g.K, nt = K / BK;
    unsigned voffA[2], voffB[2];
#pragma unroll
    for (int i = 0; i < 2; ++i) { int R, C; stage_rc(tid * 16 + i * 8192, R, C); const int Rb = Epi::PERM ? ((R & ~31) + perm32(R & 31)) : R;
        voffA[i] = (unsigned)(R * g.lda + C) * 2u; voffB[i] = (unsigned)(Rb * g.ldb + C) * 2u; }
    const size_t kstep = (size_t)(BK * 2);
    const size_t hstepA = (size_t)HALF * g.lda * 2, hstepB = (size_t)HALF * g.ldb * 2;
    const size_t tstepA = 2 * hstepA, tstepB = 2 * hstepB;
    const unsigned ldsw = (unsigned)wid * 1024u;
    const int aoff = lds_byte(wr * 64 + fr, fq * 8), boff = lds_byte(wc * 32 + fr, fq * 8);
#define PG8_SA(b, h) (((b) * 2 + (h)) * HTB)
#define PG8_SB(b, h) ((4 + (b) * 2 + (h)) * HTB)
#define PG8_STAGE(bufoff, gbase, voff) do { _Pragma("unroll") for (int _i = 0; _i < 2; ++_i) \
        __builtin_amdgcn_global_load_lds((const unsigned*)((const char*)(gbase) + (voff)[_i]), (PG8_LAS unsigned*)(lds + (bufoff) + ldsw + _i * 8192), 16, 0, 0); } while (0)
#define PG8_LDA(dst, b, h) do { _Pragma("unroll") for (int m = 0; m < 4; ++m) _Pragma("unroll") for (int k = 0; k < 2; ++k) dst[m][k] = *(const PG8_LAS bf16x8*)(lds + PG8_SA(b, h) + aoff + m * 2048 + k * 1024); } while (0)
#define PG8_LDB(dst, b, h) do { _Pragma("unroll") for (int n = 0; n < 2; ++n) _Pragma("unroll") for (int k = 0; k < 2; ++k) dst[n][k] = *(const PG8_LAS bf16x8*)(lds + PG8_SB(b, h) + boff + n * 2048 + k * 1024); } while (0)
#define PG8_MMA(ai, bj, At, Bt) do { __builtin_amdgcn_s_setprio(1); _Pragma("unroll") for (int m = 0; m < 4; ++m) _Pragma("unroll") for (int n = 0; n < 2; ++n) _Pragma("unroll") for (int k = 0; k < 2; ++k) \
        acc[ai][bj][m][n] = __builtin_amdgcn_mfma_f32_16x16x32_bf16(Bt[n][k], At[m][k], acc[ai][bj][m][n], 0, 0, 0); __builtin_amdgcn_s_setprio(0); } while (0)
#define PG8_WAIT_V(n) asm volatile("s_waitcnt vmcnt(" #n ")" ::: "memory")
#define PG8_WAIT_L(n) asm volatile("s_waitcnt lgkmcnt(" #n ")" ::: "memory")
#define PG8_BAR __builtin_amdgcn_s_barrier()
#define PG8_SCHED __builtin_amdgcn_sched_barrier(0)
    Unit cur, nxt; int ui = 0;
    if (!S.next(0, cur)) return;
    f32x4 acc[2][2][4][2];
#pragma unroll
    for (int a = 0; a < 2; ++a)
#pragma unroll
        for (int b = 0; b < 2; ++b)
#pragma unroll
            for (int m = 0; m < 4; ++m)
#pragma unroll
                for (int n = 0; n < 2; ++n) acc[a][b][m][n] = (f32x4){0.f, 0.f, 0.f, 0.f};
    bf16x8 At[4][2], B0[2][2], B1[2][2];
    const char* cA = (const char*)g.A + (size_t)cur.pm * tstepA; const char* cB = (const char*)g.Bt + (size_t)cur.pn * tstepB;
    S.a_ready(cur);
    if constexpr (SP2) {
        PG8_STAGE(PG8_SB(0, 0), cB, voffB); PG8_STAGE(PG8_SB(0, 1), cB + hstepB, voffB); PG8_STAGE(PG8_SA(0, 0), cA, voffA); PG8_STAGE(PG8_SA(0, 1), cA + hstepA, voffA);
        if (wr == 1) PG8_BAR;
        PG8_WAIT_V(2); PG8_BAR;
        PG8_STAGE(PG8_SB(1, 0), cB + kstep, voffB); PG8_STAGE(PG8_SA(1, 0), cA + kstep, voffA); PG8_STAGE(PG8_SB(1, 1), cB + hstepB + kstep, voffB);
        PG8_WAIT_V(6); PG8_BAR;
    } else {
        PG8_STAGE(PG8_SB(0, 0), cB, voffB); PG8_STAGE(PG8_SA(0, 0), cA, voffA); PG8_STAGE(PG8_SB(0, 1), cB + hstepB, voffB); PG8_STAGE(PG8_SA(0, 1), cA + hstepA, voffA);
        if (wr == 1) PG8_BAR;
        PG8_WAIT_V(4); PG8_BAR;
        PG8_STAGE(PG8_SB(1, 0), cB + kstep, voffB); PG8_STAGE(PG8_SA(1, 0), cA + kstep, voffA); PG8_STAGE(PG8_SB(1, 1), cB + hstepB + kstep, voffB);
        PG8_WAIT_V(6); PG8_BAR;
    }
    for (;;) {
        const bool has_next = S.next(ui + 1, nxt);
        const char* nA = has_next ? (const char*)g.A + (size_t)nxt.pm * tstepA : cA; const char* nB = has_next ? (const char*)g.Bt + (size_t)nxt.pn * tstepB : cB;
        for (int t = 0; t < nt; t += 2) {
            const bool last = (t == nt - 2);
            const char* a1 = cA + (size_t)(t + 1) * kstep;
            const char* a2 = last ? nA : cA + (size_t)(t + 2) * kstep; const char* b2 = last ? nB : cB + (size_t)(t + 2) * kstep;
            const char* a3 = a2 + kstep; const char* b3 = b2 + kstep;
            if (last && has_next) S.a_ready(nxt);
            if constexpr (SP2) {
            PG8_LDB(B0, 0, 0); PG8_LDB(B1, 0, 1); PG8_SCHED; PG8_LDA(At, 0, 0); PG8_STAGE(PG8_SA(1, 1), a1 + hstepA, voffA);
            PG8_WAIT_V(8); PG8_WAIT_L(0); PG8_BAR; PG8_MMA(0, 0, At, B0); PG8_MMA(0, 1, At, B1); PG8_BAR; PG8_SCHED;
            PG8_LDA(At, 0, 1); PG8_STAGE(PG8_SB(0, 0), b2, voffB); PG8_STAGE(PG8_SB(0, 1), b2 + hstepB, voffB); PG8_STAGE(PG8_SA(0, 0), a2, voffA);
            PG8_WAIT_V(8); PG8_WAIT_L(0); PG8_BAR; PG8_MMA(1, 0, At, B0); PG8_MMA(1, 1, At, B1); PG8_BAR; PG8_SCHED;
            PG8_LDB(B0, 1, 0); PG8_LDB(B1, 1, 1); PG8_SCHED; PG8_LDA(At, 1, 0); PG8_STAGE(PG8_SA(0, 1), a2 + hstepA, voffA);
            PG8_WAIT_V(8); PG8_WAIT_L(0); PG8_BAR; PG8_MMA(0, 0, At, B0); PG8_MMA(0, 1, At, B1); PG8_BAR; PG8_SCHED;
            PG8_LDA(At, 1, 1); PG8_STAGE(PG8_SB(1, 0), b3, voffB); PG8_STAGE(PG8_SB(1, 1), b3 + hstepB, voffB); PG8_STAGE(PG8_SA(1, 0), a3, voffA);
            PG8_WAIT_V(8); PG8_WAIT_L(0); PG8_BAR; PG8_MMA(1, 0, At, B0); PG8_MMA(1, 1, At, B1); PG8_BAR; PG8_SCHED;
            } else {
            PG8_LDB(B0, 0, 0); PG8_SCHED; PG8_LDA(At, 0, 0); PG8_STAGE(PG8_SA(1, 1), a1 + hstepA, voffA);
            PG8_WAIT_L(8); PG8_BAR; PG8_WAIT_L(0); PG8_MMA(0, 0, At, B0); PG8_BAR; PG8_SCHED;
            PG8_LDB(B1, 0, 1); PG8_STAGE(PG8_SB(0, 0), b2, voffB);
            PG8_BAR; PG8_WAIT_L(0); PG8_MMA(0, 1, At, B1); PG8_BAR;
            PG8_LDA(At, 0, 1); PG8_STAGE(PG8_SA(0, 0), a2, voffA);
            PG8_BAR; PG8_WAIT_L(0); PG8_MMA(1, 0, At, B0); PG8_BAR; PG8_SCHED;
            PG8_STAGE(PG8_SB(0, 1), b2 + hstepB, voffB);
            PG8_WAIT_V(6); PG8_BAR; PG8_MMA(1, 1, At, B1); PG8_BAR;
            PG8_LDB(B0, 1, 0); PG8_SCHED; PG8_LDA(At, 1, 0); PG8_STAGE(PG8_SA(0, 1), a2 + hstepA, voffA);
            PG8_WAIT_L(8); PG8_BAR; PG8_WAIT_L(0); PG8_MMA(0, 0, At, B0); PG8_BAR; PG8_SCHED;
            PG8_LDB(B1, 1, 1); PG8_STAGE(PG8_SB(1, 0), b3, voffB);
            PG8_BAR; PG8_WAIT_L(0); PG8_MMA(0, 1, At, B1); PG8_BAR;
            PG8_LDA(At, 1, 1); PG8_STAGE(PG8_SA(1, 0), a3, voffA);
            PG8_BAR; PG8_WAIT_L(0); PG8_MMA(1, 0, At, B0); PG8_BAR; PG8_SCHED;
            PG8_STAGE(PG8_SB(1, 1), b3 + hstepB, voffB);
            PG8_WAIT_V(6); PG8_BAR; PG8_MMA(1, 1, At, B1); PG8_BAR;
            }
        }
        if constexpr (ALIGN_EPI) { if (wr == 0) PG8_BAR; }
        if constexpr (!Epi::AFTER_DRAIN) { E(acc, cur, wr, wc, fr, fq); S.done(cur); }
        if (!has_next) break;
#pragma unroll
        for (int a = 0; a < 2; ++a)
#pragma unroll
            for (int b = 0; b < 2; ++b)
#pragma unroll
                for (int m = 0; m < 4; ++m)
#pragma unroll
                    for (int n = 0; n < 2; ++n) acc[a][b][m][n] = (f32x4){0.f, 0.f, 0.f, 0.f};
        cur = nxt; cA = nA; cB = nB; ++ui;
        if constexpr (ALIGN_EPI) { if (wr == 1) PG8_BAR; }
    }
    PG8_WAIT_V(0);
    if constexpr (!ALIGN_EPI) { if (wr == 0) PG8_BAR; }
    PG8_BAR;
    if constexpr (Epi::AFTER_DRAIN) { E.fused(acc, cur, wr, wc, fr, fq, lds, wid, lane); S.done(cur); }
#undef PG8_SA
#undef PG8_SB
#undef PG8_STAGE
#undef PG8_LDA
#undef PG8_LDB
#undef PG8_MMA
#undef PG8_WAIT_V
#undef PG8_WAIT_L
#undef PG8_BAR
#undef PG8_SCHED
}
}
#ifndef PG8_SP2
#define PG8_SP2 true
#endif
#ifndef PG8_ALIGN
#define PG8_ALIGN true
#endif

constexpr int NWAVES = 8, NTHR = 512;
constexpr int D = 1024, NB = 2, T = 8192, M = NB * T;
constexpr int SSD_H = 24, SSD_P = 64, SSD_IN = 1536, SSD_G = 4, SSD_N = 128, XBC = 2560, INCOLS = 6960, NIN_PAD = 7168;
constexpr int S5_W = 768, S5_G = 48, S5_P = 64, S5_K = 16;
constexpr int NE = 16, FF = 2816, CAP = 1024, MROWS = NE * NB * CAP;
constexpr float LN_EPS = 1e-5f, RMS_EPS = 1e-5f;
constexpr float ALPHA = 1.189207115002721f;

constexpr size_t MiB = 1u << 20;
constexpr size_t WS_CTL = 0, CTL_ZERO_BYTES = 64 * 1024;
constexpr size_t WS_WIN = 1 * MiB, WS_WOUT = 15 * MiB, WS_WGLU = 18 * MiB, WS_WO = 21 * MiB, WS_W1 = 23 * MiB, WS_W2 = 199 * MiB, WS_ACT = 287 * MiB;
constexpr size_t A_XB = WS_ACT + 0 * MiB;
constexpr size_t A_Z = WS_ACT + 32 * MiB;
constexpr size_t A_XBC = WS_ACT + 80 * MiB;
constexpr size_t A_GT = WS_ACT + 160 * MiB;
constexpr size_t A_UC = WS_ACT + 331 * MiB;
constexpr size_t A_DT = WS_ACT + 248 * MiB;
constexpr size_t A_XS = WS_ACT + 251 * MiB;
constexpr size_t A_BM = WS_ACT + 299 * MiB;
constexpr size_t A_CM = WS_ACT + 315 * MiB;
constexpr size_t A_YF = WS_ACT + 80 * MiB;
constexpr size_t A_YB = WS_ACT + 369 * MiB;
constexpr size_t A_GY = WS_ACT + 128 * MiB;
constexpr size_t A_YA = WS_ACT + 0 * MiB;
constexpr size_t A_MIX = WS_ACT + 224 * MiB;
constexpr size_t A_HP = WS_ACT + 256 * MiB;
constexpr size_t A_H = WS_ACT + 349 * MiB;
constexpr size_t A_HB = WS_ACT + 0 * MiB;
constexpr size_t A_AFF = WS_ACT + 413 * MiB;
constexpr size_t A_IDX = A_AFF + 512 * 1024;
constexpr size_t A_SEL = A_AFF + 1 * MiB;
constexpr size_t A_GATE = A_AFF + 2 * MiB;
constexpr size_t A_XIN = WS_ACT + 32 * MiB;
constexpr size_t A_HID = WS_ACT + 96 * MiB;
constexpr size_t A_YE = WS_ACT + 272 * MiB;
constexpr size_t WS_TV = WS_W2 + 0 * MiB;
constexpr size_t WS_WS5 = WS_W2 + 36 * MiB;
constexpr size_t WS_SLOC = WS_W2 + 48 * MiB;
constexpr size_t WS_AQ = WS_W2 + 72 * MiB;
constexpr size_t WS_END = 704 * MiB;
static_assert(A_GATE + 1 * MiB <= WS_END && A_H + 64 * MiB <= A_AFF && A_YE + 64 * MiB <= A_H && A_HID + 176 * MiB <= A_YE && A_XIN + 64 * MiB <= A_HID, "d_ws map (late phases)");
static_assert(A_YB + 48 * MiB <= WS_END && A_CM + 16 * MiB <= A_UC && A_UC + 36 * MiB <= A_YB && A_GY + 24 * MiB <= A_GT && A_YF + 48 * MiB <= A_GY, "d_ws map (early phases)");
constexpr int CW_BAR = 1024;

constexpr int RING_BYTES = 131072;
constexpr int MISC_OFF = RING_BYTES;
constexpr int LDS_BYTES = 147456;

#define GAS __attribute__((address_space(1)))
#define LAS __attribute__((address_space(3)))
typedef unsigned short bf16;
typedef unsigned v4u __attribute__((ext_vector_type(4)));
typedef unsigned v2u __attribute__((ext_vector_type(2)));
typedef float f32x4 __attribute__((ext_vector_type(4)));
#define LDS_WAIT() asm volatile("s_waitcnt lgkmcnt(0)" ::: "memory")
__device__ __forceinline__ unsigned f2bf(float f) { unsigned u = __builtin_bit_cast(unsigned, f); return (u + 0x7fffu + ((u >> 16) & 1u)) >> 16; }
__device__ __forceinline__ unsigned pk2(float lo, float hi) { return f2bf(lo) | (f2bf(hi) << 16); }
__device__ __forceinline__ float bflo(unsigned w) { return __uint_as_float(w << 16); }
__device__ __forceinline__ float bfhi(unsigned w) { return __uint_as_float(w & 0xffff0000u); }
__device__ __forceinline__ float wave_sum(float v) {
#pragma unroll
    for (int o = 1; o < 64; o <<= 1) v += __shfl_xor(v, o);
    return v;
}
#define XB_TMO      128
#define XB_XCNT(j)  (256  + 64 * (j))
#define XB_XSUB(j)  (1280 + 64 * (j))
#define XB_XGEN(j)  (2304 + 64 * (j))
#define XB_TOP      3328
#define XB_TOPGEN   3392
#define XCD_BAR_WORDS 3456
#define XB_SPIN_CAP (1u << 18)

__device__ __forceinline__ unsigned xb_ld(unsigned* p)              { return __hip_atomic_load(p, __ATOMIC_RELAXED, __HIP_MEMORY_SCOPE_AGENT); }
__device__ __forceinline__ unsigned xb_add(unsigned* p, unsigned v) { return __hip_atomic_fetch_add(p, v, __ATOMIC_RELAXED, __HIP_MEMORY_SCOPE_AGENT); }
__device__ __forceinline__ unsigned xb_xcc_id() { return (unsigned)__builtin_amdgcn_s_getreg((3 << 11) | 20) & 0xFu; }
#define XB_SPIN(cond, bar) do { unsigned _sp = 0; while (cond) { __builtin_amdgcn_s_sleep(1); \
    if ((++_sp & 255u) == 0u) { if (xb_ld(&(bar)[XB_TMO])) break; if (_sp > XB_SPIN_CAP) { atomicAdd(&(bar)[XB_TMO], 1u); break; } } } } while (0)

struct XcdBarrier {
    unsigned* bar; unsigned x;
    volatile LAS unsigned* st;
};

__device__ __forceinline__ XcdBarrier xcd_barrier_post(unsigned* bar, volatile LAS unsigned* st) {
    XcdBarrier b; b.bar = bar; b.x = xb_xcc_id(); b.st = st;
    if (threadIdx.x == 0) (void)xb_add(&bar[XB_XCNT(b.x)], 1u);
    return b;
}
__device__ __forceinline__ void xcd_barrier_complete(unsigned* bar, unsigned x, unsigned& nloc, unsigned& nx) {
    const unsigned G = gridDim.x * gridDim.y * gridDim.z;
    unsigned sum, cnt, mine, sp = 0u;
    for (;;) {
        sum = 0u; cnt = 0u; mine = 0u;
#pragma unroll
        for (unsigned j = 0; j < 16; ++j) { const unsigned c = xb_ld(&bar[XB_XCNT(j)]); sum += c; cnt += (c > 0u) ? 1u : 0u; mine = (j == x) ? c : mine; }
        if (sum == G) break;
        __builtin_amdgcn_s_sleep(1);
        if ((++sp & 255u) == 0u) { if (xb_ld(&bar[XB_TMO])) break; if (sp > XB_SPIN_CAP) { atomicAdd(&bar[XB_TMO], 1u); break; } }
    }
    nloc = mine > 0u ? mine : 1u; nx = cnt > 0u ? cnt : 1u;
}

__device__ __forceinline__ void xcd_barrier(const XcdBarrier& b) {
    asm volatile("s_waitcnt vmcnt(0)" ::: "memory");
    __syncthreads();
    if (threadIdx.x == 0) {
        unsigned* bar = b.bar;
        __builtin_amdgcn_s_waitcnt(0);
        unsigned nloc = b.st[0], nx = b.st[1];
        if (nloc == 0u) { xcd_barrier_complete(bar, b.x, nloc, nx); b.st[0] = nloc; b.st[1] = nx; }
        const unsigned old = xb_add(&bar[XB_XSUB(b.x)], 1u);
        const unsigned gen = old / nloc;
        if (old + 1u == (gen + 1u) * nloc) {
            __builtin_amdgcn_fence(__ATOMIC_RELEASE, "agent");
            asm volatile("s_waitcnt vmcnt(0)" ::: "memory");
            const unsigned og = xb_add(&bar[XB_TOP], 1u);
            const unsigned tg = og / nx;
            if (og + 1u == (tg + 1u) * nx) xb_add(&bar[XB_TOPGEN], 1u);
            else XB_SPIN(xb_ld(&bar[XB_TOPGEN]) == tg, bar);
            __builtin_amdgcn_fence(__ATOMIC_ACQUIRE, "agent");
            xb_add(&bar[XB_XGEN(b.x)], 1u);
            asm volatile("s_waitcnt vmcnt(0)" ::: "memory");
        } else {
            XB_SPIN(xb_ld(&bar[XB_XGEN(b.x)]) == gen, bar);
            __builtin_amdgcn_fence(__ATOMIC_ACQUIRE, "agent");
            asm volatile("s_waitcnt vmcnt(0)" ::: "memory");
        }
    }
    __syncthreads();
}

struct Frame {
    LAS unsigned char* lds;
    int tid, lane, wave, bid, G;
    const float* const* in; float* out; unsigned char* ws;
};
#define WSP(T_, off) ((T_*)(F.ws + (off)))

__device__ __forceinline__ void tr_item(const float* W, int ldw, int col0, int ncols, int K, bf16* WT, int drow, LAS float* scr, int k0, int n0, int lane) {
    const int nl = lane & 31; const bool okc = (n0 + nl) < ncols;
#pragma unroll 8
    for (int i = 0; i < 32; ++i) { const int kk = 2 * i + (lane >> 5); scr[kk * 33 + nl] = okc ? W[(size_t)(k0 + kk) * ldw + col0 + n0 + nl] : 0.f; }
    LDS_WAIT(); asm volatile("" ::: "memory");
    const int c = lane & 7;
#pragma unroll
    for (int j = 0; j < 4; ++j) { const int n = (lane >> 3) + 8 * j; const LAS float* s = scr + (8 * c) * 33 + n;
        v4u o; o.x = pk2(s[0 * 33], s[1 * 33]); o.y = pk2(s[2 * 33], s[3 * 33]); o.z = pk2(s[4 * 33], s[5 * 33]); o.w = pk2(s[6 * 33], s[7 * 33]);
        if (n0 + n < ncols) *(v4u*)(WT + (size_t)(drow + n) * K + k0 + 8 * c) = o; }
    LDS_WAIT(); asm volatile("" ::: "memory");
}
struct TrJob { const float* W; int ldw, col0, ncols, K; bf16* WT; int drow0, interleave; };
__device__ __forceinline__ int tr_job_items(const TrJob& j) { return (j.K / 64) * ((j.ncols + 31) / 32); }
__device__ __forceinline__ void tr_job_item(const TrJob& j, int item, LAS float* scr, int lane) {
    const int nblk = (j.ncols + 31) / 32, kb = item / nblk, nb = item % nblk, n0 = nb * 32;
    const int drow = j.interleave ? j.drow0 + (n0 >> 7) * 256 + (n0 & 127) : j.drow0 + n0;
    tr_item(j.W, j.ldw, j.col0, j.ncols, j.K, j.WT, drow, scr, kb * 64, n0, lane);
}
__device__ __forceinline__ void p0_prologue(Frame& F) {
    LAS float* scr = (LAS float*)(F.lds + F.wave * 8704);
    const int gw = F.bid * NWAVES + F.wave, NGW = F.G * NWAVES;
    { const f32x4* x4 = (const f32x4*)F.in[0]; v4u* o = WSP(v4u, A_XB); const int n8 = M * D / 8;
      for (int i = F.bid * NTHR + F.tid; i < n8; i += F.G * NTHR) { const f32x4 a = x4[2 * i], b = x4[2 * i + 1]; v4u w; w.x = pk2(a.x, a.y); w.y = pk2(a.z, a.w); w.z = pk2(b.x, b.y); w.w = pk2(b.z, b.w); o[i] = w; } }
    {
        bf16* WIN = WSP(bf16, WS_WIN); bf16* WOUT = WSP(bf16, WS_WOUT); bf16* WGLU = WSP(bf16, WS_WGLU); bf16* WO = WSP(bf16, WS_WO);
        const TrJob jobs[8] = {
            {F.in[1], INCOLS, 0, 4096, D, WIN, 0, 0}, {F.in[1], INCOLS, 4096, 48, D, WIN, 4096, 0}, {F.in[1], INCOLS, 4144, 768, D, WIN, 4352, 0}, {F.in[1], INCOLS, 4912, 2048, D, WIN, 5120, 0},
            {F.in[10], D, 0, D, SSD_IN, WOUT, 0, 0}, {F.in[22], D, 0, D, S5_W, WGLU, 0, 1}, {F.in[23], D, 0, D, S5_W, WGLU, 128, 1}, {F.in[24], D, 0, D, D, WO, 0, 0} };
        int base = 0;
#pragma unroll
        for (int q = 0; q < 8; ++q) { const int n = tr_job_items(jobs[q]);
            int it0 = (gw - base) % NGW; if (it0 < 0) it0 += NGW;
            for (int it = it0; it < n; it += NGW) tr_job_item(jobs[q], it, scr, F.lane);
            base += n; }
    }
    {
        bf16* W1 = WSP(bf16, WS_W1);
        constexpr int I13 = (D / 64) * (FF / 32);
        for (int it = gw; it < NE * 2 * I13; it += NGW) {
            const int e = it / (2 * I13); int r = it % (2 * I13);
            if (r < I13) { const TrJob j{F.in[28] + (size_t)e * D * FF, FF, 0, FF, D, W1 + (size_t)e * 2 * FF * D, 0, 1}; tr_job_item(j, r, scr, F.lane); }
            else { const TrJob j{F.in[29] + (size_t)e * D * FF, FF, 0, FF, D, W1 + (size_t)e * 2 * FF * D, 128, 1}; tr_job_item(j, r - I13, scr, F.lane); }
        }
    }
}
__device__ __forceinline__ void w2_convert(Frame& F, int gw, int ngw) {
    LAS float* scr = (LAS float*)(F.lds + F.wave * 8704);
    bf16* W2 = WSP(bf16, WS_W2);
    constexpr int I2 = (FF / 64) * (D / 32);
    for (int it = gw; it < NE * I2; it += ngw) { const int e = it / I2, r = it % I2;
        const TrJob j{F.in[30] + (size_t)e * FF * D, D, 0, D, FF, W2 + (size_t)e * D * FF, 0, 0}; tr_job_item(j, r, scr, F.lane); }
}

__device__ __forceinline__ void cmul(float ar, float ai, float br, float bi, float& cr, float& ci) { cr = ar * br - ai * bi; ci = ar * bi + ai * br; }
__device__ __forceinline__ void s5_precompute_item(Frame& F, int g, int tau) {
    LAS float* PQ = (LAS float*)(F.lds + 72 * 1024);
    LAS float* PW = PQ + 256;
    bf16* TV = WSP(bf16, WS_TV) + (size_t)g * 512 * 768; bf16* WM = WSP(bf16, WS_WS5) + (size_t)g * 256 * 512; float* AQ = WSP(float, WS_AQ);
    const int tid = F.tid;
    __syncthreads();
    if (tid < 128) {
        const int d = tid >> 6, p = tid & 63;
        const float are = (d ? F.in[14] : F.in[11])[g * 64 + p], aim = (d ? F.in[15] : F.in[12])[g * 64 + p], step = __expf((d ? F.in[16] : F.in[13])[g]);
        const float zr = are * step, zi = aim * step;
        const float er = expf(zr), cs = cosf(zi), sn = sinf(zi), abr = er * cs, abi = er * sn;
        const float sh = sinf(0.5f * zi), dr = expm1f(zr) * cs - 2.f * sh * sh, di = abi;
        const float den = 1.0f / (are * are + aim * aim), qr = (dr * are + di * aim) * den, qi = (di * are - dr * aim) * den;
        float pr = 1.f, pi = 0.f, br = abr, bi = abi;
#pragma unroll
        for (int bit = 0; bit < 6; ++bit) { if ((tau >> bit) & 1) { float tr_, ti_; cmul(pr, pi, br, bi, tr_, ti_); pr = tr_; pi = ti_; } float sr_, si_; cmul(br, bi, br, bi, sr_, si_); br = sr_; bi = si_; }
        float xr, xi; cmul(pr, pi, qr, qi, xr, xi);
        PQ[(d * 64 + p) * 2] = xr; PQ[(d * 64 + p) * 2 + 1] = xi; PW[(d * 64 + p) * 2] = pr; PW[(d * 64 + p) * 2 + 1] = pi;
        if (tau == 32) { AQ[((g * 2 + d) * 64 + p) * 2] = pr; AQ[((g * 2 + d) * 64 + p) * 2 + 1] = pi; }
    }
    __syncthreads();
    const float* cre = F.in[19] + (size_t)g * 16 * 64; const float* cim = F.in[20] + (size_t)g * 16 * 64;
    const float* bre = F.in[17] + (size_t)g * 64 * 16; const float* bim = F.in[18] + (size_t)g * 64 * 16;
    if (tid < 256 && tau < 32) {
        const int k = tid >> 4, j = tid & 15; float kf = 0.f, kb = 0.f;
        for (int p = 0; p < 64; ++p) { const float cr = cre[k * 64 + p], ci = cim[k * 64 + p], br = bre[p * 16 + j], bi = bim[p * 16 + j];
            float wr_, wi_; cmul(cr, ci, PQ[p * 2], PQ[p * 2 + 1], wr_, wi_); kf += wr_ * br - wi_ * bi;
            cmul(cr, ci, PQ[(64 + p) * 2], PQ[(64 + p) * 2 + 1], wr_, wi_); kb += wr_ * br - wi_ * bi; }
        if (tau == 0) { const bf16 v = (bf16)f2bf(kf + kb); for (int t = 0; t < 32; ++t) TV[(size_t)(t * 16 + k) * 768 + t * 16 + j] = v; }
        else { const bf16 vf = (bf16)f2bf(kf), vb = (bf16)f2bf(kb);
            for (int t = tau; t < 32; ++t) { const int s = t - tau; TV[(size_t)(t * 16 + k) * 768 + s * 16 + j] = vf; TV[(size_t)(s * 16 + k) * 768 + t * 16 + j] = vb; } }
    }
    if (tid >= 256) {
        const int q = tid - 256;
        if (tau >= 1) {
#pragma unroll 1
            for (int i = 0; i < 8; ++i) { const int e = q * 8 + i, d = e >> 10, k = (e >> 6) & 15, p = e & 63;
                float vr, vi; cmul(cre[k * 64 + p], cim[k * 64 + p], PW[(d * 64 + p) * 2], PW[(d * 64 + p) * 2 + 1], vr, vi);
                const int t = d ? 32 - tau : tau - 1; bf16* row = TV + (size_t)(t * 16 + k) * 768 + 512 + d * 128;
                row[p] = (bf16)f2bf(vr); row[64 + p] = (bf16)f2bf(-vi); } }
        if (tau < 32) {
#pragma unroll 1
            for (int i = 0; i < 8; ++i) { const int e = q * 8 + i, d = e >> 10, p = (e >> 4) & 63, j = e & 15;
                float vr, vi; cmul(PQ[(d * 64 + p) * 2], PQ[(d * 64 + p) * 2 + 1], bre[p * 16 + j], bim[p * 16 + j], vr, vi);
                const int s = d ? tau : 31 - tau; bf16* col = WM + (size_t)(d * 128 + p) * 512 + s * 16 + j;
                col[0] = (bf16)f2bf(vr); col[(size_t)64 * 512] = (bf16)f2bf(vi); } }
    }
}
__device__ __forceinline__ void p0_s5(Frame& F) { for (int it = F.bid; it < S5_G * 33; it += F.G) s5_precompute_item(F, it / 33, it % 33); }

__device__ __forceinline__ void s5_scan_item(Frame& F, int item) {
    const int d = item & 1, b = (item >> 1) & 1, g = item >> 2, tid = F.tid;
    LAS float* S = (LAS float*)F.lds;
    const float* SL = WSP(float, WS_SLOC) + ((size_t)(g * 512 + b * 256) * 256 + d * 128);
    __syncthreads();
    for (int i = tid; i < 256 * 32; i += NTHR) { const int ci = i >> 5, c4 = (i & 31) * 4; *(LAS f32x4*)(S + ci * 128 + c4) = *(const f32x4*)(SL + (size_t)ci * 256 + c4); }
    __syncthreads();
    if (tid < 64) {
        const float* AQ = WSP(float, WS_AQ); const float qr = AQ[((g * 2 + d) * 64 + tid) * 2], qi = AQ[((g * 2 + d) * 64 + tid) * 2 + 1];
        float sr = 0.f, si = 0.f;
        for (int n = 0; n < 256; ++n) { const int ci = d ? 255 - n : n;
            const float tr_ = S[ci * 128 + tid], ti_ = S[ci * 128 + 64 + tid];
            S[ci * 128 + tid] = sr; S[ci * 128 + 64 + tid] = si;
            const float nr = qr * sr - qi * si + tr_, ni = qr * si + qi * sr + ti_; sr = nr; si = ni; }
    }
    __syncthreads();
    bf16* UC = WSP(bf16, A_UC) + ((size_t)(g * 512 + b * 256) * 768 + 512 + d * 128);
    for (int i = tid; i < 256 * 16; i += NTHR) { const int ci = i >> 4, c8 = (i & 15) * 8; const LAS float* s = S + ci * 128 + c8;
        v4u o; o.x = pk2(s[0], s[1]); o.y = pk2(s[2], s[3]); o.z = pk2(s[4], s[5]); o.w = pk2(s[6], s[7]);
        *(v4u*)(UC + (size_t)ci * 768 + c8) = o; }
}

__device__ __forceinline__ void unpack8(const v4u w, float (&f)[8]) { f[0] = bflo(w.x); f[1] = bfhi(w.x); f[2] = bflo(w.y); f[3] = bfhi(w.y); f[4] = bflo(w.z); f[5] = bfhi(w.z); f[6] = bflo(w.w); f[7] = bfhi(w.w); }
__device__ __forceinline__ void p2_conv(Frame& F) {
    const bf16* xbc = WSP(bf16, A_XBC); bf16* XS = WSP(bf16, A_XS); bf16* BMp = WSP(bf16, A_BM); bf16* CMp = WSP(bf16, A_CM);
    const float* cw = F.in[2]; const float* cb = F.in[3];
    constexpr int RUN = 32, NCG = XBC / 8, NITEM = (M / RUN) * NCG;
    for (int item = F.bid * NTHR + F.tid; item < NITEM; item += F.G * NTHR) {
        const int cg = item % NCG, r = item / NCG, ch = cg * 8, m0 = r * RUN, tb = m0 % T;
        float w[5][8], bias[8];
#pragma unroll
        for (int k = 0; k < 5; ++k) { const f32x4 a = *(const f32x4*)(cw + k * XBC + ch), b = *(const f32x4*)(cw + k * XBC + ch + 4); w[k][0] = a.x; w[k][1] = a.y; w[k][2] = a.z; w[k][3] = a.w; w[k][4] = b.x; w[k][5] = b.y; w[k][6] = b.z; w[k][7] = b.w; }
        { const f32x4 a = *(const f32x4*)(cb + ch), b = *(const f32x4*)(cb + ch + 4); bias[0] = a.x; bias[1] = a.y; bias[2] = a.z; bias[3] = a.w; bias[4] = b.x; bias[5] = b.y; bias[6] = b.z; bias[7] = b.w; }
        bf16* dst; int ldd, dc;
        if (ch < SSD_IN) { dst = XS; ldd = SSD_IN; dc = ch; } else if (ch < SSD_IN + 512) { dst = BMp; ldd = 512; dc = ch - SSD_IN; } else { dst = CMp; ldd = 512; dc = ch - SSD_IN - 512; }
        const v4u zero4 = {0u, 0u, 0u, 0u};
        v4u win[5];
        const bf16* src = xbc + (size_t)m0 * XBC + ch;
        win[0] = (tb - 2 >= 0) ? *(const v4u*)(src - 2 * XBC) : zero4;
        win[1] = (tb - 1 >= 0) ? *(const v4u*)(src - 1 * XBC) : zero4;
        win[2] = *(const v4u*)(src);
        win[3] = *(const v4u*)(src + XBC);
        for (int i = 0; i < RUN; ++i) {
            win[4] = (tb + i + 2 < T) ? *(const v4u*)(src + (size_t)(i + 2) * XBC) : zero4;
            float acc[8];
#pragma unroll
            for (int j = 0; j < 8; ++j) acc[j] = bias[j];
#pragma unroll
            for (int k = 0; k < 5; ++k) { float f[8]; unpack8(win[k], f);
#pragma unroll
                for (int j = 0; j < 8; ++j) acc[j] += w[k][j] * f[j]; }
#pragma unroll
            for (int j = 0; j < 8; ++j) acc[j] = acc[j] * __builtin_amdgcn_rcpf(1.0f + __expf(-acc[j]));
            v4u o; o.x = pk2(acc[0], acc[1]); o.y = pk2(acc[2], acc[3]); o.z = pk2(acc[4], acc[5]); o.w = pk2(acc[6], acc[7]);
            *(v4u*)(dst + (size_t)(m0 + i) * ldd + dc) = o;
            win[0] = win[1]; win[1] = win[2]; win[2] = win[3]; win[3] = win[4];
        }
    }
}

__device__ __forceinline__ void ssd_naive(Frame& F, int blk) {
    const int dir = blk & 1, h = (blk >> 1) % SSD_H, b = blk / (2 * SSD_H), g = h / 6;
    const float a = -__expf((dir ? F.in[5] : F.in[4])[h]);
    const bf16* XS = WSP(bf16, A_XS); const bf16* BMp = WSP(bf16, A_BM); const bf16* CMp = WSP(bf16, A_CM); const float* DT = WSP(float, A_DT);
    bf16* YO = dir ? WSP(bf16, A_YB) : WSP(bf16, A_YF);
    LAS float* Bs = (LAS float*)(F.lds); LAS float* Cs = Bs + 64 * 128; LAS float* Xs = Cs + 64 * 128; LAS float* Ys = Xs + 64 * 64; LAS float* Ds = Ys + 64 * 64;
    const int tid = F.tid, p = tid >> 3, nq = tid & 7;
    float hs[16];
#pragma unroll
    for (int i = 0; i < 16; ++i) hs[i] = 0.f;
    for (int c = 0; c < T / 64; ++c) {
        const int tbase = dir ? (T - 64 * (c + 1)) : 64 * c; const size_t mb = (size_t)b * T + tbase;
        { const int idx = tid * 16, row = idx >> 7, col = idx & 127;
          const v4u b0 = *(const v4u*)(BMp + (mb + row) * 512 + g * 128 + col), b1 = *(const v4u*)(BMp + (mb + row) * 512 + g * 128 + col + 8);
          const v4u c0 = *(const v4u*)(CMp + (mb + row) * 512 + g * 128 + col), c1 = *(const v4u*)(CMp + (mb + row) * 512 + g * 128 + col + 8);
          float f[8];
          unpack8(b0, f);
#pragma unroll
          for (int j = 0; j < 8; ++j) Bs[idx + j] = f[j];
          unpack8(b1, f);
#pragma unroll
          for (int j = 0; j < 8; ++j) Bs[idx + 8 + j] = f[j];
          unpack8(c0, f);
#pragma unroll
          for (int j = 0; j < 8; ++j) Cs[idx + j] = f[j];
          unpack8(c1, f);
#pragma unroll
          for (int j = 0; j < 8; ++j) Cs[idx + 8 + j] = f[j];
          const int xi = tid * 8, xr = xi >> 6, xc = xi & 63;
          const v4u x0 = *(const v4u*)(XS + (mb + xr) * SSD_IN + h * 64 + xc); unpack8(x0, f);
#pragma unroll
          for (int j = 0; j < 8; ++j) Xs[xi + j] = f[j];
          if (tid < 64) Ds[tid] = DT[(mb + tid) * 48 + dir * 24 + h]; }
        __syncthreads();
        for (int jj = 0; jj < 64; ++jj) {
            const int tl = dir ? 63 - jj : jj;
            const float dt = Ds[tl], da = __expf(dt * a), dtx = dt * Xs[tl * 64 + p];
            const LAS float* Bv = Bs + tl * 128 + nq * 16; const LAS float* Cv = Cs + tl * 128 + nq * 16;
            float acc = 0.f;
#pragma unroll
            for (int i = 0; i < 16; ++i) { hs[i] = hs[i] * da + dtx * Bv[i]; acc += hs[i] * Cv[i]; }
            acc += __shfl_xor(acc, 1); acc += __shfl_xor(acc, 2); acc += __shfl_xor(acc, 4);
            if (nq == 0) Ys[tl * 64 + p] = acc;
        }
        __syncthreads();
        { const int xi = tid * 8, xr = xi >> 6, xc = xi & 63; const LAS float* s = Ys + xi;
          v4u o; o.x = pk2(s[0], s[1]); o.y = pk2(s[2], s[3]); o.z = pk2(s[4], s[5]); o.w = pk2(s[6], s[7]);
          *(v4u*)(YO + (mb + xr) * SSD_IN + h * 64 + xc) = o; }
        __syncthreads();
    }
}
__device__ __forceinline__ float gelu_tanh(float x) { const float u = 0.7978845608028654f * (x + 0.044715f * x * x * x); const float e = __expf(2.f * u); const float th = 1.f - 2.f * __builtin_amdgcn_rcpf(e + 1.f); return 0.5f * x * (1.f + th); }
__device__ __forceinline__ void p4_combine(Frame& F) {
    const int gw = F.bid * NWAVES + F.wave, NGW = F.G * NWAVES, lane = F.lane;
    bf16* YF = WSP(bf16, A_YF); const bf16* YB = WSP(bf16, A_YB); const bf16* XS = WSP(bf16, A_XS); const bf16* Z = WSP(bf16, A_Z);
    const float* dsk = F.in[8]; const float* ng = F.in[9];
    for (int m = gw; m < M; m += NGW) {
#pragma unroll 1
        for (int gi = 0; gi < SSD_G; ++gi) {
            const int ch = gi * 384 + lane * 8; float y[8]; float ss = 0.f;
            if (lane < 48) {
                const size_t o = (size_t)m * SSD_IN + ch; float a[8], bb[8], x[8], z[8];
                unpack8(*(const v4u*)(YF + o), a); unpack8(*(const v4u*)(YB + o), bb); unpack8(*(const v4u*)(XS + o), x); unpack8(*(const v4u*)(Z + o), z);
                const float dk = dsk[ch >> 6];
#pragma unroll
                for (int j = 0; j < 8; ++j) { y[j] = (a[j] + bb[j] + x[j] * dk) * z[j]; ss += y[j] * y[j]; }
            }
            ss = wave_sum(ss);
            const float r = 1.0f / sqrtf(ss * (1.0f / 384.0f) + RMS_EPS);
            if (lane < 48) {
                const f32x4 g0 = *(const f32x4*)(ng + ch), g1 = *(const f32x4*)(ng + ch + 4);
                v4u o; o.x = pk2(y[0] * r * g0.x, y[1] * r * g0.y); o.y = pk2(y[2] * r * g0.z, y[3] * r * g0.w); o.z = pk2(y[4] * r * g1.x, y[5] * r * g1.y); o.w = pk2(y[6] * r * g1.z, y[7] * r * g1.w);
                *(v4u*)(YF + (size_t)m * SSD_IN + ch) = o;
            }
        }
    }
}

__device__ __forceinline__ void p8_ln_router(Frame& F) {
    const int gw = F.bid * NWAVES + F.wave, NGW = F.G * NWAVES, lane = F.lane;
    LAS float* wr = (LAS float*)F.lds;
    for (int i = F.tid; i < D * NE; i += NTHR) wr[(i & 15) * D + (i >> 4)] = F.in[27][i];
    __syncthreads();
    const float* HP = WSP(float, A_HP); float* H = WSP(float, A_H); bf16* HB = WSP(bf16, A_HB); float* AFF = WSP(float, A_AFF);
    const float* g1 = F.in[25]; const float* b1 = F.in[26];
    for (int m = gw; m < M; m += NGW) {
        const f32x4* xr = (const f32x4*)(HP + (size_t)m * D) + lane;
        f32x4 v[4]; float s = 0.f;
#pragma unroll
        for (int j = 0; j < 4; ++j) { v[j] = xr[64 * j]; s += (v[j].x + v[j].y) + (v[j].z + v[j].w); }
        const float mean = wave_sum(s) * (1.f / D); float s2 = 0.f;
#pragma unroll
        for (int j = 0; j < 4; ++j) { v[j] = v[j] - mean; s2 += (v[j].x * v[j].x + v[j].y * v[j].y) + (v[j].z * v[j].z + v[j].w * v[j].w); }
        const float rstd = 1.f / sqrtf(wave_sum(s2) * (1.f / D) + LN_EPS);
        float lg[16];
#pragma unroll
        for (int e = 0; e < 16; ++e) lg[e] = 0.f;
#pragma unroll
        for (int j = 0; j < 4; ++j) { const int c = 4 * lane + 256 * j; const f32x4 gg = *(const f32x4*)(g1 + c), bb = *(const f32x4*)(b1 + c);
            v[j] = v[j] * rstd * gg + bb;
            *((f32x4*)(H + (size_t)m * D) + lane + 64 * j) = v[j];
            v2u hb; hb.x = pk2(v[j].x, v[j].y); hb.y = pk2(v[j].z, v[j].w); *((v2u*)(HB + (size_t)m * D) + lane + 64 * j) = hb;
#pragma unroll
            for (int e = 0; e < 16; ++e) { const f32x4 w4 = *(const LAS f32x4*)(wr + e * D + c); lg[e] += (v[j].x * w4.x + v[j].y * w4.y) + (v[j].z * w4.z + v[j].w * w4.w); }
            asm volatile("" ::: "memory"); }
        { const bool hi = lane & 32;
#pragma unroll
          for (int k = 0; k < 8; ++k) { const float keep = hi ? lg[k + 8] : lg[k], send = hi ? lg[k] : lg[k + 8]; lg[k] = keep + __shfl_xor(send, 32); } }
        { const bool hi = lane & 16;
#pragma unroll
          for (int k = 0; k < 4; ++k) { const float keep = hi ? lg[k + 4] : lg[k], send = hi ? lg[k] : lg[k + 4]; lg[k] = keep + __shfl_xor(send, 16); } }
        { const bool hi = lane & 8;
#pragma unroll
          for (int k = 0; k < 2; ++k) { const float keep = hi ? lg[k + 2] : lg[k], send = hi ? lg[k] : lg[k + 2]; lg[k] = keep + __shfl_xor(send, 8); } }
        { const bool hi = lane & 4; const float keep = hi ? lg[1] : lg[0], send = hi ? lg[0] : lg[1]; lg[0] = keep + __shfl_xor(send, 4); }
        float lo = lg[0]; lo += __shfl_xor(lo, 2); lo += __shfl_xor(lo, 1);
        float mx = lo;
#pragma unroll
        for (int o = 4; o < 64; o <<= 1) mx = fmaxf(mx, __shfl_xor(mx, o));
        const float ex = expf(lo - mx); float sum = ex;
#pragma unroll
        for (int o = 4; o < 64; o <<= 1) sum += __shfl_xor(sum, o);
        if ((lane & 3) == 0) { const int e = lane >> 2, b = m / T, t = m % T; AFF[((size_t)b * NE + e) * T + t] = ex / sum; }
    }
}

__device__ __forceinline__ unsigned block_excl_scan(unsigned v, LAS unsigned* wsum  , int lane, int wave, unsigned& total) {
    unsigned inc = v;
#pragma unroll
    for (int o = 1; o < 64; o <<= 1) { const unsigned t = __shfl_up(inc, o); if (lane >= o) inc += t; }
    __syncthreads();
    if (lane == 63) wsum[wave] = inc;
    __syncthreads();
    unsigned off = 0, tot = 0;
#pragma unroll
    for (int w = 0; w < 8; ++w) { const unsigned s = wsum[w]; if (w < wave) off += s; tot += s; }
    total = tot; return off + inc - v;
}
__device__ __forceinline__ void p9_topk(Frame& F, int be) {
    const int b = be >> 4, e = be & 15, tid = F.tid;
    const float* av = WSP(float, A_AFF) + (size_t)be * T;
    int* IDX = WSP(int, A_IDX); int* SEL = WSP(int, A_SEL); float* GATE = WSP(float, A_GATE);
    LAS unsigned* hist = (LAS unsigned*)F.lds; LAS unsigned* shv = hist + 256; LAS unsigned* wsum = hist + 272;
    unsigned key[16];
#pragma unroll
    for (int q = 0; q < 4; ++q) { const v4u k4 = *(const v4u*)(av + tid * 16 + 4 * q); key[4 * q] = k4.x; key[4 * q + 1] = k4.y; key[4 * q + 2] = k4.z; key[4 * q + 3] = k4.w; }
    unsigned prefix = 0, pmask = 0, krem = CAP;
    for (int pass = 0; pass < 4; ++pass) {
        const int shift = 24 - 8 * pass;
        if (tid < 256) hist[tid] = 0u;
        __syncthreads();
#pragma unroll
        for (int i = 0; i < 16; ++i) if ((key[i] & pmask) == prefix) (void)__hip_atomic_fetch_add(&hist[(key[i] >> shift) & 255u], 1u, __ATOMIC_RELAXED, __HIP_MEMORY_SCOPE_WORKGROUP);
        __syncthreads();
        if (tid < 256) { unsigned above = 0; for (int d = tid + 1; d < 256; ++d) above += hist[d]; const unsigned mine = hist[tid];
            if (above < krem && krem <= above + mine) { shv[0] = (unsigned)tid; shv[1] = krem - above; } }
        __syncthreads();
        prefix |= shv[0] << shift; pmask |= 255u << shift; krem = shv[1];
        __syncthreads();
    }
    const unsigned Tk = prefix;
    unsigned cg = 0, ce = 0;
#pragma unroll
    for (int i = 0; i < 16; ++i) { cg += key[i] > Tk; ce += key[i] == Tk; }
    unsigned totg, tote;
    unsigned pg = block_excl_scan(cg, wsum, F.lane, F.wave, totg);
    unsigned pe = block_excl_scan(ce, wsum + 8, F.lane, F.wave, tote);
#pragma unroll
    for (int i = 0; i < 16; ++i) {
        const int t = tid * 16 + i; int slot = -1;
        if (key[i] > Tk) slot = (int)(pg++);
        else if (key[i] == Tk) { if (pe < krem) slot = (int)(totg + pe); ++pe; }
        const size_t m = (size_t)b * T + t;
        SEL[m * NE + e] = slot; GATE[m * NE + e] = __uint_as_float(key[i]);
        if (slot >= 0) IDX[(e * NB + b) * CAP + slot] = (int)m;
    }
}
__device__ __forceinline__ void p10_gather(Frame& F) {
    const int gw = F.bid * NWAVES + F.wave, NGW = F.G * NWAVES, lane = F.lane;
    const int* IDX = WSP(int, A_IDX); const bf16* HB = WSP(bf16, A_HB); bf16* XIN = WSP(bf16, A_XIN);
    for (int r = gw; r < MROWS; r += NGW) { const int m = IDX[r];
        const v4u* s = (const v4u*)(HB + (size_t)m * D); v4u* d = (v4u*)(XIN + (size_t)r * D);
        const v4u a = s[lane], bq = s[lane + 64]; d[lane] = a; d[lane + 64] = bq; }
}
__device__ __forceinline__ void p13_final(Frame& F) {
    const int gw = F.bid * NWAVES + F.wave, NGW = F.G * NWAVES, lane = F.lane;
    const float* H = WSP(float, A_H); const int* SEL = WSP(int, A_SEL); const float* GATE = WSP(float, A_GATE); const bf16* YE = WSP(bf16, A_YE);
    const float* g2 = F.in[31]; const float* b2 = F.in[32];
    for (int m = gw; m < M; m += NGW) {
        const int b = m / T;
        const int sl = SEL[(size_t)m * NE + (lane & 15)]; const float gt = GATE[(size_t)m * NE + (lane & 15)];
        f32x4 v[4];
#pragma unroll
        for (int j = 0; j < 4; ++j) v[j] = *((const f32x4*)(H + (size_t)m * D) + lane + 64 * j) * ALPHA;
#pragma unroll 1
        for (int e = 0; e < NE; ++e) {
            const int s = __shfl(sl, e); const float gv = __shfl(gt, e);
            if (s >= 0) { const bf16* yr = YE + ((size_t)(e * NB + b) * CAP + s) * D;
#pragma unroll
                for (int j = 0; j < 4; ++j) { const v2u w = *((const v2u*)yr + lane + 64 * j); v[j].x += gv * bflo(w.x); v[j].y += gv * bfhi(w.x); v[j].z += gv * bflo(w.y); v[j].w += gv * bfhi(w.y); } }
        }
        float s = 0.f;
#pragma unroll
        for (int j = 0; j < 4; ++j) s += (v[j].x + v[j].y) + (v[j].z + v[j].w);
        const float mean = wave_sum(s) * (1.f / D); float s2 = 0.f;
#pragma unroll
        for (int j = 0; j < 4; ++j) { v[j] = v[j] - mean; s2 += (v[j].x * v[j].x + v[j].y * v[j].y) + (v[j].z * v[j].z + v[j].w * v[j].w); }
        const float rstd = 1.f / sqrtf(wave_sum(s2) * (1.f / D) + LN_EPS);
#pragma unroll
        for (int j = 0; j < 4; ++j) { const int c = 4 * lane + 256 * j; const f32x4 gg = *(const f32x4*)(g2 + c), bb = *(const f32x4*)(b2 + c);
            *((f32x4*)(F.out + (size_t)m * D) + lane + 64 * j) = v[j] * rstd * gg + bb; }
    }
}

constexpr int N_PHASES = 16;
struct Args { const float* in[33]; float* out; unsigned char* ws; int ph_lo, ph_hi; };
__global__ void __launch_bounds__(NTHR, 2) fwd(Args args) {
    extern __shared__ __attribute__((aligned(16))) unsigned char lds[];
    Frame F;
    F.lds = (LAS unsigned char*)lds;
    F.tid = threadIdx.x; F.lane = F.tid & 63; F.wave = __builtin_amdgcn_readfirstlane(F.tid >> 6);
    F.bid = blockIdx.x; F.G = gridDim.x;
    F.in = args.in;
    F.out = args.out; F.ws = args.ws;
    volatile LAS unsigned* MISC = (volatile LAS unsigned*)(F.lds + MISC_OFF);
    if (F.tid < 64) MISC[F.tid] = 0u;
    __syncthreads();
    const int lo = args.ph_lo, hi = args.ph_hi;
    const bool single = (hi - lo) > 1;
    XcdBarrier bar; bar.bar = (unsigned*)(F.ws + WS_CTL) + CW_BAR; bar.x = 0; bar.st = nullptr;
    if (single) bar = xcd_barrier_post((unsigned*)(F.ws + WS_CTL) + CW_BAR, MISC + 8);
#ifndef PH_MASK
#define PH_MASK 0xffff
#endif
#define IN(k) (((PH_MASK >> (k)) & 1) && lo <= (k) && (k) < hi)
#define SEAM(k) do { if (IN(k) && IN((k) + 1)) xcd_barrier(bar); } while (0)

    if (IN(0)) { p0_prologue(F); p0_s5(F); } SEAM(0);
    if (IN(1)) {
        pg8::Gemm g{WSP(pg8::bf16_t, A_XB), WSP(pg8::bf16_t, WS_WIN), M, NIN_PAD, D, D, D}; pg8::StaticOrder S; S.init(M, NIN_PAD, F.G, F.bid);
        pg8::EpiIn E{WSP(pg8::bf16_t, A_Z), WSP(pg8::bf16_t, A_XBC), WSP(pg8::bf16_t, A_UC), WSP(pg8::bf16_t, A_GT), WSP(float, A_DT), F.in[6], F.in[7]};
        pg8::gemm_phase<pg8::EpiIn, pg8::StaticOrder, PG8_ALIGN, PG8_SP2>(F.lds, g, S, E);
    } SEAM(1);
    if (IN(2)) { p2_conv(F); } SEAM(2);
    if (IN(3)) {
        if (F.bid < 96) ssd_naive(F, F.bid);
        else { pg8::Gemm g{WSP(pg8::bf16_t, A_UC), WSP(pg8::bf16_t, WS_WS5), S5_G * 512, S5_G * 256, 512, 768, 512}; pg8::S5aOrder S{F.bid, 96};
            pg8::EpiS5a E{WSP(float, WS_SLOC)};
            pg8::gemm_phase<pg8::EpiS5a, pg8::S5aOrder, PG8_ALIGN, PG8_SP2>(F.lds, g, S, E); }
    } SEAM(3);
    if (IN(4)) { for (int it = F.bid; it < S5_G * 4; it += F.G) s5_scan_item(F, it); } SEAM(4);
    if (IN(5)) {
        pg8::Gemm g{WSP(pg8::bf16_t, A_UC), WSP(pg8::bf16_t, WS_TV), S5_G * 512, S5_G * 512, 768, 768, 768}; pg8::S5cOrder S{F.G, F.bid};
        pg8::EpiS5c E{WSP(pg8::bf16_t, A_GY), WSP(pg8::bf16_t, A_UC), F.in[21]};
        pg8::gemm_phase<pg8::EpiS5c, pg8::S5cOrder, PG8_ALIGN, PG8_SP2>(F.lds, g, S, E);
    } SEAM(5);
    if (IN(6)) { p4_combine(F); } SEAM(6);
    if (IN(7)) {
        pg8::Gemm g{WSP(pg8::bf16_t, A_YF), WSP(pg8::bf16_t, WS_WOUT), M, D, SSD_IN, SSD_IN, SSD_IN}; pg8::StaticOrder S; S.init(M, D, F.G, F.bid);
        pg8::EpiSsdOut E{WSP(float, A_YA), WSP(pg8::bf16_t, A_GT)};
        pg8::gemm_phase<pg8::EpiSsdOut, pg8::StaticOrder, PG8_ALIGN, PG8_SP2>(F.lds, g, S, E);
    } SEAM(7);
    if (IN(8)) {
        pg8::Gemm g{WSP(pg8::bf16_t, A_GY), WSP(pg8::bf16_t, WS_WGLU), M, 2 * D, S5_W, S5_W, S5_W}; pg8::StaticOrder S; S.init(M, 2 * D, F.G, F.bid);
        pg8::EpiGlu E{WSP(pg8::bf16_t, A_MIX), WSP(float, A_YA), WSP(pg8::bf16_t, A_GT)};
        pg8::gemm_phase<pg8::EpiGlu, pg8::StaticOrder, PG8_ALIGN, PG8_SP2>(F.lds, g, S, E);
    } SEAM(8);
    if (IN(9)) {
        pg8::Gemm g{WSP(pg8::bf16_t, A_MIX), WSP(pg8::bf16_t, WS_WO), M, D, D, D, D}; pg8::StaticOrder S; S.init(M, D, F.G, F.bid);
        pg8::EpiWo E{WSP(float, A_HP), F.in[0], ALPHA};
        pg8::gemm_phase<pg8::EpiWo, pg8::StaticOrder, PG8_ALIGN, PG8_SP2>(F.lds, g, S, E);
    } SEAM(9);
    if (IN(10)) { p8_ln_router(F); } SEAM(10);
    if (IN(11)) { if (F.bid < NB * NE) p9_topk(F, F.bid); else w2_convert(F, (F.bid - NB * NE) * NWAVES + F.wave, (F.G - NB * NE) * NWAVES); } SEAM(11);
    if (IN(12)) { p10_gather(F); } SEAM(12);
    if (IN(13)) {
        pg8::Gemm g{WSP(pg8::bf16_t, A_XIN), WSP(pg8::bf16_t, WS_W1), MROWS, NE * 2 * FF, D, D, D}; pg8::MoeOrder1 S{F.G, F.bid};
        pg8::EpiMoe1 E{WSP(pg8::bf16_t, A_HID)};
        pg8::gemm_phase<pg8::EpiMoe1, pg8::MoeOrder1, PG8_ALIGN, PG8_SP2>(F.lds, g, S, E);
    } SEAM(13);
    if (IN(14)) {
        pg8::Gemm g{WSP(pg8::bf16_t, A_HID), WSP(pg8::bf16_t, WS_W2), MROWS, NE * D, FF, FF, FF}; pg8::MoeOrder2 S{F.G, F.bid};
        pg8::EpiMoe2 E{WSP(pg8::bf16_t, A_YE)};
        pg8::gemm_phase<pg8::EpiMoe2, pg8::MoeOrder2, PG8_ALIGN, PG8_SP2>(F.lds, g, S, E);
    } SEAM(14);
    if (IN(15)) { p13_final(F); }
#undef IN
#undef SEAM
}

#ifndef MK_ONE_LAUNCH
#define MK_ONE_LAUNCH 1
#endif
extern "C" void kernel_launch(void* const* d_in, const int* in_sizes, int n_in, void* d_out, int out_size, void* d_ws, size_t ws_size, hipStream_t stream) {
    static int grid = 0;
    if (grid == 0) {
        if (n_in != 33 || in_sizes[0] != M * D || out_size != M * D || ws_size < WS_END) { fprintf(stderr, "kernel_launch: unexpected problem (n_in %d, in0 %d, out %d, ws %zu < %zu)\n", n_in, n_in > 0 ? in_sizes[0] : -1, out_size, ws_size, (size_t)WS_END); grid = -1; return; }
        int dev = 0, cus = 0, per_cu = 0;
        if (hipGetDevice(&dev) != hipSuccess || hipDeviceGetAttribute(&cus, hipDeviceAttributeMultiprocessorCount, dev) != hipSuccess) { grid = -1; return; }
        if (hipFuncSetAttribute((const void*)fwd, hipFuncAttributeMaxDynamicSharedMemorySize, LDS_BYTES) != hipSuccess) { fprintf(stderr, "kernel_launch: hipFuncSetAttribute failed\n"); grid = -1; return; }
        if (hipOccupancyMaxActiveBlocksPerMultiprocessor(&per_cu, (const void*)fwd, NTHR, LDS_BYTES) != hipSuccess || per_cu < 1) fprintf(stderr, "kernel_launch: occupancy query reports %d blocks per CU\n", per_cu);
        (void)hipGetLastError();
        grid = cus;
    }
    if (grid < 0) return;
    (void)hipMemsetAsync((char*)d_ws + WS_CTL, 0, CTL_ZERO_BYTES, stream);
    Args a{};
    for (int i = 0; i < 33; ++i) a.in[i] = (const float*)d_in[i];
    a.out = (float*)d_out; a.ws = (unsigned char*)d_ws;
#if MK_ONE_LAUNCH
    a.ph_lo = 0; a.ph_hi = N_PHASES;
    hipLaunchKernelGGL(fwd, dim3(grid), dim3(NTHR), LDS_BYTES, stream, a);
#else
    for (int p = 0; p < N_PHASES; ++p) { a.ph_lo = p; a.ph_hi = p + 1; hipLaunchKernelGGL(fwd, dim3(grid), dim3(NTHR), LDS_BYTES, stream, a); }
#endif
}
```

```cpp
#include <hip/hip_runtime.h>
#include <cstdio>
#include <cstdint>
namespace pg8 {
#define PG8_LAS __attribute__((address_space(3)))
typedef unsigned short bf16_t;
typedef short bf16x8 __attribute__((ext_vector_type(8)));
typedef float f32x4 __attribute__((ext_vector_type(4)));
typedef unsigned u32x4 __attribute__((ext_vector_type(4)));
constexpr int BM = 256, BK = 64, HALF = 128, HTB = HALF * BK * 2  , STAGE_BYTES = 8 * HTB, NXCD = 8, WGM = 8;

__host__ __device__ __forceinline__ int lds_byte(int r, int c) { const int st = (r >> 4) * 2 + (c >> 5), rr = r & 15, cc = c & 31, ob = rr * 64 + cc * 2; return st * 1024 + (ob ^ (((ob >> 9) & 1) << 5)); }
__host__ __device__ __forceinline__ void stage_rc(int b, int& R, int& C) { const int st = b / 1024, sb = b % 1024, swz = sb ^ (((sb >> 9) & 1) << 5); R = (st >> 1) * 16 + swz / 64; C = (st & 1) * 32 + (swz % 64) / 2; }
__host__ __device__ __forceinline__ int perm32(int rho) { const int n = rho >> 4, i = rho & 15; return 8 * (i >> 2) + 4 * n + (i & 3); }

struct Unit { int pm, pn; };
struct Gemm { const bf16_t* A; const bf16_t* Bt; int M, N, K, lda, ldb; };

struct StaticOrder {
    int nM, nN, nwg, G, c;
    __host__ __device__ void init(int M, int N, int G_, int c_) { nM = M / BM; nN = N / BM; nwg = nM * nN; G = G_; c = c_; }
    __host__ __device__ bool next(int i, Unit& u) const {
        const long L = (long)i * G + c; if (L >= nwg) return false;
        int wgid = (int)L; { const int q = nwg / NXCD, r = nwg % NXCD, xcd = wgid % NXCD, off = wgid / NXCD; wgid = (xcd < r ? xcd * (q + 1) : r * (q + 1) + (xcd - r) * q) + off; }
        const int nig = WGM * nN, gid = wgid / nig, fm = gid * WGM, gsz = (nM - fm) < WGM ? (nM - fm) : WGM;
        u.pm = fm + ((wgid % nig) % gsz); u.pn = (wgid % nig) / gsz; return true;
    }
    __device__ __forceinline__ void a_ready(const Unit&) const {}
    __device__ __forceinline__ void done(const Unit&) const {}
};

typedef __bf16 bf16v2_t __attribute__((ext_vector_type(2)));
typedef float f32v2_t __attribute__((ext_vector_type(2)));
__device__ __forceinline__ unsigned cvt_pk_bf16(float lo, float hi) { const f32v2_t f = {lo, hi}; return __builtin_bit_cast(unsigned, __builtin_convertvector(f, bf16v2_t)); }
typedef float f32x2 __attribute__((ext_vector_type(2)));
__device__ __forceinline__ f32x2 gelu_pk(f32x2 v) {
    const f32x2 av = __builtin_elementwise_abs(v), d = av * 0.2316418882f + 1.0f;
    f32x2 t; t.x = __builtin_amdgcn_rcpf(d.x); t.y = __builtin_amdgcn_rcpf(d.y);
    f32x2 q = t * 0.5307027145f + (-0.7265760135f); q = q * t + 0.7107068705f; q = q * t + (-0.142248368f); q = q * t + 0.127414796f; q = q * t;
    const f32x2 s = (v * v) * (-0.72134752044f);
    f32x2 e; e.x = __builtin_amdgcn_exp2f(s.x); e.y = __builtin_amdgcn_exp2f(s.y);
    const f32x2 m = v * (q * e), r = v - m;
    f32x2 o; o.x = v.x < 0.f ? m.x : r.x; o.y = v.y < 0.f ? m.y : r.y; return o;
}


__device__ __forceinline__ float fsigmoid(float x) { return __builtin_amdgcn_rcpf(1.0f + __expf(-x)); }
__device__ __forceinline__ float fsilu(float x) { return x * fsigmoid(x); }
__device__ __forceinline__ float bf_lo(unsigned w) { return __uint_as_float(w << 16); }
__device__ __forceinline__ float bf_hi(unsigned w) { return __uint_as_float(w & 0xffff0000u); }
typedef unsigned u32x2 __attribute__((ext_vector_type(2)));

struct EpiIn {
    static constexpr bool PERM = true, AFTER_DRAIN = false;
    bf16_t *Z, *XBC, *UC, *GT; float* DT; const float *dtb_f, *dtb_b;
    __device__ __forceinline__ void operator()(const f32x4 (&acc)[2][2][4][2], const Unit& u, int wr, int wc, int fr, int fq) const {
        const int row0 = u.pm * BM + wr * 64 + fr; const int pn = u.pn;
        if (pn == 16) {
            if (wc < 2) {
#pragma unroll
                for (int n = 0; n < 2; ++n) { const int col = wc * 32 + 8 * fq + 4 * n;
                    if (col < 48) { f32x4 bv;
#pragma unroll
                        for (int j = 0; j < 4; ++j) { const int cc = col + j; bv[j] = cc < 24 ? dtb_f[cc] : dtb_b[cc - 24]; }
#pragma unroll
                        for (int ai = 0; ai < 2; ++ai)
#pragma unroll
                            for (int m = 0; m < 4; ++m) { f32x4 v = acc[ai][0][m][n] + bv;
#pragma unroll
                                for (int j = 0; j < 4; ++j) { const float x = v[j]; v[j] = fmaxf(x, 0.f) + log1pf(__expf(-fabsf(x))); }
                                *(f32x4*)(DT + (size_t)(row0 + ai * HALF + m * 16) * 48 + col) = v; } } }
            }
            return;
        }
        int mode, ldc, colt; bf16_t* base;
        if (pn < 6) { mode = 1; base = Z; ldc = 1536; colt = pn * BM; }
        else if (pn < 16) { mode = 0; base = XBC; ldc = 2560; colt = (pn - 6) * BM; }
        else if (pn < 20) {
            const int uc = (pn - 17) * BM + wc * 32 + 8 * fq, g0 = uc >> 4, j0 = uc & 15;
#pragma unroll
            for (int ai = 0; ai < 2; ++ai)
#pragma unroll
                for (int m = 0; m < 4; ++m) { const int r = row0 + ai * HALF + m * 16, cl = r >> 5, s = r & 31;
#pragma unroll
                    for (int bj = 0; bj < 2; ++bj) { const f32x4 v0 = acc[ai][bj][m][0], v1 = acc[ai][bj][m][1];
                        u32x4 w; w.x = cvt_pk_bf16(v0[0], v0[1]); w.y = cvt_pk_bf16(v0[2], v0[3]); w.z = cvt_pk_bf16(v1[0], v1[1]); w.w = cvt_pk_bf16(v1[2], v1[3]);
                        *(u32x4*)(UC + ((size_t)((g0 + 8 * bj) * 512 + cl) * 768 + s * 16 + j0)) = w; } }
            return; }
        else { mode = 2; base = GT; ldc = 2048; colt = (pn - 20) * BM; }
        const int col0 = colt + wc * 32 + 8 * fq;
#pragma unroll
        for (int ai = 0; ai < 2; ++ai)
#pragma unroll
            for (int m = 0; m < 4; ++m) { bf16_t* rowp = base + (size_t)(row0 + ai * HALF + m * 16) * ldc + col0;
#pragma unroll
                for (int bj = 0; bj < 2; ++bj) { f32x4 v0 = acc[ai][bj][m][0], v1 = acc[ai][bj][m][1];
                    if (mode == 1) {
#pragma unroll
                        for (int j = 0; j < 4; ++j) { v0[j] = fsilu(v0[j]); v1[j] = fsilu(v1[j]); } }
                    else if (mode == 2) {
#pragma unroll
                        for (int j = 0; j < 4; ++j) { v0[j] = fsigmoid(v0[j]); v1[j] = fsigmoid(v1[j]); } }
                    u32x4 w; w.x = cvt_pk_bf16(v0[0], v0[1]); w.y = cvt_pk_bf16(v0[2], v0[3]); w.z = cvt_pk_bf16(v1[0], v1[1]); w.w = cvt_pk_bf16(v1[2], v1[3]);
                    *(u32x4*)(rowp + bj * HALF) = w; } }
    }
};
struct EpiSsdOut {
    static constexpr bool PERM = false, AFTER_DRAIN = false;
    float* YA; const bf16_t* GT;
    __device__ __forceinline__ void operator()(const f32x4 (&acc)[2][2][4][2], const Unit& u, int wr, int wc, int fr, int fq) const {
        const int row0 = u.pm * BM + wr * 64 + fr, col0 = u.pn * BM + wc * 32 + 4 * fq;
#pragma unroll
        for (int ai = 0; ai < 2; ++ai)
#pragma unroll
            for (int m = 0; m < 4; ++m) { const size_t r = (size_t)(row0 + ai * HALF + m * 16);
#pragma unroll
                for (int bj = 0; bj < 2; ++bj)
#pragma unroll
                    for (int n = 0; n < 2; ++n) { const int c = col0 + bj * HALF + n * 16; const u32x2 g = *(const u32x2*)(GT + r * 2048 + c);
                        f32x4 v = acc[ai][bj][m][n]; v[0] *= bf_lo(g.x); v[1] *= bf_hi(g.x); v[2] *= bf_lo(g.y); v[3] *= bf_hi(g.y);
                        *(f32x4*)(YA + r * 1024 + c) = v; } }
    }
};
struct EpiGlu {
    static constexpr bool PERM = true, AFTER_DRAIN = false;
    bf16_t* MIX; const float* YA; const bf16_t* GT;
    __device__ __forceinline__ void operator()(const f32x4 (&acc)[2][2][4][2], const Unit& u, int wr, int wc, int fr, int fq) const {
        const int row0 = u.pm * BM + wr * 64 + fr, col0 = u.pn * HALF + wc * 32 + 8 * fq;
#pragma unroll
        for (int ai = 0; ai < 2; ++ai)
#pragma unroll
            for (int m = 0; m < 4; ++m) { const size_t r = (size_t)(row0 + ai * HALF + m * 16);
                const u32x4 g = *(const u32x4*)(GT + r * 2048 + 1024 + col0); const f32x4 y0 = *(const f32x4*)(YA + r * 1024 + col0), y1 = *(const f32x4*)(YA + r * 1024 + col0 + 4);
                f32x4 a0 = acc[ai][0][m][0], a1 = acc[ai][0][m][1]; const f32x4 b0 = acc[ai][1][m][0], b1 = acc[ai][1][m][1];
#pragma unroll
                for (int j = 0; j < 4; ++j) { a0[j] *= fsigmoid(b0[j]); a1[j] *= fsigmoid(b1[j]); }
                a0[0] = a0[0] * bf_lo(g.x) + y0[0]; a0[1] = a0[1] * bf_hi(g.x) + y0[1]; a0[2] = a0[2] * bf_lo(g.y) + y0[2]; a0[3] = a0[3] * bf_hi(g.y) + y0[3];
                a1[0] = a1[0] * bf_lo(g.z) + y1[0]; a1[1] = a1[1] * bf_hi(g.z) + y1[1]; a1[2] = a1[2] * bf_lo(g.w) + y1[2]; a1[3] = a1[3] * bf_hi(g.w) + y1[3];
                u32x4 w; w.x = cvt_pk_bf16(a0[0], a0[1]); w.y = cvt_pk_bf16(a0[2], a0[3]); w.z = cvt_pk_bf16(a1[0], a1[1]); w.w = cvt_pk_bf16(a1[2], a1[3]);
                *(u32x4*)(MIX + r * 1024 + col0) = w; }
    }
};
struct EpiWo {
    static constexpr bool PERM = false, AFTER_DRAIN = false;
    float* HP; const float* X; float alpha;
    __device__ __forceinline__ void operator()(const f32x4 (&acc)[2][2][4][2], const Unit& u, int wr, int wc, int fr, int fq) const {
        const int row0 = u.pm * BM + wr * 64 + fr, col0 = u.pn * BM + wc * 32 + 4 * fq;
#pragma unroll
        for (int ai = 0; ai < 2; ++ai)
#pragma unroll
            for (int m = 0; m < 4; ++m) { const size_t r = (size_t)(row0 + ai * HALF + m * 16);
#pragma unroll
                for (int bj = 0; bj < 2; ++bj)
#pragma unroll
                    for (int n = 0; n < 2; ++n) { const int c = col0 + bj * HALF + n * 16; const f32x4 xv = *(const f32x4*)(X + r * 1024 + c);
                        *(f32x4*)(HP + r * 1024 + c) = acc[ai][bj][m][n] + xv * alpha; } }
    }
};
struct EpiMoe1 {
    static constexpr bool PERM = true, AFTER_DRAIN = false;
    bf16_t* HID;
    __device__ __forceinline__ void operator()(const f32x4 (&acc)[2][2][4][2], const Unit& u, int wr, int wc, int fr, int fq) const {
        const int row0 = u.pm * BM + wr * 64 + fr, col0 = (u.pn % 22) * HALF + wc * 32 + 8 * fq;
#pragma unroll
        for (int ai = 0; ai < 2; ++ai)
#pragma unroll
            for (int m = 0; m < 4; ++m) { const size_t r = (size_t)(row0 + ai * HALF + m * 16);
                f32x4 a0 = acc[ai][0][m][0], a1 = acc[ai][0][m][1]; const f32x4 b0 = acc[ai][1][m][0], b1 = acc[ai][1][m][1];
#pragma unroll
                for (int j = 0; j < 4; ++j) { a0[j] = fsilu(a0[j]) * b0[j]; a1[j] = fsilu(a1[j]) * b1[j]; }
                u32x4 w; w.x = cvt_pk_bf16(a0[0], a0[1]); w.y = cvt_pk_bf16(a0[2], a0[3]); w.z = cvt_pk_bf16(a1[0], a1[1]); w.w = cvt_pk_bf16(a1[2], a1[3]);
                *(u32x4*)(HID + r * 2816 + col0) = w; }
    }
};
struct EpiMoe2 {
    static constexpr bool PERM = true, AFTER_DRAIN = false;
    bf16_t* Y;
    __device__ __forceinline__ void operator()(const f32x4 (&acc)[2][2][4][2], const Unit& u, int wr, int wc, int fr, int fq) const {
        const int row0 = u.pm * BM + wr * 64 + fr, col0 = (u.pn & 3) * BM + wc * 32 + 8 * fq;
#pragma unroll
        for (int ai = 0; ai < 2; ++ai)
#pragma unroll
            for (int m = 0; m < 4; ++m) { bf16_t* rowp = Y + (size_t)(row0 + ai * HALF + m * 16) * 1024 + col0;
#pragma unroll
                for (int bj = 0; bj < 2; ++bj) { const f32x4 v0 = acc[ai][bj][m][0], v1 = acc[ai][bj][m][1];
                    u32x4 w; w.x = cvt_pk_bf16(v0[0], v0[1]); w.y = cvt_pk_bf16(v0[2], v0[3]); w.z = cvt_pk_bf16(v1[0], v1[1]); w.w = cvt_pk_bf16(v1[2], v1[3]);
                    *(u32x4*)(rowp + bj * HALF) = w; } }
    }
};

struct EpiS5a {
    static constexpr bool PERM = false, AFTER_DRAIN = false;
    float* SLOC;
    __device__ __forceinline__ void operator()(const f32x4 (&acc)[2][2][4][2], const Unit& u, int wr, int wc, int fr, int fq) const {
        const int row0 = u.pm * BM + wr * 64 + fr, col0 = wc * 32 + 4 * fq;
#pragma unroll
        for (int ai = 0; ai < 2; ++ai)
#pragma unroll
            for (int m = 0; m < 4; ++m) { float* rowp = SLOC + (size_t)(row0 + ai * HALF + m * 16) * 256 + col0;
#pragma unroll
                for (int bj = 0; bj < 2; ++bj)
#pragma unroll
                    for (int n = 0; n < 2; ++n) *(f32x4*)(rowp + bj * HALF + n * 16) = acc[ai][bj][m][n]; }
    }
};
__device__ __forceinline__ float gelu_tanh_f(float x) { const float uu = 0.7978845608028654f * (x + 0.044715f * x * x * x); const float e = __expf(2.f * uu); return 0.5f * x * (2.f - 2.f * __builtin_amdgcn_rcpf(e + 1.f)); }
struct EpiS5c {
    static constexpr bool PERM = true, AFTER_DRAIN = false;
    bf16_t* GY; const bf16_t* UC; const float* d5;
    __device__ __forceinline__ void operator()(const f32x4 (&acc)[2][2][4][2], const Unit& u, int wr, int wc, int fr, int fq) const {
        const int g = u.pm >> 1, cl0 = (u.pm & 1) * BM + wr * 64 + fr, nl0 = (u.pn & 1) * BM + wc * 32 + 8 * fq;
        const int k0 = nl0 & 15; const f32x4 d0 = *(const f32x4*)(d5 + g * 16 + k0), d1 = *(const f32x4*)(d5 + g * 16 + k0 + 4);
#pragma unroll
        for (int ai = 0; ai < 2; ++ai)
#pragma unroll
            for (int m = 0; m < 4; ++m) { const int cl = cl0 + ai * HALF + m * 16;
#pragma unroll
                for (int bj = 0; bj < 2; ++bj) { const int nl = nl0 + bj * HALF, t = nl >> 4;
                    const u32x4 uw = *(const u32x4*)(UC + ((size_t)(g * 512 + cl) * 768 + nl));
                    f32x4 v0 = acc[ai][bj][m][0], v1 = acc[ai][bj][m][1];
                    v0[0] += bf_lo(uw.x) * d0[0]; v0[1] += bf_hi(uw.x) * d0[1]; v0[2] += bf_lo(uw.y) * d0[2]; v0[3] += bf_hi(uw.y) * d0[3];
                    v1[0] += bf_lo(uw.z) * d1[0]; v1[1] += bf_hi(uw.z) * d1[1]; v1[2] += bf_lo(uw.w) * d1[2]; v1[3] += bf_hi(uw.w) * d1[3];
#pragma unroll
                    for (int j = 0; j < 4; ++j) { v0[j] = gelu_tanh_f(v0[j]); v1[j] = gelu_tanh_f(v1[j]); }
                    u32x4 w; w.x = cvt_pk_bf16(v0[0], v0[1]); w.y = cvt_pk_bf16(v0[2], v0[3]); w.z = cvt_pk_bf16(v1[0], v1[1]); w.w = cvt_pk_bf16(v1[2], v1[3]);
                    *(u32x4*)(GY + (size_t)(cl * 32 + t) * 768 + g * 16 + k0) = w; } }
    }
};
struct S5aOrder {
    int c, lo;
    __device__ __forceinline__ bool next(int i, Unit& u) const { if (i > 0 || c < lo || c >= lo + 96) return false; u.pm = c - lo; u.pn = (c - lo) >> 1; return true; }
    __device__ __forceinline__ void a_ready(const Unit&) const {}
    __device__ __forceinline__ void done(const Unit&) const {}
};
struct S5cOrder {
    int G, c;
    __device__ __forceinline__ bool next(int i, Unit& u) const { const int L = i * G + c; if (L >= 192) return false; const int g = L >> 2; u.pm = 2 * g + (L & 1); u.pn = 2 * g + ((L >> 1) & 1); return true; }
    __device__ __forceinline__ void a_ready(const Unit&) const {}
    __device__ __forceinline__ void done(const Unit&) const {}
};
struct MoeOrder1 {
    int G, c;
    __device__ __forceinline__ bool next(int i, Unit& u) const {
        if (G == 256) { if (i >= 11) return false; const int x = c & 7, j = c >> 3, q = x * 44 + i * 4 + (j >> 3); u.pm = (q / 22) * 8 + (j & 7); u.pn = q; return true; }
        const long L = (long)i * G + c; if (L >= 2816) return false; const int e = (int)(L / 176), r = (int)(L % 176); u.pm = e * 8 + (r & 7); u.pn = e * 22 + (r >> 3); return true;
    }
    __device__ __forceinline__ void a_ready(const Unit&) const {}
    __device__ __forceinline__ void done(const Unit&) const {}
};
struct MoeOrder2 {
    int G, c;
    __device__ __forceinline__ bool next(int i, Unit& u) const {
        if (G == 256) { if (i >= 2) return false; const int x = c & 7, j = c >> 3, e = 2 * x + i; u.pm = e * 8 + (j & 7); u.pn = e * 4 + (j >> 3); return true; }
        const long L = (long)i * G + c; if (L >= 512) return false; const int e = (int)(L / 32), r = (int)(L % 32); u.pm = e * 8 + (r & 7); u.pn = e * 4 + (r >> 3); return true;
    }
    __device__ __forceinline__ void a_ready(const Unit&) const {}
    __device__ __forceinline__ void done(const Unit&) const {}
};
template <class Epi, class Sched, bool ALIGN_EPI = false, bool SP2 = false>
__device__ __forceinline__ void gemm_phase(PG8_LAS unsigned char* lds, const Gemm g, const Sched& S, const Epi& E) {
    const int tid = threadIdx.x, wid = __builtin_amdgcn_readfirstlane(tid >> 6), lane = tid & 63, wr = wid >> 2, wc = wid & 3, fr = lane & 15, fq = lane >> 4;
    const int K = g.K, nt = K / BK;
    unsigned voffA[2], voffB[2];
#pragma unroll
    for (int i = 0; i < 2; ++i) { int R, C; stage_rc(tid * 16 + i * 8192, R, C); const int Rb = Epi::PERM ? ((R & ~31) + perm32(R & 31)) : R;
        voffA[i] = (unsigned)(R * g.lda + C) * 2u; voffB[i] = (unsigned)(Rb * g.ldb + C) * 2u; }
    const size_t kstep = (size_t)(BK * 2);
    const size_t hstepA = (size_t)HALF * g.lda * 2, hstepB = (size_t)HALF * g.ldb * 2;
    const size_t tstepA = 2 * hstepA, tstepB = 2 * hstepB;
    const unsigned ldsw = (unsigned)wid * 1024u;
    const int aoff = lds_byte(wr * 64 + fr, fq * 8), boff = lds_byte(wc * 32 + fr, fq * 8);
#define PG8_SA(b, h) (((b) * 2 + (h)) * HTB)
#define PG8_SB(b, h) ((4 + (b) * 2 + (h)) * HTB)
#define PG8_STAGE(bufoff, gbase, voff) do { _Pragma("unroll") for (int _i = 0; _i < 2; ++_i) \
        __builtin_amdgcn_global_load_lds((const unsigned*)((const char*)(gbase) + (voff)[_i]), (PG8_LAS unsigned*)(lds + (bufoff) + ldsw + _i * 8192), 16, 0, 0); } while (0)
#define PG8_LDA(dst, b, h) do { _Pragma("unroll") for (int m = 0; m < 4; ++m) _Pragma("unroll") for (int k = 0; k < 2; ++k) dst[m][k] = *(const PG8_LAS bf16x8*)(lds + PG8_SA(b, h) + aoff + m * 2048 + k * 1024); } while (0)
#define PG8_LDB(dst, b, h) do { _Pragma("unroll") for (int n = 0; n < 2; ++n) _Pragma("unroll") for (int k = 0; k < 2; ++k) dst[n][k] = *(const PG8_LAS bf16x8*)(lds + PG8_SB(b, h) + boff + n * 2048 + k * 1024); } while (0)
#define PG8_MMA(ai, bj, At, Bt) do { __builtin_amdgcn_s_setprio(1); _Pragma("unroll") for (int m = 0; m < 4; ++m) _Pragma("unroll") for (int n = 0; n < 2; ++n) _Pragma("unroll") for (int k = 0; k < 2; ++k) \
        acc[ai][bj][m][n] = __builtin_amdgcn_mfma_f32_16x16x32_bf16(Bt[n][k], At[m][k], acc[ai][bj][m][n], 0, 0, 0); __builtin_amdgcn_s_setprio(0); } while (0)
#define PG8_WAIT_V(n) asm volatile("s_waitcnt vmcnt(" #n ")" ::: "memory")
#define PG8_WAIT_L(n) asm volatile("s_waitcnt lgkmcnt(" #n ")" ::: "memory")
#define PG8_BAR __builtin_amdgcn_s_barrier()
#define PG8_SCHED __builtin_amdgcn_sched_barrier(0)
    Unit cur, nxt; int ui = 0;
    if (!S.next(0, cur)) return;
    f32x4 acc[2][2][4][2];
#pragma unroll
    for (int a = 0; a < 2; ++a)
#pragma unroll
        for (int b = 0; b < 2; ++b)
#pragma unroll
            for (int m = 0; m < 4; ++m)
#pragma unroll
                for (int n = 0; n < 2; ++n) acc[a][b][m][n] = (f32x4){0.f, 0.f, 0.f, 0.f};
    bf16x8 At[4][2], B0[2][2], B1[2][2];
    const char* cA = (const char*)g.A + (size_t)cur.pm * tstepA; const char* cB = (const char*)g.Bt + (size_t)cur.pn * tstepB;
    S.a_ready(cur);
    if constexpr (SP2) {
        PG8_STAGE(PG8_SB(0, 0), cB, voffB); PG8_STAGE(PG8_SB(0, 1), cB + hstepB, voffB); PG8_STAGE(PG8_SA(0, 0), cA, voffA); PG8_STAGE(PG8_SA(0, 1), cA + hstepA, voffA);
        if (wr == 1) PG8_BAR;
        PG8_WAIT_V(2); PG8_BAR;
        PG8_STAGE(PG8_SB(1, 0), cB + kstep, voffB); PG8_STAGE(PG8_SA(1, 0), cA + kstep, voffA); PG8_STAGE(PG8_SB(1, 1), cB + hstepB + kstep, voffB);
        PG8_WAIT_V(6); PG8_BAR;
    } else {
        PG8_STAGE(PG8_SB(0, 0), cB, voffB); PG8_STAGE(PG8_SA(0, 0), cA, voffA); PG8_STAGE(PG8_SB(0, 1), cB + hstepB, voffB); PG8_STAGE(PG8_SA(0, 1), cA + hstepA, voffA);
        if (wr == 1) PG8_BAR;
        PG8_WAIT_V(4); PG8_BAR;
        PG8_STAGE(PG8_SB(1, 0), cB + kstep, voffB); PG8_STAGE(PG8_SA(1, 0), cA + kstep, voffA); PG8_STAGE(PG8_SB(1, 1), cB + hstepB + kstep, voffB);
        PG8_WAIT_V(6); PG8_BAR;
    }
    for (;;) {
        const bool has_next = S.next(ui + 1, nxt);
        const char* nA = has_next ? (const char*)g.A + (size_t)nxt.pm * tstepA : cA; const char* nB = has_next ? (const char*)g.Bt + (size_t)nxt.pn * tstepB : cB;
        for (int t = 0; t < nt; t += 2) {
            const bool last = (t == nt - 2);
            const char* a1 = cA + (size_t)(t + 1) * kstep;
            const char* a2 = last ? nA : cA + (size_t)(t + 2) * kstep; const char* b2 = last ? nB : cB + (size_t)(t + 2) * kstep;
            const char* a3 = a2 + kstep; const char* b3 = b2 + kstep;
            if (last && has_next) S.a_ready(nxt);
            if constexpr (SP2) {
            PG8_LDB(B0, 0, 0); PG8_LDB(B1, 0, 1); PG8_SCHED; PG8_LDA(At, 0, 0); PG8_STAGE(PG8_SA(1, 1), a1 + hstepA, voffA);
            PG8_WAIT_V(8); PG8_WAIT_L(0); PG8_BAR; PG8_MMA(0, 0, At, B0); PG8_MMA(0, 1, At, B1); PG8_BAR; PG8_SCHED;
            PG8_LDA(At, 0, 1); PG8_STAGE(PG8_SB(0, 0), b2, voffB); PG8_STAGE(PG8_SB(0, 1), b2 + hstepB, voffB); PG8_STAGE(PG8_SA(0, 0), a2, voffA);
            PG8_WAIT_V(8); PG8_WAIT_L(0); PG8_BAR; PG8_MMA(1, 0, At, B0); PG8_MMA(1, 1, At, B1); PG8_BAR; PG8_SCHED;
            PG8_LDB(B0, 1, 0); PG8_LDB(B1, 1, 1); PG8_SCHED; PG8_LDA(At, 1, 0); PG8_STAGE(PG8_SA(0, 1), a2 + hstepA, voffA);
            PG8_WAIT_V(8); PG8_WAIT_L(0); PG8_BAR; PG8_MMA(0, 0, At, B0); PG8_MMA(0, 1, At, B1); PG8_BAR; PG8_SCHED;
            PG8_LDA(At, 1, 1); PG8_STAGE(PG8_SB(1, 0), b3, voffB); PG8_STAGE(PG8_SB(1, 1), b3 + hstepB, voffB); PG8_STAGE(PG8_SA(1, 0), a3, voffA);
            PG8_WAIT_V(8); PG8_WAIT_L(0); PG8_BAR; PG8_MMA(1, 0, At, B0); PG8_MMA(1, 1, At, B1); PG8_BAR; PG8_SCHED;
            } else {
            PG8_LDB(B0, 0, 0); PG8_SCHED; PG8_LDA(At, 0, 0); PG8_STAGE(PG8_SA(1, 1), a1 + hstepA, voffA);
            PG8_WAIT_L(8); PG8_BAR; PG8_WAIT_L(0); PG8_MMA(0, 0, At, B0); PG8_BAR; PG8_SCHED;
            PG8_LDB(B1, 0, 1); PG8_STAGE(PG8_SB(0, 0), b2, voffB);
            PG8_BAR; PG8_WAIT_L(0); PG8_MMA(0, 1, At, B1); PG8_BAR;
            PG8_LDA(At, 0, 1); PG8_STAGE(PG8_SA(0, 0), a2, voffA);
            PG8_BAR; PG8_WAIT_L(0); PG8_MMA(1, 0, At, B0); PG8_BAR; PG8_SCHED;
            PG8_STAGE(PG8_SB(0, 1), b2 + hstepB, voffB);
            PG8_WAIT_V(6); PG8_BAR; PG8_MMA(1, 1, At, B1); PG8_BAR;
            PG8_LDB(B0, 1, 0); PG8_SCHED; PG8_LDA(At, 1, 0); PG8_STAGE(PG8_SA(0, 1), a2 + hstepA, voffA);
            PG8_WAIT_L(8); PG8_BAR; PG8_WAIT_L(0); PG8_MMA(0, 0, At, B0); PG8_BAR; PG8_SCHED;
            PG8_LDB(B1, 1, 1); PG8_STAGE(PG8_SB(1, 0), b3, voffB);
            PG8_BAR; PG8_WAIT_L(0); PG8_MMA(0, 1, At, B1); PG8_BAR;
            PG8_LDA(At, 1, 1); PG8_STAGE(PG8_SA(1, 0), a3, voffA);
            PG8_BAR; PG8_WAIT_L(0); PG8_MMA(1, 0, At, B0); PG8_BAR; PG8_SCHED;
            PG8_STAGE(PG8_SB(1, 1), b3 + hstepB, voffB);
            PG8_WAIT_V(6); PG8_BAR; PG8_MMA(1, 1, At, B1); PG8_BAR;
            }
        }
        if constexpr (ALIGN_EPI) { if (wr == 0) PG8_BAR; }
        if constexpr (!Epi::AFTER_DRAIN) { E(acc, cur, wr, wc, fr, fq); S.done(cur); }
        if (!has_next) break;
#pragma unroll
        for (int a = 0; a < 2; ++a)
#pragma unroll
            for (int b = 0; b < 2; ++b)
#pragma unroll
                for (int m = 0; m < 4; ++m)
#pragma unroll
                    for (int n = 0; n < 2; ++n) acc[a][b][m][n] = (f32x4){0.f, 0.f, 0.f, 0.f};
        cur = nxt; cA = nA; cB = nB; ++ui;
        if constexpr (ALIGN_EPI) { if (wr == 1) PG8_BAR; }
    }
    PG8_WAIT_V(0);
    if constexpr (!ALIGN_EPI) { if (wr == 0) PG8_BAR; }
    PG8_BAR;
    if constexpr (Epi::AFTER_DRAIN) { E.fused(acc, cur, wr, wc, fr, fq, lds, wid, lane); S.done(cur); }
#undef PG8_SA
#undef PG8_SB
#undef PG8_STAGE
#undef PG8_LDA
#undef PG8_LDB
#undef PG8_MMA
#undef PG8_WAIT_V
#undef PG8_WAIT_L
#undef PG8_BAR
#undef PG8_SCHED
}
}
#ifndef PG8_SP2
#define PG8_SP2 true
#endif
#ifndef PG8_ALIGN
#define PG8_ALIGN true
#endif

constexpr int NWAVES = 8, NTHR = 512;
constexpr int D = 1024, NB = 2, T = 8192, M = NB * T;
constexpr int SSD_H = 24, SSD_P = 64, SSD_IN = 1536, SSD_G = 4, SSD_N = 128, XBC = 2560, INCOLS = 6960, NIN_PAD = 7168;
constexpr int S5_W = 768, S5_G = 48, S5_P = 64, S5_K = 16;
constexpr int NE = 16, FF = 2816, CAP = 1024, MROWS = NE * NB * CAP;
constexpr float LN_EPS = 1e-5f, RMS_EPS = 1e-5f;
constexpr float ALPHA = 1.189207115002721f;

constexpr size_t MiB = 1u << 20;
constexpr size_t WS_CTL = 0, CTL_ZERO_BYTES = 64 * 1024;
constexpr size_t WS_WIN = 1 * MiB, WS_WOUT = 15 * MiB, WS_WGLU = 18 * MiB, WS_WO = 21 * MiB, WS_W1 = 23 * MiB, WS_W2 = 199 * MiB, WS_ACT = 287 * MiB;
constexpr size_t A_XB = WS_ACT + 0 * MiB;
constexpr size_t A_BN = WS_ACT + 0 * MiB;
constexpr size_t A_CN = WS_ACT + 16 * MiB;
constexpr size_t A_Z = WS_ACT + 32 * MiB;
constexpr size_t A_XBC = WS_ACT + 80 * MiB;
constexpr size_t A_S = WS_ACT + 80 * MiB;
constexpr size_t A_XT = WS_ACT + 176 * MiB;
constexpr size_t A_BT = WS_ACT + 224 * MiB;
constexpr size_t A_SV = WS_ACT + 240 * MiB;
constexpr size_t A_DT = WS_ACT + 252 * MiB;
constexpr size_t A_TOT = WS_ACT + 255 * MiB;
constexpr size_t A_UC = WS_ACT + 268 * MiB;
constexpr size_t A_Y = WS_ACT + 256 * MiB;
constexpr size_t A_GY = WS_ACT + 304 * MiB;
constexpr size_t A_GT = WS_ACT + 353 * MiB;
constexpr size_t A_YA = WS_ACT + 0 * MiB;
constexpr size_t A_MIX = WS_ACT + 64 * MiB;
constexpr size_t A_HP = WS_ACT + 96 * MiB;
constexpr size_t A_H = WS_ACT + 0 * MiB;
constexpr size_t A_HB = WS_ACT + 64 * MiB;
constexpr size_t A_AFF = WS_ACT + 160 * MiB;
constexpr size_t A_IDX = A_AFF + 512 * 1024;
constexpr size_t A_SEL = A_AFF + 1 * MiB;
constexpr size_t A_GATE = A_AFF + 2 * MiB;
constexpr size_t A_XIN = WS_ACT + 164 * MiB;
constexpr size_t A_HID = WS_ACT + 228 * MiB;
constexpr size_t A_YE = WS_ACT + 96 * MiB;
constexpr size_t WS_TV = WS_W2 + 0 * MiB;
constexpr size_t WS_WS5 = WS_W2 + 36 * MiB;
constexpr size_t WS_SLOC = WS_W2 + 48 * MiB;
constexpr size_t WS_AQ = WS_W2 + 72 * MiB;
constexpr size_t WS_END = 704 * MiB;
static_assert(A_HID + 176 * MiB <= WS_END && A_XIN + 64 * MiB <= A_HID && A_GATE + 1 * MiB <= A_XIN && A_YE + 64 * MiB <= A_AFF && A_H + 64 * MiB <= A_HB && A_HB + 32 * MiB <= A_HP, "d_ws map (late phases)");
static_assert(A_GT + 64 * MiB <= WS_END && A_GY + 24 * MiB <= A_GT && A_UC + 36 * MiB <= A_GY && A_Y + 48 * MiB <= A_GY && A_TOT + 1 * MiB <= A_Y && A_DT + 3 * MiB <= A_TOT && A_SV + 12 * MiB <= A_DT && A_BT + 16 * MiB <= A_SV
              && A_XT + 48 * MiB <= A_BT && A_S + 96 * MiB <= A_XT && A_Z + 48 * MiB <= A_XBC && A_CN + 16 * MiB <= A_Z, "d_ws map (early phases)");
constexpr int CW_BAR = 1024;

constexpr int RING_BYTES = 131072;
constexpr int MISC_OFF = RING_BYTES;
constexpr int LDS_BYTES = 147456;

#define GAS __attribute__((address_space(1)))
#define LAS __attribute__((address_space(3)))
typedef unsigned short bf16;
typedef unsigned v4u __attribute__((ext_vector_type(4)));
typedef unsigned v2u __attribute__((ext_vector_type(2)));
typedef float f32x4 __attribute__((ext_vector_type(4)));
#define LDS_WAIT() asm volatile("s_waitcnt lgkmcnt(0)" ::: "memory")
__device__ __forceinline__ unsigned f2bf(float f) { unsigned u = __builtin_bit_cast(unsigned, f); return (u + 0x7fffu + ((u >> 16) & 1u)) >> 16; }
__device__ __forceinline__ unsigned pk2(float lo, float hi) { return pg8::cvt_pk_bf16(lo, hi); }
__device__ __forceinline__ float bflo(unsigned w) { return __uint_as_float(w << 16); }
__device__ __forceinline__ float bfhi(unsigned w) { return __uint_as_float(w & 0xffff0000u); }
__device__ __forceinline__ float wave_sum(float v) {
#pragma unroll
    for (int o = 1; o < 64; o <<= 1) v += __shfl_xor(v, o);
    return v;
}
#define XB_TMO      128
#define XB_XCNT(j)  (256  + 64 * (j))
#define XB_XSUB(j)  (1280 + 64 * (j))
#define XB_XGEN(j)  (2304 + 64 * (j))
#define XB_TOP      3328
#define XB_TOPGEN   3392
#define XCD_BAR_WORDS 3456
#define XB_SPIN_CAP (1u << 18)

__device__ __forceinline__ unsigned xb_ld(unsigned* p)              { return __hip_atomic_load(p, __ATOMIC_RELAXED, __HIP_MEMORY_SCOPE_AGENT); }
__device__ __forceinline__ unsigned xb_add(unsigned* p, unsigned v) { return __hip_atomic_fetch_add(p, v, __ATOMIC_RELAXED, __HIP_MEMORY_SCOPE_AGENT); }
__device__ __forceinline__ unsigned xb_xcc_id() { return (unsigned)__builtin_amdgcn_s_getreg((3 << 11) | 20) & 0xFu; }
#define XB_SPIN(cond, bar) do { unsigned _sp = 0; while (cond) { __builtin_amdgcn_s_sleep(1); \
    if ((++_sp & 255u) == 0u) { if (xb_ld(&(bar)[XB_TMO])) break; if (_sp > XB_SPIN_CAP) { atomicAdd(&(bar)[XB_TMO], 1u); break; } } } } while (0)

struct XcdBarrier {
    unsigned* bar; unsigned x;
    volatile LAS unsigned* st;
};

__device__ __forceinline__ XcdBarrier xcd_barrier_post(unsigned* bar, volatile LAS unsigned* st) {
    XcdBarrier b; b.bar = bar; b.x = xb_xcc_id(); b.st = st;
    if (threadIdx.x == 0) (void)xb_add(&bar[XB_XCNT(b.x)], 1u);
    return b;
}
__device__ __forceinline__ void xcd_barrier_complete(unsigned* bar, unsigned x, unsigned& nloc, unsigned& nx) {
    const unsigned G = gridDim.x * gridDim.y * gridDim.z;
    unsigned sum, cnt, mine, sp = 0u;
    for (;;) {
        sum = 0u; cnt = 0u; mine = 0u;
#pragma unroll
        for (unsigned j = 0; j < 16; ++j) { const unsigned c = xb_ld(&bar[XB_XCNT(j)]); sum += c; cnt += (c > 0u) ? 1u : 0u; mine = (j == x) ? c : mine; }
        if (sum == G) break;
        __builtin_amdgcn_s_sleep(1);
        if ((++sp & 255u) == 0u) { if (xb_ld(&bar[XB_TMO])) break; if (sp > XB_SPIN_CAP) { atomicAdd(&bar[XB_TMO], 1u); break; } }
    }
    nloc = mine > 0u ? mine : 1u; nx = cnt > 0u ? cnt : 1u;
}

__device__ __forceinline__ void xcd_barrier(const XcdBarrier& b) {
    asm volatile("s_waitcnt vmcnt(0)" ::: "memory");
    __syncthreads();
    if (threadIdx.x == 0) {
        unsigned* bar = b.bar;
        __builtin_amdgcn_s_waitcnt(0);
        unsigned nloc = b.st[0], nx = b.st[1];
        if (nloc == 0u) { xcd_barrier_complete(bar, b.x, nloc, nx); b.st[0] = nloc; b.st[1] = nx; }
        const unsigned old = xb_add(&bar[XB_XSUB(b.x)], 1u);
        const unsigned gen = old / nloc;
        if (old + 1u == (gen + 1u) * nloc) {
            __builtin_amdgcn_fence(__ATOMIC_RELEASE, "agent");
            asm volatile("s_waitcnt vmcnt(0)" ::: "memory");
            const unsigned og = xb_add(&bar[XB_TOP], 1u);
            const unsigned tg = og / nx;
            if (og + 1u == (tg + 1u) * nx) xb_add(&bar[XB_TOPGEN], 1u);
            else XB_SPIN(xb_ld(&bar[XB_TOPGEN]) == tg, bar);
            __builtin_amdgcn_fence(__ATOMIC_ACQUIRE, "agent");
            xb_add(&bar[XB_XGEN(b.x)], 1u);
            asm volatile("s_waitcnt vmcnt(0)" ::: "memory");
        } else {
            XB_SPIN(xb_ld(&bar[XB_XGEN(b.x)]) == gen, bar);
            __builtin_amdgcn_fence(__ATOMIC_ACQUIRE, "agent");
            asm volatile("s_waitcnt vmcnt(0)" ::: "memory");
        }
    }
    __syncthreads();
}

struct Frame {
    LAS unsigned char* lds;
    int tid, lane, wave, bid, G;
    const float* const* in; float* out; unsigned char* ws;
};
#define WSP(T_, off) ((T_*)(F.ws + (off)))

__device__ __forceinline__ void tr_item(const float* W, int ldw, int col0, int ncols, int K, bf16* WT, int drow, LAS float* scr, int k0, int n0, int lane) {
    const int nl = lane & 31; const bool okc = (n0 + nl) < ncols;
#pragma unroll 8
    for (int i = 0; i < 32; ++i) { const int kk = 2 * i + (lane >> 5); scr[kk * 33 + nl] = okc ? W[(size_t)(k0 + kk) * ldw + col0 + n0 + nl] : 0.f; }
    LDS_WAIT(); asm volatile("" ::: "memory");
    const int c = lane & 7;
#pragma unroll
    for (int j = 0; j < 4; ++j) { const int n = (lane >> 3) + 8 * j; const LAS float* s = scr + (8 * c) * 33 + n;
        v4u o; o.x = pk2(s[0 * 33], s[1 * 33]); o.y = pk2(s[2 * 33], s[3 * 33]); o.z = pk2(s[4 * 33], s[5 * 33]); o.w = pk2(s[6 * 33], s[7 * 33]);
        if (n0 + n < ncols) *(v4u*)(WT + (size_t)(drow + n) * K + k0 + 8 * c) = o; }
    LDS_WAIT(); asm volatile("" ::: "memory");
}
struct TrJob { const float* W; int ldw, col0, ncols, K; bf16* WT; int drow0, interleave; };
__device__ __forceinline__ int tr_job_items(const TrJob& j) { return (j.K / 64) * ((j.ncols + 31) / 32); }
__device__ __forceinline__ void tr_job_item(const TrJob& j, int item, LAS float* scr, int lane) {
    const int nblk = (j.ncols + 31) / 32, kb = item / nblk, nb = item % nblk, n0 = nb * 32;
    const int drow = j.interleave ? j.drow0 + (n0 >> 7) * 256 + (n0 & 127) : j.drow0 + n0;
    tr_item(j.W, j.ldw, j.col0, j.ncols, j.K, j.WT, drow, scr, kb * 64, n0, lane);
}
__device__ __forceinline__ void p0_prologue(Frame& F) {
    LAS float* scr = (LAS float*)(F.lds + F.wave * 8704);
    const int gw = F.bid * NWAVES + F.wave, NGW = F.G * NWAVES;
    { const f32x4* x4 = (const f32x4*)F.in[0]; v4u* o = WSP(v4u, A_XB); const int n8 = M * D / 8;
      for (int i = F.bid * NTHR + F.tid; i < n8; i += F.G * NTHR) { const f32x4 a = x4[2 * i], b = x4[2 * i + 1]; v4u w; w.x = pk2(a.x, a.y); w.y = pk2(a.z, a.w); w.z = pk2(b.x, b.y); w.w = pk2(b.z, b.w); o[i] = w; } }
    {
        bf16* WIN = WSP(bf16, WS_WIN); bf16* WOUT = WSP(bf16, WS_WOUT); bf16* WGLU = WSP(bf16, WS_WGLU); bf16* WO = WSP(bf16, WS_WO);
        const TrJob jobs[8] = {
            {F.in[1], INCOLS, 0, 4096, D, WIN, 0, 0}, {F.in[1], INCOLS, 4096, 48, D, WIN, 4096, 0}, {F.in[1], INCOLS, 4144, 768, D, WIN, 4352, 0}, {F.in[1], INCOLS, 4912, 2048, D, WIN, 5120, 0},
            {F.in[10], D, 0, D, SSD_IN, WOUT, 0, 0}, {F.in[22], D, 0, D, S5_W, WGLU, 0, 1}, {F.in[23], D, 0, D, S5_W, WGLU, 128, 1}, {F.in[24], D, 0, D, D, WO, 0, 0} };
        int base = 0;
#pragma unroll
        for (int q = 0; q < 8; ++q) { const int n = tr_job_items(jobs[q]);
            int it0 = (gw - base) % NGW; if (it0 < 0) it0 += NGW;
            for (int it = it0; it < n; it += NGW) tr_job_item(jobs[q], it, scr, F.lane);
            base += n; }
    }
    {
        bf16* W1 = WSP(bf16, WS_W1);
        constexpr int I13 = (D / 64) * (FF / 32);
        for (int it = gw; it < NE * 2 * I13; it += NGW) {
            const int e = it / (2 * I13); int r = it % (2 * I13);
            if (r < I13) { const TrJob j{F.in[28] + (size_t)e * D * FF, FF, 0, FF, D, W1 + (size_t)e * 2 * FF * D, 0, 1}; tr_job_item(j, r, scr, F.lane); }
            else { const TrJob j{F.in[29] + (size_t)e * D * FF, FF, 0, FF, D, W1 + (size_t)e * 2 * FF * D, 128, 1}; tr_job_item(j, r - I13, scr, F.lane); }
        }
    }
}
__device__ __forceinline__ void w2_convert(Frame& F, int gw, int ngw) {
    LAS float* scr = (LAS float*)(F.lds + F.wave * 8704);
    bf16* W2 = WSP(bf16, WS_W2);
    constexpr int I2 = (FF / 64) * (D / 32);
    for (int it = gw; it < NE * I2; it += ngw) { const int e = it / I2, r = it % I2;
        const TrJob j{F.in[30] + (size_t)e * FF * D, D, 0, D, FF, W2 + (size_t)e * D * FF, 0, 0}; tr_job_item(j, r, scr, F.lane); }
}

__device__ __forceinline__ void cmul(float ar, float ai, float br, float bi, float& cr, float& ci) { cr = ar * br - ai * bi; ci = ar * bi + ai * br; }
__device__ __forceinline__ void s5_precompute_item(Frame& F, int g, int tau) {
    LAS float* PQ = (LAS float*)(F.lds + 72 * 1024);
    LAS float* PW = PQ + 256;
    bf16* TV = WSP(bf16, WS_TV) + (size_t)g * 512 * 768; bf16* WM = WSP(bf16, WS_WS5) + (size_t)g * 256 * 512; float* AQ = WSP(float, WS_AQ);
    const int tid = F.tid;
    __syncthreads();
    if (tid < 128) {
        const int d = tid >> 6, p = tid & 63;
        const float are = (d ? F.in[14] : F.in[11])[g * 64 + p], aim = (d ? F.in[15] : F.in[12])[g * 64 + p], step = __expf((d ? F.in[16] : F.in[13])[g]);
        const float zr = are * step, zi = aim * step;
        const float er = expf(zr), cs = cosf(zi), sn = sinf(zi), abr = er * cs, abi = er * sn;
        const float sh = sinf(0.5f * zi), dr = expm1f(zr) * cs - 2.f * sh * sh, di = abi;
        const float den = 1.0f / (are * are + aim * aim), qr = (dr * are + di * aim) * den, qi = (di * are - dr * aim) * den;
        float pr = 1.f, pi = 0.f, br = abr, bi = abi;
#pragma unroll
        for (int bit = 0; bit < 6; ++bit) { if ((tau >> bit) & 1) { float tr_, ti_; cmul(pr, pi, br, bi, tr_, ti_); pr = tr_; pi = ti_; } float sr_, si_; cmul(br, bi, br, bi, sr_, si_); br = sr_; bi = si_; }
        float xr, xi; cmul(pr, pi, qr, qi, xr, xi);
        PQ[(d * 64 + p) * 2] = xr; PQ[(d * 64 + p) * 2 + 1] = xi; PW[(d * 64 + p) * 2] = pr; PW[(d * 64 + p) * 2 + 1] = pi;
        if (tau == 32) { AQ[((g * 2 + d) * 64 + p) * 2] = pr; AQ[((g * 2 + d) * 64 + p) * 2 + 1] = pi; }
    }
    __syncthreads();
    const float* cre = F.in[19] + (size_t)g * 16 * 64; const float* cim = F.in[20] + (size_t)g * 16 * 64;
    const float* bre = F.in[17] + (size_t)g * 64 * 16; const float* bim = F.in[18] + (size_t)g * 64 * 16;
    if (tid < 256 && tau < 32) {
        const int k = tid >> 4, j = tid & 15; float kf = 0.f, kb = 0.f;
        for (int p = 0; p < 64; ++p) { const float cr = cre[k * 64 + p], ci = cim[k * 64 + p], br = bre[p * 16 + j], bi = bim[p * 16 + j];
            float wr_, wi_; cmul(cr, ci, PQ[p * 2], PQ[p * 2 + 1], wr_, wi_); kf += wr_ * br - wi_ * bi;
            cmul(cr, ci, PQ[(64 + p) * 2], PQ[(64 + p) * 2 + 1], wr_, wi_); kb += wr_ * br - wi_ * bi; }
        if (tau == 0) { const bf16 v = (bf16)f2bf(kf + kb); for (int t = 0; t < 32; ++t) TV[(size_t)(t * 16 + k) * 768 + t * 16 + j] = v; }
        else { const bf16 vf = (bf16)f2bf(kf), vb = (bf16)f2bf(kb);
            for (int t = tau; t < 32; ++t) { const int s = t - tau; TV[(size_t)(t * 16 + k) * 768 + s * 16 + j] = vf; TV[(size_t)(s * 16 + k) * 768 + t * 16 + j] = vb; } }
    }
    if (tid >= 256) {
        const int q = tid - 256;
        if (tau >= 1) {
#pragma unroll 1
            for (int i = 0; i < 8; ++i) { const int e = q * 8 + i, d = e >> 10, k = (e >> 6) & 15, p = e & 63;
                float vr, vi; cmul(cre[k * 64 + p], cim[k * 64 + p], PW[(d * 64 + p) * 2], PW[(d * 64 + p) * 2 + 1], vr, vi);
                const int t = d ? 32 - tau : tau - 1; bf16* row = TV + (size_t)(t * 16 + k) * 768 + 512 + d * 128;
                row[p] = (bf16)f2bf(vr); row[64 + p] = (bf16)f2bf(-vi); } }
        if (tau < 32) {
#pragma unroll 1
            for (int i = 0; i < 8; ++i) { const int e = q * 8 + i, d = e >> 10, p = (e >> 4) & 63, j = e & 15;
                float vr, vi; cmul(PQ[(d * 64 + p) * 2], PQ[(d * 64 + p) * 2 + 1], bre[p * 16 + j], bim[p * 16 + j], vr, vi);
                const int s = d ? tau : 31 - tau; bf16* col = WM + (size_t)(d * 128 + p) * 512 + s * 16 + j;
                col[0] = (bf16)f2bf(vr); col[(size_t)64 * 512] = (bf16)f2bf(vi); } }
    }
}
__device__ __forceinline__ void p0_s5(Frame& F) { for (int it = F.bid; it < S5_G * 33; it += F.G) s5_precompute_item(F, it / 33, it % 33); }

__device__ __forceinline__ void s5_scan_item(Frame& F, int item) {
    const int d = item & 1, b = (item >> 1) & 1, g = item >> 2, tid = F.tid;
    LAS float* S = (LAS float*)F.lds;
    const float* SL = WSP(float, WS_SLOC) + ((size_t)(g * 512 + b * 256) * 256 + d * 128);
    __syncthreads();
    for (int i = tid; i < 256 * 32; i += NTHR) { const int ci = i >> 5, c4 = (i & 31) * 4; *(LAS f32x4*)(S + ci * 128 + c4) = *(const f32x4*)(SL + (size_t)ci * 256 + c4); }
    __syncthreads();
    if (tid < 64) {
        const float* AQ = WSP(float, WS_AQ); const float qr = AQ[((g * 2 + d) * 64 + tid) * 2], qi = AQ[((g * 2 + d) * 64 + tid) * 2 + 1];
        float sr = 0.f, si = 0.f;
        for (int n = 0; n < 256; ++n) { const int ci = d ? 255 - n : n;
            const float tr_ = S[ci * 128 + tid], ti_ = S[ci * 128 + 64 + tid];
            S[ci * 128 + tid] = sr; S[ci * 128 + 64 + tid] = si;
            const float nr = qr * sr - qi * si + tr_, ni = qr * si + qi * sr + ti_; sr = nr; si = ni; }
    }
    __syncthreads();
    bf16* UC = WSP(bf16, A_UC) + ((size_t)(g * 512 + b * 256) * 768 + 512 + d * 128);
    for (int i = tid; i < 256 * 16; i += NTHR) { const int ci = i >> 4, c8 = (i & 15) * 8; const LAS float* s = S + ci * 128 + c8;
        v4u o; o.x = pk2(s[0], s[1]); o.y = pk2(s[2], s[3]); o.z = pk2(s[4], s[5]); o.w = pk2(s[6], s[7]);
        *(v4u*)(UC + (size_t)ci * 768 + c8) = o; }
}

__device__ __forceinline__ void unpack8(const v4u w, float (&f)[8]) { f[0] = bflo(w.x); f[1] = bfhi(w.x); f[2] = bflo(w.y); f[3] = bfhi(w.y); f[4] = bflo(w.z); f[5] = bfhi(w.z); f[6] = bflo(w.w); f[7] = bfhi(w.w); }
__device__ __forceinline__ void p2_conv(Frame& F) {
    const bf16* xbc = WSP(bf16, A_XBC); bf16* XT = WSP(bf16, A_XT); bf16* BT = WSP(bf16, A_BT); bf16* BN = WSP(bf16, A_BN); bf16* CN = WSP(bf16, A_CN);
    const float* cw = F.in[2]; const float* cb = F.in[3];
    constexpr int RUN = 32, NCG = XBC / 8, NITEM = (M / RUN) * NCG;
    for (int item = F.bid * NTHR + F.tid; item < NITEM; item += F.G * NTHR) {
        const int cg = item % NCG, r = item / NCG, ch = cg * 8, m0 = r * RUN, tb = m0 % T, bc = m0 >> 7, s0 = m0 & 127;
        float w[5][8], bias[8];
#pragma unroll
        for (int k = 0; k < 5; ++k) { const f32x4 a = *(const f32x4*)(cw + k * XBC + ch), b = *(const f32x4*)(cw + k * XBC + ch + 4); w[k][0] = a.x; w[k][1] = a.y; w[k][2] = a.z; w[k][3] = a.w; w[k][4] = b.x; w[k][5] = b.y; w[k][6] = b.z; w[k][7] = b.w; }
        { const f32x4 a = *(const f32x4*)(cb + ch), b = *(const f32x4*)(cb + ch + 4); bias[0] = a.x; bias[1] = a.y; bias[2] = a.z; bias[3] = a.w; bias[4] = b.x; bias[5] = b.y; bias[6] = b.z; bias[7] = b.w; }
        bf16* nat = nullptr; bf16* trn = nullptr;
        if (ch < SSD_IN) { trn = XT + ((size_t)(bc * SSD_H + (ch >> 6)) * 64 + (ch & 63)) * 128 + s0; }
        else if (ch < SSD_IN + 512) { const int cc = ch - SSD_IN; nat = BN + (size_t)m0 * 512 + cc; trn = BT + ((size_t)(bc * SSD_G + (cc >> 7)) * 128 + (cc & 127)) * 128 + s0; }
        else { nat = CN + (size_t)m0 * 512 + (ch - SSD_IN - 512); }
        const v4u zero4 = {0u, 0u, 0u, 0u};
        v4u win[5];
        const bf16* src = xbc + (size_t)m0 * XBC + ch;
        win[0] = (tb - 2 >= 0) ? *(const v4u*)(src - 2 * XBC) : zero4;
        win[1] = (tb - 1 >= 0) ? *(const v4u*)(src - 1 * XBC) : zero4;
        win[2] = *(const v4u*)(src);
        win[3] = *(const v4u*)(src + XBC);
#pragma unroll 1
        for (int i8 = 0; i8 < RUN / 8; ++i8) {
            float o[8][8];
#pragma unroll
            for (int ii = 0; ii < 8; ++ii) { const int i = i8 * 8 + ii;
                win[4] = (tb + i + 2 < T) ? *(const v4u*)(src + (size_t)(i + 2) * XBC) : zero4;
#pragma unroll
                for (int j = 0; j < 8; ++j) o[ii][j] = bias[j];
#pragma unroll
                for (int k = 0; k < 5; ++k) { float f[8]; unpack8(win[k], f);
#pragma unroll
                    for (int j = 0; j < 8; ++j) o[ii][j] += w[k][j] * f[j]; }
#pragma unroll
                for (int j = 0; j < 8; ++j) o[ii][j] = o[ii][j] * __builtin_amdgcn_rcpf(1.0f + __expf(-o[ii][j]));
                if (nat) { v4u q; q.x = pk2(o[ii][0], o[ii][1]); q.y = pk2(o[ii][2], o[ii][3]); q.z = pk2(o[ii][4], o[ii][5]); q.w = pk2(o[ii][6], o[ii][7]); *(v4u*)(nat + (size_t)i * 512) = q; }
                win[0] = win[1]; win[1] = win[2]; win[2] = win[3]; win[3] = win[4]; }
            if (trn) {
#pragma unroll
                for (int j = 0; j < 8; ++j) { v4u q; q.x = pk2(o[0][j], o[1][j]); q.y = pk2(o[2][j], o[3][j]); q.z = pk2(o[4][j], o[5][j]); q.w = pk2(o[6][j], o[7][j]); *(v4u*)(trn + (size_t)j * 128 + i8 * 8) = q; } }
        }
    }
    {
        const int gw = F.bid * NWAVES + F.wave, NGW = F.G * NWAVES, lane = F.lane;
        const float* DT = WSP(float, A_DT); float* SV = WSP(float, A_SV); float* TOT = WSP(float, A_TOT);
        for (int it = gw; it < 128 * SSD_H * 2; it += NGW) {
            const int d = it & 1, h = (it >> 1) % SSD_H, bc = it / (2 * SSD_H);
            const float a = -__expf((d ? F.in[5] : F.in[4])[h]);
            const size_t mb = (size_t)bc * 128;
            const float dt0 = DT[(mb + 2 * lane) * 48 + d * 24 + h], dt1 = DT[(mb + 2 * lane + 1) * 48 + d * 24 + h];
            const float x0 = dt0 * a, x1 = dt1 * a, ps = x0 + x1;
            float inc = ps;
#pragma unroll
            for (int o = 1; o < 64; o <<= 1) { const float t_ = __shfl_up(inc, o); if (lane >= o) inc += t_; }
            const float total = __shfl(inc, 63), exc = inc - ps;
            const float ci0 = exc + x0, ci1 = inc;
            float cs0, cs1, w0, w1, f0, f1;
            if (d == 0) { cs0 = ci0; cs1 = ci1; w0 = dt0 * __expf(total - ci0); w1 = dt1 * __expf(total - ci1); f0 = __expf(ci0); f1 = __expf(ci1); }
            else { cs0 = exc; cs1 = ci0; w0 = dt0 * __expf(cs0); w1 = dt1 * __expf(cs1); f0 = __expf(total - cs0); f1 = __expf(total - cs1); }
            float* sv = SV + (size_t)it * 4 * 128 + 2 * lane;
            typedef float f32x2 __attribute__((ext_vector_type(2)));
            *(f32x2*)(sv) = (f32x2){w0, w1}; *(f32x2*)(sv + 128) = (f32x2){cs0, cs1}; *(f32x2*)(sv + 256) = (f32x2){dt0, dt1}; *(f32x2*)(sv + 384) = (f32x2){f0, f1};
            if (lane == 0) TOT[it] = __expf(total);
        }
    }
}

typedef short bf16x8 __attribute__((ext_vector_type(8)));
typedef float f32x16 __attribute__((ext_vector_type(16)));
__device__ __forceinline__ unsigned cvtpk(float lo, float hi) { return pg8::cvt_pk_bf16(lo, hi); }
__device__ __forceinline__ void ssd_state_item(Frame& F, int item) {
    const int nt = item & 3, u = item >> 2, h = u % SSD_H, bc = u / SSD_H, g = h / 6, b = bc >> 6, c = bc & 63, lane = F.lane, l31 = lane & 31, hf = lane >> 5;
    const bf16* XT = WSP(bf16, A_XT) + (size_t)u * 64 * 128; const bf16* BT = WSP(bf16, A_BT) + ((size_t)(bc * SSD_G + g) * 128 + nt * 32 + l31) * 128;
    const float* SV = WSP(float, A_SV); bf16* S = WSP(bf16, A_S);
    LAS float* wl = (LAS float*)(F.lds + F.wave * 1024);
    LDS_WAIT(); asm volatile("" ::: "memory");
#pragma unroll
    for (int d = 0; d < 2; ++d) { const float* sv = SV + (size_t)(u * 2 + d) * 4 * 128; wl[d * 128 + lane] = sv[lane]; wl[d * 128 + 64 + lane] = sv[64 + lane]; }
    LDS_WAIT(); asm volatile("" ::: "memory");
    f32x16 acc[2][2];
#pragma unroll
    for (int d = 0; d < 2; ++d)
#pragma unroll
        for (int pt = 0; pt < 2; ++pt)
#pragma unroll
            for (int r = 0; r < 16; ++r) acc[d][pt][r] = 0.f;
#pragma unroll
    for (int ks = 0; ks < 8; ++ks) {
        const int sb = ks * 16 + 8 * hf;
        const v4u a = *(const v4u*)(BT + sb);
        const bf16x8 b0 = *(const bf16x8*)(XT + (size_t)l31 * 128 + sb), b1 = *(const bf16x8*)(XT + (size_t)(32 + l31) * 128 + sb);
        float af[8]; unpack8(a, af);
#pragma unroll
        for (int d = 0; d < 2; ++d) {
            const f32x4 w0 = *(const LAS f32x4*)(wl + d * 128 + sb), w1 = *(const LAS f32x4*)(wl + d * 128 + sb + 4);
            v4u aw; aw.x = cvtpk(af[0] * w0.x, af[1] * w0.y); aw.y = cvtpk(af[2] * w0.z, af[3] * w0.w); aw.z = cvtpk(af[4] * w1.x, af[5] * w1.y); aw.w = cvtpk(af[6] * w1.z, af[7] * w1.w);
            const bf16x8 av = __builtin_bit_cast(bf16x8, aw);
            acc[d][0] = __builtin_amdgcn_mfma_f32_32x32x16_bf16(av, b0, acc[d][0], 0, 0, 0);
            acc[d][1] = __builtin_amdgcn_mfma_f32_32x32x16_bf16(av, b1, acc[d][1], 0, 0, 0);
        }
    }
#pragma unroll
    for (int d = 0; d < 2; ++d) { bf16* So = S + ((size_t)((b * SSD_H + h) * 2 + d) * 64 + c) * 8192;
#pragma unroll
        for (int pt = 0; pt < 2; ++pt)
#pragma unroll
            for (int q = 0; q < 4; ++q) { v2u o; o.x = cvtpk(acc[d][pt][4 * q], acc[d][pt][4 * q + 1]); o.y = cvtpk(acc[d][pt][4 * q + 2], acc[d][pt][4 * q + 3]);
                *(v2u*)(So + (size_t)(32 * pt + l31) * 128 + nt * 32 + 8 * q + 4 * hf) = o; } }
}
__device__ __forceinline__ void ssd_scan(Frame& F, int tg, int ntg) {
    bf16* S = WSP(bf16, A_S); const float* TOT = WSP(float, A_TOT);
    for (int item = tg; item < 96 * 1024; item += ntg) {
        const int e8 = item & 1023, bhd = item >> 10, d = bhd & 1, h = (bhd >> 1) % SSD_H, b = bhd / (2 * SSD_H);
        bf16* base = S + (size_t)bhd * 64 * 8192 + e8 * 8;
        float H[8];
#pragma unroll
        for (int j = 0; j < 8; ++j) H[j] = 0.f;
#pragma unroll 1
        for (int n0 = 0; n0 < 64; n0 += 8) {
            v4u v[8]; float dec[8];
#pragma unroll
            for (int k = 0; k < 8; ++k) { const int c = d ? 63 - (n0 + k) : n0 + k; v[k] = *(const v4u*)(base + (size_t)c * 8192); dec[k] = TOT[((b * 64 + c) * SSD_H + h) * 2 + d]; }
#pragma unroll
            for (int k = 0; k < 8; ++k) { const int c = d ? 63 - (n0 + k) : n0 + k; float f[8]; unpack8(v[k], f);
                v4u o; o.x = cvtpk(H[0], H[1]); o.y = cvtpk(H[2], H[3]); o.z = cvtpk(H[4], H[5]); o.w = cvtpk(H[6], H[7]);
                *(v4u*)(base + (size_t)c * 8192) = o;
#pragma unroll
                for (int j = 0; j < 8; ++j) H[j] = H[j] * dec[k] + f[j]; }
        }
    }
}
__device__ __forceinline__ void ssd_out_unit(Frame& F, int unit) {
    const int g = unit & 3, bc = unit >> 2, b = bc >> 6, c = bc & 63, lane = F.lane, l31 = lane & 31, hf = lane >> 5, j = F.wave & 3, hh = F.wave >> 2;
    const size_t mb = (size_t)bc * 128;
    const bf16* CN = WSP(bf16, A_CN) + (mb + 32 * j + l31) * 512 + g * 128 + 8 * hf;
    const bf16* BN = WSP(bf16, A_BN) + (mb + l31) * 512 + g * 128 + 8 * hf;
    const float* SV = WSP(float, A_SV); const bf16* S = WSP(bf16, A_S); const bf16* XT = WSP(bf16, A_XT); bf16* Y = WSP(bf16, A_Y);
    LAS float* svl = (LAS float*)(F.lds + F.wave * 12288);
    LDS_WAIT(); asm volatile("" ::: "memory");
    {
#pragma unroll
        for (int q = 0; q < 9; ++q) { const int idx = q * 64 + lane, vec = idx >> 5, c4 = (idx & 31) * 4, i3 = vec / 6, d = (vec / 3) & 1, v = vec % 3;
            const int h = g * 6 + hh * 3 + i3;
            *(LAS f32x4*)(svl + vec * 128 + c4) = *(const f32x4*)(SV + ((size_t)((bc * SSD_H + h) * 2 + d) * 4 + 1 + v) * 128 + c4); }
    }
    bf16x8 cfr[8];
#pragma unroll
    for (int ks = 0; ks < 8; ++ks) cfr[ks] = *(const bf16x8*)(CN + ks * 16);
    f32x16 cbt[4];
#pragma unroll
    for (int i = 0; i < 4; ++i) {
#pragma unroll
        for (int r = 0; r < 16; ++r) cbt[i][r] = 0.f;
#pragma unroll
        for (int ks = 0; ks < 8; ++ks) { const bf16x8 a = *(const bf16x8*)(BN + (size_t)(32 * i) * 512 + ks * 16); cbt[i] = __builtin_amdgcn_mfma_f32_32x32x16_bf16(a, cfr[ks], cbt[i], 0, 0, 0); }
    }
    LDS_WAIT(); asm volatile("" ::: "memory");
    const int tl = 32 * j + l31;
#pragma unroll 1
    for (int i3 = 0; i3 < 3; ++i3) {
        const int h = g * 6 + hh * 3 + i3;
        const LAS float* vf = svl + (i3 * 2 + 0) * 384; const LAS float* vb = svl + (i3 * 2 + 1) * 384;
        const float csf_t = vf[tl], sf_t = vf[256 + tl], ecsb_t = vb[tl], sb_t = vb[256 + tl], Dh = F.in[8][h];
        f32x16 acc[2];
        {
            const bf16* Hf = S + ((size_t)((b * SSD_H + h) * 2 + 0) * 64 + c) * 8192 + (size_t)l31 * 128 + 8 * hf; const bf16* Hb = Hf + (size_t)64 * 8192;
#pragma unroll
            for (int pt = 0; pt < 2; ++pt) { f32x16 af, ab;
#pragma unroll
                for (int r = 0; r < 16; ++r) { af[r] = 0.f; ab[r] = 0.f; }
#pragma unroll
                for (int ks = 0; ks < 8; ++ks) { const bf16x8 a0 = *(const bf16x8*)(Hf + (size_t)(32 * pt) * 128 + ks * 16), a1 = *(const bf16x8*)(Hb + (size_t)(32 * pt) * 128 + ks * 16);
                    af = __builtin_amdgcn_mfma_f32_32x32x16_bf16(a0, cfr[ks], af, 0, 0, 0); ab = __builtin_amdgcn_mfma_f32_32x32x16_bf16(a1, cfr[ks], ab, 0, 0, 0); }
#pragma unroll
                for (int r = 0; r < 16; ++r) acc[pt][r] = af[r] * sf_t + ab[r] * sb_t; }
        }
        const bf16* xt = XT + ((size_t)(bc * SSD_H + h) * 64 + l31) * 128 + 4 * hf;
#pragma unroll
        for (int i = 0; i < 4; ++i) {
#pragma unroll
            for (int k2 = 0; k2 < 2; ++k2) {
                const int sA = 32 * i + 16 * k2 + 4 * hf;
                float f[8];
#pragma unroll
                for (int e = 0; e < 8; ++e) f[e] = 0.f;
                if (i <= j) {
                    const f32x4 c0 = *(const LAS f32x4*)(vf + sA), c1 = *(const LAS f32x4*)(vf + sA + 8), d0 = *(const LAS f32x4*)(vf + 128 + sA), d1 = *(const LAS f32x4*)(vf + 128 + sA + 8);
#pragma unroll
                    for (int e = 0; e < 4; ++e) { const int s0_ = sA + e, s1_ = sA + 8 + e;
                        f[e] += (s0_ <= tl) ? d0[e] * __expf(fminf(csf_t - c0[e], 0.f)) : 0.f; f[4 + e] += (s1_ <= tl) ? d1[e] * __expf(fminf(csf_t - c1[e], 0.f)) : 0.f; } }
                if (i >= j) {
                    const f32x4 c0 = *(const LAS f32x4*)(vb + sA), c1 = *(const LAS f32x4*)(vb + sA + 8), d0 = *(const LAS f32x4*)(vb + 128 + sA), d1 = *(const LAS f32x4*)(vb + 128 + sA + 8);
#pragma unroll
                    for (int e = 0; e < 4; ++e) { const int s0_ = sA + e, s1_ = sA + 8 + e;
                        f[e] += (s0_ >= tl) ? d0[e] * __expf(fminf(c0[e] - ecsb_t, 0.f)) : 0.f; f[4 + e] += (s1_ >= tl) ? d1[e] * __expf(fminf(c1[e] - ecsb_t, 0.f)) : 0.f; } }
                float mv[8];
#pragma unroll
                for (int e = 0; e < 8; ++e) { const int s_ = sA + (e & 3) + 8 * (e >> 2); mv[e] = cbt[i][8 * k2 + e] * f[e] + ((s_ == tl) ? Dh : 0.f); }
                v4u mw; mw.x = cvtpk(mv[0], mv[1]); mw.y = cvtpk(mv[2], mv[3]); mw.z = cvtpk(mv[4], mv[5]); mw.w = cvtpk(mv[6], mv[7]);
                const bf16x8 mfr = __builtin_bit_cast(bf16x8, mw);
#pragma unroll
                for (int pt = 0; pt < 2; ++pt) { const v2u x0 = *(const v2u*)(xt + (size_t)(32 * pt) * 128 + 32 * i + 16 * k2), x1 = *(const v2u*)(xt + (size_t)(32 * pt) * 128 + 32 * i + 16 * k2 + 8);
                    v4u xw; xw.x = x0.x; xw.y = x0.y; xw.z = x1.x; xw.w = x1.y;
                    acc[pt] = __builtin_amdgcn_mfma_f32_32x32x16_bf16(__builtin_bit_cast(bf16x8, xw), mfr, acc[pt], 0, 0, 0); }
            }
        }
        bf16* yo = Y + (mb + tl) * SSD_IN + h * 64 + 4 * hf;
#pragma unroll
        for (int pt = 0; pt < 2; ++pt)
#pragma unroll
            for (int q = 0; q < 4; ++q) { v2u o; o.x = cvtpk(acc[pt][4 * q], acc[pt][4 * q + 1]); o.y = cvtpk(acc[pt][4 * q + 2], acc[pt][4 * q + 3]); *(v2u*)(yo + 32 * pt + 8 * q) = o; }
    }
}

__device__ __forceinline__ void p4_combine(Frame& F) {
    const int gw = F.bid * NWAVES + F.wave, NGW = F.G * NWAVES, lane = F.lane;
    bf16* Y = WSP(bf16, A_Y); const bf16* Z = WSP(bf16, A_Z); const float* ng = F.in[9];
    for (int m = gw; m < M; m += NGW) {
#pragma unroll 1
        for (int gi = 0; gi < SSD_G; ++gi) {
            const int ch = gi * 384 + lane * 8; float y[8]; float ss = 0.f;
            if (lane < 48) { const size_t o = (size_t)m * SSD_IN + ch; float a[8], z[8]; unpack8(*(const v4u*)(Y + o), a); unpack8(*(const v4u*)(Z + o), z);
#pragma unroll
                for (int jj = 0; jj < 8; ++jj) { y[jj] = a[jj] * z[jj]; ss += y[jj] * y[jj]; } }
            ss = wave_sum(ss);
            const float r = 1.0f / sqrtf(ss * (1.0f / 384.0f) + RMS_EPS);
            if (lane < 48) { const f32x4 g0 = *(const f32x4*)(ng + ch), g1 = *(const f32x4*)(ng + ch + 4);
                v4u o; o.x = pk2(y[0] * r * g0.x, y[1] * r * g0.y); o.y = pk2(y[2] * r * g0.z, y[3] * r * g0.w); o.z = pk2(y[4] * r * g1.x, y[5] * r * g1.y); o.w = pk2(y[6] * r * g1.z, y[7] * r * g1.w);
                *(v4u*)(Y + (size_t)m * SSD_IN + ch) = o; }
        }
    }
}

__device__ __forceinline__ void p8_ln_router(Frame& F) {
    const int gw = F.bid * NWAVES + F.wave, NGW = F.G * NWAVES, lane = F.lane;
    LAS float* wr = (LAS float*)F.lds;
    for (int i = F.tid; i < D * NE; i += NTHR) wr[(i & 15) * D + (i >> 4)] = F.in[27][i];
    __syncthreads();
    const float* HP = WSP(float, A_HP); float* H = WSP(float, A_H); bf16* HB = WSP(bf16, A_HB); float* AFF = WSP(float, A_AFF);
    const float* g1 = F.in[25]; const float* b1 = F.in[26];
    for (int m = gw; m < M; m += NGW) {
        const f32x4* xr = (const f32x4*)(HP + (size_t)m * D) + lane;
        f32x4 v[4]; float s = 0.f;
#pragma unroll
        for (int j = 0; j < 4; ++j) { v[j] = xr[64 * j]; s += (v[j].x + v[j].y) + (v[j].z + v[j].w); }
        const float mean = wave_sum(s) * (1.f / D); float s2 = 0.f;
#pragma unroll
        for (int j = 0; j < 4; ++j) { v[j] = v[j] - mean; s2 += (v[j].x * v[j].x + v[j].y * v[j].y) + (v[j].z * v[j].z + v[j].w * v[j].w); }
        const float rstd = 1.f / sqrtf(wave_sum(s2) * (1.f / D) + LN_EPS);
        float lg[16];
#pragma unroll
        for (int e = 0; e < 16; ++e) lg[e] = 0.f;
#pragma unroll
        for (int j = 0; j < 4; ++j) { const int c = 4 * lane + 256 * j; const f32x4 gg = *(const f32x4*)(g1 + c), bb = *(const f32x4*)(b1 + c);
            v[j] = v[j] * rstd * gg + bb;
            *((f32x4*)(H + (size_t)m * D) + lane + 64 * j) = v[j];
            v2u hb; hb.x = pk2(v[j].x, v[j].y); hb.y = pk2(v[j].z, v[j].w); *((v2u*)(HB + (size_t)m * D) + lane + 64 * j) = hb;
#pragma unroll
            for (int e = 0; e < 16; ++e) { const f32x4 w4 = *(const LAS f32x4*)(wr + e * D + c); lg[e] += (v[j].x * w4.x + v[j].y * w4.y) + (v[j].z * w4.z + v[j].w * w4.w); }
            asm volatile("" ::: "memory"); }
        { const bool hi = lane & 32;
#pragma unroll
          for (int k = 0; k < 8; ++k) { const float keep = hi ? lg[k + 8] : lg[k], send = hi ? lg[k] : lg[k + 8]; lg[k] = keep + __shfl_xor(send, 32); } }
        { const bool hi = lane & 16;
#pragma unroll
          for (int k = 0; k < 4; ++k) { const float keep = hi ? lg[k + 4] : lg[k], send = hi ? lg[k] : lg[k + 4]; lg[k] = keep + __shfl_xor(send, 16); } }
        { const bool hi = lane & 8;
#pragma unroll
          for (int k = 0; k < 2; ++k) { const float keep = hi ? lg[k + 2] : lg[k], send = hi ? lg[k] : lg[k + 2]; lg[k] = keep + __shfl_xor(send, 8); } }
        { const bool hi = lane & 4; const float keep = hi ? lg[1] : lg[0], send = hi ? lg[0] : lg[1]; lg[0] = keep + __shfl_xor(send, 4); }
        float lo = lg[0]; lo += __shfl_xor(lo, 2); lo += __shfl_xor(lo, 1);
        float mx = lo;
#pragma unroll
        for (int o = 4; o < 64; o <<= 1) mx = fmaxf(mx, __shfl_xor(mx, o));
        const float ex = expf(lo - mx); float sum = ex;
#pragma unroll
        for (int o = 4; o < 64; o <<= 1) sum += __shfl_xor(sum, o);
        if ((lane & 3) == 0) { const int e = lane >> 2, b = m / T, t = m % T; AFF[((size_t)b * NE + e) * T + t] = ex / sum; }
    }
}

__device__ __forceinline__ unsigned block_excl_scan(unsigned v, LAS unsigned* wsum  , int lane, int wave, unsigned& total) {
    unsigned inc = v;
#pragma unroll
    for (int o = 1; o < 64; o <<= 1) { const unsigned t = __shfl_up(inc, o); if (lane >= o) inc += t; }
    __syncthreads();
    if (lane == 63) wsum[wave] = inc;
    __syncthreads();
    unsigned off = 0, tot = 0;
#pragma unroll
    for (int w = 0; w < 8; ++w) { const unsigned s = wsum[w]; if (w < wave) off += s; tot += s; }
    total = tot; return off + inc - v;
}
__device__ __forceinline__ void p9_topk(Frame& F, int be) {
    const int b = be >> 4, e = be & 15, tid = F.tid;
    const float* av = WSP(float, A_AFF) + (size_t)be * T;
    int* IDX = WSP(int, A_IDX); int* SEL = WSP(int, A_SEL); float* GATE = WSP(float, A_GATE);
    LAS unsigned* hist = (LAS unsigned*)F.lds; LAS unsigned* shv = hist + 256; LAS unsigned* wsum = hist + 272;
    unsigned key[16];
#pragma unroll
    for (int q = 0; q < 4; ++q) { const v4u k4 = *(const v4u*)(av + tid * 16 + 4 * q); key[4 * q] = k4.x; key[4 * q + 1] = k4.y; key[4 * q + 2] = k4.z; key[4 * q + 3] = k4.w; }
    unsigned prefix = 0, pmask = 0, krem = CAP;
    for (int pass = 0; pass < 4; ++pass) {
        const int shift = 24 - 8 * pass;
        if (tid < 256) hist[tid] = 0u;
        __syncthreads();
#pragma unroll
        for (int i = 0; i < 16; ++i) if ((key[i] & pmask) == prefix) (void)__hip_atomic_fetch_add(&hist[(key[i] >> shift) & 255u], 1u, __ATOMIC_RELAXED, __HIP_MEMORY_SCOPE_WORKGROUP);
        __syncthreads();
        if (tid < 256) { unsigned above = 0; for (int d = tid + 1; d < 256; ++d) above += hist[d]; const unsigned mine = hist[tid];
            if (above < krem && krem <= above + mine) { shv[0] = (unsigned)tid; shv[1] = krem - above; } }
        __syncthreads();
        prefix |= shv[0] << shift; pmask |= 255u << shift; krem = shv[1];
        __syncthreads();
    }
    const unsigned Tk = prefix;
    unsigned cg = 0, ce = 0;
#pragma unroll
    for (int i = 0; i < 16; ++i) { cg += key[i] > Tk; ce += key[i] == Tk; }
    unsigned totg, tote;
    unsigned pg = block_excl_scan(cg, wsum, F.lane, F.wave, totg);
    unsigned pe = block_excl_scan(ce, wsum + 8, F.lane, F.wave, tote);
#pragma unroll
    for (int i = 0; i < 16; ++i) {
        const int t = tid * 16 + i; int slot = -1;
        if (key[i] > Tk) slot = (int)(pg++);
        else if (key[i] == Tk) { if (pe < krem) slot = (int)(totg + pe); ++pe; }
        const size_t m = (size_t)b * T + t;
        SEL[m * NE + e] = slot; GATE[m * NE + e] = __uint_as_float(key[i]);
        if (slot >= 0) IDX[(e * NB + b) * CAP + slot] = (int)m;
    }
}
__device__ __forceinline__ void p10_gather(Frame& F) {
    const int gw = F.bid * NWAVES + F.wave, NGW = F.G * NWAVES, lane = F.lane;
    const int* IDX = WSP(int, A_IDX); const bf16* HB = WSP(bf16, A_HB); bf16* XIN = WSP(bf16, A_XIN);
    for (int r = gw; r < MROWS; r += NGW) { const int m = IDX[r];
        const v4u* s = (const v4u*)(HB + (size_t)m * D); v4u* d = (v4u*)(XIN + (size_t)r * D);
        const v4u a = s[lane], bq = s[lane + 64]; d[lane] = a; d[lane + 64] = bq; }
}
__device__ __forceinline__ void p13_final(Frame& F) {
    const int gw = F.bid * NWAVES + F.wave, NGW = F.G * NWAVES, lane = F.lane;
    const float* H = WSP(float, A_H); const int* SEL = WSP(int, A_SEL); const float* GATE = WSP(float, A_GATE); const bf16* YE = WSP(bf16, A_YE);
    const float* g2 = F.in[31]; const float* b2 = F.in[32];
    for (int m = gw; m < M; m += NGW) {
        const int b = m / T;
        const int sl = SEL[(size_t)m * NE + (lane & 15)]; const float gt = GATE[(size_t)m * NE + (lane & 15)];
        f32x4 v[4];
#pragma unroll
        for (int j = 0; j < 4; ++j) v[j] = *((const f32x4*)(H + (size_t)m * D) + lane + 64 * j) * ALPHA;
#pragma unroll 1
        for (int e = 0; e < NE; ++e) {
            const int s = __shfl(sl, e); const float gv = __shfl(gt, e);
            if (s >= 0) { const bf16* yr = YE + ((size_t)(e * NB + b) * CAP + s) * D;
#pragma unroll
                for (int j = 0; j < 4; ++j) { const v2u w = *((const v2u*)yr + lane + 64 * j); v[j].x += gv * bflo(w.x); v[j].y += gv * bfhi(w.x); v[j].z += gv * bflo(w.y); v[j].w += gv * bfhi(w.y); } }
        }
        float s = 0.f;
#pragma unroll
        for (int j = 0; j < 4; ++j) s += (v[j].x + v[j].y) + (v[j].z + v[j].w);
        const float mean = wave_sum(s) * (1.f / D); float s2 = 0.f;
#pragma unroll
        for (int j = 0; j < 4; ++j) { v[j] = v[j] - mean; s2 += (v[j].x * v[j].x + v[j].y * v[j].y) + (v[j].z * v[j].z + v[j].w * v[j].w); }
        const float rstd = 1.f / sqrtf(wave_sum(s2) * (1.f / D) + LN_EPS);
#pragma unroll
        for (int j = 0; j < 4; ++j) { const int c = 4 * lane + 256 * j; const f32x4 gg = *(const f32x4*)(g2 + c), bb = *(const f32x4*)(b2 + c);
            *((f32x4*)(F.out + (size_t)m * D) + lane + 64 * j) = v[j] * rstd * gg + bb; }
    }
}

constexpr int N_PHASES = 16;
struct Args { const float* in[33]; float* out; unsigned char* ws; int ph_lo, ph_hi; };
__global__ void __launch_bounds__(NTHR, 2) fwd(Args args) {
    extern __shared__ __attribute__((aligned(16))) unsigned char lds[];
    Frame F;
    F.lds = (LAS unsigned char*)lds;
    F.tid = threadIdx.x; F.lane = F.tid & 63; F.wave = __builtin_amdgcn_readfirstlane(F.tid >> 6);
    F.bid = blockIdx.x; F.G = gridDim.x;
    F.in = args.in;
    F.out = args.out; F.ws = args.ws;
    volatile LAS unsigned* MISC = (volatile LAS unsigned*)(F.lds + MISC_OFF);
    if (F.tid < 64) MISC[F.tid] = 0u;
    __syncthreads();
    const int lo = args.ph_lo, hi = args.ph_hi;
    const bool single = (hi - lo) > 1;
    XcdBarrier bar; bar.bar = (unsigned*)(F.ws + WS_CTL) + CW_BAR; bar.x = 0; bar.st = nullptr;
    if (single) bar = xcd_barrier_post((unsigned*)(F.ws + WS_CTL) + CW_BAR, MISC + 8);
#ifndef PH_MASK
#define PH_MASK 0xffff
#endif
#define IN(k) (((PH_MASK >> (k)) & 1) && lo <= (k) && (k) < hi)
#define SEAM(k) do { if (IN(k) && IN((k) + 1)) xcd_barrier(bar); } while (0)

    if (IN(0)) { p0_prologue(F); p0_s5(F); } SEAM(0);
    if (IN(1)) {
        pg8::Gemm g{WSP(pg8::bf16_t, A_XB), WSP(pg8::bf16_t, WS_WIN), M, NIN_PAD, D, D, D}; pg8::StaticOrder S; S.init(M, NIN_PAD, F.G, F.bid);
        pg8::EpiIn E{WSP(pg8::bf16_t, A_Z), WSP(pg8::bf16_t, A_XBC), WSP(pg8::bf16_t, A_UC), WSP(pg8::bf16_t, A_GT), WSP(float, A_DT), F.in[6], F.in[7]};
        pg8::gemm_phase<pg8::EpiIn, pg8::StaticOrder, PG8_ALIGN, PG8_SP2>(F.lds, g, S, E);
    } SEAM(1);
    if (IN(2)) {
        if (F.bid >= 160) { pg8::Gemm g{WSP(pg8::bf16_t, A_UC), WSP(pg8::bf16_t, WS_WS5), S5_G * 512, S5_G * 256, 512, 768, 512}; pg8::S5aOrder S{F.bid, 160};
            pg8::EpiS5a E{WSP(float, WS_SLOC)};
            pg8::gemm_phase<pg8::EpiS5a, pg8::S5aOrder, PG8_ALIGN, PG8_SP2>(F.lds, g, S, E); __syncthreads(); }
        p2_conv(F);
    } SEAM(2);
    if (IN(3)) {
        for (int it = F.bid; it < S5_G * 4; it += F.G) s5_scan_item(F, it);
        __syncthreads();
        for (int it = F.bid * NWAVES + F.wave; it < 128 * SSD_H * 4; it += F.G * NWAVES) ssd_state_item(F, it);
    } SEAM(3);
    if (IN(4)) {
        { pg8::Gemm g{WSP(pg8::bf16_t, A_UC), WSP(pg8::bf16_t, WS_TV), S5_G * 512, S5_G * 512, 768, 768, 768}; pg8::S5cOrder S{F.G, F.bid};
          pg8::EpiS5c E{WSP(pg8::bf16_t, A_GY), WSP(pg8::bf16_t, A_UC), F.in[21]};
          pg8::gemm_phase<pg8::EpiS5c, pg8::S5cOrder, PG8_ALIGN, PG8_SP2>(F.lds, g, S, E); }
        ssd_scan(F, F.bid * NTHR + F.tid, F.G * NTHR);
    } SEAM(4);
    if (IN(5)) { __syncthreads(); for (int u = F.bid; u < 128 * SSD_G; u += F.G) ssd_out_unit(F, u); } SEAM(5);
    if (IN(6)) { p4_combine(F); } SEAM(6);
    if (IN(7)) {
        pg8::Gemm g{WSP(pg8::bf16_t, A_Y), WSP(pg8::bf16_t, WS_WOUT), M, D, SSD_IN, SSD_IN, SSD_IN}; pg8::StaticOrder S; S.init(M, D, F.G, F.bid);
        pg8::EpiSsdOut E{WSP(float, A_YA), WSP(pg8::bf16_t, A_GT)};
        pg8::gemm_phase<pg8::EpiSsdOut, pg8::StaticOrder, PG8_ALIGN, PG8_SP2>(F.lds, g, S, E);
    } SEAM(7);
    if (IN(8)) {
        pg8::Gemm g{WSP(pg8::bf16_t, A_GY), WSP(pg8::bf16_t, WS_WGLU), M, 2 * D, S5_W, S5_W, S5_W}; pg8::StaticOrder S; S.init(M, 2 * D, F.G, F.bid);
        pg8::EpiGlu E{WSP(pg8::bf16_t, A_MIX), WSP(float, A_YA), WSP(pg8::bf16_t, A_GT)};
        pg8::gemm_phase<pg8::EpiGlu, pg8::StaticOrder, PG8_ALIGN, PG8_SP2>(F.lds, g, S, E);
    } SEAM(8);
    if (IN(9)) {
        pg8::Gemm g{WSP(pg8::bf16_t, A_MIX), WSP(pg8::bf16_t, WS_WO), M, D, D, D, D}; pg8::StaticOrder S; S.init(M, D, F.G, F.bid);
        pg8::EpiWo E{WSP(float, A_HP), F.in[0], ALPHA};
        pg8::gemm_phase<pg8::EpiWo, pg8::StaticOrder, PG8_ALIGN, PG8_SP2>(F.lds, g, S, E);
    } SEAM(9);
    if (IN(10)) { p8_ln_router(F); } SEAM(10);
    if (IN(11)) { if (F.bid < NB * NE) p9_topk(F, F.bid); else w2_convert(F, (F.bid - NB * NE) * NWAVES + F.wave, (F.G - NB * NE) * NWAVES); } SEAM(11);
    if (IN(12)) { p10_gather(F); } SEAM(12);
    if (IN(13)) {
        pg8::Gemm g{WSP(pg8::bf16_t, A_XIN), WSP(pg8::bf16_t, WS_W1), MROWS, NE * 2 * FF, D, D, D}; pg8::MoeOrder1 S{F.G, F.bid};
        pg8::EpiMoe1 E{WSP(pg8::bf16_t, A_HID)};
        pg8::gemm_phase<pg8::EpiMoe1, pg8::MoeOrder1, PG8_ALIGN, PG8_SP2>(F.lds, g, S, E);
    } SEAM(13);
    if (IN(14)) {
        pg8::Gemm g{WSP(pg8::bf16_t, A_HID), WSP(pg8::bf16_t, WS_W2), MROWS, NE * D, FF, FF, FF}; pg8::MoeOrder2 S{F.G, F.bid};
        pg8::EpiMoe2 E{WSP(pg8::bf16_t, A_YE)};
        pg8::gemm_phase<pg8::EpiMoe2, pg8::MoeOrder2, PG8_ALIGN, PG8_SP2>(F.lds, g, S, E);
    } SEAM(14);
    if (IN(15)) { p13_final(F); }
#undef IN
#undef SEAM
}

#ifndef MK_ONE_LAUNCH
#define MK_ONE_LAUNCH 1
#endif
extern "C" void kernel_launch(void* const* d_in, const int* in_sizes, int n_in, void* d_out, int out_size, void* d_ws, size_t ws_size, hipStream_t stream) {
    static int grid = 0;
    if (grid == 0) {
        if (n_in != 33 || in_sizes[0] != M * D || out_size != M * D || ws_size < WS_END) { fprintf(stderr, "kernel_launch: unexpected problem (n_in %d, in0 %d, out %d, ws %zu < %zu)\n", n_in, n_in > 0 ? in_sizes[0] : -1, out_size, ws_size, (size_t)WS_END); grid = -1; return; }
        int dev = 0, cus = 0, per_cu = 0;
        if (hipGetDevice(&dev) != hipSuccess || hipDeviceGetAttribute(&cus, hipDeviceAttributeMultiprocessorCount, dev) != hipSuccess) { grid = -1; return; }
        if (hipFuncSetAttribute((const void*)fwd, hipFuncAttributeMaxDynamicSharedMemorySize, LDS_BYTES) != hipSuccess) { fprintf(stderr, "kernel_launch: hipFuncSetAttribute failed\n"); grid = -1; return; }
        if (hipOccupancyMaxActiveBlocksPerMultiprocessor(&per_cu, (const void*)fwd, NTHR, LDS_BYTES) != hipSuccess || per_cu < 1) fprintf(stderr, "kernel_launch: occupancy query reports %d blocks per CU\n", per_cu);
        (void)hipGetLastError();
        grid = cus;
    }
    if (grid < 0) return;
    (void)hipMemsetAsync((char*)d_ws + WS_CTL, 0, CTL_ZERO_BYTES, stream);
    Args a{};
    for (int i = 0; i < 33; ++i) a.in[i] = (const float*)d_in[i];
    a.out = (float*)d_out; a.ws = (unsigned char*)d_ws;
#if MK_ONE_LAUNCH
    a.ph_lo = 0; a.ph_hi = N_PHASES;
    hipLaunchKernelGGL(fwd, dim3(grid), dim3(NTHR), LDS_BYTES, stream, a);
#else
    for (int p = 0; p < N_PHASES; ++p) { a.ph_lo = p; a.ph_hi = p + 1; hipLaunchKernelGGL(fwd, dim3(grid), dim3(NTHR), LDS_BYTES, stream, a); }
#endif
}
```

```cpp
#include <hip/hip_runtime.h>
#include <cstdio>
#include <cstdint>
namespace pg8 {
#define PG8_LAS __attribute__((address_space(3)))
typedef unsigned short bf16_t;
typedef short bf16x8 __attribute__((ext_vector_type(8)));
typedef float f32x4 __attribute__((ext_vector_type(4)));
typedef unsigned u32x4 __attribute__((ext_vector_type(4)));
constexpr int BM = 256, BK = 64, HALF = 128, HTB = HALF * BK * 2  , STAGE_BYTES = 8 * HTB, NXCD = 8, WGM = 8;

__host__ __device__ __forceinline__ int lds_byte(int r, int c) { const int st = (r >> 4) * 2 + (c >> 5), rr = r & 15, cc = c & 31, ob = rr * 64 + cc * 2; return st * 1024 + (ob ^ (((ob >> 9) & 1) << 5)); }
__host__ __device__ __forceinline__ void stage_rc(int b, int& R, int& C) { const int st = b / 1024, sb = b % 1024, swz = sb ^ (((sb >> 9) & 1) << 5); R = (st >> 1) * 16 + swz / 64; C = (st & 1) * 32 + (swz % 64) / 2; }
__host__ __device__ __forceinline__ int perm32(int rho) { const int n = rho >> 4, i = rho & 15; return 8 * (i >> 2) + 4 * n + (i & 3); }

struct Unit { int pm, pn; };
struct Gemm { const bf16_t* A; const bf16_t* Bt; int M, N, K, lda, ldb; };

struct StaticOrder {
    int nM, nN, nwg, G, c;
    __host__ __device__ void init(int M, int N, int G_, int c_) { nM = M / BM; nN = N / BM; nwg = nM * nN; G = G_; c = c_; }
    __host__ __device__ bool next(int i, Unit& u) const {
        const long L = (long)i * G + c; if (L >= nwg) return false;
        int wgid = (int)L; { const int q = nwg / NXCD, r = nwg % NXCD, xcd = wgid % NXCD, off = wgid / NXCD; wgid = (xcd < r ? xcd * (q + 1) : r * (q + 1) + (xcd - r) * q) + off; }
        const int nig = WGM * nN, gid = wgid / nig, fm = gid * WGM, gsz = (nM - fm) < WGM ? (nM - fm) : WGM;
        u.pm = fm + ((wgid % nig) % gsz); u.pn = (wgid % nig) / gsz; return true;
    }
    __device__ __forceinline__ void a_ready(const Unit&) const {}
    __device__ __forceinline__ void done(const Unit&) const {}
};

typedef __bf16 bf16v2_t __attribute__((ext_vector_type(2)));
typedef float f32v2_t __attribute__((ext_vector_type(2)));
__device__ __forceinline__ unsigned cvt_pk_bf16(float lo, float hi) { const f32v2_t f = {lo, hi}; return __builtin_bit_cast(unsigned, __builtin_convertvector(f, bf16v2_t)); }
typedef float f32x2 __attribute__((ext_vector_type(2)));
__device__ __forceinline__ f32x2 gelu_pk(f32x2 v) {
    const f32x2 av = __builtin_elementwise_abs(v), d = av * 0.2316418882f + 1.0f;
    f32x2 t; t.x = __builtin_amdgcn_rcpf(d.x); t.y = __builtin_amdgcn_rcpf(d.y);
    f32x2 q = t * 0.5307027145f + (-0.7265760135f); q = q * t + 0.7107068705f; q = q * t + (-0.142248368f); q = q * t + 0.127414796f; q = q * t;
    const f32x2 s = (v * v) * (-0.72134752044f);
    f32x2 e; e.x = __builtin_amdgcn_exp2f(s.x); e.y = __builtin_amdgcn_exp2f(s.y);
    const f32x2 m = v * (q * e), r = v - m;
    f32x2 o; o.x = v.x < 0.f ? m.x : r.x; o.y = v.y < 0.f ? m.y : r.y; return o;
}


__device__ __forceinline__ float fsigmoid(float x) { return __builtin_amdgcn_rcpf(1.0f + __expf(-x)); }
__device__ __forceinline__ float fsilu(float x) { return x * fsigmoid(x); }
__device__ __forceinline__ float bf_lo(unsigned w) { return __uint_as_float(w << 16); }
__device__ __forceinline__ float bf_hi(unsigned w) { return __uint_as_float(w & 0xffff0000u); }
typedef unsigned u32x2 __attribute__((ext_vector_type(2)));

struct EpiIn {
    static constexpr bool PERM = true, AFTER_DRAIN = false;
    bf16_t *Z, *XBC, *UC, *GT; float* DT; const float *dtb_f, *dtb_b;
    __device__ __forceinline__ void operator()(const f32x4 (&acc)[2][2][4][2], const Unit& u, int wr, int wc, int fr, int fq) const {
        const int row0 = u.pm * BM + wr * 64 + fr; const int pn = u.pn;
        if (pn == 16) {
            if (wc < 2) {
#pragma unroll
                for (int n = 0; n < 2; ++n) { const int col = wc * 32 + 8 * fq + 4 * n;
                    if (col < 48) { f32x4 bv;
#pragma unroll
                        for (int j = 0; j < 4; ++j) { const int cc = col + j; bv[j] = cc < 24 ? dtb_f[cc] : dtb_b[cc - 24]; }
#pragma unroll
                        for (int ai = 0; ai < 2; ++ai)
#pragma unroll
                            for (int m = 0; m < 4; ++m) { f32x4 v = acc[ai][0][m][n] + bv;
#pragma unroll
                                for (int j = 0; j < 4; ++j) { const float x = v[j]; v[j] = fmaxf(x, 0.f) + log1pf(__expf(-fabsf(x))); }
                                *(f32x4*)(DT + (size_t)(row0 + ai * HALF + m * 16) * 48 + col) = v; } } }
            }
            return;
        }
        int mode, ldc, colt; bf16_t* base;
        if (pn < 6) { mode = 1; base = Z; ldc = 1536; colt = pn * BM; }
        else if (pn < 16) { mode = 0; base = XBC; ldc = 2560; colt = (pn - 6) * BM; }
        else if (pn < 20) {
            const int uc = (pn - 17) * BM + wc * 32 + 8 * fq, g0 = uc >> 4, j0 = uc & 15;
#pragma unroll
            for (int ai = 0; ai < 2; ++ai)
#pragma unroll
                for (int m = 0; m < 4; ++m) { const int r = row0 + ai * HALF + m * 16, cl = r >> 5, s = r & 31;
#pragma unroll
                    for (int bj = 0; bj < 2; ++bj) { const f32x4 v0 = acc[ai][bj][m][0], v1 = acc[ai][bj][m][1];
                        u32x4 w; w.x = cvt_pk_bf16(v0[0], v0[1]); w.y = cvt_pk_bf16(v0[2], v0[3]); w.z = cvt_pk_bf16(v1[0], v1[1]); w.w = cvt_pk_bf16(v1[2], v1[3]);
                        *(u32x4*)(UC + ((size_t)((g0 + 8 * bj) * 512 + cl) * 768 + s * 16 + j0)) = w; } }
            return; }
        else { mode = 2; base = GT; ldc = 2048; colt = (pn - 20) * BM; }
        const int col0 = colt + wc * 32 + 8 * fq;
#pragma unroll
        for (int ai = 0; ai < 2; ++ai)
#pragma unroll
            for (int m = 0; m < 4; ++m) { bf16_t* rowp = base + (size_t)(row0 + ai * HALF + m * 16) * ldc + col0;
#pragma unroll
                for (int bj = 0; bj < 2; ++bj) { f32x4 v0 = acc[ai][bj][m][0], v1 = acc[ai][bj][m][1];
                    if (mode == 1) {
#pragma unroll
                        for (int j = 0; j < 4; ++j) { v0[j] = fsilu(v0[j]); v1[j] = fsilu(v1[j]); } }
                    else if (mode == 2) {
#pragma unroll
                        for (int j = 0; j < 4; ++j) { v0[j] = fsigmoid(v0[j]); v1[j] = fsigmoid(v1[j]); } }
                    u32x4 w; w.x = cvt_pk_bf16(v0[0], v0[1]); w.y = cvt_pk_bf16(v0[2], v0[3]); w.z = cvt_pk_bf16(v1[0], v1[1]); w.w = cvt_pk_bf16(v1[2], v1[3]);
                    *(u32x4*)(rowp + bj * HALF) = w; } }
    }
};
struct EpiSsdOut {
    static constexpr bool PERM = false, AFTER_DRAIN = false;
    float* YA; const bf16_t* GT;
    __device__ __forceinline__ void operator()(const f32x4 (&acc)[2][2][4][2], const Unit& u, int wr, int wc, int fr, int fq) const {
        const int row0 = u.pm * BM + wr * 64 + fr, col0 = u.pn * BM + wc * 32 + 4 * fq;
#pragma unroll
        for (int ai = 0; ai < 2; ++ai)
#pragma unroll
            for (int m = 0; m < 4; ++m) { const size_t r = (size_t)(row0 + ai * HALF + m * 16);
#pragma unroll
                for (int bj = 0; bj < 2; ++bj)
#pragma unroll
                    for (int n = 0; n < 2; ++n) { const int c = col0 + bj * HALF + n * 16; const u32x2 g = *(const u32x2*)(GT + r * 2048 + c);
                        f32x4 v = acc[ai][bj][m][n]; v[0] *= bf_lo(g.x); v[1] *= bf_hi(g.x); v[2] *= bf_lo(g.y); v[3] *= bf_hi(g.y);
                        *(f32x4*)(YA + r * 1024 + c) = v; } }
    }
};
struct EpiGlu {
    static constexpr bool PERM = true, AFTER_DRAIN = false;
    bf16_t* MIX; const float* YA; const bf16_t* GT;
    __device__ __forceinline__ void operator()(const f32x4 (&acc)[2][2][4][2], const Unit& u, int wr, int wc, int fr, int fq) const {
        const int row0 = u.pm * BM + wr * 64 + fr, col0 = u.pn * HALF + wc * 32 + 8 * fq;
#pragma unroll
        for (int ai = 0; ai < 2; ++ai)
#pragma unroll
            for (int m = 0; m < 4; ++m) { const size_t r = (size_t)(row0 + ai * HALF + m * 16);
                const u32x4 g = *(const u32x4*)(GT + r * 2048 + 1024 + col0); const f32x4 y0 = *(const f32x4*)(YA + r * 1024 + col0), y1 = *(const f32x4*)(YA + r * 1024 + col0 + 4);
                f32x4 a0 = acc[ai][0][m][0], a1 = acc[ai][0][m][1]; const f32x4 b0 = acc[ai][1][m][0], b1 = acc[ai][1][m][1];
#pragma unroll
                for (int j = 0; j < 4; ++j) { a0[j] *= fsigmoid(b0[j]); a1[j] *= fsigmoid(b1[j]); }
                a0[0] = a0[0] * bf_lo(g.x) + y0[0]; a0[1] = a0[1] * bf_hi(g.x) + y0[1]; a0[2] = a0[2] * bf_lo(g.y) + y0[2]; a0[3] = a0[3] * bf_hi(g.y) + y0[3];
                a1[0] = a1[0] * bf_lo(g.z) + y1[0]; a1[1] = a1[1] * bf_hi(g.z) + y1[1]; a1[2] = a1[2] * bf_lo(g.w) + y1[2]; a1[3] = a1[3] * bf_hi(g.w) + y1[3];
                u32x4 w; w.x = cvt_pk_bf16(a0[0], a0[1]); w.y = cvt_pk_bf16(a0[2], a0[3]); w.z = cvt_pk_bf16(a1[0], a1[1]); w.w = cvt_pk_bf16(a1[2], a1[3]);
                *(u32x4*)(MIX + r * 1024 + col0) = w; }
    }
};
struct EpiWo {
    static constexpr bool PERM = false, AFTER_DRAIN = false;
    float* HP; const float* X; float alpha;
    __device__ __forceinline__ void operator()(const f32x4 (&acc)[2][2][4][2], const Unit& u, int wr, int wc, int fr, int fq) const {
        const int row0 = u.pm * BM + wr * 64 + fr, col0 = u.pn * BM + wc * 32 + 4 * fq;
#pragma unroll
        for (int ai = 0; ai < 2; ++ai)
#pragma unroll
            for (int m = 0; m < 4; ++m) { const size_t r = (size_t)(row0 + ai * HALF + m * 16);
#pragma unroll
                for (int bj = 0; bj < 2; ++bj)
#pragma unroll
                    for (int n = 0; n < 2; ++n) { const int c = col0 + bj * HALF + n * 16; const f32x4 xv = *(const f32x4*)(X + r * 1024 + c);
                        *(f32x4*)(HP + r * 1024 + c) = acc[ai][bj][m][n] + xv * alpha; } }
    }
};
struct EpiMoe1 {
    static constexpr bool PERM = true, AFTER_DRAIN = false;
    bf16_t* HID;
    __device__ __forceinline__ void operator()(const f32x4 (&acc)[2][2][4][2], const Unit& u, int wr, int wc, int fr, int fq) const {
        const int row0 = u.pm * BM + wr * 64 + fr, col0 = (u.pn % 22) * HALF + wc * 32 + 8 * fq;
#pragma unroll
        for (int ai = 0; ai < 2; ++ai)
#pragma unroll
            for (int m = 0; m < 4; ++m) { const size_t r = (size_t)(row0 + ai * HALF + m * 16);
                f32x4 a0 = acc[ai][0][m][0], a1 = acc[ai][0][m][1]; const f32x4 b0 = acc[ai][1][m][0], b1 = acc[ai][1][m][1];
#pragma unroll
                for (int j = 0; j < 4; ++j) { a0[j] = fsilu(a0[j]) * b0[j]; a1[j] = fsilu(a1[j]) * b1[j]; }
                u32x4 w; w.x = cvt_pk_bf16(a0[0], a0[1]); w.y = cvt_pk_bf16(a0[2], a0[3]); w.z = cvt_pk_bf16(a1[0], a1[1]); w.w = cvt_pk_bf16(a1[2], a1[3]);
                *(u32x4*)(HID + r * 2816 + col0) = w; }
    }
};
struct EpiMoe2 {
    static constexpr bool PERM = true, AFTER_DRAIN = false;
    bf16_t* Y;
    __device__ __forceinline__ void operator()(const f32x4 (&acc)[2][2][4][2], const Unit& u, int wr, int wc, int fr, int fq) const {
        const int row0 = u.pm * BM + wr * 64 + fr, col0 = (u.pn & 3) * BM + wc * 32 + 8 * fq;
#pragma unroll
        for (int ai = 0; ai < 2; ++ai)
#pragma unroll
            for (int m = 0; m < 4; ++m) { bf16_t* rowp = Y + (size_t)(row0 + ai * HALF + m * 16) * 1024 + col0;
#pragma unroll
                for (int bj = 0; bj < 2; ++bj) { const f32x4 v0 = acc[ai][bj][m][0], v1 = acc[ai][bj][m][1];
                    u32x4 w; w.x = cvt_pk_bf16(v0[0], v0[1]); w.y = cvt_pk_bf16(v0[2], v0[3]); w.z = cvt_pk_bf16(v1[0], v1[1]); w.w = cvt_pk_bf16(v1[2], v1[3]);
                    *(u32x4*)(rowp + bj * HALF) = w; } }
    }
};

struct EpiS5a {
    static constexpr bool PERM = false, AFTER_DRAIN = false;
    float* SLOC;
    __device__ __forceinline__ void operator()(const f32x4 (&acc)[2][2][4][2], const Unit& u, int wr, int wc, int fr, int fq) const {
        const int row0 = u.pm * BM + wr * 64 + fr, col0 = wc * 32 + 4 * fq;
#pragma unroll
        for (int ai = 0; ai < 2; ++ai)
#pragma unroll
            for (int m = 0; m < 4; ++m) { float* rowp = SLOC + (size_t)(row0 + ai * HALF + m * 16) * 256 + col0;
#pragma unroll
                for (int bj = 0; bj < 2; ++bj)
#pragma unroll
                    for (int n = 0; n < 2; ++n) *(f32x4*)(rowp + bj * HALF + n * 16) = acc[ai][bj][m][n]; }
    }
};
__device__ __forceinline__ float gelu_tanh_f(float x) { const float uu = 0.7978845608028654f * (x + 0.044715f * x * x * x); const float e = __expf(2.f * uu); return 0.5f * x * (2.f - 2.f * __builtin_amdgcn_rcpf(e + 1.f)); }
struct EpiS5c {
    static constexpr bool PERM = true, AFTER_DRAIN = false;
    bf16_t* GY; const bf16_t* UC; const float* d5;
    __device__ __forceinline__ void operator()(const f32x4 (&acc)[2][2][4][2], const Unit& u, int wr, int wc, int fr, int fq) const {
        const int g = u.pm >> 1, cl0 = (u.pm & 1) * BM + wr * 64 + fr, nl0 = (u.pn & 1) * BM + wc * 32 + 8 * fq;
        const int k0 = nl0 & 15; const f32x4 d0 = *(const f32x4*)(d5 + g * 16 + k0), d1 = *(const f32x4*)(d5 + g * 16 + k0 + 4);
#pragma unroll
        for (int ai = 0; ai < 2; ++ai)
#pragma unroll
            for (int m = 0; m < 4; ++m) { const int cl = cl0 + ai * HALF + m * 16;
#pragma unroll
                for (int bj = 0; bj < 2; ++bj) { const int nl = nl0 + bj * HALF, t = nl >> 4;
                    const u32x4 uw = *(const u32x4*)(UC + ((size_t)(g * 512 + cl) * 768 + nl));
                    f32x4 v0 = acc[ai][bj][m][0], v1 = acc[ai][bj][m][1];
                    v0[0] += bf_lo(uw.x) * d0[0]; v0[1] += bf_hi(uw.x) * d0[1]; v0[2] += bf_lo(uw.y) * d0[2]; v0[3] += bf_hi(uw.y) * d0[3];
                    v1[0] += bf_lo(uw.z) * d1[0]; v1[1] += bf_hi(uw.z) * d1[1]; v1[2] += bf_lo(uw.w) * d1[2]; v1[3] += bf_hi(uw.w) * d1[3];
#pragma unroll
                    for (int j = 0; j < 4; ++j) { v0[j] = gelu_tanh_f(v0[j]); v1[j] = gelu_tanh_f(v1[j]); }
                    u32x4 w; w.x = cvt_pk_bf16(v0[0], v0[1]); w.y = cvt_pk_bf16(v0[2], v0[3]); w.z = cvt_pk_bf16(v1[0], v1[1]); w.w = cvt_pk_bf16(v1[2], v1[3]);
                    *(u32x4*)(GY + (size_t)(cl * 32 + t) * 768 + g * 16 + k0) = w; } }
    }
};
struct S5aOrder {
    int c, lo;
    __device__ __forceinline__ bool next(int i, Unit& u) const { if (i > 0 || c < lo || c >= lo + 96) return false; u.pm = c - lo; u.pn = (c - lo) >> 1; return true; }
    __device__ __forceinline__ void a_ready(const Unit&) const {}
    __device__ __forceinline__ void done(const Unit&) const {}
};
struct S5cOrder {
    int G, c;
    __device__ __forceinline__ bool next(int i, Unit& u) const { const int L = i * G + c; if (L >= 192) return false; const int g = L >> 2; u.pm = 2 * g + (L & 1); u.pn = 2 * g + ((L >> 1) & 1); return true; }
    __device__ __forceinline__ void a_ready(const Unit&) const {}
    __device__ __forceinline__ void done(const Unit&) const {}
};
struct MoeOrder1 {
    int G, c;
    __device__ __forceinline__ bool next(int i, Unit& u) const {
        if (G == 256) { if (i >= 11) return false; const int x = c & 7, j = c >> 3, q = x * 44 + i * 4 + (j >> 3); u.pm = (q / 22) * 8 + (j & 7); u.pn = q; return true; }
        const long L = (long)i * G + c; if (L >= 2816) return false; const int e = (int)(L / 176), r = (int)(L % 176); u.pm = e * 8 + (r & 7); u.pn = e * 22 + (r >> 3); return true;
    }
    __device__ __forceinline__ void a_ready(const Unit&) const {}
    __device__ __forceinline__ void done(const Unit&) const {}
};
struct MoeOrder2 {
    int G, c;
    __device__ __forceinline__ bool next(int i, Unit& u) const {
        if (G == 256) { if (i >= 2) return false; const int x = c & 7, j = c >> 3, e = 2 * x + i; u.pm = e * 8 + (j & 7); u.pn = e * 4 + (j >> 3); return true; }
        const long L = (long)i * G + c; if (L >= 512) return false; const int e = (int)(L / 32), r = (int)(L % 32); u.pm = e * 8 + (r & 7); u.pn = e * 4 + (r >> 3); return true;
    }
    __device__ __forceinline__ void a_ready(const Unit&) const {}
    __device__ __forceinline__ void done(const Unit&) const {}
};
template <class Epi, class Sched, bool ALIGN_EPI = false, bool SP2 = false>
__device__ __forceinline__ void gemm_phase(PG8_LAS unsigned char* lds, const Gemm g, const Sched& S, const Epi& E) {
    const int tid = threadIdx.x, wid = __builtin_amdgcn_readfirstlane(tid >> 6), lane = tid & 63, wr = wid >> 2, wc = wid & 3, fr = lane & 15, fq = lane >> 4;
    const int K = g.K, nt = K / BK;
    unsigned voffA[2], voffB[2];
#pragma unroll
    for (int i = 0; i < 2; ++i) { int R, C; stage_rc(tid * 16 + i * 8192, R, C); const int Rb = Epi::PERM ? ((R & ~31) + perm32(R & 31)) : R;
        voffA[i] = (unsigned)(R * g.lda + C) * 2u; voffB[i] = (unsigned)(Rb * g.ldb + C) * 2u; }
    const size_t kstep = (size_t)(BK * 2);
    const size_t hstepA = (size_t)HALF * g.lda * 2, hstepB = (size_t)HALF * g.ldb * 2;
    const size_t tstepA = 2 * hstepA, tstepB = 2 * hstepB;
    const unsigned ldsw = (unsigned)wid * 1024u;
    const int aoff = lds_byte(wr * 64 + fr, fq * 8), boff = lds_byte(wc * 32 + fr, fq * 8);
#define PG8_SA(b, h) (((b) * 2 + (h)) * HTB)
#define PG8_SB(b, h) ((4 + (b) * 2 + (h)) * HTB)
#define PG8_STAGE(bufoff, gbase, voff) do { _Pragma("unroll") for (int _i = 0; _i < 2; ++_i) \
        __builtin_amdgcn_global_load_lds((const unsigned*)((const char*)(gbase) + (voff)[_i]), (PG8_LAS unsigned*)(lds + (bufoff) + ldsw + _i * 8192), 16, 0, 0); } while (0)
#define PG8_LDA(dst, b, h) do { _Pragma("unroll") for (int m = 0; m < 4; ++m) _Pragma("unroll") for (int k = 0; k < 2; ++k) dst[m][k] = *(const PG8_LAS bf16x8*)(lds + PG8_SA(b, h) + aoff + m * 2048 + k * 1024); } while (0)
#define PG8_LDB(dst, b, h) do { _Pragma("unroll") for (int n = 0; n < 2; ++n) _Pragma("unroll") for (int k = 0; k < 2; ++k) dst[n][k] = *(const PG8_LAS bf16x8*)(lds + PG8_SB(b, h) + boff + n * 2048 + k * 1024); } while (0)
#define PG8_MMA(ai, bj, At, Bt) do { __builtin_amdgcn_s_setprio(1); _Pragma("unroll") for (int m = 0; m < 4; ++m) _Pragma("unroll") for (int n = 0; n < 2; ++n) _Pragma("unroll") for (int k = 0; k < 2; ++k) \
        acc[ai][bj][m][n] = __builtin_amdgcn_mfma_f32_16x16x32_bf16(Bt[n][k], At[m][k], acc[ai][bj][m][n], 0, 0, 0); __builtin_amdgcn_s_setprio(0); } while (0)
#define PG8_WAIT_V(n) asm volatile("s_waitcnt vmcnt(" #n ")" ::: "memory")
#define PG8_WAIT_L(n) asm volatile("s_waitcnt lgkmcnt(" #n ")" ::: "memory")
#define PG8_BAR __builtin_amdgcn_s_barrier()
#define PG8_SCHED __builtin_amdgcn_sched_barrier(0)
    Unit cur, nxt; int ui = 0;
    if (!S.next(0, cur)) return;
    f32x4 acc[2][2][4][2];
#pragma unroll
    for (int a = 0; a < 2; ++a)
#pragma unroll
        for (int b = 0; b < 2; ++b)
#pragma unroll
            for (int m = 0; m < 4; ++m)
#pragma unroll
                for (int n = 0; n < 2; ++n) acc[a][b][m][n] = (f32x4){0.f, 0.f, 0.f, 0.f};
    bf16x8 At[4][2], B0[2][2], B1[2][2];
    const char* cA = (const char*)g.A + (size_t)cur.pm * tstepA; const char* cB = (const char*)g.Bt + (size_t)cur.pn * tstepB;
    S.a_ready(cur);
    if constexpr (SP2) {
        PG8_STAGE(PG8_SB(0, 0), cB, voffB); PG8_STAGE(PG8_SB(0, 1), cB + hstepB, voffB); PG8_STAGE(PG8_SA(0, 0), cA, voffA); PG8_STAGE(PG8_SA(0, 1), cA + hstepA, voffA);
        if (wr == 1) PG8_BAR;
        PG8_WAIT_V(2); PG8_BAR;
        PG8_STAGE(PG8_SB(1, 0), cB + kstep, voffB); PG8_STAGE(PG8_SA(1, 0), cA + kstep, voffA); PG8_STAGE(PG8_SB(1, 1), cB + hstepB + kstep, voffB);
        PG8_WAIT_V(6); PG8_BAR;
    } else {
        PG8_STAGE(PG8_SB(0, 0), cB, voffB); PG8_STAGE(PG8_SA(0, 0), cA, voffA); PG8_STAGE(PG8_SB(0, 1), cB + hstepB, voffB); PG8_STAGE(PG8_SA(0, 1), cA + hstepA, voffA);
        if (wr == 1) PG8_BAR;
        PG8_WAIT_V(4); PG8_BAR;
        PG8_STAGE(PG8_SB(1, 0), cB + kstep, voffB); PG8_STAGE(PG8_SA(1, 0), cA + kstep, voffA); PG8_STAGE(PG8_SB(1, 1), cB + hstepB + kstep, voffB);
        PG8_WAIT_V(6); PG8_BAR;
    }
    for (;;) {
        const bool has_next = S.next(ui + 1, nxt);
        const char* nA = has_next ? (const char*)g.A + (size_t)nxt.pm * tstepA : cA; const char* nB = has_next ? (const char*)g.Bt + (size_t)nxt.pn * tstepB : cB;
        for (int t = 0; t < nt; t += 2) {
            const bool last = (t == nt - 2);
            const char* a1 = cA + (size_t)(t + 1) * kstep;
            const char* a2 = last ? nA : cA + (size_t)(t + 2) * kstep; const char* b2 = last ? nB : cB + (size_t)(t + 2) * kstep;
            const char* a3 = a2 + kstep; const char* b3 = b2 + kstep;
            if (last && has_next) S.a_ready(nxt);
            if constexpr (SP2) {
            PG8_LDB(B0, 0, 0); PG8_LDB(B1, 0, 1); PG8_SCHED; PG8_LDA(At, 0, 0); PG8_STAGE(PG8_SA(1, 1), a1 + hstepA, voffA);
            PG8_WAIT_V(8); PG8_WAIT_L(0); PG8_BAR; PG8_MMA(0, 0, At, B0); PG8_MMA(0, 1, At, B1); PG8_BAR; PG8_SCHED;
            PG8_LDA(At, 0, 1); PG8_STAGE(PG8_SB(0, 0), b2, voffB); PG8_STAGE(PG8_SB(0, 1), b2 + hstepB, voffB); PG8_STAGE(PG8_SA(0, 0), a2, voffA);
            PG8_WAIT_V(8); PG8_WAIT_L(0); PG8_BAR; PG8_MMA(1, 0, At, B0); PG8_MMA(1, 1, At, B1); PG8_BAR; PG8_SCHED;
            PG8_LDB(B0, 1, 0); PG8_LDB(B1, 1, 1); PG8_SCHED; PG8_LDA(At, 1, 0); PG8_STAGE(PG8_SA(0, 1), a2 + hstepA, voffA);
            PG8_WAIT_V(8); PG8_WAIT_L(0); PG8_BAR; PG8_MMA(0, 0, At, B0); PG8_MMA(0, 1, At, B1); PG8_BAR; PG8_SCHED;
            PG8_LDA(At, 1, 1); PG8_STAGE(PG8_SB(1, 0), b3, voffB); PG8_STAGE(PG8_SB(1, 1), b3 + hstepB, voffB); PG8_STAGE(PG8_SA(1, 0), a3, voffA);
            PG8_WAIT_V(8); PG8_WAIT_L(0); PG8_BAR; PG8_MMA(1, 0, At, B0); PG8_MMA(1, 1, At, B1); PG8_BAR; PG8_SCHED;
            } else {
            PG8_LDB(B0, 0, 0); PG8_SCHED; PG8_LDA(At, 0, 0); PG8_STAGE(PG8_SA(1, 1), a1 + hstepA, voffA);
            PG8_WAIT_L(8); PG8_BAR; PG8_WAIT_L(0); PG8_MMA(0, 0, At, B0); PG8_BAR; PG8_SCHED;
            PG8_LDB(B1, 0, 1); PG8_STAGE(PG8_SB(0, 0), b2, voffB);
            PG8_BAR; PG8_WAIT_L(0); PG8_MMA(0, 1, At, B1); PG8_BAR;
            PG8_LDA(At, 0, 1); PG8_STAGE(PG8_SA(0, 0), a2, voffA);
            PG8_BAR; PG8_WAIT_L(0); PG8_MMA(1, 0, At, B0); PG8_BAR; PG8_SCHED;
            PG8_STAGE(PG8_SB(0, 1), b2 + hstepB, voffB);
            PG8_WAIT_V(6); PG8_BAR; PG8_MMA(1, 1, At, B1); PG8_BAR;
            PG8_LDB(B0, 1, 0); PG8_SCHED; PG8_LDA(At, 1, 0); PG8_STAGE(PG8_SA(0, 1), a2 + hstepA, voffA);
            PG8_WAIT_L(8); PG8_BAR; PG8_WAIT_L(0); PG8_MMA(0, 0, At, B0); PG8_BAR; PG8_SCHED;
            PG8_LDB(B1, 1, 1); PG8_STAGE(PG8_SB(1, 0), b3, voffB);
            PG8_BAR; PG8_WAIT_L(0); PG8_MMA(0, 1, At, B1); PG8_BAR;
            PG8_LDA(At, 1, 1); PG8_STAGE(PG8_SA(1, 0), a3, voffA);
            PG8_BAR; PG8_WAIT_L(0); PG8_MMA(1, 0, At, B0); PG8_BAR; PG8_SCHED;
            PG8_STAGE(PG8_SB(1, 1), b3 + hstepB, voffB);
            PG8_WAIT_V(6); PG8_BAR; PG8_MMA(1, 1, At, B1); PG8_BAR;
            }
        }
        if constexpr (ALIGN_EPI) { if (wr == 0) PG8_BAR; }
        if constexpr (!Epi::AFTER_DRAIN) { E(acc, cur, wr, wc, fr, fq); S.done(cur); }
        if (!has_next) break;
#pragma unroll
        for (int a = 0; a < 2; ++a)
#pragma unroll
            for (int b = 0; b < 2; ++b)
#pragma unroll
                for (int m = 0; m < 4; ++m)
#pragma unroll
                    for (int n = 0; n < 2; ++n) acc[a][b][m][n] = (f32x4){0.f, 0.f, 0.f, 0.f};
        cur = nxt; cA = nA; cB = nB; ++ui;
        if constexpr (ALIGN_EPI) { if (wr == 1) PG8_BAR; }
    }
    PG8_WAIT_V(0);
    if constexpr (!ALIGN_EPI) { if (wr == 0) PG8_BAR; }
    PG8_BAR;
    if constexpr (Epi::AFTER_DRAIN) { E.fused(acc, cur, wr, wc, fr, fq, lds, wid, lane); S.done(cur); }
#undef PG8_SA
#undef PG8_SB
#undef PG8_STAGE
#undef PG8_LDA
#undef PG8_LDB
#undef PG8_MMA
#undef PG8_WAIT_V
#undef PG8_WAIT_L
#undef PG8_BAR
#undef PG8_SCHED
}
}
#ifndef PG8_SP2
#define PG8_SP2 true
#endif
#ifndef PG8_ALIGN
#define PG8_ALIGN true
#endif

constexpr int NWAVES = 8, NTHR = 512;
constexpr int D = 1024, NB = 2, T = 8192, M = NB * T;
constexpr int SSD_H = 24, SSD_P = 64, SSD_IN = 1536, SSD_G = 4, SSD_N = 128, XBC = 2560, INCOLS = 6960, NIN_PAD = 7168;
constexpr int S5_W = 768, S5_G = 48, S5_P = 64, S5_K = 16;
constexpr int NE = 16, FF = 2816, CAP = 1024, MROWS = NE * NB * CAP;
constexpr float LN_EPS = 1e-5f, RMS_EPS = 1e-5f;
constexpr float ALPHA = 1.189207115002721f;

constexpr size_t MiB = 1u << 20;
constexpr size_t WS_CTL = 0, CTL_ZERO_BYTES = 64 * 1024;
constexpr size_t WS_WIN = 1 * MiB, WS_WOUT = 15 * MiB, WS_WGLU = 18 * MiB, WS_WO = 21 * MiB, WS_W1 = 23 * MiB, WS_W2 = 199 * MiB, WS_ACT = 287 * MiB;
constexpr size_t A_XB = WS_ACT + 0 * MiB;
constexpr size_t A_BN = WS_ACT + 0 * MiB;
constexpr size_t A_CN = WS_ACT + 16 * MiB;
constexpr size_t A_Z = WS_ACT + 32 * MiB;
constexpr size_t A_XBC = WS_ACT + 80 * MiB;
constexpr size_t A_S = WS_ACT + 80 * MiB;
constexpr size_t A_XT = WS_ACT + 176 * MiB;
constexpr size_t A_BT = WS_ACT + 224 * MiB;
constexpr size_t A_SV = WS_ACT + 240 * MiB;
constexpr size_t A_DT = WS_ACT + 252 * MiB;
constexpr size_t A_TOT = WS_ACT + 255 * MiB;
constexpr size_t A_UC = WS_ACT + 268 * MiB;
constexpr size_t A_Y = WS_ACT + 256 * MiB;
constexpr size_t A_GY = WS_ACT + 304 * MiB;
constexpr size_t A_GT = WS_ACT + 353 * MiB;
constexpr size_t A_YA = WS_ACT + 0 * MiB;
constexpr size_t A_MIX = WS_ACT + 64 * MiB;
constexpr size_t A_HP = WS_ACT + 96 * MiB;
constexpr size_t A_H = WS_ACT + 0 * MiB;
constexpr size_t A_HB = WS_ACT + 64 * MiB;
constexpr size_t A_AFF = WS_ACT + 160 * MiB;
constexpr size_t A_IDX = A_AFF + 512 * 1024;
constexpr size_t A_SEL = A_AFF + 1 * MiB;
constexpr size_t A_GATE = A_AFF + 2 * MiB;
constexpr size_t A_XIN = WS_ACT + 164 * MiB;
constexpr size_t A_HID = WS_ACT + 228 * MiB;
constexpr size_t A_YE = WS_ACT + 96 * MiB;
constexpr size_t WS_TV = WS_W2 + 0 * MiB;
constexpr size_t WS_WS5 = WS_W2 + 36 * MiB;
constexpr size_t WS_SLOC = WS_W2 + 48 * MiB;
constexpr size_t WS_AQ = WS_W2 + 72 * MiB;
constexpr size_t WS_END = 704 * MiB;
static_assert(A_HID + 176 * MiB <= WS_END && A_XIN + 64 * MiB <= A_HID && A_GATE + 1 * MiB <= A_XIN && A_YE + 64 * MiB <= A_AFF && A_H + 64 * MiB <= A_HB && A_HB + 32 * MiB <= A_HP, "d_ws map (late phases)");
static_assert(A_GT + 64 * MiB <= WS_END && A_GY + 24 * MiB <= A_GT && A_UC + 36 * MiB <= A_GY && A_Y + 48 * MiB <= A_GY && A_TOT + 1 * MiB <= A_Y && A_DT + 3 * MiB <= A_TOT && A_SV + 12 * MiB <= A_DT && A_BT + 16 * MiB <= A_SV
              && A_XT + 48 * MiB <= A_BT && A_S + 96 * MiB <= A_XT && A_Z + 48 * MiB <= A_XBC && A_CN + 16 * MiB <= A_Z, "d_ws map (early phases)");
constexpr int CW_BAR = 1024;

constexpr int RING_BYTES = 131072;
constexpr int MISC_OFF = RING_BYTES;
constexpr int LDS_BYTES = 147456;

#define GAS __attribute__((address_space(1)))
#define LAS __attribute__((address_space(3)))
typedef unsigned short bf16;
typedef unsigned v4u __attribute__((ext_vector_type(4)));
typedef unsigned v2u __attribute__((ext_vector_type(2)));
typedef float f32x4 __attribute__((ext_vector_type(4)));
#define LDS_WAIT() asm volatile("s_waitcnt lgkmcnt(0)" ::: "memory")
__device__ __forceinline__ unsigned f2bf(float f) { unsigned u = __builtin_bit_cast(unsigned, f); return (u + 0x7fffu + ((u >> 16) & 1u)) >> 16; }
__device__ __forceinline__ unsigned pk2(float lo, float hi) { return pg8::cvt_pk_bf16(lo, hi); }
__device__ __forceinline__ float bflo(unsigned w) { return __uint_as_float(w << 16); }
__device__ __forceinline__ float bfhi(unsigned w) { return __uint_as_float(w & 0xffff0000u); }
__device__ __forceinline__ float wave_sum(float v) {
#pragma unroll
    for (int o = 1; o < 64; o <<= 1) v += __shfl_xor(v, o);
    return v;
}
#define XB_TMO      128
#define XB_XCNT(j)  (256  + 64 * (j))
#define XB_XSUB(j)  (1280 + 64 * (j))
#define XB_XGEN(j)  (2304 + 64 * (j))
#define XB_TOP      3328
#define XB_TOPGEN   3392
#define XCD_BAR_WORDS 3456
#define XB_SPIN_CAP (1u << 18)

__device__ __forceinline__ unsigned xb_ld(unsigned* p)              { return __hip_atomic_load(p, __ATOMIC_RELAXED, __HIP_MEMORY_SCOPE_AGENT); }
__device__ __forceinline__ unsigned xb_add(unsigned* p, unsigned v) { return __hip_atomic_fetch_add(p, v, __ATOMIC_RELAXED, __HIP_MEMORY_SCOPE_AGENT); }
__device__ __forceinline__ unsigned xb_xcc_id() { return (unsigned)__builtin_amdgcn_s_getreg((3 << 11) | 20) & 0xFu; }
#define XB_SPIN(cond, bar) do { unsigned _sp = 0; while (cond) { __builtin_amdgcn_s_sleep(1); \
    if ((++_sp & 255u) == 0u) { if (xb_ld(&(bar)[XB_TMO])) break; if (_sp > XB_SPIN_CAP) { atomicAdd(&(bar)[XB_TMO], 1u); break; } } } } while (0)

struct XcdBarrier {
    unsigned* bar; unsigned x;
    volatile LAS unsigned* st;
};

__device__ __forceinline__ XcdBarrier xcd_barrier_post(unsigned* bar, volatile LAS unsigned* st) {
    XcdBarrier b; b.bar = bar; b.x = xb_xcc_id(); b.st = st;
    if (threadIdx.x == 0) (void)xb_add(&bar[XB_XCNT(b.x)], 1u);
    return b;
}
__device__ __forceinline__ void xcd_barrier_complete(unsigned* bar, unsigned x, unsigned& nloc, unsigned& nx) {
    const unsigned G = gridDim.x * gridDim.y * gridDim.z;
    unsigned sum, cnt, mine, sp = 0u;
    for (;;) {
        sum = 0u; cnt = 0u; mine = 0u;
#pragma unroll
        for (unsigned j = 0; j < 16; ++j) { const unsigned c = xb_ld(&bar[XB_XCNT(j)]); sum += c; cnt += (c > 0u) ? 1u : 0u; mine = (j == x) ? c : mine; }
        if (sum == G) break;
        __builtin_amdgcn_s_sleep(1);
        if ((++sp & 255u) == 0u) { if (xb_ld(&bar[XB_TMO])) break; if (sp > XB_SPIN_CAP) { atomicAdd(&bar[XB_TMO], 1u); break; } }
    }
    nloc = mine > 0u ? mine : 1u; nx = cnt > 0u ? cnt : 1u;
}

__device__ __forceinline__ void xcd_barrier(const XcdBarrier& b) {
    asm volatile("s_waitcnt vmcnt(0)" ::: "memory");
    __syncthreads();
    if (threadIdx.x == 0) {
        unsigned* bar = b.bar;
        __builtin_amdgcn_s_waitcnt(0);
        unsigned nloc = b.st[0], nx = b.st[1];
        if (nloc == 0u) { xcd_barrier_complete(bar, b.x, nloc, nx); b.st[0] = nloc; b.st[1] = nx; }
        const unsigned old = xb_add(&bar[XB_XSUB(b.x)], 1u);
        const unsigned gen = old / nloc;
        if (old + 1u == (gen + 1u) * nloc) {
            __builtin_amdgcn_fence(__ATOMIC_RELEASE, "agent");
            asm volatile("s_waitcnt vmcnt(0)" ::: "memory");
            const unsigned og = xb_add(&bar[XB_TOP], 1u);
            const unsigned tg = og / nx;
            if (og + 1u == (tg + 1u) * nx) xb_add(&bar[XB_TOPGEN], 1u);
            else XB_SPIN(xb_ld(&bar[XB_TOPGEN]) == tg, bar);
            __builtin_amdgcn_fence(__ATOMIC_ACQUIRE, "agent");
            xb_add(&bar[XB_XGEN(b.x)], 1u);
            asm volatile("s_waitcnt vmcnt(0)" ::: "memory");
        } else {
            XB_SPIN(xb_ld(&bar[XB_XGEN(b.x)]) == gen, bar);
            __builtin_amdgcn_fence(__ATOMIC_ACQUIRE, "agent");
            asm volatile("s_waitcnt vmcnt(0)" ::: "memory");
        }
    }
    __syncthreads();
}

struct Frame {
    LAS unsigned char* lds;
    int tid, lane, wave, bid, G;
    const float* const* in; float* out; unsigned char* ws;
};
#define WSP(T_, off) ((T_*)(F.ws + (off)))

__device__ __forceinline__ void tr_item(const float* W, int ldw, int col0, int ncols, int K, bf16* WT, int drow, LAS float* scr, int k0, int n0, int lane) {
    const int nl = lane & 31; const bool okc = (n0 + nl) < ncols;
#pragma unroll 8
    for (int i = 0; i < 32; ++i) { const int kk = 2 * i + (lane >> 5); scr[kk * 33 + nl] = okc ? W[(size_t)(k0 + kk) * ldw + col0 + n0 + nl] : 0.f; }
    LDS_WAIT(); asm volatile("" ::: "memory");
    const int c = lane & 7;
#pragma unroll
    for (int j = 0; j < 4; ++j) { const int n = (lane >> 3) + 8 * j; const LAS float* s = scr + (8 * c) * 33 + n;
        v4u o; o.x = pk2(s[0 * 33], s[1 * 33]); o.y = pk2(s[2 * 33], s[3 * 33]); o.z = pk2(s[4 * 33], s[5 * 33]); o.w = pk2(s[6 * 33], s[7 * 33]);
        if (n0 + n < ncols) *(v4u*)(WT + (size_t)(drow + n) * K + k0 + 8 * c) = o; }
    LDS_WAIT(); asm volatile("" ::: "memory");
}
struct TrJob { const float* W; int ldw, col0, ncols, K; bf16* WT; int drow0, interleave; };
__device__ __forceinline__ int tr_job_items(const TrJob& j) { return (j.K / 64) * ((j.ncols + 31) / 32); }
__device__ __forceinline__ void tr_job_item(const TrJob& j, int item, LAS float* scr, int lane) {
    const int nblk = (j.ncols + 31) / 32, kb = item / nblk, nb = item % nblk, n0 = nb * 32;
    const int drow = j.interleave ? j.drow0 + (n0 >> 7) * 256 + (n0 & 127) : j.drow0 + n0;
    tr_item(j.W, j.ldw, j.col0, j.ncols, j.K, j.WT, drow, scr, kb * 64, n0, lane);
}
__device__ __forceinline__ void p0_prologue(Frame& F) {
    LAS float* scr = (LAS float*)(F.lds + F.wave * 8704);
    const int gw = F.bid * NWAVES + F.wave, NGW = F.G * NWAVES;
    { const f32x4* x4 = (const f32x4*)F.in[0]; v4u* o = WSP(v4u, A_XB); const int n8 = M * D / 8;
      for (int i = F.bid * NTHR + F.tid; i < n8; i += F.G * NTHR) { const f32x4 a = x4[2 * i], b = x4[2 * i + 1]; v4u w; w.x = pk2(a.x, a.y); w.y = pk2(a.z, a.w); w.z = pk2(b.x, b.y); w.w = pk2(b.z, b.w); o[i] = w; } }
    {
        bf16* WIN = WSP(bf16, WS_WIN); bf16* WOUT = WSP(bf16, WS_WOUT); bf16* WGLU = WSP(bf16, WS_WGLU); bf16* WO = WSP(bf16, WS_WO);
        const TrJob jobs[8] = {
            {F.in[1], INCOLS, 0, 4096, D, WIN, 0, 0}, {F.in[1], INCOLS, 4096, 48, D, WIN, 4096, 0}, {F.in[1], INCOLS, 4144, 768, D, WIN, 4352, 0}, {F.in[1], INCOLS, 4912, 2048, D, WIN, 5120, 0},
            {F.in[10], D, 0, D, SSD_IN, WOUT, 0, 0}, {F.in[22], D, 0, D, S5_W, WGLU, 0, 1}, {F.in[23], D, 0, D, S5_W, WGLU, 128, 1}, {F.in[24], D, 0, D, D, WO, 0, 0} };
        int base = 0;
#pragma unroll
        for (int q = 0; q < 8; ++q) { const int n = tr_job_items(jobs[q]);
            int it0 = (gw - base) % NGW; if (it0 < 0) it0 += NGW;
            for (int it = it0; it < n; it += NGW) tr_job_item(jobs[q], it, scr, F.lane);
            base += n; }
    }
    {
        bf16* W1 = WSP(bf16, WS_W1);
        constexpr int I13 = (D / 64) * (FF / 32);
        for (int it = gw; it < NE * 2 * I13; it += NGW) {
            const int e = it / (2 * I13); int r = it % (2 * I13);
            if (r < I13) { const TrJob j{F.in[28] + (size_t)e * D * FF, FF, 0, FF, D, W1 + (size_t)e * 2 * FF * D, 0, 1}; tr_job_item(j, r, scr, F.lane); }
            else { const TrJob j{F.in[29] + (size_t)e * D * FF, FF, 0, FF, D, W1 + (size_t)e * 2 * FF * D, 128, 1}; tr_job_item(j, r - I13, scr, F.lane); }
        }
    }
}
__device__ __forceinline__ void w2_convert(Frame& F, int gw, int ngw) {
    LAS float* scr = (LAS float*)(F.lds + F.wave * 8704);
    bf16* W2 = WSP(bf16, WS_W2);
    constexpr int I2 = (FF / 64) * (D / 32);
    for (int it = gw; it < NE * I2; it += ngw) { const int e = it / I2, r = it % I2;
        const TrJob j{F.in[30] + (size_t)e * FF * D, D, 0, D, FF, W2 + (size_t)e * D * FF, 0, 0}; tr_job_item(j, r, scr, F.lane); }
}

__device__ __forceinline__ void cmul(float ar, float ai, float br, float bi, float& cr, float& ci) { cr = ar * br - ai * bi; ci = ar * bi + ai * br; }
__device__ __forceinline__ void s5_precompute_item(Frame& F, int g, int tau) {
    LAS float* PQ = (LAS float*)(F.lds + 72 * 1024);
    LAS float* PW = PQ + 256;
    bf16* TV = WSP(bf16, WS_TV) + (size_t)g * 512 * 768; bf16* WM = WSP(bf16, WS_WS5) + (size_t)g * 256 * 512; float* AQ = WSP(float, WS_AQ);
    const int tid = F.tid;
    __syncthreads();
    if (tid < 128) {
        const int d = tid >> 6, p = tid & 63;
        const float are = (d ? F.in[14] : F.in[11])[g * 64 + p], aim = (d ? F.in[15] : F.in[12])[g * 64 + p], step = __expf((d ? F.in[16] : F.in[13])[g]);
        const float zr = are * step, zi = aim * step;
        const float er = expf(zr), cs = cosf(zi), sn = sinf(zi), abr = er * cs, abi = er * sn;
        const float sh = sinf(0.5f * zi), dr = expm1f(zr) * cs - 2.f * sh * sh, di = abi;
        const float den = 1.0f / (are * are + aim * aim), qr = (dr * are + di * aim) * den, qi = (di * are - dr * aim) * den;
        float pr = 1.f, pi = 0.f, br = abr, bi = abi;
#pragma unroll
        for (int bit = 0; bit < 6; ++bit) { if ((tau >> bit) & 1) { float tr_, ti_; cmul(pr, pi, br, bi, tr_, ti_); pr = tr_; pi = ti_; } float sr_, si_; cmul(br, bi, br, bi, sr_, si_); br = sr_; bi = si_; }
        float xr, xi; cmul(pr, pi, qr, qi, xr, xi);
        PQ[(d * 64 + p) * 2] = xr; PQ[(d * 64 + p) * 2 + 1] = xi; PW[(d * 64 + p) * 2] = pr; PW[(d * 64 + p) * 2 + 1] = pi;
        if (tau == 32) { AQ[((g * 2 + d) * 64 + p) * 2] = pr; AQ[((g * 2 + d) * 64 + p) * 2 + 1] = pi; }
    }
    __syncthreads();
    const float* cre = F.in[19] + (size_t)g * 16 * 64; const float* cim = F.in[20] + (size_t)g * 16 * 64;
    const float* bre = F.in[17] + (size_t)g * 64 * 16; const float* bim = F.in[18] + (size_t)g * 64 * 16;
    if (tid < 256 && tau < 32) {
        const int k = tid >> 4, j = tid & 15; float kf = 0.f, kb = 0.f;
        for (int p = 0; p < 64; ++p) { const float cr = cre[k * 64 + p], ci = cim[k * 64 + p], br = bre[p * 16 + j], bi = bim[p * 16 + j];
            float wr_, wi_; cmul(cr, ci, PQ[p * 2], PQ[p * 2 + 1], wr_, wi_); kf += wr_ * br - wi_ * bi;
            cmul(cr, ci, PQ[(64 + p) * 2], PQ[(64 + p) * 2 + 1], wr_, wi_); kb += wr_ * br - wi_ * bi; }
        if (tau == 0) { const bf16 v = (bf16)f2bf(kf + kb); for (int t = 0; t < 32; ++t) TV[(size_t)(t * 16 + k) * 768 + t * 16 + j] = v; }
        else { const bf16 vf = (bf16)f2bf(kf), vb = (bf16)f2bf(kb);
            for (int t = tau; t < 32; ++t) { const int s = t - tau; TV[(size_t)(t * 16 + k) * 768 + s * 16 + j] = vf; TV[(size_t)(s * 16 + k) * 768 + t * 16 + j] = vb; } }
    }
    if (tid >= 256) {
        const int q = tid - 256;
        if (tau >= 1) {
#pragma unroll 1
            for (int i = 0; i < 8; ++i) { const int e = q * 8 + i, d = e >> 10, k = (e >> 6) & 15, p = e & 63;
                float vr, vi; cmul(cre[k * 64 + p], cim[k * 64 + p], PW[(d * 64 + p) * 2], PW[(d * 64 + p) * 2 + 1], vr, vi);
                const int t = d ? 32 - tau : tau - 1; bf16* row = TV + (size_t)(t * 16 + k) * 768 + 512 + d * 128;
                row[p] = (bf16)f2bf(vr); row[64 + p] = (bf16)f2bf(-vi); } }
        if (tau < 32) {
#pragma unroll 1
            for (int i = 0; i < 8; ++i) { const int e = q * 8 + i, d = e >> 10, p = (e >> 4) & 63, j = e & 15;
                float vr, vi; cmul(PQ[(d * 64 + p) * 2], PQ[(d * 64 + p) * 2 + 1], bre[p * 16 + j], bim[p * 16 + j], vr, vi);
                const int s = d ? tau : 31 - tau; bf16* col = WM + (size_t)(d * 128 + p) * 512 + s * 16 + j;
                col[0] = (bf16)f2bf(vr); col[(size_t)64 * 512] = (bf16)f2bf(vi); } }
    }
}
__device__ __forceinline__ void p0_s5(Frame& F) { for (int it = F.bid; it < S5_G * 33; it += F.G) s5_precompute_item(F, it / 33, it % 33); }

__device__ __forceinline__ void s5_scan_item(Frame& F, int item) {
    const int d = item & 1, b = (item >> 1) & 1, g = item >> 2, tid = F.tid;
    LAS float* S = (LAS float*)F.lds;
    const float* SL = WSP(float, WS_SLOC) + ((size_t)(g * 512 + b * 256) * 256 + d * 128);
    __syncthreads();
    for (int i = tid; i < 256 * 32; i += NTHR) { const int ci = i >> 5, c4 = (i & 31) * 4; *(LAS f32x4*)(S + ci * 128 + c4) = *(const f32x4*)(SL + (size_t)ci * 256 + c4); }
    __syncthreads();
    if (tid < 64) {
        const float* AQ = WSP(float, WS_AQ); const float qr = AQ[((g * 2 + d) * 64 + tid) * 2], qi = AQ[((g * 2 + d) * 64 + tid) * 2 + 1];
        float sr = 0.f, si = 0.f;
        for (int n = 0; n < 256; ++n) { const int ci = d ? 255 - n : n;
            const float tr_ = S[ci * 128 + tid], ti_ = S[ci * 128 + 64 + tid];
            S[ci * 128 + tid] = sr; S[ci * 128 + 64 + tid] = si;
            const float nr = qr * sr - qi * si + tr_, ni = qr * si + qi * sr + ti_; sr = nr; si = ni; }
    }
    __syncthreads();
    bf16* UC = WSP(bf16, A_UC) + ((size_t)(g * 512 + b * 256) * 768 + 512 + d * 128);
    for (int i = tid; i < 256 * 16; i += NTHR) { const int ci = i >> 4, c8 = (i & 15) * 8; const LAS float* s = S + ci * 128 + c8;
        v4u o; o.x = pk2(s[0], s[1]); o.y = pk2(s[2], s[3]); o.z = pk2(s[4], s[5]); o.w = pk2(s[6], s[7]);
        *(v4u*)(UC + (size_t)ci * 768 + c8) = o; }
}

__device__ __forceinline__ void unpack8(const v4u w, float (&f)[8]) { f[0] = bflo(w.x); f[1] = bfhi(w.x); f[2] = bflo(w.y); f[3] = bfhi(w.y); f[4] = bflo(w.z); f[5] = bfhi(w.z); f[6] = bflo(w.w); f[7] = bfhi(w.w); }
__device__ __forceinline__ void p2_conv(Frame& F) {
    const bf16* xbc = WSP(bf16, A_XBC); bf16* XT = WSP(bf16, A_XT); bf16* BT = WSP(bf16, A_BT); bf16* BN = WSP(bf16, A_BN); bf16* CN = WSP(bf16, A_CN);
    const float* cw = F.in[2]; const float* cb = F.in[3];
    constexpr int RUN = 32, NCG = XBC / 8, NITEM = (M / RUN) * NCG;
    for (int item = F.bid * NTHR + F.tid; item < NITEM; item += F.G * NTHR) {
        const int cg = item % NCG, r = item / NCG, ch = cg * 8, m0 = r * RUN, tb = m0 % T, bc = m0 >> 7, s0 = m0 & 127;
        float w[5][8], bias[8];
#pragma unroll
        for (int k = 0; k < 5; ++k) { const f32x4 a = *(const f32x4*)(cw + k * XBC + ch), b = *(const f32x4*)(cw + k * XBC + ch + 4); w[k][0] = a.x; w[k][1] = a.y; w[k][2] = a.z; w[k][3] = a.w; w[k][4] = b.x; w[k][5] = b.y; w[k][6] = b.z; w[k][7] = b.w; }
        { const f32x4 a = *(const f32x4*)(cb + ch), b = *(const f32x4*)(cb + ch + 4); bias[0] = a.x; bias[1] = a.y; bias[2] = a.z; bias[3] = a.w; bias[4] = b.x; bias[5] = b.y; bias[6] = b.z; bias[7] = b.w; }
        bf16* nat = nullptr; bf16* trn = nullptr;
        if (ch < SSD_IN) { trn = XT + ((size_t)(bc * SSD_H + (ch >> 6)) * 64 + (ch & 63)) * 128 + s0; }
        else if (ch < SSD_IN + 512) { const int cc = ch - SSD_IN; nat = BN + (size_t)m0 * 512 + cc; trn = BT + ((size_t)(bc * SSD_G + (cc >> 7)) * 128 + (cc & 127)) * 128 + s0; }
        else { nat = CN + (size_t)m0 * 512 + (ch - SSD_IN - 512); }
        const v4u zero4 = {0u, 0u, 0u, 0u};
        v4u win[5];
        const bf16* src = xbc + (size_t)m0 * XBC + ch;
        win[0] = (tb - 2 >= 0) ? *(const v4u*)(src - 2 * XBC) : zero4;
        win[1] = (tb - 1 >= 0) ? *(const v4u*)(src - 1 * XBC) : zero4;
        win[2] = *(const v4u*)(src);
        win[3] = *(const v4u*)(src + XBC);
#pragma unroll 1
        for (int i8 = 0; i8 < RUN / 8; ++i8) {
            float o[8][8];
#pragma unroll
            for (int ii = 0; ii < 8; ++ii) { const int i = i8 * 8 + ii;
                win[4] = (tb + i + 2 < T) ? *(const v4u*)(src + (size_t)(i + 2) * XBC) : zero4;
#pragma unroll
                for (int j = 0; j < 8; ++j) o[ii][j] = bias[j];
#pragma unroll
                for (int k = 0; k < 5; ++k) { float f[8]; unpack8(win[k], f);
#pragma unroll
                    for (int j = 0; j < 8; ++j) o[ii][j] += w[k][j] * f[j]; }
#pragma unroll
                for (int j = 0; j < 8; ++j) o[ii][j] = o[ii][j] * __builtin_amdgcn_rcpf(1.0f + __expf(-o[ii][j]));
                if (nat) { v4u q; q.x = pk2(o[ii][0], o[ii][1]); q.y = pk2(o[ii][2], o[ii][3]); q.z = pk2(o[ii][4], o[ii][5]); q.w = pk2(o[ii][6], o[ii][7]); *(v4u*)(nat + (size_t)i * 512) = q; }
                win[0] = win[1]; win[1] = win[2]; win[2] = win[3]; win[3] = win[4]; }
            if (trn) {
#pragma unroll
                for (int j = 0; j < 8; ++j) { v4u q; q.x = pk2(o[0][j], o[1][j]); q.y = pk2(o[2][j], o[3][j]); q.z = pk2(o[4][j], o[5][j]); q.w = pk2(o[6][j], o[7][j]); *(v4u*)(trn + (size_t)j * 128 + i8 * 8) = q; } }
        }
    }
    {
        const int gw = F.bid * NWAVES + F.wave, NGW = F.G * NWAVES, lane = F.lane;
        const float* DT = WSP(float, A_DT); float* SV = WSP(float, A_SV); float* TOT = WSP(float, A_TOT);
        for (int it = gw; it < 128 * SSD_H * 2; it += NGW) {
            const int d = it & 1, h = (it >> 1) % SSD_H, bc = it / (2 * SSD_H);
            const float a = -__expf((d ? F.in[5] : F.in[4])[h]);
            const size_t mb = (size_t)bc * 128;
            const float dt0 = DT[(mb + 2 * lane) * 48 + d * 24 + h], dt1 = DT[(mb + 2 * lane + 1) * 48 + d * 24 + h];
            const float x0 = dt0 * a, x1 = dt1 * a, ps = x0 + x1;
            float inc = ps;
#pragma unroll
            for (int o = 1; o < 64; o <<= 1) { const float t_ = __shfl_up(inc, o); if (lane >= o) inc += t_; }
            const float total = __shfl(inc, 63), exc = inc - ps;
            const float ci0 = exc + x0, ci1 = inc;
            float cs0, cs1, w0, w1, f0, f1;
            if (d == 0) { cs0 = ci0; cs1 = ci1; w0 = dt0 * __expf(total - ci0); w1 = dt1 * __expf(total - ci1); f0 = __expf(ci0); f1 = __expf(ci1); }
            else { cs0 = exc; cs1 = ci0; w0 = dt0 * __expf(cs0); w1 = dt1 * __expf(cs1); f0 = __expf(total - cs0); f1 = __expf(total - cs1); }
            float* sv = SV + (size_t)it * 4 * 128 + 2 * lane;
            typedef float f32x2 __attribute__((ext_vector_type(2)));
            *(f32x2*)(sv) = (f32x2){w0, w1}; *(f32x2*)(sv + 128) = (f32x2){cs0, cs1}; *(f32x2*)(sv + 256) = (f32x2){dt0, dt1}; *(f32x2*)(sv + 384) = (f32x2){f0, f1};
            if (lane == 0) TOT[it] = __expf(total);
        }
    }
}

typedef short bf16x8 __attribute__((ext_vector_type(8)));
typedef float f32x16 __attribute__((ext_vector_type(16)));
__device__ __forceinline__ unsigned cvtpk(float lo, float hi) { return pg8::cvt_pk_bf16(lo, hi); }
__device__ __forceinline__ void ssd_state_item(Frame& F, int item) {
    const int nt = item & 3, u = item >> 2, h = u % SSD_H, bc = u / SSD_H, g = h / 6, b = bc >> 6, c = bc & 63, lane = F.lane, l31 = lane & 31, hf = lane >> 5;
    const bf16* XT = WSP(bf16, A_XT) + (size_t)u * 64 * 128; const bf16* BT = WSP(bf16, A_BT) + ((size_t)(bc * SSD_G + g) * 128 + nt * 32 + l31) * 128;
    const float* SV = WSP(float, A_SV); bf16* S = WSP(bf16, A_S);
    LAS float* wl = (LAS float*)(F.lds + F.wave * 1024);
    LDS_WAIT(); asm volatile("" ::: "memory");
#pragma unroll
    for (int d = 0; d < 2; ++d) { const float* sv = SV + (size_t)(u * 2 + d) * 4 * 128; wl[d * 128 + lane] = sv[lane]; wl[d * 128 + 64 + lane] = sv[64 + lane]; }
    LDS_WAIT(); asm volatile("" ::: "memory");
    f32x16 acc[2][2];
#pragma unroll
    for (int d = 0; d < 2; ++d)
#pragma unroll
        for (int pt = 0; pt < 2; ++pt)
#pragma unroll
            for (int r = 0; r < 16; ++r) acc[d][pt][r] = 0.f;
#pragma unroll
    for (int ks = 0; ks < 8; ++ks) {
        const int sb = ks * 16 + 8 * hf;
        const v4u a = *(const v4u*)(BT + sb);
        const bf16x8 b0 = *(const bf16x8*)(XT + (size_t)l31 * 128 + sb), b1 = *(const bf16x8*)(XT + (size_t)(32 + l31) * 128 + sb);
        float af[8]; unpack8(a, af);
#pragma unroll
        for (int d = 0; d < 2; ++d) {
            const f32x4 w0 = *(const LAS f32x4*)(wl + d * 128 + sb), w1 = *(const LAS f32x4*)(wl + d * 128 + sb + 4);
            v4u aw; aw.x = cvtpk(af[0] * w0.x, af[1] * w0.y); aw.y = cvtpk(af[2] * w0.z, af[3] * w0.w); aw.z = cvtpk(af[4] * w1.x, af[5] * w1.y); aw.w = cvtpk(af[6] * w1.z, af[7] * w1.w);
            const bf16x8 av = __builtin_bit_cast(bf16x8, aw);
            acc[d][0] = __builtin_amdgcn_mfma_f32_32x32x16_bf16(av, b0, acc[d][0], 0, 0, 0);
            acc[d][1] = __builtin_amdgcn_mfma_f32_32x32x16_bf16(av, b1, acc[d][1], 0, 0, 0);
        }
    }
#pragma unroll
    for (int d = 0; d < 2; ++d) { bf16* So = S + ((size_t)((b * SSD_H + h) * 2 + d) * 64 + c) * 8192;
#pragma unroll
        for (int pt = 0; pt < 2; ++pt)
#pragma unroll
            for (int q = 0; q < 4; ++q) { v2u o; o.x = cvtpk(acc[d][pt][4 * q], acc[d][pt][4 * q + 1]); o.y = cvtpk(acc[d][pt][4 * q + 2], acc[d][pt][4 * q + 3]);
                *(v2u*)(So + (size_t)(32 * pt + l31) * 128 + nt * 32 + 8 * q + 4 * hf) = o; } }
}
__device__ __forceinline__ void ssd_scan(Frame& F, int tg, int ntg) {
    bf16* S = WSP(bf16, A_S); const float* TOT = WSP(float, A_TOT);
    for (int item = tg; item < 96 * 1024; item += ntg) {
        const int e8 = item & 1023, bhd = item >> 10, d = bhd & 1, h = (bhd >> 1) % SSD_H, b = bhd / (2 * SSD_H);
        bf16* base = S + (size_t)bhd * 64 * 8192 + e8 * 8;
        float H[8];
#pragma unroll
        for (int j = 0; j < 8; ++j) H[j] = 0.f;
#pragma unroll 1
        for (int n0 = 0; n0 < 64; n0 += 8) {
            v4u v[8]; float dec[8];
#pragma unroll
            for (int k = 0; k < 8; ++k) { const int c = d ? 63 - (n0 + k) : n0 + k; v[k] = *(const v4u*)(base + (size_t)c * 8192); dec[k] = TOT[((b * 64 + c) * SSD_H + h) * 2 + d]; }
#pragma unroll
            for (int k = 0; k < 8; ++k) { const int c = d ? 63 - (n0 + k) : n0 + k; float f[8]; unpack8(v[k], f);
                v4u o; o.x = cvtpk(H[0], H[1]); o.y = cvtpk(H[2], H[3]); o.z = cvtpk(H[4], H[5]); o.w = cvtpk(H[6], H[7]);
                *(v4u*)(base + (size_t)c * 8192) = o;
#pragma unroll
                for (int j = 0; j < 8; ++j) H[j] = H[j] * dec[k] + f[j]; }
        }
    }
}
__device__ __forceinline__ void ssd_out_unit(Frame& F, int unit) {
    int lane = F.lane; asm volatile("" : "+v"(lane));
    const int g = unit & 3, bc = unit >> 2, b = bc >> 6, c = bc & 63, l31 = lane & 31, hf = lane >> 5, j = F.wave & 3, hh = F.wave >> 2;
    const size_t mb = (size_t)bc * 128;
    const bf16* CN = WSP(bf16, A_CN) + (mb + 32 * j + l31) * 512 + g * 128 + 8 * hf;
    const bf16* BN = WSP(bf16, A_BN) + (mb + l31) * 512 + g * 128 + 8 * hf;
    const float* SV = WSP(float, A_SV); const bf16* S = WSP(bf16, A_S); const bf16* XT = WSP(bf16, A_XT); bf16* Y = WSP(bf16, A_Y);
    LAS float* svl = (LAS float*)(F.lds + F.wave * 12288);
    asm volatile("" : "+v"(CN), "+v"(BN));
    LDS_WAIT(); asm volatile("" ::: "memory");
    {
        const f32x4* src = (const f32x4*)(SV + (size_t)((bc * SSD_H + g * 6 + hh * 3) * 2) * 512) + lane;
#pragma unroll
        for (int q = 0; q < 12; ++q) *(LAS f32x4*)(svl + (q * 64 + lane) * 4) = src[q * 64];
    }
    f32x16 cbt[4];
    {   bf16x8 cfr[8];
#pragma unroll
        for (int ks = 0; ks < 8; ++ks) cfr[ks] = *(const bf16x8*)(CN + ks * 16);
#pragma unroll
        for (int i = 0; i < 4; ++i) {
#pragma unroll
            for (int r = 0; r < 16; ++r) cbt[i][r] = 0.f;
#pragma unroll
            for (int ks = 0; ks < 8; ++ks) { const bf16x8 a = *(const bf16x8*)(BN + (size_t)(32 * i) * 512 + ks * 16); cbt[i] = __builtin_amdgcn_mfma_f32_32x32x16_bf16(a, cfr[ks], cbt[i], 0, 0, 0); }
            asm volatile("" ::: "memory");
        }
    }
    LDS_WAIT(); asm volatile("" ::: "memory");
    const int tl = 32 * j + l31;
#pragma unroll 1
    for (int i3 = 0; i3 < 3; ++i3) {
        const int h = g * 6 + hh * 3 + i3;
        const LAS float* vf = svl + (i3 * 2 + 0) * 512 + 128; const LAS float* vb = svl + (i3 * 2 + 1) * 512 + 128;
        const float csf_t = vf[tl], sf_t = vf[256 + tl], ecsb_t = vb[tl], sb_t = vb[256 + tl], Dh = F.in[8][h];
        int tlv = tl; asm volatile("" : "+v"(tlv));
        f32x16 acc[2];
        {
            const bf16* Hf = S + ((size_t)((b * SSD_H + h) * 2 + 0) * 64 + c) * 8192 + (size_t)l31 * 128 + 8 * hf; const bf16* Hb = Hf + (size_t)64 * 8192;
            const bf16* cn = CN; asm volatile("" : "+v"(Hf), "+v"(Hb), "+v"(cn));
            bf16x8 cfr[8];
#pragma unroll
            for (int ks = 0; ks < 8; ++ks) cfr[ks] = *(const bf16x8*)(cn + ks * 16);
#pragma unroll
            for (int pt = 0; pt < 2; ++pt) { f32x16 af;
#pragma unroll
                for (int r = 0; r < 16; ++r) af[r] = 0.f;
#pragma unroll
                for (int ks = 0; ks < 8; ++ks) { const bf16x8 a0 = *(const bf16x8*)(Hf + (size_t)(32 * pt) * 128 + ks * 16); af = __builtin_amdgcn_mfma_f32_32x32x16_bf16(a0, cfr[ks], af, 0, 0, 0); }
#pragma unroll
                for (int r = 0; r < 16; ++r) acc[pt][r] = af[r] * sf_t;
                asm volatile("" ::: "memory");
#pragma unroll
                for (int r = 0; r < 16; ++r) af[r] = 0.f;
#pragma unroll
                for (int ks = 0; ks < 8; ++ks) { const bf16x8 a1 = *(const bf16x8*)(Hb + (size_t)(32 * pt) * 128 + ks * 16); af = __builtin_amdgcn_mfma_f32_32x32x16_bf16(a1, cfr[ks], af, 0, 0, 0); }
#pragma unroll
                for (int r = 0; r < 16; ++r) acc[pt][r] += af[r] * sb_t;
                asm volatile("" ::: "memory"); }
        }
        const bf16* xt = XT + ((size_t)(bc * SSD_H + h) * 64 + l31) * 128 + 4 * hf;
        asm volatile("" : "+v"(xt));
#pragma unroll
        for (int i = 0; i < 4; ++i) {
#pragma unroll
            for (int k2 = 0; k2 < 2; ++k2) {
                const int sA = 32 * i + 16 * k2 + 4 * hf;
                float mv[8];
                if (i < j) {
                    const f32x4 c0 = *(const LAS f32x4*)(vf + sA), c1 = *(const LAS f32x4*)(vf + sA + 8), d0 = *(const LAS f32x4*)(vf + 128 + sA), d1 = *(const LAS f32x4*)(vf + 128 + sA + 8);
#pragma unroll
                    for (int e = 0; e < 4; ++e) { mv[e] = cbt[i][8 * k2 + e] * (d0[e] * __expf(fminf(csf_t - c0[e], 0.f))); mv[4 + e] = cbt[i][8 * k2 + 4 + e] * (d1[e] * __expf(fminf(csf_t - c1[e], 0.f))); }
                } else if (i > j) {
                    const f32x4 c0 = *(const LAS f32x4*)(vb + sA), c1 = *(const LAS f32x4*)(vb + sA + 8), d0 = *(const LAS f32x4*)(vb + 128 + sA), d1 = *(const LAS f32x4*)(vb + 128 + sA + 8);
#pragma unroll
                    for (int e = 0; e < 4; ++e) { mv[e] = cbt[i][8 * k2 + e] * (d0[e] * __expf(fminf(c0[e] - ecsb_t, 0.f))); mv[4 + e] = cbt[i][8 * k2 + 4 + e] * (d1[e] * __expf(fminf(c1[e] - ecsb_t, 0.f))); }
                } else {
                    const f32x4 c0 = *(const LAS f32x4*)(vf + sA), c1 = *(const LAS f32x4*)(vf + sA + 8), d0 = *(const LAS f32x4*)(vf + 128 + sA), d1 = *(const LAS f32x4*)(vf + 128 + sA + 8);
                    const f32x4 g0 = *(const LAS f32x4*)(vb + sA), g1 = *(const LAS f32x4*)(vb + sA + 8), h0 = *(const LAS f32x4*)(vb + 128 + sA), h1 = *(const LAS f32x4*)(vb + 128 + sA + 8);
#pragma unroll
                    for (int e = 0; e < 8; ++e) { const int s_ = sA + (e & 3) + 8 * (e >> 2); const float cf = e < 4 ? c0[e & 3] : c1[e & 3], df = e < 4 ? d0[e & 3] : d1[e & 3], cb_ = e < 4 ? g0[e & 3] : g1[e & 3], db = e < 4 ? h0[e & 3] : h1[e & 3];
                        float f = 0.f;
                        f += (s_ <= tlv) ? df * __expf(fminf(csf_t - cf, 0.f)) : 0.f;
                        f += (s_ >= tlv) ? db * __expf(fminf(cb_ - ecsb_t, 0.f)) : 0.f;
                        mv[e] = cbt[i][8 * k2 + e] * f + ((s_ == tlv) ? Dh : 0.f); }
                }
                v4u mw; mw.x = cvtpk(mv[0], mv[1]); mw.y = cvtpk(mv[2], mv[3]); mw.z = cvtpk(mv[4], mv[5]); mw.w = cvtpk(mv[6], mv[7]);
                const bf16x8 mfr = __builtin_bit_cast(bf16x8, mw);
#pragma unroll
                for (int pt = 0; pt < 2; ++pt) { const v2u x0 = *(const v2u*)(xt + (size_t)(32 * pt) * 128 + 32 * i + 16 * k2), x1 = *(const v2u*)(xt + (size_t)(32 * pt) * 128 + 32 * i + 16 * k2 + 8);
                    v4u xw; xw.x = x0.x; xw.y = x0.y; xw.z = x1.x; xw.w = x1.y;
                    acc[pt] = __builtin_amdgcn_mfma_f32_32x32x16_bf16(__builtin_bit_cast(bf16x8, xw), mfr, acc[pt], 0, 0, 0); }
                asm volatile("" ::: "memory");
            }
        }
        bf16* yo = Y + (mb + tl) * SSD_IN + h * 64 + 4 * hf;
        asm volatile("" : "+v"(yo));
#pragma unroll
        for (int pt = 0; pt < 2; ++pt)
#pragma unroll
            for (int q = 0; q < 4; ++q) { v2u o; o.x = cvtpk(acc[pt][4 * q], acc[pt][4 * q + 1]); o.y = cvtpk(acc[pt][4 * q + 2], acc[pt][4 * q + 3]); *(v2u*)(yo + 32 * pt + 8 * q) = o; }
    }
}

__device__ __forceinline__ void p4_combine(Frame& F) {
    const int gw = F.bid * NWAVES + F.wave, NGW = F.G * NWAVES, lane = F.lane;
    bf16* Y = WSP(bf16, A_Y); const bf16* Z = WSP(bf16, A_Z); const float* ng = F.in[9];
    for (int m = gw; m < M; m += NGW) {
#pragma unroll 1
        for (int gi = 0; gi < SSD_G; ++gi) {
            const int ch = gi * 384 + lane * 8; float y[8]; float ss = 0.f;
            if (lane < 48) { const size_t o = (size_t)m * SSD_IN + ch; float a[8], z[8]; unpack8(*(const v4u*)(Y + o), a); unpack8(*(const v4u*)(Z + o), z);
#pragma unroll
                for (int jj = 0; jj < 8; ++jj) { y[jj] = a[jj] * z[jj]; ss += y[jj] * y[jj]; } }
            ss = wave_sum(ss);
            const float r = 1.0f / sqrtf(ss * (1.0f / 384.0f) + RMS_EPS);
            if (lane < 48) { const f32x4 g0 = *(const f32x4*)(ng + ch), g1 = *(const f32x4*)(ng + ch + 4);
                v4u o; o.x = pk2(y[0] * r * g0.x, y[1] * r * g0.y); o.y = pk2(y[2] * r * g0.z, y[3] * r * g0.w); o.z = pk2(y[4] * r * g1.x, y[5] * r * g1.y); o.w = pk2(y[6] * r * g1.z, y[7] * r * g1.w);
                *(v4u*)(Y + (size_t)m * SSD_IN + ch) = o; }
        }
    }
}

__device__ __forceinline__ void p8_ln_router(Frame& F) {
    const int gw = F.bid * NWAVES + F.wave, NGW = F.G * NWAVES, lane = F.lane;
    LAS float* wr = (LAS float*)F.lds;
    for (int i = F.tid; i < D * NE; i += NTHR) wr[(i & 15) * D + (i >> 4)] = F.in[27][i];
    __syncthreads();
    const float* HP = WSP(float, A_HP); float* H = WSP(float, A_H); bf16* HB = WSP(bf16, A_HB); float* AFF = WSP(float, A_AFF);
    const float* g1 = F.in[25]; const float* b1 = F.in[26];
    for (int m = gw; m < M; m += NGW) {
        const f32x4* xr = (const f32x4*)(HP + (size_t)m * D) + lane;
        f32x4 v[4]; float s = 0.f;
#pragma unroll
        for (int j = 0; j < 4; ++j) { v[j] = xr[64 * j]; s += (v[j].x + v[j].y) + (v[j].z + v[j].w); }
        const float mean = wave_sum(s) * (1.f / D); float s2 = 0.f;
#pragma unroll
        for (int j = 0; j < 4; ++j) { v[j] = v[j] - mean; s2 += (v[j].x * v[j].x + v[j].y * v[j].y) + (v[j].z * v[j].z + v[j].w * v[j].w); }
        const float rstd = 1.f / sqrtf(wave_sum(s2) * (1.f / D) + LN_EPS);
        float lg[16];
#pragma unroll
        for (int e = 0; e < 16; ++e) lg[e] = 0.f;
#pragma unroll
        for (int j = 0; j < 4; ++j) { const int c = 4 * lane + 256 * j; const f32x4 gg = *(const f32x4*)(g1 + c), bb = *(const f32x4*)(b1 + c);
            v[j] = v[j] * rstd * gg + bb;
            *((f32x4*)(H + (size_t)m * D) + lane + 64 * j) = v[j];
            v2u hb; hb.x = pk2(v[j].x, v[j].y); hb.y = pk2(v[j].z, v[j].w); *((v2u*)(HB + (size_t)m * D) + lane + 64 * j) = hb;
#pragma unroll
            for (int e = 0; e < 16; ++e) { const f32x4 w4 = *(const LAS f32x4*)(wr + e * D + c); lg[e] += (v[j].x * w4.x + v[j].y * w4.y) + (v[j].z * w4.z + v[j].w * w4.w); }
            asm volatile("" ::: "memory"); }
        { const bool hi = lane & 32;
#pragma unroll
          for (int k = 0; k < 8; ++k) { const float keep = hi ? lg[k + 8] : lg[k], send = hi ? lg[k] : lg[k + 8]; lg[k] = keep + __shfl_xor(send, 32); } }
        { const bool hi = lane & 16;
#pragma unroll
          for (int k = 0; k < 4; ++k) { const float keep = hi ? lg[k + 4] : lg[k], send = hi ? lg[k] : lg[k + 4]; lg[k] = keep + __shfl_xor(send, 16); } }
        { const bool hi = lane & 8;
#pragma unroll
          for (int k = 0; k < 2; ++k) { const float keep = hi ? lg[k + 2] : lg[k], send = hi ? lg[k] : lg[k + 2]; lg[k] = keep + __shfl_xor(send, 8); } }
        { const bool hi = lane & 4; const float keep = hi ? lg[1] : lg[0], send = hi ? lg[0] : lg[1]; lg[0] = keep + __shfl_xor(send, 4); }
        float lo = lg[0]; lo += __shfl_xor(lo, 2); lo += __shfl_xor(lo, 1);
        float mx = lo;
#pragma unroll
        for (int o = 4; o < 64; o <<= 1) mx = fmaxf(mx, __shfl_xor(mx, o));
        const float ex = expf(lo - mx); float sum = ex;
#pragma unroll
        for (int o = 4; o < 64; o <<= 1) sum += __shfl_xor(sum, o);
        if ((lane & 3) == 0) { const int e = lane >> 2, b = m / T, t = m % T; AFF[((size_t)b * NE + e) * T + t] = ex / sum; }
    }
}

__device__ __forceinline__ unsigned block_excl_scan(unsigned v, LAS unsigned* wsum  , int lane, int wave, unsigned& total) {
    unsigned inc = v;
#pragma unroll
    for (int o = 1; o < 64; o <<= 1) { const unsigned t = __shfl_up(inc, o); if (lane >= o) inc += t; }
    __syncthreads();
    if (lane == 63) wsum[wave] = inc;
    __syncthreads();
    unsigned off = 0, tot = 0;
#pragma unroll
    for (int w = 0; w < 8; ++w) { const unsigned s = wsum[w]; if (w < wave) off += s; tot += s; }
    total = tot; return off + inc - v;
}
__device__ __forceinline__ void p9_topk(Frame& F, int be) {
    const int b = be >> 4, e = be & 15, tid = F.tid;
    const float* av = WSP(float, A_AFF) + (size_t)be * T;
    int* IDX = WSP(int, A_IDX); int* SEL = WSP(int, A_SEL); float* GATE = WSP(float, A_GATE);
    LAS unsigned* hist = (LAS unsigned*)F.lds; LAS unsigned* shv = hist + 256; LAS unsigned* wsum = hist + 272;
    unsigned key[16];
#pragma unroll
    for (int q = 0; q < 4; ++q) { const v4u k4 = *(const v4u*)(av + tid * 16 + 4 * q); key[4 * q] = k4.x; key[4 * q + 1] = k4.y; key[4 * q + 2] = k4.z; key[4 * q + 3] = k4.w; }
    unsigned prefix = 0, pmask = 0, krem = CAP;
    for (int pass = 0; pass < 4; ++pass) {
        const int shift = 24 - 8 * pass;
        if (tid < 256) hist[tid] = 0u;
        __syncthreads();
#pragma unroll
        for (int i = 0; i < 16; ++i) if ((key[i] & pmask) == prefix) (void)__hip_atomic_fetch_add(&hist[(key[i] >> shift) & 255u], 1u, __ATOMIC_RELAXED, __HIP_MEMORY_SCOPE_WORKGROUP);
        __syncthreads();
        if (tid < 256) { unsigned above = 0; for (int d = tid + 1; d < 256; ++d) above += hist[d]; const unsigned mine = hist[tid];
            if (above < krem && krem <= above + mine) { shv[0] = (unsigned)tid; shv[1] = krem - above; } }
        __syncthreads();
        prefix |= shv[0] << shift; pmask |= 255u << shift; krem = shv[1];
        __syncthreads();
    }
    const unsigned Tk = prefix;
    unsigned cg = 0, ce = 0;
#pragma unroll
    for (int i = 0; i < 16; ++i) { cg += key[i] > Tk; ce += key[i] == Tk; }
    unsigned totg, tote;
    unsigned pg = block_excl_scan(cg, wsum, F.lane, F.wave, totg);
    unsigned pe = block_excl_scan(ce, wsum + 8, F.lane, F.wave, tote);
#pragma unroll
    for (int i = 0; i < 16; ++i) {
        const int t = tid * 16 + i; int slot = -1;
        if (key[i] > Tk) slot = (int)(pg++);
        else if (key[i] == Tk) { if (pe < krem) slot = (int)(totg + pe); ++pe; }
        const size_t m = (size_t)b * T + t;
        SEL[m * NE + e] = slot; GATE[m * NE + e] = __uint_as_float(key[i]);
        if (slot >= 0) IDX[(e * NB + b) * CAP + slot] = (int)m;
    }
}
__device__ __forceinline__ void p10_gather(Frame& F) {
    const int gw = F.bid * NWAVES + F.wave, NGW = F.G * NWAVES, lane = F.lane;
    const int* IDX = WSP(int, A_IDX); const bf16* HB = WSP(bf16, A_HB); bf16* XIN = WSP(bf16, A_XIN);
    for (int r = gw; r < MROWS; r += NGW) { const int m = IDX[r];
        const v4u* s = (const v4u*)(HB + (size_t)m * D); v4u* d = (v4u*)(XIN + (size_t)r * D);
        const v4u a = s[lane], bq = s[lane + 64]; d[lane] = a; d[lane + 64] = bq; }
}
__device__ __forceinline__ void p13_final(Frame& F) {
    const int gw = F.bid * NWAVES + F.wave, NGW = F.G * NWAVES, lane = F.lane;
    const float* H = WSP(float, A_H); const int* SEL = WSP(int, A_SEL); const float* GATE = WSP(float, A_GATE); const bf16* YE = WSP(bf16, A_YE);
    const float* g2 = F.in[31]; const float* b2 = F.in[32];
    for (int m = gw; m < M; m += NGW) {
        const int b = m / T;
        const int sl = SEL[(size_t)m * NE + (lane & 15)]; const float gt = GATE[(size_t)m * NE + (lane & 15)];
        f32x4 v[4];
#pragma unroll
        for (int j = 0; j < 4; ++j) v[j] = *((const f32x4*)(H + (size_t)m * D) + lane + 64 * j) * ALPHA;
#pragma unroll 1
        for (int e = 0; e < NE; ++e) {
            const int s = __shfl(sl, e); const float gv = __shfl(gt, e);
            if (s >= 0) { const bf16* yr = YE + ((size_t)(e * NB + b) * CAP + s) * D;
#pragma unroll
                for (int j = 0; j < 4; ++j) { const v2u w = *((const v2u*)yr + lane + 64 * j); v[j].x += gv * bflo(w.x); v[j].y += gv * bfhi(w.x); v[j].z += gv * bflo(w.y); v[j].w += gv * bfhi(w.y); } }
        }
        float s = 0.f;
#pragma unroll
        for (int j = 0; j < 4; ++j) s += (v[j].x + v[j].y) + (v[j].z + v[j].w);
        const float mean = wave_sum(s) * (1.f / D); float s2 = 0.f;
#pragma unroll
        for (int j = 0; j < 4; ++j) { v[j] = v[j] - mean; s2 += (v[j].x * v[j].x + v[j].y * v[j].y) + (v[j].z * v[j].z + v[j].w * v[j].w); }
        const float rstd = 1.f / sqrtf(wave_sum(s2) * (1.f / D) + LN_EPS);
#pragma unroll
        for (int j = 0; j < 4; ++j) { const int c = 4 * lane + 256 * j; const f32x4 gg = *(const f32x4*)(g2 + c), bb = *(const f32x4*)(b2 + c);
            *((f32x4*)(F.out + (size_t)m * D) + lane + 64 * j) = v[j] * rstd * gg + bb; }
    }
}

constexpr int N_PHASES = 16;
struct Args { const float* in[33]; float* out; unsigned char* ws; int ph_lo, ph_hi; };
__global__ void __launch_bounds__(NTHR, 2) fwd(Args args) {
    extern __shared__ __attribute__((aligned(16))) unsigned char lds[];
    Frame F;
    F.lds = (LAS unsigned char*)lds;
    F.tid = threadIdx.x; F.lane = F.tid & 63; F.wave = __builtin_amdgcn_readfirstlane(F.tid >> 6);
    F.bid = blockIdx.x; F.G = gridDim.x;
    F.in = args.in;
    F.out = args.out; F.ws = args.ws;
    volatile LAS unsigned* MISC = (volatile LAS unsigned*)(F.lds + MISC_OFF);
    if (F.tid < 64) MISC[F.tid] = 0u;
    __syncthreads();
    const int lo = args.ph_lo, hi = args.ph_hi;
    const bool single = (hi - lo) > 1;
    XcdBarrier bar; bar.bar = (unsigned*)(F.ws + WS_CTL) + CW_BAR; bar.x = 0; bar.st = nullptr;
    if (single) bar = xcd_barrier_post((unsigned*)(F.ws + WS_CTL) + CW_BAR, MISC + 8);
#ifndef PH_MASK
#define PH_MASK 0xffff
#endif
#define IN(k) (((PH_MASK >> (k)) & 1) && lo <= (k) && (k) < hi)
#define LAUNDER1(T_, p_) do { unsigned long long x_ = (unsigned long long)(p_); unsigned lo_ = (unsigned)x_, hi_ = (unsigned)(x_ >> 32); asm volatile("" : "+v"(lo_), "+v"(hi_)); \
        lo_ = __builtin_amdgcn_readfirstlane(lo_); hi_ = __builtin_amdgcn_readfirstlane(hi_); (p_) = (T_)(((unsigned long long)hi_ << 32) | lo_); } while (0)
#define LAUNDER() do { } while (0)
#define SEAM(k) do { if (IN(k) && IN((k) + 1)) xcd_barrier(bar); } while (0)

    if (IN(0)) { LAUNDER(); p0_prologue(F); p0_s5(F); } SEAM(0);
    if (IN(1)) { LAUNDER();
        pg8::Gemm g{WSP(pg8::bf16_t, A_XB), WSP(pg8::bf16_t, WS_WIN), M, NIN_PAD, D, D, D}; pg8::StaticOrder S; S.init(M, NIN_PAD, F.G, F.bid);
        pg8::EpiIn E{WSP(pg8::bf16_t, A_Z), WSP(pg8::bf16_t, A_XBC), WSP(pg8::bf16_t, A_UC), WSP(pg8::bf16_t, A_GT), WSP(float, A_DT), F.in[6], F.in[7]};
        pg8::gemm_phase<pg8::EpiIn, pg8::StaticOrder, PG8_ALIGN, PG8_SP2>(F.lds, g, S, E);
    } SEAM(1);
    if (IN(2)) { LAUNDER();
        if (F.bid >= 160) { pg8::Gemm g{WSP(pg8::bf16_t, A_UC), WSP(pg8::bf16_t, WS_WS5), S5_G * 512, S5_G * 256, 512, 768, 512}; pg8::S5aOrder S{F.bid, 160};
            pg8::EpiS5a E{WSP(float, WS_SLOC)};
            pg8::gemm_phase<pg8::EpiS5a, pg8::S5aOrder, PG8_ALIGN, PG8_SP2>(F.lds, g, S, E); __syncthreads(); }
        p2_conv(F);
    } SEAM(2);
    if (IN(3)) { LAUNDER();
        for (int it = F.bid; it < S5_G * 4; it += F.G) s5_scan_item(F, it);
        __syncthreads();
        for (int it = F.bid * NWAVES + F.wave; it < 128 * SSD_H * 4; it += F.G * NWAVES) ssd_state_item(F, it);
    } SEAM(3);
    if (IN(4)) { LAUNDER();
        { pg8::Gemm g{WSP(pg8::bf16_t, A_UC), WSP(pg8::bf16_t, WS_TV), S5_G * 512, S5_G * 512, 768, 768, 768}; pg8::S5cOrder S{F.G, F.bid};
          pg8::EpiS5c E{WSP(pg8::bf16_t, A_GY), WSP(pg8::bf16_t, A_UC), F.in[21]};
          pg8::gemm_phase<pg8::EpiS5c, pg8::S5cOrder, PG8_ALIGN, PG8_SP2>(F.lds, g, S, E); }
        ssd_scan(F, F.bid * NTHR + F.tid, F.G * NTHR);
    } SEAM(4);
    if (IN(5)) { LAUNDER(); __syncthreads(); for (int u = F.bid; u < 128 * SSD_G; u += F.G) ssd_out_unit(F, u); } SEAM(5);
    if (IN(6)) { LAUNDER(); p4_combine(F); } SEAM(6);
    if (IN(7)) { LAUNDER();
        pg8::Gemm g{WSP(pg8::bf16_t, A_Y), WSP(pg8::bf16_t, WS_WOUT), M, D, SSD_IN, SSD_IN, SSD_IN}; pg8::StaticOrder S; S.init(M, D, F.G, F.bid);
        pg8::EpiSsdOut E{WSP(float, A_YA), WSP(pg8::bf16_t, A_GT)};
        pg8::gemm_phase<pg8::EpiSsdOut, pg8::StaticOrder, PG8_ALIGN, PG8_SP2>(F.lds, g, S, E);
    } SEAM(7);
    if (IN(8)) { LAUNDER();
        pg8::Gemm g{WSP(pg8::bf16_t, A_GY), WSP(pg8::bf16_t, WS_WGLU), M, 2 * D, S5_W, S5_W, S5_W}; pg8::StaticOrder S; S.init(M, 2 * D, F.G, F.bid);
        pg8::EpiGlu E{WSP(pg8::bf16_t, A_MIX), WSP(float, A_YA), WSP(pg8::bf16_t, A_GT)};
        pg8::gemm_phase<pg8::EpiGlu, pg8::StaticOrder, PG8_ALIGN, PG8_SP2>(F.lds, g, S, E);
    } SEAM(8);
    if (IN(9)) { LAUNDER();
        pg8::Gemm g{WSP(pg8::bf16_t, A_MIX), WSP(pg8::bf16_t, WS_WO), M, D, D, D, D}; pg8::StaticOrder S; S.init(M, D, F.G, F.bid);
        pg8::EpiWo E{WSP(float, A_HP), F.in[0], ALPHA};
        pg8::gemm_phase<pg8::EpiWo, pg8::StaticOrder, PG8_ALIGN, PG8_SP2>(F.lds, g, S, E);
    } SEAM(9);
    if (IN(10)) { LAUNDER(); p8_ln_router(F); } SEAM(10);
    if (IN(11)) { LAUNDER(); if (F.bid < NB * NE) p9_topk(F, F.bid); else w2_convert(F, (F.bid - NB * NE) * NWAVES + F.wave, (F.G - NB * NE) * NWAVES); } SEAM(11);
    if (IN(12)) { LAUNDER(); p10_gather(F); } SEAM(12);
    if (IN(13)) { LAUNDER();
        pg8::Gemm g{WSP(pg8::bf16_t, A_XIN), WSP(pg8::bf16_t, WS_W1), MROWS, NE * 2 * FF, D, D, D}; pg8::MoeOrder1 S{F.G, F.bid};
        pg8::EpiMoe1 E{WSP(pg8::bf16_t, A_HID)};
        pg8::gemm_phase<pg8::EpiMoe1, pg8::MoeOrder1, PG8_ALIGN, PG8_SP2>(F.lds, g, S, E);
    } SEAM(13);
    if (IN(14)) { LAUNDER();
        pg8::Gemm g{WSP(pg8::bf16_t, A_HID), WSP(pg8::bf16_t, WS_W2), MROWS, NE * D, FF, FF, FF}; pg8::MoeOrder2 S{F.G, F.bid};
        pg8::EpiMoe2 E{WSP(pg8::bf16_t, A_YE)};
        pg8::gemm_phase<pg8::EpiMoe2, pg8::MoeOrder2, PG8_ALIGN, PG8_SP2>(F.lds, g, S, E);
    } SEAM(14);
    if (IN(15)) { LAUNDER(); p13_final(F); }
#undef IN
#undef SEAM
}

#ifndef MK_ONE_LAUNCH
#define MK_ONE_LAUNCH 1
#endif
extern "C" void kernel_launch(void* const* d_in, const int* in_sizes, int n_in, void* d_out, int out_size, void* d_ws, size_t ws_size, hipStream_t stream) {
    static int grid = 0;
    if (grid == 0) {
        if (n_in != 33 || in_sizes[0] != M * D || out_size != M * D || ws_size < WS_END) { fprintf(stderr, "kernel_launch: unexpected problem (n_in %d, in0 %d, out %d, ws %zu < %zu)\n", n_in, n_in > 0 ? in_sizes[0] : -1, out_size, ws_size, (size_t)WS_END); grid = -1; return; }
        int dev = 0, cus = 0, per_cu = 0;
        if (hipGetDevice(&dev) != hipSuccess || hipDeviceGetAttribute(&cus, hipDeviceAttributeMultiprocessorCount, dev) != hipSuccess) { grid = -1; return; }
        if (hipFuncSetAttribute((const void*)fwd, hipFuncAttributeMaxDynamicSharedMemorySize, LDS_BYTES) != hipSuccess) { fprintf(stderr, "kernel_launch: hipFuncSetAttribute failed\n"); grid = -1; return; }
        if (hipOccupancyMaxActiveBlocksPerMultiprocessor(&per_cu, (const void*)fwd, NTHR, LDS_BYTES) != hipSuccess || per_cu < 1) fprintf(stderr, "kernel_launch: occupancy query reports %d blocks per CU\n", per_cu);
        (void)hipGetLastError();
        grid = cus;
    }
    if (grid < 0) return;
    (void)hipMemsetAsync((char*)d_ws + WS_CTL, 0, CTL_ZERO_BYTES, stream);
    Args a{};
    for (int i = 0; i < 33; ++i) a.in[i] = (const float*)d_in[i];
    a.out = (float*)d_out; a.ws = (unsigned char*)d_ws;
#if MK_ONE_LAUNCH
    a.ph_lo = 0; a.ph_hi = N_PHASES;
    hipLaunchKernelGGL(fwd, dim3(grid), dim3(NTHR), LDS_BYTES, stream, a);
#else
    for (int p = 0; p < N_PHASES; ++p) { a.ph_lo = p; a.ph_hi = p + 1; hipLaunchKernelGGL(fwd, dim3(grid), dim3(NTHR), LDS_BYTES, stream, a); }
#endif
}
```

```cpp
#include <hip/hip_runtime.h>
#include <cstdio>
#include <cstdint>
namespace pg8 {
#define PG8_LAS __attribute__((address_space(3)))
typedef unsigned short bf16_t;
typedef short bf16x8 __attribute__((ext_vector_type(8)));
typedef float f32x4 __attribute__((ext_vector_type(4)));
typedef unsigned u32x4 __attribute__((ext_vector_type(4)));
constexpr int BM = 256, BK = 64, HALF = 128, HTB = HALF * BK * 2  , STAGE_BYTES = 8 * HTB, NXCD = 8, WGM = 8;

__host__ __device__ __forceinline__ int lds_byte(int r, int c) { const int st = (r >> 4) * 2 + (c >> 5), rr = r & 15, cc = c & 31, ob = rr * 64 + cc * 2; return st * 1024 + (ob ^ (((ob >> 9) & 1) << 5)); }
__host__ __device__ __forceinline__ void stage_rc(int b, int& R, int& C) { const int st = b / 1024, sb = b % 1024, swz = sb ^ (((sb >> 9) & 1) << 5); R = (st >> 1) * 16 + swz / 64; C = (st & 1) * 32 + (swz % 64) / 2; }
__host__ __device__ __forceinline__ int perm32(int rho) { const int n = rho >> 4, i = rho & 15; return 8 * (i >> 2) + 4 * n + (i & 3); }

struct Unit { int pm, pn; };
struct Gemm { const bf16_t* A; const bf16_t* Bt; int M, N, K, lda, ldb; };

struct StaticOrder {
    int nM, nN, nwg, G, c;
    __host__ __device__ void init(int M, int N, int G_, int c_) { nM = M / BM; nN = N / BM; nwg = nM * nN; G = G_; c = c_; }
    __host__ __device__ bool next(int i, Unit& u) const {
        const long L = (long)i * G + c; if (L >= nwg) return false;
        int wgid = (int)L; { const int q = nwg / NXCD, r = nwg % NXCD, xcd = wgid % NXCD, off = wgid / NXCD; wgid = (xcd < r ? xcd * (q + 1) : r * (q + 1) + (xcd - r) * q) + off; }
        const int nig = WGM * nN, gid = wgid / nig, fm = gid * WGM, gsz = (nM - fm) < WGM ? (nM - fm) : WGM;
        u.pm = fm + ((wgid % nig) % gsz); u.pn = (wgid % nig) / gsz; return true;
    }
    __device__ __forceinline__ void a_ready(const Unit&) const {}
    __device__ __forceinline__ void done(const Unit&) const {}
};

typedef __bf16 bf16v2_t __attribute__((ext_vector_type(2)));
typedef float f32v2_t __attribute__((ext_vector_type(2)));
__device__ __forceinline__ unsigned cvt_pk_bf16(float lo, float hi) { const f32v2_t f = {lo, hi}; return __builtin_bit_cast(unsigned, __builtin_convertvector(f, bf16v2_t)); }
typedef float f32x2 __attribute__((ext_vector_type(2)));
__device__ __forceinline__ f32x2 gelu_pk(f32x2 v) {
    const f32x2 av = __builtin_elementwise_abs(v), d = av * 0.2316418882f + 1.0f;
    f32x2 t; t.x = __builtin_amdgcn_rcpf(d.x); t.y = __builtin_amdgcn_rcpf(d.y);
    f32x2 q = t * 0.5307027145f + (-0.7265760135f); q = q * t + 0.7107068705f; q = q * t + (-0.142248368f); q = q * t + 0.127414796f; q = q * t;
    const f32x2 s = (v * v) * (-0.72134752044f);
    f32x2 e; e.x = __builtin_amdgcn_exp2f(s.x); e.y = __builtin_amdgcn_exp2f(s.y);
    const f32x2 m = v * (q * e), r = v - m;
    f32x2 o; o.x = v.x < 0.f ? m.x : r.x; o.y = v.y < 0.f ? m.y : r.y; return o;
}


__device__ __forceinline__ float fsigmoid(float x) { return __builtin_amdgcn_rcpf(1.0f + __expf(-x)); }
__device__ __forceinline__ float fsilu(float x) { return x * fsigmoid(x); }
__device__ __forceinline__ float bf_lo(unsigned w) { return __uint_as_float(w << 16); }
__device__ __forceinline__ float bf_hi(unsigned w) { return __uint_as_float(w & 0xffff0000u); }
typedef unsigned u32x2 __attribute__((ext_vector_type(2)));

struct EpiIn {
    static constexpr bool PERM = true, AFTER_DRAIN = false;
    bf16_t *Z, *XBC, *UC, *GT; float* DT; const float *dtb_f, *dtb_b;
    __device__ __forceinline__ void operator()(const f32x4 (&acc)[2][2][4][2], const Unit& u, int wr, int wc, int fr, int fq) const {
        const int row0 = u.pm * BM + wr * 64 + fr; const int pn = u.pn;
        if (pn == 16) {
            if (wc < 2) {
#pragma unroll
                for (int n = 0; n < 2; ++n) { const int col = wc * 32 + 8 * fq + 4 * n;
                    if (col < 48) { f32x4 bv;
#pragma unroll
                        for (int j = 0; j < 4; ++j) { const int cc = col + j; bv[j] = cc < 24 ? dtb_f[cc] : dtb_b[cc - 24]; }
#pragma unroll
                        for (int ai = 0; ai < 2; ++ai)
#pragma unroll
                            for (int m = 0; m < 4; ++m) { f32x4 v = acc[ai][0][m][n] + bv;
#pragma unroll
                                for (int j = 0; j < 4; ++j) { const float x = v[j]; v[j] = fmaxf(x, 0.f) + log1pf(__expf(-fabsf(x))); }
                                *(f32x4*)(DT + (size_t)(row0 + ai * HALF + m * 16) * 48 + col) = v; } } }
            }
            return;
        }
        int mode, ldc, colt; bf16_t* base;
        if (pn < 6) { mode = 1; base = Z; ldc = 1536; colt = pn * BM; }
        else if (pn < 16) { mode = 0; base = XBC; ldc = 2560; colt = (pn - 6) * BM; }
        else if (pn < 20) {
            const int uc = (pn - 17) * BM + wc * 32 + 8 * fq, g0 = uc >> 4, j0 = uc & 15;
#pragma unroll
            for (int ai = 0; ai < 2; ++ai)
#pragma unroll
                for (int m = 0; m < 4; ++m) { const int r = row0 + ai * HALF + m * 16, cl = r >> 5, s = r & 31;
#pragma unroll
                    for (int bj = 0; bj < 2; ++bj) { const f32x4 v0 = acc[ai][bj][m][0], v1 = acc[ai][bj][m][1];
                        u32x4 w; w.x = cvt_pk_bf16(v0[0], v0[1]); w.y = cvt_pk_bf16(v0[2], v0[3]); w.z = cvt_pk_bf16(v1[0], v1[1]); w.w = cvt_pk_bf16(v1[2], v1[3]);
                        *(u32x4*)(UC + ((size_t)((g0 + 8 * bj) * 512 + cl) * 768 + s * 16 + j0)) = w; } }
            return; }
        else { mode = 2; base = GT; ldc = 2048; colt = (pn - 20) * BM; }
        const int col0 = colt + wc * 32 + 8 * fq;
#pragma unroll
        for (int ai = 0; ai < 2; ++ai)
#pragma unroll
            for (int m = 0; m < 4; ++m) { bf16_t* rowp = base + (size_t)(row0 + ai * HALF + m * 16) * ldc + col0;
#pragma unroll
                for (int bj = 0; bj < 2; ++bj) { f32x4 v0 = acc[ai][bj][m][0], v1 = acc[ai][bj][m][1];
                    if (mode == 1) {
#pragma unroll
                        for (int j = 0; j < 4; ++j) { v0[j] = fsilu(v0[j]); v1[j] = fsilu(v1[j]); } }
                    else if (mode == 2) {
#pragma unroll
                        for (int j = 0; j < 4; ++j) { v0[j] = fsigmoid(v0[j]); v1[j] = fsigmoid(v1[j]); } }
                    u32x4 w; w.x = cvt_pk_bf16(v0[0], v0[1]); w.y = cvt_pk_bf16(v0[2], v0[3]); w.z = cvt_pk_bf16(v1[0], v1[1]); w.w = cvt_pk_bf16(v1[2], v1[3]);
                    *(u32x4*)(rowp + bj * HALF) = w; } }
    }
};
struct EpiSsdOut {
    static constexpr bool PERM = false, AFTER_DRAIN = false;
    float* YA; const bf16_t* GT;
    __device__ __forceinline__ void operator()(const f32x4 (&acc)[2][2][4][2], const Unit& u, int wr, int wc, int fr, int fq) const {
        const int row0 = u.pm * BM + wr * 64 + fr, col0 = u.pn * BM + wc * 32 + 4 * fq;
#pragma unroll
        for (int ai = 0; ai < 2; ++ai)
#pragma unroll
            for (int m = 0; m < 4; ++m) { const size_t r = (size_t)(row0 + ai * HALF + m * 16);
#pragma unroll
                for (int bj = 0; bj < 2; ++bj)
#pragma unroll
                    for (int n = 0; n < 2; ++n) { const int c = col0 + bj * HALF + n * 16; const u32x2 g = *(const u32x2*)(GT + r * 2048 + c);
                        f32x4 v = acc[ai][bj][m][n]; v[0] *= bf_lo(g.x); v[1] *= bf_hi(g.x); v[2] *= bf_lo(g.y); v[3] *= bf_hi(g.y);
                        *(f32x4*)(YA + r * 1024 + c) = v; } }
    }
};
struct EpiGlu {
    static constexpr bool PERM = true, AFTER_DRAIN = false;
    bf16_t* MIX; const float* YA; const bf16_t* GT;
    __device__ __forceinline__ void operator()(const f32x4 (&acc)[2][2][4][2], const Unit& u, int wr, int wc, int fr, int fq) const {
        const int row0 = u.pm * BM + wr * 64 + fr, col0 = u.pn * HALF + wc * 32 + 8 * fq;
#pragma unroll
        for (int ai = 0; ai < 2; ++ai)
#pragma unroll
            for (int m = 0; m < 4; ++m) { const size_t r = (size_t)(row0 + ai * HALF + m * 16);
                const u32x4 g = *(const u32x4*)(GT + r * 2048 + 1024 + col0); const f32x4 y0 = *(const f32x4*)(YA + r * 1024 + col0), y1 = *(const f32x4*)(YA + r * 1024 + col0 + 4);
                f32x4 a0 = acc[ai][0][m][0], a1 = acc[ai][0][m][1]; const f32x4 b0 = acc[ai][1][m][0], b1 = acc[ai][1][m][1];
#pragma unroll
                for (int j = 0; j < 4; ++j) { a0[j] *= fsigmoid(b0[j]); a1[j] *= fsigmoid(b1[j]); }
                a0[0] = a0[0] * bf_lo(g.x) + y0[0]; a0[1] = a0[1] * bf_hi(g.x) + y0[1]; a0[2] = a0[2] * bf_lo(g.y) + y0[2]; a0[3] = a0[3] * bf_hi(g.y) + y0[3];
                a1[0] = a1[0] * bf_lo(g.z) + y1[0]; a1[1] = a1[1] * bf_hi(g.z) + y1[1]; a1[2] = a1[2] * bf_lo(g.w) + y1[2]; a1[3] = a1[3] * bf_hi(g.w) + y1[3];
                u32x4 w; w.x = cvt_pk_bf16(a0[0], a0[1]); w.y = cvt_pk_bf16(a0[2], a0[3]); w.z = cvt_pk_bf16(a1[0], a1[1]); w.w = cvt_pk_bf16(a1[2], a1[3]);
                *(u32x4*)(MIX + r * 1024 + col0) = w; }
    }
};
struct EpiWo {
    static constexpr bool PERM = false, AFTER_DRAIN = false;
    float* HP; const float* X; float alpha;
    __device__ __forceinline__ void operator()(const f32x4 (&acc)[2][2][4][2], const Unit& u, int wr, int wc, int fr, int fq) const {
        const int row0 = u.pm * BM + wr * 64 + fr, col0 = u.pn * BM + wc * 32 + 4 * fq;
#pragma unroll
        for (int ai = 0; ai < 2; ++ai)
#pragma unroll
            for (int m = 0; m < 4; ++m) { const size_t r = (size_t)(row0 + ai * HALF + m * 16);
#pragma unroll
                for (int bj = 0; bj < 2; ++bj)
#pragma unroll
                    for (int n = 0; n < 2; ++n) { const int c = col0 + bj * HALF + n * 16; const f32x4 xv = *(const f32x4*)(X + r * 1024 + c);
                        *(f32x4*)(HP + r * 1024 + c) = acc[ai][bj][m][n] + xv * alpha; } }
    }
};
struct EpiMoe1 {
    static constexpr bool PERM = true, AFTER_DRAIN = false;
    bf16_t* HID;
    __device__ __forceinline__ void operator()(const f32x4 (&acc)[2][2][4][2], const Unit& u, int wr, int wc, int fr, int fq) const {
        const int row0 = u.pm * BM + wr * 64 + fr, col0 = (u.pn % 22) * HALF + wc * 32 + 8 * fq;
#pragma unroll
        for (int ai = 0; ai < 2; ++ai)
#pragma unroll
            for (int m = 0; m < 4; ++m) { const size_t r = (size_t)(row0 + ai * HALF + m * 16);
                f32x4 a0 = acc[ai][0][m][0], a1 = acc[ai][0][m][1]; const f32x4 b0 = acc[ai][1][m][0], b1 = acc[ai][1][m][1];
#pragma unroll
                for (int j = 0; j < 4; ++j) { a0[j] = fsilu(a0[j]) * b0[j]; a1[j] = fsilu(a1[j]) * b1[j]; }
                u32x4 w; w.x = cvt_pk_bf16(a0[0], a0[1]); w.y = cvt_pk_bf16(a0[2], a0[3]); w.z = cvt_pk_bf16(a1[0], a1[1]); w.w = cvt_pk_bf16(a1[2], a1[3]);
                *(u32x4*)(HID + r * 2816 + col0) = w; }
    }
};
struct EpiMoe2 {
    static constexpr bool PERM = true, AFTER_DRAIN = false;
    bf16_t* Y;
    __device__ __forceinline__ void operator()(const f32x4 (&acc)[2][2][4][2], const Unit& u, int wr, int wc, int fr, int fq) const {
        const int row0 = u.pm * BM + wr * 64 + fr, col0 = (u.pn & 3) * BM + wc * 32 + 8 * fq;
#pragma unroll
        for (int ai = 0; ai < 2; ++ai)
#pragma unroll
            for (int m = 0; m < 4; ++m) { bf16_t* rowp = Y + (size_t)(row0 + ai * HALF + m * 16) * 1024 + col0;
#pragma unroll
                for (int bj = 0; bj < 2; ++bj) { const f32x4 v0 = acc[ai][bj][m][0], v1 = acc[ai][bj][m][1];
                    u32x4 w; w.x = cvt_pk_bf16(v0[0], v0[1]); w.y = cvt_pk_bf16(v0[2], v0[3]); w.z = cvt_pk_bf16(v1[0], v1[1]); w.w = cvt_pk_bf16(v1[2], v1[3]);
                    *(u32x4*)(rowp + bj * HALF) = w; } }
    }
};

struct EpiS5a {
    static constexpr bool PERM = false, AFTER_DRAIN = false;
    float* SLOC;
    __device__ __forceinline__ void operator()(const f32x4 (&acc)[2][2][4][2], const Unit& u, int wr, int wc, int fr, int fq) const {
        const int row0 = u.pm * BM + wr * 64 + fr, col0 = wc * 32 + 4 * fq;
#pragma unroll
        for (int ai = 0; ai < 2; ++ai)
#pragma unroll
            for (int m = 0; m < 4; ++m) { float* rowp = SLOC + (size_t)(row0 + ai * HALF + m * 16) * 256 + col0;
#pragma unroll
                for (int bj = 0; bj < 2; ++bj)
#pragma unroll
                    for (int n = 0; n < 2; ++n) *(f32x4*)(rowp + bj * HALF + n * 16) = acc[ai][bj][m][n]; }
    }
};
__device__ __forceinline__ float gelu_tanh_f(float x) { const float uu = 0.7978845608028654f * (x + 0.044715f * x * x * x); const float e = __expf(2.f * uu); return 0.5f * x * (2.f - 2.f * __builtin_amdgcn_rcpf(e + 1.f)); }
struct EpiS5c {
    static constexpr bool PERM = true, AFTER_DRAIN = false;
    bf16_t* GY; const bf16_t* UC; const float* d5;
    __device__ __forceinline__ void operator()(const f32x4 (&acc)[2][2][4][2], const Unit& u, int wr, int wc, int fr, int fq) const {
        const int g = u.pm >> 1, cl0 = (u.pm & 1) * BM + wr * 64 + fr, nl0 = (u.pn & 1) * BM + wc * 32 + 8 * fq;
        const int k0 = nl0 & 15; const f32x4 d0 = *(const f32x4*)(d5 + g * 16 + k0), d1 = *(const f32x4*)(d5 + g * 16 + k0 + 4);
#pragma unroll
        for (int ai = 0; ai < 2; ++ai)
#pragma unroll
            for (int m = 0; m < 4; ++m) { const int cl = cl0 + ai * HALF + m * 16;
#pragma unroll
                for (int bj = 0; bj < 2; ++bj) { const int nl = nl0 + bj * HALF, t = nl >> 4;
                    const u32x4 uw = *(const u32x4*)(UC + ((size_t)(g * 512 + cl) * 768 + nl));
                    f32x4 v0 = acc[ai][bj][m][0], v1 = acc[ai][bj][m][1];
                    v0[0] += bf_lo(uw.x) * d0[0]; v0[1] += bf_hi(uw.x) * d0[1]; v0[2] += bf_lo(uw.y) * d0[2]; v0[3] += bf_hi(uw.y) * d0[3];
                    v1[0] += bf_lo(uw.z) * d1[0]; v1[1] += bf_hi(uw.z) * d1[1]; v1[2] += bf_lo(uw.w) * d1[2]; v1[3] += bf_hi(uw.w) * d1[3];
#pragma unroll
                    for (int j = 0; j < 4; ++j) { v0[j] = gelu_tanh_f(v0[j]); v1[j] = gelu_tanh_f(v1[j]); }
                    u32x4 w; w.x = cvt_pk_bf16(v0[0], v0[1]); w.y = cvt_pk_bf16(v0[2], v0[3]); w.z = cvt_pk_bf16(v1[0], v1[1]); w.w = cvt_pk_bf16(v1[2], v1[3]);
                    *(u32x4*)(GY + (size_t)(cl * 32 + t) * 768 + g * 16 + k0) = w; } }
    }
};
struct S5aOrder {
    int c, lo;
    __device__ __forceinline__ bool next(int i, Unit& u) const { if (i > 0 || c < lo || c >= lo + 96) return false; u.pm = c - lo; u.pn = (c - lo) >> 1; return true; }
    __device__ __forceinline__ void a_ready(const Unit&) const {}
    __device__ __forceinline__ void done(const Unit&) const {}
};
struct S5cOrder {
    int G, c;
    __device__ __forceinline__ bool next(int i, Unit& u) const { const int L = i * G + c; if (L >= 192) return false; const int g = L >> 2; u.pm = 2 * g + (L & 1); u.pn = 2 * g + ((L >> 1) & 1); return true; }
    __device__ __forceinline__ void a_ready(const Unit&) const {}
    __device__ __forceinline__ void done(const Unit&) const {}
};
struct MoeOrder1 {
    int G, c;
    __device__ __forceinline__ bool next(int i, Unit& u) const {
        if (G == 256) { if (i >= 11) return false; const int x = c & 7, j = c >> 3, q = x * 44 + i * 4 + (j >> 3); u.pm = (q / 22) * 8 + (j & 7); u.pn = q; return true; }
        const long L = (long)i * G + c; if (L >= 2816) return false; const int e = (int)(L / 176), r = (int)(L % 176); u.pm = e * 8 + (r & 7); u.pn = e * 22 + (r >> 3); return true;
    }
    __device__ __forceinline__ void a_ready(const Unit&) const {}
    __device__ __forceinline__ void done(const Unit&) const {}
};
struct MoeOrder2 {
    int G, c;
    __device__ __forceinline__ bool next(int i, Unit& u) const {
        if (G == 256) { if (i >= 2) return false; const int x = c & 7, j = c >> 3, e = 2 * x + i; u.pm = e * 8 + (j & 7); u.pn = e * 4 + (j >> 3); return true; }
        const long L = (long)i * G + c; if (L >= 512) return false; const int e = (int)(L / 32), r = (int)(L % 32); u.pm = e * 8 + (r & 7); u.pn = e * 4 + (r >> 3); return true;
    }
    __device__ __forceinline__ void a_ready(const Unit&) const {}
    __device__ __forceinline__ void done(const Unit&) const {}
};
template <class Epi, class Sched, bool ALIGN_EPI = false, bool SP2 = false>
__device__ __forceinline__ void gemm_phase(PG8_LAS unsigned char* lds, const Gemm g, const Sched& S, const Epi& E) {
    const int tid = threadIdx.x, wid = __builtin_amdgcn_readfirstlane(tid >> 6), lane = tid & 63, wr = wid >> 2, wc = wid & 3, fr = lane & 15, fq = lane >> 4;
    const int K = g.K, nt = K / BK;
    unsigned voffA[2], voffB[2];
#pragma unroll
    for (int i = 0; i < 2; ++i) { int R, C; stage_rc(tid * 16 + i * 8192, R, C); const int Rb = Epi::PERM ? ((R & ~31) + perm32(R & 31)) : R;
        voffA[i] = (unsigned)(R * g.lda + C) * 2u; voffB[i] = (unsigned)(Rb * g.ldb + C) * 2u; }
    const size_t kstep = (size_t)(BK * 2);
    const size_t hstepA = (size_t)HALF * g.lda * 2, hstepB = (size_t)HALF * g.ldb * 2;
    const size_t tstepA = 2 * hstepA, tstepB = 2 * hstepB;
    const unsigned ldsw = (unsigned)wid * 1024u;
    const int aoff = lds_byte(wr * 64 + fr, fq * 8), boff = lds_byte(wc * 32 + fr, fq * 8);
#define PG8_SA(b, h) (((b) * 2 + (h)) * HTB)
#define PG8_SB(b, h) ((4 + (b) * 2 + (h)) * HTB)
#define PG8_STAGE(bufoff, gbase, voff) do { _Pragma("unroll") for (int _i = 0; _i < 2; ++_i) \
        __builtin_amdgcn_global_load_lds((const unsigned*)((const char*)(gbase) + (voff)[_i]), (PG8_LAS unsigned*)(lds + (bufoff) + ldsw + _i * 8192), 16, 0, 0); } while (0)
#define PG8_LDA(dst, b, h) do { _Pragma("unroll") for (int m = 0; m < 4; ++m) _Pragma("unroll") for (int k = 0; k < 2; ++k) dst[m][k] = *(const PG8_LAS bf16x8*)(lds + PG8_SA(b, h) + aoff + m * 2048 + k * 1024); } while (0)
#define PG8_LDB(dst, b, h) do { _Pragma("unroll") for (int n = 0; n < 2; ++n) _Pragma("unroll") for (int k = 0; k < 2; ++k) dst[n][k] = *(const PG8_LAS bf16x8*)(lds + PG8_SB(b, h) + boff + n * 2048 + k * 1024); } while (0)
#define PG8_MMA(ai, bj, At, Bt) do { __builtin_amdgcn_s_setprio(1); _Pragma("unroll") for (int m = 0; m < 4; ++m) _Pragma("unroll") for (int n = 0; n < 2; ++n) _Pragma("unroll") for (int k = 0; k < 2; ++k) \
        acc[ai][bj][m][n] = __builtin_amdgcn_mfma_f32_16x16x32_bf16(Bt[n][k], At[m][k], acc[ai][bj][m][n], 0, 0, 0); __builtin_amdgcn_s_setprio(0); } while (0)
#define PG8_WAIT_V(n) asm volatile("s_waitcnt vmcnt(" #n ")" ::: "memory")
#define PG8_WAIT_L(n) asm volatile("s_waitcnt lgkmcnt(" #n ")" ::: "memory")
#define PG8_BAR __builtin_amdgcn_s_barrier()
#define PG8_SCHED __builtin_amdgcn_sched_barrier(0)
    Unit cur, nxt; int ui = 0;
    if (!S.next(0, cur)) return;
    f32x4 acc[2][2][4][2];
#pragma unroll
    for (int a = 0; a < 2; ++a)
#pragma unroll
        for (int b = 0; b < 2; ++b)
#pragma unroll
            for (int m = 0; m < 4; ++m)
#pragma unroll
                for (int n = 0; n < 2; ++n) acc[a][b][m][n] = (f32x4){0.f, 0.f, 0.f, 0.f};
    bf16x8 At[4][2], B0[2][2], B1[2][2];
    const char* cA = (const char*)g.A + (size_t)cur.pm * tstepA; const char* cB = (const char*)g.Bt + (size_t)cur.pn * tstepB;
    S.a_ready(cur);
    if constexpr (SP2) {
        PG8_STAGE(PG8_SB(0, 0), cB, voffB); PG8_STAGE(PG8_SB(0, 1), cB + hstepB, voffB); PG8_STAGE(PG8_SA(0, 0), cA, voffA); PG8_STAGE(PG8_SA(0, 1), cA + hstepA, voffA);
        if (wr == 1) PG8_BAR;
        PG8_WAIT_V(2); PG8_BAR;
        PG8_STAGE(PG8_SB(1, 0), cB + kstep, voffB); PG8_STAGE(PG8_SA(1, 0), cA + kstep, voffA); PG8_STAGE(PG8_SB(1, 1), cB + hstepB + kstep, voffB);
        PG8_WAIT_V(6); PG8_BAR;
    } else {
        PG8_STAGE(PG8_SB(0, 0), cB, voffB); PG8_STAGE(PG8_SA(0, 0), cA, voffA); PG8_STAGE(PG8_SB(0, 1), cB + hstepB, voffB); PG8_STAGE(PG8_SA(0, 1), cA + hstepA, voffA);
        if (wr == 1) PG8_BAR;
        PG8_WAIT_V(4); PG8_BAR;
        PG8_STAGE(PG8_SB(1, 0), cB + kstep, voffB); PG8_STAGE(PG8_SA(1, 0), cA + kstep, voffA); PG8_STAGE(PG8_SB(1, 1), cB + hstepB + kstep, voffB);
        PG8_WAIT_V(6); PG8_BAR;
    }
    for (;;) {
        const bool has_next = S.next(ui + 1, nxt);
        const char* nA = has_next ? (const char*)g.A + (size_t)nxt.pm * tstepA : cA; const char* nB = has_next ? (const char*)g.Bt + (size_t)nxt.pn * tstepB : cB;
        for (int t = 0; t < nt; t += 2) {
            const bool last = (t == nt - 2);
            const char* a1 = cA + (size_t)(t + 1) * kstep;
            const char* a2 = last ? nA : cA + (size_t)(t + 2) * kstep; const char* b2 = last ? nB : cB + (size_t)(t + 2) * kstep;
            const char* a3 = a2 + kstep; const char* b3 = b2 + kstep;
            if (last && has_next) S.a_ready(nxt);
            if constexpr (SP2) {
            PG8_LDB(B0, 0, 0); PG8_LDB(B1, 0, 1); PG8_SCHED; PG8_LDA(At, 0, 0); PG8_STAGE(PG8_SA(1, 1), a1 + hstepA, voffA);
            PG8_WAIT_V(8); PG8_WAIT_L(0); PG8_BAR; PG8_MMA(0, 0, At, B0); PG8_MMA(0, 1, At, B1); PG8_BAR; PG8_SCHED;
            PG8_LDA(At, 0, 1); PG8_STAGE(PG8_SB(0, 0), b2, voffB); PG8_STAGE(PG8_SB(0, 1), b2 + hstepB, voffB); PG8_STAGE(PG8_SA(0, 0), a2, voffA);
            PG8_WAIT_V(8); PG8_WAIT_L(0); PG8_BAR; PG8_MMA(1, 0, At, B0); PG8_MMA(1, 1, At, B1); PG8_BAR; PG8_SCHED;
            PG8_LDB(B0, 1, 0); PG8_LDB(B1, 1, 1); PG8_SCHED; PG8_LDA(At, 1, 0); PG8_STAGE(PG8_SA(0, 1), a2 + hstepA, voffA);
            PG8_WAIT_V(8); PG8_WAIT_L(0); PG8_BAR; PG8_MMA(0, 0, At, B0); PG8_MMA(0, 1, At, B1); PG8_BAR; PG8_SCHED;
            PG8_LDA(At, 1, 1); PG8_STAGE(PG8_SB(1, 0), b3, voffB); PG8_STAGE(PG8_SB(1, 1), b3 + hstepB, voffB); PG8_STAGE(PG8_SA(1, 0), a3, voffA);
            PG8_WAIT_V(8); PG8_WAIT_L(0); PG8_BAR; PG8_MMA(1, 0, At, B0); PG8_MMA(1, 1, At, B1); PG8_BAR; PG8_SCHED;
            } else {
            PG8_LDB(B0, 0, 0); PG8_SCHED; PG8_LDA(At, 0, 0); PG8_STAGE(PG8_SA(1, 1), a1 + hstepA, voffA);
            PG8_WAIT_L(8); PG8_BAR; PG8_WAIT_L(0); PG8_MMA(0, 0, At, B0); PG8_BAR; PG8_SCHED;
            PG8_LDB(B1, 0, 1); PG8_STAGE(PG8_SB(0, 0), b2, voffB);
            PG8_BAR; PG8_WAIT_L(0); PG8_MMA(0, 1, At, B1); PG8_BAR;
            PG8_LDA(At, 0, 1); PG8_STAGE(PG8_SA(0, 0), a2, voffA);
            PG8_BAR; PG8_WAIT_L(0); PG8_MMA(1, 0, At, B0); PG8_BAR; PG8_SCHED;
            PG8_STAGE(PG8_SB(0, 1), b2 + hstepB, voffB);
            PG8_WAIT_V(6); PG8_BAR; PG8_MMA(1, 1, At, B1); PG8_BAR;
            PG8_LDB(B0, 1, 0); PG8_SCHED; PG8_LDA(At, 1, 0); PG8_STAGE(PG8_SA(0, 1), a2 + hstepA, voffA);
            PG8_WAIT_L(8); PG8_BAR; PG8_WAIT_L(0); PG8_MMA(0, 0, At, B0); PG8_BAR; PG8_SCHED;
            PG8_LDB(B1, 1, 1); PG8_STAGE(PG8_SB(1, 0), b3, voffB);
            PG8_BAR; PG8_WAIT_L(0); PG8_MMA(0, 1, At, B1); PG8_BAR;
            PG8_LDA(At, 1, 1); PG8_STAGE(PG8_SA(1, 0), a3, voffA);
            PG8_BAR; PG8_WAIT_L(0); PG8_MMA(1, 0, At, B0); PG8_BAR; PG8_SCHED;
            PG8_STAGE(PG8_SB(1, 1), b3 + hstepB, voffB);
            PG8_WAIT_V(6); PG8_BAR; PG8_MMA(1, 1, At, B1); PG8_BAR;
            }
        }
        if constexpr (ALIGN_EPI) { if (wr == 0) PG8_BAR; }
        if constexpr (!Epi::AFTER_DRAIN) { E(acc, cur, wr, wc, fr, fq); S.done(cur); }
        if (!has_next) break;
#pragma unroll
        for (int a = 0; a < 2; ++a)
#pragma unroll
            for (int b = 0; b < 2; ++b)
#pragma unroll
                for (int m = 0; m < 4; ++m)
#pragma unroll
                    for (int n = 0; n < 2; ++n) acc[a][b][m][n] = (f32x4){0.f, 0.f, 0.f, 0.f};
        cur = nxt; cA = nA; cB = nB; ++ui;
        if constexpr (ALIGN_EPI) { if (wr == 1) PG8_BAR; }
    }
    PG8_WAIT_V(0);
    if constexpr (!ALIGN_EPI) { if (wr == 0) PG8_BAR; }
    PG8_BAR;
    if constexpr (Epi::AFTER_DRAIN) { E.fused(acc, cur, wr, wc, fr, fq, lds, wid, lane); S.done(cur); }
#undef PG8_SA
#undef PG8_SB
#undef PG8_STAGE
#undef PG8_LDA
#undef PG8_LDB
#undef PG8_MMA
#undef PG8_WAIT_V
#undef PG8_WAIT_L
#undef PG8_BAR
#undef PG8_SCHED
}
}
#ifndef PG8_SP2
#define PG8_SP2 true
#endif
#ifndef PG8_ALIGN
#define PG8_ALIGN true
#endif

constexpr int NWAVES = 8, NTHR = 512;
constexpr int D = 1024, NB = 2, T = 8192, M = NB * T;
constexpr int SSD_H = 24, SSD_P = 64, SSD_IN = 1536, SSD_G = 4, SSD_N = 128, XBC = 2560, INCOLS = 6960, NIN_PAD = 7168;
constexpr int S5_W = 768, S5_G = 48, S5_P = 64, S5_K = 16;
constexpr int NE = 16, FF = 2816, CAP = 1024, MROWS = NE * NB * CAP;
constexpr float LN_EPS = 1e-5f, RMS_EPS = 1e-5f;
constexpr float ALPHA = 1.189207115002721f;

constexpr size_t MiB = 1u << 20;
constexpr size_t WS_CTL = 0, CTL_ZERO_BYTES = 64 * 1024;
constexpr size_t WS_WIN = 1 * MiB, WS_WOUT = 15 * MiB, WS_WGLU = 18 * MiB, WS_WO = 21 * MiB, WS_W1 = 23 * MiB, WS_W2 = 199 * MiB, WS_ACT = 287 * MiB;
constexpr size_t A_XB = WS_ACT + 0 * MiB;
constexpr size_t A_BN = WS_ACT + 0 * MiB;
constexpr size_t A_CN = WS_ACT + 16 * MiB;
constexpr size_t A_Z = WS_ACT + 32 * MiB;
constexpr size_t A_XBC = WS_ACT + 80 * MiB;
constexpr size_t A_S = WS_ACT + 80 * MiB;
constexpr size_t A_XT = WS_ACT + 176 * MiB;
constexpr size_t A_BT = WS_ACT + 224 * MiB;
constexpr size_t A_SV = WS_ACT + 240 * MiB;
constexpr size_t A_DT = WS_ACT + 252 * MiB;
constexpr size_t A_TOT = WS_ACT + 255 * MiB;
constexpr size_t A_UC = WS_ACT + 268 * MiB;
constexpr size_t A_Y = WS_ACT + 256 * MiB;
constexpr size_t A_GY = WS_ACT + 304 * MiB;
constexpr size_t A_GT = WS_ACT + 353 * MiB;
constexpr size_t A_YA = WS_ACT + 0 * MiB;
constexpr size_t A_MIX = WS_ACT + 64 * MiB;
constexpr size_t A_HP = WS_ACT + 96 * MiB;
constexpr size_t A_H = WS_ACT + 0 * MiB;
constexpr size_t A_HB = WS_ACT + 64 * MiB;
constexpr size_t A_AFF = WS_ACT + 160 * MiB;
constexpr size_t A_IDX = A_AFF + 512 * 1024;
constexpr size_t A_SEL = A_AFF + 1 * MiB;
constexpr size_t A_GATE = A_AFF + 2 * MiB;
constexpr size_t A_XIN = WS_ACT + 164 * MiB;
constexpr size_t A_HID = WS_ACT + 228 * MiB;
constexpr size_t A_YE = WS_ACT + 96 * MiB;
constexpr size_t WS_TV = WS_W2 + 0 * MiB;
constexpr size_t WS_WS5 = WS_W2 + 36 * MiB;
constexpr size_t WS_SLOC = WS_W2 + 48 * MiB;
constexpr size_t WS_AQ = WS_W2 + 72 * MiB;
constexpr size_t WS_END = 704 * MiB;
static_assert(A_HID + 176 * MiB <= WS_END && A_XIN + 64 * MiB <= A_HID && A_GATE + 1 * MiB <= A_XIN && A_YE + 64 * MiB <= A_AFF && A_H + 64 * MiB <= A_HB && A_HB + 32 * MiB <= A_HP, "d_ws map (late phases)");
static_assert(A_GT + 64 * MiB <= WS_END && A_GY + 24 * MiB <= A_GT && A_UC + 36 * MiB <= A_GY && A_Y + 48 * MiB <= A_GY && A_TOT + 1 * MiB <= A_Y && A_DT + 3 * MiB <= A_TOT && A_SV + 12 * MiB <= A_DT && A_BT + 16 * MiB <= A_SV
              && A_XT + 48 * MiB <= A_BT && A_S + 96 * MiB <= A_XT && A_Z + 48 * MiB <= A_XBC && A_CN + 16 * MiB <= A_Z, "d_ws map (early phases)");
constexpr int CW_BAR = 1024;

constexpr int RING_BYTES = 131072;
constexpr int MISC_OFF = RING_BYTES;
constexpr int LDS_BYTES = 147456;

#define GAS __attribute__((address_space(1)))
#define LAS __attribute__((address_space(3)))
typedef unsigned short bf16;
typedef unsigned v4u __attribute__((ext_vector_type(4)));
typedef unsigned v2u __attribute__((ext_vector_type(2)));
typedef float f32x4 __attribute__((ext_vector_type(4)));
#define LDS_WAIT() asm volatile("s_waitcnt lgkmcnt(0)" ::: "memory")
__device__ __forceinline__ unsigned f2bf(float f) { unsigned u = __builtin_bit_cast(unsigned, f); return (u + 0x7fffu + ((u >> 16) & 1u)) >> 16; }
__device__ __forceinline__ unsigned pk2(float lo, float hi) { return pg8::cvt_pk_bf16(lo, hi); }
__device__ __forceinline__ float bflo(unsigned w) { return __uint_as_float(w << 16); }
__device__ __forceinline__ float bfhi(unsigned w) { return __uint_as_float(w & 0xffff0000u); }
__device__ __forceinline__ float wave_sum(float v) {
#pragma unroll
    for (int o = 1; o < 64; o <<= 1) v += __shfl_xor(v, o);
    return v;
}
#define XB_TMO      128
#define XB_XCNT(j)  (256  + 64 * (j))
#define XB_XSUB(j)  (1280 + 64 * (j))
#define XB_XGEN(j)  (2304 + 64 * (j))
#define XB_TOP      3328
#define XB_TOPGEN   3392
#define XCD_BAR_WORDS 3456
#define XB_SPIN_CAP (1u << 18)

__device__ __forceinline__ unsigned xb_ld(unsigned* p)              { return __hip_atomic_load(p, __ATOMIC_RELAXED, __HIP_MEMORY_SCOPE_AGENT); }
__device__ __forceinline__ unsigned xb_add(unsigned* p, unsigned v) { return __hip_atomic_fetch_add(p, v, __ATOMIC_RELAXED, __HIP_MEMORY_SCOPE_AGENT); }
__device__ __forceinline__ unsigned xb_xcc_id() { return (unsigned)__builtin_amdgcn_s_getreg((3 << 11) | 20) & 0xFu; }
#define XB_SPIN(cond, bar) do { unsigned _sp = 0; while (cond) { __builtin_amdgcn_s_sleep(1); \
    if ((++_sp & 255u) == 0u) { if (xb_ld(&(bar)[XB_TMO])) break; if (_sp > XB_SPIN_CAP) { atomicAdd(&(bar)[XB_TMO], 1u); break; } } } } while (0)

struct XcdBarrier {
    unsigned* bar; unsigned x;
    volatile LAS unsigned* st;
};

__device__ __forceinline__ XcdBarrier xcd_barrier_post(unsigned* bar, volatile LAS unsigned* st) {
    XcdBarrier b; b.bar = bar; b.x = xb_xcc_id(); b.st = st;
    if (threadIdx.x == 0) (void)xb_add(&bar[XB_XCNT(b.x)], 1u);
    return b;
}
__device__ __forceinline__ void xcd_barrier_complete(unsigned* bar, unsigned x, unsigned& nloc, unsigned& nx) {
    const unsigned G = gridDim.x * gridDim.y * gridDim.z;
    unsigned sum, cnt, mine, sp = 0u;
    for (;;) {
        sum = 0u; cnt = 0u; mine = 0u;
#pragma unroll
        for (unsigned j = 0; j < 16; ++j) { const unsigned c = xb_ld(&bar[XB_XCNT(j)]); sum += c; cnt += (c > 0u) ? 1u : 0u; mine = (j == x) ? c : mine; }
        if (sum == G) break;
        __builtin_amdgcn_s_sleep(1);
        if ((++sp & 255u) == 0u) { if (xb_ld(&bar[XB_TMO])) break; if (sp > XB_SPIN_CAP) { atomicAdd(&bar[XB_TMO], 1u); break; } }
    }
    nloc = mine > 0u ? mine : 1u; nx = cnt > 0u ? cnt : 1u;
}

__device__ __forceinline__ void xcd_barrier(const XcdBarrier& b) {
    asm volatile("s_waitcnt vmcnt(0)" ::: "memory");
    __syncthreads();
    if (threadIdx.x == 0) {
        unsigned* bar = b.bar;
        __builtin_amdgcn_s_waitcnt(0);
        unsigned nloc = b.st[0], nx = b.st[1];
        if (nloc == 0u) { xcd_barrier_complete(bar, b.x, nloc, nx); b.st[0] = nloc; b.st[1] = nx; }
        const unsigned old = xb_add(&bar[XB_XSUB(b.x)], 1u);
        const unsigned gen = old / nloc;
        if (old + 1u == (gen + 1u) * nloc) {
            __builtin_amdgcn_fence(__ATOMIC_RELEASE, "agent");
            asm volatile("s_waitcnt vmcnt(0)" ::: "memory");
            const unsigned og = xb_add(&bar[XB_TOP], 1u);
            const unsigned tg = og / nx;
            if (og + 1u == (tg + 1u) * nx) xb_add(&bar[XB_TOPGEN], 1u);
            else XB_SPIN(xb_ld(&bar[XB_TOPGEN]) == tg, bar);
            __builtin_amdgcn_fence(__ATOMIC_ACQUIRE, "agent");
            xb_add(&bar[XB_XGEN(b.x)], 1u);
            asm volatile("s_waitcnt vmcnt(0)" ::: "memory");
        } else {
            XB_SPIN(xb_ld(&bar[XB_XGEN(b.x)]) == gen, bar);
            __builtin_amdgcn_fence(__ATOMIC_ACQUIRE, "agent");
            asm volatile("s_waitcnt vmcnt(0)" ::: "memory");
        }
    }
    __syncthreads();
}

struct Frame {
    LAS unsigned char* lds;
    int tid, lane, wave, bid, G;
    const float* const* in; float* out; unsigned char* ws;
};
#define WSP(T_, off) ((T_*)(F.ws + (off)))

__device__ __forceinline__ void tr_item(const float* W, int ldw, int col0, int ncols, int K, bf16* WT, int drow, LAS float* scr, int k0, int n0, int lane) {
    const int kr = lane >> 4, c4 = lane & 15; const bool okc = (n0 + 4 * c4) < ncols;
    const float* src = W + (size_t)(k0 + kr) * ldw + col0 + n0 + 4 * c4;
    f32x4 v[16];
#pragma unroll
    for (int i = 0; i < 16; ++i) v[i] = okc ? *(const f32x4*)(src + (size_t)(4 * i) * ldw) : (f32x4){0.f, 0.f, 0.f, 0.f};
#pragma unroll
    for (int i = 0; i < 16; ++i) { const int k = 4 * i + kr; *(LAS f32x4*)(scr + k * 64 + 4 * (c4 ^ ((k >> 3) & 7))) = v[i]; }
    LDS_WAIT(); asm volatile("" ::: "memory");
    const int nl = lane >> 3, c = lane & 7;
#pragma unroll
    for (int j = 0; j < 8; ++j) { const int n = 8 * j + nl; const LAS float* s = scr + (8 * c) * 64 + 4 * ((n >> 2) ^ c) + (n & 3);
        v4u o; o.x = pk2(s[0 * 64], s[1 * 64]); o.y = pk2(s[2 * 64], s[3 * 64]); o.z = pk2(s[4 * 64], s[5 * 64]); o.w = pk2(s[6 * 64], s[7 * 64]);
        if (n0 + n < ncols) *(v4u*)(WT + (size_t)(drow + n) * K + k0 + 8 * c) = o; }
    LDS_WAIT(); asm volatile("" ::: "memory");
}
struct TrJob { const float* W; int ldw, col0, ncols, K; bf16* WT; int drow0, interleave; };
__device__ __forceinline__ int tr_job_items(const TrJob& j) { return (j.K / 64) * ((j.ncols + 63) / 64); }
__device__ __forceinline__ void tr_job_item(const TrJob& j, int item, LAS float* scr, int lane) {
    const int nblk = (j.ncols + 63) / 64, kb = item / nblk, nb = item % nblk, n0 = nb * 64;
    const int drow = j.interleave ? j.drow0 + (n0 >> 7) * 256 + (n0 & 127) : j.drow0 + n0;
    tr_item(j.W, j.ldw, j.col0, j.ncols, j.K, j.WT, drow, scr, kb * 64, n0, lane);
}
__device__ __forceinline__ void p0_prologue(Frame& F) {
    LAS float* scr = (LAS float*)(F.lds + F.wave * 16384);
    const int gw = F.bid * NWAVES + F.wave, NGW = F.G * NWAVES;
    { const f32x4* x4 = (const f32x4*)F.in[0]; v4u* o = WSP(v4u, A_XB); const int n8 = M * D / 8;
      for (int i = F.bid * NTHR + F.tid; i < n8; i += F.G * NTHR) { const f32x4 a = x4[2 * i], b = x4[2 * i + 1]; v4u w; w.x = pk2(a.x, a.y); w.y = pk2(a.z, a.w); w.z = pk2(b.x, b.y); w.w = pk2(b.z, b.w); o[i] = w; } }
    {
        bf16* WIN = WSP(bf16, WS_WIN); bf16* WOUT = WSP(bf16, WS_WOUT); bf16* WGLU = WSP(bf16, WS_WGLU); bf16* WO = WSP(bf16, WS_WO);
        const TrJob jobs[8] = {
            {F.in[1], INCOLS, 0, 4096, D, WIN, 0, 0}, {F.in[1], INCOLS, 4096, 48, D, WIN, 4096, 0}, {F.in[1], INCOLS, 4144, 768, D, WIN, 4352, 0}, {F.in[1], INCOLS, 4912, 2048, D, WIN, 5120, 0},
            {F.in[10], D, 0, D, SSD_IN, WOUT, 0, 0}, {F.in[22], D, 0, D, S5_W, WGLU, 0, 1}, {F.in[23], D, 0, D, S5_W, WGLU, 128, 1}, {F.in[24], D, 0, D, D, WO, 0, 0} };
        int base = 0;
#pragma unroll
        for (int q = 0; q < 8; ++q) { const int n = tr_job_items(jobs[q]);
            int it0 = (gw - base) % NGW; if (it0 < 0) it0 += NGW;
            for (int it = it0; it < n; it += NGW) tr_job_item(jobs[q], it, scr, F.lane);
            base += n; }
    }
    {
        bf16* W1 = WSP(bf16, WS_W1);
        constexpr int I13 = (D / 64) * (FF / 64);
        for (int it = gw; it < NE * 2 * I13; it += NGW) {
            const int e = it / (2 * I13); int r = it % (2 * I13);
            if (r < I13) { const TrJob j{F.in[28] + (size_t)e * D * FF, FF, 0, FF, D, W1 + (size_t)e * 2 * FF * D, 0, 1}; tr_job_item(j, r, scr, F.lane); }
            else { const TrJob j{F.in[29] + (size_t)e * D * FF, FF, 0, FF, D, W1 + (size_t)e * 2 * FF * D, 128, 1}; tr_job_item(j, r - I13, scr, F.lane); }
        }
    }
}
__device__ __forceinline__ void w2_convert(Frame& F, int gw, int ngw) {
    LAS float* scr = (LAS float*)(F.lds + F.wave * 16384);
    bf16* W2 = WSP(bf16, WS_W2);
    constexpr int I2 = (FF / 64) * (D / 64);
    for (int it = gw; it < NE * I2; it += ngw) { const int e = it / I2, r = it % I2;
        const TrJob j{F.in[30] + (size_t)e * FF * D, D, 0, D, FF, W2 + (size_t)e * D * FF, 0, 0}; tr_job_item(j, r, scr, F.lane); }
}

__device__ __forceinline__ void cmul(float ar, float ai, float br, float bi, float& cr, float& ci) { cr = ar * br - ai * bi; ci = ar * bi + ai * br; }
__device__ __forceinline__ void s5_precompute_item(Frame& F, int g, int tau) {
    LAS float* PQ = (LAS float*)(F.lds + 72 * 1024);
    LAS float* PW = PQ + 256;
    bf16* TV = WSP(bf16, WS_TV) + (size_t)g * 512 * 768; bf16* WM = WSP(bf16, WS_WS5) + (size_t)g * 256 * 512; float* AQ = WSP(float, WS_AQ);
    const int tid = F.tid;
    __syncthreads();
    if (tid < 128) {
        const int d = tid >> 6, p = tid & 63;
        const float are = (d ? F.in[14] : F.in[11])[g * 64 + p], aim = (d ? F.in[15] : F.in[12])[g * 64 + p], step = __expf((d ? F.in[16] : F.in[13])[g]);
        const float zr = are * step, zi = aim * step;
        const float er = expf(zr), cs = cosf(zi), sn = sinf(zi), abr = er * cs, abi = er * sn;
        const float sh = sinf(0.5f * zi), dr = expm1f(zr) * cs - 2.f * sh * sh, di = abi;
        const float den = 1.0f / (are * are + aim * aim), qr = (dr * are + di * aim) * den, qi = (di * are - dr * aim) * den;
        float pr = 1.f, pi = 0.f, br = abr, bi = abi;
#pragma unroll
        for (int bit = 0; bit < 6; ++bit) { if ((tau >> bit) & 1) { float tr_, ti_; cmul(pr, pi, br, bi, tr_, ti_); pr = tr_; pi = ti_; } float sr_, si_; cmul(br, bi, br, bi, sr_, si_); br = sr_; bi = si_; }
        float xr, xi; cmul(pr, pi, qr, qi, xr, xi);
        PQ[(d * 64 + p) * 2] = xr; PQ[(d * 64 + p) * 2 + 1] = xi; PW[(d * 64 + p) * 2] = pr; PW[(d * 64 + p) * 2 + 1] = pi;
        if (tau == 32) { AQ[((g * 2 + d) * 64 + p) * 2] = pr; AQ[((g * 2 + d) * 64 + p) * 2 + 1] = pi; }
    }
    __syncthreads();
    const float* cre = F.in[19] + (size_t)g * 16 * 64; const float* cim = F.in[20] + (size_t)g * 16 * 64;
    const float* bre = F.in[17] + (size_t)g * 64 * 16; const float* bim = F.in[18] + (size_t)g * 64 * 16;
    if (tid < 256 && tau < 32) {
        const int k = tid >> 4, j = tid & 15; float kf = 0.f, kb = 0.f;
        for (int p = 0; p < 64; ++p) { const float cr = cre[k * 64 + p], ci = cim[k * 64 + p], br = bre[p * 16 + j], bi = bim[p * 16 + j];
            float wr_, wi_; cmul(cr, ci, PQ[p * 2], PQ[p * 2 + 1], wr_, wi_); kf += wr_ * br - wi_ * bi;
            cmul(cr, ci, PQ[(64 + p) * 2], PQ[(64 + p) * 2 + 1], wr_, wi_); kb += wr_ * br - wi_ * bi; }
        if (tau == 0) { const bf16 v = (bf16)f2bf(kf + kb); for (int t = 0; t < 32; ++t) TV[(size_t)(t * 16 + k) * 768 + t * 16 + j] = v; }
        else { const bf16 vf = (bf16)f2bf(kf), vb = (bf16)f2bf(kb);
            for (int t = tau; t < 32; ++t) { const int s = t - tau; TV[(size_t)(t * 16 + k) * 768 + s * 16 + j] = vf; TV[(size_t)(s * 16 + k) * 768 + t * 16 + j] = vb; } }
    }
    if (tid >= 256) {
        const int q = tid - 256;
        if (tau >= 1) {
#pragma unroll 1
            for (int i = 0; i < 8; ++i) { const int e = q * 8 + i, d = e >> 10, k = (e >> 6) & 15, p = e & 63;
                float vr, vi; cmul(cre[k * 64 + p], cim[k * 64 + p], PW[(d * 64 + p) * 2], PW[(d * 64 + p) * 2 + 1], vr, vi);
                const int t = d ? 32 - tau : tau - 1; bf16* row = TV + (size_t)(t * 16 + k) * 768 + 512 + d * 128;
                row[p] = (bf16)f2bf(vr); row[64 + p] = (bf16)f2bf(-vi); } }
        if (tau < 32) {
#pragma unroll 1
            for (int i = 0; i < 8; ++i) { const int e = q * 8 + i, d = e >> 10, p = (e >> 4) & 63, j = e & 15;
                float vr, vi; cmul(PQ[(d * 64 + p) * 2], PQ[(d * 64 + p) * 2 + 1], bre[p * 16 + j], bim[p * 16 + j], vr, vi);
                const int s = d ? tau : 31 - tau; bf16* col = WM + (size_t)(d * 128 + p) * 512 + s * 16 + j;
                col[0] = (bf16)f2bf(vr); col[(size_t)64 * 512] = (bf16)f2bf(vi); } }
    }
}
__device__ __forceinline__ void p0_s5(Frame& F) { for (int it = F.bid; it < S5_G * 33; it += F.G) s5_precompute_item(F, it / 33, it % 33); }

__device__ __forceinline__ void s5_scan_item(Frame& F, int item) {
    const int d = item & 1, b = (item >> 1) & 1, g = item >> 2, tid = F.tid;
    LAS float* S = (LAS float*)F.lds;
    const float* SL = WSP(float, WS_SLOC) + ((size_t)(g * 512 + b * 256) * 256 + d * 128);
    __syncthreads();
    for (int i = tid; i < 256 * 32; i += NTHR) { const int ci = i >> 5, c4 = (i & 31) * 4; *(LAS f32x4*)(S + ci * 128 + c4) = *(const f32x4*)(SL + (size_t)ci * 256 + c4); }
    __syncthreads();
    if (tid < 64) {
        const float* AQ = WSP(float, WS_AQ); const float qr = AQ[((g * 2 + d) * 64 + tid) * 2], qi = AQ[((g * 2 + d) * 64 + tid) * 2 + 1];
        float sr = 0.f, si = 0.f;
        for (int n = 0; n < 256; ++n) { const int ci = d ? 255 - n : n;
            const float tr_ = S[ci * 128 + tid], ti_ = S[ci * 128 + 64 + tid];
            S[ci * 128 + tid] = sr; S[ci * 128 + 64 + tid] = si;
            const float nr = qr * sr - qi * si + tr_, ni = qr * si + qi * sr + ti_; sr = nr; si = ni; }
    }
    __syncthreads();
    bf16* UC = WSP(bf16, A_UC) + ((size_t)(g * 512 + b * 256) * 768 + 512 + d * 128);
    for (int i = tid; i < 256 * 16; i += NTHR) { const int ci = i >> 4, c8 = (i & 15) * 8; const LAS float* s = S + ci * 128 + c8;
        v4u o; o.x = pk2(s[0], s[1]); o.y = pk2(s[2], s[3]); o.z = pk2(s[4], s[5]); o.w = pk2(s[6], s[7]);
        *(v4u*)(UC + (size_t)ci * 768 + c8) = o; }
}

__device__ __forceinline__ void unpack8(const v4u w, float (&f)[8]) { f[0] = bflo(w.x); f[1] = bfhi(w.x); f[2] = bflo(w.y); f[3] = bfhi(w.y); f[4] = bflo(w.z); f[5] = bfhi(w.z); f[6] = bflo(w.w); f[7] = bfhi(w.w); }
__device__ __forceinline__ void p2_conv(Frame& F) {
    const bf16* xbc = WSP(bf16, A_XBC); bf16* XT = WSP(bf16, A_XT); bf16* BT = WSP(bf16, A_BT); bf16* BN = WSP(bf16, A_BN); bf16* CN = WSP(bf16, A_CN);
    const float* cw = F.in[2]; const float* cb = F.in[3];
    constexpr int RUN = 32, NCG = XBC / 8, NITEM = (M / RUN) * NCG;
    for (int item = F.bid * NTHR + F.tid; item < NITEM; item += F.G * NTHR) {
        const int cg = item % NCG, r = item / NCG, ch = cg * 8, m0 = r * RUN, tb = m0 % T, bc = m0 >> 7, s0 = m0 & 127;
        float w[5][8], bias[8];
#pragma unroll
        for (int k = 0; k < 5; ++k) { const f32x4 a = *(const f32x4*)(cw + k * XBC + ch), b = *(const f32x4*)(cw + k * XBC + ch + 4); w[k][0] = a.x; w[k][1] = a.y; w[k][2] = a.z; w[k][3] = a.w; w[k][4] = b.x; w[k][5] = b.y; w[k][6] = b.z; w[k][7] = b.w; }
        { const f32x4 a = *(const f32x4*)(cb + ch), b = *(const f32x4*)(cb + ch + 4); bias[0] = a.x; bias[1] = a.y; bias[2] = a.z; bias[3] = a.w; bias[4] = b.x; bias[5] = b.y; bias[6] = b.z; bias[7] = b.w; }
        bf16* nat = nullptr; bf16* trn = nullptr;
        if (ch < SSD_IN) { trn = XT + ((size_t)(bc * SSD_H + (ch >> 6)) * 64 + (ch & 63)) * 128 + s0; }
        else if (ch < SSD_IN + 512) { const int cc = ch - SSD_IN; nat = BN + (size_t)m0 * 512 + cc; trn = BT + ((size_t)(bc * SSD_G + (cc >> 7)) * 128 + (cc & 127)) * 128 + s0; }
        else { nat = CN + (size_t)m0 * 512 + (ch - SSD_IN - 512); }
        const v4u zero4 = {0u, 0u, 0u, 0u};
        v4u win[5];
        const bf16* src = xbc + (size_t)m0 * XBC + ch;
        win[0] = (tb - 2 >= 0) ? *(const v4u*)(src - 2 * XBC) : zero4;
        win[1] = (tb - 1 >= 0) ? *(const v4u*)(src - 1 * XBC) : zero4;
        win[2] = *(const v4u*)(src);
        win[3] = *(const v4u*)(src + XBC);
#pragma unroll 1
        for (int i8 = 0; i8 < RUN / 8; ++i8) {
            float o[8][8];
#pragma unroll
            for (int ii = 0; ii < 8; ++ii) { const int i = i8 * 8 + ii;
                win[4] = (tb + i + 2 < T) ? *(const v4u*)(src + (size_t)(i + 2) * XBC) : zero4;
#pragma unroll
                for (int j = 0; j < 8; ++j) o[ii][j] = bias[j];
#pragma unroll
                for (int k = 0; k < 5; ++k) { float f[8]; unpack8(win[k], f);
#pragma unroll
                    for (int j = 0; j < 8; ++j) o[ii][j] += w[k][j] * f[j]; }
#pragma unroll
                for (int j = 0; j < 8; ++j) o[ii][j] = o[ii][j] * __builtin_amdgcn_rcpf(1.0f + __expf(-o[ii][j]));
                if (nat) { v4u q; q.x = pk2(o[ii][0], o[ii][1]); q.y = pk2(o[ii][2], o[ii][3]); q.z = pk2(o[ii][4], o[ii][5]); q.w = pk2(o[ii][6], o[ii][7]); *(v4u*)(nat + (size_t)i * 512) = q; }
                win[0] = win[1]; win[1] = win[2]; win[2] = win[3]; win[3] = win[4]; }
            if (trn) {
#pragma unroll
                for (int j = 0; j < 8; ++j) { v4u q; q.x = pk2(o[0][j], o[1][j]); q.y = pk2(o[2][j], o[3][j]); q.z = pk2(o[4][j], o[5][j]); q.w = pk2(o[6][j], o[7][j]); *(v4u*)(trn + (size_t)j * 128 + i8 * 8) = q; } }
        }
    }
    {
        const int gw = F.bid * NWAVES + F.wave, NGW = F.G * NWAVES, lane = F.lane;
        const float* DT = WSP(float, A_DT); float* SV = WSP(float, A_SV); float* TOT = WSP(float, A_TOT);
        for (int it = gw; it < 128 * SSD_H * 2; it += NGW) {
            const int d = it & 1, h = (it >> 1) % SSD_H, bc = it / (2 * SSD_H);
            const float a = -__expf((d ? F.in[5] : F.in[4])[h]);
            const size_t mb = (size_t)bc * 128;
            const float dt0 = DT[(mb + 2 * lane) * 48 + d * 24 + h], dt1 = DT[(mb + 2 * lane + 1) * 48 + d * 24 + h];
            const float x0 = dt0 * a, x1 = dt1 * a, ps = x0 + x1;
            float inc = ps;
#pragma unroll
            for (int o = 1; o < 64; o <<= 1) { const float t_ = __shfl_up(inc, o); if (lane >= o) inc += t_; }
            const float total = __shfl(inc, 63), exc = inc - ps;
            const float ci0 = exc + x0, ci1 = inc;
            float cs0, cs1, w0, w1, f0, f1;
            if (d == 0) { cs0 = ci0; cs1 = ci1; w0 = dt0 * __expf(total - ci0); w1 = dt1 * __expf(total - ci1); f0 = __expf(ci0); f1 = __expf(ci1); }
            else { cs0 = exc; cs1 = ci0; w0 = dt0 * __expf(cs0); w1 = dt1 * __expf(cs1); f0 = __expf(total - cs0); f1 = __expf(total - cs1); }
            float* sv = SV + (size_t)it * 4 * 128 + 2 * lane;
            typedef float f32x2 __attribute__((ext_vector_type(2)));
            *(f32x2*)(sv) = (f32x2){w0, w1}; *(f32x2*)(sv + 128) = (f32x2){cs0, cs1}; *(f32x2*)(sv + 256) = (f32x2){dt0, dt1}; *(f32x2*)(sv + 384) = (f32x2){f0, f1};
            if (lane == 0) TOT[it] = __expf(total);
        }
    }
}

typedef short bf16x8 __attribute__((ext_vector_type(8)));
typedef float f32x16 __attribute__((ext_vector_type(16)));
__device__ __forceinline__ unsigned cvtpk(float lo, float hi) { return pg8::cvt_pk_bf16(lo, hi); }
__device__ __forceinline__ void ssd_state_item(Frame& F, int item) {
    const int nt = item & 3, u = item >> 2, h = u % SSD_H, bc = u / SSD_H, g = h / 6, b = bc >> 6, c = bc & 63, lane = F.lane, l31 = lane & 31, hf = lane >> 5;
    const bf16* XT = WSP(bf16, A_XT) + (size_t)u * 64 * 128; const bf16* BT = WSP(bf16, A_BT) + ((size_t)(bc * SSD_G + g) * 128 + nt * 32 + l31) * 128;
    const float* SV = WSP(float, A_SV); bf16* S = WSP(bf16, A_S);
    LAS float* wl = (LAS float*)(F.lds + F.wave * 1024);
    LDS_WAIT(); asm volatile("" ::: "memory");
#pragma unroll
    for (int d = 0; d < 2; ++d) { const float* sv = SV + (size_t)(u * 2 + d) * 4 * 128; wl[d * 128 + lane] = sv[lane]; wl[d * 128 + 64 + lane] = sv[64 + lane]; }
    LDS_WAIT(); asm volatile("" ::: "memory");
    f32x16 acc[2][2];
#pragma unroll
    for (int d = 0; d < 2; ++d)
#pragma unroll
        for (int pt = 0; pt < 2; ++pt)
#pragma unroll
            for (int r = 0; r < 16; ++r) acc[d][pt][r] = 0.f;
#pragma unroll
    for (int ks = 0; ks < 8; ++ks) {
        const int sb = ks * 16 + 8 * hf;
        const v4u a = *(const v4u*)(BT + sb);
        const bf16x8 b0 = *(const bf16x8*)(XT + (size_t)l31 * 128 + sb), b1 = *(const bf16x8*)(XT + (size_t)(32 + l31) * 128 + sb);
        float af[8]; unpack8(a, af);
#pragma unroll
        for (int d = 0; d < 2; ++d) {
            const f32x4 w0 = *(const LAS f32x4*)(wl + d * 128 + sb), w1 = *(const LAS f32x4*)(wl + d * 128 + sb + 4);
            v4u aw; aw.x = cvtpk(af[0] * w0.x, af[1] * w0.y); aw.y = cvtpk(af[2] * w0.z, af[3] * w0.w); aw.z = cvtpk(af[4] * w1.x, af[5] * w1.y); aw.w = cvtpk(af[6] * w1.z, af[7] * w1.w);
            const bf16x8 av = __builtin_bit_cast(bf16x8, aw);
            acc[d][0] = __builtin_amdgcn_mfma_f32_32x32x16_bf16(av, b0, acc[d][0], 0, 0, 0);
            acc[d][1] = __builtin_amdgcn_mfma_f32_32x32x16_bf16(av, b1, acc[d][1], 0, 0, 0);
        }
    }
#pragma unroll
    for (int d = 0; d < 2; ++d) { bf16* So = S + ((size_t)((b * SSD_H + h) * 2 + d) * 64 + c) * 8192;
#pragma unroll
        for (int pt = 0; pt < 2; ++pt)
#pragma unroll
            for (int q = 0; q < 4; ++q) { v2u o; o.x = cvtpk(acc[d][pt][4 * q], acc[d][pt][4 * q + 1]); o.y = cvtpk(acc[d][pt][4 * q + 2], acc[d][pt][4 * q + 3]);
                *(v2u*)(So + (size_t)(32 * pt + l31) * 128 + nt * 32 + 8 * q + 4 * hf) = o; } }
}
__device__ __forceinline__ void ssd_scan(Frame& F, int tg, int ntg) {
    bf16* S = WSP(bf16, A_S); const float* TOT = WSP(float, A_TOT);
    for (int item = tg; item < 96 * 1024; item += ntg) {
        const int e8 = item & 1023, bhd = item >> 10, d = bhd & 1, h = (bhd >> 1) % SSD_H, b = bhd / (2 * SSD_H);
        bf16* base = S + (size_t)bhd * 64 * 8192 + e8 * 8;
        float H[8];
#pragma unroll
        for (int j = 0; j < 8; ++j) H[j] = 0.f;
#pragma unroll 1
        for (int n0 = 0; n0 < 64; n0 += 8) {
            v4u v[8]; float dec[8];
#pragma unroll
            for (int k = 0; k < 8; ++k) { const int c = d ? 63 - (n0 + k) : n0 + k; v[k] = *(const v4u*)(base + (size_t)c * 8192); dec[k] = TOT[((b * 64 + c) * SSD_H + h) * 2 + d]; }
#pragma unroll
            for (int k = 0; k < 8; ++k) { const int c = d ? 63 - (n0 + k) : n0 + k; float f[8]; unpack8(v[k], f);
                v4u o; o.x = cvtpk(H[0], H[1]); o.y = cvtpk(H[2], H[3]); o.z = cvtpk(H[4], H[5]); o.w = cvtpk(H[6], H[7]);
                *(v4u*)(base + (size_t)c * 8192) = o;
#pragma unroll
                for (int j = 0; j < 8; ++j) H[j] = H[j] * dec[k] + f[j]; }
        }
    }
}
__device__ __forceinline__ void ssd_out_unit(Frame& F, int unit) {
    int lane = F.lane; asm volatile("" : "+v"(lane));
    const int g = unit & 3, bc = unit >> 2, b = bc >> 6, c = bc & 63, l31 = lane & 31, hf = lane >> 5, j = F.wave & 3, hh = F.wave >> 2;
    const size_t mb = (size_t)bc * 128;
    const bf16* CN = WSP(bf16, A_CN) + (mb + 32 * j + l31) * 512 + g * 128 + 8 * hf;
    const bf16* BN = WSP(bf16, A_BN) + (mb + l31) * 512 + g * 128 + 8 * hf;
    const float* SV = WSP(float, A_SV); const bf16* S = WSP(bf16, A_S); const bf16* XT = WSP(bf16, A_XT); bf16* Y = WSP(bf16, A_Y);
    LAS float* svl = (LAS float*)(F.lds + F.wave * 12288);
    asm volatile("" : "+v"(CN), "+v"(BN));
    LDS_WAIT(); asm volatile("" ::: "memory");
    {
        const f32x4* src = (const f32x4*)(SV + (size_t)((bc * SSD_H + g * 6 + hh * 3) * 2) * 512) + lane;
#pragma unroll
        for (int q = 0; q < 12; ++q) *(LAS f32x4*)(svl + (q * 64 + lane) * 4) = src[q * 64];
    }
    f32x16 cbt[4];
    {   bf16x8 cfr[8];
#pragma unroll
        for (int ks = 0; ks < 8; ++ks) cfr[ks] = *(const bf16x8*)(CN + ks * 16);
#pragma unroll
        for (int i = 0; i < 4; ++i) {
#pragma unroll
            for (int r = 0; r < 16; ++r) cbt[i][r] = 0.f;
#pragma unroll
            for (int ks = 0; ks < 8; ++ks) { const bf16x8 a = *(const bf16x8*)(BN + (size_t)(32 * i) * 512 + ks * 16); cbt[i] = __builtin_amdgcn_mfma_f32_32x32x16_bf16(a, cfr[ks], cbt[i], 0, 0, 0); }
            asm volatile("" ::: "memory");
        }
    }
    LDS_WAIT(); asm volatile("" ::: "memory");
    const int tl = 32 * j + l31;
#pragma unroll 1
    for (int i3 = 0; i3 < 3; ++i3) {
        const int h = g * 6 + hh * 3 + i3;
        const LAS float* vf = svl + (i3 * 2 + 0) * 512 + 128; const LAS float* vb = svl + (i3 * 2 + 1) * 512 + 128;
        const float csf_t = vf[tl], sf_t = vf[256 + tl], ecsb_t = vb[tl], sb_t = vb[256 + tl], Dh = F.in[8][h];
        int tlv = tl; asm volatile("" : "+v"(tlv));
        f32x16 acc[2];
        {
            const bf16* Hf = S + ((size_t)((b * SSD_H + h) * 2 + 0) * 64 + c) * 8192 + (size_t)l31 * 128 + 8 * hf; const bf16* Hb = Hf + (size_t)64 * 8192;
            const bf16* cn = CN; asm volatile("" : "+v"(Hf), "+v"(Hb), "+v"(cn));
            bf16x8 cfr[8];
#pragma unroll
            for (int ks = 0; ks < 8; ++ks) cfr[ks] = *(const bf16x8*)(cn + ks * 16);
#pragma unroll
            for (int pt = 0; pt < 2; ++pt) { f32x16 af;
#pragma unroll
                for (int r = 0; r < 16; ++r) af[r] = 0.f;
#pragma unroll
                for (int ks = 0; ks < 8; ++ks) { const bf16x8 a0 = *(const bf16x8*)(Hf + (size_t)(32 * pt) * 128 + ks * 16); af = __builtin_amdgcn_mfma_f32_32x32x16_bf16(a0, cfr[ks], af, 0, 0, 0); }
#pragma unroll
                for (int r = 0; r < 16; ++r) acc[pt][r] = af[r] * sf_t;
                asm volatile("" ::: "memory");
#pragma unroll
                for (int r = 0; r < 16; ++r) af[r] = 0.f;
#pragma unroll
                for (int ks = 0; ks < 8; ++ks) { const bf16x8 a1 = *(const bf16x8*)(Hb + (size_t)(32 * pt) * 128 + ks * 16); af = __builtin_amdgcn_mfma_f32_32x32x16_bf16(a1, cfr[ks], af, 0, 0, 0); }
#pragma unroll
                for (int r = 0; r < 16; ++r) acc[pt][r] += af[r] * sb_t;
                asm volatile("" ::: "memory"); }
        }
        const bf16* xt = XT + ((size_t)(bc * SSD_H + h) * 64 + l31) * 128 + 4 * hf;
        asm volatile("" : "+v"(xt));
#pragma unroll
        for (int i = 0; i < 4; ++i) {
#pragma unroll
            for (int k2 = 0; k2 < 2; ++k2) {
                const int sA = 32 * i + 16 * k2 + 4 * hf;
                float mv[8];
                if (i < j) {
                    const f32x4 c0 = *(const LAS f32x4*)(vf + sA), c1 = *(const LAS f32x4*)(vf + sA + 8), d0 = *(const LAS f32x4*)(vf + 128 + sA), d1 = *(const LAS f32x4*)(vf + 128 + sA + 8);
#pragma unroll
                    for (int e = 0; e < 4; ++e) { mv[e] = cbt[i][8 * k2 + e] * (d0[e] * __expf(fminf(csf_t - c0[e], 0.f))); mv[4 + e] = cbt[i][8 * k2 + 4 + e] * (d1[e] * __expf(fminf(csf_t - c1[e], 0.f))); }
                } else if (i > j) {
                    const f32x4 c0 = *(const LAS f32x4*)(vb + sA), c1 = *(const LAS f32x4*)(vb + sA + 8), d0 = *(const LAS f32x4*)(vb + 128 + sA), d1 = *(const LAS f32x4*)(vb + 128 + sA + 8);
#pragma unroll
                    for (int e = 0; e < 4; ++e) { mv[e] = cbt[i][8 * k2 + e] * (d0[e] * __expf(fminf(c0[e] - ecsb_t, 0.f))); mv[4 + e] = cbt[i][8 * k2 + 4 + e] * (d1[e] * __expf(fminf(c1[e] - ecsb_t, 0.f))); }
                } else {
                    const f32x4 c0 = *(const LAS f32x4*)(vf + sA), c1 = *(const LAS f32x4*)(vf + sA + 8), d0 = *(const LAS f32x4*)(vf + 128 + sA), d1 = *(const LAS f32x4*)(vf + 128 + sA + 8);
                    const f32x4 g0 = *(const LAS f32x4*)(vb + sA), g1 = *(const LAS f32x4*)(vb + sA + 8), h0 = *(const LAS f32x4*)(vb + 128 + sA), h1 = *(const LAS f32x4*)(vb + 128 + sA + 8);
#pragma unroll
                    for (int e = 0; e < 8; ++e) { const int s_ = sA + (e & 3) + 8 * (e >> 2); const float cf = e < 4 ? c0[e & 3] : c1[e & 3], df = e < 4 ? d0[e & 3] : d1[e & 3], cb_ = e < 4 ? g0[e & 3] : g1[e & 3], db = e < 4 ? h0[e & 3] : h1[e & 3];
                        float f = 0.f;
                        f += (s_ <= tlv) ? df * __expf(fminf(csf_t - cf, 0.f)) : 0.f;
                        f += (s_ >= tlv) ? db * __expf(fminf(cb_ - ecsb_t, 0.f)) : 0.f;
                        mv[e] = cbt[i][8 * k2 + e] * f + ((s_ == tlv) ? Dh : 0.f); }
                }
                v4u mw; mw.x = cvtpk(mv[0], mv[1]); mw.y = cvtpk(mv[2], mv[3]); mw.z = cvtpk(mv[4], mv[5]); mw.w = cvtpk(mv[6], mv[7]);
                const bf16x8 mfr = __builtin_bit_cast(bf16x8, mw);
#pragma unroll
                for (int pt = 0; pt < 2; ++pt) { const v2u x0 = *(const v2u*)(xt + (size_t)(32 * pt) * 128 + 32 * i + 16 * k2), x1 = *(const v2u*)(xt + (size_t)(32 * pt) * 128 + 32 * i + 16 * k2 + 8);
                    v4u xw; xw.x = x0.x; xw.y = x0.y; xw.z = x1.x; xw.w = x1.y;
                    acc[pt] = __builtin_amdgcn_mfma_f32_32x32x16_bf16(__builtin_bit_cast(bf16x8, xw), mfr, acc[pt], 0, 0, 0); }
                asm volatile("" ::: "memory");
            }
        }
        bf16* yo = Y + (mb + tl) * SSD_IN + h * 64 + 4 * hf;
        asm volatile("" : "+v"(yo));
#pragma unroll
        for (int pt = 0; pt < 2; ++pt)
#pragma unroll
            for (int q = 0; q < 4; ++q) { v2u o; o.x = cvtpk(acc[pt][4 * q], acc[pt][4 * q + 1]); o.y = cvtpk(acc[pt][4 * q + 2], acc[pt][4 * q + 3]); *(v2u*)(yo + 32 * pt + 8 * q) = o; }
    }
}

__device__ __forceinline__ void p4_combine(Frame& F) {
    const int gw = F.bid * NWAVES + F.wave, NGW = F.G * NWAVES, lane = F.lane;
    bf16* Y = WSP(bf16, A_Y); const bf16* Z = WSP(bf16, A_Z); const float* ng = F.in[9];
    for (int m = gw; m < M; m += NGW) {
#pragma unroll 1
        for (int gi = 0; gi < SSD_G; ++gi) {
            const int ch = gi * 384 + lane * 8; float y[8]; float ss = 0.f;
            if (lane < 48) { const size_t o = (size_t)m * SSD_IN + ch; float a[8], z[8]; unpack8(*(const v4u*)(Y + o), a); unpack8(*(const v4u*)(Z + o), z);
#pragma unroll
                for (int jj = 0; jj < 8; ++jj) { y[jj] = a[jj] * z[jj]; ss += y[jj] * y[jj]; } }
            ss = wave_sum(ss);
            const float r = 1.0f / sqrtf(ss * (1.0f / 384.0f) + RMS_EPS);
            if (lane < 48) { const f32x4 g0 = *(const f32x4*)(ng + ch), g1 = *(const f32x4*)(ng + ch + 4);
                v4u o; o.x = pk2(y[0] * r * g0.x, y[1] * r * g0.y); o.y = pk2(y[2] * r * g0.z, y[3] * r * g0.w); o.z = pk2(y[4] * r * g1.x, y[5] * r * g1.y); o.w = pk2(y[6] * r * g1.z, y[7] * r * g1.w);
                *(v4u*)(Y + (size_t)m * SSD_IN + ch) = o; }
        }
    }
}

__device__ __forceinline__ void p8_ln_router(Frame& F) {
    const int gw = F.bid * NWAVES + F.wave, NGW = F.G * NWAVES, lane = F.lane;
    LAS float* wr = (LAS float*)F.lds;
    for (int i = F.tid; i < D * NE; i += NTHR) wr[(i & 15) * D + (i >> 4)] = F.in[27][i];
    __syncthreads();
    const float* HP = WSP(float, A_HP); float* H = WSP(float, A_H); bf16* HB = WSP(bf16, A_HB); float* AFF = WSP(float, A_AFF);
    const float* g1 = F.in[25]; const float* b1 = F.in[26];
    for (int m = gw; m < M; m += NGW) {
        const f32x4* xr = (const f32x4*)(HP + (size_t)m * D) + lane;
        f32x4 v[4]; float s = 0.f;
#pragma unroll
        for (int j = 0; j < 4; ++j) { v[j] = xr[64 * j]; s += (v[j].x + v[j].y) + (v[j].z + v[j].w); }
        const float mean = wave_sum(s) * (1.f / D); float s2 = 0.f;
#pragma unroll
        for (int j = 0; j < 4; ++j) { v[j] = v[j] - mean; s2 += (v[j].x * v[j].x + v[j].y * v[j].y) + (v[j].z * v[j].z + v[j].w * v[j].w); }
        const float rstd = 1.f / sqrtf(wave_sum(s2) * (1.f / D) + LN_EPS);
        float lg[16];
#pragma unroll
        for (int e = 0; e < 16; ++e) lg[e] = 0.f;
#pragma unroll
        for (int j = 0; j < 4; ++j) { const int c = 4 * lane + 256 * j; const f32x4 gg = *(const f32x4*)(g1 + c), bb = *(const f32x4*)(b1 + c);
            v[j] = v[j] * rstd * gg + bb;
            *((f32x4*)(H + (size_t)m * D) + lane + 64 * j) = v[j];
            v2u hb; hb.x = pk2(v[j].x, v[j].y); hb.y = pk2(v[j].z, v[j].w); *((v2u*)(HB + (size_t)m * D) + lane + 64 * j) = hb;
#pragma unroll
            for (int e = 0; e < 16; ++e) { const f32x4 w4 = *(const LAS f32x4*)(wr + e * D + c); lg[e] += (v[j].x * w4.x + v[j].y * w4.y) + (v[j].z * w4.z + v[j].w * w4.w); }
            asm volatile("" ::: "memory"); }
        { const bool hi = lane & 32;
#pragma unroll
          for (int k = 0; k < 8; ++k) { const float keep = hi ? lg[k + 8] : lg[k], send = hi ? lg[k] : lg[k + 8]; lg[k] = keep + __shfl_xor(send, 32); } }
        { const bool hi = lane & 16;
#pragma unroll
          for (int k = 0; k < 4; ++k) { const float keep = hi ? lg[k + 4] : lg[k], send = hi ? lg[k] : lg[k + 4]; lg[k] = keep + __shfl_xor(send, 16); } }
        { const bool hi = lane & 8;
#pragma unroll
          for (int k = 0; k < 2; ++k) { const float keep = hi ? lg[k + 2] : lg[k], send = hi ? lg[k] : lg[k + 2]; lg[k] = keep + __shfl_xor(send, 8); } }
        { const bool hi = lane & 4; const float keep = hi ? lg[1] : lg[0], send = hi ? lg[0] : lg[1]; lg[0] = keep + __shfl_xor(send, 4); }
        float lo = lg[0]; lo += __shfl_xor(lo, 2); lo += __shfl_xor(lo, 1);
        float mx = lo;
#pragma unroll
        for (int o = 4; o < 64; o <<= 1) mx = fmaxf(mx, __shfl_xor(mx, o));
        const float ex = expf(lo - mx); float sum = ex;
#pragma unroll
        for (int o = 4; o < 64; o <<= 1) sum += __shfl_xor(sum, o);
        if ((lane & 3) == 0) { const int e = lane >> 2, b = m / T, t = m % T; AFF[((size_t)b * NE + e) * T + t] = ex / sum; }
    }
}

__device__ __forceinline__ unsigned block_excl_scan(unsigned v, LAS unsigned* wsum  , int lane, int wave, unsigned& total) {
    unsigned inc = v;
#pragma unroll
    for (int o = 1; o < 64; o <<= 1) { const unsigned t = __shfl_up(inc, o); if (lane >= o) inc += t; }
    __syncthreads();
    if (lane == 63) wsum[wave] = inc;
    __syncthreads();
    unsigned off = 0, tot = 0;
#pragma unroll
    for (int w = 0; w < 8; ++w) { const unsigned s = wsum[w]; if (w < wave) off += s; tot += s; }
    total = tot; return off + inc - v;
}
__device__ __forceinline__ void p9_topk(Frame& F, int be) {
    const int b = be >> 4, e = be & 15, tid = F.tid;
    const float* av = WSP(float, A_AFF) + (size_t)be * T;
    int* IDX = WSP(int, A_IDX); int* SEL = WSP(int, A_SEL); float* GATE = WSP(float, A_GATE);
    LAS unsigned* hist = (LAS unsigned*)F.lds; LAS unsigned* shv = hist + 256; LAS unsigned* wsum = hist + 272;
    unsigned key[16];
#pragma unroll
    for (int q = 0; q < 4; ++q) { const v4u k4 = *(const v4u*)(av + tid * 16 + 4 * q); key[4 * q] = k4.x; key[4 * q + 1] = k4.y; key[4 * q + 2] = k4.z; key[4 * q + 3] = k4.w; }
    unsigned prefix = 0, pmask = 0, krem = CAP;
    for (int pass = 0; pass < 4; ++pass) {
        const int shift = 24 - 8 * pass;
        if (tid < 256) hist[tid] = 0u;
        __syncthreads();
#pragma unroll
        for (int i = 0; i < 16; ++i) if ((key[i] & pmask) == prefix) (void)__hip_atomic_fetch_add(&hist[(key[i] >> shift) & 255u], 1u, __ATOMIC_RELAXED, __HIP_MEMORY_SCOPE_WORKGROUP);
        __syncthreads();
        if (tid < 256) { unsigned above = 0; for (int d = tid + 1; d < 256; ++d) above += hist[d]; const unsigned mine = hist[tid];
            if (above < krem && krem <= above + mine) { shv[0] = (unsigned)tid; shv[1] = krem - above; } }
        __syncthreads();
        prefix |= shv[0] << shift; pmask |= 255u << shift; krem = shv[1];
        __syncthreads();
    }
    const unsigned Tk = prefix;
    unsigned cg = 0, ce = 0;
#pragma unroll
    for (int i = 0; i < 16; ++i) { cg += key[i] > Tk; ce += key[i] == Tk; }
    unsigned totg, tote;
    unsigned pg = block_excl_scan(cg, wsum, F.lane, F.wave, totg);
    unsigned pe = block_excl_scan(ce, wsum + 8, F.lane, F.wave, tote);
#pragma unroll
    for (int i = 0; i < 16; ++i) {
        const int t = tid * 16 + i; int slot = -1;
        if (key[i] > Tk) slot = (int)(pg++);
        else if (key[i] == Tk) { if (pe < krem) slot = (int)(totg + pe); ++pe; }
        const size_t m = (size_t)b * T + t;
        SEL[m * NE + e] = slot; GATE[m * NE + e] = __uint_as_float(key[i]);
        if (slot >= 0) IDX[(e * NB + b) * CAP + slot] = (int)m;
    }
}
__device__ __forceinline__ void p10_gather(Frame& F) {
    const int gw = F.bid * NWAVES + F.wave, NGW = F.G * NWAVES, lane = F.lane;
    const int* IDX = WSP(int, A_IDX); const bf16* HB = WSP(bf16, A_HB); bf16* XIN = WSP(bf16, A_XIN);
    for (int r = gw; r < MROWS; r += NGW) { const int m = IDX[r];
        const v4u* s = (const v4u*)(HB + (size_t)m * D); v4u* d = (v4u*)(XIN + (size_t)r * D);
        const v4u a = s[lane], bq = s[lane + 64]; d[lane] = a; d[lane + 64] = bq; }
}
__device__ __forceinline__ void p13_final(Frame& F) {
    const int gw = F.bid * NWAVES + F.wave, NGW = F.G * NWAVES, lane = F.lane;
    const float* H = WSP(float, A_H); const int* SEL = WSP(int, A_SEL); const float* GATE = WSP(float, A_GATE); const bf16* YE = WSP(bf16, A_YE);
    const float* g2 = F.in[31]; const float* b2 = F.in[32];
    for (int m = gw; m < M; m += NGW) {
        const int b = m / T;
        const int sl = SEL[(size_t)m * NE + (lane & 15)]; const float gt = GATE[(size_t)m * NE + (lane & 15)];
        f32x4 v[4];
#pragma unroll
        for (int j = 0; j < 4; ++j) v[j] = *((const f32x4*)(H + (size_t)m * D) + lane + 64 * j) * ALPHA;
#pragma unroll 1
        for (int e = 0; e < NE; ++e) {
            const int s = __shfl(sl, e); const float gv = __shfl(gt, e);
            if (s >= 0) { const bf16* yr = YE + ((size_t)(e * NB + b) * CAP + s) * D;
#pragma unroll
                for (int j = 0; j < 4; ++j) { const v2u w = *((const v2u*)yr + lane + 64 * j); v[j].x += gv * bflo(w.x); v[j].y += gv * bfhi(w.x); v[j].z += gv * bflo(w.y); v[j].w += gv * bfhi(w.y); } }
        }
        float s = 0.f;
#pragma unroll
        for (int j = 0; j < 4; ++j) s += (v[j].x + v[j].y) + (v[j].z + v[j].w);
        const float mean = wave_sum(s) * (1.f / D); float s2 = 0.f;
#pragma unroll
        for (int j = 0; j < 4; ++j) { v[j] = v[j] - mean; s2 += (v[j].x * v[j].x + v[j].y * v[j].y) + (v[j].z * v[j].z + v[j].w * v[j].w); }
        const float rstd = 1.f / sqrtf(wave_sum(s2) * (1.f / D) + LN_EPS);
#pragma unroll
        for (int j = 0; j < 4; ++j) { const int c = 4 * lane + 256 * j; const f32x4 gg = *(const f32x4*)(g2 + c), bb = *(const f32x4*)(b2 + c);
            *((f32x4*)(F.out + (size_t)m * D) + lane + 64 * j) = v[j] * rstd * gg + bb; }
    }
}

constexpr int N_PHASES = 16;
struct Args { const float* in[33]; float* out; unsigned char* ws; int ph_lo, ph_hi; };
__global__ void __launch_bounds__(NTHR, 2) fwd(Args args) {
    extern __shared__ __attribute__((aligned(16))) unsigned char lds[];
    Frame F;
    F.lds = (LAS unsigned char*)lds;
    F.tid = threadIdx.x; F.lane = F.tid & 63; F.wave = __builtin_amdgcn_readfirstlane(F.tid >> 6);
    F.bid = blockIdx.x; F.G = gridDim.x;
    F.in = args.in;
    F.out = args.out; F.ws = args.ws;
    volatile LAS unsigned* MISC = (volatile LAS unsigned*)(F.lds + MISC_OFF);
    if (F.tid < 64) MISC[F.tid] = 0u;
    __syncthreads();
    const int lo = args.ph_lo, hi = args.ph_hi;
    const bool single = (hi - lo) > 1;
    XcdBarrier bar; bar.bar = (unsigned*)(F.ws + WS_CTL) + CW_BAR; bar.x = 0; bar.st = nullptr;
    if (single) bar = xcd_barrier_post((unsigned*)(F.ws + WS_CTL) + CW_BAR, MISC + 8);
#ifndef PH_MASK
#define PH_MASK 0xffff
#endif
#define IN(k) (((PH_MASK >> (k)) & 1) && lo <= (k) && (k) < hi)
#define LAUNDER1(T_, p_) do { unsigned long long x_ = (unsigned long long)(p_); unsigned lo_ = (unsigned)x_, hi_ = (unsigned)(x_ >> 32); asm volatile("" : "+v"(lo_), "+v"(hi_)); \
        lo_ = __builtin_amdgcn_readfirstlane(lo_); hi_ = __builtin_amdgcn_readfirstlane(hi_); (p_) = (T_)(((unsigned long long)hi_ << 32) | lo_); } while (0)
#define LAUNDER() do { } while (0)
#define SEAM(k) do { if (IN(k) && IN((k) + 1)) xcd_barrier(bar); } while (0)

    if (IN(0)) { LAUNDER(); p0_prologue(F); p0_s5(F); } SEAM(0);
    if (IN(1)) { LAUNDER();
        pg8::Gemm g{WSP(pg8::bf16_t, A_XB), WSP(pg8::bf16_t, WS_WIN), M, NIN_PAD, D, D, D}; pg8::StaticOrder S; S.init(M, NIN_PAD, F.G, F.bid);
        pg8::EpiIn E{WSP(pg8::bf16_t, A_Z), WSP(pg8::bf16_t, A_XBC), WSP(pg8::bf16_t, A_UC), WSP(pg8::bf16_t, A_GT), WSP(float, A_DT), F.in[6], F.in[7]};
        pg8::gemm_phase<pg8::EpiIn, pg8::StaticOrder, PG8_ALIGN, PG8_SP2>(F.lds, g, S, E);
    } SEAM(1);
    if (IN(2)) { LAUNDER();
        if (F.bid >= 160) { pg8::Gemm g{WSP(pg8::bf16_t, A_UC), WSP(pg8::bf16_t, WS_WS5), S5_G * 512, S5_G * 256, 512, 768, 512}; pg8::S5aOrder S{F.bid, 160};
            pg8::EpiS5a E{WSP(float, WS_SLOC)};
            pg8::gemm_phase<pg8::EpiS5a, pg8::S5aOrder, PG8_ALIGN, PG8_SP2>(F.lds, g, S, E); __syncthreads(); }
        p2_conv(F);
    } SEAM(2);
    if (IN(3)) { LAUNDER();
        for (int it = F.bid; it < S5_G * 4; it += F.G) s5_scan_item(F, it);
        __syncthreads();
        for (int it = F.bid * NWAVES + F.wave; it < 128 * SSD_H * 4; it += F.G * NWAVES) ssd_state_item(F, it);
    } SEAM(3);
    if (IN(4)) { LAUNDER();
        { pg8::Gemm g{WSP(pg8::bf16_t, A_UC), WSP(pg8::bf16_t, WS_TV), S5_G * 512, S5_G * 512, 768, 768, 768}; pg8::S5cOrder S{F.G, F.bid};
          pg8::EpiS5c E{WSP(pg8::bf16_t, A_GY), WSP(pg8::bf16_t, A_UC), F.in[21]};
          pg8::gemm_phase<pg8::EpiS5c, pg8::S5cOrder, PG8_ALIGN, PG8_SP2>(F.lds, g, S, E); }
        ssd_scan(F, F.bid * NTHR + F.tid, F.G * NTHR);
    } SEAM(4);
    if (IN(5)) { LAUNDER(); __syncthreads(); for (int u = F.bid; u < 128 * SSD_G; u += F.G) ssd_out_unit(F, u); } SEAM(5);
    if (IN(6)) { LAUNDER(); p4_combine(F); } SEAM(6);
    if (IN(7)) { LAUNDER();
        pg8::Gemm g{WSP(pg8::bf16_t, A_Y), WSP(pg8::bf16_t, WS_WOUT), M, D, SSD_IN, SSD_IN, SSD_IN}; pg8::StaticOrder S; S.init(M, D, F.G, F.bid);
        pg8::EpiSsdOut E{WSP(float, A_YA), WSP(pg8::bf16_t, A_GT)};
        pg8::gemm_phase<pg8::EpiSsdOut, pg8::StaticOrder, PG8_ALIGN, PG8_SP2>(F.lds, g, S, E);
    } SEAM(7);
    if (IN(8)) { LAUNDER();
        pg8::Gemm g{WSP(pg8::bf16_t, A_GY), WSP(pg8::bf16_t, WS_WGLU), M, 2 * D, S5_W, S5_W, S5_W}; pg8::StaticOrder S; S.init(M, 2 * D, F.G, F.bid);
        pg8::EpiGlu E{WSP(pg8::bf16_t, A_MIX), WSP(float, A_YA), WSP(pg8::bf16_t, A_GT)};
        pg8::gemm_phase<pg8::EpiGlu, pg8::StaticOrder, PG8_ALIGN, PG8_SP2>(F.lds, g, S, E);
    } SEAM(8);
    if (IN(9)) { LAUNDER();
        pg8::Gemm g{WSP(pg8::bf16_t, A_MIX), WSP(pg8::bf16_t, WS_WO), M, D, D, D, D}; pg8::StaticOrder S; S.init(M, D, F.G, F.bid);
        pg8::EpiWo E{WSP(float, A_HP), F.in[0], ALPHA};
        pg8::gemm_phase<pg8::EpiWo, pg8::StaticOrder, PG8_ALIGN, PG8_SP2>(F.lds, g, S, E);
    } SEAM(9);
    if (IN(10)) { LAUNDER(); p8_ln_router(F); } SEAM(10);
    if (IN(11)) { LAUNDER(); if (F.bid < NB * NE) p9_topk(F, F.bid); else w2_convert(F, (F.bid - NB * NE) * NWAVES + F.wave, (F.G - NB * NE) * NWAVES); } SEAM(11);
    if (IN(12)) { LAUNDER(); p10_gather(F); } SEAM(12);
    if (IN(13)) { LAUNDER();
        pg8::Gemm g{WSP(pg8::bf16_t, A_XIN), WSP(pg8::bf16_t, WS_W1), MROWS, NE * 2 * FF, D, D, D}; pg8::MoeOrder1 S{F.G, F.bid};
        pg8::EpiMoe1 E{WSP(pg8::bf16_t, A_HID)};
        pg8::gemm_phase<pg8::EpiMoe1, pg8::MoeOrder1, PG8_ALIGN, PG8_SP2>(F.lds, g, S, E);
    } SEAM(13);
    if (IN(14)) { LAUNDER();
        pg8::Gemm g{WSP(pg8::bf16_t, A_HID), WSP(pg8::bf16_t, WS_W2), MROWS, NE * D, FF, FF, FF}; pg8::MoeOrder2 S{F.G, F.bid};
        pg8::EpiMoe2 E{WSP(pg8::bf16_t, A_YE)};
        pg8::gemm_phase<pg8::EpiMoe2, pg8::MoeOrder2, PG8_ALIGN, PG8_SP2>(F.lds, g, S, E);
    } SEAM(14);
    if (IN(15)) { LAUNDER(); p13_final(F); }
#undef IN
#undef SEAM
}

#ifndef MK_ONE_LAUNCH
#define MK_ONE_LAUNCH 1
#endif
extern "C" void kernel_launch(void* const* d_in, const int* in_sizes, int n_in, void* d_out, int out_size, void* d_ws, size_t ws_size, hipStream_t stream) {
    static int grid = 0;
    if (grid == 0) {
        if (n_in != 33 || in_sizes[0] != M * D || out_size != M * D || ws_size < WS_END) { fprintf(stderr, "kernel_launch: unexpected problem (n_in %d, in0 %d, out %d, ws %zu < %zu)\n", n_in, n_in > 0 ? in_sizes[0] : -1, out_size, ws_size, (size_t)WS_END); grid = -1; return; }
        int dev = 0, cus = 0, per_cu = 0;
        if (hipGetDevice(&dev) != hipSuccess || hipDeviceGetAttribute(&cus, hipDeviceAttributeMultiprocessorCount, dev) != hipSuccess) { grid = -1; return; }
        if (hipFuncSetAttribute((const void*)fwd, hipFuncAttributeMaxDynamicSharedMemorySize, LDS_BYTES) != hipSuccess) { fprintf(stderr, "kernel_launch: hipFuncSetAttribute failed\n"); grid = -1; return; }
        if (hipOccupancyMaxActiveBlocksPerMultiprocessor(&per_cu, (const void*)fwd, NTHR, LDS_BYTES) != hipSuccess || per_cu < 1) fprintf(stderr, "kernel_launch: occupancy query reports %d blocks per CU\n", per_cu);
        (void)hipGetLastError();
        grid = cus;
    }
    if (grid < 0) return;
    (void)hipMemsetAsync((char*)d_ws + WS_CTL, 0, CTL_ZERO_BYTES, stream);
    Args a{};
    for (int i = 0; i < 33; ++i) a.in[i] = (const float*)d_in[i];
    a.out = (float*)d_out; a.ws = (unsigned char*)d_ws;
#if MK_ONE_LAUNCH
    a.ph_lo = 0; a.ph_hi = N_PHASES;
    hipLaunchKernelGGL(fwd, dim3(grid), dim3(NTHR), LDS_BYTES, stream, a);
#else
    for (int p = 0; p < N_PHASES; ++p) { a.ph_lo = p; a.ph_hi = p + 1; hipLaunchKernelGGL(fwd, dim3(grid), dim3(NTHR), LDS_BYTES, stream, a); }
#endif
}
```

```cpp
#include <hip/hip_runtime.h>
#include <cstdio>
#include <cstdint>
namespace pg8 {
#define PG8_LAS __attribute__((address_space(3)))
typedef unsigned short bf16_t;
typedef short bf16x8 __attribute__((ext_vector_type(8)));
typedef float f32x4 __attribute__((ext_vector_type(4)));
typedef unsigned u32x4 __attribute__((ext_vector_type(4)));
constexpr int BM = 256, BK = 64, HALF = 128, HTB = HALF * BK * 2  , STAGE_BYTES = 8 * HTB, NXCD = 8, WGM = 8;

__host__ __device__ __forceinline__ int lds_byte(int r, int c) { const int st = (r >> 4) * 2 + (c >> 5), rr = r & 15, cc = c & 31, ob = rr * 64 + cc * 2; return st * 1024 + (ob ^ (((ob >> 9) & 1) << 5)); }
__host__ __device__ __forceinline__ void stage_rc(int b, int& R, int& C) { const int st = b / 1024, sb = b % 1024, swz = sb ^ (((sb >> 9) & 1) << 5); R = (st >> 1) * 16 + swz / 64; C = (st & 1) * 32 + (swz % 64) / 2; }
__host__ __device__ __forceinline__ int perm32(int rho) { const int n = rho >> 4, i = rho & 15; return 8 * (i >> 2) + 4 * n + (i & 3); }

struct Unit { int pm, pn; };
struct Gemm { const bf16_t* A; const bf16_t* Bt; int M, N, K, lda, ldb; };

struct StaticOrder {
    int nM, nN, nwg, G, c;
    __host__ __device__ void init(int M, int N, int G_, int c_) { nM = M / BM; nN = N / BM; nwg = nM * nN; G = G_; c = c_; }
    __host__ __device__ bool next(int i, Unit& u) const {
        const long L = (long)i * G + c; if (L >= nwg) return false;
        int wgid = (int)L; { const int q = nwg / NXCD, r = nwg % NXCD, xcd = wgid % NXCD, off = wgid / NXCD; wgid = (xcd < r ? xcd * (q + 1) : r * (q + 1) + (xcd - r) * q) + off; }
        const int nig = WGM * nN, gid = wgid / nig, fm = gid * WGM, gsz = (nM - fm) < WGM ? (nM - fm) : WGM;
        u.pm = fm + ((wgid % nig) % gsz); u.pn = (wgid % nig) / gsz; return true;
    }
    __device__ __forceinline__ void a_ready(const Unit&) const {}
    __device__ __forceinline__ void done(const Unit&) const {}
};

typedef __bf16 bf16v2_t __attribute__((ext_vector_type(2)));
typedef float f32v2_t __attribute__((ext_vector_type(2)));
__device__ __forceinline__ unsigned cvt_pk_bf16(float lo, float hi) { const f32v2_t f = {lo, hi}; return __builtin_bit_cast(unsigned, __builtin_convertvector(f, bf16v2_t)); }
typedef float f32x2 __attribute__((ext_vector_type(2)));
__device__ __forceinline__ f32x2 gelu_pk(f32x2 v) {
    const f32x2 av = __builtin_elementwise_abs(v), d = av * 0.2316418882f + 1.0f;
    f32x2 t; t.x = __builtin_amdgcn_rcpf(d.x); t.y = __builtin_amdgcn_rcpf(d.y);
    f32x2 q = t * 0.5307027145f + (-0.7265760135f); q = q * t + 0.7107068705f; q = q * t + (-0.142248368f); q = q * t + 0.127414796f; q = q * t;
    const f32x2 s = (v * v) * (-0.72134752044f);
    f32x2 e; e.x = __builtin_amdgcn_exp2f(s.x); e.y = __builtin_amdgcn_exp2f(s.y);
    const f32x2 m = v * (q * e), r = v - m;
    f32x2 o; o.x = v.x < 0.f ? m.x : r.x; o.y = v.y < 0.f ? m.y : r.y; return o;
}


__device__ __forceinline__ float fsigmoid(float x) { return __builtin_amdgcn_rcpf(1.0f + __expf(-x)); }
__device__ __forceinline__ float fsilu(float x) { return x * fsigmoid(x); }
__device__ __forceinline__ float bf_lo(unsigned w) { return __uint_as_float(w << 16); }
__device__ __forceinline__ float bf_hi(unsigned w) { return __uint_as_float(w & 0xffff0000u); }
typedef unsigned u32x2 __attribute__((ext_vector_type(2)));

struct EpiIn {
    static constexpr bool PERM = true, AFTER_DRAIN = false;
    bf16_t *Z, *XBC, *UC, *GT; float* DT; const float *dtb_f, *dtb_b;
    __device__ __forceinline__ void operator()(const f32x4 (&acc)[2][2][4][2], const Unit& u, int wr, int wc, int fr, int fq) const {
        const int row0 = u.pm * BM + wr * 64 + fr; const int pn = u.pn;
        if (pn == 16) {
            if (wc < 2) {
#pragma unroll
                for (int n = 0; n < 2; ++n) { const int col = wc * 32 + 8 * fq + 4 * n;
                    if (col < 48) { f32x4 bv;
#pragma unroll
                        for (int j = 0; j < 4; ++j) { const int cc = col + j; bv[j] = cc < 24 ? dtb_f[cc] : dtb_b[cc - 24]; }
#pragma unroll
                        for (int ai = 0; ai < 2; ++ai)
#pragma unroll
                            for (int m = 0; m < 4; ++m) { f32x4 v = acc[ai][0][m][n] + bv;
#pragma unroll
                                for (int j = 0; j < 4; ++j) { const float x = v[j]; v[j] = fmaxf(x, 0.f) + log1pf(__expf(-fabsf(x))); }
                                *(f32x4*)(DT + (size_t)(row0 + ai * HALF + m * 16) * 48 + col) = v; } } }
            }
            return;
        }
        int mode, ldc, colt; bf16_t* base;
        if (pn < 6) { mode = 1; base = Z; ldc = 1536; colt = pn * BM; }
        else if (pn < 16) { mode = 0; base = XBC; ldc = 2560; colt = (pn - 6) * BM; }
        else if (pn < 20) {
            const int uc = (pn - 17) * BM + wc * 32 + 8 * fq, g0 = uc >> 4, j0 = uc & 15;
#pragma unroll
            for (int ai = 0; ai < 2; ++ai)
#pragma unroll
                for (int m = 0; m < 4; ++m) { const int r = row0 + ai * HALF + m * 16, cl = r >> 5, s = r & 31;
#pragma unroll
                    for (int bj = 0; bj < 2; ++bj) { const f32x4 v0 = acc[ai][bj][m][0], v1 = acc[ai][bj][m][1];
                        u32x4 w; w.x = cvt_pk_bf16(v0[0], v0[1]); w.y = cvt_pk_bf16(v0[2], v0[3]); w.z = cvt_pk_bf16(v1[0], v1[1]); w.w = cvt_pk_bf16(v1[2], v1[3]);
                        *(u32x4*)(UC + ((size_t)((g0 + 8 * bj) * 512 + cl) * 768 + s * 16 + j0)) = w; } }
            return; }
        else { mode = 2; base = GT; ldc = 2048; colt = (pn - 20) * BM; }
        const int col0 = colt + wc * 32 + 8 * fq;
#pragma unroll
        for (int ai = 0; ai < 2; ++ai)
#pragma unroll
            for (int m = 0; m < 4; ++m) { bf16_t* rowp = base + (size_t)(row0 + ai * HALF + m * 16) * ldc + col0;
#pragma unroll
                for (int bj = 0; bj < 2; ++bj) { f32x4 v0 = acc[ai][bj][m][0], v1 = acc[ai][bj][m][1];
                    if (mode == 1) {
#pragma unroll
                        for (int j = 0; j < 4; ++j) { v0[j] = fsilu(v0[j]); v1[j] = fsilu(v1[j]); } }
                    else if (mode == 2) {
#pragma unroll
                        for (int j = 0; j < 4; ++j) { v0[j] = fsigmoid(v0[j]); v1[j] = fsigmoid(v1[j]); } }
                    u32x4 w; w.x = cvt_pk_bf16(v0[0], v0[1]); w.y = cvt_pk_bf16(v0[2], v0[3]); w.z = cvt_pk_bf16(v1[0], v1[1]); w.w = cvt_pk_bf16(v1[2], v1[3]);
                    *(u32x4*)(rowp + bj * HALF) = w; } }
    }
};
struct EpiSsdOut {
    static constexpr bool PERM = false, AFTER_DRAIN = false;
    float* YA; const bf16_t* GT;
    __device__ __forceinline__ void operator()(const f32x4 (&acc)[2][2][4][2], const Unit& u, int wr, int wc, int fr, int fq) const {
        const int row0 = u.pm * BM + wr * 64 + fr, col0 = u.pn * BM + wc * 32 + 4 * fq;
#pragma unroll
        for (int ai = 0; ai < 2; ++ai)
#pragma unroll
            for (int m = 0; m < 4; ++m) { const size_t r = (size_t)(row0 + ai * HALF + m * 16);
#pragma unroll
                for (int bj = 0; bj < 2; ++bj)
#pragma unroll
                    for (int n = 0; n < 2; ++n) { const int c = col0 + bj * HALF + n * 16; const u32x2 g = *(const u32x2*)(GT + r * 2048 + c);
                        f32x4 v = acc[ai][bj][m][n]; v[0] *= bf_lo(g.x); v[1] *= bf_hi(g.x); v[2] *= bf_lo(g.y); v[3] *= bf_hi(g.y);
                        *(f32x4*)(YA + r * 1024 + c) = v; } }
    }
};
struct EpiGlu {
    static constexpr bool PERM = true, AFTER_DRAIN = false;
    bf16_t* MIX; const float* YA; const bf16_t* GT;
    __device__ __forceinline__ void operator()(const f32x4 (&acc)[2][2][4][2], const Unit& u, int wr, int wc, int fr, int fq) const {
        const int row0 = u.pm * BM + wr * 64 + fr, col0 = u.pn * HALF + wc * 32 + 8 * fq;
#pragma unroll
        for (int ai = 0; ai < 2; ++ai)
#pragma unroll
            for (int m = 0; m < 4; ++m) { const size_t r = (size_t)(row0 + ai * HALF + m * 16);
                const u32x4 g = *(const u32x4*)(GT + r * 2048 + 1024 + col0); const f32x4 y0 = *(const f32x4*)(YA + r * 1024 + col0), y1 = *(const f32x4*)(YA + r * 1024 + col0 + 4);
                f32x4 a0 = acc[ai][0][m][0], a1 = acc[ai][0][m][1]; const f32x4 b0 = acc[ai][1][m][0], b1 = acc[ai][1][m][1];
#pragma unroll
                for (int j = 0; j < 4; ++j) { a0[j] *= fsigmoid(b0[j]); a1[j] *= fsigmoid(b1[j]); }
                a0[0] = a0[0] * bf_lo(g.x) + y0[0]; a0[1] = a0[1] * bf_hi(g.x) + y0[1]; a0[2] = a0[2] * bf_lo(g.y) + y0[2]; a0[3] = a0[3] * bf_hi(g.y) + y0[3];
                a1[0] = a1[0] * bf_lo(g.z) + y1[0]; a1[1] = a1[1] * bf_hi(g.z) + y1[1]; a1[2] = a1[2] * bf_lo(g.w) + y1[2]; a1[3] = a1[3] * bf_hi(g.w) + y1[3];
                u32x4 w; w.x = cvt_pk_bf16(a0[0], a0[1]); w.y = cvt_pk_bf16(a0[2], a0[3]); w.z = cvt_pk_bf16(a1[0], a1[1]); w.w = cvt_pk_bf16(a1[2], a1[3]);
                *(u32x4*)(MIX + r * 1024 + col0) = w; }
    }
};
struct EpiWo {
    static constexpr bool PERM = false, AFTER_DRAIN = false;
    float* HP; const float* X; float alpha;
    __device__ __forceinline__ void operator()(const f32x4 (&acc)[2][2][4][2], const Unit& u, int wr, int wc, int fr, int fq) const {
        const int row0 = u.pm * BM + wr * 64 + fr, col0 = u.pn * BM + wc * 32 + 4 * fq;
#pragma unroll
        for (int ai = 0; ai < 2; ++ai)
#pragma unroll
            for (int m = 0; m < 4; ++m) { const size_t r = (size_t)(row0 + ai * HALF + m * 16);
#pragma unroll
                for (int bj = 0; bj < 2; ++bj)
#pragma unroll
                    for (int n = 0; n < 2; ++n) { const int c = col0 + bj * HALF + n * 16; const f32x4 xv = *(const f32x4*)(X + r * 1024 + c);
                        *(f32x4*)(HP + r * 1024 + c) = acc[ai][bj][m][n] + xv * alpha; } }
    }
};
struct EpiMoe1 {
    static constexpr bool PERM = true, AFTER_DRAIN = false;
    bf16_t* HID;
    __device__ __forceinline__ void operator()(const f32x4 (&acc)[2][2][4][2], const Unit& u, int wr, int wc, int fr, int fq) const {
        const int row0 = u.pm * BM + wr * 64 + fr, col0 = (u.pn % 22) * HALF + wc * 32 + 8 * fq;
#pragma unroll
        for (int ai = 0; ai < 2; ++ai)
#pragma unroll
            for (int m = 0; m < 4; ++m) { const size_t r = (size_t)(row0 + ai * HALF + m * 16);
                f32x4 a0 = acc[ai][0][m][0], a1 = acc[ai][0][m][1]; const f32x4 b0 = acc[ai][1][m][0], b1 = acc[ai][1][m][1];
#pragma unroll
                for (int j = 0; j < 4; ++j) { a0[j] = fsilu(a0[j]) * b0[j]; a1[j] = fsilu(a1[j]) * b1[j]; }
                u32x4 w; w.x = cvt_pk_bf16(a0[0], a0[1]); w.y = cvt_pk_bf16(a0[2], a0[3]); w.z = cvt_pk_bf16(a1[0], a1[1]); w.w = cvt_pk_bf16(a1[2], a1[3]);
                *(u32x4*)(HID + r * 2816 + col0) = w; }
    }
};
struct EpiMoe2 {
    static constexpr bool PERM = true, AFTER_DRAIN = false;
    bf16_t* Y;
    __device__ __forceinline__ void operator()(const f32x4 (&acc)[2][2][4][2], const Unit& u, int wr, int wc, int fr, int fq) const {
        const int row0 = u.pm * BM + wr * 64 + fr, col0 = (u.pn & 3) * BM + wc * 32 + 8 * fq;
#pragma unroll
        for (int ai = 0; ai < 2; ++ai)
#pragma unroll
            for (int m = 0; m < 4; ++m) { bf16_t* rowp = Y + (size_t)(row0 + ai * HALF + m * 16) * 1024 + col0;
#pragma unroll
                for (int bj = 0; bj < 2; ++bj) { const f32x4 v0 = acc[ai][bj][m][0], v1 = acc[ai][bj][m][1];
                    u32x4 w; w.x = cvt_pk_bf16(v0[0], v0[1]); w.y = cvt_pk_bf16(v0[2], v0[3]); w.z = cvt_pk_bf16(v1[0], v1[1]); w.w = cvt_pk_bf16(v1[2], v1[3]);
                    *(u32x4*)(rowp + bj * HALF) = w; } }
    }
};

struct EpiS5a {
    static constexpr bool PERM = false, AFTER_DRAIN = false;
    float* SLOC;
    __device__ __forceinline__ void operator()(const f32x4 (&acc)[2][2][4][2], const Unit& u, int wr, int wc, int fr, int fq) const {
        const int row0 = u.pm * BM + wr * 64 + fr, col0 = wc * 32 + 4 * fq;
#pragma unroll
        for (int ai = 0; ai < 2; ++ai)
#pragma unroll
            for (int m = 0; m < 4; ++m) { float* rowp = SLOC + (size_t)(row0 + ai * HALF + m * 16) * 256 + col0;
#pragma unroll
                for (int bj = 0; bj < 2; ++bj)
#pragma unroll
                    for (int n = 0; n < 2; ++n) *(f32x4*)(rowp + bj * HALF + n * 16) = acc[ai][bj][m][n]; }
    }
};
__device__ __forceinline__ float gelu_tanh_f(float x) { const float uu = 0.7978845608028654f * (x + 0.044715f * x * x * x); const float e = __expf(2.f * uu); return 0.5f * x * (2.f - 2.f * __builtin_amdgcn_rcpf(e + 1.f)); }
struct EpiS5c {
    static constexpr bool PERM = true, AFTER_DRAIN = false;
    bf16_t* GY; const bf16_t* UC; const float* d5;
    __device__ __forceinline__ void operator()(const f32x4 (&acc)[2][2][4][2], const Unit& u, int wr, int wc, int fr, int fq) const {
        const int g = u.pm >> 1, cl0 = (u.pm & 1) * BM + wr * 64 + fr, nl0 = (u.pn & 1) * BM + wc * 32 + 8 * fq;
        const int k0 = nl0 & 15; const f32x4 d0 = *(const f32x4*)(d5 + g * 16 + k0), d1 = *(const f32x4*)(d5 + g * 16 + k0 + 4);
#pragma unroll
        for (int ai = 0; ai < 2; ++ai)
#pragma unroll
            for (int m = 0; m < 4; ++m) { const int cl = cl0 + ai * HALF + m * 16;
#pragma unroll
                for (int bj = 0; bj < 2; ++bj) { const int nl = nl0 + bj * HALF, t = nl >> 4;
                    const u32x4 uw = *(const u32x4*)(UC + ((size_t)(g * 512 + cl) * 768 + nl));
                    f32x4 v0 = acc[ai][bj][m][0], v1 = acc[ai][bj][m][1];
                    v0[0] += bf_lo(uw.x) * d0[0]; v0[1] += bf_hi(uw.x) * d0[1]; v0[2] += bf_lo(uw.y) * d0[2]; v0[3] += bf_hi(uw.y) * d0[3];
                    v1[0] += bf_lo(uw.z) * d1[0]; v1[1] += bf_hi(uw.z) * d1[1]; v1[2] += bf_lo(uw.w) * d1[2]; v1[3] += bf_hi(uw.w) * d1[3];
#pragma unroll
                    for (int j = 0; j < 4; ++j) { v0[j] = gelu_tanh_f(v0[j]); v1[j] = gelu_tanh_f(v1[j]); }
                    u32x4 w; w.x = cvt_pk_bf16(v0[0], v0[1]); w.y = cvt_pk_bf16(v0[2], v0[3]); w.z = cvt_pk_bf16(v1[0], v1[1]); w.w = cvt_pk_bf16(v1[2], v1[3]);
                    *(u32x4*)(GY + (size_t)(cl * 32 + t) * 768 + g * 16 + k0) = w; } }
    }
};
struct S5aOrder {
    int c, lo;
    __device__ __forceinline__ bool next(int i, Unit& u) const { if (i > 0 || c < lo || c >= lo + 96) return false; u.pm = c - lo; u.pn = (c - lo) >> 1; return true; }
    __device__ __forceinline__ void a_ready(const Unit&) const {}
    __device__ __forceinline__ void done(const Unit&) const {}
};
struct S5cOrder {
    int G, c;
    __device__ __forceinline__ bool next(int i, Unit& u) const { const int L = i * G + c; if (L >= 192) return false; const int g = L >> 2; u.pm = 2 * g + (L & 1); u.pn = 2 * g + ((L >> 1) & 1); return true; }
    __device__ __forceinline__ void a_ready(const Unit&) const {}
    __device__ __forceinline__ void done(const Unit&) const {}
};
struct MoeOrder1 {
    int G, c;
    __device__ __forceinline__ bool next(int i, Unit& u) const {
        if (G == 256) { if (i >= 11) return false; const int x = c & 7, j = c >> 3, q = x * 44 + i * 4 + (j >> 3); u.pm = (q / 22) * 8 + (j & 7); u.pn = q; return true; }
        const long L = (long)i * G + c; if (L >= 2816) return false; const int e = (int)(L / 176), r = (int)(L % 176); u.pm = e * 8 + (r & 7); u.pn = e * 22 + (r >> 3); return true;
    }
    __device__ __forceinline__ void a_ready(const Unit&) const {}
    __device__ __forceinline__ void done(const Unit&) const {}
};
struct MoeOrder2 {
    int G, c;
    __device__ __forceinline__ bool next(int i, Unit& u) const {
        if (G == 256) { if (i >= 2) return false; const int x = c & 7, j = c >> 3, e = 2 * x + i; u.pm = e * 8 + (j & 7); u.pn = e * 4 + (j >> 3); return true; }
        const long L = (long)i * G + c; if (L >= 512) return false; const int e = (int)(L / 32), r = (int)(L % 32); u.pm = e * 8 + (r & 7); u.pn = e * 4 + (r >> 3); return true;
    }
    __device__ __forceinline__ void a_ready(const Unit&) const {}
    __device__ __forceinline__ void done(const Unit&) const {}
};
template <class Epi, class Sched, bool ALIGN_EPI = false, bool SP2 = false>
__device__ __forceinline__ void gemm_phase(PG8_LAS unsigned char* lds, const Gemm g, const Sched& S, const Epi& E) {
    const int tid = threadIdx.x, wid = __builtin_amdgcn_readfirstlane(tid >> 6), lane = tid & 63, wr = wid >> 2, wc = wid & 3, fr = lane & 15, fq = lane >> 4;
    const int K = g.K, nt = K / BK;
    unsigned voffA[2], voffB[2];
#pragma unroll
    for (int i = 0; i < 2; ++i) { int R, C; stage_rc(tid * 16 + i * 8192, R, C); const int Rb = Epi::PERM ? ((R & ~31) + perm32(R & 31)) : R;
        voffA[i] = (unsigned)(R * g.lda + C) * 2u; voffB[i] = (unsigned)(Rb * g.ldb + C) * 2u; }
    const size_t kstep = (size_t)(BK * 2);
    const size_t hstepA = (size_t)HALF * g.lda * 2, hstepB = (size_t)HALF * g.ldb * 2;
    const size_t tstepA = 2 * hstepA, tstepB = 2 * hstepB;
    const unsigned ldsw = (unsigned)wid * 1024u;
    const int aoff = lds_byte(wr * 64 + fr, fq * 8), boff = lds_byte(wc * 32 + fr, fq * 8);
#define PG8_SA(b, h) (((b) * 2 + (h)) * HTB)
#define PG8_SB(b, h) ((4 + (b) * 2 + (h)) * HTB)
#define PG8_STAGE(bufoff, gbase, voff) do { _Pragma("unroll") for (int _i = 0; _i < 2; ++_i) \
        __builtin_amdgcn_global_load_lds((const unsigned*)((const char*)(gbase) + (voff)[_i]), (PG8_LAS unsigned*)(lds + (bufoff) + ldsw + _i * 8192), 16, 0, 0); } while (0)
#define PG8_LDA(dst, b, h) do { _Pragma("unroll") for (int m = 0; m < 4; ++m) _Pragma("unroll") for (int k = 0; k < 2; ++k) dst[m][k] = *(const PG8_LAS bf16x8*)(lds + PG8_SA(b, h) + aoff + m * 2048 + k * 1024); } while (0)
#define PG8_LDB(dst, b, h) do { _Pragma("unroll") for (int n = 0; n < 2; ++n) _Pragma("unroll") for (int k = 0; k < 2; ++k) dst[n][k] = *(const PG8_LAS bf16x8*)(lds + PG8_SB(b, h) + boff + n * 2048 + k * 1024); } while (0)
#define PG8_MMA(ai, bj, At, Bt) do { __builtin_amdgcn_s_setprio(1); _Pragma("unroll") for (int m = 0; m < 4; ++m) _Pragma("unroll") for (int n = 0; n < 2; ++n) _Pragma("unroll") for (int k = 0; k < 2; ++k) \
        acc[ai][bj][m][n] = __builtin_amdgcn_mfma_f32_16x16x32_bf16(Bt[n][k], At[m][k], acc[ai][bj][m][n], 0, 0, 0); __builtin_amdgcn_s_setprio(0); } while (0)
#define PG8_WAIT_V(n) asm volatile("s_waitcnt vmcnt(" #n ")" ::: "memory")
#define PG8_WAIT_L(n) asm volatile("s_waitcnt lgkmcnt(" #n ")" ::: "memory")
#define PG8_BAR __builtin_amdgcn_s_barrier()
#define PG8_SCHED __builtin_amdgcn_sched_barrier(0)
    Unit cur, nxt; int ui = 0;
    if (!S.next(0, cur)) return;
    f32x4 acc[2][2][4][2];
#pragma unroll
    for (int a = 0; a < 2; ++a)
#pragma unroll
        for (int b = 0; b < 2; ++b)
#pragma unroll
            for (int m = 0; m < 4; ++m)
#pragma unroll
                for (int n = 0; n < 2; ++n) acc[a][b][m][n] = (f32x4){0.f, 0.f, 0.f, 0.f};
    bf16x8 At[4][2], B0[2][2], B1[2][2];
    const char* cA = (const char*)g.A + (size_t)cur.pm * tstepA; const char* cB = (const char*)g.Bt + (size_t)cur.pn * tstepB;
    S.a_ready(cur);
    if constexpr (SP2) {
        PG8_STAGE(PG8_SB(0, 0), cB, voffB); PG8_STAGE(PG8_SB(0, 1), cB + hstepB, voffB); PG8_STAGE(PG8_SA(0, 0), cA, voffA); PG8_STAGE(PG8_SA(0, 1), cA + hstepA, voffA);
        if (wr == 1) PG8_BAR;
        PG8_WAIT_V(2); PG8_BAR;
        PG8_STAGE(PG8_SB(1, 0), cB + kstep, voffB); PG8_STAGE(PG8_SA(1, 0), cA + kstep, voffA); PG8_STAGE(PG8_SB(1, 1), cB + hstepB + kstep, voffB);
        PG8_WAIT_V(6); PG8_BAR;
    } else {
        PG8_STAGE(PG8_SB(0, 0), cB, voffB); PG8_STAGE(PG8_SA(0, 0), cA, voffA); PG8_STAGE(PG8_SB(0, 1), cB + hstepB, voffB); PG8_STAGE(PG8_SA(0, 1), cA + hstepA, voffA);
        if (wr == 1) PG8_BAR;
        PG8_WAIT_V(4); PG8_BAR;
        PG8_STAGE(PG8_SB(1, 0), cB + kstep, voffB); PG8_STAGE(PG8_SA(1, 0), cA + kstep, voffA); PG8_STAGE(PG8_SB(1, 1), cB + hstepB + kstep, voffB);
        PG8_WAIT_V(6); PG8_BAR;
    }
    for (;;) {
        const bool has_next = S.next(ui + 1, nxt);
        const char* nA = has_next ? (const char*)g.A + (size_t)nxt.pm * tstepA : cA; const char* nB = has_next ? (const char*)g.Bt + (size_t)nxt.pn * tstepB : cB;
        for (int t = 0; t < nt; t += 2) {
            const bool last = (t == nt - 2);
            const char* a1 = cA + (size_t)(t + 1) * kstep;
            const char* a2 = last ? nA : cA + (size_t)(t + 2) * kstep; const char* b2 = last ? nB : cB + (size_t)(t + 2) * kstep;
            const char* a3 = a2 + kstep; const char* b3 = b2 + kstep;
            if (last && has_next) S.a_ready(nxt);
            if constexpr (SP2) {
            PG8_LDB(B0, 0, 0); PG8_LDB(B1, 0, 1); PG8_SCHED; PG8_LDA(At, 0, 0); PG8_STAGE(PG8_SA(1, 1), a1 + hstepA, voffA);
            PG8_WAIT_V(8); PG8_WAIT_L(0); PG8_BAR; PG8_MMA(0, 0, At, B0); PG8_MMA(0, 1, At, B1); PG8_BAR; PG8_SCHED;
            PG8_LDA(At, 0, 1); PG8_STAGE(PG8_SB(0, 0), b2, voffB); PG8_STAGE(PG8_SB(0, 1), b2 + hstepB, voffB); PG8_STAGE(PG8_SA(0, 0), a2, voffA);
            PG8_WAIT_V(8); PG8_WAIT_L(0); PG8_BAR; PG8_MMA(1, 0, At, B0); PG8_MMA(1, 1, At, B1); PG8_BAR; PG8_SCHED;
            PG8_LDB(B0, 1, 0); PG8_LDB(B1, 1, 1); PG8_SCHED; PG8_LDA(At, 1, 0); PG8_STAGE(PG8_SA(0, 1), a2 + hstepA, voffA);
            PG8_WAIT_V(8); PG8_WAIT_L(0); PG8_BAR; PG8_MMA(0, 0, At, B0); PG8_MMA(0, 1, At, B1); PG8_BAR; PG8_SCHED;
            PG8_LDA(At, 1, 1); PG8_STAGE(PG8_SB(1, 0), b3, voffB); PG8_STAGE(PG8_SB(1, 1), b3 + hstepB, voffB); PG8_STAGE(PG8_SA(1, 0), a3, voffA);
            PG8_WAIT_V(8); PG8_WAIT_L(0); PG8_BAR; PG8_MMA(1, 0, At, B0); PG8_MMA(1, 1, At, B1); PG8_BAR; PG8_SCHED;
            } else {
            PG8_LDB(B0, 0, 0); PG8_SCHED; PG8_LDA(At, 0, 0); PG8_STAGE(PG8_SA(1, 1), a1 + hstepA, voffA);
            PG8_WAIT_L(8); PG8_BAR; PG8_WAIT_L(0); PG8_MMA(0, 0, At, B0); PG8_BAR; PG8_SCHED;
            PG8_LDB(B1, 0, 1); PG8_STAGE(PG8_SB(0, 0), b2, voffB);
            PG8_BAR; PG8_WAIT_L(0); PG8_MMA(0, 1, At, B1); PG8_BAR;
            PG8_LDA(At, 0, 1); PG8_STAGE(PG8_SA(0, 0), a2, voffA);
            PG8_BAR; PG8_WAIT_L(0); PG8_MMA(1, 0, At, B0); PG8_BAR; PG8_SCHED;
            PG8_STAGE(PG8_SB(0, 1), b2 + hstepB, voffB);
            PG8_WAIT_V(6); PG8_BAR; PG8_MMA(1, 1, At, B1); PG8_BAR;
            PG8_LDB(B0, 1, 0); PG8_SCHED; PG8_LDA(At, 1, 0); PG8_STAGE(PG8_SA(0, 1), a2 + hstepA, voffA);
            PG8_WAIT_L(8); PG8_BAR; PG8_WAIT_L(0); PG8_MMA(0, 0, At, B0); PG8_BAR; PG8_SCHED;
            PG8_LDB(B1, 1, 1); PG8_STAGE(PG8_SB(1, 0), b3, voffB);
            PG8_BAR; PG8_WAIT_L(0); PG8_MMA(0, 1, At, B1); PG8_BAR;
            PG8_LDA(At, 1, 1); PG8_STAGE(PG8_SA(1, 0), a3, voffA);
            PG8_BAR; PG8_WAIT_L(0); PG8_MMA(1, 0, At, B0); PG8_BAR; PG8_SCHED;
            PG8_STAGE(PG8_SB(1, 1), b3 + hstepB, voffB);
            PG8_WAIT_V(6); PG8_BAR; PG8_MMA(1, 1, At, B1); PG8_BAR;
            }
        }
        if constexpr (ALIGN_EPI) { if (wr == 0) PG8_BAR; }
        if constexpr (!Epi::AFTER_DRAIN) { E(acc, cur, wr, wc, fr, fq); S.done(cur); }
        if (!has_next) break;
#pragma unroll
        for (int a = 0; a < 2; ++a)
#pragma unroll
            for (int b = 0; b < 2; ++b)
#pragma unroll
                for (int m = 0; m < 4; ++m)
#pragma unroll
                    for (int n = 0; n < 2; ++n) acc[a][b][m][n] = (f32x4){0.f, 0.f, 0.f, 0.f};
        cur = nxt; cA = nA; cB = nB; ++ui;
        if constexpr (ALIGN_EPI) { if (wr == 1) PG8_BAR; }
    }
    PG8_WAIT_V(0);
    if constexpr (!ALIGN_EPI) { if (wr == 0) PG8_BAR; }
    PG8_BAR;
    if constexpr (Epi::AFTER_DRAIN) { E.fused(acc, cur, wr, wc, fr, fq, lds, wid, lane); S.done(cur); }
#undef PG8_SA
#undef PG8_SB
#undef PG8_STAGE
#undef PG8_LDA
#undef PG8_LDB
#undef PG8_MMA
#undef PG8_WAIT_V
#undef PG8_WAIT_L
#undef PG8_BAR
#undef PG8_SCHED
}
}
#ifndef PG8_SP2
#define PG8_SP2 true
#endif
#ifndef PG8_ALIGN
#define PG8_ALIGN true
#endif

constexpr int NWAVES = 8, NTHR = 512;
constexpr int D = 1024, NB = 2, T = 8192, M = NB * T;
constexpr int SSD_H = 24, SSD_P = 64, SSD_IN = 1536, SSD_G = 4, SSD_N = 128, XBC = 2560, INCOLS = 6960, NIN_PAD = 7168;
constexpr int S5_W = 768, S5_G = 48, S5_P = 64, S5_K = 16;
constexpr int NE = 16, FF = 2816, CAP = 1024, MROWS = NE * NB * CAP;
constexpr float LN_EPS = 1e-5f, RMS_EPS = 1e-5f;
constexpr float ALPHA = 1.189207115002721f;

constexpr size_t MiB = 1u << 20;
constexpr size_t WS_CTL = 0, CTL_ZERO_BYTES = 64 * 1024;
constexpr size_t WS_WIN = 1 * MiB, WS_WOUT = 15 * MiB, WS_WGLU = 18 * MiB, WS_WO = 21 * MiB, WS_W1 = 23 * MiB, WS_W2 = 199 * MiB, WS_ACT = 287 * MiB;
constexpr size_t A_XB = WS_ACT + 0 * MiB;
constexpr size_t A_BN = WS_ACT + 0 * MiB;
constexpr size_t A_CN = WS_ACT + 16 * MiB;
constexpr size_t A_Z = WS_ACT + 32 * MiB;
constexpr size_t A_XBC = WS_ACT + 80 * MiB;
constexpr size_t A_S = WS_ACT + 80 * MiB;
constexpr size_t A_XT = WS_ACT + 176 * MiB;
constexpr size_t A_BT = WS_ACT + 224 * MiB;
constexpr size_t A_SV = WS_ACT + 240 * MiB;
constexpr size_t A_DT = WS_ACT + 252 * MiB;
constexpr size_t A_TOT = WS_ACT + 255 * MiB;
constexpr size_t A_UC = WS_ACT + 268 * MiB;
constexpr size_t A_Y = WS_ACT + 256 * MiB;
constexpr size_t A_GY = WS_ACT + 304 * MiB;
constexpr size_t A_GT = WS_ACT + 353 * MiB;
constexpr size_t A_YA = WS_ACT + 0 * MiB;
constexpr size_t A_MIX = WS_ACT + 64 * MiB;
constexpr size_t A_HP = WS_ACT + 96 * MiB;
constexpr size_t A_H = WS_ACT + 0 * MiB;
constexpr size_t A_HB = WS_ACT + 64 * MiB;
constexpr size_t A_AFF = WS_ACT + 160 * MiB;
constexpr size_t A_IDX = A_AFF + 1 * MiB;
constexpr size_t A_SEL = A_AFF + 2 * MiB;
constexpr size_t A_GATE = A_AFF + 3 * MiB;
constexpr size_t A_XIN = WS_ACT + 164 * MiB;
constexpr size_t A_HID = WS_ACT + 228 * MiB;
constexpr size_t A_YE = WS_ACT + 96 * MiB;
constexpr size_t WS_TV = WS_W2 + 0 * MiB;
constexpr size_t WS_WS5 = WS_W2 + 36 * MiB;
constexpr size_t WS_SLOC = WS_W2 + 48 * MiB;
constexpr size_t WS_AQ = WS_W2 + 72 * MiB;
constexpr size_t WS_END = 704 * MiB;
static_assert(A_HID + 176 * MiB <= WS_END && A_XIN + 64 * MiB <= A_HID && A_GATE + 1 * MiB <= A_XIN && A_YE + 64 * MiB <= A_AFF && A_H + 64 * MiB <= A_HB && A_HB + 32 * MiB <= A_HP, "d_ws map (late phases)");
static_assert(A_GT + 64 * MiB <= WS_END && A_GY + 24 * MiB <= A_GT && A_UC + 36 * MiB <= A_GY && A_Y + 48 * MiB <= A_GY && A_TOT + 1 * MiB <= A_Y && A_DT + 3 * MiB <= A_TOT && A_SV + 12 * MiB <= A_DT && A_BT + 16 * MiB <= A_SV
              && A_XT + 48 * MiB <= A_BT && A_S + 96 * MiB <= A_XT && A_Z + 48 * MiB <= A_XBC && A_CN + 16 * MiB <= A_Z, "d_ws map (early phases)");
constexpr int CW_BAR = 1024;

constexpr int RING_BYTES = 131072;
constexpr int MISC_OFF = RING_BYTES;
constexpr int LDS_BYTES = 147456;

#define GAS __attribute__((address_space(1)))
#define LAS __attribute__((address_space(3)))
typedef unsigned short bf16;
typedef unsigned v4u __attribute__((ext_vector_type(4)));
typedef unsigned v2u __attribute__((ext_vector_type(2)));
typedef float f32x4 __attribute__((ext_vector_type(4)));
#define LDS_WAIT() asm volatile("s_waitcnt lgkmcnt(0)" ::: "memory")
__device__ __forceinline__ unsigned f2bf(float f) { unsigned u = __builtin_bit_cast(unsigned, f); return (u + 0x7fffu + ((u >> 16) & 1u)) >> 16; }
__device__ __forceinline__ unsigned pk2(float lo, float hi) { return pg8::cvt_pk_bf16(lo, hi); }
__device__ __forceinline__ float bflo(unsigned w) { return __uint_as_float(w << 16); }
__device__ __forceinline__ float bfhi(unsigned w) { return __uint_as_float(w & 0xffff0000u); }
__device__ __forceinline__ float wave_sum(float v) {
#pragma unroll
    for (int o = 1; o < 64; o <<= 1) v += __shfl_xor(v, o);
    return v;
}
#define XB_TMO      128
#define XB_XCNT(j)  (256  + 64 * (j))
#define XB_XSUB(j)  (1280 + 64 * (j))
#define XB_XGEN(j)  (2304 + 64 * (j))
#define XB_TOP      3328
#define XB_TOPGEN   3392
#define XCD_BAR_WORDS 3456
#define XB_SPIN_CAP (1u << 18)

__device__ __forceinline__ unsigned xb_ld(unsigned* p)              { return __hip_atomic_load(p, __ATOMIC_RELAXED, __HIP_MEMORY_SCOPE_AGENT); }
__device__ __forceinline__ unsigned xb_add(unsigned* p, unsigned v) { return __hip_atomic_fetch_add(p, v, __ATOMIC_RELAXED, __HIP_MEMORY_SCOPE_AGENT); }
__device__ __forceinline__ unsigned xb_xcc_id() { return (unsigned)__builtin_amdgcn_s_getreg((3 << 11) | 20) & 0xFu; }
#define XB_SPIN(cond, bar) do { unsigned _sp = 0; while (cond) { __builtin_amdgcn_s_sleep(1); \
    if ((++_sp & 255u) == 0u) { if (xb_ld(&(bar)[XB_TMO])) break; if (_sp > XB_SPIN_CAP) { atomicAdd(&(bar)[XB_TMO], 1u); break; } } } } while (0)

struct XcdBarrier {
    unsigned* bar; unsigned x;
    volatile LAS unsigned* st;
};

__device__ __forceinline__ XcdBarrier xcd_barrier_post(unsigned* bar, volatile LAS unsigned* st) {
    XcdBarrier b; b.bar = bar; b.x = xb_xcc_id(); b.st = st;
    if (threadIdx.x == 0) (void)xb_add(&bar[XB_XCNT(b.x)], 1u);
    return b;
}
__device__ __forceinline__ void xcd_barrier_complete(unsigned* bar, unsigned x, unsigned& nloc, unsigned& nx) {
    const unsigned G = gridDim.x * gridDim.y * gridDim.z;
    unsigned sum, cnt, mine, sp = 0u;
    for (;;) {
        sum = 0u; cnt = 0u; mine = 0u;
#pragma unroll
        for (unsigned j = 0; j < 16; ++j) { const unsigned c = xb_ld(&bar[XB_XCNT(j)]); sum += c; cnt += (c > 0u) ? 1u : 0u; mine = (j == x) ? c : mine; }
        if (sum == G) break;
        __builtin_amdgcn_s_sleep(1);
        if ((++sp & 255u) == 0u) { if (xb_ld(&bar[XB_TMO])) break; if (sp > XB_SPIN_CAP) { atomicAdd(&bar[XB_TMO], 1u); break; } }
    }
    nloc = mine > 0u ? mine : 1u; nx = cnt > 0u ? cnt : 1u;
}

__device__ __forceinline__ void xcd_barrier(const XcdBarrier& b) {
    asm volatile("s_waitcnt vmcnt(0)" ::: "memory");
    __syncthreads();
    if (threadIdx.x == 0) {
        unsigned* bar = b.bar;
        __builtin_amdgcn_s_waitcnt(0);
        unsigned nloc = b.st[0], nx = b.st[1];
        if (nloc == 0u) { xcd_barrier_complete(bar, b.x, nloc, nx); b.st[0] = nloc; b.st[1] = nx; }
        const unsigned old = xb_add(&bar[XB_XSUB(b.x)], 1u);
        const unsigned gen = old / nloc;
        if (old + 1u == (gen + 1u) * nloc) {
            __builtin_amdgcn_fence(__ATOMIC_RELEASE, "agent");
            asm volatile("s_waitcnt vmcnt(0)" ::: "memory");
            const unsigned og = xb_add(&bar[XB_TOP], 1u);
            const unsigned tg = og / nx;
            if (og + 1u == (tg + 1u) * nx) xb_add(&bar[XB_TOPGEN], 1u);
            else XB_SPIN(xb_ld(&bar[XB_TOPGEN]) == tg, bar);
            __builtin_amdgcn_fence(__ATOMIC_ACQUIRE, "agent");
            xb_add(&bar[XB_XGEN(b.x)], 1u);
            asm volatile("s_waitcnt vmcnt(0)" ::: "memory");
        } else {
            XB_SPIN(xb_ld(&bar[XB_XGEN(b.x)]) == gen, bar);
            __builtin_amdgcn_fence(__ATOMIC_ACQUIRE, "agent");
            asm volatile("s_waitcnt vmcnt(0)" ::: "memory");
        }
    }
    __syncthreads();
}

struct Frame {
    LAS unsigned char* lds;
    int tid, lane, wave, bid, G;
    const float* const* in; float* out; unsigned char* ws;
};
#define WSP(T_, off) ((T_*)(F.ws + (off)))

__device__ __forceinline__ void tr_item(const float* W, int ldw, int col0, int ncols, int K, bf16* WT, int drow, LAS float* scr, int k0, int n0, int lane) {
    const int kr = lane >> 4, c4 = lane & 15; const bool okc = (n0 + 4 * c4) < ncols;
    const float* src = W + (size_t)(k0 + kr) * ldw + col0 + n0 + 4 * c4;
    f32x4 v[16];
#pragma unroll
    for (int i = 0; i < 16; ++i) v[i] = okc ? *(const f32x4*)(src + (size_t)(4 * i) * ldw) : (f32x4){0.f, 0.f, 0.f, 0.f};
#pragma unroll
    for (int i = 0; i < 16; ++i) { const int k = 4 * i + kr; *(LAS f32x4*)(scr + k * 64 + 4 * (c4 ^ ((k >> 3) & 7))) = v[i]; }
    LDS_WAIT(); asm volatile("" ::: "memory");
    const int nl = lane >> 3, c = lane & 7;
#pragma unroll
    for (int j = 0; j < 8; ++j) { const int n = 8 * j + nl; const LAS float* s = scr + (8 * c) * 64 + 4 * ((n >> 2) ^ c) + (n & 3);
        v4u o; o.x = pk2(s[0 * 64], s[1 * 64]); o.y = pk2(s[2 * 64], s[3 * 64]); o.z = pk2(s[4 * 64], s[5 * 64]); o.w = pk2(s[6 * 64], s[7 * 64]);
        if (n0 + n < ncols) *(v4u*)(WT + (size_t)(drow + n) * K + k0 + 8 * c) = o; }
    LDS_WAIT(); asm volatile("" ::: "memory");
}
struct TrJob { const float* W; int ldw, col0, ncols, K; bf16* WT; int drow0, interleave; };
__device__ __forceinline__ int tr_job_items(const TrJob& j) { return (j.K / 64) * ((j.ncols + 63) / 64); }
__device__ __forceinline__ void tr_job_item(const TrJob& j, int item, LAS float* scr, int lane) {
    const int nblk = (j.ncols + 63) / 64, kb = item / nblk, nb = item % nblk, n0 = nb * 64;
    const int drow = j.interleave ? j.drow0 + (n0 >> 7) * 256 + (n0 & 127) : j.drow0 + n0;
    tr_item(j.W, j.ldw, j.col0, j.ncols, j.K, j.WT, drow, scr, kb * 64, n0, lane);
}
__device__ __forceinline__ void p0_prologue(Frame& F) {
    LAS float* scr = (LAS float*)(F.lds + F.wave * 16384);
    const int gw = F.bid * NWAVES + F.wave, NGW = F.G * NWAVES;
    { const f32x4* x4 = (const f32x4*)F.in[0]; v4u* o = WSP(v4u, A_XB); const int n8 = M * D / 8;
      for (int i = F.bid * NTHR + F.tid; i < n8; i += F.G * NTHR) { const f32x4 a = x4[2 * i], b = x4[2 * i + 1]; v4u w; w.x = pk2(a.x, a.y); w.y = pk2(a.z, a.w); w.z = pk2(b.x, b.y); w.w = pk2(b.z, b.w); o[i] = w; } }
    {
        bf16* WIN = WSP(bf16, WS_WIN); bf16* WOUT = WSP(bf16, WS_WOUT); bf16* WGLU = WSP(bf16, WS_WGLU); bf16* WO = WSP(bf16, WS_WO);
        const TrJob jobs[8] = {
            {F.in[1], INCOLS, 0, 4096, D, WIN, 0, 0}, {F.in[1], INCOLS, 4096, 48, D, WIN, 4096, 0}, {F.in[1], INCOLS, 4144, 768, D, WIN, 4352, 0}, {F.in[1], INCOLS, 4912, 2048, D, WIN, 5120, 0},
            {F.in[10], D, 0, D, SSD_IN, WOUT, 0, 0}, {F.in[22], D, 0, D, S5_W, WGLU, 0, 1}, {F.in[23], D, 0, D, S5_W, WGLU, 128, 1}, {F.in[24], D, 0, D, D, WO, 0, 0} };
        int base = 0;
#pragma unroll
        for (int q = 0; q < 8; ++q) { const int n = tr_job_items(jobs[q]);
            int it0 = (gw - base) % NGW; if (it0 < 0) it0 += NGW;
            for (int it = it0; it < n; it += NGW) tr_job_item(jobs[q], it, scr, F.lane);
            base += n; }
    }
    {
        bf16* W1 = WSP(bf16, WS_W1);
        constexpr int I13 = (D / 64) * (FF / 64);
        for (int it = gw; it < NE * 2 * I13; it += NGW) {
            const int e = it / (2 * I13); int r = it % (2 * I13);
            if (r < I13) { const TrJob j{F.in[28] + (size_t)e * D * FF, FF, 0, FF, D, W1 + (size_t)e * 2 * FF * D, 0, 1}; tr_job_item(j, r, scr, F.lane); }
            else { const TrJob j{F.in[29] + (size_t)e * D * FF, FF, 0, FF, D, W1 + (size_t)e * 2 * FF * D, 128, 1}; tr_job_item(j, r - I13, scr, F.lane); }
        }
    }
}
__device__ __forceinline__ void w2_convert(Frame& F, int gw, int ngw) {
    LAS float* scr = (LAS float*)(F.lds + F.wave * 16384);
    bf16* W2 = WSP(bf16, WS_W2);
    constexpr int I2 = (FF / 64) * (D / 64);
    for (int it = gw; it < NE * I2; it += ngw) { const int e = it / I2, r = it % I2;
        const TrJob j{F.in[30] + (size_t)e * FF * D, D, 0, D, FF, W2 + (size_t)e * D * FF, 0, 0}; tr_job_item(j, r, scr, F.lane); }
}

__device__ __forceinline__ void cmul(float ar, float ai, float br, float bi, float& cr, float& ci) { cr = ar * br - ai * bi; ci = ar * bi + ai * br; }
__device__ __forceinline__ void s5_precompute_item(Frame& F, int g, int tau) {
    LAS float* PQ = (LAS float*)(F.lds + 72 * 1024);
    LAS float* PW = PQ + 256;
    bf16* TV = WSP(bf16, WS_TV) + (size_t)g * 512 * 768; bf16* WM = WSP(bf16, WS_WS5) + (size_t)g * 256 * 512; float* AQ = WSP(float, WS_AQ);
    const int tid = F.tid;
    __syncthreads();
    if (tid < 128) {
        const int d = tid >> 6, p = tid & 63;
        const float are = (d ? F.in[14] : F.in[11])[g * 64 + p], aim = (d ? F.in[15] : F.in[12])[g * 64 + p], step = __expf((d ? F.in[16] : F.in[13])[g]);
        const float zr = are * step, zi = aim * step;
        const float er = expf(zr), cs = cosf(zi), sn = sinf(zi), abr = er * cs, abi = er * sn;
        const float sh = sinf(0.5f * zi), dr = expm1f(zr) * cs - 2.f * sh * sh, di = abi;
        const float den = 1.0f / (are * are + aim * aim), qr = (dr * are + di * aim) * den, qi = (di * are - dr * aim) * den;
        float pr = 1.f, pi = 0.f, br = abr, bi = abi;
#pragma unroll
        for (int bit = 0; bit < 6; ++bit) { if ((tau >> bit) & 1) { float tr_, ti_; cmul(pr, pi, br, bi, tr_, ti_); pr = tr_; pi = ti_; } float sr_, si_; cmul(br, bi, br, bi, sr_, si_); br = sr_; bi = si_; }
        float xr, xi; cmul(pr, pi, qr, qi, xr, xi);
        PQ[(d * 64 + p) * 2] = xr; PQ[(d * 64 + p) * 2 + 1] = xi; PW[(d * 64 + p) * 2] = pr; PW[(d * 64 + p) * 2 + 1] = pi;
        if (tau == 32) { AQ[((g * 2 + d) * 64 + p) * 2] = pr; AQ[((g * 2 + d) * 64 + p) * 2 + 1] = pi; }
    }
    __syncthreads();
    const float* cre = F.in[19] + (size_t)g * 16 * 64; const float* cim = F.in[20] + (size_t)g * 16 * 64;
    const float* bre = F.in[17] + (size_t)g * 64 * 16; const float* bim = F.in[18] + (size_t)g * 64 * 16;
    if (tid < 256 && tau < 32) {
        const int k = tid >> 4, j = tid & 15; float kf = 0.f, kb = 0.f;
        for (int p = 0; p < 64; ++p) { const float cr = cre[k * 64 + p], ci = cim[k * 64 + p], br = bre[p * 16 + j], bi = bim[p * 16 + j];
            float wr_, wi_; cmul(cr, ci, PQ[p * 2], PQ[p * 2 + 1], wr_, wi_); kf += wr_ * br - wi_ * bi;
            cmul(cr, ci, PQ[(64 + p) * 2], PQ[(64 + p) * 2 + 1], wr_, wi_); kb += wr_ * br - wi_ * bi; }
        if (tau == 0) { const bf16 v = (bf16)f2bf(kf + kb); for (int t = 0; t < 32; ++t) TV[(size_t)(t * 16 + k) * 768 + t * 16 + j] = v; }
        else { const bf16 vf = (bf16)f2bf(kf), vb = (bf16)f2bf(kb);
            for (int t = tau; t < 32; ++t) { const int s = t - tau; TV[(size_t)(t * 16 + k) * 768 + s * 16 + j] = vf; TV[(size_t)(s * 16 + k) * 768 + t * 16 + j] = vb; } }
    }
    if (tid >= 256) {
        const int q = tid - 256;
        if (tau >= 1) {
#pragma unroll 1
            for (int i = 0; i < 8; ++i) { const int e = q * 8 + i, d = e >> 10, k = (e >> 6) & 15, p = e & 63;
                float vr, vi; cmul(cre[k * 64 + p], cim[k * 64 + p], PW[(d * 64 + p) * 2], PW[(d * 64 + p) * 2 + 1], vr, vi);
                const int t = d ? 32 - tau : tau - 1; bf16* row = TV + (size_t)(t * 16 + k) * 768 + 512 + d * 128;
                row[p] = (bf16)f2bf(vr); row[64 + p] = (bf16)f2bf(-vi); } }
        if (tau < 32) {
#pragma unroll 1
            for (int i = 0; i < 8; ++i) { const int e = q * 8 + i, d = e >> 10, p = (e >> 4) & 63, j = e & 15;
                float vr, vi; cmul(PQ[(d * 64 + p) * 2], PQ[(d * 64 + p) * 2 + 1], bre[p * 16 + j], bim[p * 16 + j], vr, vi);
                const int s = d ? tau : 31 - tau; bf16* col = WM + (size_t)(d * 128 + p) * 512 + s * 16 + j;
                col[0] = (bf16)f2bf(vr); col[(size_t)64 * 512] = (bf16)f2bf(vi); } }
    }
}
__device__ __forceinline__ void p0_s5(Frame& F) { for (int it = F.bid; it < S5_G * 33; it += F.G) s5_precompute_item(F, it / 33, it % 33); }

__device__ __forceinline__ void s5_scan_item(Frame& F, int item) {
    const int d = item & 1, b = (item >> 1) & 1, g = item >> 2, tid = F.tid;
    LAS float* S = (LAS float*)F.lds;
    const float* SL = WSP(float, WS_SLOC) + ((size_t)(g * 512 + b * 256) * 256 + d * 128);
    __syncthreads();
    for (int i = tid; i < 256 * 32; i += NTHR) { const int ci = i >> 5, c4 = (i & 31) * 4; *(LAS f32x4*)(S + ci * 128 + c4) = *(const f32x4*)(SL + (size_t)ci * 256 + c4); }
    __syncthreads();
    if (tid < 64) {
        const float* AQ = WSP(float, WS_AQ); const float qr = AQ[((g * 2 + d) * 64 + tid) * 2], qi = AQ[((g * 2 + d) * 64 + tid) * 2 + 1];
        float sr = 0.f, si = 0.f;
        for (int n = 0; n < 256; ++n) { const int ci = d ? 255 - n : n;
            const float tr_ = S[ci * 128 + tid], ti_ = S[ci * 128 + 64 + tid];
            S[ci * 128 + tid] = sr; S[ci * 128 + 64 + tid] = si;
            const float nr = qr * sr - qi * si + tr_, ni = qr * si + qi * sr + ti_; sr = nr; si = ni; }
    }
    __syncthreads();
    bf16* UC = WSP(bf16, A_UC) + ((size_t)(g * 512 + b * 256) * 768 + 512 + d * 128);
    for (int i = tid; i < 256 * 16; i += NTHR) { const int ci = i >> 4, c8 = (i & 15) * 8; const LAS float* s = S + ci * 128 + c8;
        v4u o; o.x = pk2(s[0], s[1]); o.y = pk2(s[2], s[3]); o.z = pk2(s[4], s[5]); o.w = pk2(s[6], s[7]);
        *(v4u*)(UC + (size_t)ci * 768 + c8) = o; }
}

__device__ __forceinline__ void unpack8(const v4u w, float (&f)[8]) { f[0] = bflo(w.x); f[1] = bfhi(w.x); f[2] = bflo(w.y); f[3] = bfhi(w.y); f[4] = bflo(w.z); f[5] = bfhi(w.z); f[6] = bflo(w.w); f[7] = bfhi(w.w); }
__device__ __forceinline__ void p2_conv(Frame& F) {
    const bf16* xbc = WSP(bf16, A_XBC); bf16* XT = WSP(bf16, A_XT); bf16* BT = WSP(bf16, A_BT); bf16* BN = WSP(bf16, A_BN); bf16* CN = WSP(bf16, A_CN);
    const float* cw = F.in[2]; const float* cb = F.in[3];
    constexpr int RUN = 32, NCG = XBC / 8, NITEM = (M / RUN) * NCG;
    for (int item = F.bid * NTHR + F.tid; item < NITEM; item += F.G * NTHR) {
        const int cg = item % NCG, r = item / NCG, ch = cg * 8, m0 = r * RUN, tb = m0 % T, bc = m0 >> 7, s0 = m0 & 127;
        float w[5][8], bias[8];
#pragma unroll
        for (int k = 0; k < 5; ++k) { const f32x4 a = *(const f32x4*)(cw + k * XBC + ch), b = *(const f32x4*)(cw + k * XBC + ch + 4); w[k][0] = a.x; w[k][1] = a.y; w[k][2] = a.z; w[k][3] = a.w; w[k][4] = b.x; w[k][5] = b.y; w[k][6] = b.z; w[k][7] = b.w; }
        { const f32x4 a = *(const f32x4*)(cb + ch), b = *(const f32x4*)(cb + ch + 4); bias[0] = a.x; bias[1] = a.y; bias[2] = a.z; bias[3] = a.w; bias[4] = b.x; bias[5] = b.y; bias[6] = b.z; bias[7] = b.w; }
        bf16* nat = nullptr; bf16* trn = nullptr;
        if (ch < SSD_IN) { trn = XT + ((size_t)(bc * SSD_H + (ch >> 6)) * 64 + (ch & 63)) * 128 + s0; }
        else if (ch < SSD_IN + 512) { const int cc = ch - SSD_IN; nat = BN + (size_t)m0 * 512 + cc; trn = BT + ((size_t)(bc * SSD_G + (cc >> 7)) * 128 + (cc & 127)) * 128 + s0; }
        else { nat = CN + (size_t)m0 * 512 + (ch - SSD_IN - 512); }
        const v4u zero4 = {0u, 0u, 0u, 0u};
        v4u win[5];
        const bf16* src = xbc + (size_t)m0 * XBC + ch;
        win[0] = (tb - 2 >= 0) ? *(const v4u*)(src - 2 * XBC) : zero4;
        win[1] = (tb - 1 >= 0) ? *(const v4u*)(src - 1 * XBC) : zero4;
        win[2] = *(const v4u*)(src);
        win[3] = *(const v4u*)(src + XBC);
#pragma unroll 1
        for (int i8 = 0; i8 < RUN / 8; ++i8) {
            float o[8][8];
#pragma unroll
            for (int ii = 0; ii < 8; ++ii) { const int i = i8 * 8 + ii;
                win[4] = (tb + i + 2 < T) ? *(const v4u*)(src + (size_t)(i + 2) * XBC) : zero4;
#pragma unroll
                for (int j = 0; j < 8; ++j) o[ii][j] = bias[j];
#pragma unroll
                for (int k = 0; k < 5; ++k) { float f[8]; unpack8(win[k], f);
#pragma unroll
                    for (int j = 0; j < 8; ++j) o[ii][j] += w[k][j] * f[j]; }
#pragma unroll
                for (int j = 0; j < 8; ++j) o[ii][j] = o[ii][j] * __builtin_amdgcn_rcpf(1.0f + __expf(-o[ii][j]));
                if (nat) { v4u q; q.x = pk2(o[ii][0], o[ii][1]); q.y = pk2(o[ii][2], o[ii][3]); q.z = pk2(o[ii][4], o[ii][5]); q.w = pk2(o[ii][6], o[ii][7]); *(v4u*)(nat + (size_t)i * 512) = q; }
                win[0] = win[1]; win[1] = win[2]; win[2] = win[3]; win[3] = win[4]; }
            if (trn) {
#pragma unroll
                for (int j = 0; j < 8; ++j) { v4u q; q.x = pk2(o[0][j], o[1][j]); q.y = pk2(o[2][j], o[3][j]); q.z = pk2(o[4][j], o[5][j]); q.w = pk2(o[6][j], o[7][j]); *(v4u*)(trn + (size_t)j * 128 + i8 * 8) = q; } }
        }
    }
    {
        const int gw = F.bid * NWAVES + F.wave, NGW = F.G * NWAVES, lane = F.lane;
        const float* DT = WSP(float, A_DT); float* SV = WSP(float, A_SV); float* TOT = WSP(float, A_TOT);
        for (int it = gw; it < 128 * SSD_H * 2; it += NGW) {
            const int d = it & 1, h = (it >> 1) % SSD_H, bc = it / (2 * SSD_H);
            const float a = -__expf((d ? F.in[5] : F.in[4])[h]);
            const size_t mb = (size_t)bc * 128;
            const float dt0 = DT[(mb + 2 * lane) * 48 + d * 24 + h], dt1 = DT[(mb + 2 * lane + 1) * 48 + d * 24 + h];
            const float x0 = dt0 * a, x1 = dt1 * a, ps = x0 + x1;
            float inc = ps;
#pragma unroll
            for (int o = 1; o < 64; o <<= 1) { const float t_ = __shfl_up(inc, o); if (lane >= o) inc += t_; }
            const float total = __shfl(inc, 63), exc = inc - ps;
            const float ci0 = exc + x0, ci1 = inc;
            float cs0, cs1, w0, w1, f0, f1;
            if (d == 0) { cs0 = ci0; cs1 = ci1; w0 = dt0 * __expf(total - ci0); w1 = dt1 * __expf(total - ci1); f0 = __expf(ci0); f1 = __expf(ci1); }
            else { cs0 = exc; cs1 = ci0; w0 = dt0 * __expf(cs0); w1 = dt1 * __expf(cs1); f0 = __expf(total - cs0); f1 = __expf(total - cs1); }
            float* sv = SV + (size_t)it * 4 * 128 + 2 * lane;
            typedef float f32x2 __attribute__((ext_vector_type(2)));
            *(f32x2*)(sv) = (f32x2){w0, w1}; *(f32x2*)(sv + 128) = (f32x2){cs0, cs1}; *(f32x2*)(sv + 256) = (f32x2){dt0, dt1}; *(f32x2*)(sv + 384) = (f32x2){f0, f1};
            if (lane == 0) TOT[it] = __expf(total);
        }
    }
}

typedef short bf16x8 __attribute__((ext_vector_type(8)));
typedef float f32x16 __attribute__((ext_vector_type(16)));
__device__ __forceinline__ unsigned cvtpk(float lo, float hi) { return pg8::cvt_pk_bf16(lo, hi); }
__device__ __forceinline__ void ssd_state_item(Frame& F, int item) {
    const int nt = item & 3, u = item >> 2, h = u % SSD_H, bc = u / SSD_H, g = h / 6, b = bc >> 6, c = bc & 63, lane = F.lane, l31 = lane & 31, hf = lane >> 5;
    const bf16* XT = WSP(bf16, A_XT) + (size_t)u * 64 * 128; const bf16* BT = WSP(bf16, A_BT) + ((size_t)(bc * SSD_G + g) * 128 + nt * 32 + l31) * 128;
    const float* SV = WSP(float, A_SV); bf16* S = WSP(bf16, A_S);
    LAS float* wl = (LAS float*)(F.lds + F.wave * 1024);
    LDS_WAIT(); asm volatile("" ::: "memory");
#pragma unroll
    for (int d = 0; d < 2; ++d) { const float* sv = SV + (size_t)(u * 2 + d) * 4 * 128; wl[d * 128 + lane] = sv[lane]; wl[d * 128 + 64 + lane] = sv[64 + lane]; }
    LDS_WAIT(); asm volatile("" ::: "memory");
    f32x16 acc[2][2];
#pragma unroll
    for (int d = 0; d < 2; ++d)
#pragma unroll
        for (int pt = 0; pt < 2; ++pt)
#pragma unroll
            for (int r = 0; r < 16; ++r) acc[d][pt][r] = 0.f;
#pragma unroll
    for (int ks = 0; ks < 8; ++ks) {
        const int sb = ks * 16 + 8 * hf;
        const v4u a = *(const v4u*)(BT + sb);
        const bf16x8 b0 = *(const bf16x8*)(XT + (size_t)l31 * 128 + sb), b1 = *(const bf16x8*)(XT + (size_t)(32 + l31) * 128 + sb);
        float af[8]; unpack8(a, af);
#pragma unroll
        for (int d = 0; d < 2; ++d) {
            const f32x4 w0 = *(const LAS f32x4*)(wl + d * 128 + sb), w1 = *(const LAS f32x4*)(wl + d * 128 + sb + 4);
            v4u aw; aw.x = cvtpk(af[0] * w0.x, af[1] * w0.y); aw.y = cvtpk(af[2] * w0.z, af[3] * w0.w); aw.z = cvtpk(af[4] * w1.x, af[5] * w1.y); aw.w = cvtpk(af[6] * w1.z, af[7] * w1.w);
            const bf16x8 av = __builtin_bit_cast(bf16x8, aw);
            acc[d][0] = __builtin_amdgcn_mfma_f32_32x32x16_bf16(av, b0, acc[d][0], 0, 0, 0);
            acc[d][1] = __builtin_amdgcn_mfma_f32_32x32x16_bf16(av, b1, acc[d][1], 0, 0, 0);
        }
    }
#pragma unroll
    for (int d = 0; d < 2; ++d) { bf16* So = S + ((size_t)((b * SSD_H + h) * 2 + d) * 64 + c) * 8192;
#pragma unroll
        for (int pt = 0; pt < 2; ++pt)
#pragma unroll
            for (int q = 0; q < 4; ++q) { v2u o; o.x = cvtpk(acc[d][pt][4 * q], acc[d][pt][4 * q + 1]); o.y = cvtpk(acc[d][pt][4 * q + 2], acc[d][pt][4 * q + 3]);
                *(v2u*)(So + (size_t)(32 * pt + l31) * 128 + nt * 32 + 8 * q + 4 * hf) = o; } }
}
__device__ __forceinline__ void ssd_scan(Frame& F, int tg, int ntg) {
    bf16* S = WSP(bf16, A_S); const float* TOT = WSP(float, A_TOT);
    for (int item = tg; item < 96 * 1024; item += ntg) {
        const int e8 = item & 1023, bhd = item >> 10, d = bhd & 1, h = (bhd >> 1) % SSD_H, b = bhd / (2 * SSD_H);
        bf16* base = S + (size_t)bhd * 64 * 8192 + e8 * 8;
        float H[8];
#pragma unroll
        for (int j = 0; j < 8; ++j) H[j] = 0.f;
#pragma unroll 1
        for (int n0 = 0; n0 < 64; n0 += 8) {
            v4u v[8]; float dec[8];
#pragma unroll
            for (int k = 0; k < 8; ++k) { const int c = d ? 63 - (n0 + k) : n0 + k; v[k] = *(const v4u*)(base + (size_t)c * 8192); dec[k] = TOT[((b * 64 + c) * SSD_H + h) * 2 + d]; }
#pragma unroll
            for (int k = 0; k < 8; ++k) { const int c = d ? 63 - (n0 + k) : n0 + k; float f[8]; unpack8(v[k], f);
                v4u o; o.x = cvtpk(H[0], H[1]); o.y = cvtpk(H[2], H[3]); o.z = cvtpk(H[4], H[5]); o.w = cvtpk(H[6], H[7]);
                *(v4u*)(base + (size_t)c * 8192) = o;
#pragma unroll
                for (int j = 0; j < 8; ++j) H[j] = H[j] * dec[k] + f[j]; }
        }
    }
}
__device__ __forceinline__ void ssd_out_unit(Frame& F, int unit) {
    int lane = F.lane; asm volatile("" : "+v"(lane));
    const int g = unit & 3, bc = unit >> 2, b = bc >> 6, c = bc & 63, l31 = lane & 31, hf = lane >> 5, j = F.wave & 3, hh = F.wave >> 2;
    const size_t mb = (size_t)bc * 128;
    const bf16* CN = WSP(bf16, A_CN) + (mb + 32 * j + l31) * 512 + g * 128 + 8 * hf;
    const bf16* BN = WSP(bf16, A_BN) + (mb + l31) * 512 + g * 128 + 8 * hf;
    const float* SV = WSP(float, A_SV); const bf16* S = WSP(bf16, A_S); const bf16* XT = WSP(bf16, A_XT); bf16* Y = WSP(bf16, A_Y);
    LAS float* svl = (LAS float*)(F.lds + F.wave * 12288);
    asm volatile("" : "+v"(CN), "+v"(BN));
    LDS_WAIT(); asm volatile("" ::: "memory");
    {
        const f32x4* src = (const f32x4*)(SV + (size_t)((bc * SSD_H + g * 6 + hh * 3) * 2) * 512) + lane;
#pragma unroll
        for (int q = 0; q < 12; ++q) *(LAS f32x4*)(svl + (q * 64 + lane) * 4) = src[q * 64];
    }
    f32x16 cbt[4];
    {   bf16x8 cfr[8];
#pragma unroll
        for (int ks = 0; ks < 8; ++ks) cfr[ks] = *(const bf16x8*)(CN + ks * 16);
#pragma unroll
        for (int i = 0; i < 4; ++i) {
#pragma unroll
            for (int r = 0; r < 16; ++r) cbt[i][r] = 0.f;
#pragma unroll
            for (int ks = 0; ks < 8; ++ks) { const bf16x8 a = *(const bf16x8*)(BN + (size_t)(32 * i) * 512 + ks * 16); cbt[i] = __builtin_amdgcn_mfma_f32_32x32x16_bf16(a, cfr[ks], cbt[i], 0, 0, 0); }
            asm volatile("" ::: "memory");
        }
    }
    LDS_WAIT(); asm volatile("" ::: "memory");
    const int tl = 32 * j + l31;
#pragma unroll 1
    for (int i3 = 0; i3 < 3; ++i3) {
        const int h = g * 6 + hh * 3 + i3;
        const LAS float* vf = svl + (i3 * 2 + 0) * 512 + 128; const LAS float* vb = svl + (i3 * 2 + 1) * 512 + 128;
        const float csf_t = vf[tl], sf_t = vf[256 + tl], ecsb_t = vb[tl], sb_t = vb[256 + tl], Dh = F.in[8][h];
        int tlv = tl; asm volatile("" : "+v"(tlv));
        f32x16 acc[2];
        {
            const bf16* Hf = S + ((size_t)((b * SSD_H + h) * 2 + 0) * 64 + c) * 8192 + (size_t)l31 * 128 + 8 * hf; const bf16* Hb = Hf + (size_t)64 * 8192;
            const bf16* cn = CN; asm volatile("" : "+v"(Hf), "+v"(Hb), "+v"(cn));
            bf16x8 cfr[8];
#pragma unroll
            for (int ks = 0; ks < 8; ++ks) cfr[ks] = *(const bf16x8*)(cn + ks * 16);
#pragma unroll
            for (int pt = 0; pt < 2; ++pt) { f32x16 af;
#pragma unroll
                for (int r = 0; r < 16; ++r) af[r] = 0.f;
#pragma unroll
                for (int ks = 0; ks < 8; ++ks) { const bf16x8 a0 = *(const bf16x8*)(Hf + (size_t)(32 * pt) * 128 + ks * 16); af = __builtin_amdgcn_mfma_f32_32x32x16_bf16(a0, cfr[ks], af, 0, 0, 0); }
#pragma unroll
                for (int r = 0; r < 16; ++r) acc[pt][r] = af[r] * sf_t;
                asm volatile("" ::: "memory");
#pragma unroll
                for (int r = 0; r < 16; ++r) af[r] = 0.f;
#pragma unroll
                for (int ks = 0; ks < 8; ++ks) { const bf16x8 a1 = *(const bf16x8*)(Hb + (size_t)(32 * pt) * 128 + ks * 16); af = __builtin_amdgcn_mfma_f32_32x32x16_bf16(a1, cfr[ks], af, 0, 0, 0); }
#pragma unroll
                for (int r = 0; r < 16; ++r) acc[pt][r] += af[r] * sb_t;
                asm volatile("" ::: "memory"); }
        }
        const bf16* xt = XT + ((size_t)(bc * SSD_H + h) * 64 + l31) * 128 + 4 * hf;
        asm volatile("" : "+v"(xt));
#pragma unroll
        for (int i = 0; i < 4; ++i) {
#pragma unroll
            for (int k2 = 0; k2 < 2; ++k2) {
                const int sA = 32 * i + 16 * k2 + 4 * hf;
                float mv[8];
                if (i < j) {
                    const f32x4 c0 = *(const LAS f32x4*)(vf + sA), c1 = *(const LAS f32x4*)(vf + sA + 8), d0 = *(const LAS f32x4*)(vf + 128 + sA), d1 = *(const LAS f32x4*)(vf + 128 + sA + 8);
#pragma unroll
                    for (int e = 0; e < 4; ++e) { mv[e] = cbt[i][8 * k2 + e] * (d0[e] * __expf(fminf(csf_t - c0[e], 0.f))); mv[4 + e] = cbt[i][8 * k2 + 4 + e] * (d1[e] * __expf(fminf(csf_t - c1[e], 0.f))); }
                } else if (i > j) {
                    const f32x4 c0 = *(const LAS f32x4*)(vb + sA), c1 = *(const LAS f32x4*)(vb + sA + 8), d0 = *(const LAS f32x4*)(vb + 128 + sA), d1 = *(const LAS f32x4*)(vb + 128 + sA + 8);
#pragma unroll
                    for (int e = 0; e < 4; ++e) { mv[e] = cbt[i][8 * k2 + e] * (d0[e] * __expf(fminf(c0[e] - ecsb_t, 0.f))); mv[4 + e] = cbt[i][8 * k2 + 4 + e] * (d1[e] * __expf(fminf(c1[e] - ecsb_t, 0.f))); }
                } else {
                    const f32x4 c0 = *(const LAS f32x4*)(vf + sA), c1 = *(const LAS f32x4*)(vf + sA + 8), d0 = *(const LAS f32x4*)(vf + 128 + sA), d1 = *(const LAS f32x4*)(vf + 128 + sA + 8);
                    const f32x4 g0 = *(const LAS f32x4*)(vb + sA), g1 = *(const LAS f32x4*)(vb + sA + 8), h0 = *(const LAS f32x4*)(vb + 128 + sA), h1 = *(const LAS f32x4*)(vb + 128 + sA + 8);
#pragma unroll
                    for (int e = 0; e < 8; ++e) { const int s_ = sA + (e & 3) + 8 * (e >> 2); const float cf = e < 4 ? c0[e & 3] : c1[e & 3], df = e < 4 ? d0[e & 3] : d1[e & 3], cb_ = e < 4 ? g0[e & 3] : g1[e & 3], db = e < 4 ? h0[e & 3] : h1[e & 3];
                        float f = 0.f;
                        f += (s_ <= tlv) ? df * __expf(fminf(csf_t - cf, 0.f)) : 0.f;
                        f += (s_ >= tlv) ? db * __expf(fminf(cb_ - ecsb_t, 0.f)) : 0.f;
                        mv[e] = cbt[i][8 * k2 + e] * f + ((s_ == tlv) ? Dh : 0.f); }
                }
                v4u mw; mw.x = cvtpk(mv[0], mv[1]); mw.y = cvtpk(mv[2], mv[3]); mw.z = cvtpk(mv[4], mv[5]); mw.w = cvtpk(mv[6], mv[7]);
                const bf16x8 mfr = __builtin_bit_cast(bf16x8, mw);
#pragma unroll
                for (int pt = 0; pt < 2; ++pt) { const v2u x0 = *(const v2u*)(xt + (size_t)(32 * pt) * 128 + 32 * i + 16 * k2), x1 = *(const v2u*)(xt + (size_t)(32 * pt) * 128 + 32 * i + 16 * k2 + 8);
                    v4u xw; xw.x = x0.x; xw.y = x0.y; xw.z = x1.x; xw.w = x1.y;
                    acc[pt] = __builtin_amdgcn_mfma_f32_32x32x16_bf16(__builtin_bit_cast(bf16x8, xw), mfr, acc[pt], 0, 0, 0); }
                asm volatile("" ::: "memory");
            }
        }
        bf16* yo = Y + (mb + tl) * SSD_IN + h * 64 + 4 * hf;
        asm volatile("" : "+v"(yo));
#pragma unroll
        for (int pt = 0; pt < 2; ++pt)
#pragma unroll
            for (int q = 0; q < 4; ++q) { v2u o; o.x = cvtpk(acc[pt][4 * q], acc[pt][4 * q + 1]); o.y = cvtpk(acc[pt][4 * q + 2], acc[pt][4 * q + 3]); *(v2u*)(yo + 32 * pt + 8 * q) = o; }
    }
}

__device__ __forceinline__ void p4_combine(Frame& F) {
    const int gw = F.bid * NWAVES + F.wave, NGW = F.G * NWAVES, lane = F.lane;
    bf16* Y = WSP(bf16, A_Y); const bf16* Z = WSP(bf16, A_Z); const float* ng = F.in[9];
    for (int m = gw; m < M; m += NGW) {
#pragma unroll 1
        for (int gi = 0; gi < SSD_G; ++gi) {
            const int ch = gi * 384 + lane * 8; float y[8]; float ss = 0.f;
            if (lane < 48) { const size_t o = (size_t)m * SSD_IN + ch; float a[8], z[8]; unpack8(*(const v4u*)(Y + o), a); unpack8(*(const v4u*)(Z + o), z);
#pragma unroll
                for (int jj = 0; jj < 8; ++jj) { y[jj] = a[jj] * z[jj]; ss += y[jj] * y[jj]; } }
            ss = wave_sum(ss);
            const float r = 1.0f / sqrtf(ss * (1.0f / 384.0f) + RMS_EPS);
            if (lane < 48) { const f32x4 g0 = *(const f32x4*)(ng + ch), g1 = *(const f32x4*)(ng + ch + 4);
                v4u o; o.x = pk2(y[0] * r * g0.x, y[1] * r * g0.y); o.y = pk2(y[2] * r * g0.z, y[3] * r * g0.w); o.z = pk2(y[4] * r * g1.x, y[5] * r * g1.y); o.w = pk2(y[6] * r * g1.z, y[7] * r * g1.w);
                *(v4u*)(Y + (size_t)m * SSD_IN + ch) = o; }
        }
    }
}

__device__ __forceinline__ void p8_ln_router(Frame& F) {
    const int gw = F.bid * NWAVES + F.wave, NGW = F.G * NWAVES, lane = F.lane;
    LAS float* wr = (LAS float*)F.lds;
    for (int i = F.tid; i < D * NE; i += NTHR) wr[(i & 15) * D + (i >> 4)] = F.in[27][i];
    __syncthreads();
    const float* HP = WSP(float, A_HP); float* H = WSP(float, A_H); bf16* HB = WSP(bf16, A_HB); float* AFF = WSP(float, A_AFF);
    const float* g1 = F.in[25]; const float* b1 = F.in[26];
    for (int m = gw; m < M; m += NGW) {
        const f32x4* xr = (const f32x4*)(HP + (size_t)m * D) + lane;
        f32x4 v[4]; float s = 0.f;
#pragma unroll
        for (int j = 0; j < 4; ++j) { v[j] = xr[64 * j]; s += (v[j].x + v[j].y) + (v[j].z + v[j].w); }
        const float mean = wave_sum(s) * (1.f / D); float s2 = 0.f;
#pragma unroll
        for (int j = 0; j < 4; ++j) { v[j] = v[j] - mean; s2 += (v[j].x * v[j].x + v[j].y * v[j].y) + (v[j].z * v[j].z + v[j].w * v[j].w); }
        const float rstd = 1.f / sqrtf(wave_sum(s2) * (1.f / D) + LN_EPS);
        float lg[16];
#pragma unroll
        for (int e = 0; e < 16; ++e) lg[e] = 0.f;
#pragma unroll
        for (int j = 0; j < 4; ++j) { const int c = 4 * lane + 256 * j; const f32x4 gg = *(const f32x4*)(g1 + c), bb = *(const f32x4*)(b1 + c);
            v[j] = v[j] * rstd * gg + bb;
            *((f32x4*)(H + (size_t)m * D) + lane + 64 * j) = v[j];
            v2u hb; hb.x = pk2(v[j].x, v[j].y); hb.y = pk2(v[j].z, v[j].w); *((v2u*)(HB + (size_t)m * D) + lane + 64 * j) = hb;
#pragma unroll
            for (int e = 0; e < 16; ++e) { const f32x4 w4 = *(const LAS f32x4*)(wr + e * D + c); lg[e] += (v[j].x * w4.x + v[j].y * w4.y) + (v[j].z * w4.z + v[j].w * w4.w); }
            asm volatile("" ::: "memory"); }
        { const bool hi = lane & 32;
#pragma unroll
          for (int k = 0; k < 8; ++k) { const float keep = hi ? lg[k + 8] : lg[k], send = hi ? lg[k] : lg[k + 8]; lg[k] = keep + __shfl_xor(send, 32); } }
        { const bool hi = lane & 16;
#pragma unroll
          for (int k = 0; k < 4; ++k) { const float keep = hi ? lg[k + 4] : lg[k], send = hi ? lg[k] : lg[k + 4]; lg[k] = keep + __shfl_xor(send, 16); } }
        { const bool hi = lane & 8;
#pragma unroll
          for (int k = 0; k < 2; ++k) { const float keep = hi ? lg[k + 2] : lg[k], send = hi ? lg[k] : lg[k + 2]; lg[k] = keep + __shfl_xor(send, 8); } }
        { const bool hi = lane & 4; const float keep = hi ? lg[1] : lg[0], send = hi ? lg[0] : lg[1]; lg[0] = keep + __shfl_xor(send, 4); }
        float lo = lg[0]; lo += __shfl_xor(lo, 2); lo += __shfl_xor(lo, 1);
        float mx = lo;
#pragma unroll
        for (int o = 4; o < 64; o <<= 1) mx = fmaxf(mx, __shfl_xor(mx, o));
        const float ex = expf(lo - mx); float sum = ex;
#pragma unroll
        for (int o = 4; o < 64; o <<= 1) sum += __shfl_xor(sum, o);
        if ((lane & 3) == 0) { const int e = lane >> 2, b = m / T, t = m % T; AFF[((size_t)b * NE + e) * T + t] = ex / sum; }
    }
}

__device__ __forceinline__ unsigned block_excl_scan(unsigned v, LAS unsigned* wsum  , int lane, int wave, unsigned& total) {
    unsigned inc = v;
#pragma unroll
    for (int o = 1; o < 64; o <<= 1) { const unsigned t = __shfl_up(inc, o); if (lane >= o) inc += t; }
    __syncthreads();
    if (lane == 63) wsum[wave] = inc;
    __syncthreads();
    unsigned off = 0, tot = 0;
#pragma unroll
    for (int w = 0; w < 8; ++w) { const unsigned s = wsum[w]; if (w < wave) off += s; tot += s; }
    total = tot; return off + inc - v;
}
__device__ __forceinline__ void p9_topk(Frame& F, int be) {
    const int b = be >> 4, e = be & 15, tid = F.tid;
    const float* av = WSP(float, A_AFF) + (size_t)be * T;
    int* IDX = WSP(int, A_IDX); int* SEL = WSP(int, A_SEL); float* GATE = WSP(float, A_GATE);
    LAS unsigned* hist = (LAS unsigned*)F.lds; LAS unsigned* shv = hist + 256; LAS unsigned* wsum = hist + 272;
    unsigned key[16];
#pragma unroll
    for (int q = 0; q < 4; ++q) { const v4u k4 = *(const v4u*)(av + tid * 16 + 4 * q); key[4 * q] = k4.x; key[4 * q + 1] = k4.y; key[4 * q + 2] = k4.z; key[4 * q + 3] = k4.w; }
    unsigned prefix = 0, pmask = 0, krem = CAP;
    for (int pass = 0; pass < 4; ++pass) {
        const int shift = 24 - 8 * pass;
        if (tid < 256) hist[tid] = 0u;
        __syncthreads();
#pragma unroll
        for (int i = 0; i < 16; ++i) if ((key[i] & pmask) == prefix) (void)__hip_atomic_fetch_add(&hist[(key[i] >> shift) & 255u], 1u, __ATOMIC_RELAXED, __HIP_MEMORY_SCOPE_WORKGROUP);
        __syncthreads();
        if (tid < 256) { unsigned above = 0; for (int d = tid + 1; d < 256; ++d) above += hist[d]; const unsigned mine = hist[tid];
            if (above < krem && krem <= above + mine) { shv[0] = (unsigned)tid; shv[1] = krem - above; } }
        __syncthreads();
        prefix |= shv[0] << shift; pmask |= 255u << shift; krem = shv[1];
        __syncthreads();
    }
    const unsigned Tk = prefix;
    unsigned cg = 0, ce = 0;
#pragma unroll
    for (int i = 0; i < 16; ++i) { cg += key[i] > Tk; ce += key[i] == Tk; }
    unsigned totg, tote;
    unsigned pg = block_excl_scan(cg, wsum, F.lane, F.wave, totg);
    unsigned pe = block_excl_scan(ce, wsum + 8, F.lane, F.wave, tote);
#pragma unroll
    for (int i = 0; i < 16; ++i) {
        const int t = tid * 16 + i; int slot = -1;
        if (key[i] > Tk) slot = (int)(pg++);
        else if (key[i] == Tk) { if (pe < krem) slot = (int)(totg + pe); ++pe; }
        const size_t m = (size_t)b * T + t;
        SEL[m * NE + e] = slot; GATE[m * NE + e] = __uint_as_float(key[i]);
        if (slot >= 0) IDX[(e * NB + b) * CAP + slot] = (int)m;
    }
}
__device__ __forceinline__ void p10_gather(Frame& F) {
    const int gw = F.bid * NWAVES + F.wave, NGW = F.G * NWAVES, lane = F.lane;
    const int* IDX = WSP(int, A_IDX); const bf16* HB = WSP(bf16, A_HB); bf16* XIN = WSP(bf16, A_XIN);
    for (int r = gw; r < MROWS; r += NGW) { const int m = IDX[r];
        const v4u* s = (const v4u*)(HB + (size_t)m * D); v4u* d = (v4u*)(XIN + (size_t)r * D);
        const v4u a = s[lane], bq = s[lane + 64]; d[lane] = a; d[lane + 64] = bq; }
}
__device__ __forceinline__ void p13_final(Frame& F) {
    const int gw = F.bid * NWAVES + F.wave, NGW = F.G * NWAVES, lane = F.lane;
    const float* H = WSP(float, A_H); const int* SEL = WSP(int, A_SEL); const float* GATE = WSP(float, A_GATE); const bf16* YE = WSP(bf16, A_YE);
    const float* g2 = F.in[31]; const float* b2 = F.in[32];
    for (int m = gw; m < M; m += NGW) {
        const int b = m / T;
        const int sl = SEL[(size_t)m * NE + (lane & 15)]; const float gt = GATE[(size_t)m * NE + (lane & 15)];
        f32x4 v[4];
#pragma unroll
        for (int j = 0; j < 4; ++j) v[j] = *((const f32x4*)(H + (size_t)m * D) + lane + 64 * j) * ALPHA;
#pragma unroll 1
        for (int e = 0; e < NE; ++e) {
            const int s = __shfl(sl, e); const float gv = __shfl(gt, e);
            if (s >= 0) { const bf16* yr = YE + ((size_t)(e * NB + b) * CAP + s) * D;
#pragma unroll
                for (int j = 0; j < 4; ++j) { const v2u w = *((const v2u*)yr + lane + 64 * j); v[j].x += gv * bflo(w.x); v[j].y += gv * bfhi(w.x); v[j].z += gv * bflo(w.y); v[j].w += gv * bfhi(w.y); } }
        }
        float s = 0.f;
#pragma unroll
        for (int j = 0; j < 4; ++j) s += (v[j].x + v[j].y) + (v[j].z + v[j].w);
        const float mean = wave_sum(s) * (1.f / D); float s2 = 0.f;
#pragma unroll
        for (int j = 0; j < 4; ++j) { v[j] = v[j] - mean; s2 += (v[j].x * v[j].x + v[j].y * v[j].y) + (v[j].z * v[j].z + v[j].w * v[j].w); }
        const float rstd = 1.f / sqrtf(wave_sum(s2) * (1.f / D) + LN_EPS);
#pragma unroll
        for (int j = 0; j < 4; ++j) { const int c = 4 * lane + 256 * j; const f32x4 gg = *(const f32x4*)(g2 + c), bb = *(const f32x4*)(b2 + c);
            *((f32x4*)(F.out + (size_t)m * D) + lane + 64 * j) = v[j] * rstd * gg + bb; }
    }
}

constexpr int N_PHASES = 16;
struct Args { const float* in[33]; float* out; unsigned char* ws; int ph_lo, ph_hi; };
__global__ void __launch_bounds__(NTHR, 2) fwd(Args args) {
    extern __shared__ __attribute__((aligned(16))) unsigned char lds[];
    Frame F;
    F.lds = (LAS unsigned char*)lds;
    F.tid = threadIdx.x; F.lane = F.tid & 63; F.wave = __builtin_amdgcn_readfirstlane(F.tid >> 6);
    F.bid = blockIdx.x; F.G = gridDim.x;
    F.in = args.in;
    F.out = args.out; F.ws = args.ws;
    volatile LAS unsigned* MISC = (volatile LAS unsigned*)(F.lds + MISC_OFF);
    if (F.tid < 64) MISC[F.tid] = 0u;
    __syncthreads();
    const int lo = args.ph_lo, hi = args.ph_hi;
    const bool single = (hi - lo) > 1;
    XcdBarrier bar; bar.bar = (unsigned*)(F.ws + WS_CTL) + CW_BAR; bar.x = 0; bar.st = nullptr;
    if (single) bar = xcd_barrier_post((unsigned*)(F.ws + WS_CTL) + CW_BAR, MISC + 8);
#ifndef PH_MASK
#define PH_MASK 0xffff
#endif
#define IN(k) (((PH_MASK >> (k)) & 1) && lo <= (k) && (k) < hi)
#define LAUNDER1(T_, p_) do { unsigned long long x_ = (unsigned long long)(p_); unsigned lo_ = (unsigned)x_, hi_ = (unsigned)(x_ >> 32); asm volatile("" : "+v"(lo_), "+v"(hi_)); \
        lo_ = __builtin_amdgcn_readfirstlane(lo_); hi_ = __builtin_amdgcn_readfirstlane(hi_); (p_) = (T_)(((unsigned long long)hi_ << 32) | lo_); } while (0)
#define LAUNDER() do { } while (0)
#define SEAM(k) do { if (IN(k) && IN((k) + 1)) xcd_barrier(bar); } while (0)

    if (IN(0)) { LAUNDER(); p0_prologue(F); p0_s5(F); } SEAM(0);
    if (IN(1)) { LAUNDER();
        pg8::Gemm g{WSP(pg8::bf16_t, A_XB), WSP(pg8::bf16_t, WS_WIN), M, NIN_PAD, D, D, D}; pg8::StaticOrder S; S.init(M, NIN_PAD, F.G, F.bid);
        pg8::EpiIn E{WSP(pg8::bf16_t, A_Z), WSP(pg8::bf16_t, A_XBC), WSP(pg8::bf16_t, A_UC), WSP(pg8::bf16_t, A_GT), WSP(float, A_DT), F.in[6], F.in[7]};
        pg8::gemm_phase<pg8::EpiIn, pg8::StaticOrder, PG8_ALIGN, PG8_SP2>(F.lds, g, S, E);
    } SEAM(1);
    if (IN(2)) { LAUNDER();
        if (F.bid >= 160) { pg8::Gemm g{WSP(pg8::bf16_t, A_UC), WSP(pg8::bf16_t, WS_WS5), S5_G * 512, S5_G * 256, 512, 768, 512}; pg8::S5aOrder S{F.bid, 160};
            pg8::EpiS5a E{WSP(float, WS_SLOC)};
            pg8::gemm_phase<pg8::EpiS5a, pg8::S5aOrder, PG8_ALIGN, PG8_SP2>(F.lds, g, S, E); __syncthreads(); }
        p2_conv(F);
    } SEAM(2);
    if (IN(3)) { LAUNDER();
        for (int it = F.bid; it < S5_G * 4; it += F.G) s5_scan_item(F, it);
        __syncthreads();
        for (int it = F.bid * NWAVES + F.wave; it < 128 * SSD_H * 4; it += F.G * NWAVES) ssd_state_item(F, it);
    } SEAM(3);
    if (IN(4)) { LAUNDER();
        { pg8::Gemm g{WSP(pg8::bf16_t, A_UC), WSP(pg8::bf16_t, WS_TV), S5_G * 512, S5_G * 512, 768, 768, 768}; pg8::S5cOrder S{F.G, F.bid};
          pg8::EpiS5c E{WSP(pg8::bf16_t, A_GY), WSP(pg8::bf16_t, A_UC), F.in[21]};
          pg8::gemm_phase<pg8::EpiS5c, pg8::S5cOrder, PG8_ALIGN, PG8_SP2>(F.lds, g, S, E); }
        ssd_scan(F, F.bid * NTHR + F.tid, F.G * NTHR);
    } SEAM(4);
    if (IN(5)) { LAUNDER(); __syncthreads(); for (int u = F.bid; u < 128 * SSD_G; u += F.G) ssd_out_unit(F, u); } SEAM(5);
    if (IN(6)) { LAUNDER(); p4_combine(F); } SEAM(6);
    if (IN(7)) { LAUNDER();
        pg8::Gemm g{WSP(pg8::bf16_t, A_Y), WSP(pg8::bf16_t, WS_WOUT), M, D, SSD_IN, SSD_IN, SSD_IN}; pg8::StaticOrder S; S.init(M, D, F.G, F.bid);
        pg8::EpiSsdOut E{WSP(float, A_YA), WSP(pg8::bf16_t, A_GT)};
        pg8::gemm_phase<pg8::EpiSsdOut, pg8::StaticOrder, PG8_ALIGN, PG8_SP2>(F.lds, g, S, E);
    } SEAM(7);
    if (IN(8)) { LAUNDER();
        pg8::Gemm g{WSP(pg8::bf16_t, A_GY), WSP(pg8::bf16_t, WS_WGLU), M, 2 * D, S5_W, S5_W, S5_W}; pg8::StaticOrder S; S.init(M, 2 * D, F.G, F.bid);
        pg8::EpiGlu E{WSP(pg8::bf16_t, A_MIX), WSP(float, A_YA), WSP(pg8::bf16_t, A_GT)};
        pg8::gemm_phase<pg8::EpiGlu, pg8::StaticOrder, PG8_ALIGN, PG8_SP2>(F.lds, g, S, E);
    } SEAM(8);
    if (IN(9)) { LAUNDER();
        pg8::Gemm g{WSP(pg8::bf16_t, A_MIX), WSP(pg8::bf16_t, WS_WO), M, D, D, D, D}; pg8::StaticOrder S; S.init(M, D, F.G, F.bid);
        pg8::EpiWo E{WSP(float, A_HP), F.in[0], ALPHA};
        pg8::gemm_phase<pg8::EpiWo, pg8::StaticOrder, PG8_ALIGN, PG8_SP2>(F.lds, g, S, E);
    } SEAM(9);
    if (IN(10)) { LAUNDER(); p8_ln_router(F); } SEAM(10);
    if (IN(11)) { LAUNDER(); if (F.bid < NB * NE) p9_topk(F, F.bid); else w2_convert(F, (F.bid - NB * NE) * NWAVES + F.wave, (F.G - NB * NE) * NWAVES); } SEAM(11);
    if (IN(12)) { LAUNDER(); p10_gather(F); } SEAM(12);
    if (IN(13)) { LAUNDER();
        pg8::Gemm g{WSP(pg8::bf16_t, A_XIN), WSP(pg8::bf16_t, WS_W1), MROWS, NE * 2 * FF, D, D, D}; pg8::MoeOrder1 S{F.G, F.bid};
        pg8::EpiMoe1 E{WSP(pg8::bf16_t, A_HID)};
        pg8::gemm_phase<pg8::EpiMoe1, pg8::MoeOrder1, PG8_ALIGN, PG8_SP2>(F.lds, g, S, E);
    } SEAM(13);
    if (IN(14)) { LAUNDER();
        pg8::Gemm g{WSP(pg8::bf16_t, A_HID), WSP(pg8::bf16_t, WS_W2), MROWS, NE * D, FF, FF, FF}; pg8::MoeOrder2 S{F.G, F.bid};
        pg8::EpiMoe2 E{WSP(pg8::bf16_t, A_YE)};
        pg8::gemm_phase<pg8::EpiMoe2, pg8::MoeOrder2, PG8_ALIGN, PG8_SP2>(F.lds, g, S, E);
    } SEAM(14);
    if (IN(15)) { LAUNDER(); p13_final(F); }
#undef IN
#undef SEAM
}

#ifndef MK_ONE_LAUNCH
#define MK_ONE_LAUNCH 1
#endif
extern "C" void kernel_launch(void* const* d_in, const int* in_sizes, int n_in, void* d_out, int out_size, void* d_ws, size_t ws_size, hipStream_t stream) {
    static int grid = 0;
    if (grid == 0) {
        if (n_in != 33 || in_sizes[0] != M * D || out_size != M * D || ws_size < WS_END) { fprintf(stderr, "kernel_launch: unexpected problem (n_in %d, in0 %d, out %d, ws %zu < %zu)\n", n_in, n_in > 0 ? in_sizes[0] : -1, out_size, ws_size, (size_t)WS_END); grid = -1; return; }
        int dev = 0, cus = 0, per_cu = 0;
        if (hipGetDevice(&dev) != hipSuccess || hipDeviceGetAttribute(&cus, hipDeviceAttributeMultiprocessorCount, dev) != hipSuccess) { grid = -1; return; }
        if (hipFuncSetAttribute((const void*)fwd, hipFuncAttributeMaxDynamicSharedMemorySize, LDS_BYTES) != hipSuccess) { fprintf(stderr, "kernel_launch: hipFuncSetAttribute failed\n"); grid = -1; return; }
        if (hipOccupancyMaxActiveBlocksPerMultiprocessor(&per_cu, (const void*)fwd, NTHR, LDS_BYTES) != hipSuccess || per_cu < 1) fprintf(stderr, "kernel_launch: occupancy query reports %d blocks per CU\n", per_cu);
        (void)hipGetLastError();
        grid = cus;
    }
    if (grid < 0) return;
    (void)hipMemsetAsync((char*)d_ws + WS_CTL, 0, CTL_ZERO_BYTES, stream);
    Args a{};
    for (int i = 0; i < 33; ++i) a.in[i] = (const float*)d_in[i];
    a.out = (float*)d_out; a.ws = (unsigned char*)d_ws;
#if MK_ONE_LAUNCH
    a.ph_lo = 0; a.ph_hi = N_PHASES;
    hipLaunchKernelGGL(fwd, dim3(grid), dim3(NTHR), LDS_BYTES, stream, a);
#else
    for (int p = 0; p < N_PHASES; ++p) { a.ph_lo = p; a.ph_hi = p + 1; hipLaunchKernelGGL(fwd, dim3(grid), dim3(NTHR), LDS_BYTES, stream, a); }
#endif
}
```

```cpp
#include <hip/hip_runtime.h>
#include <cstdio>
#include <cstdint>
namespace pg8 {
#define PG8_LAS __attribute__((address_space(3)))
typedef unsigned short bf16_t;
typedef short bf16x8 __attribute__((ext_vector_type(8)));
typedef float f32x4 __attribute__((ext_vector_type(4)));
typedef unsigned u32x4 __attribute__((ext_vector_type(4)));
constexpr int BM = 256, BK = 64, HALF = 128, HTB = HALF * BK * 2  , STAGE_BYTES = 8 * HTB, NXCD = 8, WGM = 8;

__host__ __device__ __forceinline__ int lds_byte(int r, int c) { const int st = (r >> 4) * 2 + (c >> 5), rr = r & 15, cc = c & 31, ob = rr * 64 + cc * 2; return st * 1024 + (ob ^ (((ob >> 9) & 1) << 5)); }
__host__ __device__ __forceinline__ void stage_rc(int b, int& R, int& C) { const int st = b / 1024, sb = b % 1024, swz = sb ^ (((sb >> 9) & 1) << 5); R = (st >> 1) * 16 + swz / 64; C = (st & 1) * 32 + (swz % 64) / 2; }
__host__ __device__ __forceinline__ int perm32(int rho) { const int n = rho >> 4, i = rho & 15; return 8 * (i >> 2) + 4 * n + (i & 3); }

struct Unit { int pm, pn; };
struct Gemm { const bf16_t* A; const bf16_t* Bt; int M, N, K, lda, ldb; };

struct StaticOrder {
    int nM, nN, nwg, G, c;
    __host__ __device__ void init(int M, int N, int G_, int c_) { nM = M / BM; nN = N / BM; nwg = nM * nN; G = G_; c = c_; }
    __host__ __device__ bool next(int i, Unit& u) const {
        const long L = (long)i * G + c; if (L >= nwg) return false;
        int wgid = (int)L; { const int q = nwg / NXCD, r = nwg % NXCD, xcd = wgid % NXCD, off = wgid / NXCD; wgid = (xcd < r ? xcd * (q + 1) : r * (q + 1) + (xcd - r) * q) + off; }
        const int nig = WGM * nN, gid = wgid / nig, fm = gid * WGM, gsz = (nM - fm) < WGM ? (nM - fm) : WGM;
        u.pm = fm + ((wgid % nig) % gsz); u.pn = (wgid % nig) / gsz; return true;
    }
    __device__ __forceinline__ void a_ready(const Unit&) const {}
    __device__ __forceinline__ void done(const Unit&) const {}
};

typedef __bf16 bf16v2_t __attribute__((ext_vector_type(2)));
typedef float f32v2_t __attribute__((ext_vector_type(2)));
__device__ __forceinline__ unsigned cvt_pk_bf16(float lo, float hi) { const f32v2_t f = {lo, hi}; return __builtin_bit_cast(unsigned, __builtin_convertvector(f, bf16v2_t)); }
typedef float f32x2 __attribute__((ext_vector_type(2)));
__device__ __forceinline__ f32x2 gelu_pk(f32x2 v) {
    const f32x2 av = __builtin_elementwise_abs(v), d = av * 0.2316418882f + 1.0f;
    f32x2 t; t.x = __builtin_amdgcn_rcpf(d.x); t.y = __builtin_amdgcn_rcpf(d.y);
    f32x2 q = t * 0.5307027145f + (-0.7265760135f); q = q * t + 0.7107068705f; q = q * t + (-0.142248368f); q = q * t + 0.127414796f; q = q * t;
    const f32x2 s = (v * v) * (-0.72134752044f);
    f32x2 e; e.x = __builtin_amdgcn_exp2f(s.x); e.y = __builtin_amdgcn_exp2f(s.y);
    const f32x2 m = v * (q * e), r = v - m;
    f32x2 o; o.x = v.x < 0.f ? m.x : r.x; o.y = v.y < 0.f ? m.y : r.y; return o;
}


__device__ __forceinline__ float fsigmoid(float x) { return __builtin_amdgcn_rcpf(1.0f + __expf(-x)); }
__device__ __forceinline__ float fsilu(float x) { return x * fsigmoid(x); }
__device__ __forceinline__ float bf_lo(unsigned w) { return __uint_as_float(w << 16); }
__device__ __forceinline__ float bf_hi(unsigned w) { return __uint_as_float(w & 0xffff0000u); }
typedef unsigned u32x2 __attribute__((ext_vector_type(2)));

struct EpiIn {
    static constexpr bool PERM = true, AFTER_DRAIN = false;
    bf16_t *Z, *XBC, *UC, *GT; float* DT; const float *dtb_f, *dtb_b;
    __device__ __forceinline__ void operator()(const f32x4 (&acc)[2][2][4][2], const Unit& u, int wr, int wc, int fr, int fq) const {
        const int row0 = u.pm * BM + wr * 64 + fr; const int pn = u.pn;
        if (pn == 16) {
            if (wc < 2) {
#pragma unroll
                for (int n = 0; n < 2; ++n) { const int col = wc * 32 + 8 * fq + 4 * n;
                    if (col < 48) { f32x4 bv;
#pragma unroll
                        for (int j = 0; j < 4; ++j) { const int cc = col + j; bv[j] = cc < 24 ? dtb_f[cc] : dtb_b[cc - 24]; }
#pragma unroll
                        for (int ai = 0; ai < 2; ++ai)
#pragma unroll
                            for (int m = 0; m < 4; ++m) { f32x4 v = acc[ai][0][m][n] + bv;
#pragma unroll
                                for (int j = 0; j < 4; ++j) { const float x = v[j]; v[j] = fmaxf(x, 0.f) + log1pf(__expf(-fabsf(x))); }
                                *(f32x4*)(DT + (size_t)(row0 + ai * HALF + m * 16) * 48 + col) = v; } } }
            }
            return;
        }
        int mode, ldc, colt; bf16_t* base;
        if (pn < 6) { mode = 1; base = Z; ldc = 1536; colt = pn * BM; }
        else if (pn < 16) { mode = 0; base = XBC; ldc = 2560; colt = (pn - 6) * BM; }
        else if (pn < 20) {
            const int uc = (pn - 17) * BM + wc * 32 + 8 * fq, g0 = uc >> 4, j0 = uc & 15;
#pragma unroll
            for (int ai = 0; ai < 2; ++ai)
#pragma unroll
                for (int m = 0; m < 4; ++m) { const int r = row0 + ai * HALF + m * 16, cl = r >> 5, s = r & 31;
#pragma unroll
                    for (int bj = 0; bj < 2; ++bj) { const f32x4 v0 = acc[ai][bj][m][0], v1 = acc[ai][bj][m][1];
                        u32x4 w; w.x = cvt_pk_bf16(v0[0], v0[1]); w.y = cvt_pk_bf16(v0[2], v0[3]); w.z = cvt_pk_bf16(v1[0], v1[1]); w.w = cvt_pk_bf16(v1[2], v1[3]);
                        *(u32x4*)(UC + ((size_t)((g0 + 8 * bj) * 512 + cl) * 768 + s * 16 + j0)) = w; } }
            return; }
        else { mode = 2; base = GT; ldc = 2048; colt = (pn - 20) * BM; }
        const int col0 = colt + wc * 32 + 8 * fq;
#pragma unroll
        for (int ai = 0; ai < 2; ++ai)
#pragma unroll
            for (int m = 0; m < 4; ++m) { bf16_t* rowp = base + (size_t)(row0 + ai * HALF + m * 16) * ldc + col0;
#pragma unroll
                for (int bj = 0; bj < 2; ++bj) { f32x4 v0 = acc[ai][bj][m][0], v1 = acc[ai][bj][m][1];
                    if (mode == 1) {
#pragma unroll
                        for (int j = 0; j < 4; ++j) { v0[j] = fsilu(v0[j]); v1[j] = fsilu(v1[j]); } }
                    else if (mode == 2) {
#pragma unroll
                        for (int j = 0; j < 4; ++j) { v0[j] = fsigmoid(v0[j]); v1[j] = fsigmoid(v1[j]); } }
                    u32x4 w; w.x = cvt_pk_bf16(v0[0], v0[1]); w.y = cvt_pk_bf16(v0[2], v0[3]); w.z = cvt_pk_bf16(v1[0], v1[1]); w.w = cvt_pk_bf16(v1[2], v1[3]);
                    *(u32x4*)(rowp + bj * HALF) = w; } }
    }
};
struct EpiSsdOut {
    static constexpr bool PERM = false, AFTER_DRAIN = false;
    float* YA; const bf16_t* GT;
    __device__ __forceinline__ void operator()(const f32x4 (&acc)[2][2][4][2], const Unit& u, int wr, int wc, int fr, int fq) const {
        const int row0 = u.pm * BM + wr * 64 + fr, col0 = u.pn * BM + wc * 32 + 4 * fq;
#pragma unroll
        for (int ai = 0; ai < 2; ++ai)
#pragma unroll
            for (int m = 0; m < 4; ++m) { const size_t r = (size_t)(row0 + ai * HALF + m * 16);
#pragma unroll
                for (int bj = 0; bj < 2; ++bj)
#pragma unroll
                    for (int n = 0; n < 2; ++n) { const int c = col0 + bj * HALF + n * 16; const u32x2 g = *(const u32x2*)(GT + r * 2048 + c);
                        f32x4 v = acc[ai][bj][m][n]; v[0] *= bf_lo(g.x); v[1] *= bf_hi(g.x); v[2] *= bf_lo(g.y); v[3] *= bf_hi(g.y);
                        *(f32x4*)(YA + r * 1024 + c) = v; } }
    }
};
struct EpiGlu {
    static constexpr bool PERM = true, AFTER_DRAIN = false;
    bf16_t* MIX; const float* YA; const bf16_t* GT;
    __device__ __forceinline__ void operator()(const f32x4 (&acc)[2][2][4][2], const Unit& u, int wr, int wc, int fr, int fq) const {
        const int row0 = u.pm * BM + wr * 64 + fr, col0 = u.pn * HALF + wc * 32 + 8 * fq;
#pragma unroll
        for (int ai = 0; ai < 2; ++ai)
#pragma unroll
            for (int m = 0; m < 4; ++m) { const size_t r = (size_t)(row0 + ai * HALF + m * 16);
                const u32x4 g = *(const u32x4*)(GT + r * 2048 + 1024 + col0); const f32x4 y0 = *(const f32x4*)(YA + r * 1024 + col0), y1 = *(const f32x4*)(YA + r * 1024 + col0 + 4);
                f32x4 a0 = acc[ai][0][m][0], a1 = acc[ai][0][m][1]; const f32x4 b0 = acc[ai][1][m][0], b1 = acc[ai][1][m][1];
#pragma unroll
                for (int j = 0; j < 4; ++j) { a0[j] *= fsigmoid(b0[j]); a1[j] *= fsigmoid(b1[j]); }
                a0[0] = a0[0] * bf_lo(g.x) + y0[0]; a0[1] = a0[1] * bf_hi(g.x) + y0[1]; a0[2] = a0[2] * bf_lo(g.y) + y0[2]; a0[3] = a0[3] * bf_hi(g.y) + y0[3];
                a1[0] = a1[0] * bf_lo(g.z) + y1[0]; a1[1] = a1[1] * bf_hi(g.z) + y1[1]; a1[2] = a1[2] * bf_lo(g.w) + y1[2]; a1[3] = a1[3] * bf_hi(g.w) + y1[3];
                u32x4 w; w.x = cvt_pk_bf16(a0[0], a0[1]); w.y = cvt_pk_bf16(a0[2], a0[3]); w.z = cvt_pk_bf16(a1[0], a1[1]); w.w = cvt_pk_bf16(a1[2], a1[3]);
                *(u32x4*)(MIX + r * 1024 + col0) = w; }
    }
};
struct EpiWo {
    static constexpr bool PERM = false, AFTER_DRAIN = false;
    float* HP; const float* X; float alpha;
    __device__ __forceinline__ void operator()(const f32x4 (&acc)[2][2][4][2], const Unit& u, int wr, int wc, int fr, int fq) const {
        const int row0 = u.pm * BM + wr * 64 + fr, col0 = u.pn * BM + wc * 32 + 4 * fq;
#pragma unroll
        for (int ai = 0; ai < 2; ++ai)
#pragma unroll
            for (int m = 0; m < 4; ++m) { const size_t r = (size_t)(row0 + ai * HALF + m * 16);
#pragma unroll
                for (int bj = 0; bj < 2; ++bj)
#pragma unroll
                    for (int n = 0; n < 2; ++n) { const int c = col0 + bj * HALF + n * 16; const f32x4 xv = *(const f32x4*)(X + r * 1024 + c);
                        *(f32x4*)(HP + r * 1024 + c) = acc[ai][bj][m][n] + xv * alpha; } }
    }
};
struct EpiMoe1 {
    static constexpr bool PERM = true, AFTER_DRAIN = false;
    bf16_t* HID;
    __device__ __forceinline__ void operator()(const f32x4 (&acc)[2][2][4][2], const Unit& u, int wr, int wc, int fr, int fq) const {
        const int row0 = u.pm * BM + wr * 64 + fr, col0 = (u.pn % 22) * HALF + wc * 32 + 8 * fq;
#pragma unroll
        for (int ai = 0; ai < 2; ++ai)
#pragma unroll
            for (int m = 0; m < 4; ++m) { const size_t r = (size_t)(row0 + ai * HALF + m * 16);
                f32x4 a0 = acc[ai][0][m][0], a1 = acc[ai][0][m][1]; const f32x4 b0 = acc[ai][1][m][0], b1 = acc[ai][1][m][1];
#pragma unroll
                for (int j = 0; j < 4; ++j) { a0[j] = fsilu(a0[j]) * b0[j]; a1[j] = fsilu(a1[j]) * b1[j]; }
                u32x4 w; w.x = cvt_pk_bf16(a0[0], a0[1]); w.y = cvt_pk_bf16(a0[2], a0[3]); w.z = cvt_pk_bf16(a1[0], a1[1]); w.w = cvt_pk_bf16(a1[2], a1[3]);
                *(u32x4*)(HID + r * 2816 + col0) = w; }
    }
};
struct EpiMoe2 {
    static constexpr bool PERM = true, AFTER_DRAIN = false;
    bf16_t* Y;
    __device__ __forceinline__ void operator()(const f32x4 (&acc)[2][2][4][2], const Unit& u, int wr, int wc, int fr, int fq) const {
        const int row0 = u.pm * BM + wr * 64 + fr, col0 = (u.pn & 3) * BM + wc * 32 + 8 * fq;
#pragma unroll
        for (int ai = 0; ai < 2; ++ai)
#pragma unroll
            for (int m = 0; m < 4; ++m) { bf16_t* rowp = Y + (size_t)(row0 + ai * HALF + m * 16) * 1024 + col0;
#pragma unroll
                for (int bj = 0; bj < 2; ++bj) { const f32x4 v0 = acc[ai][bj][m][0], v1 = acc[ai][bj][m][1];
                    u32x4 w; w.x = cvt_pk_bf16(v0[0], v0[1]); w.y = cvt_pk_bf16(v0[2], v0[3]); w.z = cvt_pk_bf16(v1[0], v1[1]); w.w = cvt_pk_bf16(v1[2], v1[3]);
                    *(u32x4*)(rowp + bj * HALF) = w; } }
    }
};

struct EpiS5a {
    static constexpr bool PERM = false, AFTER_DRAIN = false;
    float* SLOC;
    __device__ __forceinline__ void operator()(const f32x4 (&acc)[2][2][4][2], const Unit& u, int wr, int wc, int fr, int fq) const {
        const int row0 = u.pm * BM + wr * 64 + fr, col0 = wc * 32 + 4 * fq;
#pragma unroll
        for (int ai = 0; ai < 2; ++ai)
#pragma unroll
            for (int m = 0; m < 4; ++m) { float* rowp = SLOC + (size_t)(row0 + ai * HALF + m * 16) * 256 + col0;
#pragma unroll
                for (int bj = 0; bj < 2; ++bj)
#pragma unroll
                    for (int n = 0; n < 2; ++n) *(f32x4*)(rowp + bj * HALF + n * 16) = acc[ai][bj][m][n]; }
    }
};
__device__ __forceinline__ float gelu_tanh_f(float x) { const float uu = 0.7978845608028654f * (x + 0.044715f * x * x * x); const float e = __expf(2.f * uu); return 0.5f * x * (2.f - 2.f * __builtin_amdgcn_rcpf(e + 1.f)); }
struct EpiS5c {
    static constexpr bool PERM = true, AFTER_DRAIN = false;
    bf16_t* GY; const bf16_t* UC; const float* d5;
    __device__ __forceinline__ void operator()(const f32x4 (&acc)[2][2][4][2], const Unit& u, int wr, int wc, int fr, int fq) const {
        const int g = u.pm >> 1, cl0 = (u.pm & 1) * BM + wr * 64 + fr, nl0 = (u.pn & 1) * BM + wc * 32 + 8 * fq;
        const int k0 = nl0 & 15; const f32x4 d0 = *(const f32x4*)(d5 + g * 16 + k0), d1 = *(const f32x4*)(d5 + g * 16 + k0 + 4);
#pragma unroll
        for (int ai = 0; ai < 2; ++ai)
#pragma unroll
            for (int m = 0; m < 4; ++m) { const int cl = cl0 + ai * HALF + m * 16;
#pragma unroll
                for (int bj = 0; bj < 2; ++bj) { const int nl = nl0 + bj * HALF, t = nl >> 4;
                    const u32x4 uw = *(const u32x4*)(UC + ((size_t)(g * 512 + cl) * 768 + nl));
                    f32x4 v0 = acc[ai][bj][m][0], v1 = acc[ai][bj][m][1];
                    v0[0] += bf_lo(uw.x) * d0[0]; v0[1] += bf_hi(uw.x) * d0[1]; v0[2] += bf_lo(uw.y) * d0[2]; v0[3] += bf_hi(uw.y) * d0[3];
                    v1[0] += bf_lo(uw.z) * d1[0]; v1[1] += bf_hi(uw.z) * d1[1]; v1[2] += bf_lo(uw.w) * d1[2]; v1[3] += bf_hi(uw.w) * d1[3];
#pragma unroll
                    for (int j = 0; j < 4; ++j) { v0[j] = gelu_tanh_f(v0[j]); v1[j] = gelu_tanh_f(v1[j]); }
                    u32x4 w; w.x = cvt_pk_bf16(v0[0], v0[1]); w.y = cvt_pk_bf16(v0[2], v0[3]); w.z = cvt_pk_bf16(v1[0], v1[1]); w.w = cvt_pk_bf16(v1[2], v1[3]);
                    *(u32x4*)(GY + (size_t)(cl * 32 + t) * 768 + g * 16 + k0) = w; } }
    }
};
struct S5aOrder {
    int c, lo;
    __device__ __forceinline__ bool next(int i, Unit& u) const { if (i > 0 || c < lo || c >= lo + 96) return false; u.pm = c - lo; u.pn = (c - lo) >> 1; return true; }
    __device__ __forceinline__ void a_ready(const Unit&) const {}
    __device__ __forceinline__ void done(const Unit&) const {}
};
struct S5cOrder {
    int G, c;
    __device__ __forceinline__ bool next(int i, Unit& u) const { const int L = i * G + c; if (L >= 192) return false; const int g = L >> 2; u.pm = 2 * g + (L & 1); u.pn = 2 * g + ((L >> 1) & 1); return true; }
    __device__ __forceinline__ void a_ready(const Unit&) const {}
    __device__ __forceinline__ void done(const Unit&) const {}
};
struct MoeOrder1 {
    int G, c;
    __device__ __forceinline__ bool next(int i, Unit& u) const {
        if (G == 256) { if (i >= 11) return false; const int x = c & 7, j = c >> 3, q = x * 44 + i * 4 + (j >> 3); u.pm = (q / 22) * 8 + (j & 7); u.pn = q; return true; }
        const long L = (long)i * G + c; if (L >= 2816) return false; const int e = (int)(L / 176), r = (int)(L % 176); u.pm = e * 8 + (r & 7); u.pn = e * 22 + (r >> 3); return true;
    }
    __device__ __forceinline__ void a_ready(const Unit&) const {}
    __device__ __forceinline__ void done(const Unit&) const {}
};
struct MoeOrder2 {
    int G, c;
    __device__ __forceinline__ bool next(int i, Unit& u) const {
        if (G == 256) { if (i >= 2) return false; const int x = c & 7, j = c >> 3, e = 2 * x + i; u.pm = e * 8 + (j & 7); u.pn = e * 4 + (j >> 3); return true; }
        const long L = (long)i * G + c; if (L >= 512) return false; const int e = (int)(L / 32), r = (int)(L % 32); u.pm = e * 8 + (r & 7); u.pn = e * 4 + (r >> 3); return true;
    }
    __device__ __forceinline__ void a_ready(const Unit&) const {}
    __device__ __forceinline__ void done(const Unit&) const {}
};
template <class Epi, class Sched, bool ALIGN_EPI = false, bool SP2 = false>
__device__ __forceinline__ void gemm_phase(PG8_LAS unsigned char* lds, const Gemm g, const Sched& S, const Epi& E) {
    const int tid = threadIdx.x, wid = __builtin_amdgcn_readfirstlane(tid >> 6), lane = tid & 63, wr = wid >> 2, wc = wid & 3, fr = lane & 15, fq = lane >> 4;
    const int K = g.K, nt = K / BK;
    unsigned voffA[2], voffB[2];
#pragma unroll
    for (int i = 0; i < 2; ++i) { int R, C; stage_rc(tid * 16 + i * 8192, R, C); const int Rb = Epi::PERM ? ((R & ~31) + perm32(R & 31)) : R;
        voffA[i] = (unsigned)(R * g.lda + C) * 2u; voffB[i] = (unsigned)(Rb * g.ldb + C) * 2u; }
    const size_t kstep = (size_t)(BK * 2);
    const size_t hstepA = (size_t)HALF * g.lda * 2, hstepB = (size_t)HALF * g.ldb * 2;
    const size_t tstepA = 2 * hstepA, tstepB = 2 * hstepB;
    const unsigned ldsw = (unsigned)wid * 1024u;
    const int aoff = lds_byte(wr * 64 + fr, fq * 8), boff = lds_byte(wc * 32 + fr, fq * 8);
#define PG8_SA(b, h) (((b) * 2 + (h)) * HTB)
#define PG8_SB(b, h) ((4 + (b) * 2 + (h)) * HTB)
#define PG8_STAGE(bufoff, gbase, voff) do { _Pragma("unroll") for (int _i = 0; _i < 2; ++_i) \
        __builtin_amdgcn_global_load_lds((const unsigned*)((const char*)(gbase) + (voff)[_i]), (PG8_LAS unsigned*)(lds + (bufoff) + ldsw + _i * 8192), 16, 0, 0); } while (0)
#define PG8_LDA(dst, b, h) do { _Pragma("unroll") for (int m = 0; m < 4; ++m) _Pragma("unroll") for (int k = 0; k < 2; ++k) dst[m][k] = *(const PG8_LAS bf16x8*)(lds + PG8_SA(b, h) + aoff + m * 2048 + k * 1024); } while (0)
#define PG8_LDB(dst, b, h) do { _Pragma("unroll") for (int n = 0; n < 2; ++n) _Pragma("unroll") for (int k = 0; k < 2; ++k) dst[n][k] = *(const PG8_LAS bf16x8*)(lds + PG8_SB(b, h) + boff + n * 2048 + k * 1024); } while (0)
#define PG8_MMA(ai, bj, At, Bt) do { __builtin_amdgcn_s_setprio(1); _Pragma("unroll") for (int m = 0; m < 4; ++m) _Pragma("unroll") for (int n = 0; n < 2; ++n) _Pragma("unroll") for (int k = 0; k < 2; ++k) \
        acc[ai][bj][m][n] = __builtin_amdgcn_mfma_f32_16x16x32_bf16(Bt[n][k], At[m][k], acc[ai][bj][m][n], 0, 0, 0); __builtin_amdgcn_s_setprio(0); } while (0)
#define PG8_WAIT_V(n) asm volatile("s_waitcnt vmcnt(" #n ")" ::: "memory")
#define PG8_WAIT_L(n) asm volatile("s_waitcnt lgkmcnt(" #n ")" ::: "memory")
#define PG8_BAR __builtin_amdgcn_s_barrier()
#define PG8_SCHED __builtin_amdgcn_sched_barrier(0)
    Unit cur, nxt; int ui = 0;
    if (!S.next(0, cur)) return;
    f32x4 acc[2][2][4][2];
#pragma unroll
    for (int a = 0; a < 2; ++a)
#pragma unroll
        for (int b = 0; b < 2; ++b)
#pragma unroll
            for (int m = 0; m < 4; ++m)
#pragma unroll
                for (int n = 0; n < 2; ++n) acc[a][b][m][n] = (f32x4){0.f, 0.f, 0.f, 0.f};
    bf16x8 At[4][2], B0[2][2], B1[2][2];
    const char* cA = (const char*)g.A + (size_t)cur.pm * tstepA; const char* cB = (const char*)g.Bt + (size_t)cur.pn * tstepB;
    S.a_ready(cur);
    if constexpr (SP2) {
        PG8_STAGE(PG8_SB(0, 0), cB, voffB); PG8_STAGE(PG8_SB(0, 1), cB + hstepB, voffB); PG8_STAGE(PG8_SA(0, 0), cA, voffA); PG8_STAGE(PG8_SA(0, 1), cA + hstepA, voffA);
        if (wr == 1) PG8_BAR;
        PG8_WAIT_V(2); PG8_BAR;
        PG8_STAGE(PG8_SB(1, 0), cB + kstep, voffB); PG8_STAGE(PG8_SA(1, 0), cA + kstep, voffA); PG8_STAGE(PG8_SB(1, 1), cB + hstepB + kstep, voffB);
        PG8_WAIT_V(6); PG8_BAR;
    } else {
        PG8_STAGE(PG8_SB(0, 0), cB, voffB); PG8_STAGE(PG8_SA(0, 0), cA, voffA); PG8_STAGE(PG8_SB(0, 1), cB + hstepB, voffB); PG8_STAGE(PG8_SA(0, 1), cA + hstepA, voffA);
        if (wr == 1) PG8_BAR;
        PG8_WAIT_V(4); PG8_BAR;
        PG8_STAGE(PG8_SB(1, 0), cB + kstep, voffB); PG8_STAGE(PG8_SA(1, 0), cA + kstep, voffA); PG8_STAGE(PG8_SB(1, 1), cB + hstepB + kstep, voffB);
        PG8_WAIT_V(6); PG8_BAR;
    }
    for (;;) {
        const bool has_next = S.next(ui + 1, nxt);
        const char* nA = has_next ? (const char*)g.A + (size_t)nxt.pm * tstepA : cA; const char* nB = has_next ? (const char*)g.Bt + (size_t)nxt.pn * tstepB : cB;
        for (int t = 0; t < nt; t += 2) {
            const bool last = (t == nt - 2);
            const char* a1 = cA + (size_t)(t + 1) * kstep;
            const char* a2 = last ? nA : cA + (size_t)(t + 2) * kstep; const char* b2 = last ? nB : cB + (size_t)(t + 2) * kstep;
            const char* a3 = a2 + kstep; const char* b3 = b2 + kstep;
            if (last && has_next) S.a_ready(nxt);
            if constexpr (SP2) {
            PG8_LDB(B0, 0, 0); PG8_LDB(B1, 0, 1); PG8_SCHED; PG8_LDA(At, 0, 0); PG8_STAGE(PG8_SA(1, 1), a1 + hstepA, voffA);
            PG8_WAIT_V(8); PG8_WAIT_L(0); PG8_BAR; PG8_MMA(0, 0, At, B0); PG8_MMA(0, 1, At, B1); PG8_BAR; PG8_SCHED;
            PG8_LDA(At, 0, 1); PG8_STAGE(PG8_SB(0, 0), b2, voffB); PG8_STAGE(PG8_SB(0, 1), b2 + hstepB, voffB); PG8_STAGE(PG8_SA(0, 0), a2, voffA);
            PG8_WAIT_V(8); PG8_WAIT_L(0); PG8_BAR; PG8_MMA(1, 0, At, B0); PG8_MMA(1, 1, At, B1); PG8_BAR; PG8_SCHED;
            PG8_LDB(B0, 1, 0); PG8_LDB(B1, 1, 1); PG8_SCHED; PG8_LDA(At, 1, 0); PG8_STAGE(PG8_SA(0, 1), a2 + hstepA, voffA);
            PG8_WAIT_V(8); PG8_WAIT_L(0); PG8_BAR; PG8_MMA(0, 0, At, B0); PG8_MMA(0, 1, At, B1); PG8_BAR; PG8_SCHED;
            PG8_LDA(At, 1, 1); PG8_STAGE(PG8_SB(1, 0), b3, voffB); PG8_STAGE(PG8_SB(1, 1), b3 + hstepB, voffB); PG8_STAGE(PG8_SA(1, 0), a3, voffA);
            PG8_WAIT_V(8); PG8_WAIT_L(0); PG8_BAR; PG8_MMA(1, 0, At, B0); PG8_MMA(1, 1, At, B1); PG8_BAR; PG8_SCHED;
            } else {
            PG8_LDB(B0, 0, 0); PG8_SCHED; PG8_LDA(At, 0, 0); PG8_STAGE(PG8_SA(1, 1), a1 + hstepA, voffA);
            PG8_WAIT_L(8); PG8_BAR; PG8_WAIT_L(0); PG8_MMA(0, 0, At, B0); PG8_BAR; PG8_SCHED;
            PG8_LDB(B1, 0, 1); PG8_STAGE(PG8_SB(0, 0), b2, voffB);
            PG8_BAR; PG8_WAIT_L(0); PG8_MMA(0, 1, At, B1); PG8_BAR;
            PG8_LDA(At, 0, 1); PG8_STAGE(PG8_SA(0, 0), a2, voffA);
            PG8_BAR; PG8_WAIT_L(0); PG8_MMA(1, 0, At, B0); PG8_BAR; PG8_SCHED;
            PG8_STAGE(PG8_SB(0, 1), b2 + hstepB, voffB);
            PG8_WAIT_V(6); PG8_BAR; PG8_MMA(1, 1, At, B1); PG8_BAR;
            PG8_LDB(B0, 1, 0); PG8_SCHED; PG8_LDA(At, 1, 0); PG8_STAGE(PG8_SA(0, 1), a2 + hstepA, voffA);
            PG8_WAIT_L(8); PG8_BAR; PG8_WAIT_L(0); PG8_MMA(0, 0, At, B0); PG8_BAR; PG8_SCHED;
            PG8_LDB(B1, 1, 1); PG8_STAGE(PG8_SB(1, 0), b3, voffB);
            PG8_BAR; PG8_WAIT_L(0); PG8_MMA(0, 1, At, B1); PG8_BAR;
            PG8_LDA(At, 1, 1); PG8_STAGE(PG8_SA(1, 0), a3, voffA);
            PG8_BAR; PG8_WAIT_L(0); PG8_MMA(1, 0, At, B0); PG8_BAR; PG8_SCHED;
            PG8_STAGE(PG8_SB(1, 1), b3 + hstepB, voffB);
            PG8_WAIT_V(6); PG8_BAR; PG8_MMA(1, 1, At, B1); PG8_BAR;
            }
        }
        if constexpr (ALIGN_EPI) { if (wr == 0) PG8_BAR; }
        if constexpr (!Epi::AFTER_DRAIN) { E(acc, cur, wr, wc, fr, fq); S.done(cur); }
        if (!has_next) break;
#pragma unroll
        for (int a = 0; a < 2; ++a)
#pragma unroll
            for (int b = 0; b < 2; ++b)
#pragma unroll
                for (int m = 0; m < 4; ++m)
#pragma unroll
                    for (int n = 0; n < 2; ++n) acc[a][b][m][n] = (f32x4){0.f, 0.f, 0.f, 0.f};
        cur = nxt; cA = nA; cB = nB; ++ui;
        if constexpr (ALIGN_EPI) { if (wr == 1) PG8_BAR; }
    }
    PG8_WAIT_V(0);
    if constexpr (!ALIGN_EPI) { if (wr == 0) PG8_BAR; }
    PG8_BAR;
    if constexpr (Epi::AFTER_DRAIN) { E.fused(acc, cur, wr, wc, fr, fq, lds, wid, lane); S.done(cur); }
#undef PG8_SA
#undef PG8_SB
#undef PG8_STAGE
#undef PG8_LDA
#undef PG8_LDB
#undef PG8_MMA
#undef PG8_WAIT_V
#undef PG8_WAIT_L
#undef PG8_BAR
#undef PG8_SCHED
}
}
#ifndef PG8_SP2
#define PG8_SP2 true
#endif
#ifndef PG8_ALIGN
#define PG8_ALIGN true
#endif

constexpr int NWAVES = 8, NTHR = 512;
constexpr int D = 1024, NB = 2, T = 8192, M = NB * T;
constexpr int SSD_H = 24, SSD_P = 64, SSD_IN = 1536, SSD_G = 4, SSD_N = 128, XBC = 2560, INCOLS = 6960, NIN_PAD = 7168;
constexpr int S5_W = 768, S5_G = 48, S5_P = 64, S5_K = 16;
constexpr int NE = 16, FF = 2816, CAP = 1024, MROWS = NE * NB * CAP;
constexpr float LN_EPS = 1e-5f, RMS_EPS = 1e-5f;
constexpr float ALPHA = 1.189207115002721f;

constexpr size_t MiB = 1u << 20;
constexpr size_t WS_CTL = 0, CTL_ZERO_BYTES = 64 * 1024;
constexpr size_t WS_WIN = 1 * MiB, WS_WOUT = 15 * MiB, WS_WGLU = 18 * MiB, WS_WO = 21 * MiB, WS_W1 = 23 * MiB, WS_W2 = 199 * MiB, WS_ACT = 287 * MiB;
constexpr size_t A_XB = WS_ACT + 0 * MiB;
constexpr size_t A_BN = WS_ACT + 0 * MiB;
constexpr size_t A_CN = WS_ACT + 16 * MiB;
constexpr size_t A_Z = WS_ACT + 32 * MiB;
constexpr size_t A_XBC = WS_ACT + 80 * MiB;
constexpr size_t A_S = WS_ACT + 80 * MiB;
constexpr size_t A_XT = WS_ACT + 176 * MiB;
constexpr size_t A_BT = WS_ACT + 224 * MiB;
constexpr size_t A_SV = WS_ACT + 240 * MiB;
constexpr size_t A_DT = WS_ACT + 252 * MiB;
constexpr size_t A_TOT = WS_ACT + 255 * MiB;
constexpr size_t A_UC = WS_ACT + 268 * MiB;
constexpr size_t A_Y = WS_ACT + 256 * MiB;
constexpr size_t A_GY = WS_ACT + 304 * MiB;
constexpr size_t A_GT = WS_ACT + 353 * MiB;
constexpr size_t A_YA = WS_ACT + 0 * MiB;
constexpr size_t A_MIX = WS_ACT + 64 * MiB;
constexpr size_t A_HP = WS_ACT + 96 * MiB;
constexpr size_t A_H = WS_ACT + 0 * MiB;
constexpr size_t A_HB = WS_ACT + 64 * MiB;
constexpr size_t A_AFF = WS_ACT + 160 * MiB;
constexpr size_t A_IDX = A_AFF + 1 * MiB;
constexpr size_t A_SEL = A_AFF + 2 * MiB;
constexpr size_t A_GATE = A_AFF + 3 * MiB;
constexpr size_t A_XIN = WS_ACT + 164 * MiB;
constexpr size_t A_HID = WS_ACT + 228 * MiB;
constexpr size_t A_YE = WS_ACT + 96 * MiB;
constexpr size_t WS_TV = WS_W2 + 0 * MiB;
constexpr size_t WS_WS5 = WS_W2 + 36 * MiB;
constexpr size_t WS_SLOC = WS_W2 + 48 * MiB;
constexpr size_t WS_AQ = WS_W2 + 72 * MiB;
constexpr size_t WS_END = 704 * MiB;
static_assert(A_HID + 176 * MiB <= WS_END && A_XIN + 64 * MiB <= A_HID && A_GATE + 1 * MiB <= A_XIN && A_YE + 64 * MiB <= A_AFF && A_H + 64 * MiB <= A_HB && A_HB + 32 * MiB <= A_HP, "d_ws map (late phases)");
static_assert(A_GT + 64 * MiB <= WS_END && A_GY + 24 * MiB <= A_GT && A_UC + 36 * MiB <= A_GY && A_Y + 48 * MiB <= A_GY && A_TOT + 1 * MiB <= A_Y && A_DT + 3 * MiB <= A_TOT && A_SV + 12 * MiB <= A_DT && A_BT + 16 * MiB <= A_SV
              && A_XT + 48 * MiB <= A_BT && A_S + 96 * MiB <= A_XT && A_Z + 48 * MiB <= A_XBC && A_CN + 16 * MiB <= A_Z, "d_ws map (early phases)");
constexpr int CW_BAR = 1024;

constexpr int RING_BYTES = 131072;
constexpr int MISC_OFF = RING_BYTES;
constexpr int LDS_BYTES = 147456;

#define GAS __attribute__((address_space(1)))
#define LAS __attribute__((address_space(3)))
typedef unsigned short bf16;
typedef unsigned v4u __attribute__((ext_vector_type(4)));
typedef unsigned v2u __attribute__((ext_vector_type(2)));
typedef float f32x4 __attribute__((ext_vector_type(4)));
#define LDS_WAIT() asm volatile("s_waitcnt lgkmcnt(0)" ::: "memory")
__device__ __forceinline__ unsigned f2bf(float f) { unsigned u = __builtin_bit_cast(unsigned, f); return (u + 0x7fffu + ((u >> 16) & 1u)) >> 16; }
__device__ __forceinline__ unsigned pk2(float lo, float hi) { return pg8::cvt_pk_bf16(lo, hi); }
__device__ __forceinline__ float bflo(unsigned w) { return __uint_as_float(w << 16); }
__device__ __forceinline__ float bfhi(unsigned w) { return __uint_as_float(w & 0xffff0000u); }
__device__ __forceinline__ float wave_sum(float v) {
#pragma unroll
    for (int o = 1; o < 64; o <<= 1) v += __shfl_xor(v, o);
    return v;
}
#define XB_TMO      128
#define XB_XCNT(j)  (256  + 64 * (j))
#define XB_XSUB(j)  (1280 + 64 * (j))
#define XB_XGEN(j)  (2304 + 64 * (j))
#define XB_TOP      3328
#define XB_TOPGEN   3392
#define XCD_BAR_WORDS 3456
#define XB_SPIN_CAP (1u << 18)

__device__ __forceinline__ unsigned xb_ld(unsigned* p)              { return __hip_atomic_load(p, __ATOMIC_RELAXED, __HIP_MEMORY_SCOPE_AGENT); }
__device__ __forceinline__ unsigned xb_add(unsigned* p, unsigned v) { return __hip_atomic_fetch_add(p, v, __ATOMIC_RELAXED, __HIP_MEMORY_SCOPE_AGENT); }
__device__ __forceinline__ unsigned xb_xcc_id() { return (unsigned)__builtin_amdgcn_s_getreg((3 << 11) | 20) & 0xFu; }
#define XB_SPIN(cond, bar) do { unsigned _sp = 0; while (cond) { __builtin_amdgcn_s_sleep(1); \
    if ((++_sp & 255u) == 0u) { if (xb_ld(&(bar)[XB_TMO])) break; if (_sp > XB_SPIN_CAP) { atomicAdd(&(bar)[XB_TMO], 1u); break; } } } } while (0)

struct XcdBarrier {
    unsigned* bar; unsigned x;
    volatile LAS unsigned* st;
};

__device__ __forceinline__ XcdBarrier xcd_barrier_post(unsigned* bar, volatile LAS unsigned* st) {
    XcdBarrier b; b.bar = bar; b.x = xb_xcc_id(); b.st = st;
    if (threadIdx.x == 0) (void)xb_add(&bar[XB_XCNT(b.x)], 1u);
    return b;
}
__device__ __forceinline__ void xcd_barrier_complete(unsigned* bar, unsigned x, unsigned& nloc, unsigned& nx) {
    const unsigned G = gridDim.x * gridDim.y * gridDim.z;
    unsigned sum, cnt, mine, sp = 0u;
    for (;;) {
        sum = 0u; cnt = 0u; mine = 0u;
#pragma unroll
        for (unsigned j = 0; j < 16; ++j) { const unsigned c = xb_ld(&bar[XB_XCNT(j)]); sum += c; cnt += (c > 0u) ? 1u : 0u; mine = (j == x) ? c : mine; }
        if (sum == G) break;
        __builtin_amdgcn_s_sleep(1);
        if ((++sp & 255u) == 0u) { if (xb_ld(&bar[XB_TMO])) break; if (sp > XB_SPIN_CAP) { atomicAdd(&bar[XB_TMO], 1u); break; } }
    }
    nloc = mine > 0u ? mine : 1u; nx = cnt > 0u ? cnt : 1u;
}

__device__ __forceinline__ void xcd_barrier(const XcdBarrier& b) {
    asm volatile("s_waitcnt vmcnt(0)" ::: "memory");
    __syncthreads();
    if (threadIdx.x == 0) {
        unsigned* bar = b.bar;
        __builtin_amdgcn_s_waitcnt(0);
        unsigned nloc = b.st[0], nx = b.st[1];
        if (nloc == 0u) { xcd_barrier_complete(bar, b.x, nloc, nx); b.st[0] = nloc; b.st[1] = nx; }
        const unsigned old = xb_add(&bar[XB_XSUB(b.x)], 1u);
        const unsigned gen = old / nloc;
        if (old + 1u == (gen + 1u) * nloc) {
            __builtin_amdgcn_fence(__ATOMIC_RELEASE, "agent");
            asm volatile("s_waitcnt vmcnt(0)" ::: "memory");
            const unsigned og = xb_add(&bar[XB_TOP], 1u);
            const unsigned tg = og / nx;
            if (og + 1u == (tg + 1u) * nx) xb_add(&bar[XB_TOPGEN], 1u);
            else XB_SPIN(xb_ld(&bar[XB_TOPGEN]) == tg, bar);
            __builtin_amdgcn_fence(__ATOMIC_ACQUIRE, "agent");
            xb_add(&bar[XB_XGEN(b.x)], 1u);
            asm volatile("s_waitcnt vmcnt(0)" ::: "memory");
        } else {
            XB_SPIN(xb_ld(&bar[XB_XGEN(b.x)]) == gen, bar);
            __builtin_amdgcn_fence(__ATOMIC_ACQUIRE, "agent");
            asm volatile("s_waitcnt vmcnt(0)" ::: "memory");
        }
    }
    __syncthreads();
}

struct Frame {
    LAS unsigned char* lds;
    int tid, lane, wave, bid, G;
    const float* const* in; float* out; unsigned char* ws;
};
#define WSP(T_, off) ((T_*)(F.ws + (off)))

__device__ __forceinline__ void tr_item(const float* W, int ldw, int col0, int ncols, int K, bf16* WT, int drow, LAS float* scr, int k0, int n0, int lane) {
    const int kr = lane >> 4, c4 = lane & 15; const bool okc = (n0 + 4 * c4) < ncols;
    const float* src = W + (size_t)(k0 + kr) * ldw + col0 + n0 + 4 * c4;
    f32x4 v[16];
#pragma unroll
    for (int i = 0; i < 16; ++i) v[i] = okc ? *(const f32x4*)(src + (size_t)(4 * i) * ldw) : (f32x4){0.f, 0.f, 0.f, 0.f};
#pragma unroll
    for (int i = 0; i < 16; ++i) { const int k = 4 * i + kr; *(LAS f32x4*)(scr + k * 64 + 4 * (c4 ^ ((k >> 3) & 7))) = v[i]; }
    LDS_WAIT(); asm volatile("" ::: "memory");
    const int nl = lane >> 3, c = lane & 7;
#pragma unroll
    for (int j = 0; j < 8; ++j) { const int n = 8 * j + nl; const LAS float* s = scr + (8 * c) * 64 + 4 * ((n >> 2) ^ c) + (n & 3);
        v4u o; o.x = pk2(s[0 * 64], s[1 * 64]); o.y = pk2(s[2 * 64], s[3 * 64]); o.z = pk2(s[4 * 64], s[5 * 64]); o.w = pk2(s[6 * 64], s[7 * 64]);
        if (n0 + n < ncols) *(v4u*)(WT + (size_t)(drow + n) * K + k0 + 8 * c) = o; }
    LDS_WAIT(); asm volatile("" ::: "memory");
}
struct TrJob { const float* W; int ldw, col0, ncols, K; bf16* WT; int drow0, interleave; };
__device__ __forceinline__ int tr_job_items(const TrJob& j) { return (j.K / 64) * ((j.ncols + 63) / 64); }
__device__ __forceinline__ void tr_job_item(const TrJob& j, int item, LAS float* scr, int lane) {
    const int nblk = (j.ncols + 63) / 64, kb = item / nblk, nb = item % nblk, n0 = nb * 64;
    const int drow = j.interleave ? j.drow0 + (n0 >> 7) * 256 + (n0 & 127) : j.drow0 + n0;
    tr_item(j.W, j.ldw, j.col0, j.ncols, j.K, j.WT, drow, scr, kb * 64, n0, lane);
}
__device__ __forceinline__ void p0_prologue(Frame& F) {
    LAS float* scr = (LAS float*)(F.lds + F.wave * 16384);
    const int gw = F.bid * NWAVES + F.wave, NGW = F.G * NWAVES;
    { const f32x4* x4 = (const f32x4*)F.in[0]; v4u* o = WSP(v4u, A_XB); const int n8 = M * D / 8;
      for (int i = F.bid * NTHR + F.tid; i < n8; i += F.G * NTHR) { const f32x4 a = x4[2 * i], b = x4[2 * i + 1]; v4u w; w.x = pk2(a.x, a.y); w.y = pk2(a.z, a.w); w.z = pk2(b.x, b.y); w.w = pk2(b.z, b.w); o[i] = w; } }
    {
        bf16* WIN = WSP(bf16, WS_WIN); bf16* WOUT = WSP(bf16, WS_WOUT); bf16* WGLU = WSP(bf16, WS_WGLU); bf16* WO = WSP(bf16, WS_WO);
        const TrJob jobs[8] = {
            {F.in[1], INCOLS, 0, 4096, D, WIN, 0, 0}, {F.in[1], INCOLS, 4096, 48, D, WIN, 4096, 0}, {F.in[1], INCOLS, 4144, 768, D, WIN, 4352, 0}, {F.in[1], INCOLS, 4912, 2048, D, WIN, 5120, 0},
            {F.in[10], D, 0, D, SSD_IN, WOUT, 0, 0}, {F.in[22], D, 0, D, S5_W, WGLU, 0, 1}, {F.in[23], D, 0, D, S5_W, WGLU, 128, 1}, {F.in[24], D, 0, D, D, WO, 0, 0} };
        int base = 0;
#pragma unroll
        for (int q = 0; q < 8; ++q) { const int n = tr_job_items(jobs[q]);
            int it0 = (gw - base) % NGW; if (it0 < 0) it0 += NGW;
            for (int it = it0; it < n; it += NGW) tr_job_item(jobs[q], it, scr, F.lane);
            base += n; }
    }
    {
        bf16* W1 = WSP(bf16, WS_W1);
        constexpr int I13 = (D / 64) * (FF / 64);
        for (int it = gw; it < NE * 2 * I13; it += NGW) {
            const int e = it / (2 * I13); int r = it % (2 * I13);
            if (r < I13) { const TrJob j{F.in[28] + (size_t)e * D * FF, FF, 0, FF, D, W1 + (size_t)e * 2 * FF * D, 0, 1}; tr_job_item(j, r, scr, F.lane); }
            else { const TrJob j{F.in[29] + (size_t)e * D * FF, FF, 0, FF, D, W1 + (size_t)e * 2 * FF * D, 128, 1}; tr_job_item(j, r - I13, scr, F.lane); }
        }
    }
}
__device__ __forceinline__ void w2_convert(Frame& F, int gw, int ngw) {
    LAS float* scr = (LAS float*)(F.lds + F.wave * 16384);
    bf16* W2 = WSP(bf16, WS_W2);
    constexpr int I2 = (FF / 64) * (D / 64);
    for (int it = gw; it < NE * I2; it += ngw) { const int e = it / I2, r = it % I2;
        const TrJob j{F.in[30] + (size_t)e * FF * D, D, 0, D, FF, W2 + (size_t)e * D * FF, 0, 0}; tr_job_item(j, r, scr, F.lane); }
}

__device__ __forceinline__ void cmul(float ar, float ai, float br, float bi, float& cr, float& ci) { cr = ar * br - ai * bi; ci = ar * bi + ai * br; }
__device__ __forceinline__ void s5_precompute_item(Frame& F, int g, int tau) {
    LAS float* PQ = (LAS float*)(F.lds + 72 * 1024);
    LAS float* PW = PQ + 256;
    bf16* TV = WSP(bf16, WS_TV) + (size_t)g * 512 * 768; bf16* WM = WSP(bf16, WS_WS5) + (size_t)g * 256 * 512; float* AQ = WSP(float, WS_AQ);
    const int tid = F.tid;
    __syncthreads();
    if (tid < 128) {
        const int d = tid >> 6, p = tid & 63;
        const float are = (d ? F.in[14] : F.in[11])[g * 64 + p], aim = (d ? F.in[15] : F.in[12])[g * 64 + p], step = __expf((d ? F.in[16] : F.in[13])[g]);
        const float zr = are * step, zi = aim * step;
        const float er = expf(zr), cs = cosf(zi), sn = sinf(zi), abr = er * cs, abi = er * sn;
        const float sh = sinf(0.5f * zi), dr = expm1f(zr) * cs - 2.f * sh * sh, di = abi;
        const float den = 1.0f / (are * are + aim * aim), qr = (dr * are + di * aim) * den, qi = (di * are - dr * aim) * den;
        float pr = 1.f, pi = 0.f, br = abr, bi = abi;
#pragma unroll
        for (int bit = 0; bit < 6; ++bit) { if ((tau >> bit) & 1) { float tr_, ti_; cmul(pr, pi, br, bi, tr_, ti_); pr = tr_; pi = ti_; } float sr_, si_; cmul(br, bi, br, bi, sr_, si_); br = sr_; bi = si_; }
        float xr, xi; cmul(pr, pi, qr, qi, xr, xi);
        PQ[(d * 64 + p) * 2] = xr; PQ[(d * 64 + p) * 2 + 1] = xi; PW[(d * 64 + p) * 2] = pr; PW[(d * 64 + p) * 2 + 1] = pi;
        if (tau == 32) { AQ[((g * 2 + d) * 64 + p) * 2] = pr; AQ[((g * 2 + d) * 64 + p) * 2 + 1] = pi; }
    }
    __syncthreads();
    const float* cre = F.in[19] + (size_t)g * 16 * 64; const float* cim = F.in[20] + (size_t)g * 16 * 64;
    const float* bre = F.in[17] + (size_t)g * 64 * 16; const float* bim = F.in[18] + (size_t)g * 64 * 16;
    if (tid < 256 && tau < 32) {
        const int k = tid >> 4, j = tid & 15; float kf = 0.f, kb = 0.f;
        for (int p = 0; p < 64; ++p) { const float cr = cre[k * 64 + p], ci = cim[k * 64 + p], br = bre[p * 16 + j], bi = bim[p * 16 + j];
            float wr_, wi_; cmul(cr, ci, PQ[p * 2], PQ[p * 2 + 1], wr_, wi_); kf += wr_ * br - wi_ * bi;
            cmul(cr, ci, PQ[(64 + p) * 2], PQ[(64 + p) * 2 + 1], wr_, wi_); kb += wr_ * br - wi_ * bi; }
        if (tau == 0) { const bf16 v = (bf16)f2bf(kf + kb); for (int t = 0; t < 32; ++t) TV[(size_t)(t * 16 + k) * 768 + t * 16 + j] = v; }
        else { const bf16 vf = (bf16)f2bf(kf), vb = (bf16)f2bf(kb);
            for (int t = tau; t < 32; ++t) { const int s = t - tau; TV[(size_t)(t * 16 + k) * 768 + s * 16 + j] = vf; TV[(size_t)(s * 16 + k) * 768 + t * 16 + j] = vb; } }
    }
    if (tid >= 256) {
        const int q = tid - 256;
        if (tau >= 1) {
#pragma unroll 1
            for (int i = 0; i < 8; ++i) { const int e = q * 8 + i, d = e >> 10, k = (e >> 6) & 15, p = e & 63;
                float vr, vi; cmul(cre[k * 64 + p], cim[k * 64 + p], PW[(d * 64 + p) * 2], PW[(d * 64 + p) * 2 + 1], vr, vi);
                const int t = d ? 32 - tau : tau - 1; bf16* row = TV + (size_t)(t * 16 + k) * 768 + 512 + d * 128;
                row[p] = (bf16)f2bf(vr); row[64 + p] = (bf16)f2bf(-vi); } }
        if (tau < 32) {
#pragma unroll 1
            for (int i = 0; i < 8; ++i) { const int e = q * 8 + i, d = e >> 10, p = (e >> 4) & 63, j = e & 15;
                float vr, vi; cmul(PQ[(d * 64 + p) * 2], PQ[(d * 64 + p) * 2 + 1], bre[p * 16 + j], bim[p * 16 + j], vr, vi);
                const int s = d ? tau : 31 - tau; bf16* col = WM + (size_t)(d * 128 + p) * 512 + s * 16 + j;
                col[0] = (bf16)f2bf(vr); col[(size_t)64 * 512] = (bf16)f2bf(vi); } }
    }
}
__device__ __forceinline__ void p0_s5(Frame& F) { for (int it = F.bid; it < S5_G * 33; it += F.G) s5_precompute_item(F, it / 33, it % 33); }

__device__ __forceinline__ void s5_scan_item(Frame& F, int item) {
    const int d = item & 1, b = (item >> 1) & 1, g = item >> 2, tid = F.tid;
    LAS float* S = (LAS float*)F.lds;
    const float* SL = WSP(float, WS_SLOC) + ((size_t)(g * 512 + b * 256) * 256 + d * 128);
    __syncthreads();
    for (int i = tid; i < 256 * 32; i += NTHR) { const int ci = i >> 5, c4 = (i & 31) * 4; *(LAS f32x4*)(S + ci * 128 + c4) = *(const f32x4*)(SL + (size_t)ci * 256 + c4); }
    __syncthreads();
    if (tid < 64) {
        const float* AQ = WSP(float, WS_AQ); const float qr = AQ[((g * 2 + d) * 64 + tid) * 2], qi = AQ[((g * 2 + d) * 64 + tid) * 2 + 1];
        float sr = 0.f, si = 0.f;
        for (int n = 0; n < 256; ++n) { const int ci = d ? 255 - n : n;
            const float tr_ = S[ci * 128 + tid], ti_ = S[ci * 128 + 64 + tid];
            S[ci * 128 + tid] = sr; S[ci * 128 + 64 + tid] = si;
            const float nr = qr * sr - qi * si + tr_, ni = qr * si + qi * sr + ti_; sr = nr; si = ni; }
    }
    __syncthreads();
    bf16* UC = WSP(bf16, A_UC) + ((size_t)(g * 512 + b * 256) * 768 + 512 + d * 128);
    for (int i = tid; i < 256 * 16; i += NTHR) { const int ci = i >> 4, c8 = (i & 15) * 8; const LAS float* s = S + ci * 128 + c8;
        v4u o; o.x = pk2(s[0], s[1]); o.y = pk2(s[2], s[3]); o.z = pk2(s[4], s[5]); o.w = pk2(s[6], s[7]);
        *(v4u*)(UC + (size_t)ci * 768 + c8) = o; }
}

__device__ __forceinline__ void unpack8(const v4u w, float (&f)[8]) { f[0] = bflo(w.x); f[1] = bfhi(w.x); f[2] = bflo(w.y); f[3] = bfhi(w.y); f[4] = bflo(w.z); f[5] = bfhi(w.z); f[6] = bflo(w.w); f[7] = bfhi(w.w); }
__device__ __forceinline__ void p2_conv(Frame& F) {
    const bf16* xbc = WSP(bf16, A_XBC); bf16* XT = WSP(bf16, A_XT); bf16* BT = WSP(bf16, A_BT); bf16* BN = WSP(bf16, A_BN); bf16* CN = WSP(bf16, A_CN);
    const float* cw = F.in[2]; const float* cb = F.in[3];
    constexpr int RUN = 32, NCG = XBC / 8, NITEM = (M / RUN) * NCG;
    for (int item = F.bid * NTHR + F.tid; item < NITEM; item += F.G * NTHR) {
        const int cg = item % NCG, r = item / NCG, ch = cg * 8, m0 = r * RUN, tb = m0 % T, bc = m0 >> 7, s0 = m0 & 127;
        float w[5][8], bias[8];
#pragma unroll
        for (int k = 0; k < 5; ++k) { const f32x4 a = *(const f32x4*)(cw + k * XBC + ch), b = *(const f32x4*)(cw + k * XBC + ch + 4); w[k][0] = a.x; w[k][1] = a.y; w[k][2] = a.z; w[k][3] = a.w; w[k][4] = b.x; w[k][5] = b.y; w[k][6] = b.z; w[k][7] = b.w; }
        { const f32x4 a = *(const f32x4*)(cb + ch), b = *(const f32x4*)(cb + ch + 4); bias[0] = a.x; bias[1] = a.y; bias[2] = a.z; bias[3] = a.w; bias[4] = b.x; bias[5] = b.y; bias[6] = b.z; bias[7] = b.w; }
        bf16* nat = nullptr; bf16* trn = nullptr;
        if (ch < SSD_IN) { trn = XT + ((size_t)(bc * SSD_H + (ch >> 6)) * 64 + (ch & 63)) * 128 + s0; }
        else if (ch < SSD_IN + 512) { const int cc = ch - SSD_IN; nat = BN + (size_t)m0 * 512 + cc; trn = BT + ((size_t)(bc * SSD_G + (cc >> 7)) * 128 + (cc & 127)) * 128 + s0; }
        else { nat = CN + (size_t)m0 * 512 + (ch - SSD_IN - 512); }
        const v4u zero4 = {0u, 0u, 0u, 0u};
        v4u rows[12];
        const bf16* src = xbc + (size_t)m0 * XBC + ch;
        rows[0] = (tb - 2 >= 0) ? *(const v4u*)(src - 2 * XBC) : zero4;
        rows[1] = (tb - 1 >= 0) ? *(const v4u*)(src - 1 * XBC) : zero4;
        rows[2] = *(const v4u*)(src);
        rows[3] = *(const v4u*)(src + XBC);
#pragma unroll 1
        for (int i8 = 0; i8 < RUN / 8; ++i8) {
#pragma unroll
            for (int q = 0; q < 8; ++q) { const int i = i8 * 8 + q + 2; rows[4 + q] = (tb + i < T) ? *(const v4u*)(src + (size_t)i * XBC) : zero4; }
            float o[8][8];
#pragma unroll
            for (int ii = 0; ii < 8; ++ii) { const int i = i8 * 8 + ii;
#pragma unroll
                for (int j = 0; j < 8; ++j) o[ii][j] = bias[j];
#pragma unroll
                for (int k = 0; k < 5; ++k) { float f[8]; unpack8(rows[ii + k], f);
#pragma unroll
                    for (int j = 0; j < 8; ++j) o[ii][j] += w[k][j] * f[j]; }
#pragma unroll
                for (int j = 0; j < 8; ++j) o[ii][j] = o[ii][j] * __builtin_amdgcn_rcpf(1.0f + __expf(-o[ii][j]));
                if (nat) { v4u q; q.x = pk2(o[ii][0], o[ii][1]); q.y = pk2(o[ii][2], o[ii][3]); q.z = pk2(o[ii][4], o[ii][5]); q.w = pk2(o[ii][6], o[ii][7]); *(v4u*)(nat + (size_t)i * 512) = q; } }
            if (trn) {
#pragma unroll
                for (int j = 0; j < 8; ++j) { v4u q; q.x = pk2(o[0][j], o[1][j]); q.y = pk2(o[2][j], o[3][j]); q.z = pk2(o[4][j], o[5][j]); q.w = pk2(o[6][j], o[7][j]); *(v4u*)(trn + (size_t)j * 128 + i8 * 8) = q; } }
#pragma unroll
            for (int q = 0; q < 4; ++q) rows[q] = rows[8 + q];
        }
    }
    {
        const int gw = F.bid * NWAVES + F.wave, NGW = F.G * NWAVES, lane = F.lane;
        const float* DT = WSP(float, A_DT); float* SV = WSP(float, A_SV); float* TOT = WSP(float, A_TOT);
        for (int it = gw; it < 128 * SSD_H * 2; it += NGW) {
            const int d = it & 1, h = (it >> 1) % SSD_H, bc = it / (2 * SSD_H);
            const float a = -__expf((d ? F.in[5] : F.in[4])[h]);
            const size_t mb = (size_t)bc * 128;
            const float dt0 = DT[(mb + 2 * lane) * 48 + d * 24 + h], dt1 = DT[(mb + 2 * lane + 1) * 48 + d * 24 + h];
            const float x0 = dt0 * a, x1 = dt1 * a, ps = x0 + x1;
            float inc = ps;
#pragma unroll
            for (int o = 1; o < 64; o <<= 1) { const float t_ = __shfl_up(inc, o); if (lane >= o) inc += t_; }
            const float total = __shfl(inc, 63), exc = inc - ps;
            const float ci0 = exc + x0, ci1 = inc;
            float cs0, cs1, w0, w1, f0, f1;
            if (d == 0) { cs0 = ci0; cs1 = ci1; w0 = dt0 * __expf(total - ci0); w1 = dt1 * __expf(total - ci1); f0 = __expf(ci0); f1 = __expf(ci1); }
            else { cs0 = exc; cs1 = ci0; w0 = dt0 * __expf(cs0); w1 = dt1 * __expf(cs1); f0 = __expf(total - cs0); f1 = __expf(total - cs1); }
            float* sv = SV + (size_t)it * 4 * 128 + 2 * lane;
            typedef float f32x2 __attribute__((ext_vector_type(2)));
            *(f32x2*)(sv) = (f32x2){w0, w1}; *(f32x2*)(sv + 128) = (f32x2){cs0, cs1}; *(f32x2*)(sv + 256) = (f32x2){dt0, dt1}; *(f32x2*)(sv + 384) = (f32x2){f0, f1};
            if (lane == 0) TOT[it] = __expf(total);
        }
    }
}

typedef short bf16x8 __attribute__((ext_vector_type(8)));
typedef float f32x16 __attribute__((ext_vector_type(16)));
__device__ __forceinline__ unsigned cvtpk(float lo, float hi) { return pg8::cvt_pk_bf16(lo, hi); }
__device__ __forceinline__ void ssd_state_item(Frame& F, int item) {
    const int nt = item & 3, u = item >> 2, h = u % SSD_H, bc = u / SSD_H, g = h / 6, b = bc >> 6, c = bc & 63, lane = F.lane, l31 = lane & 31, hf = lane >> 5;
    const bf16* XT = WSP(bf16, A_XT) + (size_t)u * 64 * 128; const bf16* BT = WSP(bf16, A_BT) + ((size_t)(bc * SSD_G + g) * 128 + nt * 32 + l31) * 128;
    const float* SV = WSP(float, A_SV); bf16* S = WSP(bf16, A_S);
    LAS float* wl = (LAS float*)(F.lds + F.wave * 1024);
    LDS_WAIT(); asm volatile("" ::: "memory");
#pragma unroll
    for (int d = 0; d < 2; ++d) { const float* sv = SV + (size_t)(u * 2 + d) * 4 * 128; wl[d * 128 + lane] = sv[lane]; wl[d * 128 + 64 + lane] = sv[64 + lane]; }
    LDS_WAIT(); asm volatile("" ::: "memory");
    f32x16 acc[2][2];
#pragma unroll
    for (int d = 0; d < 2; ++d)
#pragma unroll
        for (int pt = 0; pt < 2; ++pt)
#pragma unroll
            for (int r = 0; r < 16; ++r) acc[d][pt][r] = 0.f;
#pragma unroll
    for (int ks = 0; ks < 8; ++ks) {
        const int sb = ks * 16 + 8 * hf;
        const v4u a = *(const v4u*)(BT + sb);
        const bf16x8 b0 = *(const bf16x8*)(XT + (size_t)l31 * 128 + sb), b1 = *(const bf16x8*)(XT + (size_t)(32 + l31) * 128 + sb);
        float af[8]; unpack8(a, af);
#pragma unroll
        for (int d = 0; d < 2; ++d) {
            const f32x4 w0 = *(const LAS f32x4*)(wl + d * 128 + sb), w1 = *(const LAS f32x4*)(wl + d * 128 + sb + 4);
            v4u aw; aw.x = cvtpk(af[0] * w0.x, af[1] * w0.y); aw.y = cvtpk(af[2] * w0.z, af[3] * w0.w); aw.z = cvtpk(af[4] * w1.x, af[5] * w1.y); aw.w = cvtpk(af[6] * w1.z, af[7] * w1.w);
            const bf16x8 av = __builtin_bit_cast(bf16x8, aw);
            acc[d][0] = __builtin_amdgcn_mfma_f32_32x32x16_bf16(av, b0, acc[d][0], 0, 0, 0);
            acc[d][1] = __builtin_amdgcn_mfma_f32_32x32x16_bf16(av, b1, acc[d][1], 0, 0, 0);
        }
    }
#pragma unroll
    for (int d = 0; d < 2; ++d) { bf16* So = S + ((size_t)((b * SSD_H + h) * 2 + d) * 64 + c) * 8192;
#pragma unroll
        for (int pt = 0; pt < 2; ++pt)
#pragma unroll
            for (int q = 0; q < 4; ++q) { v2u o; o.x = cvtpk(acc[d][pt][4 * q], acc[d][pt][4 * q + 1]); o.y = cvtpk(acc[d][pt][4 * q + 2], acc[d][pt][4 * q + 3]);
                *(v2u*)(So + (size_t)(32 * pt + l31) * 128 + nt * 32 + 8 * q + 4 * hf) = o; } }
}
__device__ __forceinline__ void ssd_scan(Frame& F, int tg, int ntg) {
    bf16* S = WSP(bf16, A_S); const float* TOT = WSP(float, A_TOT);
    for (int item = tg; item < 96 * 1024; item += ntg) {
        const int e8 = item & 1023, bhd = item >> 10, d = bhd & 1, h = (bhd >> 1) % SSD_H, b = bhd / (2 * SSD_H);
        bf16* base = S + (size_t)bhd * 64 * 8192 + e8 * 8;
        float H[8];
#pragma unroll
        for (int j = 0; j < 8; ++j) H[j] = 0.f;
#pragma unroll 1
        for (int n0 = 0; n0 < 64; n0 += 8) {
            v4u v[8]; float dec[8];
#pragma unroll
            for (int k = 0; k < 8; ++k) { const int c = d ? 63 - (n0 + k) : n0 + k; v[k] = *(const v4u*)(base + (size_t)c * 8192); dec[k] = TOT[((b * 64 + c) * SSD_H + h) * 2 + d]; }
#pragma unroll
            for (int k = 0; k < 8; ++k) { const int c = d ? 63 - (n0 + k) : n0 + k; float f[8]; unpack8(v[k], f);
                v4u o; o.x = cvtpk(H[0], H[1]); o.y = cvtpk(H[2], H[3]); o.z = cvtpk(H[4], H[5]); o.w = cvtpk(H[6], H[7]);
                *(v4u*)(base + (size_t)c * 8192) = o;
#pragma unroll
                for (int j = 0; j < 8; ++j) H[j] = H[j] * dec[k] + f[j]; }
        }
    }
}
__device__ __forceinline__ void ssd_out_unit(Frame& F, int unit) {
    int lane = F.lane; asm volatile("" : "+v"(lane));
    const int g = unit & 3, bc = unit >> 2, b = bc >> 6, c = bc & 63, l31 = lane & 31, hf = lane >> 5, j = F.wave & 3, hh = F.wave >> 2;
    const size_t mb = (size_t)bc * 128;
    const bf16* CN = WSP(bf16, A_CN) + (mb + 32 * j + l31) * 512 + g * 128 + 8 * hf;
    const bf16* BN = WSP(bf16, A_BN) + (mb + l31) * 512 + g * 128 + 8 * hf;
    const float* SV = WSP(float, A_SV); const bf16* S = WSP(bf16, A_S); const bf16* XT = WSP(bf16, A_XT); bf16* Y = WSP(bf16, A_Y);
    LAS float* svl = (LAS float*)(F.lds + F.wave * 12288);
    asm volatile("" : "+v"(CN), "+v"(BN));
    LDS_WAIT(); asm volatile("" ::: "memory");
    {
        const f32x4* src = (const f32x4*)(SV + (size_t)((bc * SSD_H + g * 6 + hh * 3) * 2) * 512) + lane;
#pragma unroll
        for (int q = 0; q < 12; ++q) *(LAS f32x4*)(svl + (q * 64 + lane) * 4) = src[q * 64];
    }
    f32x16 cbt[4];
    {   bf16x8 cfr[8];
#pragma unroll
        for (int ks = 0; ks < 8; ++ks) cfr[ks] = *(const bf16x8*)(CN + ks * 16);
#pragma unroll
        for (int i = 0; i < 4; ++i) {
#pragma unroll
            for (int r = 0; r < 16; ++r) cbt[i][r] = 0.f;
#pragma unroll
            for (int ks = 0; ks < 8; ++ks) { const bf16x8 a = *(const bf16x8*)(BN + (size_t)(32 * i) * 512 + ks * 16); cbt[i] = __builtin_amdgcn_mfma_f32_32x32x16_bf16(a, cfr[ks], cbt[i], 0, 0, 0); }
            asm volatile("" ::: "memory");
        }
    }
    LDS_WAIT(); asm volatile("" ::: "memory");
    const int tl = 32 * j + l31;
#pragma unroll 1
    for (int i3 = 0; i3 < 3; ++i3) {
        const int h = g * 6 + hh * 3 + i3;
        const LAS float* vf = svl + (i3 * 2 + 0) * 512 + 128; const LAS float* vb = svl + (i3 * 2 + 1) * 512 + 128;
        const float csf_t = vf[tl], sf_t = vf[256 + tl], ecsb_t = vb[tl], sb_t = vb[256 + tl], Dh = F.in[8][h];
        int tlv = tl; asm volatile("" : "+v"(tlv));
        f32x16 acc[2];
        {
            const bf16* Hf = S + ((size_t)((b * SSD_H + h) * 2 + 0) * 64 + c) * 8192 + (size_t)l31 * 128 + 8 * hf; const bf16* Hb = Hf + (size_t)64 * 8192;
            const bf16* cn = CN; asm volatile("" : "+v"(Hf), "+v"(Hb), "+v"(cn));
            bf16x8 cfr[8];
#pragma unroll
            for (int ks = 0; ks < 8; ++ks) cfr[ks] = *(const bf16x8*)(cn + ks * 16);
#pragma unroll
            for (int pt = 0; pt < 2; ++pt) { f32x16 af;
#pragma unroll
                for (int r = 0; r < 16; ++r) af[r] = 0.f;
#pragma unroll
                for (int ks = 0; ks < 8; ++ks) { const bf16x8 a0 = *(const bf16x8*)(Hf + (size_t)(32 * pt) * 128 + ks * 16); af = __builtin_amdgcn_mfma_f32_32x32x16_bf16(a0, cfr[ks], af, 0, 0, 0); }
#pragma unroll
                for (int r = 0; r < 16; ++r) acc[pt][r] = af[r] * sf_t;
                asm volatile("" ::: "memory");
#pragma unroll
                for (int r = 0; r < 16; ++r) af[r] = 0.f;
#pragma unroll
                for (int ks = 0; ks < 8; ++ks) { const bf16x8 a1 = *(const bf16x8*)(Hb + (size_t)(32 * pt) * 128 + ks * 16); af = __builtin_amdgcn_mfma_f32_32x32x16_bf16(a1, cfr[ks], af, 0, 0, 0); }
#pragma unroll
                for (int r = 0; r < 16; ++r) acc[pt][r] += af[r] * sb_t;
                asm volatile("" ::: "memory"); }
        }
        const bf16* xt = XT + ((size_t)(bc * SSD_H + h) * 64 + l31) * 128 + 4 * hf;
        asm volatile("" : "+v"(xt));
#pragma unroll
        for (int i = 0; i < 4; ++i) {
#pragma unroll
            for (int k2 = 0; k2 < 2; ++k2) {
                const int sA = 32 * i + 16 * k2 + 4 * hf;
                float mv[8];
                if (i < j) {
                    const f32x4 c0 = *(const LAS f32x4*)(vf + sA), c1 = *(const LAS f32x4*)(vf + sA + 8), d0 = *(const LAS f32x4*)(vf + 128 + sA), d1 = *(const LAS f32x4*)(vf + 128 + sA + 8);
#pragma unroll
                    for (int e = 0; e < 4; ++e) { mv[e] = cbt[i][8 * k2 + e] * (d0[e] * __expf(fminf(csf_t - c0[e], 0.f))); mv[4 + e] = cbt[i][8 * k2 + 4 + e] * (d1[e] * __expf(fminf(csf_t - c1[e], 0.f))); }
                } else if (i > j) {
                    const f32x4 c0 = *(const LAS f32x4*)(vb + sA), c1 = *(const LAS f32x4*)(vb + sA + 8), d0 = *(const LAS f32x4*)(vb + 128 + sA), d1 = *(const LAS f32x4*)(vb + 128 + sA + 8);
#pragma unroll
                    for (int e = 0; e < 4; ++e) { mv[e] = cbt[i][8 * k2 + e] * (d0[e] * __expf(fminf(c0[e] - ecsb_t, 0.f))); mv[4 + e] = cbt[i][8 * k2 + 4 + e] * (d1[e] * __expf(fminf(c1[e] - ecsb_t, 0.f))); }
                } else {
                    const f32x4 c0 = *(const LAS f32x4*)(vf + sA), c1 = *(const LAS f32x4*)(vf + sA + 8), d0 = *(const LAS f32x4*)(vf + 128 + sA), d1 = *(const LAS f32x4*)(vf + 128 + sA + 8);
                    const f32x4 g0 = *(const LAS f32x4*)(vb + sA), g1 = *(const LAS f32x4*)(vb + sA + 8), h0 = *(const LAS f32x4*)(vb + 128 + sA), h1 = *(const LAS f32x4*)(vb + 128 + sA + 8);
#pragma unroll
                    for (int e = 0; e < 8; ++e) { const int s_ = sA + (e & 3) + 8 * (e >> 2); const float cf = e < 4 ? c0[e & 3] : c1[e & 3], df = e < 4 ? d0[e & 3] : d1[e & 3], cb_ = e < 4 ? g0[e & 3] : g1[e & 3], db = e < 4 ? h0[e & 3] : h1[e & 3];
                        float f = 0.f;
                        f += (s_ <= tlv) ? df * __expf(fminf(csf_t - cf, 0.f)) : 0.f;
                        f += (s_ >= tlv) ? db * __expf(fminf(cb_ - ecsb_t, 0.f)) : 0.f;
                        mv[e] = cbt[i][8 * k2 + e] * f + ((s_ == tlv) ? Dh : 0.f); }
                }
                v4u mw; mw.x = cvtpk(mv[0], mv[1]); mw.y = cvtpk(mv[2], mv[3]); mw.z = cvtpk(mv[4], mv[5]); mw.w = cvtpk(mv[6], mv[7]);
                const bf16x8 mfr = __builtin_bit_cast(bf16x8, mw);
#pragma unroll
                for (int pt = 0; pt < 2; ++pt) { const v2u x0 = *(const v2u*)(xt + (size_t)(32 * pt) * 128 + 32 * i + 16 * k2), x1 = *(const v2u*)(xt + (size_t)(32 * pt) * 128 + 32 * i + 16 * k2 + 8);
                    v4u xw; xw.x = x0.x; xw.y = x0.y; xw.z = x1.x; xw.w = x1.y;
                    acc[pt] = __builtin_amdgcn_mfma_f32_32x32x16_bf16(__builtin_bit_cast(bf16x8, xw), mfr, acc[pt], 0, 0, 0); }
                asm volatile("" ::: "memory");
            }
        }
        bf16* yo = Y + (mb + tl) * SSD_IN + h * 64 + 4 * hf;
        asm volatile("" : "+v"(yo));
#pragma unroll
        for (int pt = 0; pt < 2; ++pt)
#pragma unroll
            for (int q = 0; q < 4; ++q) { v2u o; o.x = cvtpk(acc[pt][4 * q], acc[pt][4 * q + 1]); o.y = cvtpk(acc[pt][4 * q + 2], acc[pt][4 * q + 3]); *(v2u*)(yo + 32 * pt + 8 * q) = o; }
    }
}

__device__ __forceinline__ void p4_combine(Frame& F) {
    const int gw = F.bid * NWAVES + F.wave, NGW = F.G * NWAVES, lane = F.lane;
    bf16* Y = WSP(bf16, A_Y); const bf16* Z = WSP(bf16, A_Z); const float* ng = F.in[9];
    for (int m = gw; m < M; m += NGW) {
#pragma unroll 1
        for (int gi = 0; gi < SSD_G; ++gi) {
            const int ch = gi * 384 + lane * 8; float y[8]; float ss = 0.f;
            if (lane < 48) { const size_t o = (size_t)m * SSD_IN + ch; float a[8], z[8]; unpack8(*(const v4u*)(Y + o), a); unpack8(*(const v4u*)(Z + o), z);
#pragma unroll
                for (int jj = 0; jj < 8; ++jj) { y[jj] = a[jj] * z[jj]; ss += y[jj] * y[jj]; } }
            ss = wave_sum(ss);
            const float r = 1.0f / sqrtf(ss * (1.0f / 384.0f) + RMS_EPS);
            if (lane < 48) { const f32x4 g0 = *(const f32x4*)(ng + ch), g1 = *(const f32x4*)(ng + ch + 4);
                v4u o; o.x = pk2(y[0] * r * g0.x, y[1] * r * g0.y); o.y = pk2(y[2] * r * g0.z, y[3] * r * g0.w); o.z = pk2(y[4] * r * g1.x, y[5] * r * g1.y); o.w = pk2(y[6] * r * g1.z, y[7] * r * g1.w);
                *(v4u*)(Y + (size_t)m * SSD_IN + ch) = o; }
        }
    }
}

__device__ __forceinline__ void p8_ln_router(Frame& F) {
    const int gw = F.bid * NWAVES + F.wave, NGW = F.G * NWAVES, lane = F.lane;
    LAS float* wr = (LAS float*)F.lds;
    for (int i = F.tid; i < D * NE; i += NTHR) wr[(i & 15) * D + (i >> 4)] = F.in[27][i];
    __syncthreads();
    const float* HP = WSP(float, A_HP); float* H = WSP(float, A_H); bf16* HB = WSP(bf16, A_HB); float* AFF = WSP(float, A_AFF);
    const float* g1 = F.in[25]; const float* b1 = F.in[26];
    for (int m = gw; m < M; m += NGW) {
        const f32x4* xr = (const f32x4*)(HP + (size_t)m * D) + lane;
        f32x4 v[4]; float s = 0.f;
#pragma unroll
        for (int j = 0; j < 4; ++j) { v[j] = xr[64 * j]; s += (v[j].x + v[j].y) + (v[j].z + v[j].w); }
        const float mean = wave_sum(s) * (1.f / D); float s2 = 0.f;
#pragma unroll
        for (int j = 0; j < 4; ++j) { v[j] = v[j] - mean; s2 += (v[j].x * v[j].x + v[j].y * v[j].y) + (v[j].z * v[j].z + v[j].w * v[j].w); }
        const float rstd = 1.f / sqrtf(wave_sum(s2) * (1.f / D) + LN_EPS);
        float lg[16];
#pragma unroll
        for (int e = 0; e < 16; ++e) lg[e] = 0.f;
#pragma unroll
        for (int j = 0; j < 4; ++j) { const int c = 4 * lane + 256 * j; const f32x4 gg = *(const f32x4*)(g1 + c), bb = *(const f32x4*)(b1 + c);
            v[j] = v[j] * rstd * gg + bb;
            *((f32x4*)(H + (size_t)m * D) + lane + 64 * j) = v[j];
            v2u hb; hb.x = pk2(v[j].x, v[j].y); hb.y = pk2(v[j].z, v[j].w); *((v2u*)(HB + (size_t)m * D) + lane + 64 * j) = hb;
#pragma unroll
            for (int e = 0; e < 16; ++e) { const f32x4 w4 = *(const LAS f32x4*)(wr + e * D + c); lg[e] += (v[j].x * w4.x + v[j].y * w4.y) + (v[j].z * w4.z + v[j].w * w4.w); }
            asm volatile("" ::: "memory"); }
        { const bool hi = lane & 32;
#pragma unroll
          for (int k = 0; k < 8; ++k) { const float keep = hi ? lg[k + 8] : lg[k], send = hi ? lg[k] : lg[k + 8]; lg[k] = keep + __shfl_xor(send, 32); } }
        { const bool hi = lane & 16;
#pragma unroll
          for (int k = 0; k < 4; ++k) { const float keep = hi ? lg[k + 4] : lg[k], send = hi ? lg[k] : lg[k + 4]; lg[k] = keep + __shfl_xor(send, 16); } }
        { const bool hi = lane & 8;
#pragma unroll
          for (int k = 0; k < 2; ++k) { const float keep = hi ? lg[k + 2] : lg[k], send = hi ? lg[k] : lg[k + 2]; lg[k] = keep + __shfl_xor(send, 8); } }
        { const bool hi = lane & 4; const float keep = hi ? lg[1] : lg[0], send = hi ? lg[0] : lg[1]; lg[0] = keep + __shfl_xor(send, 4); }
        float lo = lg[0]; lo += __shfl_xor(lo, 2); lo += __shfl_xor(lo, 1);
        float mx = lo;
#pragma unroll
        for (int o = 4; o < 64; o <<= 1) mx = fmaxf(mx, __shfl_xor(mx, o));
        const float ex = expf(lo - mx); float sum = ex;
#pragma unroll
        for (int o = 4; o < 64; o <<= 1) sum += __shfl_xor(sum, o);
        if ((lane & 3) == 0) { const int e = lane >> 2, b = m / T, t = m % T; AFF[((size_t)b * NE + e) * T + t] = ex / sum; }
    }
}

__device__ __forceinline__ unsigned block_excl_scan(unsigned v, LAS unsigned* wsum  , int lane, int wave, unsigned& total) {
    unsigned inc = v;
#pragma unroll
    for (int o = 1; o < 64; o <<= 1) { const unsigned t = __shfl_up(inc, o); if (lane >= o) inc += t; }
    __syncthreads();
    if (lane == 63) wsum[wave] = inc;
    __syncthreads();
    unsigned off = 0, tot = 0;
#pragma unroll
    for (int w = 0; w < 8; ++w) { const unsigned s = wsum[w]; if (w < wave) off += s; tot += s; }
    total = tot; return off + inc - v;
}
__device__ __forceinline__ void p9_topk(Frame& F, int be) {
    const int b = be >> 4, e = be & 15, tid = F.tid;
    const float* av = WSP(float, A_AFF) + (size_t)be * T;
    int* IDX = WSP(int, A_IDX); int* SEL = WSP(int, A_SEL); float* GATE = WSP(float, A_GATE);
    LAS unsigned* hist = (LAS unsigned*)F.lds; LAS unsigned* shv = hist + 256; LAS unsigned* wsum = hist + 272;
    unsigned key[16];
#pragma unroll
    for (int q = 0; q < 4; ++q) { const v4u k4 = *(const v4u*)(av + tid * 16 + 4 * q); key[4 * q] = k4.x; key[4 * q + 1] = k4.y; key[4 * q + 2] = k4.z; key[4 * q + 3] = k4.w; }
    unsigned prefix = 0, pmask = 0, krem = CAP;
    for (int pass = 0; pass < 4; ++pass) {
        const int shift = 24 - 8 * pass;
        if (tid < 256) hist[tid] = 0u;
        __syncthreads();
#pragma unroll
        for (int i = 0; i < 16; ++i) if ((key[i] & pmask) == prefix) (void)__hip_atomic_fetch_add(&hist[(key[i] >> shift) & 255u], 1u, __ATOMIC_RELAXED, __HIP_MEMORY_SCOPE_WORKGROUP);
        __syncthreads();
        if (tid < 256) { unsigned above = 0; for (int d = tid + 1; d < 256; ++d) above += hist[d]; const unsigned mine = hist[tid];
            if (above < krem && krem <= above + mine) { shv[0] = (unsigned)tid; shv[1] = krem - above; } }
        __syncthreads();
        prefix |= shv[0] << shift; pmask |= 255u << shift; krem = shv[1];
        __syncthreads();
    }
    const unsigned Tk = prefix;
    unsigned cg = 0, ce = 0;
#pragma unroll
    for (int i = 0; i < 16; ++i) { cg += key[i] > Tk; ce += key[i] == Tk; }
    unsigned totg, tote;
    unsigned pg = block_excl_scan(cg, wsum, F.lane, F.wave, totg);
    unsigned pe = block_excl_scan(ce, wsum + 8, F.lane, F.wave, tote);
#pragma unroll
    for (int i = 0; i < 16; ++i) {
        const int t = tid * 16 + i; int slot = -1;
        if (key[i] > Tk) slot = (int)(pg++);
        else if (key[i] == Tk) { if (pe < krem) slot = (int)(totg + pe); ++pe; }
        const size_t m = (size_t)b * T + t;
        SEL[m * NE + e] = slot; GATE[m * NE + e] = __uint_as_float(key[i]);
        if (slot >= 0) IDX[(e * NB + b) * CAP + slot] = (int)m;
    }
}
__device__ __forceinline__ void p10_gather(Frame& F) {
    const int gw = F.bid * NWAVES + F.wave, NGW = F.G * NWAVES, lane = F.lane;
    const int* IDX = WSP(int, A_IDX); const bf16* HB = WSP(bf16, A_HB); bf16* XIN = WSP(bf16, A_XIN);
    for (int r = gw; r < MROWS; r += NGW) { const int m = IDX[r];
        const v4u* s = (const v4u*)(HB + (size_t)m * D); v4u* d = (v4u*)(XIN + (size_t)r * D);
        const v4u a = s[lane], bq = s[lane + 64]; d[lane] = a; d[lane + 64] = bq; }
}
__device__ __forceinline__ void p13_final(Frame& F) {
    const int gw = F.bid * NWAVES + F.wave, NGW = F.G * NWAVES, lane = F.lane;
    const float* H = WSP(float, A_H); const int* SEL = WSP(int, A_SEL); const float* GATE = WSP(float, A_GATE); const bf16* YE = WSP(bf16, A_YE);
    const float* g2 = F.in[31]; const float* b2 = F.in[32];
    for (int m = gw; m < M; m += NGW) {
        const int b = m / T;
        const int sl = SEL[(size_t)m * NE + (lane & 15)]; const float gt = GATE[(size_t)m * NE + (lane & 15)];
        f32x4 v[4];
#pragma unroll
        for (int j = 0; j < 4; ++j) v[j] = *((const f32x4*)(H + (size_t)m * D) + lane + 64 * j) * ALPHA;
#pragma unroll 1
        for (int e = 0; e < NE; ++e) {
            const int s = __shfl(sl, e); const float gv = __shfl(gt, e);
            if (s >= 0) { const bf16* yr = YE + ((size_t)(e * NB + b) * CAP + s) * D;
#pragma unroll
                for (int j = 0; j < 4; ++j) { const v2u w = *((const v2u*)yr + lane + 64 * j); v[j].x += gv * bflo(w.x); v[j].y += gv * bfhi(w.x); v[j].z += gv * bflo(w.y); v[j].w += gv * bfhi(w.y); } }
        }
        float s = 0.f;
#pragma unroll
        for (int j = 0; j < 4; ++j) s += (v[j].x + v[j].y) + (v[j].z + v[j].w);
        const float mean = wave_sum(s) * (1.f / D); float s2 = 0.f;
#pragma unroll
        for (int j = 0; j < 4; ++j) { v[j] = v[j] - mean; s2 += (v[j].x * v[j].x + v[j].y * v[j].y) + (v[j].z * v[j].z + v[j].w * v[j].w); }
        const float rstd = 1.f / sqrtf(wave_sum(s2) * (1.f / D) + LN_EPS);
#pragma unroll
        for (int j = 0; j < 4; ++j) { const int c = 4 * lane + 256 * j; const f32x4 gg = *(const f32x4*)(g2 + c), bb = *(const f32x4*)(b2 + c);
            *((f32x4*)(F.out + (size_t)m * D) + lane + 64 * j) = v[j] * rstd * gg + bb; }
    }
}

constexpr int N_PHASES = 16;
struct Args { const float* in[33]; float* out; unsigned char* ws; int ph_lo, ph_hi; };
__global__ void __launch_bounds__(NTHR, 2) fwd(Args args) {
    extern __shared__ __attribute__((aligned(16))) unsigned char lds[];
    Frame F;
    F.lds = (LAS unsigned char*)lds;
    F.tid = threadIdx.x; F.lane = F.tid & 63; F.wave = __builtin_amdgcn_readfirstlane(F.tid >> 6);
    F.bid = blockIdx.x; F.G = gridDim.x;
    F.in = args.in;
    F.out = args.out; F.ws = args.ws;
    volatile LAS unsigned* MISC = (volatile LAS unsigned*)(F.lds + MISC_OFF);
    if (F.tid < 64) MISC[F.tid] = 0u;
    __syncthreads();
    const int lo = args.ph_lo, hi = args.ph_hi;
    const bool single = (hi - lo) > 1;
    XcdBarrier bar; bar.bar = (unsigned*)(F.ws + WS_CTL) + CW_BAR; bar.x = 0; bar.st = nullptr;
    if (single) bar = xcd_barrier_post((unsigned*)(F.ws + WS_CTL) + CW_BAR, MISC + 8);
#ifndef PH_MASK
#define PH_MASK 0xffff
#endif
#define IN(k) (((PH_MASK >> (k)) & 1) && lo <= (k) && (k) < hi)
#define LAUNDER1(T_, p_) do { unsigned long long x_ = (unsigned long long)(p_); unsigned lo_ = (unsigned)x_, hi_ = (unsigned)(x_ >> 32); asm volatile("" : "+v"(lo_), "+v"(hi_)); \
        lo_ = __builtin_amdgcn_readfirstlane(lo_); hi_ = __builtin_amdgcn_readfirstlane(hi_); (p_) = (T_)(((unsigned long long)hi_ << 32) | lo_); } while (0)
#define LAUNDER() do { } while (0)
#define SEAM(k) do { if (IN(k) && IN((k) + 1)) xcd_barrier(bar); } while (0)

    if (IN(0)) { LAUNDER(); p0_prologue(F); p0_s5(F); } SEAM(0);
    if (IN(1)) { LAUNDER();
        pg8::Gemm g{WSP(pg8::bf16_t, A_XB), WSP(pg8::bf16_t, WS_WIN), M, NIN_PAD, D, D, D}; pg8::StaticOrder S; S.init(M, NIN_PAD, F.G, F.bid);
        pg8::EpiIn E{WSP(pg8::bf16_t, A_Z), WSP(pg8::bf16_t, A_XBC), WSP(pg8::bf16_t, A_UC), WSP(pg8::bf16_t, A_GT), WSP(float, A_DT), F.in[6], F.in[7]};
        pg8::gemm_phase<pg8::EpiIn, pg8::StaticOrder, PG8_ALIGN, PG8_SP2>(F.lds, g, S, E);
    } SEAM(1);
    if (IN(2)) { LAUNDER();
        if (F.bid >= 160) { pg8::Gemm g{WSP(pg8::bf16_t, A_UC), WSP(pg8::bf16_t, WS_WS5), S5_G * 512, S5_G * 256, 512, 768, 512}; pg8::S5aOrder S{F.bid, 160};
            pg8::EpiS5a E{WSP(float, WS_SLOC)};
            pg8::gemm_phase<pg8::EpiS5a, pg8::S5aOrder, PG8_ALIGN, PG8_SP2>(F.lds, g, S, E); __syncthreads(); }
        p2_conv(F);
    } SEAM(2);
    if (IN(3)) { LAUNDER();
        for (int it = F.bid; it < S5_G * 4; it += F.G) s5_scan_item(F, it);
        __syncthreads();
        for (int it = F.bid * NWAVES + F.wave; it < 128 * SSD_H * 4; it += F.G * NWAVES) ssd_state_item(F, it);
    } SEAM(3);
    if (IN(4)) { LAUNDER();
        { pg8::Gemm g{WSP(pg8::bf16_t, A_UC), WSP(pg8::bf16_t, WS_TV), S5_G * 512, S5_G * 512, 768, 768, 768}; pg8::S5cOrder S{F.G, F.bid};
          pg8::EpiS5c E{WSP(pg8::bf16_t, A_GY), WSP(pg8::bf16_t, A_UC), F.in[21]};
          pg8::gemm_phase<pg8::EpiS5c, pg8::S5cOrder, PG8_ALIGN, PG8_SP2>(F.lds, g, S, E); }
        ssd_scan(F, F.bid * NTHR + F.tid, F.G * NTHR);
    } SEAM(4);
    if (IN(5)) { LAUNDER(); __syncthreads(); for (int u = F.bid; u < 128 * SSD_G; u += F.G) ssd_out_unit(F, u); } SEAM(5);
    if (IN(6)) { LAUNDER(); p4_combine(F); } SEAM(6);
    if (IN(7)) { LAUNDER();
        pg8::Gemm g{WSP(pg8::bf16_t, A_Y), WSP(pg8::bf16_t, WS_WOUT), M, D, SSD_IN, SSD_IN, SSD_IN}; pg8::StaticOrder S; S.init(M, D, F.G, F.bid);
        pg8::EpiSsdOut E{WSP(float, A_YA), WSP(pg8::bf16_t, A_GT)};
        pg8::gemm_phase<pg8::EpiSsdOut, pg8::StaticOrder, PG8_ALIGN, PG8_SP2>(F.lds, g, S, E);
    } SEAM(7);
    if (IN(8)) { LAUNDER();
        pg8::Gemm g{WSP(pg8::bf16_t, A_GY), WSP(pg8::bf16_t, WS_WGLU), M, 2 * D, S5_W, S5_W, S5_W}; pg8::StaticOrder S; S.init(M, 2 * D, F.G, F.bid);
        pg8::EpiGlu E{WSP(pg8::bf16_t, A_MIX), WSP(float, A_YA), WSP(pg8::bf16_t, A_GT)};
        pg8::gemm_phase<pg8::EpiGlu, pg8::StaticOrder, PG8_ALIGN, PG8_SP2>(F.lds, g, S, E);
    } SEAM(8);
    if (IN(9)) { LAUNDER();
        pg8::Gemm g{WSP(pg8::bf16_t, A_MIX), WSP(pg8::bf16_t, WS_WO), M, D, D, D, D}; pg8::StaticOrder S; S.init(M, D, F.G, F.bid);
        pg8::EpiWo E{WSP(float, A_HP), F.in[0], ALPHA};
        pg8::gemm_phase<pg8::EpiWo, pg8::StaticOrder, PG8_ALIGN, PG8_SP2>(F.lds, g, S, E);
    } SEAM(9);
    if (IN(10)) { LAUNDER(); p8_ln_router(F); } SEAM(10);
    if (IN(11)) { LAUNDER(); if (F.bid < NB * NE) p9_topk(F, F.bid); else w2_convert(F, (F.bid - NB * NE) * NWAVES + F.wave, (F.G - NB * NE) * NWAVES); } SEAM(11);
    if (IN(12)) { LAUNDER(); p10_gather(F); } SEAM(12);
    if (IN(13)) { LAUNDER();
        pg8::Gemm g{WSP(pg8::bf16_t, A_XIN), WSP(pg8::bf16_t, WS_W1), MROWS, NE * 2 * FF, D, D, D}; pg8::MoeOrder1 S{F.G, F.bid};
        pg8::EpiMoe1 E{WSP(pg8::bf16_t, A_HID)};
        pg8::gemm_phase<pg8::EpiMoe1, pg8::MoeOrder1, PG8_ALIGN, PG8_SP2>(F.lds, g, S, E);
    } SEAM(13);
    if (IN(14)) { LAUNDER();
        pg8::Gemm g{WSP(pg8::bf16_t, A_HID), WSP(pg8::bf16_t, WS_W2), MROWS, NE * D, FF, FF, FF}; pg8::MoeOrder2 S{F.G, F.bid};
        pg8::EpiMoe2 E{WSP(pg8::bf16_t, A_YE)};
        pg8::gemm_phase<pg8::EpiMoe2, pg8::MoeOrder2, PG8_ALIGN, PG8_SP2>(F.lds, g, S, E);
    } SEAM(14);
    if (IN(15)) { LAUNDER(); p13_final(F); }
#undef IN
#undef SEAM
}

#ifndef MK_ONE_LAUNCH
#define MK_ONE_LAUNCH 1
#endif
extern "C" void kernel_launch(void* const* d_in, const int* in_sizes, int n_in, void* d_out, int out_size, void* d_ws, size_t ws_size, hipStream_t stream) {
    static int grid = 0;
    if (grid == 0) {
        if (n_in != 33 || in_sizes[0] != M * D || out_size != M * D || ws_size < WS_END) { fprintf(stderr, "kernel_launch: unexpected problem (n_in %d, in0 %d, out %d, ws %zu < %zu)\n", n_in, n_in > 0 ? in_sizes[0] : -1, out_size, ws_size, (size_t)WS_END); grid = -1; return; }
        int dev = 0, cus = 0, per_cu = 0;
        if (hipGetDevice(&dev) != hipSuccess || hipDeviceGetAttribute(&cus, hipDeviceAttributeMultiprocessorCount, dev) != hipSuccess) { grid = -1; return; }
        if (hipFuncSetAttribute((const void*)fwd, hipFuncAttributeMaxDynamicSharedMemorySize, LDS_BYTES) != hipSuccess) { fprintf(stderr, "kernel_launch: hipFuncSetAttribute failed\n"); grid = -1; return; }
        if (hipOccupancyMaxActiveBlocksPerMultiprocessor(&per_cu, (const void*)fwd, NTHR, LDS_BYTES) != hipSuccess || per_cu < 1) fprintf(stderr, "kernel_launch: occupancy query reports %d blocks per CU\n", per_cu);
        (void)hipGetLastError();
        grid = cus;
    }
    if (grid < 0) return;
    (void)hipMemsetAsync((char*)d_ws + WS_CTL, 0, CTL_ZERO_BYTES, stream);
    Args a{};
    for (int i = 0; i < 33; ++i) a.in[i] = (const float*)d_in[i];
    a.out = (float*)d_out; a.ws = (unsigned char*)d_ws;
#if MK_ONE_LAUNCH
    a.ph_lo = 0; a.ph_hi = N_PHASES;
    hipLaunchKernelGGL(fwd, dim3(grid), dim3(NTHR), LDS_BYTES, stream, a);
#else
    for (int p = 0; p < N_PHASES; ++p) { a.ph_lo = p; a.ph_hi = p + 1; hipLaunchKernelGGL(fwd, dim3(grid), dim3(NTHR), LDS_BYTES, stream, a); }
#endif
}
```

```cpp
#include <hip/hip_runtime.h>
#include <cstdio>
#include <cstdint>
namespace pg8 {
#define PG8_LAS __attribute__((address_space(3)))
typedef unsigned short bf16_t;
typedef short bf16x8 __attribute__((ext_vector_type(8)));
typedef float f32x4 __attribute__((ext_vector_type(4)));
typedef unsigned u32x4 __attribute__((ext_vector_type(4)));
typedef int i32x8 __attribute__((ext_vector_type(8)));
constexpr int BM = 256, BK = 64, HALF = 128, HTB = HALF * BK * 2  , STAGE_BYTES = 8 * HTB, NXCD = 8, WGM = 8;

__host__ __device__ __forceinline__ int lds_byte(int r, int c) { const int st = (r >> 4) * 2 + (c >> 5), rr = r & 15, cc = c & 31, ob = rr * 64 + cc * 2; return st * 1024 + (ob ^ (((ob >> 9) & 1) << 5)); }
__host__ __device__ __forceinline__ void stage_rc(int b, int& R, int& C) { const int st = b / 1024, sb = b % 1024, swz = sb ^ (((sb >> 9) & 1) << 5); R = (st >> 1) * 16 + swz / 64; C = (st & 1) * 32 + (swz % 64) / 2; }
__host__ __device__ __forceinline__ int perm32(int rho) { const int n = rho >> 4, i = rho & 15; return 8 * (i >> 2) + 4 * n + (i & 3); }

struct Unit { int pm, pn; };
struct Gemm { const bf16_t* A; const bf16_t* Bt; int M, N, K, lda, ldb; };

struct StaticOrder {
    int nM, nN, nwg, G, c;
    __host__ __device__ void init(int M, int N, int G_, int c_) { nM = M / BM; nN = N / BM; nwg = nM * nN; G = G_; c = c_; }
    __host__ __device__ bool next(int i, Unit& u) const {
        const long L = (long)i * G + c; if (L >= nwg) return false;
        int wgid = (int)L; { const int q = nwg / NXCD, r = nwg % NXCD, xcd = wgid % NXCD, off = wgid / NXCD; wgid = (xcd < r ? xcd * (q + 1) : r * (q + 1) + (xcd - r) * q) + off; }
        const int nig = WGM * nN, gid = wgid / nig, fm = gid * WGM, gsz = (nM - fm) < WGM ? (nM - fm) : WGM;
        u.pm = fm + ((wgid % nig) % gsz); u.pn = (wgid % nig) / gsz; return true;
    }
    __device__ __forceinline__ void a_ready(const Unit&) const {}
    __device__ __forceinline__ void done(const Unit&) const {}
};

typedef __bf16 bf16v2_t __attribute__((ext_vector_type(2)));
typedef float f32v2_t __attribute__((ext_vector_type(2)));
__device__ __forceinline__ unsigned cvt_pk_bf16(float lo, float hi) { const f32v2_t f = {lo, hi}; return __builtin_bit_cast(unsigned, __builtin_convertvector(f, bf16v2_t)); }
typedef float f32x2 __attribute__((ext_vector_type(2)));
__device__ __forceinline__ f32x2 gelu_pk(f32x2 v) {
    const f32x2 av = __builtin_elementwise_abs(v), d = av * 0.2316418882f + 1.0f;
    f32x2 t; t.x = __builtin_amdgcn_rcpf(d.x); t.y = __builtin_amdgcn_rcpf(d.y);
    f32x2 q = t * 0.5307027145f + (-0.7265760135f); q = q * t + 0.7107068705f; q = q * t + (-0.142248368f); q = q * t + 0.127414796f; q = q * t;
    const f32x2 s = (v * v) * (-0.72134752044f);
    f32x2 e; e.x = __builtin_amdgcn_exp2f(s.x); e.y = __builtin_amdgcn_exp2f(s.y);
    const f32x2 m = v * (q * e), r = v - m;
    f32x2 o; o.x = v.x < 0.f ? m.x : r.x; o.y = v.y < 0.f ? m.y : r.y; return o;
}


__device__ __forceinline__ float fsigmoid(float x) { return __builtin_amdgcn_rcpf(1.0f + __expf(-x)); }
__device__ __forceinline__ float fsilu(float x) { return x * fsigmoid(x); }
__device__ __forceinline__ float bf_lo(unsigned w) { return __uint_as_float(w << 16); }
__device__ __forceinline__ float bf_hi(unsigned w) { return __uint_as_float(w & 0xffff0000u); }
typedef unsigned u32x2 __attribute__((ext_vector_type(2)));

struct EpiIn {
    static constexpr bool PERM = true, AFTER_DRAIN = false;
    bf16_t *Z, *XBC, *UC, *GT; float* DT; const float *dtb_f, *dtb_b;
    __device__ __forceinline__ void operator()(const f32x4 (&acc)[2][2][4][2], const Unit& u, int wr, int wc, int fr, int fq) const {
        const int row0 = u.pm * BM + wr * 64 + fr; const int pn = u.pn;
        if (pn == 16) {
            if (wc < 2) {
#pragma unroll
                for (int n = 0; n < 2; ++n) { const int col = wc * 32 + 8 * fq + 4 * n;
                    if (col < 48) { f32x4 bv;
#pragma unroll
                        for (int j = 0; j < 4; ++j) { const int cc = col + j; bv[j] = cc < 24 ? dtb_f[cc] : dtb_b[cc - 24]; }
#pragma unroll
                        for (int ai = 0; ai < 2; ++ai)
#pragma unroll
                            for (int m = 0; m < 4; ++m) { f32x4 v = acc[ai][0][m][n] + bv;
#pragma unroll
                                for (int j = 0; j < 4; ++j) { const float x = v[j]; v[j] = fmaxf(x, 0.f) + log1pf(__expf(-fabsf(x))); }
                                *(f32x4*)(DT + (size_t)(row0 + ai * HALF + m * 16) * 48 + col) = v; } } }
            }
            return;
        }
        int mode, ldc, colt; bf16_t* base;
        if (pn < 6) { mode = 1; base = Z; ldc = 1536; colt = pn * BM; }
        else if (pn < 16) { mode = 0; base = XBC; ldc = 2560; colt = (pn - 6) * BM; }
        else if (pn < 20) {
            const int uc = (pn - 17) * BM + wc * 32 + 8 * fq, g0 = uc >> 4, j0 = uc & 15;
#pragma unroll
            for (int ai = 0; ai < 2; ++ai)
#pragma unroll
                for (int m = 0; m < 4; ++m) { const int r = row0 + ai * HALF + m * 16, cl = r >> 5, s = r & 31;
#pragma unroll
                    for (int bj = 0; bj < 2; ++bj) { const f32x4 v0 = acc[ai][bj][m][0], v1 = acc[ai][bj][m][1];
                        u32x4 w; w.x = cvt_pk_bf16(v0[0], v0[1]); w.y = cvt_pk_bf16(v0[2], v0[3]); w.z = cvt_pk_bf16(v1[0], v1[1]); w.w = cvt_pk_bf16(v1[2], v1[3]);
                        *(u32x4*)(UC + ((size_t)((g0 + 8 * bj) * 512 + cl) * 768 + s * 16 + j0)) = w; } }
            return; }
        else { mode = 2; base = GT; ldc = 2048; colt = (pn - 20) * BM; }
        const int col0 = colt + wc * 32 + 8 * fq;
#pragma unroll
        for (int ai = 0; ai < 2; ++ai)
#pragma unroll
            for (int m = 0; m < 4; ++m) { bf16_t* rowp = base + (size_t)(row0 + ai * HALF + m * 16) * ldc + col0;
#pragma unroll
                for (int bj = 0; bj < 2; ++bj) { f32x4 v0 = acc[ai][bj][m][0], v1 = acc[ai][bj][m][1];
                    if (mode == 1) {
#pragma unroll
                        for (int j = 0; j < 4; ++j) { v0[j] = fsilu(v0[j]); v1[j] = fsilu(v1[j]); } }
                    else if (mode == 2) {
#pragma unroll
                        for (int j = 0; j < 4; ++j) { v0[j] = fsigmoid(v0[j]); v1[j] = fsigmoid(v1[j]); } }
                    u32x4 w; w.x = cvt_pk_bf16(v0[0], v0[1]); w.y = cvt_pk_bf16(v0[2], v0[3]); w.z = cvt_pk_bf16(v1[0], v1[1]); w.w = cvt_pk_bf16(v1[2], v1[3]);
                    *(u32x4*)(rowp + bj * HALF) = w; } }
    }
};
struct EpiSsdOut {
    static constexpr bool PERM = true, AFTER_DRAIN = false;
    bf16_t* MIX; const bf16_t* YB; const bf16_t* GT;
    __device__ __forceinline__ void operator()(const f32x4 (&acc)[2][2][4][2], const Unit& u, int wr, int wc, int fr, int fq) const {
        const int row0 = u.pm * BM + wr * 64 + fr, col0 = u.pn * BM + wc * 32 + 8 * fq;
#pragma unroll
        for (int ai = 0; ai < 2; ++ai)
#pragma unroll
            for (int m = 0; m < 4; ++m) { const size_t r = (size_t)(row0 + ai * HALF + m * 16);
#pragma unroll
                for (int bj = 0; bj < 2; ++bj) { const int c = col0 + bj * HALF; const u32x4 g = *(const u32x4*)(GT + r * 2048 + c), y = *(const u32x4*)(YB + r * 1024 + c);
                    const f32x4 a0 = acc[ai][bj][m][0], a1 = acc[ai][bj][m][1];
                    u32x4 w; w.x = cvt_pk_bf16(a0[0] * bf_lo(g.x) + bf_lo(y.x), a0[1] * bf_hi(g.x) + bf_hi(y.x)); w.y = cvt_pk_bf16(a0[2] * bf_lo(g.y) + bf_lo(y.y), a0[3] * bf_hi(g.y) + bf_hi(y.y));
                    w.z = cvt_pk_bf16(a1[0] * bf_lo(g.z) + bf_lo(y.z), a1[1] * bf_hi(g.z) + bf_hi(y.z)); w.w = cvt_pk_bf16(a1[2] * bf_lo(g.w) + bf_lo(y.w), a1[3] * bf_hi(g.w) + bf_hi(y.w));
                    *(u32x4*)(MIX + r * 1024 + c) = w; } }
    }
};
struct EpiGlu {
    static constexpr bool PERM = true, AFTER_DRAIN = false;
    bf16_t* YB; const bf16_t* GT;
    __device__ __forceinline__ void operator()(const f32x4 (&acc)[2][2][4][2], const Unit& u, int wr, int wc, int fr, int fq) const {
        const int row0 = u.pm * BM + wr * 64 + fr, col0 = u.pn * HALF + wc * 32 + 8 * fq;
#pragma unroll
        for (int ai = 0; ai < 2; ++ai)
#pragma unroll
            for (int m = 0; m < 4; ++m) { const size_t r = (size_t)(row0 + ai * HALF + m * 16);
                const u32x4 g = *(const u32x4*)(GT + r * 2048 + 1024 + col0);
                f32x4 a0 = acc[ai][0][m][0], a1 = acc[ai][0][m][1]; const f32x4 b0 = acc[ai][1][m][0], b1 = acc[ai][1][m][1];
#pragma unroll
                for (int j = 0; j < 4; ++j) { a0[j] *= fsigmoid(b0[j]); a1[j] *= fsigmoid(b1[j]); }
                u32x4 w; w.x = cvt_pk_bf16(a0[0] * bf_lo(g.x), a0[1] * bf_hi(g.x)); w.y = cvt_pk_bf16(a0[2] * bf_lo(g.y), a0[3] * bf_hi(g.y)); w.z = cvt_pk_bf16(a1[0] * bf_lo(g.z), a1[1] * bf_hi(g.z)); w.w = cvt_pk_bf16(a1[2] * bf_lo(g.w), a1[3] * bf_hi(g.w));
                *(u32x4*)(YB + r * 1024 + col0) = w; }
    }
};
struct EpiWo {
    static constexpr bool PERM = false, AFTER_DRAIN = false;
    float* HP; const float* X; float alpha;
    __device__ __forceinline__ void operator()(const f32x4 (&acc)[2][2][4][2], const Unit& u, int wr, int wc, int fr, int fq) const {
        const int row0 = u.pm * BM + wr * 64 + fr, col0 = u.pn * BM + wc * 32 + 4 * fq;
#pragma unroll
        for (int ai = 0; ai < 2; ++ai)
#pragma unroll
            for (int m = 0; m < 4; ++m) { const size_t r = (size_t)(row0 + ai * HALF + m * 16);
#pragma unroll
                for (int bj = 0; bj < 2; ++bj)
#pragma unroll
                    for (int n = 0; n < 2; ++n) { const int c = col0 + bj * HALF + n * 16; const f32x4 xv = *(const f32x4*)(X + r * 1024 + c);
                        *(f32x4*)(HP + r * 1024 + c) = acc[ai][bj][m][n] + xv * alpha; } }
    }
};
__device__ __forceinline__ unsigned pk4_fp8_(float a, float b, float c, float d) { int r_ = __builtin_amdgcn_cvt_pk_fp8_f32(a, b, 0, false); r_ = __builtin_amdgcn_cvt_pk_fp8_f32(c, d, r_, true); return (unsigned)r_; }
struct EpiMoe1 {
    static constexpr bool PERM = true, AFTER_DRAIN = false;
    unsigned char* HID; float inv, hs;
    __device__ __forceinline__ void operator()(const f32x4 (&acc)[2][2][4][2], const Unit& u, int wr, int wc, int fr, int fq) const {
        const int row0 = u.pm * BM + wr * 64 + fr, col0 = (u.pn % 22) * HALF + wc * 32 + 8 * fq;
#pragma unroll
        for (int ai = 0; ai < 2; ++ai)
#pragma unroll
            for (int m = 0; m < 4; ++m) { const size_t r = (size_t)(row0 + ai * HALF + m * 16);
                f32x4 a0 = acc[ai][0][m][0] * inv, a1 = acc[ai][0][m][1] * inv; const f32x4 b0 = acc[ai][1][m][0] * (inv * hs), b1 = acc[ai][1][m][1] * (inv * hs);
#pragma unroll
                for (int j = 0; j < 4; ++j) { a0[j] = fsilu(a0[j]) * b0[j]; a1[j] = fsilu(a1[j]) * b1[j]; }
                u32x2 w; w.x = pk4_fp8_(a0[0], a0[1], a0[2], a0[3]); w.y = pk4_fp8_(a1[0], a1[1], a1[2], a1[3]);
                *(u32x2*)(HID + r * 2816 + col0) = w; }
    }
};
struct EpiMoe2 {
    static constexpr bool PERM = true, AFTER_DRAIN = false;
    bf16_t* Y; float inv;
    __device__ __forceinline__ void operator()(const f32x4 (&acc)[2][2][4][2], const Unit& u, int wr, int wc, int fr, int fq) const {
        const int row0 = u.pm * BM + wr * 64 + fr, col0 = (u.pn & 3) * BM + wc * 32 + 8 * fq;
#pragma unroll
        for (int ai = 0; ai < 2; ++ai)
#pragma unroll
            for (int m = 0; m < 4; ++m) { bf16_t* rowp = Y + (size_t)(row0 + ai * HALF + m * 16) * 1024 + col0;
#pragma unroll
                for (int bj = 0; bj < 2; ++bj) { const f32x4 v0 = acc[ai][bj][m][0] * inv, v1 = acc[ai][bj][m][1] * inv;
                    u32x4 w; w.x = cvt_pk_bf16(v0[0], v0[1]); w.y = cvt_pk_bf16(v0[2], v0[3]); w.z = cvt_pk_bf16(v1[0], v1[1]); w.w = cvt_pk_bf16(v1[2], v1[3]);
                    *(u32x4*)(rowp + bj * HALF) = w; } }
    }
};
struct EpiS5a {
    static constexpr bool PERM = false, AFTER_DRAIN = false;
    float* SLOC;
    __device__ __forceinline__ void operator()(const f32x4 (&acc)[2][2][4][2], const Unit& u, int wr, int wc, int fr, int fq) const {
        const int row0 = u.pm * BM + wr * 64 + fr, col0 = wc * 32 + 4 * fq;
#pragma unroll
        for (int ai = 0; ai < 2; ++ai)
#pragma unroll
            for (int m = 0; m < 4; ++m) { float* rowp = SLOC + (size_t)(row0 + ai * HALF + m * 16) * 256 + col0;
#pragma unroll
                for (int bj = 0; bj < 2; ++bj)
#pragma unroll
                    for (int n = 0; n < 2; ++n) *(f32x4*)(rowp + bj * HALF + n * 16) = acc[ai][bj][m][n]; }
    }
};
__device__ __forceinline__ float gelu_tanh_f(float x) { const float uu = 0.7978845608028654f * (x + 0.044715f * x * x * x); const float e = __expf(2.f * uu); return 0.5f * x * (2.f - 2.f * __builtin_amdgcn_rcpf(e + 1.f)); }
struct EpiS5c {
    static constexpr bool PERM = true, AFTER_DRAIN = false;
    bf16_t* GY; const bf16_t* UC; const float* d5;
    __device__ __forceinline__ void operator()(const f32x4 (&acc)[2][2][4][2], const Unit& u, int wr, int wc, int fr, int fq) const {
        const int g = u.pm >> 1, cl0 = (u.pm & 1) * BM + wr * 64 + fr, nl0 = (u.pn & 1) * BM + wc * 32 + 8 * fq;
        const int k0 = nl0 & 15; const f32x4 d0 = *(const f32x4*)(d5 + g * 16 + k0), d1 = *(const f32x4*)(d5 + g * 16 + k0 + 4);
#pragma unroll
        for (int ai = 0; ai < 2; ++ai)
#pragma unroll
            for (int m = 0; m < 4; ++m) { const int cl = cl0 + ai * HALF + m * 16;
#pragma unroll
                for (int bj = 0; bj < 2; ++bj) { const int nl = nl0 + bj * HALF, t = nl >> 4;
                    const u32x4 uw = *(const u32x4*)(UC + ((size_t)(g * 512 + cl) * 768 + nl));
                    f32x4 v0 = acc[ai][bj][m][0], v1 = acc[ai][bj][m][1];
                    v0[0] += bf_lo(uw.x) * d0[0]; v0[1] += bf_hi(uw.x) * d0[1]; v0[2] += bf_lo(uw.y) * d0[2]; v0[3] += bf_hi(uw.y) * d0[3];
                    v1[0] += bf_lo(uw.z) * d1[0]; v1[1] += bf_hi(uw.z) * d1[1]; v1[2] += bf_lo(uw.w) * d1[2]; v1[3] += bf_hi(uw.w) * d1[3];
#pragma unroll
                    for (int j = 0; j < 4; ++j) { v0[j] = gelu_tanh_f(v0[j]); v1[j] = gelu_tanh_f(v1[j]); }
                    u32x4 w; w.x = cvt_pk_bf16(v0[0], v0[1]); w.y = cvt_pk_bf16(v0[2], v0[3]); w.z = cvt_pk_bf16(v1[0], v1[1]); w.w = cvt_pk_bf16(v1[2], v1[3]);
                    *(u32x4*)(GY + (size_t)(cl * 32 + t) * 768 + g * 16 + k0) = w; } }
    }
};
struct S5aOrder {
    int c, lo;
    __device__ __forceinline__ bool next(int i, Unit& u) const { if (i > 0 || c < lo || c >= lo + 96) return false; u.pm = c - lo; u.pn = (c - lo) >> 1; return true; }
    __device__ __forceinline__ void a_ready(const Unit&) const {}
    __device__ __forceinline__ void done(const Unit&) const {}
};
struct S5cOrder {
    int G, c;
    __device__ __forceinline__ bool next(int i, Unit& u) const { const int L = i * G + c; if (L >= 192) return false; const int g = L >> 2; u.pm = 2 * g + (L & 1); u.pn = 2 * g + ((L >> 1) & 1); return true; }
    __device__ __forceinline__ void a_ready(const Unit&) const {}
    __device__ __forceinline__ void done(const Unit&) const {}
};
struct MoeOrder1 {
    int G, c;
    __device__ __forceinline__ bool next(int i, Unit& u) const {
        if (G == 256) { if (i >= 11) return false; const int x = c & 7, j = c >> 3, q = x * 44 + i * 4 + (j >> 3); u.pm = (q / 22) * 8 + (j & 7); u.pn = q; return true; }
        const long L = (long)i * G + c; if (L >= 2816) return false; const int e = (int)(L / 176), r = (int)(L % 176); u.pm = e * 8 + (r & 7); u.pn = e * 22 + (r >> 3); return true;
    }
    __device__ __forceinline__ void a_ready(const Unit&) const {}
    __device__ __forceinline__ void done(const Unit&) const {}
};
struct MoeOrder2 {
    int G, c;
    __device__ __forceinline__ bool next(int i, Unit& u) const {
        if (G == 256) { if (i >= 2) return false; const int x = c & 7, j = c >> 3, e = 2 * x + i; u.pm = e * 8 + (j & 7); u.pn = e * 4 + (j >> 3); return true; }
        const long L = (long)i * G + c; if (L >= 512) return false; const int e = (int)(L / 32), r = (int)(L % 32); u.pm = e * 8 + (r & 7); u.pn = e * 4 + (r >> 3); return true;
    }
    __device__ __forceinline__ void a_ready(const Unit&) const {}
    __device__ __forceinline__ void done(const Unit&) const {}
};
template <class Epi, class Sched, bool ALIGN_EPI = false, bool SP2 = false, bool F8 = false>
__device__ __forceinline__ void gemm_phase(PG8_LAS unsigned char* lds, const Gemm g, const Sched& S, const Epi& E, const int tid) {
    const int wid = __builtin_amdgcn_readfirstlane(tid >> 6), lane = tid & 63, wr = wid >> 2, wc = wid & 3, fr = lane & 15, fq = lane >> 4;
    const int K = g.K, nt = F8 ? K / 128 : K / BK; constexpr int ESZ = F8 ? 1 : 2, KOFF = F8 ? 16 : 1024;
    unsigned voffA, voffB;
    { int R, C; stage_rc(tid * 16, R, C); const int Rb = Epi::PERM ? ((R & ~31) + perm32(R & 31)) : R;
      voffA = (unsigned)(R * g.lda * ESZ + C * 2); voffB = (unsigned)(Rb * g.ldb * ESZ + C * 2); }
    const unsigned r64A = 64u * (unsigned)g.lda * ESZ, r64B = 64u * (unsigned)g.ldb * ESZ;
    const __amdgpu_buffer_rsrc_t rsrcA = __builtin_amdgcn_make_buffer_rsrc((void*)g.A, 0, (int)((unsigned)g.M * (unsigned)g.lda * ESZ), 0x00020000), rsrcB = __builtin_amdgcn_make_buffer_rsrc((void*)g.Bt, 0, (int)((unsigned)g.N * (unsigned)g.ldb * ESZ), 0x00020000);
    const unsigned kstep = (unsigned)(BK * 2);
    const unsigned hstepA = (unsigned)HALF * g.lda * ESZ, hstepB = (unsigned)HALF * g.ldb * ESZ;
    const unsigned tstepA = 2 * hstepA, tstepB = 2 * hstepB;
    const unsigned ldsw = (unsigned)wid * 1024u;
    const int aoff = lds_byte(wr * 64 + fr, F8 ? fq * 16 : fq * 8), boff = lds_byte(wc * 32 + fr, F8 ? fq * 16 : fq * 8);
#define PG8_SA(b, h) (((b) * 2 + (h)) * HTB)
#define PG8_SB(b, h) ((4 + (b) * 2 + (h)) * HTB)
#define PG8_STAGE(bufoff, gbase, voff) do { _Pragma("unroll") for (int _i = 0; _i < 2; ++_i) \
        __builtin_amdgcn_raw_ptr_buffer_load_lds(PG8_RSRC(voff), (PG8_LAS unsigned*)(lds + (bufoff) + ldsw + _i * 8192), 16, (int)(voff), (int)((gbase) + _i * PG8_R64(voff)), 0, 0); } while (0)
#define PG8_RSRC(voff) (&(voff) == &voffA ? rsrcA : rsrcB)
#define PG8_R64(voff) (&(voff) == &voffA ? r64A : r64B)
#define PG8_LDA(dst, b, h) do { _Pragma("unroll") for (int m = 0; m < 4; ++m) _Pragma("unroll") for (int k = 0; k < 2; ++k) dst[m][k] = *(const PG8_LAS bf16x8*)(lds + PG8_SA(b, h) + aoff + m * 2048 + k * KOFF); } while (0)
#define PG8_LDB(dst, b, h) do { _Pragma("unroll") for (int n = 0; n < 2; ++n) _Pragma("unroll") for (int k = 0; k < 2; ++k) dst[n][k] = *(const PG8_LAS bf16x8*)(lds + PG8_SB(b, h) + boff + n * 2048 + k * KOFF); } while (0)
#define PG8_CAT8(x_) __builtin_bit_cast(i32x8, __builtin_shufflevector((x_)[0], (x_)[1], 0, 1, 2, 3, 4, 5, 6, 7, 8, 9, 10, 11, 12, 13, 14, 15))
#define PG8_MMA(ai, bj, At, Bt) do { __builtin_amdgcn_s_setprio(1); if constexpr (F8) { _Pragma("unroll") for (int m = 0; m < 4; ++m) _Pragma("unroll") for (int n = 0; n < 2; ++n) \
        acc[ai][bj][m][n] = __builtin_amdgcn_mfma_scale_f32_16x16x128_f8f6f4(PG8_CAT8(Bt[n]), PG8_CAT8(At[m]), acc[ai][bj][m][n], 0, 0, 0, 0x7f7f7f7f, 0, 0x7f7f7f7f); } \
      else { _Pragma("unroll") for (int m = 0; m < 4; ++m) _Pragma("unroll") for (int n = 0; n < 2; ++n) _Pragma("unroll") for (int k = 0; k < 2; ++k) \
        acc[ai][bj][m][n] = __builtin_amdgcn_mfma_f32_16x16x32_bf16(Bt[n][k], At[m][k], acc[ai][bj][m][n], 0, 0, 0); } __builtin_amdgcn_s_setprio(0); } while (0)
#define PG8_WAIT_V(n) asm volatile("s_waitcnt vmcnt(" #n ")" ::: "memory")
#define PG8_WAIT_L(n) asm volatile("s_waitcnt lgkmcnt(" #n ")" ::: "memory")
#define PG8_BAR __builtin_amdgcn_s_barrier()
#define PG8_SCHED __builtin_amdgcn_sched_barrier(0)
    Unit cur, nxt; int ui = 0;
    if (!S.next(0, cur)) return;
    f32x4 acc[2][2][4][2];
#pragma unroll
    for (int a = 0; a < 2; ++a)
#pragma unroll
        for (int b = 0; b < 2; ++b)
#pragma unroll
            for (int m = 0; m < 4; ++m)
#pragma unroll
                for (int n = 0; n < 2; ++n) acc[a][b][m][n] = (f32x4){0.f, 0.f, 0.f, 0.f};
    bf16x8 At[4][2], B0[2][2], B1[2][2];
    unsigned cA = (unsigned)cur.pm * tstepA, cB = (unsigned)cur.pn * tstepB;
    S.a_ready(cur);
    if constexpr (SP2) {
        PG8_STAGE(PG8_SB(0, 0), cB, voffB); PG8_STAGE(PG8_SB(0, 1), cB + hstepB, voffB); PG8_STAGE(PG8_SA(0, 0), cA, voffA); PG8_STAGE(PG8_SA(0, 1), cA + hstepA, voffA);
        if (wr == 1) PG8_BAR;
        PG8_WAIT_V(2); PG8_BAR;
        PG8_STAGE(PG8_SB(1, 0), cB + kstep, voffB); PG8_STAGE(PG8_SA(1, 0), cA + kstep, voffA); PG8_STAGE(PG8_SB(1, 1), cB + hstepB + kstep, voffB);
        PG8_WAIT_V(6); PG8_BAR;
    } else {
        PG8_STAGE(PG8_SB(0, 0), cB, voffB); PG8_STAGE(PG8_SA(0, 0), cA, voffA); PG8_STAGE(PG8_SB(0, 1), cB + hstepB, voffB); PG8_STAGE(PG8_SA(0, 1), cA + hstepA, voffA);
        if (wr == 1) PG8_BAR;
        PG8_WAIT_V(4); PG8_BAR;
        PG8_STAGE(PG8_SB(1, 0), cB + kstep, voffB); PG8_STAGE(PG8_SA(1, 0), cA + kstep, voffA); PG8_STAGE(PG8_SB(1, 1), cB + hstepB + kstep, voffB);
        PG8_WAIT_V(6); PG8_BAR;
    }
    for (;;) {
        const bool has_next = S.next(ui + 1, nxt);
        const unsigned nA = has_next ? (unsigned)nxt.pm * tstepA : cA, nB = has_next ? (unsigned)nxt.pn * tstepB : cB;
#pragma unroll 1
        for (int t = 0; t < nt; t += 2) {
            const bool last = (t == nt - 2);
            const unsigned a1 = cA + (unsigned)(t + 1) * kstep;
            const unsigned a2 = last ? nA : cA + (unsigned)(t + 2) * kstep, b2 = last ? nB : cB + (unsigned)(t + 2) * kstep;
            const unsigned a3 = a2 + kstep, b3 = b2 + kstep;
            if (last && has_next) S.a_ready(nxt);
            if constexpr (SP2) {
            PG8_LDB(B0, 0, 0); PG8_LDB(B1, 0, 1); PG8_SCHED; PG8_LDA(At, 0, 0); PG8_STAGE(PG8_SA(1, 1), a1 + hstepA, voffA);
            PG8_WAIT_V(8); PG8_WAIT_L(0); PG8_BAR; PG8_MMA(0, 0, At, B0); PG8_MMA(0, 1, At, B1); PG8_BAR; PG8_SCHED;
            PG8_LDA(At, 0, 1); PG8_STAGE(PG8_SB(0, 0), b2, voffB); PG8_STAGE(PG8_SB(0, 1), b2 + hstepB, voffB); PG8_STAGE(PG8_SA(0, 0), a2, voffA);
            PG8_WAIT_V(8); PG8_WAIT_L(0); PG8_BAR; PG8_MMA(1, 0, At, B0); PG8_MMA(1, 1, At, B1); PG8_BAR; PG8_SCHED;
            PG8_LDB(B0, 1, 0); PG8_LDB(B1, 1, 1); PG8_SCHED; PG8_LDA(At, 1, 0); PG8_STAGE(PG8_SA(0, 1), a2 + hstepA, voffA);
            PG8_WAIT_V(8); PG8_WAIT_L(0); PG8_BAR; PG8_MMA(0, 0, At, B0); PG8_MMA(0, 1, At, B1); PG8_BAR; PG8_SCHED;
            PG8_LDA(At, 1, 1); PG8_STAGE(PG8_SB(1, 0), b3, voffB); PG8_STAGE(PG8_SB(1, 1), b3 + hstepB, voffB); PG8_STAGE(PG8_SA(1, 0), a3, voffA);
            PG8_WAIT_V(8); PG8_WAIT_L(0); PG8_BAR; PG8_MMA(1, 0, At, B0); PG8_MMA(1, 1, At, B1); PG8_BAR; PG8_SCHED;
            } else {
            PG8_LDB(B0, 0, 0); PG8_SCHED; PG8_LDA(At, 0, 0); PG8_STAGE(PG8_SA(1, 1), a1 + hstepA, voffA);
            PG8_WAIT_L(8); PG8_BAR; PG8_WAIT_L(0); PG8_MMA(0, 0, At, B0); PG8_BAR; PG8_SCHED;
            PG8_LDB(B1, 0, 1); PG8_STAGE(PG8_SB(0, 0), b2, voffB);
            PG8_BAR; PG8_WAIT_L(0); PG8_MMA(0, 1, At, B1); PG8_BAR;
            PG8_LDA(At, 0, 1); PG8_STAGE(PG8_SA(0, 0), a2, voffA);
            PG8_BAR; PG8_WAIT_L(0); PG8_MMA(1, 0, At, B0); PG8_BAR; PG8_SCHED;
            PG8_STAGE(PG8_SB(0, 1), b2 + hstepB, voffB);
            PG8_WAIT_V(6); PG8_BAR; PG8_MMA(1, 1, At, B1); PG8_BAR;
            PG8_LDB(B0, 1, 0); PG8_SCHED; PG8_LDA(At, 1, 0); PG8_STAGE(PG8_SA(0, 1), a2 + hstepA, voffA);
            PG8_WAIT_L(8); PG8_BAR; PG8_WAIT_L(0); PG8_MMA(0, 0, At, B0); PG8_BAR; PG8_SCHED;
            PG8_LDB(B1, 1, 1); PG8_STAGE(PG8_SB(1, 0), b3, voffB);
            PG8_BAR; PG8_WAIT_L(0); PG8_MMA(0, 1, At, B1); PG8_BAR;
            PG8_LDA(At, 1, 1); PG8_STAGE(PG8_SA(1, 0), a3, voffA);
            PG8_BAR; PG8_WAIT_L(0); PG8_MMA(1, 0, At, B0); PG8_BAR; PG8_SCHED;
            PG8_STAGE(PG8_SB(1, 1), b3 + hstepB, voffB);
            PG8_WAIT_V(6); PG8_BAR; PG8_MMA(1, 1, At, B1); PG8_BAR;
            }
        }
        if constexpr (ALIGN_EPI) { if (wr == 0) PG8_BAR; }
        if constexpr (!Epi::AFTER_DRAIN) { E(acc, cur, wr, wc, fr, fq); S.done(cur); }
        if (!has_next) break;
#pragma unroll
        for (int a = 0; a < 2; ++a)
#pragma unroll
            for (int b = 0; b < 2; ++b)
#pragma unroll
                for (int m = 0; m < 4; ++m)
#pragma unroll
                    for (int n = 0; n < 2; ++n) acc[a][b][m][n] = (f32x4){0.f, 0.f, 0.f, 0.f};
        cur = nxt; cA = nA; cB = nB; ++ui;
        if constexpr (ALIGN_EPI) { if (wr == 1) PG8_BAR; }
    }
    PG8_WAIT_V(0);
    if constexpr (!ALIGN_EPI) { if (wr == 0) PG8_BAR; }
    PG8_BAR;
    if constexpr (Epi::AFTER_DRAIN) { E.fused(acc, cur, wr, wc, fr, fq, lds, wid, lane); S.done(cur); }
#undef PG8_SA
#undef PG8_SB
#undef PG8_STAGE
#undef PG8_RSRC
#undef PG8_R64
#undef PG8_LDA
#undef PG8_LDB
#undef PG8_MMA
#undef PG8_CAT8
#undef PG8_WAIT_V
#undef PG8_WAIT_L
#undef PG8_BAR
#undef PG8_SCHED
}
}
#ifndef PG8_SP2
#define PG8_SP2 true
#endif
#ifndef PG8_ALIGN
#define PG8_ALIGN true
#endif

constexpr int NWAVES = 8, NTHR = 512;
constexpr int D = 1024, NB = 2, T = 8192, M = NB * T;
constexpr int SSD_H = 24, SSD_P = 64, SSD_IN = 1536, SSD_G = 4, SSD_N = 128, XBC = 2560, INCOLS = 6960, NIN_PAD = 7168;
constexpr int S5_W = 768, S5_G = 48, S5_P = 64, S5_K = 16;
constexpr int NE = 16, FF = 2816, CAP = 1024, MROWS = NE * NB * CAP;
constexpr float LN_EPS = 1e-5f, RMS_EPS = 1e-5f;
constexpr float ALPHA = 1.189207115002721f;
constexpr float W1_SCALE = 32.f, W2_SCALE = 64.f, HID_SCALE = 4.f;

constexpr size_t MiB = 1u << 20;
constexpr size_t WS_CTL = 0, CTL_ZERO_BYTES = 64 * 1024;
constexpr size_t WS_WIN = 1 * MiB, WS_WOUT = 15 * MiB, WS_WGLU = 18 * MiB, WS_WO = 21 * MiB, WS_W1 = 23 * MiB, WS_W2 = 199 * MiB, WS_ACT = 287 * MiB;
constexpr size_t A_XB = WS_ACT + 0 * MiB;
constexpr size_t A_BN = WS_ACT + 0 * MiB;
constexpr size_t A_CN = WS_ACT + 16 * MiB;
constexpr size_t A_Z = WS_ACT + 32 * MiB;
constexpr size_t A_XBC = WS_ACT + 80 * MiB;
constexpr size_t A_S = WS_ACT + 80 * MiB;
constexpr size_t A_XT = WS_ACT + 176 * MiB;
constexpr size_t A_BT = WS_ACT + 224 * MiB;
constexpr size_t A_SV = WS_ACT + 340 * MiB;
constexpr size_t A_DT = WS_ACT + 252 * MiB;
constexpr size_t A_TOT = WS_ACT + 255 * MiB;
constexpr size_t A_UC = WS_ACT + 268 * MiB;
constexpr size_t A_Y = WS_ACT + 256 * MiB;
constexpr size_t A_GY = WS_ACT + 224 * MiB;
constexpr size_t A_GT = WS_ACT + 353 * MiB;
constexpr size_t A_YB = WS_ACT + 304 * MiB;
constexpr size_t A_MIX = WS_ACT + 64 * MiB;
constexpr size_t A_HP = WS_ACT + 96 * MiB;
constexpr size_t A_ST = WS_ACT + 0 * MiB;
constexpr size_t A_H8 = WS_ACT + 64 * MiB;
constexpr size_t A_AFF = WS_ACT + 160 * MiB;
constexpr size_t A_IDX = A_AFF + 1 * MiB;
constexpr size_t A_SEL = A_AFF + 2 * MiB;
constexpr size_t A_GATE = A_AFF + 3 * MiB;
constexpr size_t A_XIN = WS_ACT + 164 * MiB;
constexpr size_t A_HID = WS_ACT + 228 * MiB;
constexpr size_t A_YE = WS_ACT + 164 * MiB;
constexpr size_t WS_TV = WS_W2 + 0 * MiB;
constexpr size_t WS_WS5 = WS_W2 + 36 * MiB;
constexpr size_t WS_SLOC = WS_W2 + 48 * MiB;
constexpr size_t WS_AQ = WS_W2 + 72 * MiB;
constexpr size_t WS_END = 704 * MiB;
static_assert(A_HID + 176 * MiB <= WS_END && A_XIN + 64 * MiB <= A_HID && A_YE + 64 * MiB <= A_HID && A_GATE + 1 * MiB <= A_XIN && A_HP + 64 * MiB <= A_AFF && A_H8 + 16 * MiB <= A_HP && A_ST + 1 * MiB <= A_H8, "d_ws map (late phases)");
static_assert(A_GT + 64 * MiB <= WS_END && A_SV + 12 * MiB <= A_GT && A_YB + 32 * MiB <= A_SV && A_UC + 36 * MiB <= A_YB && A_Y + 48 * MiB <= A_YB && A_TOT + 1 * MiB <= A_Y && A_DT + 3 * MiB <= A_TOT && A_GY + 24 * MiB <= A_DT && A_BT + 16 * MiB <= A_DT
              && A_XT + 48 * MiB <= A_BT && A_S + 96 * MiB <= A_XT && A_Z + 48 * MiB <= A_XBC && A_CN + 16 * MiB <= A_Z, "d_ws map (early phases)");
constexpr int CW_LIST = 8192;
constexpr int CW_QW1 = 12288;
constexpr int CW_BAR = 1024;

constexpr int RING_BYTES = 131072;
constexpr int MISC_OFF = RING_BYTES;
constexpr int LDS_BYTES = 147456;

#define GAS __attribute__((address_space(1)))
#define LAS __attribute__((address_space(3)))
typedef unsigned short bf16;
typedef unsigned v4u __attribute__((ext_vector_type(4)));
typedef unsigned v2u __attribute__((ext_vector_type(2)));
typedef float f32x4 __attribute__((ext_vector_type(4)));
#define LDS_WAIT() asm volatile("s_waitcnt lgkmcnt(0)" ::: "memory")
__device__ __forceinline__ unsigned f2bf(float f) { unsigned u = __builtin_bit_cast(unsigned, f); return (u + 0x7fffu + ((u >> 16) & 1u)) >> 16; }
__device__ __forceinline__ unsigned pk2(float lo, float hi) { return pg8::cvt_pk_bf16(lo, hi); }
__device__ __forceinline__ float bflo(unsigned w) { return __uint_as_float(w << 16); }
__device__ __forceinline__ float bfhi(unsigned w) { return __uint_as_float(w & 0xffff0000u); }
__device__ __forceinline__ float wave_sum(float v) {
#pragma unroll
    for (int o = 1; o < 64; o <<= 1) v += __shfl_xor(v, o);
    return v;
}
#define XB_TMO      128
#define XB_XCNT(j)  (256  + 64 * (j))
#define XB_XSUB(j)  (1280 + 64 * (j))
#define XB_XGEN(j)  (2304 + 64 * (j))
#define XB_TOP      3328
#define XB_TOPGEN   3392
#define XCD_BAR_WORDS 3456
#define XB_SPIN_CAP (1u << 18)

__device__ __forceinline__ unsigned xb_ld(unsigned* p)              { return __hip_atomic_load(p, __ATOMIC_RELAXED, __HIP_MEMORY_SCOPE_AGENT); }
__device__ __forceinline__ unsigned xb_add(unsigned* p, unsigned v) { return __hip_atomic_fetch_add(p, v, __ATOMIC_RELAXED, __HIP_MEMORY_SCOPE_AGENT); }
__device__ __forceinline__ unsigned xb_xcc_id() { return (unsigned)__builtin_amdgcn_s_getreg((3 << 11) | 20) & 0xFu; }
#define XB_SPIN(cond, bar) do { unsigned _sp = 0; while (cond) { __builtin_amdgcn_s_sleep(1); \
    if ((++_sp & 255u) == 0u) { if (xb_ld(&(bar)[XB_TMO])) break; if (_sp > XB_SPIN_CAP) { atomicAdd(&(bar)[XB_TMO], 1u); break; } } } } while (0)

struct XcdBarrier {
    unsigned* bar; unsigned x;
    volatile LAS unsigned* st;
};

__device__ __forceinline__ XcdBarrier xcd_barrier_post(unsigned* bar, volatile LAS unsigned* st) {
    XcdBarrier b; b.bar = bar; b.x = xb_xcc_id(); b.st = st;
    if (threadIdx.x == 0) (void)xb_add(&bar[XB_XCNT(b.x)], 1u);
    return b;
}
__device__ __forceinline__ void xcd_barrier_complete(unsigned* bar, unsigned x, unsigned& nloc, unsigned& nx) {
    const unsigned G = gridDim.x * gridDim.y * gridDim.z;
    unsigned sum, cnt, mine, sp = 0u;
    for (;;) {
        sum = 0u; cnt = 0u; mine = 0u;
#pragma unroll
        for (unsigned j = 0; j < 16; ++j) { const unsigned c = xb_ld(&bar[XB_XCNT(j)]); sum += c; cnt += (c > 0u) ? 1u : 0u; mine = (j == x) ? c : mine; }
        if (sum == G) break;
        __builtin_amdgcn_s_sleep(1);
        if ((++sp & 255u) == 0u) { if (xb_ld(&bar[XB_TMO])) break; if (sp > XB_SPIN_CAP) { atomicAdd(&bar[XB_TMO], 1u); break; } }
    }
    nloc = mine > 0u ? mine : 1u; nx = cnt > 0u ? cnt : 1u;
}

__device__ __forceinline__ void xcd_barrier(const XcdBarrier& b, const bool t0  ) {
    asm volatile("s_waitcnt vmcnt(0)" ::: "memory");
    __syncthreads();
    if (t0) {
        unsigned* bar = b.bar;
        __builtin_amdgcn_s_waitcnt(0);
        unsigned nloc = b.st[0], nx = b.st[1];
        if (nloc == 0u) { xcd_barrier_complete(bar, b.x, nloc, nx); b.st[0] = nloc; b.st[1] = nx; }
        const unsigned old = xb_add(&bar[XB_XSUB(b.x)], 1u);
        const unsigned gen = old / nloc;
        if (old + 1u == (gen + 1u) * nloc) {
            __builtin_amdgcn_fence(__ATOMIC_RELEASE, "agent");
            asm volatile("s_waitcnt vmcnt(0)" ::: "memory");
            const unsigned og = xb_add(&bar[XB_TOP], 1u);
            const unsigned tg = og / nx;
            if (og + 1u == (tg + 1u) * nx) xb_add(&bar[XB_TOPGEN], 1u);
            else XB_SPIN(xb_ld(&bar[XB_TOPGEN]) == tg, bar);
            __builtin_amdgcn_fence(__ATOMIC_ACQUIRE, "agent");
            xb_add(&bar[XB_XGEN(b.x)], 1u);
            asm volatile("s_waitcnt vmcnt(0)" ::: "memory");
        } else {
            XB_SPIN(xb_ld(&bar[XB_XGEN(b.x)]) == gen, bar);
            __builtin_amdgcn_fence(__ATOMIC_ACQUIRE, "agent");
            asm volatile("s_waitcnt vmcnt(0)" ::: "memory");
        }
    }
    __syncthreads();
}

struct Frame {
    LAS unsigned char* lds;
    int tid, lane, wave, bid, G;
    LAS unsigned* ptab; float* out; unsigned char* ws;
};
__device__ __forceinline__ const float* inp_(const Frame& F, int k) { const unsigned lo = __builtin_amdgcn_readfirstlane(F.ptab[2 * k]), hi = __builtin_amdgcn_readfirstlane(F.ptab[2 * k + 1]); return (const float*)(((unsigned long long)hi << 32) | lo); }
#define INP(k) inp_(F, k)
__device__ __forceinline__ unsigned lane_now() { unsigned z_ = 0u; asm volatile("" : "+s"(z_)); return __builtin_amdgcn_mbcnt_hi(~0u, __builtin_amdgcn_mbcnt_lo(~0u, z_)); }
#define WSP(T_, off) ((T_*)(F.ws + (off)))

__device__ __forceinline__ unsigned pk4_fp8(float a, float b, float c, float d) { int r_ = __builtin_amdgcn_cvt_pk_fp8_f32(a, b, 0, false); r_ = __builtin_amdgcn_cvt_pk_fp8_f32(c, d, r_, true); return (unsigned)r_; }
__device__ __forceinline__ void tr_load(const float* W, int ldw, int col0, int ncols, int k0, int n0, int lane, f32x4 (&v)[16]) {
    const int kr = lane >> 4, c4 = lane & 15; const bool okc = (n0 + 4 * c4) < ncols;
    const float* src = W + (size_t)(k0 + kr) * ldw + col0 + n0 + 4 * c4;
#pragma unroll
    for (int i = 0; i < 16; ++i) v[i] = okc ? *(const f32x4*)(src + (size_t)(4 * i) * ldw) : (f32x4){0.f, 0.f, 0.f, 0.f};
}
__device__ __forceinline__ void tr_store(const f32x4 (&v)[16], int ncols, int K, bf16* WT, int drow, LAS float* scr, int k0, int n0, int lane, float qs) {
    const int kr = lane >> 4, c4 = lane & 15;
#pragma unroll
    for (int i = 0; i < 16; ++i) { const int k = 4 * i + kr; *(LAS f32x4*)(scr + k * 64 + 4 * (c4 ^ ((k >> 3) & 7))) = v[i]; }
    LDS_WAIT(); asm volatile("" ::: "memory");
    const int nl = lane >> 3, c = lane & 7;
#pragma unroll
    for (int j = 0; j < 8; ++j) { const int n = 8 * j + nl; const LAS float* s = scr + (8 * c) * 64 + 4 * ((n >> 2) ^ c) + (n & 3);
        if (qs != 0.f) { v2u o; o.x = pk4_fp8(s[0 * 64] * qs, s[1 * 64] * qs, s[2 * 64] * qs, s[3 * 64] * qs); o.y = pk4_fp8(s[4 * 64] * qs, s[5 * 64] * qs, s[6 * 64] * qs, s[7 * 64] * qs);
            if (n0 + n < ncols) *(v2u*)((unsigned char*)WT + (size_t)(drow + n) * K + k0 + 8 * c) = o; }
        else { v4u o; o.x = pk2(s[0 * 64], s[1 * 64]); o.y = pk2(s[2 * 64], s[3 * 64]); o.z = pk2(s[4 * 64], s[5 * 64]); o.w = pk2(s[6 * 64], s[7 * 64]);
            if (n0 + n < ncols) *(v4u*)(WT + (size_t)(drow + n) * K + k0 + 8 * c) = o; } }
    LDS_WAIT(); asm volatile("" ::: "memory");
}
__device__ __forceinline__ void tr_item(const float* W, int ldw, int col0, int ncols, int K, bf16* WT, int drow, LAS float* scr, int k0, int n0, int lane, float qs) {
    f32x4 v[16]; tr_load(W, ldw, col0, ncols, k0, n0, lane, v); tr_store(v, ncols, K, WT, drow, scr, k0, n0, lane, qs);
}
struct TrJob { const float* W; int ldw, col0, ncols, K; bf16* WT; int drow0, interleave; float qs; };
__device__ __forceinline__ int tr_job_items(const TrJob& j) { return (j.K / 64) * ((j.ncols + 63) / 64); }
__device__ __forceinline__ void tr_job_item(const TrJob& j, int item, LAS float* scr, int lane) {
    const int nblk = (j.ncols + 63) / 64, kb = item / nblk, nb = item % nblk, n0 = nb * 64;
    const int drow = j.interleave ? j.drow0 + (n0 >> 7) * 256 + (n0 & 127) : j.drow0 + n0;
    tr_item(j.W, j.ldw, j.col0, j.ncols, j.K, j.WT, drow, scr, kb * 64, n0, lane, j.qs);
}
__device__ __forceinline__ void p0_prologue(Frame& F) {
    LAS float* scr = (LAS float*)(F.lds + F.wave * 16384);
    const int gw = F.bid * NWAVES + F.wave, NGW = F.G * NWAVES;
    { const f32x4* x4 = (const f32x4*)INP(0); v4u* o = WSP(v4u, A_XB); const int n8 = M * D / 8;
      const int stride = F.G * NTHR;
      for (int i0 = F.bid * NTHR + F.tid; i0 < n8; i0 += 8 * stride) {
          f32x4 a[8], b[8];
#pragma unroll
          for (int q = 0; q < 8; ++q) { const int i = i0 + q * stride; if (i < n8) { a[q] = x4[2 * i]; b[q] = x4[2 * i + 1]; } }
#pragma unroll
          for (int q = 0; q < 8; ++q) { const int i = i0 + q * stride; if (i < n8) { v4u w; w.x = pk2(a[q].x, a[q].y); w.y = pk2(a[q].z, a[q].w); w.z = pk2(b[q].x, b[q].y); w.w = pk2(b[q].z, b[q].w); o[i] = w; } } } }
    {
        bf16* WIN = WSP(bf16, WS_WIN); bf16* WOUT = WSP(bf16, WS_WOUT); bf16* WGLU = WSP(bf16, WS_WGLU); bf16* WO = WSP(bf16, WS_WO);
        const TrJob jobs[8] = {
            {INP(1), INCOLS, 0, 4096, D, WIN, 0, 0, 0.f}, {INP(1), INCOLS, 4096, 48, D, WIN, 4096, 0, 0.f}, {INP(1), INCOLS, 4144, 768, D, WIN, 4352, 0, 0.f}, {INP(1), INCOLS, 4912, 2048, D, WIN, 5120, 0, 0.f},
            {INP(10), D, 0, D, SSD_IN, WOUT, 0, 0, 0.f}, {INP(22), D, 0, D, S5_W, WGLU, 0, 1, 0.f}, {INP(23), D, 0, D, S5_W, WGLU, 128, 1, 0.f}, {INP(24), D, 0, D, D, WO, 0, 0, 0.f} };
        int base = 0;
#pragma unroll
        for (int q = 0; q < 8; ++q) { const int n = tr_job_items(jobs[q]);
            int it0 = (gw - base) % NGW; if (it0 < 0) it0 += NGW;
            for (int it = it0; it < n; it += NGW) tr_job_item(jobs[q], it, scr, F.lane);
            base += n; }
    }
}
template <int WHICH> __device__ __forceinline__ void expert_convert(Frame& F, int gw, int ngw, unsigned* queue = nullptr, int it_lo = 0, int it_hi = 1 << 30) {
    LAS float* scr = (LAS float*)(F.lds + F.wave * 16384);
    constexpr int IPM = WHICH == 0 ? (D / 64) * (FF / 64) : (FF / 64) * (D / 64);
    constexpr int NIT_ALL = WHICH == 0 ? NE * 2 * IPM : NE * IPM; const int NIT = it_hi < NIT_ALL ? it_hi : NIT_ALL;
    constexpr int NBLK = WHICH == 0 ? FF / 64 : D / 64, LDW = WHICH == 0 ? FF : D, KK = WHICH == 0 ? D : FF; const float qs = WHICH == 0 ? W1_SCALE : W2_SCALE;
    const float* w1 = INP(28); const float* w3 = INP(29); const float* w2 = INP(30);
    unsigned char* W1b = F.ws + WS_W1; unsigned char* W2b = F.ws + WS_W2;
    const int lane = (int)lane_now();
    auto src_of = [&](int it, int& k0, int& n0) -> const float* { const int mtx = it / IPM, r = it % IPM; k0 = (r / NBLK) * 64; n0 = (r % NBLK) * 64;
        if (WHICH == 0) { const int e = mtx >> 1; return ((mtx & 1) ? w3 : w1) + (size_t)e * D * FF; } return w2 + (size_t)mtx * FF * D; };
    const int rfirst = F.bid * 88 + (F.wave < 4 ? F.wave * 9 : 36 + (F.wave - 4) * 13), rend = rfirst + (F.wave < 4 ? 9 : 13);
    auto claim = [&](int prev) -> int { if (!queue) return prev < 0 ? it_lo + gw : prev + ngw;
        const int nx_ = prev < 0 ? rfirst : prev + 1; return nx_ < rend ? nx_ : NIT; };
    auto finish = [&](const f32x4 (&v)[16], int it, int k0, int n0) { const int mtx = it / IPM; bf16* dst; int drow;
        if (WHICH == 0) { dst = (bf16*)(W1b + (size_t)(mtx >> 1) * 2 * FF * D); drow = (mtx & 1) * 128 + (n0 >> 7) * 256 + (n0 & 127); } else { dst = (bf16*)(W2b + (size_t)mtx * D * FF); drow = n0; }
        tr_store(v, LDW, KK, dst, drow, scr, k0, n0, lane, qs); };
    f32x4 va[16], vb[16]; int k0a = 0, n0a = 0, k0b = 0, n0b = 0;
    int ita = claim(-1);
    if (ita < NIT) { const float* sa = src_of(ita, k0a, n0a); tr_load(sa, LDW, 0, LDW, k0a, n0a, lane, va); }
    while (ita < NIT) {
        const int itb = claim(ita);
        if (itb < NIT) { const float* sb = src_of(itb, k0b, n0b); tr_load(sb, LDW, 0, LDW, k0b, n0b, lane, vb); }
        finish(va, ita, k0a, n0a);
        if (itb >= NIT) break;
        ita = claim(itb);
        if (ita < NIT) { const float* sa = src_of(ita, k0a, n0a); tr_load(sa, LDW, 0, LDW, k0a, n0a, lane, va); }
        finish(vb, itb, k0b, n0b);
    }
}
__device__ __forceinline__ void w1_convert(Frame& F, int gw, int ngw, unsigned* queue = nullptr) { expert_convert<0>(F, gw, ngw, queue); }
__device__ __forceinline__ void w2_convert(Frame& F, int gw, int ngw, int it_lo = 0, int it_hi = 1 << 30) { expert_convert<1>(F, gw, ngw, nullptr, it_lo, it_hi); }

__device__ __forceinline__ void cmul(float ar, float ai, float br, float bi, float& cr, float& ci) { cr = ar * br - ai * bi; ci = ar * bi + ai * br; }
__device__ __forceinline__ void s5_precompute_item(Frame& F, int g, int tau) {
    LAS float* PQ = (LAS float*)(F.lds + 72 * 1024);
    LAS float* PW = PQ + 256;
    bf16* TV = WSP(bf16, WS_TV) + (size_t)g * 512 * 768; bf16* WM = WSP(bf16, WS_WS5) + (size_t)g * 256 * 512; float* AQ = WSP(float, WS_AQ);
    const int tid = F.tid;
    __syncthreads();
    { LAS float* dst = PQ + 512; const float* s0 = INP(19) + (size_t)g * 1024; const float* s1 = INP(20) + (size_t)g * 1024; const float* s2 = INP(17) + (size_t)g * 1024; const float* s3 = INP(18) + (size_t)g * 1024;
      dst[tid] = s0[tid]; dst[512 + tid] = s0[512 + tid]; dst[1024 + tid] = s1[tid]; dst[1536 + tid] = s1[512 + tid]; dst[2048 + tid] = s2[tid]; dst[2560 + tid] = s2[512 + tid]; dst[3072 + tid] = s3[tid]; dst[3584 + tid] = s3[512 + tid]; }
    if (tid < 128) {
        const int d = tid >> 6, p = tid & 63;
        const float are = (d ? INP(14) : INP(11))[g * 64 + p], aim = (d ? INP(15) : INP(12))[g * 64 + p], step = __expf((d ? INP(16) : INP(13))[g]);
        const float zr = are * step, zi = aim * step;
        const float er = expf(zr), cs = cosf(zi), sn = sinf(zi), abr = er * cs, abi = er * sn;
        const float sh = sinf(0.5f * zi), dr = expm1f(zr) * cs - 2.f * sh * sh, di = abi;
        const float den = 1.0f / (are * are + aim * aim), qr = (dr * are + di * aim) * den, qi = (di * are - dr * aim) * den;
        float pr = 1.f, pi = 0.f, br = abr, bi = abi;
#pragma unroll
        for (int bit = 0; bit < 6; ++bit) { if ((tau >> bit) & 1) { float tr_, ti_; cmul(pr, pi, br, bi, tr_, ti_); pr = tr_; pi = ti_; } float sr_, si_; cmul(br, bi, br, bi, sr_, si_); br = sr_; bi = si_; }
        float xr, xi; cmul(pr, pi, qr, qi, xr, xi);
        PQ[(d * 64 + p) * 2] = xr; PQ[(d * 64 + p) * 2 + 1] = xi; PW[(d * 64 + p) * 2] = pr; PW[(d * 64 + p) * 2 + 1] = pi;
        if (tau == 32) { AQ[((g * 2 + d) * 64 + p) * 2] = pr; AQ[((g * 2 + d) * 64 + p) * 2 + 1] = pi; }
    }
    __syncthreads();
    LAS float* cre = PQ + 512; LAS float* cim = cre + 1024; LAS float* bre = cim + 1024; LAS float* bim = bre + 1024;
    if (tid < 256 && tau < 32) {
        const int k = tid >> 4, j = tid & 15; float kf = 0.f, kb = 0.f;
        for (int p = 0; p < 64; ++p) { const float cr = cre[k * 64 + p], ci = cim[k * 64 + p], br = bre[p * 16 + j], bi = bim[p * 16 + j];
            float wr_, wi_; cmul(cr, ci, PQ[p * 2], PQ[p * 2 + 1], wr_, wi_); kf += wr_ * br - wi_ * bi;
            cmul(cr, ci, PQ[(64 + p) * 2], PQ[(64 + p) * 2 + 1], wr_, wi_); kb += wr_ * br - wi_ * bi; }
        if (tau == 0) { const bf16 v = (bf16)f2bf(kf + kb); for (int t = 0; t < 32; ++t) TV[(size_t)(t * 16 + k) * 768 + t * 16 + j] = v; }
        else { const bf16 vf = (bf16)f2bf(kf), vb = (bf16)f2bf(kb);
            for (int t = tau; t < 32; ++t) { const int s = t - tau; TV[(size_t)(t * 16 + k) * 768 + s * 16 + j] = vf; TV[(size_t)(s * 16 + k) * 768 + t * 16 + j] = vb; } }
    }
    if (tid >= 256) {
        const int q = tid - 256;
        if (tau >= 1) {
#pragma unroll 1
            for (int i = 0; i < 8; ++i) { const int e = q * 8 + i, d = e >> 10, k = (e >> 6) & 15, p = e & 63;
                float vr, vi; cmul(cre[k * 64 + p], cim[k * 64 + p], PW[(d * 64 + p) * 2], PW[(d * 64 + p) * 2 + 1], vr, vi);
                const int t = d ? 32 - tau : tau - 1; bf16* row = TV + (size_t)(t * 16 + k) * 768 + 512 + d * 128;
                row[p] = (bf16)f2bf(vr); row[64 + p] = (bf16)f2bf(-vi); } }
        if (tau < 32) {
#pragma unroll 1
            for (int i = 0; i < 8; ++i) { const int e = q * 8 + i, d = e >> 10, p = (e >> 4) & 63, j = e & 15;
                float vr, vi; cmul(PQ[(d * 64 + p) * 2], PQ[(d * 64 + p) * 2 + 1], bre[p * 16 + j], bim[p * 16 + j], vr, vi);
                const int s = d ? tau : 31 - tau; bf16* col = WM + (size_t)(d * 128 + p) * 512 + s * 16 + j;
                col[0] = (bf16)f2bf(vr); col[(size_t)64 * 512] = (bf16)f2bf(vi); } }
    }
}
__device__ __forceinline__ void s5_pre_wave(Frame& F, int g, int tau) {
    const int lane = (int)lane_now();
    LAS float* cre = (LAS float*)(F.lds + F.wave * 16384); LAS float* cim = cre + 1024; LAS float* bre = cim + 1024; LAS float* bim = bre + 1024;
    bf16* TV = WSP(bf16, WS_TV) + (size_t)g * 512 * 768; bf16* WM = WSP(bf16, WS_WS5) + (size_t)g * 256 * 512; float* AQ = WSP(float, WS_AQ);
    LDS_WAIT(); asm volatile("" ::: "memory");
    { const f32x4* s0 = (const f32x4*)(INP(19) + (size_t)g * 1024); const f32x4* s1 = (const f32x4*)(INP(20) + (size_t)g * 1024); const f32x4* s2 = (const f32x4*)(INP(17) + (size_t)g * 1024); const f32x4* s3 = (const f32x4*)(INP(18) + (size_t)g * 1024);
#pragma unroll
      for (int q = 0; q < 4; ++q) { const int i = q * 64 + lane; *(LAS f32x4*)(cre + 4 * i) = s0[i]; *(LAS f32x4*)(cim + 4 * i) = s1[i]; *(LAS f32x4*)(bre + 4 * i) = s2[i]; *(LAS f32x4*)(bim + 4 * i) = s3[i]; } }
    float Pr[2], Pi[2], Qr[2], Qi[2];
#pragma unroll
    for (int d = 0; d < 2; ++d) {
        const float are = (d ? INP(14) : INP(11))[g * 64 + lane], aim = (d ? INP(15) : INP(12))[g * 64 + lane], step = __expf((d ? INP(16) : INP(13))[g]);
        const float zr = are * step, zi = aim * step;
        const float er = expf(zr), cs = cosf(zi), sn = sinf(zi), abr = er * cs, abi = er * sn;
        const float sh = sinf(0.5f * zi), dr = expm1f(zr) * cs - 2.f * sh * sh, di = abi;
        const float den = 1.0f / (are * are + aim * aim), qr = (dr * are + di * aim) * den, qi = (di * are - dr * aim) * den;
        float pr = 1.f, pi = 0.f, br = abr, bi = abi;
#pragma unroll
        for (int bit = 0; bit < 6; ++bit) { if ((tau >> bit) & 1) { float tr_, ti_; cmul(pr, pi, br, bi, tr_, ti_); pr = tr_; pi = ti_; } float sr_, si_; cmul(br, bi, br, bi, sr_, si_); br = sr_; bi = si_; }
        Pr[d] = pr; Pi[d] = pi; cmul(pr, pi, qr, qi, Qr[d], Qi[d]);
        if (tau == 32) { AQ[((g * 2 + d) * 64 + lane) * 2] = pr; AQ[((g * 2 + d) * 64 + lane) * 2 + 1] = pi; }
    }
    LDS_WAIT(); asm volatile("" ::: "memory");
    if (tau < 32) {
        const int k = lane >> 2, j4 = (lane & 3) * 4; float kf[4] = {0.f, 0.f, 0.f, 0.f}, kb[4] = {0.f, 0.f, 0.f, 0.f};
#pragma unroll 4
        for (int p = 0; p < 64; ++p) { const float cr = cre[k * 64 + p], ci = cim[k * 64 + p]; const f32x4 br4 = *(const LAS f32x4*)(bre + p * 16 + j4), bi4 = *(const LAS f32x4*)(bim + p * 16 + j4);
            const float fr_ = __shfl(Qr[0], p), fi_ = __shfl(Qi[0], p), gr_ = __shfl(Qr[1], p), gi_ = __shfl(Qi[1], p);
            float wr_, wi_; cmul(cr, ci, fr_, fi_, wr_, wi_);
#pragma unroll
            for (int i = 0; i < 4; ++i) kf[i] += wr_ * br4[i] - wi_ * bi4[i];
            cmul(cr, ci, gr_, gi_, wr_, wi_);
#pragma unroll
            for (int i = 0; i < 4; ++i) kb[i] += wr_ * br4[i] - wi_ * bi4[i]; }
        if (tau == 0) { v2u v; v.x = pk2(kf[0] + kb[0], kf[1] + kb[1]); v.y = pk2(kf[2] + kb[2], kf[3] + kb[3]); for (int t = 0; t < 32; ++t) *(v2u*)(TV + (size_t)(t * 16 + k) * 768 + t * 16 + j4) = v; }
        else { v2u vf, vb; vf.x = pk2(kf[0], kf[1]); vf.y = pk2(kf[2], kf[3]); vb.x = pk2(kb[0], kb[1]); vb.y = pk2(kb[2], kb[3]);
            for (int t = tau; t < 32; ++t) { const int s = t - tau; *(v2u*)(TV + (size_t)(t * 16 + k) * 768 + s * 16 + j4) = vf; *(v2u*)(TV + (size_t)(s * 16 + k) * 768 + t * 16 + j4) = vb; } }
    }
    if (tau >= 1) {
#pragma unroll
        for (int d = 0; d < 2; ++d) { const int t = d ? 32 - tau : tau - 1;
#pragma unroll 4
            for (int k = 0; k < 16; ++k) { float vr, vi; cmul(cre[k * 64 + lane], cim[k * 64 + lane], Pr[d], Pi[d], vr, vi);
                bf16* row = TV + (size_t)(t * 16 + k) * 768 + 512 + d * 128; row[lane] = (bf16)f2bf(vr); row[64 + lane] = (bf16)f2bf(-vi); } }
    }
    if (tau < 32) {
        const int j = lane & 15;
#pragma unroll
        for (int d = 0; d < 2; ++d) { const int s = d ? tau : 31 - tau;
#pragma unroll 4
            for (int ps = 0; ps < 16; ++ps) { const int p = 4 * ps + (lane >> 4); const float xr = __shfl(Qr[d], p), xi = __shfl(Qi[d], p);
                float vr, vi; cmul(xr, xi, bre[p * 16 + j], bim[p * 16 + j], vr, vi);
                bf16* col = WM + (size_t)(d * 128 + p) * 512 + s * 16 + j; col[0] = (bf16)f2bf(vr); col[(size_t)64 * 512] = (bf16)f2bf(vi); } }
    }
    LDS_WAIT(); asm volatile("" ::: "memory");
}
__device__ __forceinline__ void p0_s5(Frame& F) { if (F.wave < 4) for (int it = F.bid * 4 + F.wave; it < S5_G * 33; it += F.G * 4) s5_pre_wave(F, it / 33, it % 33); }

__device__ __forceinline__ void s5_scan_item(Frame& F, int item) {
    const int d = item & 1, b = (item >> 1) & 1, g = item >> 2, tid = F.tid;
    LAS float* S = (LAS float*)F.lds;
    const float* SL = WSP(float, WS_SLOC) + ((size_t)(g * 512 + b * 256) * 256 + d * 128);
    __syncthreads();
    {   f32x4 v[16];
#pragma unroll
        for (int q = 0; q < 16; ++q) { const int i = q * NTHR + tid, ci = i >> 5, c4 = (i & 31) * 4; v[q] = *(const f32x4*)(SL + (size_t)ci * 256 + c4); }
#pragma unroll
        for (int q = 0; q < 16; ++q) { const int i = q * NTHR + tid, ci = i >> 5, c4 = (i & 31) * 4; *(LAS f32x4*)(S + ci * 128 + c4) = v[q]; } }
    __syncthreads();
    if (tid < 64) {
        const float* AQ = WSP(float, WS_AQ); const float qr = AQ[((g * 2 + d) * 64 + tid) * 2], qi = AQ[((g * 2 + d) * 64 + tid) * 2 + 1];
        float sr = 0.f, si = 0.f;
#pragma unroll 1
        for (int n0 = 0; n0 < 256; n0 += 16) {
            float tr_[16], ti_[16];
#pragma unroll
            for (int k = 0; k < 16; ++k) { const int ci = d ? 255 - (n0 + k) : n0 + k; tr_[k] = S[ci * 128 + tid]; ti_[k] = S[ci * 128 + 64 + tid]; }
#pragma unroll
            for (int k = 0; k < 16; ++k) { const int ci = d ? 255 - (n0 + k) : n0 + k; S[ci * 128 + tid] = sr; S[ci * 128 + 64 + tid] = si;
                const float nr = qr * sr - qi * si + tr_[k], ni = qr * si + qi * sr + ti_[k]; sr = nr; si = ni; }
        }
    }
    __syncthreads();
    bf16* UC = WSP(bf16, A_UC) + ((size_t)(g * 512 + b * 256) * 768 + 512 + d * 128);
#pragma unroll
    for (int q = 0; q < 8; ++q) { const int i = q * NTHR + tid, ci = i >> 4, c8 = (i & 15) * 8; const LAS float* s = S + ci * 128 + c8;
        v4u o; o.x = pk2(s[0], s[1]); o.y = pk2(s[2], s[3]); o.z = pk2(s[4], s[5]); o.w = pk2(s[6], s[7]);
        *(v4u*)(UC + (size_t)ci * 768 + c8) = o; }
}
__device__ __forceinline__ void unpack8(const v4u w, float (&f)[8]) { f[0] = bflo(w.x); f[1] = bfhi(w.x); f[2] = bflo(w.y); f[3] = bfhi(w.y); f[4] = bflo(w.z); f[5] = bfhi(w.z); f[6] = bflo(w.w); f[7] = bfhi(w.w); }
__device__ __forceinline__ void p2_conv(Frame& F) {
    const bf16* xbc = WSP(bf16, A_XBC); bf16* XT = WSP(bf16, A_XT); bf16* BT = WSP(bf16, A_BT); bf16* BN = WSP(bf16, A_BN); bf16* CN = WSP(bf16, A_CN);
    const float* cw = INP(2); const float* cb = INP(3);
    constexpr int RUN = 16, NCG = XBC / 8, NITEM = (M / RUN) * NCG;
    const int s5lo = (F.G == 256) ? 160 : F.G, NA = (F.G == 256) ? 196608 : 0;
    for (int pass = 0; pass < 2; ++pass)
    for (int item = pass == 0 ? (F.bid < s5lo ? F.bid * NTHR + F.tid : NITEM) : NA + F.bid * NTHR + F.tid; item < (pass == 0 ? NA : NITEM); item += (pass == 0 ? s5lo : F.G) * NTHR) {
        const int cg = item % NCG, r = item / NCG, ch = cg * 8, m0 = r * RUN, tb = m0 % T, bc = m0 >> 7, s0 = m0 & 127;
        float w[5][8], bias[8];
#pragma unroll
        for (int k = 0; k < 5; ++k) { const f32x4 a = *(const f32x4*)(cw + k * XBC + ch), b = *(const f32x4*)(cw + k * XBC + ch + 4); w[k][0] = a.x; w[k][1] = a.y; w[k][2] = a.z; w[k][3] = a.w; w[k][4] = b.x; w[k][5] = b.y; w[k][6] = b.z; w[k][7] = b.w; }
        { const f32x4 a = *(const f32x4*)(cb + ch), b = *(const f32x4*)(cb + ch + 4); bias[0] = a.x; bias[1] = a.y; bias[2] = a.z; bias[3] = a.w; bias[4] = b.x; bias[5] = b.y; bias[6] = b.z; bias[7] = b.w; }
        bf16* nat = nullptr; bf16* trn = nullptr; int trn_stride = 64 * 8;
        int trn_cstride = 8;
        if (ch < SSD_IN) { trn = XT + (size_t)(bc * SSD_H + (ch >> 6)) * 8192 + ((s0 >> 3) * 64 + ((ch & 63) >> 3)) * 8; trn_cstride = 64; }
        else if (ch < SSD_IN + 512) { const int cc = ch - SSD_IN; nat = BN + (size_t)m0 * 512 + cc; trn = BT + (size_t)(bc * SSD_G + (cc >> 7)) * 16384 + ((s0 >> 3) * 128 + (cc & 127)) * 8; trn_stride = 128 * 8; }
        else { nat = CN + (size_t)m0 * 512 + (ch - SSD_IN - 512); }
        v4u rows[RUN + 4];
        const bf16* src = xbc + (size_t)m0 * XBC + ch;
#pragma unroll
        for (int q = 0; q < RUN + 4; ++q) { const int tt = tb - 2 + q; const bool ok = tt >= 0 && tt < T; const int qq = ok ? q - 2 : 0; const v4u v = *(const v4u*)(src + (ptrdiff_t)qq * XBC);
            rows[q].x = ok ? v.x : 0u; rows[q].y = ok ? v.y : 0u; rows[q].z = ok ? v.z : 0u; rows[q].w = ok ? v.w : 0u; }
#pragma unroll
        for (int i8 = 0; i8 < RUN / 8; ++i8) {
            float o[8][8];
#pragma unroll
            for (int ii = 0; ii < 8; ++ii) { const int i = i8 * 8 + ii;
#pragma unroll
                for (int j = 0; j < 8; ++j) o[ii][j] = bias[j];
#pragma unroll
                for (int k = 0; k < 5; ++k) { float f[8]; unpack8(rows[i + k], f);
#pragma unroll
                    for (int j = 0; j < 8; ++j) o[ii][j] += w[k][j] * f[j]; }
#pragma unroll
                for (int j = 0; j < 8; ++j) o[ii][j] = o[ii][j] * __builtin_amdgcn_rcpf(1.0f + __expf(-o[ii][j]));
                if (nat) { v4u q; q.x = pk2(o[ii][0], o[ii][1]); q.y = pk2(o[ii][2], o[ii][3]); q.z = pk2(o[ii][4], o[ii][5]); q.w = pk2(o[ii][6], o[ii][7]); *(v4u*)(nat + (size_t)i * 512) = q; } }
            if (trn) {
#pragma unroll
                for (int j = 0; j < 8; ++j) { v4u q; q.x = pk2(o[0][j], o[1][j]); q.y = pk2(o[2][j], o[3][j]); q.z = pk2(o[4][j], o[5][j]); q.w = pk2(o[6][j], o[7][j]); *(v4u*)(trn + (size_t)i8 * trn_stride + j * trn_cstride) = q; } }
        }
    }
    {
        const int gw = F.bid * NWAVES + F.wave, NGW = F.G * NWAVES, lane = F.lane;
        const float* DT = WSP(float, A_DT); float* SV = WSP(float, A_SV); float* TOT = WSP(float, A_TOT);
        for (int it = gw; it < 128 * SSD_H * 2; it += NGW) {
            const int d = it & 1, h = (it >> 1) % SSD_H, bc = it / (2 * SSD_H);
            const float a = -__expf((d ? INP(5) : INP(4))[h]);
            const size_t mb = (size_t)bc * 128;
            const float dt0 = DT[(mb + 2 * lane) * 48 + d * 24 + h], dt1 = DT[(mb + 2 * lane + 1) * 48 + d * 24 + h];
            const float x0 = dt0 * a, x1 = dt1 * a, ps = x0 + x1;
            float inc = ps;
#pragma unroll
            for (int o = 1; o < 64; o <<= 1) { const float t_ = __shfl_up(inc, o); if (lane >= o) inc += t_; }
            const float total = __shfl(inc, 63), exc = inc - ps;
            const float ci0 = exc + x0, ci1 = inc;
            float cs0, cs1, w0, w1, f0, f1;
            if (d == 0) { cs0 = ci0; cs1 = ci1; w0 = dt0 * __expf(total - ci0); w1 = dt1 * __expf(total - ci1); f0 = __expf(ci0); f1 = __expf(ci1); }
            else { cs0 = exc; cs1 = ci0; w0 = dt0 * __expf(cs0); w1 = dt1 * __expf(cs1); f0 = __expf(total - cs0); f1 = __expf(total - cs1); }
            float* sv = SV + (size_t)it * 4 * 128 + 2 * lane;
            typedef float f32x2 __attribute__((ext_vector_type(2)));
            *(f32x2*)(sv) = (f32x2){w0, w1}; *(f32x2*)(sv + 128) = (f32x2){cs0, cs1}; *(f32x2*)(sv + 256) = (f32x2){dt0, dt1}; *(f32x2*)(sv + 384) = (f32x2){f0, f1};
            if (lane == 0) TOT[it] = __expf(total);
        }
    }
}

typedef short bf16x8 __attribute__((ext_vector_type(8)));
typedef float f32x16 __attribute__((ext_vector_type(16)));
__device__ __forceinline__ unsigned cvtpk(float lo, float hi) { return pg8::cvt_pk_bf16(lo, hi); }
__device__ __forceinline__ void ssd_state_item(Frame& F, int item) {
    unsigned z_ = 0u; asm volatile("" : "+s"(z_)); int lane = (int)__builtin_amdgcn_mbcnt_hi(~0u, __builtin_amdgcn_mbcnt_lo(~0u, z_)); asm volatile("" : "+v"(lane));
    const int nt = item & 3, u = item >> 2, h = u % SSD_H, bc = u / SSD_H, g = h / 6, b = bc >> 6, c = bc & 63, l31 = lane & 31, hf = lane >> 5;
    const bf16* XT = WSP(bf16, A_XT) + (size_t)u * 8192 + l31 * 8; const bf16* BT = WSP(bf16, A_BT) + (size_t)(bc * SSD_G + g) * 16384 + (nt * 32 + l31) * 8;
    const float* SV = WSP(float, A_SV); bf16* S = WSP(bf16, A_S);
    LAS float* wl = (LAS float*)(F.lds + F.wave * 1024);
    LDS_WAIT(); asm volatile("" ::: "memory");
#pragma unroll
    for (int d = 0; d < 2; ++d) { const float* sv = SV + (size_t)(u * 2 + d) * 4 * 128; wl[d * 128 + lane] = sv[lane]; wl[d * 128 + 64 + lane] = sv[64 + lane]; }
    LDS_WAIT(); asm volatile("" ::: "memory");
    f32x16 acc[2][2];
#pragma unroll
    for (int d = 0; d < 2; ++d)
#pragma unroll
        for (int pt = 0; pt < 2; ++pt)
#pragma unroll
            for (int r = 0; r < 16; ++r) acc[d][pt][r] = 0.f;
#pragma unroll
    for (int ks = 0; ks < 8; ++ks) {
        const int sb = ks * 16 + 8 * hf, q = 2 * ks + hf;
        const v4u a = *(const v4u*)(BT + q * 1024);
        const bf16x8 b0 = *(const bf16x8*)(XT + q * 512), b1 = *(const bf16x8*)(XT + q * 512 + 256);
        float af[8]; unpack8(a, af);
#pragma unroll
        for (int d = 0; d < 2; ++d) {
            const f32x4 w0 = *(const LAS f32x4*)(wl + d * 128 + sb), w1 = *(const LAS f32x4*)(wl + d * 128 + sb + 4);
            v4u aw; aw.x = cvtpk(af[0] * w0.x, af[1] * w0.y); aw.y = cvtpk(af[2] * w0.z, af[3] * w0.w); aw.z = cvtpk(af[4] * w1.x, af[5] * w1.y); aw.w = cvtpk(af[6] * w1.z, af[7] * w1.w);
            const bf16x8 av = __builtin_bit_cast(bf16x8, aw);
            acc[d][0] = __builtin_amdgcn_mfma_f32_32x32x16_bf16(av, b0, acc[d][0], 0, 0, 0);
            acc[d][1] = __builtin_amdgcn_mfma_f32_32x32x16_bf16(av, b1, acc[d][1], 0, 0, 0);
        }
    }
#pragma unroll
    for (int d = 0; d < 2; ++d) { bf16* So = S + ((size_t)((b * SSD_H + h) * 2 + d) * 64 + c) * 8192 + nt * 2048 + lane * 4;
#pragma unroll
        for (int pt = 0; pt < 2; ++pt)
#pragma unroll
            for (int q = 0; q < 4; ++q) { v2u o; o.x = cvtpk(acc[d][pt][4 * q], acc[d][pt][4 * q + 1]); o.y = cvtpk(acc[d][pt][4 * q + 2], acc[d][pt][4 * q + 3]);
                *(v2u*)(So + (pt * 4 + q) * 256) = o; } }
}
__device__ __forceinline__ void ssd_scan(Frame& F, int tg, int ntg, int item_lo, int item_hi) {
    bf16* S = WSP(bf16, A_S); const float* TOT = WSP(float, A_TOT);
    for (int item = item_lo + tg; item < item_hi; item += ntg) {
        const int e8 = item & 1023, bhd = item >> 10, d = bhd & 1, h = (bhd >> 1) % SSD_H, b = bhd / (2 * SSD_H);
        bf16* base = S + (size_t)bhd * 64 * 8192 + e8 * 8;
        float H[8];
#pragma unroll
        for (int j = 0; j < 8; ++j) H[j] = 0.f;
#pragma unroll 1
        for (int n0 = 0; n0 < 64; n0 += 16) {
            v4u v[16]; float dec[16];
#pragma unroll
            for (int k = 0; k < 16; ++k) { const int c = d ? 63 - (n0 + k) : n0 + k; v[k] = *(const v4u*)(base + (size_t)c * 8192); dec[k] = TOT[((b * 64 + c) * SSD_H + h) * 2 + d]; }
#pragma unroll
            for (int k = 0; k < 16; ++k) { const int c = d ? 63 - (n0 + k) : n0 + k; float f[8]; unpack8(v[k], f);
                v4u o; o.x = cvtpk(H[0], H[1]); o.y = cvtpk(H[2], H[3]); o.z = cvtpk(H[4], H[5]); o.w = cvtpk(H[6], H[7]);
                *(v4u*)(base + (size_t)c * 8192) = o;
#pragma unroll
                for (int j = 0; j < 8; ++j) H[j] = H[j] * dec[k] + f[j]; }
        }
    }
}
constexpr int PC_SVL_BYTES = 24576, PC_MAT_BYTES = 64 * 272;
__device__ __forceinline__ void pc_prefetch(v4u (&pre)[12], const bf16* XT, const bf16* S, int bc, int b, int c, int g, int i3, int tid) {
#pragma unroll
    for (int q = 0; q < 12; ++q) { const int mtx = q >> 1, hh = mtx / 3, t = mtx % 3, h = g * 6 + hh * 3 + i3, idx = (q & 1) * 512 + tid;
        const bf16* src = (t == 0) ? XT + (size_t)(bc * SSD_H + h) * 8192 + idx * 8 : S + ((size_t)((b * SSD_H + h) * 2 + (t - 1)) * 64 + c) * 8192 + idx * 8;
        pre[q] = *(const v4u*)src; }
}
__device__ __forceinline__ void ssd_out_unit(Frame& F, int unit) {
    unsigned z_ = 0u; asm volatile("" : "+s"(z_)); int lane = (int)__builtin_amdgcn_mbcnt_hi(~0u, __builtin_amdgcn_mbcnt_lo(~0u, z_)); asm volatile("" : "+v"(lane));
    int tid = F.wave * 64 + lane; asm volatile("" : "+v"(tid));
    const int g = unit & 3, bc = unit >> 2, b = bc >> 6, c = bc & 63, l31 = lane & 31, hf = lane >> 5, j = F.wave & 3, hh = F.wave >> 2;
    const size_t mb = (size_t)bc * 128;
    const bf16* CN = WSP(bf16, A_CN) + (mb + 32 * j + l31) * 512 + g * 128 + 8 * hf;
    const bf16* BN = WSP(bf16, A_BN) + (mb + l31) * 512 + g * 128 + 8 * hf;
    const float* SV = WSP(float, A_SV); const bf16* S = WSP(bf16, A_S); const bf16* XT = WSP(bf16, A_XT); bf16* Y = WSP(bf16, A_Y);
    LAS float* svl = (LAS float*)F.lds + hh * 3072;
    LAS unsigned char* mats = F.lds + PC_SVL_BYTES;
    asm volatile("" : "+v"(CN), "+v"(BN));
    __syncthreads();
    {   const f32x4* src = (const f32x4*)(SV + (size_t)((bc * SSD_H + g * 6) * 2) * 512) + tid;
#pragma unroll
        for (int q = 0; q < 3; ++q) *(LAS f32x4*)((LAS float*)F.lds + (q * 512 + tid) * 4) = src[q * 512]; }
    v4u pre[12];
    pc_prefetch(pre, XT, S, bc, b, c, g, 0, tid);
    unsigned cbp[4][8];
    {
        LAS unsigned char* tb = mats; LAS unsigned char* tc = mats + 128 * 272;
        { const bf16* bsrc = WSP(bf16, A_BN) + mb * 512 + g * 128; const bf16* csrc = WSP(bf16, A_CN) + mb * 512 + g * 128; v4u vb_[4], vc_[4];
#pragma unroll
          for (int q = 0; q < 4; ++q) { const int idx = q * 512 + tid, row = idx >> 4, ch = idx & 15; vb_[q] = *(const v4u*)(bsrc + (size_t)row * 512 + ch * 8); vc_[q] = *(const v4u*)(csrc + (size_t)row * 512 + ch * 8); }
#pragma unroll
          for (int q = 0; q < 4; ++q) { const int idx = q * 512 + tid, row = idx >> 4, ch = idx & 15; *(LAS v4u*)(tb + row * 272 + ch * 16) = vb_[q]; *(LAS v4u*)(tc + row * 272 + ch * 16) = vc_[q]; } }
        __syncthreads();
        bf16x8 cfr[8];
#pragma unroll
        for (int ks = 0; ks < 8; ++ks) cfr[ks] = *(const LAS bf16x8*)(tc + (32 * j + l31) * 272 + ks * 32 + hf * 16);
#pragma unroll
        for (int i = 0; i < 4; ++i) { f32x16 t_;
#pragma unroll
            for (int r = 0; r < 16; ++r) t_[r] = 0.f;
#pragma unroll
            for (int ks = 0; ks < 8; ++ks) { const bf16x8 a = *(const LAS bf16x8*)(tb + (32 * i + l31) * 272 + ks * 32 + hf * 16); t_ = __builtin_amdgcn_mfma_f32_32x32x16_bf16(a, cfr[ks], t_, 0, 0, 0); }
#pragma unroll
            for (int r = 0; r < 8; ++r) cbp[i][r] = cvtpk(t_[2 * r], t_[2 * r + 1]);
        }
    }
#define CBT(i_, r_) (((r_) & 1) ? bfhi(cbp[i_][(r_) >> 1]) : bflo(cbp[i_][(r_) >> 1]))
#pragma unroll 1
    for (int i3 = 0; i3 < 3; ++i3) {
        const int h = g * 6 + hh * 3 + i3;
        { int l_ = lane, t_ = tid; asm volatile("" : "+v"(l_), "+v"(t_)); lane = l_; tid = t_; }
        const int l31 = lane & 31, hf = lane >> 5, tl = 32 * j + l31;
        __syncthreads();
#pragma unroll
        for (int q = 0; q < 12; ++q) { const int mtx = q >> 1, idx = (q & 1) * 512 + tid; LAS unsigned char* mt = mats + mtx * PC_MAT_BYTES;
            if ((mtx % 3) == 0) { const int pos = idx & 63, row = (pos & 7) * 8 + (pos >> 3), ch = idx >> 6; *(LAS v4u*)(mt + row * 272 + ch * 16) = pre[q]; }
            else { const int blk = idx >> 5, c_ = idx & 31, nt_ = blk >> 3, pt_ = (blk >> 2) & 1, q_ = blk & 3, hf_ = c_ >> 4, la = (2 * c_) & 31;
                const int pa = 32 * pt_ + la, pb = pa + 1, ra = (pa & 7) * 8 + (pa >> 3), rb = (pb & 7) * 8 + (pb >> 3), cb = (32 * nt_ + 8 * q_ + 4 * hf_) * 2;
                v2u lo_; lo_.x = pre[q].x; lo_.y = pre[q].y; v2u hi_; hi_.x = pre[q].z; hi_.y = pre[q].w;
                *(LAS v2u*)(mt + ra * 272 + cb) = lo_; *(LAS v2u*)(mt + rb * 272 + cb) = hi_; } }
        __syncthreads();
        const LAS float* vf = svl + (i3 * 2 + 0) * 512 + 128; const LAS float* vb = svl + (i3 * 2 + 1) * 512 + 128;
        const float csf_t = vf[tl], sf_t = vf[256 + tl], ecsb_t = vb[tl], sb_t = vb[256 + tl], Dh = INP(8)[h];
        int tlv = tl - 4 * hf; asm volatile("" : "+v"(tlv));
        const LAS unsigned char* mx = mats + (hh * 3 + 0) * PC_MAT_BYTES + l31 * 272 + hf * 8;
        const LAS unsigned char* mf = mats + (hh * 3 + 1) * PC_MAT_BYTES + l31 * 272 + hf * 16;
        const LAS unsigned char* mbk = mats + (hh * 3 + 2) * PC_MAT_BYTES + l31 * 272 + hf * 16;
        f32x16 acc[2];
        {
            const bf16* cn = CN; asm volatile("" : "+v"(cn));
            bf16x8 cfr[8];
#pragma unroll
            for (int ks = 0; ks < 8; ++ks) cfr[ks] = *(const bf16x8*)(cn + ks * 16);
#pragma unroll
            for (int pt = 0; pt < 2; ++pt) { f32x16 af;
#pragma unroll
                for (int r = 0; r < 16; ++r) af[r] = 0.f;
#pragma unroll
                for (int ks = 0; ks < 8; ++ks) { const bf16x8 a0 = *(const LAS bf16x8*)(mf + pt * 32 * 272 + ks * 32); af = __builtin_amdgcn_mfma_f32_32x32x16_bf16(a0, cfr[ks], af, 0, 0, 0); }
#pragma unroll
                for (int r = 0; r < 16; ++r) acc[pt][r] = af[r] * sf_t;
#pragma unroll
                for (int r = 0; r < 16; ++r) af[r] = 0.f;
#pragma unroll
                for (int ks = 0; ks < 8; ++ks) { const bf16x8 a1 = *(const LAS bf16x8*)(mbk + pt * 32 * 272 + ks * 32); af = __builtin_amdgcn_mfma_f32_32x32x16_bf16(a1, cfr[ks], af, 0, 0, 0); }
#pragma unroll
                for (int r = 0; r < 16; ++r) acc[pt][r] += af[r] * sb_t; }
        }
        asm volatile("" ::: "memory");
        if (i3 < 2) pc_prefetch(pre, XT, S, bc, b, c, g, i3 + 1, tid);
#pragma unroll
        for (int i = 0; i < 4; ++i) {
#pragma unroll
            for (int k2 = 0; k2 < 2; ++k2) {
                const int sA = 32 * i + 16 * k2 + 4 * hf;
                float mv[8];
                if (i < j) {
                    const f32x4 c0 = *(const LAS f32x4*)(vf + sA), c1 = *(const LAS f32x4*)(vf + sA + 8), d0 = *(const LAS f32x4*)(vf + 128 + sA), d1 = *(const LAS f32x4*)(vf + 128 + sA + 8);
#pragma unroll
                    for (int e = 0; e < 4; ++e) { mv[e] = CBT(i, 8 * k2 + e) * (d0[e] * __expf(fminf(csf_t - c0[e], 0.f))); mv[4 + e] = CBT(i, 8 * k2 + 4 + e) * (d1[e] * __expf(fminf(csf_t - c1[e], 0.f))); }
                } else if (i > j) {
                    const f32x4 c0 = *(const LAS f32x4*)(vb + sA), c1 = *(const LAS f32x4*)(vb + sA + 8), d0 = *(const LAS f32x4*)(vb + 128 + sA), d1 = *(const LAS f32x4*)(vb + 128 + sA + 8);
#pragma unroll
                    for (int e = 0; e < 4; ++e) { mv[e] = CBT(i, 8 * k2 + e) * (d0[e] * __expf(fminf(c0[e] - ecsb_t, 0.f))); mv[4 + e] = CBT(i, 8 * k2 + 4 + e) * (d1[e] * __expf(fminf(c1[e] - ecsb_t, 0.f))); }
                } else {
                    const f32x4 c0 = *(const LAS f32x4*)(vf + sA), c1 = *(const LAS f32x4*)(vf + sA + 8), d0 = *(const LAS f32x4*)(vf + 128 + sA), d1 = *(const LAS f32x4*)(vf + 128 + sA + 8);
                    const f32x4 g0 = *(const LAS f32x4*)(vb + sA), g1 = *(const LAS f32x4*)(vb + sA + 8), h0 = *(const LAS f32x4*)(vb + 128 + sA), h1 = *(const LAS f32x4*)(vb + 128 + sA + 8);
#pragma unroll
                    for (int e = 0; e < 8; ++e) { const int s_ = 32 * i + 16 * k2 + (e & 3) + 8 * (e >> 2); const float cf = e < 4 ? c0[e & 3] : c1[e & 3], df = e < 4 ? d0[e & 3] : d1[e & 3], cb_ = e < 4 ? g0[e & 3] : g1[e & 3], db = e < 4 ? h0[e & 3] : h1[e & 3];
                        float f = 0.f;
                        f += (s_ <= tlv) ? df * __expf(fminf(csf_t - cf, 0.f)) : 0.f;
                        f += (s_ >= tlv) ? db * __expf(fminf(cb_ - ecsb_t, 0.f)) : 0.f;
                        mv[e] = CBT(i, 8 * k2 + e) * f + ((s_ == tlv) ? Dh : 0.f); }
                }
                v4u mw; mw.x = cvtpk(mv[0], mv[1]); mw.y = cvtpk(mv[2], mv[3]); mw.z = cvtpk(mv[4], mv[5]); mw.w = cvtpk(mv[6], mv[7]);
                const bf16x8 mfr = __builtin_bit_cast(bf16x8, mw);
#pragma unroll
                for (int pt = 0; pt < 2; ++pt) { const v2u x0 = *(const LAS v2u*)(mx + pt * 32 * 272 + 64 * i + 32 * k2), x1 = *(const LAS v2u*)(mx + pt * 32 * 272 + 64 * i + 32 * k2 + 16);
                    v4u xw; xw.x = x0.x; xw.y = x0.y; xw.z = x1.x; xw.w = x1.y;
                    acc[pt] = __builtin_amdgcn_mfma_f32_32x32x16_bf16(__builtin_bit_cast(bf16x8, xw), mfr, acc[pt], 0, 0, 0); }
                asm volatile("" ::: "memory");
            }
        }
        bf16* yo = Y + (mb + tl) * SSD_IN + h * 64 + 4 * hf;
        asm volatile("" : "+v"(yo));
#pragma unroll
        for (int pt = 0; pt < 2; ++pt)
#pragma unroll
            for (int q = 0; q < 4; ++q) { v2u o; o.x = cvtpk(acc[pt][4 * q], acc[pt][4 * q + 1]); o.y = cvtpk(acc[pt][4 * q + 2], acc[pt][4 * q + 3]); *(v2u*)(yo + 32 * pt + 8 * q) = o; }
    }
}

#undef CBT
__device__ __forceinline__ void ssd_norm_unit(Frame& F, int unit) {
    const int g = unit & 3, bc = unit >> 2; const int lane = (int)lane_now(), tq = lane >> 4, j16 = lane & 15;
    const size_t rowbase = ((size_t)bc * 128 + F.wave * 16 + tq) * SSD_IN + g * 384 + j16 * 8;
    bf16* Y = WSP(bf16, A_Y) + rowbase; const bf16* Z = WSP(bf16, A_Z) + rowbase; const float* ng = INP(9) + g * 384 + j16 * 8;
    v4u yv[12], zv[12];
#pragma unroll
    for (int r = 0; r < 4; ++r)
#pragma unroll
        for (int i = 0; i < 3; ++i) zv[r * 3 + i] = *(const v4u*)(Z + (size_t)(4 * r) * SSD_IN + 128 * i);
    asm volatile("s_waitcnt vmcnt(0)" ::: "memory"); __syncthreads();
#pragma unroll
    for (int r = 0; r < 4; ++r)
#pragma unroll
        for (int i = 0; i < 3; ++i) yv[r * 3 + i] = *(const v4u*)(Y + (size_t)(4 * r) * SSD_IN + 128 * i);
    f32x4 g0[3], g1[3];
#pragma unroll
    for (int i = 0; i < 3; ++i) { g0[i] = *(const f32x4*)(ng + 128 * i); g1[i] = *(const f32x4*)(ng + 128 * i + 4); }
#pragma unroll
    for (int r = 0; r < 4; ++r) { float ss = 0.f;
#pragma unroll
        for (int i = 0; i < 3; ++i) { float a[8], z[8]; unpack8(yv[r * 3 + i], a); unpack8(zv[r * 3 + i], z);
#pragma unroll
            for (int jj = 0; jj < 8; ++jj) { a[jj] *= z[jj]; ss += a[jj] * a[jj]; }
            yv[r * 3 + i].x = pk2(a[0], a[1]); yv[r * 3 + i].y = pk2(a[2], a[3]); yv[r * 3 + i].z = pk2(a[4], a[5]); yv[r * 3 + i].w = pk2(a[6], a[7]); }
        ss += __shfl_xor(ss, 1); ss += __shfl_xor(ss, 2); ss += __shfl_xor(ss, 4); ss += __shfl_xor(ss, 8);
        const float rn = 1.0f / sqrtf(ss * (1.0f / 384.0f) + RMS_EPS);
#pragma unroll
        for (int i = 0; i < 3; ++i) { float a[8]; unpack8(yv[r * 3 + i], a);
            v4u o; o.x = pk2(a[0] * rn * g0[i].x, a[1] * rn * g0[i].y); o.y = pk2(a[2] * rn * g0[i].z, a[3] * rn * g0[i].w); o.z = pk2(a[4] * rn * g1[i].x, a[5] * rn * g1[i].y); o.w = pk2(a[6] * rn * g1[i].z, a[7] * rn * g1[i].w);
            *(v4u*)(Y + (size_t)(4 * r) * SSD_IN + 128 * i) = o; } }
}

__device__ __forceinline__ void p8_ln_router(Frame& F) {
    const int gw = F.bid * NWAVES + F.wave, NGW = F.G * NWAVES, lane = F.lane;
    LAS float* wr = (LAS float*)F.lds;
    for (int i = F.tid; i < D * NE; i += NTHR) wr[(i & 15) * D + (i >> 4)] = INP(27)[i];
    __syncthreads();
    const float* HP = WSP(float, A_HP); float* ST = WSP(float, A_ST); unsigned char* H8 = F.ws + A_H8; float* AFF = WSP(float, A_AFF);
    const float* g1 = INP(25); const float* b1 = INP(26);
    f32x4 nx[4];
#pragma unroll
    for (int j = 0; j < 4; ++j) nx[j] = *((const f32x4*)(HP + (size_t)(gw < M ? gw : 0) * D) + lane + 64 * j);
    for (int m = gw; m < M; m += NGW) {
        f32x4 v[4]; float s = 0.f;
#pragma unroll
        for (int j = 0; j < 4; ++j) { v[j] = nx[j]; s += (v[j].x + v[j].y) + (v[j].z + v[j].w); }
        { const int mn = (m + NGW < M) ? m + NGW : m;
#pragma unroll
          for (int j = 0; j < 4; ++j) nx[j] = *((const f32x4*)(HP + (size_t)mn * D) + lane + 64 * j); }
        const float mean = wave_sum(s) * (1.f / D); float s2 = 0.f;
#pragma unroll
        for (int j = 0; j < 4; ++j) { v[j] = v[j] - mean; s2 += (v[j].x * v[j].x + v[j].y * v[j].y) + (v[j].z * v[j].z + v[j].w * v[j].w); }
        const float rstd = 1.f / sqrtf(wave_sum(s2) * (1.f / D) + LN_EPS);
        if (lane == 0) { typedef float f32x2_ __attribute__((ext_vector_type(2))); *(f32x2_*)(ST + 2 * (size_t)m) = (f32x2_){mean, rstd}; }
        float lg[16];
#pragma unroll
        for (int e = 0; e < 16; ++e) lg[e] = 0.f;
#pragma unroll
        for (int j = 0; j < 4; ++j) { const int c = 4 * lane + 256 * j; const f32x4 gg = *(const f32x4*)(g1 + c), bb = *(const f32x4*)(b1 + c);
            v[j] = v[j] * rstd * gg + bb;
            *((unsigned*)(H8 + (size_t)m * D) + lane + 64 * j) = pk4_fp8(v[j].x, v[j].y, v[j].z, v[j].w);
#pragma unroll
            for (int e = 0; e < 16; ++e) { const f32x4 w4 = *(const LAS f32x4*)(wr + e * D + c); lg[e] += (v[j].x * w4.x + v[j].y * w4.y) + (v[j].z * w4.z + v[j].w * w4.w); }
            asm volatile("" ::: "memory"); }
        { const bool hi = lane & 32;
#pragma unroll
          for (int k = 0; k < 8; ++k) { const float keep = hi ? lg[k + 8] : lg[k], send = hi ? lg[k] : lg[k + 8]; lg[k] = keep + __shfl_xor(send, 32); } }
        { const bool hi = lane & 16;
#pragma unroll
          for (int k = 0; k < 4; ++k) { const float keep = hi ? lg[k + 4] : lg[k], send = hi ? lg[k] : lg[k + 4]; lg[k] = keep + __shfl_xor(send, 16); } }
        { const bool hi = lane & 8;
#pragma unroll
          for (int k = 0; k < 2; ++k) { const float keep = hi ? lg[k + 2] : lg[k], send = hi ? lg[k] : lg[k + 2]; lg[k] = keep + __shfl_xor(send, 8); } }
        { const bool hi = lane & 4; const float keep = hi ? lg[1] : lg[0], send = hi ? lg[0] : lg[1]; lg[0] = keep + __shfl_xor(send, 4); }
        float lo = lg[0]; lo += __shfl_xor(lo, 2); lo += __shfl_xor(lo, 1);
        float mx = lo;
#pragma unroll
        for (int o = 4; o < 64; o <<= 1) mx = fmaxf(mx, __shfl_xor(mx, o));
        const float ex = expf(lo - mx); float sum = ex;
#pragma unroll
        for (int o = 4; o < 64; o <<= 1) sum += __shfl_xor(sum, o);
        if ((lane & 3) == 0) { const int e = lane >> 2, b = m / T, t = m % T; AFF[((size_t)b * NE + e) * T + t] = ex / sum; }
    }
}

__device__ __forceinline__ unsigned block_excl_scan(unsigned v, LAS unsigned* wsum  , int lane, int wave, unsigned& total) {
    unsigned inc = v;
#pragma unroll
    for (int o = 1; o < 64; o <<= 1) { const unsigned t = __shfl_up(inc, o); if (lane >= o) inc += t; }
    __syncthreads();
    if (lane == 63) wsum[wave] = inc;
    __syncthreads();
    unsigned off = 0, tot = 0;
#pragma unroll
    for (int w = 0; w < 8; ++w) { const unsigned s = wsum[w]; if (w < wave) off += s; tot += s; }
    total = tot; return off + inc - v;
}
__device__ __forceinline__ void p9_topk(Frame& F, int be) {
    const int b = be >> 4, e = be & 15, tid = F.tid;
    const float* av = WSP(float, A_AFF) + (size_t)be * T;
    int* IDX = WSP(int, A_IDX); int* SEL = WSP(int, A_SEL); float* GATE = WSP(float, A_GATE);
    LAS unsigned* hist = (LAS unsigned*)F.lds; LAS unsigned* shv = hist + 256; LAS unsigned* wsum = hist + 272;
    unsigned key[16];
#pragma unroll
    for (int q = 0; q < 4; ++q) { const v4u k4 = *(const v4u*)(av + tid * 16 + 4 * q); key[4 * q] = k4.x; key[4 * q + 1] = k4.y; key[4 * q + 2] = k4.z; key[4 * q + 3] = k4.w; }
    unsigned lo = 0u, hi_ex = 0u;
    bool hi_set = false;
    for (int it = 0; it < 32; ++it) {
        const unsigned span = (hi_set ? hi_ex : 0u) - lo;
        const unsigned mid = lo + (span >> 1) + ((span == 0u && !hi_set) ? 0x80000000u : 0u);
        unsigned cnt = 0;
#pragma unroll
        for (int i = 0; i < 16; ++i) cnt += (unsigned)__builtin_popcountll(__ballot(key[i] >= mid));
        LAS unsigned* slot_ = wsum + 16 + (it & 1) * 8;
        if (F.lane == 0) slot_[F.wave] = cnt;
        __syncthreads();
        unsigned tot = 0;
#pragma unroll
        for (int w = 0; w < 8; ++w) tot += slot_[w];
        if (tot >= (unsigned)CAP) lo = mid; else { hi_ex = mid; hi_set = true; }
    }
    const unsigned Tk = lo;
    unsigned krem;
    { unsigned cnt = 0;
#pragma unroll
      for (int i = 0; i < 16; ++i) cnt += (unsigned)__builtin_popcountll(__ballot(key[i] > Tk));
      __syncthreads(); if (F.lane == 0) wsum[16 + F.wave] = cnt; __syncthreads();
      unsigned tot = 0;
#pragma unroll
      for (int w = 0; w < 8; ++w) tot += wsum[16 + w];
      krem = (unsigned)CAP - tot; __syncthreads(); }
    unsigned cg = 0, ce = 0;
#pragma unroll
    for (int i = 0; i < 16; ++i) { cg += key[i] > Tk; ce += key[i] == Tk; }
    unsigned totg, tote;
    unsigned pg = block_excl_scan(cg, wsum, F.lane, F.wave, totg);
    unsigned pe = block_excl_scan(ce, wsum + 8, F.lane, F.wave, tote);
#pragma unroll
    for (int i = 0; i < 16; ++i) {
        const int t = tid * 16 + i; int slot = -1;
        if (key[i] > Tk) slot = (int)(pg++);
        else if (key[i] == Tk) { if (pe < krem) slot = (int)(totg + pe); ++pe; }
        const size_t m = (size_t)b * T + t;
        SEL[m * NE + e] = slot; GATE[m * NE + e] = __uint_as_float(key[i]);
        if (slot >= 0) IDX[(e * NB + b) * CAP + slot] = (int)m;
    }
    __builtin_amdgcn_fence(__ATOMIC_RELEASE, "agent"); asm volatile("s_waitcnt vmcnt(0)" ::: "memory"); __syncthreads();
    if (tid == 0) __hip_atomic_store((unsigned*)(F.ws + WS_CTL) + CW_LIST + 64 * be, 1u, __ATOMIC_RELAXED, __HIP_MEMORY_SCOPE_AGENT);
}
__device__ __forceinline__ void gather_rows_after(Frame& F, int r0, int nrows) {
    const int li = r0 >> 10, e = li >> 1, b = li & 1, be = b * 16 + e;
    if (F.wave == 0) { unsigned* flag = (unsigned*)(F.ws + WS_CTL) + CW_LIST + 64 * be; unsigned spins = 0;
        while (__builtin_amdgcn_readfirstlane(__hip_atomic_load(flag, __ATOMIC_RELAXED, __HIP_MEMORY_SCOPE_AGENT)) == 0u) { __builtin_amdgcn_s_sleep(2); if (++spins > (1u << 22)) break; }
        __builtin_amdgcn_fence(__ATOMIC_ACQUIRE, "agent"); asm volatile("s_waitcnt vmcnt(0)" ::: "memory"); }
    __syncthreads();
    const int* IDX = WSP(int, A_IDX); const unsigned char* H8 = F.ws + A_H8; unsigned char* XIN = F.ws + A_XIN; const int lane = F.lane;
    for (int rr = F.wave; rr < nrows; rr += 8 * NWAVES) {
        v4u va[8];
#pragma unroll
        for (int q = 0; q < 8; ++q) { const int ri = rr + q * NWAVES < nrows ? rr + q * NWAVES : rr; const int m_ = IDX[r0 + ri]; va[q] = *((const v4u*)(H8 + (size_t)m_ * D) + lane); }
#pragma unroll
        for (int q = 0; q < 8; ++q) if (rr + q * NWAVES < nrows) *((v4u*)(XIN + (size_t)(r0 + rr + q * NWAVES) * D) + lane) = va[q];
    }
}
__device__ __forceinline__ void moe_accumulate(f32x4 (&v)[4], int sl, float gt, int b, const bf16* YE, int lane) {
    unsigned mask = (unsigned)(__ballot(sl >= 0) & 0xffffull);
    while (mask) {
        int e[4]; float gv[4]; const bf16* yr[4];
#pragma unroll
        for (int k = 0; k < 4; ++k) { const bool ok = mask != 0u; const int ek = ok ? __builtin_ctz(mask) : e[k > 0 ? k - 1 : 0]; if (ok) mask &= mask - 1u; e[k] = ek;
            const int s = __shfl(sl, ek); gv[k] = ok ? __shfl(gt, ek) : 0.f; yr[k] = YE + ((size_t)(ek * NB + b) * CAP + (s < 0 ? 0 : s)) * D; }
        v2u w[4][4];
#pragma unroll
        for (int k = 0; k < 4; ++k)
#pragma unroll
            for (int j = 0; j < 4; ++j) w[k][j] = *((const v2u*)yr[k] + lane + 64 * j);
#pragma unroll
        for (int k = 0; k < 4; ++k)
#pragma unroll
            for (int j = 0; j < 4; ++j) { v[j].x += gv[k] * bflo(w[k][j].x); v[j].y += gv[k] * bfhi(w[k][j].x); v[j].z += gv[k] * bflo(w[k][j].y); v[j].w += gv[k] * bfhi(w[k][j].y); }
    }
}
__device__ __forceinline__ void ln_row_store(f32x4 (&v)[4], const float* g2, const float* b2, float* orow, int lane) {
    float s = 0.f;
#pragma unroll
    for (int j = 0; j < 4; ++j) s += (v[j].x + v[j].y) + (v[j].z + v[j].w);
    const float mean = wave_sum(s) * (1.f / D); float s2 = 0.f;
#pragma unroll
    for (int j = 0; j < 4; ++j) { v[j] = v[j] - mean; s2 += (v[j].x * v[j].x + v[j].y * v[j].y) + (v[j].z * v[j].z + v[j].w * v[j].w); }
    const float rstd = 1.f / sqrtf(wave_sum(s2) * (1.f / D) + LN_EPS);
#pragma unroll
    for (int j = 0; j < 4; ++j) { const int c = 4 * lane + 256 * j; const f32x4 gg = *(const f32x4*)(g2 + c), bb = *(const f32x4*)(b2 + c);
        *((f32x4*)orow + lane + 64 * j) = v[j] * rstd * gg + bb; }
}
__device__ __forceinline__ void p13_final(Frame& F) {
    const int gw = F.bid * NWAVES + F.wave, NGW = F.G * NWAVES, lane = F.lane;
    const float* HP = WSP(float, A_HP); const float* ST = WSP(float, A_ST); const float* g1 = INP(25); const float* b1 = INP(26); const int* SEL = WSP(int, A_SEL); const float* GATE = WSP(float, A_GATE); const bf16* YE = WSP(bf16, A_YE);
    const float* g2 = INP(31); const float* b2 = INP(32);
    for (int m = gw; m < M; m += 2 * NGW) {
        const int mB = (m + NGW < M) ? m + NGW : m;
        const int slA = SEL[(size_t)m * NE + (lane & 15)], slB = SEL[(size_t)mB * NE + (lane & 15)]; const float gtA = GATE[(size_t)m * NE + (lane & 15)], gtB = GATE[(size_t)mB * NE + (lane & 15)];
        typedef float f32x2_ __attribute__((ext_vector_type(2))); const f32x2_ stA = *(const f32x2_*)(ST + 2 * (size_t)m), stB = *(const f32x2_*)(ST + 2 * (size_t)mB);
        f32x4 vA[4], vB[4];
#pragma unroll
        for (int j = 0; j < 4; ++j) { const int c = 4 * lane + 256 * j; const f32x4 gg = *(const f32x4*)(g1 + c) * ALPHA, bb = *(const f32x4*)(b1 + c) * ALPHA;
            vA[j] = (*((const f32x4*)(HP + (size_t)m * D) + lane + 64 * j) - stA.x) * stA.y * gg + bb; vB[j] = (*((const f32x4*)(HP + (size_t)mB * D) + lane + 64 * j) - stB.x) * stB.y * gg + bb; }
        moe_accumulate(vA, slA, gtA, m / T, YE, lane); moe_accumulate(vB, slB, gtB, mB / T, YE, lane);
        ln_row_store(vA, g2, b2, F.out + (size_t)m * D, lane);
        if (mB != m) ln_row_store(vB, g2, b2, F.out + (size_t)mB * D, lane);
    }
}

constexpr int N_PHASES = 16;
struct Args { const float* in[33]; float* out; unsigned char* ws; int ph_lo, ph_hi; };
__global__ void __launch_bounds__(NTHR, 2) fwd(Args args) {
    extern __shared__ __attribute__((aligned(16))) unsigned char lds[];
    Frame F;
    F.lds = (LAS unsigned char*)lds;
    F.tid = threadIdx.x; F.lane = F.tid & 63; F.wave = __builtin_amdgcn_readfirstlane(F.tid >> 6);
    F.bid = blockIdx.x; F.G = gridDim.x;
    F.ptab = (LAS unsigned*)(F.lds + MISC_OFF + 512);
    if (F.tid < 33) { const unsigned long long p_ = (unsigned long long)args.in[F.tid]; F.ptab[2 * F.tid] = (unsigned)p_; F.ptab[2 * F.tid + 1] = (unsigned)(p_ >> 32); }
    F.out = args.out; F.ws = args.ws;
    volatile LAS unsigned* MISC = (volatile LAS unsigned*)(F.lds + MISC_OFF);
    if (F.tid < 64) MISC[F.tid] = 0u;
    __syncthreads();
    const int lo = args.ph_lo, hi = args.ph_hi;
    const bool single = (hi - lo) > 1;
    XcdBarrier bar; bar.bar = (unsigned*)(F.ws + WS_CTL) + CW_BAR; bar.x = 0; bar.st = nullptr;
    if (single) bar = xcd_barrier_post((unsigned*)(F.ws + WS_CTL) + CW_BAR, MISC + 8);
#ifndef PH_MASK
#define PH_MASK 0xffff
#endif
#define IN(k) (((PH_MASK >> (k)) & 1) && lo <= (k) && (k) < hi)
#define LAUNDER1(T_, p_) do { unsigned long long x_ = (unsigned long long)(p_); unsigned lo_ = (unsigned)x_, hi_ = (unsigned)(x_ >> 32); asm volatile("" : "+v"(lo_), "+v"(hi_)); \
        lo_ = __builtin_amdgcn_readfirstlane(lo_); hi_ = __builtin_amdgcn_readfirstlane(hi_); (p_) = (T_)(((unsigned long long)hi_ << 32) | lo_); } while (0)
#define LAUNDER() do { F.lane = (int)lane_now(); F.tid = F.wave * 64 + F.lane; } while (0)
#define SEAM(k) do { if (IN(k) && IN((k) + 1)) xcd_barrier(bar, T0()); } while (0)

#define T0() (F.wave == 0 && lane_now() == 0u)

    if (IN(0)) { LAUNDER(); p0_s5(F); p0_prologue(F); w1_convert(F, F.bid * NWAVES + F.wave, F.G * NWAVES, F.G == 256 ? (unsigned*)(F.ws + WS_CTL) + CW_QW1 : nullptr); } SEAM(0);
    if (IN(1)) { LAUNDER();
        pg8::Gemm g{WSP(pg8::bf16_t, A_XB), WSP(pg8::bf16_t, WS_WIN), M, NIN_PAD, D, D, D}; pg8::StaticOrder S; S.init(M, NIN_PAD, F.G, F.bid);
        pg8::EpiIn E{WSP(pg8::bf16_t, A_Z), WSP(pg8::bf16_t, A_XBC), WSP(pg8::bf16_t, A_UC), WSP(pg8::bf16_t, A_GT), WSP(float, A_DT), INP(6), INP(7)};
        pg8::gemm_phase<pg8::EpiIn, pg8::StaticOrder, PG8_ALIGN, PG8_SP2>(F.lds, g, S, E, F.tid);
    } SEAM(1);
    if (IN(2)) { LAUNDER();

        if (F.bid >= 160) { pg8::Gemm g{WSP(pg8::bf16_t, A_UC), WSP(pg8::bf16_t, WS_WS5), S5_G * 512, S5_G * 256, 512, 768, 512}; pg8::S5aOrder S{F.bid, 160};
            pg8::EpiS5a E{WSP(float, WS_SLOC)};
            pg8::gemm_phase<pg8::EpiS5a, pg8::S5aOrder, PG8_ALIGN, PG8_SP2>(F.lds, g, S, E, F.tid); __syncthreads(); }

        p2_conv(F);
        __syncthreads();
    } SEAM(2);
    if (IN(3)) { LAUNDER();
        for (int it = F.bid; it < S5_G * 4; it += F.G) s5_scan_item(F, it);
        __syncthreads();
        for (int it = F.bid * NWAVES + F.wave; it < 128 * SSD_H * 4; it += F.G * NWAVES) ssd_state_item(F, it);
    } SEAM(3);
    if (IN(4)) { LAUNDER();
        { pg8::Gemm g{WSP(pg8::bf16_t, A_UC), WSP(pg8::bf16_t, WS_TV), S5_G * 512, S5_G * 512, 768, 768, 768}; pg8::S5cOrder S{F.G, F.bid};
          pg8::EpiS5c E{WSP(pg8::bf16_t, A_GY), WSP(pg8::bf16_t, A_UC), INP(21)};
          pg8::gemm_phase<pg8::EpiS5c, pg8::S5cOrder, PG8_ALIGN, PG8_SP2>(F.lds, g, S, E, F.tid); }

        if (F.G == 256) { if (F.bid >= 192) ssd_scan(F, (F.bid - 192) * NTHR + F.tid, 64 * NTHR, 0, 65536); else if (F.bid < 64) ssd_scan(F, F.bid * NTHR + F.tid, 64 * NTHR, 65536, 96 * 1024); }
        else ssd_scan(F, F.bid * NTHR + F.tid, F.G * NTHR, 0, 96 * 1024);
    } SEAM(4);
    if (IN(5)) { LAUNDER(); __syncthreads();
        for (int u = F.bid; u < 128 * SSD_G; u += F.G) { ssd_out_unit(F, u); ssd_norm_unit(F, u); }
        __syncthreads();
        { pg8::Gemm g{WSP(pg8::bf16_t, A_GY), WSP(pg8::bf16_t, WS_WGLU), M, 2 * D, S5_W, S5_W, S5_W}; pg8::StaticOrder S; S.init(M, 2 * D, F.G, F.bid);
          pg8::EpiGlu E{WSP(pg8::bf16_t, A_YB), WSP(pg8::bf16_t, A_GT)};
          pg8::gemm_phase<pg8::EpiGlu, pg8::StaticOrder, PG8_ALIGN, PG8_SP2>(F.lds, g, S, E, F.tid); }
    } SEAM(5);
    if (IN(7)) { LAUNDER();
        pg8::Gemm g{WSP(pg8::bf16_t, A_Y), WSP(pg8::bf16_t, WS_WOUT), M, D, SSD_IN, SSD_IN, SSD_IN}; pg8::StaticOrder S; S.init(M, D, F.G, F.bid);
        pg8::EpiSsdOut E{WSP(pg8::bf16_t, A_MIX), WSP(pg8::bf16_t, A_YB), WSP(pg8::bf16_t, A_GT)};
        pg8::gemm_phase<pg8::EpiSsdOut, pg8::StaticOrder, PG8_ALIGN, PG8_SP2>(F.lds, g, S, E, F.tid);
    } SEAM(7);
    if (IN(9)) { LAUNDER();
        pg8::Gemm g{WSP(pg8::bf16_t, A_MIX), WSP(pg8::bf16_t, WS_WO), M, D, D, D, D}; pg8::StaticOrder S; S.init(M, D, F.G, F.bid);
        pg8::EpiWo E{WSP(float, A_HP), INP(0), ALPHA};
        pg8::gemm_phase<pg8::EpiWo, pg8::StaticOrder, PG8_ALIGN, PG8_SP2>(F.lds, g, S, E, F.tid);
    } SEAM(9);
    if (IN(10)) { LAUNDER(); p8_ln_router(F); } SEAM(10);
    if (IN(11)) { LAUNDER();
        if (F.bid < NB * NE) { p9_topk(F, F.bid); __syncthreads(); w2_convert(F, F.bid * NWAVES + F.wave, NB * NE * NWAVES, 0, 1280); }
        else w2_convert(F, (F.bid - NB * NE) * NWAVES + F.wave, (F.G - NB * NE) * NWAVES, 1280);
        __syncthreads();
        for (int r0 = F.bid * (MROWS / 256); r0 < MROWS; r0 += F.G * (MROWS / 256)) gather_rows_after(F, r0, MROWS / 256); __syncthreads(); } SEAM(11);

    if (IN(13)) { LAUNDER();
        pg8::Gemm g{WSP(pg8::bf16_t, A_XIN), WSP(pg8::bf16_t, WS_W1), MROWS, NE * 2 * FF, D, D, D}; pg8::MoeOrder1 S{F.G, F.bid};
        pg8::EpiMoe1 E{F.ws + A_HID, 1.0f / W1_SCALE, HID_SCALE};
        pg8::gemm_phase<pg8::EpiMoe1, pg8::MoeOrder1, PG8_ALIGN, PG8_SP2, true>(F.lds, g, S, E, F.tid);
    } SEAM(13);
    if (IN(14)) { LAUNDER();
        pg8::Gemm g{WSP(pg8::bf16_t, A_HID), WSP(pg8::bf16_t, WS_W2), MROWS, NE * D, FF, FF, FF}; pg8::MoeOrder2 S{F.G, F.bid};
        pg8::EpiMoe2 E{WSP(pg8::bf16_t, A_YE), 1.0f / (W2_SCALE * HID_SCALE)};
        pg8::gemm_phase<pg8::EpiMoe2, pg8::MoeOrder2, PG8_ALIGN, PG8_SP2, true>(F.lds, g, S, E, F.tid);
    } SEAM(14);
    if (IN(15)) { LAUNDER(); p13_final(F); }
#undef IN
#undef SEAM
}

#ifndef MK_ONE_LAUNCH
#define MK_ONE_LAUNCH 1
#endif
extern "C" void kernel_launch(void* const* d_in, const int* in_sizes, int n_in, void* d_out, int out_size, void* d_ws, size_t ws_size, hipStream_t stream) {
    static int grid = 0;
    if (grid == 0) {
        if (n_in != 33 || in_sizes[0] != M * D || out_size != M * D || ws_size < WS_END) { fprintf(stderr, "kernel_launch: unexpected problem (n_in %d, in0 %d, out %d, ws %zu < %zu)\n", n_in, n_in > 0 ? in_sizes[0] : -1, out_size, ws_size, (size_t)WS_END); grid = -1; return; }
        int dev = 0, cus = 0, per_cu = 0;
        if (hipGetDevice(&dev) != hipSuccess || hipDeviceGetAttribute(&cus, hipDeviceAttributeMultiprocessorCount, dev) != hipSuccess) { grid = -1; return; }
        if (hipFuncSetAttribute((const void*)fwd, hipFuncAttributeMaxDynamicSharedMemorySize, LDS_BYTES) != hipSuccess) { fprintf(stderr, "kernel_launch: hipFuncSetAttribute failed\n"); grid = -1; return; }
        if (hipOccupancyMaxActiveBlocksPerMultiprocessor(&per_cu, (const void*)fwd, NTHR, LDS_BYTES) != hipSuccess || per_cu < 1) fprintf(stderr, "kernel_launch: occupancy query reports %d blocks per CU\n", per_cu);
        (void)hipGetLastError();
        grid = cus;
    }
    if (grid < 0) return;
    (void)hipMemsetAsync((char*)d_ws + WS_CTL, 0, CTL_ZERO_BYTES, stream);
    Args a{};
    for (int i = 0; i < 33; ++i) a.in[i] = (const float*)d_in[i];
    a.out = (float*)d_out; a.ws = (unsigned char*)d_ws;
#if MK_ONE_LAUNCH
    a.ph_lo = 0; a.ph_hi = N_PHASES;
    hipLaunchKernelGGL(fwd, dim3(grid), dim3(NTHR), LDS_BYTES, stream, a);
#else
    for (int p = 0; p < N_PHASES; ++p) { a.ph_lo = p; a.ph_hi = p + 1; hipLaunchKernelGGL(fwd, dim3(grid), dim3(NTHR), LDS_BYTES, stream, a); }
#endif
}
```

```cpp
#include <hip/hip_runtime.h>
#include <cstdio>
#include <cstdint>
namespace pg8 {
#define PG8_LAS __attribute__((address_space(3)))
typedef unsigned short bf16_t;
typedef short bf16x8 __attribute__((ext_vector_type(8)));
typedef float f32x4 __attribute__((ext_vector_type(4)));
typedef unsigned u32x4 __attribute__((ext_vector_type(4)));
typedef int i32x8 __attribute__((ext_vector_type(8)));
constexpr int BM = 256, BK = 64, HALF = 128, HTB = HALF * BK * 2  , STAGE_BYTES = 8 * HTB, NXCD = 8, WGM = 8;

__host__ __device__ __forceinline__ int lds_byte(int r, int c) { const int st = (r >> 4) * 2 + (c >> 5), rr = r & 15, cc = c & 31, ob = rr * 64 + cc * 2; return st * 1024 + (ob ^ (((ob >> 9) & 1) << 5)); }
__host__ __device__ __forceinline__ void stage_rc(int b, int& R, int& C) { const int st = b / 1024, sb = b % 1024, swz = sb ^ (((sb >> 9) & 1) << 5); R = (st >> 1) * 16 + swz / 64; C = (st & 1) * 32 + (swz % 64) / 2; }
__host__ __device__ __forceinline__ int perm32(int rho) { const int n = rho >> 4, i = rho & 15; return 8 * (i >> 2) + 4 * n + (i & 3); }

struct Unit { int pm, pn; };
struct Gemm { const bf16_t* A; const bf16_t* Bt; int M, N, K, lda, ldb; };

struct StaticOrder {
    int nM, nN, nwg, G, c;
    __host__ __device__ void init(int M, int N, int G_, int c_) { nM = M / BM; nN = N / BM; nwg = nM * nN; G = G_; c = c_; }
    __host__ __device__ bool next(int i, Unit& u) const {
        const long L = (long)i * G + c; if (L >= nwg) return false;
        int wgid = (int)L; { const int q = nwg / NXCD, r = nwg % NXCD, xcd = wgid % NXCD, off = wgid / NXCD; wgid = (xcd < r ? xcd * (q + 1) : r * (q + 1) + (xcd - r) * q) + off; }
        const int nig = WGM * nN, gid = wgid / nig, fm = gid * WGM, gsz = (nM - fm) < WGM ? (nM - fm) : WGM;
        u.pm = fm + ((wgid % nig) % gsz); u.pn = (wgid % nig) / gsz; return true;
    }
    __device__ __forceinline__ void a_ready(const Unit&) const {}
    __device__ __forceinline__ void done(const Unit&) const {}
};

typedef __bf16 bf16v2_t __attribute__((ext_vector_type(2)));
typedef float f32v2_t __attribute__((ext_vector_type(2)));
__device__ __forceinline__ unsigned cvt_pk_bf16(float lo, float hi) { const f32v2_t f = {lo, hi}; return __builtin_bit_cast(unsigned, __builtin_convertvector(f, bf16v2_t)); }
typedef float f32x2 __attribute__((ext_vector_type(2)));
__device__ __forceinline__ f32x2 gelu_pk(f32x2 v) {
    const f32x2 av = __builtin_elementwise_abs(v), d = av * 0.2316418882f + 1.0f;
    f32x2 t; t.x = __builtin_amdgcn_rcpf(d.x); t.y = __builtin_amdgcn_rcpf(d.y);
    f32x2 q = t * 0.5307027145f + (-0.7265760135f); q = q * t + 0.7107068705f; q = q * t + (-0.142248368f); q = q * t + 0.127414796f; q = q * t;
    const f32x2 s = (v * v) * (-0.72134752044f);
    f32x2 e; e.x = __builtin_amdgcn_exp2f(s.x); e.y = __builtin_amdgcn_exp2f(s.y);
    const f32x2 m = v * (q * e), r = v - m;
    f32x2 o; o.x = v.x < 0.f ? m.x : r.x; o.y = v.y < 0.f ? m.y : r.y; return o;
}


__device__ __forceinline__ float fsigmoid(float x) { return __builtin_amdgcn_rcpf(1.0f + __expf(-x)); }
__device__ __forceinline__ float fsilu(float x) { return x * fsigmoid(x); }
__device__ __forceinline__ float bf_lo(unsigned w) { return __uint_as_float(w << 16); }
__device__ __forceinline__ float bf_hi(unsigned w) { return __uint_as_float(w & 0xffff0000u); }
typedef unsigned u32x2 __attribute__((ext_vector_type(2)));

struct EpiIn {
    static constexpr bool PERM = true, AFTER_DRAIN = false;
    bf16_t *Z, *XBC, *UC, *GT; float* DT; const float *dtb_f, *dtb_b;
    __device__ __forceinline__ void operator()(const f32x4 (&acc)[2][2][4][2], const Unit& u, int wr, int wc, int fr, int fq) const {
        const int row0 = u.pm * BM + wr * 64 + fr; const int pn = u.pn;
        if (pn == 16) {
            if (wc < 2) {
#pragma unroll
                for (int n = 0; n < 2; ++n) { const int col = wc * 32 + 8 * fq + 4 * n;
                    if (col < 48) { f32x4 bv;
#pragma unroll
                        for (int j = 0; j < 4; ++j) { const int cc = col + j; bv[j] = cc < 24 ? dtb_f[cc] : dtb_b[cc - 24]; }
#pragma unroll
                        for (int ai = 0; ai < 2; ++ai)
#pragma unroll
                            for (int m = 0; m < 4; ++m) { f32x4 v = acc[ai][0][m][n] + bv;
#pragma unroll
                                for (int j = 0; j < 4; ++j) { const float x = v[j]; v[j] = fmaxf(x, 0.f) + log1pf(__expf(-fabsf(x))); }
                                *(f32x4*)(DT + (size_t)(row0 + ai * HALF + m * 16) * 48 + col) = v; } } }
            }
            return;
        }
        int mode, ldc, colt; bf16_t* base;
        if (pn < 6) { mode = 1; base = Z; ldc = 1536; colt = pn * BM; }
        else if (pn < 16) { mode = 0; base = XBC; ldc = 2560; colt = (pn - 6) * BM; }
        else if (pn < 20) {
            const int uc = (pn - 17) * BM + wc * 32 + 8 * fq, g0 = uc >> 4, j0 = uc & 15;
#pragma unroll
            for (int ai = 0; ai < 2; ++ai)
#pragma unroll
                for (int m = 0; m < 4; ++m) { const int r = row0 + ai * HALF + m * 16, cl = r >> 5, s = r & 31;
#pragma unroll
                    for (int bj = 0; bj < 2; ++bj) { const f32x4 v0 = acc[ai][bj][m][0], v1 = acc[ai][bj][m][1];
                        u32x4 w; w.x = cvt_pk_bf16(v0[0], v0[1]); w.y = cvt_pk_bf16(v0[2], v0[3]); w.z = cvt_pk_bf16(v1[0], v1[1]); w.w = cvt_pk_bf16(v1[2], v1[3]);
                        *(u32x4*)(UC + ((size_t)((g0 + 8 * bj) * 512 + cl) * 768 + s * 16 + j0)) = w; } }
            return; }
        else { mode = 2; base = GT; ldc = 2048; colt = (pn - 20) * BM; }
        const int col0 = colt + wc * 32 + 8 * fq;
#pragma unroll
        for (int ai = 0; ai < 2; ++ai)
#pragma unroll
            for (int m = 0; m < 4; ++m) { bf16_t* rowp = base + (size_t)(row0 + ai * HALF + m * 16) * ldc + col0;
#pragma unroll
                for (int bj = 0; bj < 2; ++bj) { f32x4 v0 = acc[ai][bj][m][0], v1 = acc[ai][bj][m][1];
                    if (mode == 1) {
#pragma unroll
                        for (int j = 0; j < 4; ++j) { v0[j] = fsilu(v0[j]); v1[j] = fsilu(v1[j]); } }
                    else if (mode == 2) {
#pragma unroll
                        for (int j = 0; j < 4; ++j) { v0[j] = fsigmoid(v0[j]); v1[j] = fsigmoid(v1[j]); } }
                    u32x4 w; w.x = cvt_pk_bf16(v0[0], v0[1]); w.y = cvt_pk_bf16(v0[2], v0[3]); w.z = cvt_pk_bf16(v1[0], v1[1]); w.w = cvt_pk_bf16(v1[2], v1[3]);
                    *(u32x4*)(rowp + bj * HALF) = w; } }
    }
};
struct EpiSsdOut {
    static constexpr bool PERM = true, AFTER_DRAIN = false;
    bf16_t* MIX; const bf16_t* YB; const bf16_t* GT;
    __device__ __forceinline__ void operator()(const f32x4 (&acc)[2][2][4][2], const Unit& u, int wr, int wc, int fr, int fq) const {
        const int row0 = u.pm * BM + wr * 64 + fr, col0 = u.pn * BM + wc * 32 + 8 * fq;
#pragma unroll
        for (int ai = 0; ai < 2; ++ai)
#pragma unroll
            for (int m = 0; m < 4; ++m) { const size_t r = (size_t)(row0 + ai * HALF + m * 16);
#pragma unroll
                for (int bj = 0; bj < 2; ++bj) { const int c = col0 + bj * HALF; const u32x4 g = *(const u32x4*)(GT + r * 2048 + c), y = *(const u32x4*)(YB + r * 1024 + c);
                    const f32x4 a0 = acc[ai][bj][m][0], a1 = acc[ai][bj][m][1];
                    u32x4 w; w.x = cvt_pk_bf16(a0[0] * bf_lo(g.x) + bf_lo(y.x), a0[1] * bf_hi(g.x) + bf_hi(y.x)); w.y = cvt_pk_bf16(a0[2] * bf_lo(g.y) + bf_lo(y.y), a0[3] * bf_hi(g.y) + bf_hi(y.y));
                    w.z = cvt_pk_bf16(a1[0] * bf_lo(g.z) + bf_lo(y.z), a1[1] * bf_hi(g.z) + bf_hi(y.z)); w.w = cvt_pk_bf16(a1[2] * bf_lo(g.w) + bf_lo(y.w), a1[3] * bf_hi(g.w) + bf_hi(y.w));
                    *(u32x4*)(MIX + r * 1024 + c) = w; } }
    }
};
struct EpiGlu {
    static constexpr bool PERM = true, AFTER_DRAIN = false;
    bf16_t* YB; const bf16_t* GT;
    __device__ __forceinline__ void operator()(const f32x4 (&acc)[2][2][4][2], const Unit& u, int wr, int wc, int fr, int fq) const {
        const int row0 = u.pm * BM + wr * 64 + fr, col0 = u.pn * HALF + wc * 32 + 8 * fq;
#pragma unroll
        for (int ai = 0; ai < 2; ++ai)
#pragma unroll
            for (int m = 0; m < 4; ++m) { const size_t r = (size_t)(row0 + ai * HALF + m * 16);
                const u32x4 g = *(const u32x4*)(GT + r * 2048 + 1024 + col0);
                f32x4 a0 = acc[ai][0][m][0], a1 = acc[ai][0][m][1]; const f32x4 b0 = acc[ai][1][m][0], b1 = acc[ai][1][m][1];
#pragma unroll
                for (int j = 0; j < 4; ++j) { a0[j] *= fsigmoid(b0[j]); a1[j] *= fsigmoid(b1[j]); }
                u32x4 w; w.x = cvt_pk_bf16(a0[0] * bf_lo(g.x), a0[1] * bf_hi(g.x)); w.y = cvt_pk_bf16(a0[2] * bf_lo(g.y), a0[3] * bf_hi(g.y)); w.z = cvt_pk_bf16(a1[0] * bf_lo(g.z), a1[1] * bf_hi(g.z)); w.w = cvt_pk_bf16(a1[2] * bf_lo(g.w), a1[3] * bf_hi(g.w));
                *(u32x4*)(YB + r * 1024 + col0) = w; }
    }
};
struct EpiWo {
    static constexpr bool PERM = false, AFTER_DRAIN = false;
    float* HP; const float* X; float alpha;
    __device__ __forceinline__ void operator()(const f32x4 (&acc)[2][2][4][2], const Unit& u, int wr, int wc, int fr, int fq) const {
        const int row0 = u.pm * BM + wr * 64 + fr, col0 = u.pn * BM + wc * 32 + 4 * fq;
#pragma unroll
        for (int ai = 0; ai < 2; ++ai)
#pragma unroll
            for (int m = 0; m < 4; ++m) { const size_t r = (size_t)(row0 + ai * HALF + m * 16);
#pragma unroll
                for (int bj = 0; bj < 2; ++bj)
#pragma unroll
                    for (int n = 0; n < 2; ++n) { const int c = col0 + bj * HALF + n * 16; const f32x4 xv = *(const f32x4*)(X + r * 1024 + c);
                        *(f32x4*)(HP + r * 1024 + c) = acc[ai][bj][m][n] + xv * alpha; } }
    }
};
__device__ __forceinline__ unsigned pk4_fp8_(float a, float b, float c, float d) { int r_ = __builtin_amdgcn_cvt_pk_fp8_f32(a, b, 0, false); r_ = __builtin_amdgcn_cvt_pk_fp8_f32(c, d, r_, true); return (unsigned)r_; }
struct EpiMoe1 {
    static constexpr bool PERM = true, AFTER_DRAIN = false;
    unsigned char* HID; float inv, hs;
    __device__ __forceinline__ void operator()(const f32x4 (&acc)[2][2][4][2], const Unit& u, int wr, int wc, int fr, int fq) const {
        const int row0 = u.pm * BM + wr * 64 + fr, col0 = (u.pn % 22) * HALF + wc * 32 + 8 * fq;
#pragma unroll
        for (int ai = 0; ai < 2; ++ai)
#pragma unroll
            for (int m = 0; m < 4; ++m) { const size_t r = (size_t)(row0 + ai * HALF + m * 16);
                f32x4 a0 = acc[ai][0][m][0] * inv, a1 = acc[ai][0][m][1] * inv; const f32x4 b0 = acc[ai][1][m][0] * (inv * hs), b1 = acc[ai][1][m][1] * (inv * hs);
#pragma unroll
                for (int j = 0; j < 4; ++j) { a0[j] = fsilu(a0[j]) * b0[j]; a1[j] = fsilu(a1[j]) * b1[j]; }
                u32x2 w; w.x = pk4_fp8_(a0[0], a0[1], a0[2], a0[3]); w.y = pk4_fp8_(a1[0], a1[1], a1[2], a1[3]);
                *(u32x2*)(HID + r * 2816 + col0) = w; }
    }
};
struct EpiMoe2 {
    static constexpr bool PERM = true, AFTER_DRAIN = false;
    bf16_t* Y; float inv;
    __device__ __forceinline__ void operator()(const f32x4 (&acc)[2][2][4][2], const Unit& u, int wr, int wc, int fr, int fq) const {
        const int row0 = u.pm * BM + wr * 64 + fr, col0 = (u.pn & 3) * BM + wc * 32 + 8 * fq;
#pragma unroll
        for (int ai = 0; ai < 2; ++ai)
#pragma unroll
            for (int m = 0; m < 4; ++m) { bf16_t* rowp = Y + (size_t)(row0 + ai * HALF + m * 16) * 1024 + col0;
#pragma unroll
                for (int bj = 0; bj < 2; ++bj) { const f32x4 v0 = acc[ai][bj][m][0] * inv, v1 = acc[ai][bj][m][1] * inv;
                    u32x4 w; w.x = cvt_pk_bf16(v0[0], v0[1]); w.y = cvt_pk_bf16(v0[2], v0[3]); w.z = cvt_pk_bf16(v1[0], v1[1]); w.w = cvt_pk_bf16(v1[2], v1[3]);
                    *(u32x4*)(rowp + bj * HALF) = w; } }
    }
};
struct EpiS5a {
    static constexpr bool PERM = false, AFTER_DRAIN = false;
    float* SLOC;
    __device__ __forceinline__ void operator()(const f32x4 (&acc)[2][2][4][2], const Unit& u, int wr, int wc, int fr, int fq) const {
        const int row0 = u.pm * BM + wr * 64 + fr, col0 = wc * 32 + 4 * fq;
#pragma unroll
        for (int ai = 0; ai < 2; ++ai)
#pragma unroll
            for (int m = 0; m < 4; ++m) { float* rowp = SLOC + (size_t)(row0 + ai * HALF + m * 16) * 256 + col0;
#pragma unroll
                for (int bj = 0; bj < 2; ++bj)
#pragma unroll
                    for (int n = 0; n < 2; ++n) *(f32x4*)(rowp + bj * HALF + n * 16) = acc[ai][bj][m][n]; }
    }
};
__device__ __forceinline__ float gelu_tanh_f(float x) { const float uu = 0.7978845608028654f * (x + 0.044715f * x * x * x); const float e = __expf(2.f * uu); return 0.5f * x * (2.f - 2.f * __builtin_amdgcn_rcpf(e + 1.f)); }
struct EpiS5c {
    static constexpr bool PERM = true, AFTER_DRAIN = false;
    bf16_t* GY; const bf16_t* UC; const float* d5;
    __device__ __forceinline__ void operator()(const f32x4 (&acc)[2][2][4][2], const Unit& u, int wr, int wc, int fr, int fq) const {
        const int g = u.pm >> 1, cl0 = (u.pm & 1) * BM + wr * 64 + fr, nl0 = (u.pn & 1) * BM + wc * 32 + 8 * fq;
        const int k0 = nl0 & 15; const f32x4 d0 = *(const f32x4*)(d5 + g * 16 + k0), d1 = *(const f32x4*)(d5 + g * 16 + k0 + 4);
#pragma unroll
        for (int ai = 0; ai < 2; ++ai)
#pragma unroll
            for (int m = 0; m < 4; ++m) { const int cl = cl0 + ai * HALF + m * 16;
#pragma unroll
                for (int bj = 0; bj < 2; ++bj) { const int nl = nl0 + bj * HALF, t = nl >> 4;
                    const u32x4 uw = *(const u32x4*)(UC + ((size_t)(g * 512 + cl) * 768 + nl));
                    f32x4 v0 = acc[ai][bj][m][0], v1 = acc[ai][bj][m][1];
                    v0[0] += bf_lo(uw.x) * d0[0]; v0[1] += bf_hi(uw.x) * d0[1]; v0[2] += bf_lo(uw.y) * d0[2]; v0[3] += bf_hi(uw.y) * d0[3];
                    v1[0] += bf_lo(uw.z) * d1[0]; v1[1] += bf_hi(uw.z) * d1[1]; v1[2] += bf_lo(uw.w) * d1[2]; v1[3] += bf_hi(uw.w) * d1[3];
#pragma unroll
                    for (int j = 0; j < 4; ++j) { v0[j] = gelu_tanh_f(v0[j]); v1[j] = gelu_tanh_f(v1[j]); }
                    u32x4 w; w.x = cvt_pk_bf16(v0[0], v0[1]); w.y = cvt_pk_bf16(v0[2], v0[3]); w.z = cvt_pk_bf16(v1[0], v1[1]); w.w = cvt_pk_bf16(v1[2], v1[3]);
                    *(u32x4*)(GY + (size_t)(cl * 32 + t) * 768 + g * 16 + k0) = w; } }
    }
};
struct S5aOrder {
    int c, lo;
    __device__ __forceinline__ bool next(int i, Unit& u) const { if (i > 0 || c < lo || c >= lo + 96) return false; u.pm = c - lo; u.pn = (c - lo) >> 1; return true; }
    __device__ __forceinline__ void a_ready(const Unit&) const {}
    __device__ __forceinline__ void done(const Unit&) const {}
};
struct S5cOrder {
    int G, c;
    __device__ __forceinline__ bool next(int i, Unit& u) const { const int L = i * G + c; if (L >= 192) return false; const int g = L >> 2; u.pm = 2 * g + (L & 1); u.pn = 2 * g + ((L >> 1) & 1); return true; }
    __device__ __forceinline__ void a_ready(const Unit&) const {}
    __device__ __forceinline__ void done(const Unit&) const {}
};
struct MoeOrder1 {
    int G, c;
    __device__ __forceinline__ bool next(int i, Unit& u) const {
        if (G == 256) { if (i >= 11) return false; const int x = c & 7, j = c >> 3, q = x * 44 + i * 4 + (j >> 3); u.pm = (q / 22) * 8 + (j & 7); u.pn = q; return true; }
        const long L = (long)i * G + c; if (L >= 2816) return false; const int e = (int)(L / 176), r = (int)(L % 176); u.pm = e * 8 + (r & 7); u.pn = e * 22 + (r >> 3); return true;
    }
    __device__ __forceinline__ void a_ready(const Unit&) const {}
    __device__ __forceinline__ void done(const Unit&) const {}
};
struct MoeOrder2 {
    int G, c;
    __device__ __forceinline__ bool next(int i, Unit& u) const {
        if (G == 256) { if (i >= 2) return false; const int x = c & 7, j = c >> 3, e = 2 * x + i; u.pm = e * 8 + (j & 7); u.pn = e * 4 + (j >> 3); return true; }
        const long L = (long)i * G + c; if (L >= 512) return false; const int e = (int)(L / 32), r = (int)(L % 32); u.pm = e * 8 + (r & 7); u.pn = e * 4 + (r >> 3); return true;
    }
    __device__ __forceinline__ void a_ready(const Unit&) const {}
    __device__ __forceinline__ void done(const Unit&) const {}
};
template <class Epi, class Sched, bool ALIGN_EPI = false, bool SP2 = false, bool F8 = false>
__device__ __forceinline__ void gemm_phase(PG8_LAS unsigned char* lds, const Gemm g, const Sched& S, const Epi& E, const int tid) {
    const int wid = __builtin_amdgcn_readfirstlane(tid >> 6), lane = tid & 63, wr = wid >> 2, wc = wid & 3, fr = lane & 15, fq = lane >> 4;
    const int K = g.K, nt = F8 ? K / 128 : K / BK; constexpr int ESZ = F8 ? 1 : 2, KOFF = F8 ? 16 : 1024;
    unsigned voffA, voffB;
    { int R, C; stage_rc(tid * 16, R, C); const int Rb = Epi::PERM ? ((R & ~31) + perm32(R & 31)) : R;
      voffA = (unsigned)(R * g.lda * ESZ + C * 2); voffB = (unsigned)(Rb * g.ldb * ESZ + C * 2); }
    const unsigned r64A = 64u * (unsigned)g.lda * ESZ, r64B = 64u * (unsigned)g.ldb * ESZ;
    const __amdgpu_buffer_rsrc_t rsrcA = __builtin_amdgcn_make_buffer_rsrc((void*)g.A, 0, (int)((unsigned)g.M * (unsigned)g.lda * ESZ), 0x00020000), rsrcB = __builtin_amdgcn_make_buffer_rsrc((void*)g.Bt, 0, (int)((unsigned)g.N * (unsigned)g.ldb * ESZ), 0x00020000);
    const unsigned kstep = (unsigned)(BK * 2);
    const unsigned hstepA = (unsigned)HALF * g.lda * ESZ, hstepB = (unsigned)HALF * g.ldb * ESZ;
    const unsigned tstepA = 2 * hstepA, tstepB = 2 * hstepB;
    const unsigned ldsw = (unsigned)wid * 1024u;
    const int aoff = lds_byte(wr * 64 + fr, F8 ? fq * 16 : fq * 8), boff = lds_byte(wc * 32 + fr, F8 ? fq * 16 : fq * 8);
#define PG8_SA(b, h) (((b) * 2 + (h)) * HTB)
#define PG8_SB(b, h) ((4 + (b) * 2 + (h)) * HTB)
#define PG8_STAGE(bufoff, gbase, voff) do { _Pragma("unroll") for (int _i = 0; _i < 2; ++_i) \
        __builtin_amdgcn_raw_ptr_buffer_load_lds(PG8_RSRC(voff), (PG8_LAS unsigned*)(lds + (bufoff) + ldsw + _i * 8192), 16, (int)(voff), (int)((gbase) + _i * PG8_R64(voff)), 0, 0); } while (0)
#define PG8_RSRC(voff) (&(voff) == &voffA ? rsrcA : rsrcB)
#define PG8_R64(voff) (&(voff) == &voffA ? r64A : r64B)
#define PG8_LDA(dst, b, h) do { _Pragma("unroll") for (int m = 0; m < 4; ++m) _Pragma("unroll") for (int k = 0; k < 2; ++k) dst[m][k] = *(const PG8_LAS bf16x8*)(lds + PG8_SA(b, h) + aoff + m * 2048 + k * KOFF); } while (0)
#define PG8_LDB(dst, b, h) do { _Pragma("unroll") for (int n = 0; n < 2; ++n) _Pragma("unroll") for (int k = 0; k < 2; ++k) dst[n][k] = *(const PG8_LAS bf16x8*)(lds + PG8_SB(b, h) + boff + n * 2048 + k * KOFF); } while (0)
#define PG8_CAT8(x_) __builtin_bit_cast(i32x8, __builtin_shufflevector((x_)[0], (x_)[1], 0, 1, 2, 3, 4, 5, 6, 7, 8, 9, 10, 11, 12, 13, 14, 15))
#define PG8_MMA(ai, bj, At, Bt) do { __builtin_amdgcn_s_setprio(1); if constexpr (F8) { _Pragma("unroll") for (int m = 0; m < 4; ++m) _Pragma("unroll") for (int n = 0; n < 2; ++n) \
        acc[ai][bj][m][n] = __builtin_amdgcn_mfma_scale_f32_16x16x128_f8f6f4(PG8_CAT8(Bt[n]), PG8_CAT8(At[m]), acc[ai][bj][m][n], 0, 0, 0, 0x7f7f7f7f, 0, 0x7f7f7f7f); } \
      else { _Pragma("unroll") for (int m = 0; m < 4; ++m) _Pragma("unroll") for (int n = 0; n < 2; ++n) _Pragma("unroll") for (int k = 0; k < 2; ++k) \
        acc[ai][bj][m][n] = __builtin_amdgcn_mfma_f32_16x16x32_bf16(Bt[n][k], At[m][k], acc[ai][bj][m][n], 0, 0, 0); } __builtin_amdgcn_s_setprio(0); } while (0)
#define PG8_WAIT_V(n) asm volatile("s_waitcnt vmcnt(" #n ")" ::: "memory")
#define PG8_WAIT_L(n) asm volatile("s_waitcnt lgkmcnt(" #n ")" ::: "memory")
#define PG8_BAR __builtin_amdgcn_s_barrier()
#define PG8_SCHED __builtin_amdgcn_sched_barrier(0)
    Unit cur, nxt; int ui = 0;
    if (!S.next(0, cur)) return;
    f32x4 acc[2][2][4][2];
#pragma unroll
    for (int a = 0; a < 2; ++a)
#pragma unroll
        for (int b = 0; b < 2; ++b)
#pragma unroll
            for (int m = 0; m < 4; ++m)
#pragma unroll
                for (int n = 0; n < 2; ++n) acc[a][b][m][n] = (f32x4){0.f, 0.f, 0.f, 0.f};
    bf16x8 At[4][2], B0[2][2], B1[2][2];
    unsigned cA = (unsigned)cur.pm * tstepA, cB = (unsigned)cur.pn * tstepB;
    S.a_ready(cur);
    if constexpr (SP2) {
        PG8_STAGE(PG8_SB(0, 0), cB, voffB); PG8_STAGE(PG8_SB(0, 1), cB + hstepB, voffB); PG8_STAGE(PG8_SA(0, 0), cA, voffA); PG8_STAGE(PG8_SA(0, 1), cA + hstepA, voffA);
        if (wr == 1) PG8_BAR;
        PG8_WAIT_V(2); PG8_BAR;
        PG8_STAGE(PG8_SB(1, 0), cB + kstep, voffB); PG8_STAGE(PG8_SA(1, 0), cA + kstep, voffA); PG8_STAGE(PG8_SB(1, 1), cB + hstepB + kstep, voffB);
        PG8_WAIT_V(6); PG8_BAR;
    } else {
        PG8_STAGE(PG8_SB(0, 0), cB, voffB); PG8_STAGE(PG8_SA(0, 0), cA, voffA); PG8_STAGE(PG8_SB(0, 1), cB + hstepB, voffB); PG8_STAGE(PG8_SA(0, 1), cA + hstepA, voffA);
        if (wr == 1) PG8_BAR;
        PG8_WAIT_V(4); PG8_BAR;
        PG8_STAGE(PG8_SB(1, 0), cB + kstep, voffB); PG8_STAGE(PG8_SA(1, 0), cA + kstep, voffA); PG8_STAGE(PG8_SB(1, 1), cB + hstepB + kstep, voffB);
        PG8_WAIT_V(6); PG8_BAR;
    }
    for (;;) {
        const bool has_next = S.next(ui + 1, nxt);
        const unsigned nA = has_next ? (unsigned)nxt.pm * tstepA : cA, nB = has_next ? (unsigned)nxt.pn * tstepB : cB;
#pragma unroll 1
        for (int t = 0; t < nt; t += 2) {
            const bool last = (t == nt - 2);
            const unsigned a1 = cA + (unsigned)(t + 1) * kstep;
            const unsigned a2 = last ? nA : cA + (unsigned)(t + 2) * kstep, b2 = last ? nB : cB + (unsigned)(t + 2) * kstep;
            const unsigned a3 = a2 + kstep, b3 = b2 + kstep;
            if (last && has_next) S.a_ready(nxt);
            if constexpr (SP2) {
            PG8_LDB(B0, 0, 0); PG8_LDB(B1, 0, 1); PG8_SCHED; PG8_LDA(At, 0, 0); PG8_STAGE(PG8_SA(1, 1), a1 + hstepA, voffA);
            PG8_WAIT_V(8); PG8_WAIT_L(0); PG8_BAR; PG8_MMA(0, 0, At, B0); PG8_MMA(0, 1, At, B1); PG8_BAR; PG8_SCHED;
            PG8_LDA(At, 0, 1); PG8_STAGE(PG8_SB(0, 0), b2, voffB); PG8_STAGE(PG8_SB(0, 1), b2 + hstepB, voffB); PG8_STAGE(PG8_SA(0, 0), a2, voffA);
            PG8_WAIT_V(8); PG8_WAIT_L(0); PG8_BAR; PG8_MMA(1, 0, At, B0); PG8_MMA(1, 1, At, B1); PG8_BAR; PG8_SCHED;
            PG8_LDB(B0, 1, 0); PG8_LDB(B1, 1, 1); PG8_SCHED; PG8_LDA(At, 1, 0); PG8_STAGE(PG8_SA(0, 1), a2 + hstepA, voffA);
            PG8_WAIT_V(8); PG8_WAIT_L(0); PG8_BAR; PG8_MMA(0, 0, At, B0); PG8_MMA(0, 1, At, B1); PG8_BAR; PG8_SCHED;
            PG8_LDA(At, 1, 1); PG8_STAGE(PG8_SB(1, 0), b3, voffB); PG8_STAGE(PG8_SB(1, 1), b3 + hstepB, voffB); PG8_STAGE(PG8_SA(1, 0), a3, voffA);
            PG8_WAIT_V(8); PG8_WAIT_L(0); PG8_BAR; PG8_MMA(1, 0, At, B0); PG8_MMA(1, 1, At, B1); PG8_BAR; PG8_SCHED;
            } else {
            PG8_LDB(B0, 0, 0); PG8_SCHED; PG8_LDA(At, 0, 0); PG8_STAGE(PG8_SA(1, 1), a1 + hstepA, voffA);
            PG8_WAIT_L(8); PG8_BAR; PG8_WAIT_L(0); PG8_MMA(0, 0, At, B0); PG8_BAR; PG8_SCHED;
            PG8_LDB(B1, 0, 1); PG8_STAGE(PG8_SB(0, 0), b2, voffB);
            PG8_BAR; PG8_WAIT_L(0); PG8_MMA(0, 1, At, B1); PG8_BAR;
            PG8_LDA(At, 0, 1); PG8_STAGE(PG8_SA(0, 0), a2, voffA);
            PG8_BAR; PG8_WAIT_L(0); PG8_MMA(1, 0, At, B0); PG8_BAR; PG8_SCHED;
            PG8_STAGE(PG8_SB(0, 1), b2 + hstepB, voffB);
            PG8_WAIT_V(6); PG8_BAR; PG8_MMA(1, 1, At, B1); PG8_BAR;
            PG8_LDB(B0, 1, 0); PG8_SCHED; PG8_LDA(At, 1, 0); PG8_STAGE(PG8_SA(0, 1), a2 + hstepA, voffA);
            PG8_WAIT_L(8); PG8_BAR; PG8_WAIT_L(0); PG8_MMA(0, 0, At, B0); PG8_BAR; PG8_SCHED;
            PG8_LDB(B1, 1, 1); PG8_STAGE(PG8_SB(1, 0), b3, voffB);
            PG8_BAR; PG8_WAIT_L(0); PG8_MMA(0, 1, At, B1); PG8_BAR;
            PG8_LDA(At, 1, 1); PG8_STAGE(PG8_SA(1, 0), a3, voffA);
            PG8_BAR; PG8_WAIT_L(0); PG8_MMA(1, 0, At, B0); PG8_BAR; PG8_SCHED;
            PG8_STAGE(PG8_SB(1, 1), b3 + hstepB, voffB);
            PG8_WAIT_V(6); PG8_BAR; PG8_MMA(1, 1, At, B1); PG8_BAR;
            }
        }
        if constexpr (ALIGN_EPI) { if (wr == 0) PG8_BAR; }
        if constexpr (!Epi::AFTER_DRAIN) { E(acc, cur, wr, wc, fr, fq); S.done(cur); }
        if (!has_next) break;
#pragma unroll
        for (int a = 0; a < 2; ++a)
#pragma unroll
            for (int b = 0; b < 2; ++b)
#pragma unroll
                for (int m = 0; m < 4; ++m)
#pragma unroll
                    for (int n = 0; n < 2; ++n) acc[a][b][m][n] = (f32x4){0.f, 0.f, 0.f, 0.f};
        cur = nxt; cA = nA; cB = nB; ++ui;
        if constexpr (ALIGN_EPI) { if (wr == 1) PG8_BAR; }
    }
    PG8_WAIT_V(0);
    if constexpr (!ALIGN_EPI) { if (wr == 0) PG8_BAR; }
    PG8_BAR;
    if constexpr (Epi::AFTER_DRAIN) { E.fused(acc, cur, wr, wc, fr, fq, lds, wid, lane); S.done(cur); }
#undef PG8_SA
#undef PG8_SB
#undef PG8_STAGE
#undef PG8_RSRC
#undef PG8_R64
#undef PG8_LDA
#undef PG8_LDB
#undef PG8_MMA
#undef PG8_CAT8
#undef PG8_WAIT_V
#undef PG8_WAIT_L
#undef PG8_BAR
#undef PG8_SCHED
}
}
#ifndef PG8_SP2
#define PG8_SP2 true
#endif
#ifndef PG8_ALIGN
#define PG8_ALIGN true
#endif

constexpr int NWAVES = 8, NTHR = 512;
constexpr int D = 1024, NB = 2, T = 8192, M = NB * T;
constexpr int SSD_H = 24, SSD_P = 64, SSD_IN = 1536, SSD_G = 4, SSD_N = 128, XBC = 2560, INCOLS = 6960, NIN_PAD = 7168;
constexpr int S5_W = 768, S5_G = 48, S5_P = 64, S5_K = 16;
constexpr int NE = 16, FF = 2816, CAP = 1024, MROWS = NE * NB * CAP;
constexpr float LN_EPS = 1e-5f, RMS_EPS = 1e-5f;
constexpr float ALPHA = 1.189207115002721f;
constexpr float W1_SCALE = 32.f, W2_SCALE = 64.f, HID_SCALE = 4.f;

constexpr size_t MiB = 1u << 20;
constexpr size_t WS_CTL = 0, CTL_ZERO_BYTES = 64 * 1024;
constexpr size_t WS_WIN = 1 * MiB, WS_WOUT = 15 * MiB, WS_WGLU = 18 * MiB, WS_WO = 21 * MiB, WS_W1 = 23 * MiB, WS_W2 = 199 * MiB, WS_ACT = 287 * MiB;
constexpr size_t A_XB = WS_ACT + 0 * MiB;
constexpr size_t A_BN = WS_ACT + 0 * MiB;
constexpr size_t A_CN = WS_ACT + 16 * MiB;
constexpr size_t A_Z = WS_ACT + 32 * MiB;
constexpr size_t A_XBC = WS_ACT + 80 * MiB;
constexpr size_t A_S = WS_ACT + 80 * MiB;
constexpr size_t A_XT = WS_ACT + 176 * MiB;
constexpr size_t A_BT = WS_ACT + 224 * MiB;
constexpr size_t A_SV = WS_ACT + 340 * MiB;
constexpr size_t A_DT = WS_ACT + 252 * MiB;
constexpr size_t A_TOT = WS_ACT + 255 * MiB;
constexpr size_t A_UC = WS_ACT + 268 * MiB;
constexpr size_t A_Y = WS_ACT + 256 * MiB;
constexpr size_t A_GY = WS_ACT + 224 * MiB;
constexpr size_t A_GT = WS_ACT + 353 * MiB;
constexpr size_t A_YB = WS_ACT + 304 * MiB;
constexpr size_t A_MIX = WS_ACT + 64 * MiB;
constexpr size_t A_HP = WS_ACT + 96 * MiB;
constexpr size_t A_ST = WS_ACT + 0 * MiB;
constexpr size_t A_H8 = WS_ACT + 64 * MiB;
constexpr size_t A_AFF = WS_ACT + 160 * MiB;
constexpr size_t A_IDX = A_AFF + 1 * MiB;
constexpr size_t A_SEL = A_AFF + 2 * MiB;
constexpr size_t A_GATE = A_AFF + 3 * MiB;
constexpr size_t A_XIN = WS_ACT + 164 * MiB;
constexpr size_t A_HID = WS_ACT + 228 * MiB;
constexpr size_t A_YE = WS_ACT + 164 * MiB;
constexpr size_t WS_TV = WS_W2 + 0 * MiB;
constexpr size_t WS_WS5 = WS_W2 + 36 * MiB;
constexpr size_t WS_SLOC = WS_W2 + 48 * MiB;
constexpr size_t WS_AQ = WS_W2 + 72 * MiB;
constexpr size_t WS_END = 704 * MiB;
static_assert(A_HID + 176 * MiB <= WS_END && A_XIN + 64 * MiB <= A_HID && A_YE + 64 * MiB <= A_HID && A_GATE + 1 * MiB <= A_XIN && A_HP + 64 * MiB <= A_AFF && A_H8 + 16 * MiB <= A_HP && A_ST + 1 * MiB <= A_H8, "d_ws map (late phases)");
static_assert(A_GT + 64 * MiB <= WS_END && A_SV + 12 * MiB <= A_GT && A_YB + 32 * MiB <= A_SV && A_UC + 36 * MiB <= A_YB && A_Y + 48 * MiB <= A_YB && A_TOT + 1 * MiB <= A_Y && A_DT + 3 * MiB <= A_TOT && A_GY + 24 * MiB <= A_DT && A_BT + 16 * MiB <= A_DT
              && A_XT + 48 * MiB <= A_BT && A_S + 96 * MiB <= A_XT && A_Z + 48 * MiB <= A_XBC && A_CN + 16 * MiB <= A_Z, "d_ws map (early phases)");
constexpr int CW_LIST = 8192;
constexpr int CW_QW1 = 12288;
constexpr int CW_BAR = 1024;

constexpr int RING_BYTES = 131072;
constexpr int MISC_OFF = RING_BYTES;
constexpr int LDS_BYTES = 147456;

#define GAS __attribute__((address_space(1)))
#define LAS __attribute__((address_space(3)))
typedef unsigned short bf16;
typedef unsigned v4u __attribute__((ext_vector_type(4)));
typedef unsigned v2u __attribute__((ext_vector_type(2)));
typedef float f32x4 __attribute__((ext_vector_type(4)));
#define LDS_WAIT() asm volatile("s_waitcnt lgkmcnt(0)" ::: "memory")
__device__ __forceinline__ unsigned f2bf(float f) { unsigned u = __builtin_bit_cast(unsigned, f); return (u + 0x7fffu + ((u >> 16) & 1u)) >> 16; }
__device__ __forceinline__ unsigned pk2(float lo, float hi) { return pg8::cvt_pk_bf16(lo, hi); }
__device__ __forceinline__ float bflo(unsigned w) { return __uint_as_float(w << 16); }
__device__ __forceinline__ float bfhi(unsigned w) { return __uint_as_float(w & 0xffff0000u); }
__device__ __forceinline__ float wave_sum(float v) {
#pragma unroll
    for (int o = 1; o < 64; o <<= 1) v += __shfl_xor(v, o);
    return v;
}
#define XB_TMO      128
#define XB_XCNT(j)  (256  + 64 * (j))
#define XB_XSUB(j)  (1280 + 64 * (j))
#define XB_XGEN(j)  (2304 + 64 * (j))
#define XB_TOP      3328
#define XB_TOPGEN   3392
#define XCD_BAR_WORDS 3456
#define XB_SPIN_CAP (1u << 18)

__device__ __forceinline__ unsigned xb_ld(unsigned* p)              { return __hip_atomic_load(p, __ATOMIC_RELAXED, __HIP_MEMORY_SCOPE_AGENT); }
__device__ __forceinline__ unsigned xb_add(unsigned* p, unsigned v) { return __hip_atomic_fetch_add(p, v, __ATOMIC_RELAXED, __HIP_MEMORY_SCOPE_AGENT); }
__device__ __forceinline__ unsigned xb_xcc_id() { return (unsigned)__builtin_amdgcn_s_getreg((3 << 11) | 20) & 0xFu; }
#define XB_SPIN(cond, bar) do { unsigned _sp = 0; while (cond) { __builtin_amdgcn_s_sleep(1); \
    if ((++_sp & 255u) == 0u) { if (xb_ld(&(bar)[XB_TMO])) break; if (_sp > XB_SPIN_CAP) { atomicAdd(&(bar)[XB_TMO], 1u); break; } } } } while (0)

struct XcdBarrier {
    unsigned* bar; unsigned x;
    volatile LAS unsigned* st;
};

__device__ __forceinline__ XcdBarrier xcd_barrier_post(unsigned* bar, volatile LAS unsigned* st) {
    XcdBarrier b; b.bar = bar; b.x = xb_xcc_id(); b.st = st;
    if (threadIdx.x == 0) (void)xb_add(&bar[XB_XCNT(b.x)], 1u);
    return b;
}
__device__ __forceinline__ void xcd_barrier_complete(unsigned* bar, unsigned x, unsigned& nloc, unsigned& nx) {
    const unsigned G = gridDim.x * gridDim.y * gridDim.z;
    unsigned sum, cnt, mine, sp = 0u;
    for (;;) {
        sum = 0u; cnt = 0u; mine = 0u;
#pragma unroll
        for (unsigned j = 0; j < 16; ++j) { const unsigned c = xb_ld(&bar[XB_XCNT(j)]); sum += c; cnt += (c > 0u) ? 1u : 0u; mine = (j == x) ? c : mine; }
        if (sum == G) break;
        __builtin_amdgcn_s_sleep(1);
        if ((++sp & 255u) == 0u) { if (xb_ld(&bar[XB_TMO])) break; if (sp > XB_SPIN_CAP) { atomicAdd(&bar[XB_TMO], 1u); break; } }
    }
    nloc = mine > 0u ? mine : 1u; nx = cnt > 0u ? cnt : 1u;
}

__device__ __forceinline__ void xcd_barrier(const XcdBarrier& b, const bool t0  ) {
    asm volatile("s_waitcnt vmcnt(0)" ::: "memory");
    __syncthreads();
    if (t0) {
        unsigned* bar = b.bar;
        __builtin_amdgcn_s_waitcnt(0);
        unsigned nloc = b.st[0], nx = b.st[1];
        if (nloc == 0u) { xcd_barrier_complete(bar, b.x, nloc, nx); b.st[0] = nloc; b.st[1] = nx; }
        const unsigned old = xb_add(&bar[XB_XSUB(b.x)], 1u);
        const unsigned gen = old / nloc;
        if (old + 1u == (gen + 1u) * nloc) {
            __builtin_amdgcn_fence(__ATOMIC_RELEASE, "agent");
            asm volatile("s_waitcnt vmcnt(0)" ::: "memory");
            const unsigned og = xb_add(&bar[XB_TOP], 1u);
            const unsigned tg = og / nx;
            if (og + 1u == (tg + 1u) * nx) xb_add(&bar[XB_TOPGEN], 1u);
            else XB_SPIN(xb_ld(&bar[XB_TOPGEN]) == tg, bar);
            __builtin_amdgcn_fence(__ATOMIC_ACQUIRE, "agent");
            xb_add(&bar[XB_XGEN(b.x)], 1u);
            asm volatile("s_waitcnt vmcnt(0)" ::: "memory");
        } else {
            XB_SPIN(xb_ld(&bar[XB_XGEN(b.x)]) == gen, bar);
            __builtin_amdgcn_fence(__ATOMIC_ACQUIRE, "agent");
            asm volatile("s_waitcnt vmcnt(0)" ::: "memory");
        }
    }
    __syncthreads();
}

struct Frame {
    LAS unsigned char* lds;
    int tid, lane, wave, bid, G;
    LAS unsigned* ptab; float* out; unsigned char* ws;
};
__device__ __forceinline__ const float* inp_(const Frame& F, int k) { const unsigned lo = __builtin_amdgcn_readfirstlane(F.ptab[2 * k]), hi = __builtin_amdgcn_readfirstlane(F.ptab[2 * k + 1]); return (const float*)(((unsigned long long)hi << 32) | lo); }
#define INP(k) inp_(F, k)
__device__ __forceinline__ unsigned lane_now() { unsigned z_ = 0u; asm volatile("" : "+s"(z_)); return __builtin_amdgcn_mbcnt_hi(~0u, __builtin_amdgcn_mbcnt_lo(~0u, z_)); }
#define WSP(T_, off) ((T_*)(F.ws + (off)))

__device__ __forceinline__ unsigned pk4_fp8(float a, float b, float c, float d) { int r_ = __builtin_amdgcn_cvt_pk_fp8_f32(a, b, 0, false); r_ = __builtin_amdgcn_cvt_pk_fp8_f32(c, d, r_, true); return (unsigned)r_; }
__device__ __forceinline__ void tr_load(const float* W, int ldw, int col0, int ncols, int k0, int n0, int lane, f32x4 (&v)[16]) {
    const int kr = lane >> 4, c4 = lane & 15; const bool okc = (n0 + 4 * c4) < ncols;
    const float* src = W + (size_t)(k0 + kr) * ldw + col0 + n0 + 4 * c4;
#pragma unroll
    for (int i = 0; i < 16; ++i) v[i] = okc ? *(const f32x4*)(src + (size_t)(4 * i) * ldw) : (f32x4){0.f, 0.f, 0.f, 0.f};
}
__device__ __forceinline__ void tr_store(const f32x4 (&v)[16], int ncols, int K, bf16* WT, int drow, LAS float* scr, int k0, int n0, int lane, float qs) {
    const int kr = lane >> 4, c4 = lane & 15;
#pragma unroll
    for (int i = 0; i < 16; ++i) { const int k = 4 * i + kr; *(LAS f32x4*)(scr + k * 64 + 4 * (c4 ^ ((k >> 3) & 7))) = v[i]; }
    LDS_WAIT(); asm volatile("" ::: "memory");
    const int nl = lane >> 3, c = lane & 7;
#pragma unroll
    for (int j = 0; j < 8; ++j) { const int n = 8 * j + nl; const LAS float* s = scr + (8 * c) * 64 + 4 * ((n >> 2) ^ c) + (n & 3);
        if (qs != 0.f) { v2u o; o.x = pk4_fp8(s[0 * 64] * qs, s[1 * 64] * qs, s[2 * 64] * qs, s[3 * 64] * qs); o.y = pk4_fp8(s[4 * 64] * qs, s[5 * 64] * qs, s[6 * 64] * qs, s[7 * 64] * qs);
            if (n0 + n < ncols) *(v2u*)((unsigned char*)WT + (size_t)(drow + n) * K + k0 + 8 * c) = o; }
        else { v4u o; o.x = pk2(s[0 * 64], s[1 * 64]); o.y = pk2(s[2 * 64], s[3 * 64]); o.z = pk2(s[4 * 64], s[5 * 64]); o.w = pk2(s[6 * 64], s[7 * 64]);
            if (n0 + n < ncols) *(v4u*)(WT + (size_t)(drow + n) * K + k0 + 8 * c) = o; } }
    LDS_WAIT(); asm volatile("" ::: "memory");
}
__device__ __forceinline__ void tr_item(const float* W, int ldw, int col0, int ncols, int K, bf16* WT, int drow, LAS float* scr, int k0, int n0, int lane, float qs) {
    f32x4 v[16]; tr_load(W, ldw, col0, ncols, k0, n0, lane, v); tr_store(v, ncols, K, WT, drow, scr, k0, n0, lane, qs);
}
struct TrJob { const float* W; int ldw, col0, ncols, K; bf16* WT; int drow0, interleave; float qs; };
__device__ __forceinline__ int tr_job_items(const TrJob& j) { return (j.K / 64) * ((j.ncols + 63) / 64); }
__device__ __forceinline__ void tr_job_item(const TrJob& j, int item, LAS float* scr, int lane) {
    const int nblk = (j.ncols + 63) / 64, kb = item / nblk, nb = item % nblk, n0 = nb * 64;
    const int drow = j.interleave ? j.drow0 + (n0 >> 7) * 256 + (n0 & 127) : j.drow0 + n0;
    tr_item(j.W, j.ldw, j.col0, j.ncols, j.K, j.WT, drow, scr, kb * 64, n0, lane, j.qs);
}
__device__ __forceinline__ void p0_prologue(Frame& F) {
    LAS float* scr = (LAS float*)(F.lds + F.wave * 16384);
    const int gw = F.bid * NWAVES + F.wave, NGW = F.G * NWAVES;
    { const f32x4* x4 = (const f32x4*)INP(0); v4u* o = WSP(v4u, A_XB); const int n8 = M * D / 8;
      const int stride = F.G * NTHR;
      for (int i0 = F.bid * NTHR + F.tid; i0 < n8; i0 += 8 * stride) {
          f32x4 a[8], b[8];
#pragma unroll
          for (int q = 0; q < 8; ++q) { const int i = i0 + q * stride; if (i < n8) { a[q] = x4[2 * i]; b[q] = x4[2 * i + 1]; } }
#pragma unroll
          for (int q = 0; q < 8; ++q) { const int i = i0 + q * stride; if (i < n8) { v4u w; w.x = pk2(a[q].x, a[q].y); w.y = pk2(a[q].z, a[q].w); w.z = pk2(b[q].x, b[q].y); w.w = pk2(b[q].z, b[q].w); o[i] = w; } } } }
    {
        bf16* WIN = WSP(bf16, WS_WIN); bf16* WOUT = WSP(bf16, WS_WOUT); bf16* WGLU = WSP(bf16, WS_WGLU); bf16* WO = WSP(bf16, WS_WO);
        const TrJob jobs[8] = {
            {INP(1), INCOLS, 0, 4096, D, WIN, 0, 0, 0.f}, {INP(1), INCOLS, 4096, 48, D, WIN, 4096, 0, 0.f}, {INP(1), INCOLS, 4144, 768, D, WIN, 4352, 0, 0.f}, {INP(1), INCOLS, 4912, 2048, D, WIN, 5120, 0, 0.f},
            {INP(10), D, 0, D, SSD_IN, WOUT, 0, 0, 0.f}, {INP(22), D, 0, D, S5_W, WGLU, 0, 1, 0.f}, {INP(23), D, 0, D, S5_W, WGLU, 128, 1, 0.f}, {INP(24), D, 0, D, D, WO, 0, 0, 0.f} };
        int base = 0;
#pragma unroll
        for (int q = 0; q < 8; ++q) { const int n = tr_job_items(jobs[q]);
            int it0 = (gw - base) % NGW; if (it0 < 0) it0 += NGW;
            for (int it = it0; it < n; it += NGW) tr_job_item(jobs[q], it, scr, F.lane);
            base += n; }
    }
}
template <int WHICH> __device__ __forceinline__ void expert_convert(Frame& F, int gw, int ngw, unsigned* queue = nullptr, int it_lo = 0, int it_hi = 1 << 30) {
    LAS float* scr = (LAS float*)(F.lds + F.wave * 16384);
    constexpr int IPM = WHICH == 0 ? (D / 64) * (FF / 64) : (FF / 64) * (D / 64);
    constexpr int NIT_ALL = WHICH == 0 ? NE * 2 * IPM : NE * IPM; const int NIT = it_hi < NIT_ALL ? it_hi : NIT_ALL;
    constexpr int NBLK = WHICH == 0 ? FF / 64 : D / 64, LDW = WHICH == 0 ? FF : D, KK = WHICH == 0 ? D : FF; const float qs = WHICH == 0 ? W1_SCALE : W2_SCALE;
    const float* w1 = INP(28); const float* w3 = INP(29); const float* w2 = INP(30);
    unsigned char* W1b = F.ws + WS_W1; unsigned char* W2b = F.ws + WS_W2;
    const int lane = (int)lane_now();
    auto src_of = [&](int it, int& k0, int& n0) -> const float* { const int mtx = it / IPM, r = it % IPM; k0 = (r / NBLK) * 64; n0 = (r % NBLK) * 64;
        if (WHICH == 0) { const int e = mtx >> 1; return ((mtx & 1) ? w3 : w1) + (size_t)e * D * FF; } return w2 + (size_t)mtx * FF * D; };
    const int rfirst = F.bid * 88 + (F.wave < 4 ? F.wave * 9 : 36 + (F.wave - 4) * 13), rend = rfirst + (F.wave < 4 ? 9 : 13);
    auto claim = [&](int prev) -> int { if (!queue) return prev < 0 ? it_lo + gw : prev + ngw;
        const int nx_ = prev < 0 ? rfirst : prev + 1; return nx_ < rend ? nx_ : NIT; };
    auto finish = [&](const f32x4 (&v)[16], int it, int k0, int n0) { const int mtx = it / IPM; bf16* dst; int drow;
        if (WHICH == 0) { dst = (bf16*)(W1b + (size_t)(mtx >> 1) * 2 * FF * D); drow = (mtx & 1) * 128 + (n0 >> 7) * 256 + (n0 & 127); } else { dst = (bf16*)(W2b + (size_t)mtx * D * FF); drow = n0; }
        tr_store(v, LDW, KK, dst, drow, scr, k0, n0, lane, qs); };
    f32x4 va[16], vb[16]; int k0a = 0, n0a = 0, k0b = 0, n0b = 0;
    int ita = claim(-1);
    if (ita < NIT) { const float* sa = src_of(ita, k0a, n0a); tr_load(sa, LDW, 0, LDW, k0a, n0a, lane, va); }
    while (ita < NIT) {
        const int itb = claim(ita);
        if (itb < NIT) { const float* sb = src_of(itb, k0b, n0b); tr_load(sb, LDW, 0, LDW, k0b, n0b, lane, vb); }
        finish(va, ita, k0a, n0a);
        if (itb >= NIT) break;
        ita = claim(itb);
        if (ita < NIT) { const float* sa = src_of(ita, k0a, n0a); tr_load(sa, LDW, 0, LDW, k0a, n0a, lane, va); }
        finish(vb, itb, k0b, n0b);
    }
}
__device__ __forceinline__ void w1_convert(Frame& F, int gw, int ngw, unsigned* queue = nullptr) { expert_convert<0>(F, gw, ngw, queue); }
__device__ __forceinline__ void w2_convert(Frame& F, int gw, int ngw, int it_lo = 0, int it_hi = 1 << 30) { expert_convert<1>(F, gw, ngw, nullptr, it_lo, it_hi); }

__device__ __forceinline__ void cmul(float ar, float ai, float br, float bi, float& cr, float& ci) { cr = ar * br - ai * bi; ci = ar * bi + ai * br; }
__device__ __forceinline__ void s5_precompute_item(Frame& F, int g, int tau) {
    LAS float* PQ = (LAS float*)(F.lds + 72 * 1024);
    LAS float* PW = PQ + 256;
    bf16* TV = WSP(bf16, WS_TV) + (size_t)g * 512 * 768; bf16* WM = WSP(bf16, WS_WS5) + (size_t)g * 256 * 512; float* AQ = WSP(float, WS_AQ);
    const int tid = F.tid;
    __syncthreads();
    { LAS float* dst = PQ + 512; const float* s0 = INP(19) + (size_t)g * 1024; const float* s1 = INP(20) + (size_t)g * 1024; const float* s2 = INP(17) + (size_t)g * 1024; const float* s3 = INP(18) + (size_t)g * 1024;
      dst[tid] = s0[tid]; dst[512 + tid] = s0[512 + tid]; dst[1024 + tid] = s1[tid]; dst[1536 + tid] = s1[512 + tid]; dst[2048 + tid] = s2[tid]; dst[2560 + tid] = s2[512 + tid]; dst[3072 + tid] = s3[tid]; dst[3584 + tid] = s3[512 + tid]; }
    if (tid < 128) {
        const int d = tid >> 6, p = tid & 63;
        const float are = (d ? INP(14) : INP(11))[g * 64 + p], aim = (d ? INP(15) : INP(12))[g * 64 + p], step = __expf((d ? INP(16) : INP(13))[g]);
        const float zr = are * step, zi = aim * step;
        const float er = expf(zr), cs = cosf(zi), sn = sinf(zi), abr = er * cs, abi = er * sn;
        const float sh = sinf(0.5f * zi), dr = expm1f(zr) * cs - 2.f * sh * sh, di = abi;
        const float den = 1.0f / (are * are + aim * aim), qr = (dr * are + di * aim) * den, qi = (di * are - dr * aim) * den;
        float pr = 1.f, pi = 0.f, br = abr, bi = abi;
#pragma unroll
        for (int bit = 0; bit < 6; ++bit) { if ((tau >> bit) & 1) { float tr_, ti_; cmul(pr, pi, br, bi, tr_, ti_); pr = tr_; pi = ti_; } float sr_, si_; cmul(br, bi, br, bi, sr_, si_); br = sr_; bi = si_; }
        float xr, xi; cmul(pr, pi, qr, qi, xr, xi);
        PQ[(d * 64 + p) * 2] = xr; PQ[(d * 64 + p) * 2 + 1] = xi; PW[(d * 64 + p) * 2] = pr; PW[(d * 64 + p) * 2 + 1] = pi;
        if (tau == 32) { AQ[((g * 2 + d) * 64 + p) * 2] = pr; AQ[((g * 2 + d) * 64 + p) * 2 + 1] = pi; }
    }
    __syncthreads();
    LAS float* cre = PQ + 512; LAS float* cim = cre + 1024; LAS float* bre = cim + 1024; LAS float* bim = bre + 1024;
    if (tid < 256 && tau < 32) {
        const int k = tid >> 4, j = tid & 15; float kf = 0.f, kb = 0.f;
        for (int p = 0; p < 64; ++p) { const float cr = cre[k * 64 + p], ci = cim[k * 64 + p], br = bre[p * 16 + j], bi = bim[p * 16 + j];
            float wr_, wi_; cmul(cr, ci, PQ[p * 2], PQ[p * 2 + 1], wr_, wi_); kf += wr_ * br - wi_ * bi;
            cmul(cr, ci, PQ[(64 + p) * 2], PQ[(64 + p) * 2 + 1], wr_, wi_); kb += wr_ * br - wi_ * bi; }
        if (tau == 0) { const bf16 v = (bf16)f2bf(kf + kb); for (int t = 0; t < 32; ++t) TV[(size_t)(t * 16 + k) * 768 + t * 16 + j] = v; }
        else { const bf16 vf = (bf16)f2bf(kf), vb = (bf16)f2bf(kb);
            for (int t = tau; t < 32; ++t) { const int s = t - tau; TV[(size_t)(t * 16 + k) * 768 + s * 16 + j] = vf; TV[(size_t)(s * 16 + k) * 768 + t * 16 + j] = vb; } }
    }
    if (tid >= 256) {
        const int q = tid - 256;
        if (tau >= 1) {
#pragma unroll 1
            for (int i = 0; i < 8; ++i) { const int e = q * 8 + i, d = e >> 10, k = (e >> 6) & 15, p = e & 63;
                float vr, vi; cmul(cre[k * 64 + p], cim[k * 64 + p], PW[(d * 64 + p) * 2], PW[(d * 64 + p) * 2 + 1], vr, vi);
                const int t = d ? 32 - tau : tau - 1; bf16* row = TV + (size_t)(t * 16 + k) * 768 + 512 + d * 128;
                row[p] = (bf16)f2bf(vr); row[64 + p] = (bf16)f2bf(-vi); } }
        if (tau < 32) {
#pragma unroll 1
            for (int i = 0; i < 8; ++i) { const int e = q * 8 + i, d = e >> 10, p = (e >> 4) & 63, j = e & 15;
                float vr, vi; cmul(PQ[(d * 64 + p) * 2], PQ[(d * 64 + p) * 2 + 1], bre[p * 16 + j], bim[p * 16 + j], vr, vi);
                const int s = d ? tau : 31 - tau; bf16* col = WM + (size_t)(d * 128 + p) * 512 + s * 16 + j;
                col[0] = (bf16)f2bf(vr); col[(size_t)64 * 512] = (bf16)f2bf(vi); } }
    }
}
__device__ __forceinline__ void s5_pre_wave(Frame& F, int g, int tau) {
    const int lane = (int)lane_now();
    LAS float* cre = (LAS float*)(F.lds + F.wave * 16384); LAS float* cim = cre + 1024; LAS float* bre = cim + 1024; LAS float* bim = bre + 1024;
    bf16* TV = WSP(bf16, WS_TV) + (size_t)g * 512 * 768; bf16* WM = WSP(bf16, WS_WS5) + (size_t)g * 256 * 512; float* AQ = WSP(float, WS_AQ);
    LDS_WAIT(); asm volatile("" ::: "memory");
    { const f32x4* s0 = (const f32x4*)(INP(19) + (size_t)g * 1024); const f32x4* s1 = (const f32x4*)(INP(20) + (size_t)g * 1024); const f32x4* s2 = (const f32x4*)(INP(17) + (size_t)g * 1024); const f32x4* s3 = (const f32x4*)(INP(18) + (size_t)g * 1024);
#pragma unroll
      for (int q = 0; q < 4; ++q) { const int i = q * 64 + lane; *(LAS f32x4*)(cre + 4 * i) = s0[i]; *(LAS f32x4*)(cim + 4 * i) = s1[i]; *(LAS f32x4*)(bre + 4 * i) = s2[i]; *(LAS f32x4*)(bim + 4 * i) = s3[i]; } }
    float Pr[2], Pi[2], Qr[2], Qi[2];
#pragma unroll
    for (int d = 0; d < 2; ++d) {
        const float are = (d ? INP(14) : INP(11))[g * 64 + lane], aim = (d ? INP(15) : INP(12))[g * 64 + lane], step = __expf((d ? INP(16) : INP(13))[g]);
        const float zr = are * step, zi = aim * step;
        const float er = expf(zr), cs = cosf(zi), sn = sinf(zi), abr = er * cs, abi = er * sn;
        const float sh = sinf(0.5f * zi), dr = expm1f(zr) * cs - 2.f * sh * sh, di = abi;
        const float den = 1.0f / (are * are + aim * aim), qr = (dr * are + di * aim) * den, qi = (di * are - dr * aim) * den;
        float pr = 1.f, pi = 0.f, br = abr, bi = abi;
#pragma unroll
        for (int bit = 0; bit < 6; ++bit) { if ((tau >> bit) & 1) { float tr_, ti_; cmul(pr, pi, br, bi, tr_, ti_); pr = tr_; pi = ti_; } float sr_, si_; cmul(br, bi, br, bi, sr_, si_); br = sr_; bi = si_; }
        Pr[d] = pr; Pi[d] = pi; cmul(pr, pi, qr, qi, Qr[d], Qi[d]);
        if (tau == 32) { AQ[((g * 2 + d) * 64 + lane) * 2] = pr; AQ[((g * 2 + d) * 64 + lane) * 2 + 1] = pi; }
    }
    LDS_WAIT(); asm volatile("" ::: "memory");
    if (tau < 32) {
        const int k = lane >> 2, j4 = (lane & 3) * 4; float kf[4] = {0.f, 0.f, 0.f, 0.f}, kb[4] = {0.f, 0.f, 0.f, 0.f};
#pragma unroll 4
        for (int p = 0; p < 64; ++p) { const float cr = cre[k * 64 + p], ci = cim[k * 64 + p]; const f32x4 br4 = *(const LAS f32x4*)(bre + p * 16 + j4), bi4 = *(const LAS f32x4*)(bim + p * 16 + j4);
            const float fr_ = __shfl(Qr[0], p), fi_ = __shfl(Qi[0], p), gr_ = __shfl(Qr[1], p), gi_ = __shfl(Qi[1], p);
            float wr_, wi_; cmul(cr, ci, fr_, fi_, wr_, wi_);
#pragma unroll
            for (int i = 0; i < 4; ++i) kf[i] += wr_ * br4[i] - wi_ * bi4[i];
            cmul(cr, ci, gr_, gi_, wr_, wi_);
#pragma unroll
            for (int i = 0; i < 4; ++i) kb[i] += wr_ * br4[i] - wi_ * bi4[i]; }
        if (tau == 0) { v2u v; v.x = pk2(kf[0] + kb[0], kf[1] + kb[1]); v.y = pk2(kf[2] + kb[2], kf[3] + kb[3]); for (int t = 0; t < 32; ++t) *(v2u*)(TV + (size_t)(t * 16 + k) * 768 + t * 16 + j4) = v; }
        else { v2u vf, vb; vf.x = pk2(kf[0], kf[1]); vf.y = pk2(kf[2], kf[3]); vb.x = pk2(kb[0], kb[1]); vb.y = pk2(kb[2], kb[3]);
            for (int t = tau; t < 32; ++t) { const int s = t - tau; *(v2u*)(TV + (size_t)(t * 16 + k) * 768 + s * 16 + j4) = vf; *(v2u*)(TV + (size_t)(s * 16 + k) * 768 + t * 16 + j4) = vb; } }
    }
    if (tau >= 1) {
#pragma unroll
        for (int d = 0; d < 2; ++d) { const int t = d ? 32 - tau : tau - 1;
#pragma unroll 4
            for (int k = 0; k < 16; ++k) { float vr, vi; cmul(cre[k * 64 + lane], cim[k * 64 + lane], Pr[d], Pi[d], vr, vi);
                bf16* row = TV + (size_t)(t * 16 + k) * 768 + 512 + d * 128; row[lane] = (bf16)f2bf(vr); row[64 + lane] = (bf16)f2bf(-vi); } }
    }
    if (tau < 32) {
        const int j = lane & 15;
#pragma unroll
        for (int d = 0; d < 2; ++d) { const int s = d ? tau : 31 - tau;
#pragma unroll 4
            for (int ps = 0; ps < 16; ++ps) { const int p = 4 * ps + (lane >> 4); const float xr = __shfl(Qr[d], p), xi = __shfl(Qi[d], p);
                float vr, vi; cmul(xr, xi, bre[p * 16 + j], bim[p * 16 + j], vr, vi);
                bf16* col = WM + (size_t)(d * 128 + p) * 512 + s * 16 + j; col[0] = (bf16)f2bf(vr); col[(size_t)64 * 512] = (bf16)f2bf(vi); } }
    }
    LDS_WAIT(); asm volatile("" ::: "memory");
}
__device__ __forceinline__ void p0_s5(Frame& F) { if (F.wave < 4) for (int it = F.bid * 4 + F.wave; it < S5_G * 33; it += F.G * 4) s5_pre_wave(F, it / 33, it % 33); }

__device__ __forceinline__ void s5_scan_item(Frame& F, int item) {
    const int d = item & 1, b = (item >> 1) & 1, g = item >> 2, tid = F.tid;
    LAS float* S = (LAS float*)F.lds;
    const float* SL = WSP(float, WS_SLOC) + ((size_t)(g * 512 + b * 256) * 256 + d * 128);
    __syncthreads();
    {   f32x4 v[16];
#pragma unroll
        for (int q = 0; q < 16; ++q) { const int i = q * NTHR + tid, ci = i >> 5, c4 = (i & 31) * 4; v[q] = *(const f32x4*)(SL + (size_t)ci * 256 + c4); }
#pragma unroll
        for (int q = 0; q < 16; ++q) { const int i = q * NTHR + tid, ci = i >> 5, c4 = (i & 31) * 4; *(LAS f32x4*)(S + ci * 128 + c4) = v[q]; } }
    __syncthreads();
    if (tid < 64) {
        const float* AQ = WSP(float, WS_AQ); const float qr = AQ[((g * 2 + d) * 64 + tid) * 2], qi = AQ[((g * 2 + d) * 64 + tid) * 2 + 1];
        float sr = 0.f, si = 0.f;
#pragma unroll 1
        for (int n0 = 0; n0 < 256; n0 += 16) {
            float tr_[16], ti_[16];
#pragma unroll
            for (int k = 0; k < 16; ++k) { const int ci = d ? 255 - (n0 + k) : n0 + k; tr_[k] = S[ci * 128 + tid]; ti_[k] = S[ci * 128 + 64 + tid]; }
#pragma unroll
            for (int k = 0; k < 16; ++k) { const int ci = d ? 255 - (n0 + k) : n0 + k; S[ci * 128 + tid] = sr; S[ci * 128 + 64 + tid] = si;
                const float nr = qr * sr - qi * si + tr_[k], ni = qr * si + qi * sr + ti_[k]; sr = nr; si = ni; }
        }
    }
    __syncthreads();
    bf16* UC = WSP(bf16, A_UC) + ((size_t)(g * 512 + b * 256) * 768 + 512 + d * 128);
#pragma unroll
    for (int q = 0; q < 8; ++q) { const int i = q * NTHR + tid, ci = i >> 4, c8 = (i & 15) * 8; const LAS float* s = S + ci * 128 + c8;
        v4u o; o.x = pk2(s[0], s[1]); o.y = pk2(s[2], s[3]); o.z = pk2(s[4], s[5]); o.w = pk2(s[6], s[7]);
        *(v4u*)(UC + (size_t)ci * 768 + c8) = o; }
}
__device__ __forceinline__ void unpack8(const v4u w, float (&f)[8]) { f[0] = bflo(w.x); f[1] = bfhi(w.x); f[2] = bflo(w.y); f[3] = bfhi(w.y); f[4] = bflo(w.z); f[5] = bfhi(w.z); f[6] = bflo(w.w); f[7] = bfhi(w.w); }
__device__ __forceinline__ void p2_conv(Frame& F) {
    const bf16* xbc = WSP(bf16, A_XBC); bf16* XT = WSP(bf16, A_XT); bf16* BT = WSP(bf16, A_BT); bf16* BN = WSP(bf16, A_BN); bf16* CN = WSP(bf16, A_CN);
    const float* cw = INP(2); const float* cb = INP(3);
    constexpr int RUN = 16, NCG = XBC / 8, NITEM = (M / RUN) * NCG;
    const int s5lo = (F.G == 256) ? 160 : F.G, NA = (F.G == 256) ? 196608 : 0;
    for (int pass = 0; pass < 2; ++pass)
    for (int item = pass == 0 ? (F.bid < s5lo ? F.bid * NTHR + F.tid : NITEM) : NA + F.bid * NTHR + F.tid; item < (pass == 0 ? NA : NITEM); item += (pass == 0 ? s5lo : F.G) * NTHR) {
        const int cg = item % NCG, r = item / NCG, ch = cg * 8, m0 = r * RUN, tb = m0 % T, bc = m0 >> 7, s0 = m0 & 127;
        float w[5][8], bias[8];
#pragma unroll
        for (int k = 0; k < 5; ++k) { const f32x4 a = *(const f32x4*)(cw + k * XBC + ch), b = *(const f32x4*)(cw + k * XBC + ch + 4); w[k][0] = a.x; w[k][1] = a.y; w[k][2] = a.z; w[k][3] = a.w; w[k][4] = b.x; w[k][5] = b.y; w[k][6] = b.z; w[k][7] = b.w; }
        { const f32x4 a = *(const f32x4*)(cb + ch), b = *(const f32x4*)(cb + ch + 4); bias[0] = a.x; bias[1] = a.y; bias[2] = a.z; bias[3] = a.w; bias[4] = b.x; bias[5] = b.y; bias[6] = b.z; bias[7] = b.w; }
        bf16* nat = nullptr; bf16* trn = nullptr; int trn_stride = 64 * 8;
        int trn_cstride = 8;
        if (ch < SSD_IN) { trn = XT + (size_t)(bc * SSD_H + (ch >> 6)) * 8192 + ((s0 >> 3) * 64 + ((ch & 63) >> 3)) * 8; trn_cstride = 64; }
        else if (ch < SSD_IN + 512) { const int cc = ch - SSD_IN; nat = BN + (size_t)m0 * 512 + cc; trn = BT + (size_t)(bc * SSD_G + (cc >> 7)) * 16384 + ((s0 >> 3) * 128 + (cc & 127)) * 8; trn_stride = 128 * 8; }
        else { nat = CN + (size_t)m0 * 512 + (ch - SSD_IN - 512); }
        v4u rows[RUN + 4];
        const bf16* src = xbc + (size_t)m0 * XBC + ch;
#pragma unroll
        for (int q = 0; q < RUN + 4; ++q) { const int tt = tb - 2 + q; const bool ok = tt >= 0 && tt < T; const int qq = ok ? q - 2 : 0; const v4u v = *(const v4u*)(src + (ptrdiff_t)qq * XBC);
            rows[q].x = ok ? v.x : 0u; rows[q].y = ok ? v.y : 0u; rows[q].z = ok ? v.z : 0u; rows[q].w = ok ? v.w : 0u; }
#pragma unroll
        for (int i8 = 0; i8 < RUN / 8; ++i8) {
            float o[8][8];
#pragma unroll
            for (int ii = 0; ii < 8; ++ii) { const int i = i8 * 8 + ii;
#pragma unroll
                for (int j = 0; j < 8; ++j) o[ii][j] = bias[j];
#pragma unroll
                for (int k = 0; k < 5; ++k) { float f[8]; unpack8(rows[i + k], f);
#pragma unroll
                    for (int j = 0; j < 8; ++j) o[ii][j] += w[k][j] * f[j]; }
#pragma unroll
                for (int j = 0; j < 8; ++j) o[ii][j] = o[ii][j] * __builtin_amdgcn_rcpf(1.0f + __expf(-o[ii][j]));
                if (nat) { v4u q; q.x = pk2(o[ii][0], o[ii][1]); q.y = pk2(o[ii][2], o[ii][3]); q.z = pk2(o[ii][4], o[ii][5]); q.w = pk2(o[ii][6], o[ii][7]); *(v4u*)(nat + (size_t)i * 512) = q; } }
            if (trn) {
#pragma unroll
                for (int j = 0; j < 8; ++j) { v4u q; q.x = pk2(o[0][j], o[1][j]); q.y = pk2(o[2][j], o[3][j]); q.z = pk2(o[4][j], o[5][j]); q.w = pk2(o[6][j], o[7][j]); *(v4u*)(trn + (size_t)i8 * trn_stride + j * trn_cstride) = q; } }
        }
    }
    {
        const int gw = F.bid * NWAVES + F.wave, NGW = F.G * NWAVES, lane = F.lane;
        const float* DT = WSP(float, A_DT); float* SV = WSP(float, A_SV); float* TOT = WSP(float, A_TOT);
        for (int it = gw; it < 128 * SSD_H * 2; it += NGW) {
            const int d = it & 1, h = (it >> 1) % SSD_H, bc = it / (2 * SSD_H);
            const float a = -__expf((d ? INP(5) : INP(4))[h]);
            const size_t mb = (size_t)bc * 128;
            const float dt0 = DT[(mb + 2 * lane) * 48 + d * 24 + h], dt1 = DT[(mb + 2 * lane + 1) * 48 + d * 24 + h];
            const float x0 = dt0 * a, x1 = dt1 * a, ps = x0 + x1;
            float inc = ps;
#pragma unroll
            for (int o = 1; o < 64; o <<= 1) { const float t_ = __shfl_up(inc, o); if (lane >= o) inc += t_; }
            const float total = __shfl(inc, 63), exc = inc - ps;
            const float ci0 = exc + x0, ci1 = inc;
            float cs0, cs1, w0, w1, f0, f1;
            if (d == 0) { cs0 = ci0; cs1 = ci1; w0 = dt0 * __expf(total - ci0); w1 = dt1 * __expf(total - ci1); f0 = __expf(ci0); f1 = __expf(ci1); }
            else { cs0 = exc; cs1 = ci0; w0 = dt0 * __expf(cs0); w1 = dt1 * __expf(cs1); f0 = __expf(total - cs0); f1 = __expf(total - cs1); }
            float* sv = SV + (size_t)it * 4 * 128 + 2 * lane;
            typedef float f32x2 __attribute__((ext_vector_type(2)));
            *(f32x2*)(sv) = (f32x2){w0, w1}; *(f32x2*)(sv + 128) = (f32x2){cs0, cs1}; *(f32x2*)(sv + 256) = (f32x2){dt0, dt1}; *(f32x2*)(sv + 384) = (f32x2){f0, f1};
            if (lane == 0) TOT[it] = __expf(total);
        }
    }
}

typedef short bf16x8 __attribute__((ext_vector_type(8)));
typedef float f32x16 __attribute__((ext_vector_type(16)));
__device__ __forceinline__ unsigned cvtpk(float lo, float hi) { return pg8::cvt_pk_bf16(lo, hi); }
__device__ __forceinline__ void ssd_state_item(Frame& F, int item) {
    unsigned z_ = 0u; asm volatile("" : "+s"(z_)); int lane = (int)__builtin_amdgcn_mbcnt_hi(~0u, __builtin_amdgcn_mbcnt_lo(~0u, z_)); asm volatile("" : "+v"(lane));
    const int nt = item & 3, u = item >> 2, h = u % SSD_H, bc = u / SSD_H, g = h / 6, b = bc >> 6, c = bc & 63, l31 = lane & 31, hf = lane >> 5;
    const bf16* XT = WSP(bf16, A_XT) + (size_t)u * 8192 + l31 * 8; const bf16* BT = WSP(bf16, A_BT) + (size_t)(bc * SSD_G + g) * 16384 + (nt * 32 + l31) * 8;
    const float* SV = WSP(float, A_SV); bf16* S = WSP(bf16, A_S);
    LAS float* wl = (LAS float*)(F.lds + F.wave * 1024);
    LDS_WAIT(); asm volatile("" ::: "memory");
#pragma unroll
    for (int d = 0; d < 2; ++d) { const float* sv = SV + (size_t)(u * 2 + d) * 4 * 128; wl[d * 128 + lane] = sv[lane]; wl[d * 128 + 64 + lane] = sv[64 + lane]; }
    LDS_WAIT(); asm volatile("" ::: "memory");
    f32x16 acc[2][2];
#pragma unroll
    for (int d = 0; d < 2; ++d)
#pragma unroll
        for (int pt = 0; pt < 2; ++pt)
#pragma unroll
            for (int r = 0; r < 16; ++r) acc[d][pt][r] = 0.f;
#pragma unroll
    for (int ks = 0; ks < 8; ++ks) {
        const int sb = ks * 16 + 8 * hf, q = 2 * ks + hf;
        const v4u a = *(const v4u*)(BT + q * 1024);
        const bf16x8 b0 = *(const bf16x8*)(XT + q * 512), b1 = *(const bf16x8*)(XT + q * 512 + 256);
        float af[8]; unpack8(a, af);
#pragma unroll
        for (int d = 0; d < 2; ++d) {
            const f32x4 w0 = *(const LAS f32x4*)(wl + d * 128 + sb), w1 = *(const LAS f32x4*)(wl + d * 128 + sb + 4);
            v4u aw; aw.x = cvtpk(af[0] * w0.x, af[1] * w0.y); aw.y = cvtpk(af[2] * w0.z, af[3] * w0.w); aw.z = cvtpk(af[4] * w1.x, af[5] * w1.y); aw.w = cvtpk(af[6] * w1.z, af[7] * w1.w);
            const bf16x8 av = __builtin_bit_cast(bf16x8, aw);
            acc[d][0] = __builtin_amdgcn_mfma_f32_32x32x16_bf16(av, b0, acc[d][0], 0, 0, 0);
            acc[d][1] = __builtin_amdgcn_mfma_f32_32x32x16_bf16(av, b1, acc[d][1], 0, 0, 0);
        }
    }
#pragma unroll
    for (int d = 0; d < 2; ++d) { bf16* So = S + ((size_t)((b * SSD_H + h) * 2 + d) * 64 + c) * 8192 + nt * 2048 + lane * 4;
#pragma unroll
        for (int pt = 0; pt < 2; ++pt)
#pragma unroll
            for (int q = 0; q < 4; ++q) { v2u o; o.x = cvtpk(acc[d][pt][4 * q], acc[d][pt][4 * q + 1]); o.y = cvtpk(acc[d][pt][4 * q + 2], acc[d][pt][4 * q + 3]);
                *(v2u*)(So + (pt * 4 + q) * 256) = o; } }
}
__device__ __forceinline__ void ssd_scan(Frame& F, int tg, int ntg, int item_lo, int item_hi) {
    bf16* S = WSP(bf16, A_S); const float* TOT = WSP(float, A_TOT);
    for (int item = item_lo + tg; item < item_hi; item += ntg) {
        const int e8 = item & 1023, bhd = item >> 10, d = bhd & 1, h = (bhd >> 1) % SSD_H, b = bhd / (2 * SSD_H);
        bf16* base = S + (size_t)bhd * 64 * 8192 + e8 * 8;
        float H[8];
#pragma unroll
        for (int j = 0; j < 8; ++j) H[j] = 0.f;
#pragma unroll 1
        for (int n0 = 0; n0 < 64; n0 += 16) {
            v4u v[16]; float dec[16];
#pragma unroll
            for (int k = 0; k < 16; ++k) { const int c = d ? 63 - (n0 + k) : n0 + k; v[k] = *(const v4u*)(base + (size_t)c * 8192); dec[k] = TOT[((b * 64 + c) * SSD_H + h) * 2 + d]; }
#pragma unroll
            for (int k = 0; k < 16; ++k) { const int c = d ? 63 - (n0 + k) : n0 + k; float f[8]; unpack8(v[k], f);
                v4u o; o.x = cvtpk(H[0], H[1]); o.y = cvtpk(H[2], H[3]); o.z = cvtpk(H[4], H[5]); o.w = cvtpk(H[6], H[7]);
                *(v4u*)(base + (size_t)c * 8192) = o;
#pragma unroll
                for (int j = 0; j < 8; ++j) H[j] = H[j] * dec[k] + f[j]; }
        }
    }
}
constexpr int PC_SVL_BYTES = 24576, PC_MAT_BYTES = 64 * 272;
__device__ __forceinline__ void pc_prefetch(v4u (&pre)[12], const bf16* XT, const bf16* S, int bc, int b, int c, int g, int i3, int tid) {
#pragma unroll
    for (int q = 0; q < 12; ++q) { const int mtx = q >> 1, hh = mtx / 3, t = mtx % 3, h = g * 6 + hh * 3 + i3, idx = (q & 1) * 512 + tid;
        const bf16* src = (t == 0) ? XT + (size_t)(bc * SSD_H + h) * 8192 + idx * 8 : S + ((size_t)((b * SSD_H + h) * 2 + (t - 1)) * 64 + c) * 8192 + idx * 8;
        pre[q] = *(const v4u*)src; }
}
__device__ __forceinline__ void ssd_out_unit(Frame& F, int unit) {
    unsigned z_ = 0u; asm volatile("" : "+s"(z_)); int lane = (int)__builtin_amdgcn_mbcnt_hi(~0u, __builtin_amdgcn_mbcnt_lo(~0u, z_)); asm volatile("" : "+v"(lane));
    int tid = F.wave * 64 + lane; asm volatile("" : "+v"(tid));
    const int g = unit & 3, bc = unit >> 2, b = bc >> 6, c = bc & 63, l31 = lane & 31, hf = lane >> 5, j = F.wave & 3, hh = F.wave >> 2;
    const size_t mb = (size_t)bc * 128;
    const bf16* CN = WSP(bf16, A_CN) + (mb + 32 * j + l31) * 512 + g * 128 + 8 * hf;
    const bf16* BN = WSP(bf16, A_BN) + (mb + l31) * 512 + g * 128 + 8 * hf;
    const float* SV = WSP(float, A_SV); const bf16* S = WSP(bf16, A_S); const bf16* XT = WSP(bf16, A_XT); bf16* Y = WSP(bf16, A_Y);
    LAS float* svl = (LAS float*)F.lds + hh * 3072;
    LAS unsigned char* mats = F.lds + PC_SVL_BYTES;
    asm volatile("" : "+v"(CN), "+v"(BN));
    __syncthreads();
    {   const f32x4* src = (const f32x4*)(SV + (size_t)((bc * SSD_H + g * 6) * 2) * 512) + tid;
#pragma unroll
        for (int q = 0; q < 3; ++q) *(LAS f32x4*)((LAS float*)F.lds + (q * 512 + tid) * 4) = src[q * 512]; }
    v4u pre[12];
    pc_prefetch(pre, XT, S, bc, b, c, g, 0, tid);
    unsigned cbp[4][8];
    {
        LAS unsigned char* tb = mats; LAS unsigned char* tc = mats + 128 * 272;
        { const bf16* bsrc = WSP(bf16, A_BN) + mb * 512 + g * 128; const bf16* csrc = WSP(bf16, A_CN) + mb * 512 + g * 128; v4u vb_[4], vc_[4];
#pragma unroll
          for (int q = 0; q < 4; ++q) { const int idx = q * 512 + tid, row = idx >> 4, ch = idx & 15; vb_[q] = *(const v4u*)(bsrc + (size_t)row * 512 + ch * 8); vc_[q] = *(const v4u*)(csrc + (size_t)row * 512 + ch * 8); }
#pragma unroll
          for (int q = 0; q < 4; ++q) { const int idx = q * 512 + tid, row = idx >> 4, ch = idx & 15; *(LAS v4u*)(tb + row * 272 + ch * 16) = vb_[q]; *(LAS v4u*)(tc + row * 272 + ch * 16) = vc_[q]; } }
        __syncthreads();
        bf16x8 cfr[8];
#pragma unroll
        for (int ks = 0; ks < 8; ++ks) cfr[ks] = *(const LAS bf16x8*)(tc + (32 * j + l31) * 272 + ks * 32 + hf * 16);
#pragma unroll
        for (int i = 0; i < 4; ++i) { f32x16 t_;
#pragma unroll
            for (int r = 0; r < 16; ++r) t_[r] = 0.f;
#pragma unroll
            for (int ks = 0; ks < 8; ++ks) { const bf16x8 a = *(const LAS bf16x8*)(tb + (32 * i + l31) * 272 + ks * 32 + hf * 16); t_ = __builtin_amdgcn_mfma_f32_32x32x16_bf16(a, cfr[ks], t_, 0, 0, 0); }
#pragma unroll
            for (int r = 0; r < 8; ++r) cbp[i][r] = cvtpk(t_[2 * r], t_[2 * r + 1]);
        }
    }
#define CBT(i_, r_) (((r_) & 1) ? bfhi(cbp[i_][(r_) >> 1]) : bflo(cbp[i_][(r_) >> 1]))
#pragma unroll 1
    for (int i3 = 0; i3 < 3; ++i3) {
        const int h = g * 6 + hh * 3 + i3;
        { int l_ = lane, t_ = tid; asm volatile("" : "+v"(l_), "+v"(t_)); lane = l_; tid = t_; }
        const int l31 = lane & 31, hf = lane >> 5, tl = 32 * j + l31;
        __syncthreads();
#pragma unroll
        for (int q = 0; q < 12; ++q) { const int mtx = q >> 1, idx = (q & 1) * 512 + tid; LAS unsigned char* mt = mats + mtx * PC_MAT_BYTES;
            if ((mtx % 3) == 0) { const int pos = idx & 63, row = (pos & 7) * 8 + (pos >> 3), ch = idx >> 6; *(LAS v4u*)(mt + row * 272 + ch * 16) = pre[q]; }
            else { const int blk = idx >> 5, c_ = idx & 31, nt_ = blk >> 3, pt_ = (blk >> 2) & 1, q_ = blk & 3, hf_ = c_ >> 4, la = (2 * c_) & 31;
                const int pa = 32 * pt_ + la, pb = pa + 1, ra = (pa & 7) * 8 + (pa >> 3), rb = (pb & 7) * 8 + (pb >> 3), cb = (32 * nt_ + 8 * q_ + 4 * hf_) * 2;
                v2u lo_; lo_.x = pre[q].x; lo_.y = pre[q].y; v2u hi_; hi_.x = pre[q].z; hi_.y = pre[q].w;
                *(LAS v2u*)(mt + ra * 272 + cb) = lo_; *(LAS v2u*)(mt + rb * 272 + cb) = hi_; } }
        __syncthreads();
        const LAS float* vf = svl + (i3 * 2 + 0) * 512 + 128; const LAS float* vb = svl + (i3 * 2 + 1) * 512 + 128;
        const float csf_t = vf[tl], sf_t = vf[256 + tl], ecsb_t = vb[tl], sb_t = vb[256 + tl], Dh = INP(8)[h];
        int tlv = tl - 4 * hf; asm volatile("" : "+v"(tlv));
        const LAS unsigned char* mx = mats + (hh * 3 + 0) * PC_MAT_BYTES + l31 * 272 + hf * 8;
        const LAS unsigned char* mf = mats + (hh * 3 + 1) * PC_MAT_BYTES + l31 * 272 + hf * 16;
        const LAS unsigned char* mbk = mats + (hh * 3 + 2) * PC_MAT_BYTES + l31 * 272 + hf * 16;
        f32x16 acc[2];
        {
            const bf16* cn = CN; asm volatile("" : "+v"(cn));
            bf16x8 cfr[8];
#pragma unroll
            for (int ks = 0; ks < 8; ++ks) cfr[ks] = *(const bf16x8*)(cn + ks * 16);
#pragma unroll
            for (int pt = 0; pt < 2; ++pt) { f32x16 af;
#pragma unroll
                for (int r = 0; r < 16; ++r) af[r] = 0.f;
#pragma unroll
                for (int ks = 0; ks < 8; ++ks) { const bf16x8 a0 = *(const LAS bf16x8*)(mf + pt * 32 * 272 + ks * 32); af = __builtin_amdgcn_mfma_f32_32x32x16_bf16(a0, cfr[ks], af, 0, 0, 0); }
#pragma unroll
                for (int r = 0; r < 16; ++r) acc[pt][r] = af[r] * sf_t;
#pragma unroll
                for (int r = 0; r < 16; ++r) af[r] = 0.f;
#pragma unroll
                for (int ks = 0; ks < 8; ++ks) { const bf16x8 a1 = *(const LAS bf16x8*)(mbk + pt * 32 * 272 + ks * 32); af = __builtin_amdgcn_mfma_f32_32x32x16_bf16(a1, cfr[ks], af, 0, 0, 0); }
#pragma unroll
                for (int r = 0; r < 16; ++r) acc[pt][r] += af[r] * sb_t; }
        }
        asm volatile("" ::: "memory");
        if (i3 < 2) pc_prefetch(pre, XT, S, bc, b, c, g, i3 + 1, tid);
#pragma unroll
        for (int i = 0; i < 4; ++i) {
#pragma unroll
            for (int k2 = 0; k2 < 2; ++k2) {
                const int sA = 32 * i + 16 * k2 + 4 * hf;
                float mv[8];
                if (i < j) {
                    const f32x4 c0 = *(const LAS f32x4*)(vf + sA), c1 = *(const LAS f32x4*)(vf + sA + 8), d0 = *(const LAS f32x4*)(vf + 128 + sA), d1 = *(const LAS f32x4*)(vf + 128 + sA + 8);
#pragma unroll
                    for (int e = 0; e < 4; ++e) { mv[e] = CBT(i, 8 * k2 + e) * (d0[e] * __expf(csf_t - c0[e])); mv[4 + e] = CBT(i, 8 * k2 + 4 + e) * (d1[e] * __expf(csf_t - c1[e])); }
                } else if (i > j) {
                    const f32x4 c0 = *(const LAS f32x4*)(vb + sA), c1 = *(const LAS f32x4*)(vb + sA + 8), d0 = *(const LAS f32x4*)(vb + 128 + sA), d1 = *(const LAS f32x4*)(vb + 128 + sA + 8);
#pragma unroll
                    for (int e = 0; e < 4; ++e) { mv[e] = CBT(i, 8 * k2 + e) * (d0[e] * __expf(c0[e] - ecsb_t)); mv[4 + e] = CBT(i, 8 * k2 + 4 + e) * (d1[e] * __expf(c1[e] - ecsb_t)); }
                } else {
                    const f32x4 c0 = *(const LAS f32x4*)(vf + sA), c1 = *(const LAS f32x4*)(vf + sA + 8), d0 = *(const LAS f32x4*)(vf + 128 + sA), d1 = *(const LAS f32x4*)(vf + 128 + sA + 8);
                    const f32x4 g0 = *(const LAS f32x4*)(vb + sA), g1 = *(const LAS f32x4*)(vb + sA + 8), h0 = *(const LAS f32x4*)(vb + 128 + sA), h1 = *(const LAS f32x4*)(vb + 128 + sA + 8);
#pragma unroll
                    for (int e = 0; e < 8; ++e) { const int s_ = 32 * i + 16 * k2 + (e & 3) + 8 * (e >> 2); const float cf = e < 4 ? c0[e & 3] : c1[e & 3], df = e < 4 ? d0[e & 3] : d1[e & 3], cb_ = e < 4 ? g0[e & 3] : g1[e & 3], db = e < 4 ? h0[e & 3] : h1[e & 3];
                        float f = 0.f;
                        f += (s_ <= tlv) ? df * __expf(fminf(csf_t - cf, 0.f)) : 0.f;
                        f += (s_ >= tlv) ? db * __expf(fminf(cb_ - ecsb_t, 0.f)) : 0.f;
                        mv[e] = CBT(i, 8 * k2 + e) * f + ((s_ == tlv) ? Dh : 0.f); }
                }
                v4u mw; mw.x = cvtpk(mv[0], mv[1]); mw.y = cvtpk(mv[2], mv[3]); mw.z = cvtpk(mv[4], mv[5]); mw.w = cvtpk(mv[6], mv[7]);
                const bf16x8 mfr = __builtin_bit_cast(bf16x8, mw);
#pragma unroll
                for (int pt = 0; pt < 2; ++pt) { const v2u x0 = *(const LAS v2u*)(mx + pt * 32 * 272 + 64 * i + 32 * k2), x1 = *(const LAS v2u*)(mx + pt * 32 * 272 + 64 * i + 32 * k2 + 16);
                    v4u xw; xw.x = x0.x; xw.y = x0.y; xw.z = x1.x; xw.w = x1.y;
                    acc[pt] = __builtin_amdgcn_mfma_f32_32x32x16_bf16(__builtin_bit_cast(bf16x8, xw), mfr, acc[pt], 0, 0, 0); }
                asm volatile("" ::: "memory");
            }
        }
        bf16* yo = Y + (mb + tl) * SSD_IN + h * 64 + 4 * hf;
        asm volatile("" : "+v"(yo));
#pragma unroll
        for (int pt = 0; pt < 2; ++pt)
#pragma unroll
            for (int q = 0; q < 4; ++q) { v2u o; o.x = cvtpk(acc[pt][4 * q], acc[pt][4 * q + 1]); o.y = cvtpk(acc[pt][4 * q + 2], acc[pt][4 * q + 3]); *(v2u*)(yo + 32 * pt + 8 * q) = o; }
    }
}

#undef CBT
__device__ __forceinline__ void ssd_norm_unit(Frame& F, int unit) {
    const int g = unit & 3, bc = unit >> 2; const int lane = (int)lane_now(), tq = lane >> 4, j16 = lane & 15;
    const size_t rowbase = ((size_t)bc * 128 + F.wave * 16 + tq) * SSD_IN + g * 384 + j16 * 8;
    bf16* Y = WSP(bf16, A_Y) + rowbase; const bf16* Z = WSP(bf16, A_Z) + rowbase; const float* ng = INP(9) + g * 384 + j16 * 8;
    v4u yv[12], zv[12];
#pragma unroll
    for (int r = 0; r < 4; ++r)
#pragma unroll
        for (int i = 0; i < 3; ++i) zv[r * 3 + i] = *(const v4u*)(Z + (size_t)(4 * r) * SSD_IN + 128 * i);
    asm volatile("s_waitcnt vmcnt(0)" ::: "memory"); __syncthreads();
#pragma unroll
    for (int r = 0; r < 4; ++r)
#pragma unroll
        for (int i = 0; i < 3; ++i) yv[r * 3 + i] = *(const v4u*)(Y + (size_t)(4 * r) * SSD_IN + 128 * i);
    f32x4 g0[3], g1[3];
#pragma unroll
    for (int i = 0; i < 3; ++i) { g0[i] = *(const f32x4*)(ng + 128 * i); g1[i] = *(const f32x4*)(ng + 128 * i + 4); }
#pragma unroll
    for (int r = 0; r < 4; ++r) { float ss = 0.f;
#pragma unroll
        for (int i = 0; i < 3; ++i) { float a[8], z[8]; unpack8(yv[r * 3 + i], a); unpack8(zv[r * 3 + i], z);
#pragma unroll
            for (int jj = 0; jj < 8; ++jj) { a[jj] *= z[jj]; ss += a[jj] * a[jj]; }
            yv[r * 3 + i].x = pk2(a[0], a[1]); yv[r * 3 + i].y = pk2(a[2], a[3]); yv[r * 3 + i].z = pk2(a[4], a[5]); yv[r * 3 + i].w = pk2(a[6], a[7]); }
        ss += __shfl_xor(ss, 1); ss += __shfl_xor(ss, 2); ss += __shfl_xor(ss, 4); ss += __shfl_xor(ss, 8);
        const float rn = 1.0f / sqrtf(ss * (1.0f / 384.0f) + RMS_EPS);
#pragma unroll
        for (int i = 0; i < 3; ++i) { float a[8]; unpack8(yv[r * 3 + i], a);
            v4u o; o.x = pk2(a[0] * rn * g0[i].x, a[1] * rn * g0[i].y); o.y = pk2(a[2] * rn * g0[i].z, a[3] * rn * g0[i].w); o.z = pk2(a[4] * rn * g1[i].x, a[5] * rn * g1[i].y); o.w = pk2(a[6] * rn * g1[i].z, a[7] * rn * g1[i].w);
            *(v4u*)(Y + (size_t)(4 * r) * SSD_IN + 128 * i) = o; } }
}

__device__ __forceinline__ void p8_ln_router(Frame& F) {
    const int gw = F.bid * NWAVES + F.wave, NGW = F.G * NWAVES, lane = F.lane;
    LAS float* wr = (LAS float*)F.lds;
    for (int i = F.tid; i < D * NE; i += NTHR) wr[(i & 15) * D + (i >> 4)] = INP(27)[i];
    __syncthreads();
    const float* HP = WSP(float, A_HP); float* ST = WSP(float, A_ST); unsigned char* H8 = F.ws + A_H8; float* AFF = WSP(float, A_AFF);
    const float* g1 = INP(25); const float* b1 = INP(26);
    f32x4 nx[4];
#pragma unroll
    for (int j = 0; j < 4; ++j) nx[j] = *((const f32x4*)(HP + (size_t)(gw < M ? gw : 0) * D) + lane + 64 * j);
    for (int m = gw; m < M; m += NGW) {
        f32x4 v[4]; float s = 0.f;
#pragma unroll
        for (int j = 0; j < 4; ++j) { v[j] = nx[j]; s += (v[j].x + v[j].y) + (v[j].z + v[j].w); }
        { const int mn = (m + NGW < M) ? m + NGW : m;
#pragma unroll
          for (int j = 0; j < 4; ++j) nx[j] = *((const f32x4*)(HP + (size_t)mn * D) + lane + 64 * j); }
        const float mean = wave_sum(s) * (1.f / D); float s2 = 0.f;
#pragma unroll
        for (int j = 0; j < 4; ++j) { v[j] = v[j] - mean; s2 += (v[j].x * v[j].x + v[j].y * v[j].y) + (v[j].z * v[j].z + v[j].w * v[j].w); }
        const float rstd = 1.f / sqrtf(wave_sum(s2) * (1.f / D) + LN_EPS);
        if (lane == 0) { typedef float f32x2_ __attribute__((ext_vector_type(2))); *(f32x2_*)(ST + 2 * (size_t)m) = (f32x2_){mean, rstd}; }
        float lg[16];
#pragma unroll
        for (int e = 0; e < 16; ++e) lg[e] = 0.f;
#pragma unroll
        for (int j = 0; j < 4; ++j) { const int c = 4 * lane + 256 * j; const f32x4 gg = *(const f32x4*)(g1 + c), bb = *(const f32x4*)(b1 + c);
            v[j] = v[j] * rstd * gg + bb;
            *((unsigned*)(H8 + (size_t)m * D) + lane + 64 * j) = pk4_fp8(v[j].x, v[j].y, v[j].z, v[j].w);
#pragma unroll
            for (int e = 0; e < 16; ++e) { const f32x4 w4 = *(const LAS f32x4*)(wr + e * D + c); lg[e] += (v[j].x * w4.x + v[j].y * w4.y) + (v[j].z * w4.z + v[j].w * w4.w); }
            asm volatile("" ::: "memory"); }
        { const bool hi = lane & 32;
#pragma unroll
          for (int k = 0; k < 8; ++k) { const float keep = hi ? lg[k + 8] : lg[k], send = hi ? lg[k] : lg[k + 8]; lg[k] = keep + __shfl_xor(send, 32); } }
        { const bool hi = lane & 16;
#pragma unroll
          for (int k = 0; k < 4; ++k) { const float keep = hi ? lg[k + 4] : lg[k], send = hi ? lg[k] : lg[k + 4]; lg[k] = keep + __shfl_xor(send, 16); } }
        { const bool hi = lane & 8;
#pragma unroll
          for (int k = 0; k < 2; ++k) { const float keep = hi ? lg[k + 2] : lg[k], send = hi ? lg[k] : lg[k + 2]; lg[k] = keep + __shfl_xor(send, 8); } }
        { const bool hi = lane & 4; const float keep = hi ? lg[1] : lg[0], send = hi ? lg[0] : lg[1]; lg[0] = keep + __shfl_xor(send, 4); }
        float lo = lg[0]; lo += __shfl_xor(lo, 2); lo += __shfl_xor(lo, 1);
        float mx = lo;
#pragma unroll
        for (int o = 4; o < 64; o <<= 1) mx = fmaxf(mx, __shfl_xor(mx, o));
        const float ex = expf(lo - mx); float sum = ex;
#pragma unroll
        for (int o = 4; o < 64; o <<= 1) sum += __shfl_xor(sum, o);
        if ((lane & 3) == 0) { const int e = lane >> 2, b = m / T, t = m % T; AFF[((size_t)b * NE + e) * T + t] = ex / sum; }
    }
}

__device__ __forceinline__ unsigned block_excl_scan(unsigned v, LAS unsigned* wsum  , int lane, int wave, unsigned& total) {
    unsigned inc = v;
#pragma unroll
    for (int o = 1; o < 64; o <<= 1) { const unsigned t = __shfl_up(inc, o); if (lane >= o) inc += t; }
    __syncthreads();
    if (lane == 63) wsum[wave] = inc;
    __syncthreads();
    unsigned off = 0, tot = 0;
#pragma unroll
    for (int w = 0; w < 8; ++w) { const unsigned s = wsum[w]; if (w < wave) off += s; tot += s; }
    total = tot; return off + inc - v;
}
__device__ __forceinline__ void p9_topk(Frame& F, int be) {
    const int b = be >> 4, e = be & 15, tid = F.tid;
    const float* av = WSP(float, A_AFF) + (size_t)be * T;
    int* IDX = WSP(int, A_IDX); int* SEL = WSP(int, A_SEL); float* GATE = WSP(float, A_GATE);
    LAS unsigned* hist = (LAS unsigned*)F.lds; LAS unsigned* shv = hist + 256; LAS unsigned* wsum = hist + 272;
    unsigned key[16];
#pragma unroll
    for (int q = 0; q < 4; ++q) { const v4u k4 = *(const v4u*)(av + tid * 16 + 4 * q); key[4 * q] = k4.x; key[4 * q + 1] = k4.y; key[4 * q + 2] = k4.z; key[4 * q + 3] = k4.w; }
    unsigned lo = 0u, hi_ex = 0u;
    bool hi_set = false;
    for (int it = 0; it < 32; ++it) {
        const unsigned span = (hi_set ? hi_ex : 0u) - lo;
        const unsigned mid = lo + (span >> 1) + ((span == 0u && !hi_set) ? 0x80000000u : 0u);
        unsigned cnt = 0;
#pragma unroll
        for (int i = 0; i < 16; ++i) cnt += (unsigned)__builtin_popcountll(__ballot(key[i] >= mid));
        LAS unsigned* slot_ = wsum + 16 + (it & 1) * 8;
        if (F.lane == 0) slot_[F.wave] = cnt;
        __syncthreads();
        unsigned tot = 0;
#pragma unroll
        for (int w = 0; w < 8; ++w) tot += slot_[w];
        if (tot >= (unsigned)CAP) lo = mid; else { hi_ex = mid; hi_set = true; }
    }
    const unsigned Tk = lo;
    unsigned krem;
    { unsigned cnt = 0;
#pragma unroll
      for (int i = 0; i < 16; ++i) cnt += (unsigned)__builtin_popcountll(__ballot(key[i] > Tk));
      __syncthreads(); if (F.lane == 0) wsum[16 + F.wave] = cnt; __syncthreads();
      unsigned tot = 0;
#pragma unroll
      for (int w = 0; w < 8; ++w) tot += wsum[16 + w];
      krem = (unsigned)CAP - tot; __syncthreads(); }
    unsigned cg = 0, ce = 0;
#pragma unroll
    for (int i = 0; i < 16; ++i) { cg += key[i] > Tk; ce += key[i] == Tk; }
    unsigned totg, tote;
    unsigned pg = block_excl_scan(cg, wsum, F.lane, F.wave, totg);
    unsigned pe = block_excl_scan(ce, wsum + 8, F.lane, F.wave, tote);
#pragma unroll
    for (int i = 0; i < 16; ++i) {
        const int t = tid * 16 + i; int slot = -1;
        if (key[i] > Tk) slot = (int)(pg++);
        else if (key[i] == Tk) { if (pe < krem) slot = (int)(totg + pe); ++pe; }
        const size_t m = (size_t)b * T + t;
        SEL[m * NE + e] = slot; GATE[m * NE + e] = __uint_as_float(key[i]);
        if (slot >= 0) IDX[(e * NB + b) * CAP + slot] = (int)m;
    }
    __builtin_amdgcn_fence(__ATOMIC_RELEASE, "agent"); asm volatile("s_waitcnt vmcnt(0)" ::: "memory"); __syncthreads();
    if (tid == 0) __hip_atomic_store((unsigned*)(F.ws + WS_CTL) + CW_LIST + 64 * be, 1u, __ATOMIC_RELAXED, __HIP_MEMORY_SCOPE_AGENT);
}
__device__ __forceinline__ void gather_rows_after(Frame& F, int r0, int nrows) {
    const int li = r0 >> 10, e = li >> 1, b = li & 1, be = b * 16 + e;
    if (F.wave == 0) { unsigned* flag = (unsigned*)(F.ws + WS_CTL) + CW_LIST + 64 * be; unsigned spins = 0;
        while (__builtin_amdgcn_readfirstlane(__hip_atomic_load(flag, __ATOMIC_RELAXED, __HIP_MEMORY_SCOPE_AGENT)) == 0u) { __builtin_amdgcn_s_sleep(2); if (++spins > (1u << 22)) break; }
        __builtin_amdgcn_fence(__ATOMIC_ACQUIRE, "agent"); asm volatile("s_waitcnt vmcnt(0)" ::: "memory"); }
    __syncthreads();
    const int* IDX = WSP(int, A_IDX); const unsigned char* H8 = F.ws + A_H8; unsigned char* XIN = F.ws + A_XIN; const int lane = F.lane;
    for (int rr = F.wave; rr < nrows; rr += 8 * NWAVES) {
        v4u va[8];
#pragma unroll
        for (int q = 0; q < 8; ++q) { const int ri = rr + q * NWAVES < nrows ? rr + q * NWAVES : rr; const int m_ = IDX[r0 + ri]; va[q] = *((const v4u*)(H8 + (size_t)m_ * D) + lane); }
#pragma unroll
        for (int q = 0; q < 8; ++q) if (rr + q * NWAVES < nrows) *((v4u*)(XIN + (size_t)(r0 + rr + q * NWAVES) * D) + lane) = va[q];
    }
}
__device__ __forceinline__ void moe_accumulate(f32x4 (&v)[4], int sl, float gt, int b, const bf16* YE, int lane) {
    unsigned mask = (unsigned)(__ballot(sl >= 0) & 0xffffull);
    while (mask) {
        int e[4]; float gv[4]; const bf16* yr[4];
#pragma unroll
        for (int k = 0; k < 4; ++k) { const bool ok = mask != 0u; const int ek = ok ? __builtin_ctz(mask) : e[k > 0 ? k - 1 : 0]; if (ok) mask &= mask - 1u; e[k] = ek;
            const int s = __shfl(sl, ek); gv[k] = ok ? __shfl(gt, ek) : 0.f; yr[k] = YE + ((size_t)(ek * NB + b) * CAP + (s < 0 ? 0 : s)) * D; }
        v2u w[4][4];
#pragma unroll
        for (int k = 0; k < 4; ++k)
#pragma unroll
            for (int j = 0; j < 4; ++j) w[k][j] = *((const v2u*)yr[k] + lane + 64 * j);
#pragma unroll
        for (int k = 0; k < 4; ++k)
#pragma unroll
            for (int j = 0; j < 4; ++j) { v[j].x += gv[k] * bflo(w[k][j].x); v[j].y += gv[k] * bfhi(w[k][j].x); v[j].z += gv[k] * bflo(w[k][j].y); v[j].w += gv[k] * bfhi(w[k][j].y); }
    }
}
__device__ __forceinline__ void ln_row_store(f32x4 (&v)[4], const float* g2, const float* b2, float* orow, int lane) {
    float s = 0.f;
#pragma unroll
    for (int j = 0; j < 4; ++j) s += (v[j].x + v[j].y) + (v[j].z + v[j].w);
    const float mean = wave_sum(s) * (1.f / D); float s2 = 0.f;
#pragma unroll
    for (int j = 0; j < 4; ++j) { v[j] = v[j] - mean; s2 += (v[j].x * v[j].x + v[j].y * v[j].y) + (v[j].z * v[j].z + v[j].w * v[j].w); }
    const float rstd = 1.f / sqrtf(wave_sum(s2) * (1.f / D) + LN_EPS);
#pragma unroll
    for (int j = 0; j < 4; ++j) { const int c = 4 * lane + 256 * j; const f32x4 gg = *(const f32x4*)(g2 + c), bb = *(const f32x4*)(b2 + c);
        *((f32x4*)orow + lane + 64 * j) = v[j] * rstd * gg + bb; }
}
__device__ __forceinline__ void p13_final(Frame& F) {
    const int gw = F.bid * NWAVES + F.wave, NGW = F.G * NWAVES, lane = F.lane;
    const float* HP = WSP(float, A_HP); const float* ST = WSP(float, A_ST); const float* g1 = INP(25); const float* b1 = INP(26); const int* SEL = WSP(int, A_SEL); const float* GATE = WSP(float, A_GATE); const bf16* YE = WSP(bf16, A_YE);
    const float* g2 = INP(31); const float* b2 = INP(32);
    for (int m = gw; m < M; m += 2 * NGW) {
        const int mB = (m + NGW < M) ? m + NGW : m;
        const int slA = SEL[(size_t)m * NE + (lane & 15)], slB = SEL[(size_t)mB * NE + (lane & 15)]; const float gtA = GATE[(size_t)m * NE + (lane & 15)], gtB = GATE[(size_t)mB * NE + (lane & 15)];
        typedef float f32x2_ __attribute__((ext_vector_type(2))); const f32x2_ stA = *(const f32x2_*)(ST + 2 * (size_t)m), stB = *(const f32x2_*)(ST + 2 * (size_t)mB);
        f32x4 vA[4], vB[4];
#pragma unroll
        for (int j = 0; j < 4; ++j) { const int c = 4 * lane + 256 * j; const f32x4 gg = *(const f32x4*)(g1 + c) * ALPHA, bb = *(const f32x4*)(b1 + c) * ALPHA;
            vA[j] = (*((const f32x4*)(HP + (size_t)m * D) + lane + 64 * j) - stA.x) * stA.y * gg + bb; vB[j] = (*((const f32x4*)(HP + (size_t)mB * D) + lane + 64 * j) - stB.x) * stB.y * gg + bb; }
        moe_accumulate(vA, slA, gtA, m / T, YE, lane); moe_accumulate(vB, slB, gtB, mB / T, YE, lane);
        ln_row_store(vA, g2, b2, F.out + (size_t)m * D, lane);
        if (mB != m) ln_row_store(vB, g2, b2, F.out + (size_t)mB * D, lane);
    }
}

constexpr int N_PHASES = 16;
struct Args { const float* in[33]; float* out; unsigned char* ws; int ph_lo, ph_hi; };
__global__ void __launch_bounds__(NTHR, 2) fwd(Args args) {
    extern __shared__ __attribute__((aligned(16))) unsigned char lds[];
    Frame F;
    F.lds = (LAS unsigned char*)lds;
    F.tid = threadIdx.x; F.lane = F.tid & 63; F.wave = __builtin_amdgcn_readfirstlane(F.tid >> 6);
    F.bid = blockIdx.x; F.G = gridDim.x;
    F.ptab = (LAS unsigned*)(F.lds + MISC_OFF + 512);
    if (F.tid < 33) { const unsigned long long p_ = (unsigned long long)args.in[F.tid]; F.ptab[2 * F.tid] = (unsigned)p_; F.ptab[2 * F.tid + 1] = (unsigned)(p_ >> 32); }
    F.out = args.out; F.ws = args.ws;
    volatile LAS unsigned* MISC = (volatile LAS unsigned*)(F.lds + MISC_OFF);
    if (F.tid < 64) MISC[F.tid] = 0u;
    __syncthreads();
    const int lo = args.ph_lo, hi = args.ph_hi;
    const bool single = (hi - lo) > 1;
    XcdBarrier bar; bar.bar = (unsigned*)(F.ws + WS_CTL) + CW_BAR; bar.x = 0; bar.st = nullptr;
    if (single) bar = xcd_barrier_post((unsigned*)(F.ws + WS_CTL) + CW_BAR, MISC + 8);
#ifndef PH_MASK
#define PH_MASK 0xffff
#endif
#define IN(k) (((PH_MASK >> (k)) & 1) && lo <= (k) && (k) < hi)
#define LAUNDER1(T_, p_) do { unsigned long long x_ = (unsigned long long)(p_); unsigned lo_ = (unsigned)x_, hi_ = (unsigned)(x_ >> 32); asm volatile("" : "+v"(lo_), "+v"(hi_)); \
        lo_ = __builtin_amdgcn_readfirstlane(lo_); hi_ = __builtin_amdgcn_readfirstlane(hi_); (p_) = (T_)(((unsigned long long)hi_ << 32) | lo_); } while (0)
#define LAUNDER() do { F.lane = (int)lane_now(); F.tid = F.wave * 64 + F.lane; } while (0)
#define SEAM(k) do { if (IN(k) && IN((k) + 1)) xcd_barrier(bar, T0()); } while (0)

#define T0() (F.wave == 0 && lane_now() == 0u)

    if (IN(0)) { LAUNDER(); p0_s5(F); p0_prologue(F); w1_convert(F, F.bid * NWAVES + F.wave, F.G * NWAVES, F.G == 256 ? (unsigned*)(F.ws + WS_CTL) + CW_QW1 : nullptr); } SEAM(0);
    if (IN(1)) { LAUNDER();
        pg8::Gemm g{WSP(pg8::bf16_t, A_XB), WSP(pg8::bf16_t, WS_WIN), M, NIN_PAD, D, D, D}; pg8::StaticOrder S; S.init(M, NIN_PAD, F.G, F.bid);
        pg8::EpiIn E{WSP(pg8::bf16_t, A_Z), WSP(pg8::bf16_t, A_XBC), WSP(pg8::bf16_t, A_UC), WSP(pg8::bf16_t, A_GT), WSP(float, A_DT), INP(6), INP(7)};
        pg8::gemm_phase<pg8::EpiIn, pg8::StaticOrder, PG8_ALIGN, PG8_SP2>(F.lds, g, S, E, F.tid);
    } SEAM(1);
    if (IN(2)) { LAUNDER();

        if (F.bid >= 160) { pg8::Gemm g{WSP(pg8::bf16_t, A_UC), WSP(pg8::bf16_t, WS_WS5), S5_G * 512, S5_G * 256, 512, 768, 512}; pg8::S5aOrder S{F.bid, 160};
            pg8::EpiS5a E{WSP(float, WS_SLOC)};
            pg8::gemm_phase<pg8::EpiS5a, pg8::S5aOrder, PG8_ALIGN, PG8_SP2>(F.lds, g, S, E, F.tid); __syncthreads(); }

        p2_conv(F);
        __syncthreads();
    } SEAM(2);
    if (IN(3)) { LAUNDER();
        for (int it = F.bid; it < S5_G * 4; it += F.G) s5_scan_item(F, it);
        __syncthreads();
        for (int it = F.bid * NWAVES + F.wave; it < 128 * SSD_H * 4; it += F.G * NWAVES) ssd_state_item(F, it);
    } SEAM(3);
    if (IN(4)) { LAUNDER();
        { pg8::Gemm g{WSP(pg8::bf16_t, A_UC), WSP(pg8::bf16_t, WS_TV), S5_G * 512, S5_G * 512, 768, 768, 768}; pg8::S5cOrder S{F.G, F.bid};
          pg8::EpiS5c E{WSP(pg8::bf16_t, A_GY), WSP(pg8::bf16_t, A_UC), INP(21)};
          pg8::gemm_phase<pg8::EpiS5c, pg8::S5cOrder, PG8_ALIGN, PG8_SP2>(F.lds, g, S, E, F.tid); }

        if (F.G == 256) { if (F.bid >= 192) ssd_scan(F, (F.bid - 192) * NTHR + F.tid, 64 * NTHR, 0, 65536); else if (F.bid < 64) ssd_scan(F, F.bid * NTHR + F.tid, 64 * NTHR, 65536, 96 * 1024); }
        else ssd_scan(F, F.bid * NTHR + F.tid, F.G * NTHR, 0, 96 * 1024);
    } SEAM(4);
    if (IN(5)) { LAUNDER(); __syncthreads();
        for (int u = F.bid; u < 128 * SSD_G; u += F.G) { ssd_out_unit(F, u); ssd_norm_unit(F, u); }
        __syncthreads();
        { pg8::Gemm g{WSP(pg8::bf16_t, A_GY), WSP(pg8::bf16_t, WS_WGLU), M, 2 * D, S5_W, S5_W, S5_W}; pg8::StaticOrder S; S.init(M, 2 * D, F.G, F.bid);
          pg8::EpiGlu E{WSP(pg8::bf16_t, A_YB), WSP(pg8::bf16_t, A_GT)};
          pg8::gemm_phase<pg8::EpiGlu, pg8::StaticOrder, PG8_ALIGN, PG8_SP2>(F.lds, g, S, E, F.tid); }
    } SEAM(5);
    if (IN(7)) { LAUNDER();
        pg8::Gemm g{WSP(pg8::bf16_t, A_Y), WSP(pg8::bf16_t, WS_WOUT), M, D, SSD_IN, SSD_IN, SSD_IN}; pg8::StaticOrder S; S.init(M, D, F.G, F.bid);
        pg8::EpiSsdOut E{WSP(pg8::bf16_t, A_MIX), WSP(pg8::bf16_t, A_YB), WSP(pg8::bf16_t, A_GT)};
        pg8::gemm_phase<pg8::EpiSsdOut, pg8::StaticOrder, PG8_ALIGN, PG8_SP2>(F.lds, g, S, E, F.tid);
    } SEAM(7);
    if (IN(9)) { LAUNDER();
        pg8::Gemm g{WSP(pg8::bf16_t, A_MIX), WSP(pg8::bf16_t, WS_WO), M, D, D, D, D}; pg8::StaticOrder S; S.init(M, D, F.G, F.bid);
        pg8::EpiWo E{WSP(float, A_HP), INP(0), ALPHA};
        pg8::gemm_phase<pg8::EpiWo, pg8::StaticOrder, PG8_ALIGN, PG8_SP2>(F.lds, g, S, E, F.tid);
    } SEAM(9);
    if (IN(10)) { LAUNDER(); p8_ln_router(F); } SEAM(10);
    if (IN(11)) { LAUNDER();
        if (F.bid < NB * NE) { p9_topk(F, F.bid); __syncthreads(); w2_convert(F, F.bid * NWAVES + F.wave, NB * NE * NWAVES, 0, 1280); }
        else w2_convert(F, (F.bid - NB * NE) * NWAVES + F.wave, (F.G - NB * NE) * NWAVES, 1280);
        __syncthreads();
        for (int r0 = F.bid * (MROWS / 256); r0 < MROWS; r0 += F.G * (MROWS / 256)) gather_rows_after(F, r0, MROWS / 256); __syncthreads(); } SEAM(11);

    if (IN(13)) { LAUNDER();
        pg8::Gemm g{WSP(pg8::bf16_t, A_XIN), WSP(pg8::bf16_t, WS_W1), MROWS, NE * 2 * FF, D, D, D}; pg8::MoeOrder1 S{F.G, F.bid};
        pg8::EpiMoe1 E{F.ws + A_HID, 1.0f / W1_SCALE, HID_SCALE};
        pg8::gemm_phase<pg8::EpiMoe1, pg8::MoeOrder1, PG8_ALIGN, PG8_SP2, true>(F.lds, g, S, E, F.tid);
    } SEAM(13);
    if (IN(14)) { LAUNDER();
        pg8::Gemm g{WSP(pg8::bf16_t, A_HID), WSP(pg8::bf16_t, WS_W2), MROWS, NE * D, FF, FF, FF}; pg8::MoeOrder2 S{F.G, F.bid};
        pg8::EpiMoe2 E{WSP(pg8::bf16_t, A_YE), 1.0f / (W2_SCALE * HID_SCALE)};
        pg8::gemm_phase<pg8::EpiMoe2, pg8::MoeOrder2, PG8_ALIGN, PG8_SP2, true>(F.lds, g, S, E, F.tid);
    } SEAM(14);
    if (IN(15)) { LAUNDER(); p13_final(F); }
#undef IN
#undef SEAM
}

#ifndef MK_ONE_LAUNCH
#define MK_ONE_LAUNCH 1
#endif
extern "C" void kernel_launch(void* const* d_in, const int* in_sizes, int n_in, void* d_out, int out_size, void* d_ws, size_t ws_size, hipStream_t stream) {
    static int grid = 0;
    if (grid == 0) {
        if (n_in != 33 || in_sizes[0] != M * D || out_size != M * D || ws_size < WS_END) { fprintf(stderr, "kernel_launch: unexpected problem (n_in %d, in0 %d, out %d, ws %zu < %zu)\n", n_in, n_in > 0 ? in_sizes[0] : -1, out_size, ws_size, (size_t)WS_END); grid = -1; return; }
        int dev = 0, cus = 0, per_cu = 0;
        if (hipGetDevice(&dev) != hipSuccess || hipDeviceGetAttribute(&cus, hipDeviceAttributeMultiprocessorCount, dev) != hipSuccess) { grid = -1; return; }
        if (hipFuncSetAttribute((const void*)fwd, hipFuncAttributeMaxDynamicSharedMemorySize, LDS_BYTES) != hipSuccess) { fprintf(stderr, "kernel_launch: hipFuncSetAttribute failed\n"); grid = -1; return; }
        if (hipOccupancyMaxActiveBlocksPerMultiprocessor(&per_cu, (const void*)fwd, NTHR, LDS_BYTES) != hipSuccess || per_cu < 1) fprintf(stderr, "kernel_launch: occupancy query reports %d blocks per CU\n", per_cu);
        (void)hipGetLastError();
        grid = cus;
    }
    if (grid < 0) return;
    (void)hipMemsetAsync((char*)d_ws + WS_CTL, 0, CTL_ZERO_BYTES, stream);
    Args a{};
    for (int i = 0; i < 33; ++i) a.in[i] = (const float*)d_in[i];
    a.out = (float*)d_out; a.ws = (unsigned char*)d_ws;
#if MK_ONE_LAUNCH
    a.ph_lo = 0; a.ph_hi = N_PHASES;
    hipLaunchKernelGGL(fwd, dim3(grid), dim3(NTHR), LDS_BYTES, stream, a);
#else
    for (int p = 0; p < N_PHASES; ++p) { a.ph_lo = p; a.ph_hi = p + 1; hipLaunchKernelGGL(fwd, dim3(grid), dim3(NTHR), LDS_BYTES, stream, a); }
#endif
}
```

```cpp
#include <hip/hip_runtime.h>
#include <cstdio>
#include <cstdint>
namespace pg8 {
#define PG8_LAS __attribute__((address_space(3)))
typedef unsigned short bf16_t;
typedef short bf16x8 __attribute__((ext_vector_type(8)));
typedef float f32x4 __attribute__((ext_vector_type(4)));
typedef unsigned u32x4 __attribute__((ext_vector_type(4)));
typedef int i32x8 __attribute__((ext_vector_type(8)));
constexpr int BM = 256, BK = 64, HALF = 128, HTB = HALF * BK * 2  , STAGE_BYTES = 8 * HTB, NXCD = 8, WGM = 8;

__host__ __device__ __forceinline__ int lds_byte(int r, int c) { const int st = (r >> 4) * 2 + (c >> 5), rr = r & 15, cc = c & 31, ob = rr * 64 + cc * 2; return st * 1024 + (ob ^ (((ob >> 9) & 1) << 5)); }
__host__ __device__ __forceinline__ void stage_rc(int b, int& R, int& C) { const int st = b / 1024, sb = b % 1024, swz = sb ^ (((sb >> 9) & 1) << 5); R = (st >> 1) * 16 + swz / 64; C = (st & 1) * 32 + (swz % 64) / 2; }
__host__ __device__ __forceinline__ int perm32(int rho) { const int n = rho >> 4, i = rho & 15; return 8 * (i >> 2) + 4 * n + (i & 3); }

struct Unit { int pm, pn; };
struct Gemm { const bf16_t* A; const bf16_t* Bt; int M, N, K, lda, ldb; };

struct StaticOrder {
    int nM, nN, nwg, G, c;
    __host__ __device__ void init(int M, int N, int G_, int c_) { nM = M / BM; nN = N / BM; nwg = nM * nN; G = G_; c = c_; }
    __host__ __device__ bool next(int i, Unit& u) const {
        const long L = (long)i * G + c; if (L >= nwg) return false;
        int wgid = (int)L; { const int q = nwg / NXCD, r = nwg % NXCD, xcd = wgid % NXCD, off = wgid / NXCD; wgid = (xcd < r ? xcd * (q + 1) : r * (q + 1) + (xcd - r) * q) + off; }
        const int nig = WGM * nN, gid = wgid / nig, fm = gid * WGM, gsz = (nM - fm) < WGM ? (nM - fm) : WGM;
        u.pm = fm + ((wgid % nig) % gsz); u.pn = (wgid % nig) / gsz; return true;
    }
    __device__ __forceinline__ void a_ready(const Unit&) const {}
    __device__ __forceinline__ void done(const Unit&) const {}
};

typedef __bf16 bf16v2_t __attribute__((ext_vector_type(2)));
typedef float f32v2_t __attribute__((ext_vector_type(2)));
__device__ __forceinline__ unsigned cvt_pk_bf16(float lo, float hi) { const f32v2_t f = {lo, hi}; return __builtin_bit_cast(unsigned, __builtin_convertvector(f, bf16v2_t)); }
typedef float f32x2 __attribute__((ext_vector_type(2)));
__device__ __forceinline__ f32x2 gelu_pk(f32x2 v) {
    const f32x2 av = __builtin_elementwise_abs(v), d = av * 0.2316418882f + 1.0f;
    f32x2 t; t.x = __builtin_amdgcn_rcpf(d.x); t.y = __builtin_amdgcn_rcpf(d.y);
    f32x2 q = t * 0.5307027145f + (-0.7265760135f); q = q * t + 0.7107068705f; q = q * t + (-0.142248368f); q = q * t + 0.127414796f; q = q * t;
    const f32x2 s = (v * v) * (-0.72134752044f);
    f32x2 e; e.x = __builtin_amdgcn_exp2f(s.x); e.y = __builtin_amdgcn_exp2f(s.y);
    const f32x2 m = v * (q * e), r = v - m;
    f32x2 o; o.x = v.x < 0.f ? m.x : r.x; o.y = v.y < 0.f ? m.y : r.y; return o;
}


__device__ __forceinline__ float fsigmoid(float x) { return __builtin_amdgcn_rcpf(1.0f + __expf(-x)); }
__device__ __forceinline__ float fsilu(float x) { return x * fsigmoid(x); }
__device__ __forceinline__ float bf_lo(unsigned w) { return __uint_as_float(w << 16); }
__device__ __forceinline__ float bf_hi(unsigned w) { return __uint_as_float(w & 0xffff0000u); }
typedef unsigned u32x2 __attribute__((ext_vector_type(2)));

struct EpiIn {
    static constexpr bool PERM = true, AFTER_DRAIN = false;
    bf16_t *Z, *XBC, *UC, *GT; float* DT; const float *dtb_f, *dtb_b;
    __device__ __forceinline__ void operator()(const f32x4 (&acc)[2][2][4][2], const Unit& u, int wr, int wc, int fr, int fq) const {
        const int row0 = u.pm * BM + wr * 64 + fr; const int pn = u.pn;
        if (pn == 16) {
            if (wc < 2) {
#pragma unroll
                for (int n = 0; n < 2; ++n) { const int col = wc * 32 + 8 * fq + 4 * n;
                    if (col < 48) { f32x4 bv;
#pragma unroll
                        for (int j = 0; j < 4; ++j) { const int cc = col + j; bv[j] = cc < 24 ? dtb_f[cc] : dtb_b[cc - 24]; }
#pragma unroll
                        for (int ai = 0; ai < 2; ++ai)
#pragma unroll
                            for (int m = 0; m < 4; ++m) { f32x4 v = acc[ai][0][m][n] + bv;
#pragma unroll
                                for (int j = 0; j < 4; ++j) { const float x = v[j]; v[j] = fmaxf(x, 0.f) + log1pf(__expf(-fabsf(x))); }
                                *(f32x4*)(DT + (size_t)(row0 + ai * HALF + m * 16) * 48 + col) = v; } } }
            }
            return;
        }
        int mode, ldc, colt; bf16_t* base;
        if (pn < 6) { mode = 1; base = Z; ldc = 1536; colt = pn * BM; }
        else if (pn < 16) { mode = 0; base = XBC; ldc = 2560; colt = (pn - 6) * BM; }
        else if (pn < 20) {
            const int uc = (pn - 17) * BM + wc * 32 + 8 * fq, g0 = uc >> 4, j0 = uc & 15;
#pragma unroll
            for (int ai = 0; ai < 2; ++ai)
#pragma unroll
                for (int m = 0; m < 4; ++m) { const int r = row0 + ai * HALF + m * 16, cl = r >> 5, s = r & 31;
#pragma unroll
                    for (int bj = 0; bj < 2; ++bj) { const f32x4 v0 = acc[ai][bj][m][0], v1 = acc[ai][bj][m][1];
                        u32x4 w; w.x = cvt_pk_bf16(v0[0], v0[1]); w.y = cvt_pk_bf16(v0[2], v0[3]); w.z = cvt_pk_bf16(v1[0], v1[1]); w.w = cvt_pk_bf16(v1[2], v1[3]);
                        *(u32x4*)(UC + ((size_t)((g0 + 8 * bj) * 512 + cl) * 768 + s * 16 + j0)) = w; } }
            return; }
        else { mode = 2; base = GT; ldc = 2048; colt = (pn - 20) * BM; }
        const int col0 = colt + wc * 32 + 8 * fq;
#pragma unroll
        for (int ai = 0; ai < 2; ++ai)
#pragma unroll
            for (int m = 0; m < 4; ++m) { bf16_t* rowp = base + (size_t)(row0 + ai * HALF + m * 16) * ldc + col0;
#pragma unroll
                for (int bj = 0; bj < 2; ++bj) { f32x4 v0 = acc[ai][bj][m][0], v1 = acc[ai][bj][m][1];
                    if (mode == 1) {
#pragma unroll
                        for (int j = 0; j < 4; ++j) { v0[j] = fsilu(v0[j]); v1[j] = fsilu(v1[j]); } }
                    else if (mode == 2) {
#pragma unroll
                        for (int j = 0; j < 4; ++j) { v0[j] = fsigmoid(v0[j]); v1[j] = fsigmoid(v1[j]); } }
                    u32x4 w; w.x = cvt_pk_bf16(v0[0], v0[1]); w.y = cvt_pk_bf16(v0[2], v0[3]); w.z = cvt_pk_bf16(v1[0], v1[1]); w.w = cvt_pk_bf16(v1[2], v1[3]);
                    *(u32x4*)(rowp + bj * HALF) = w; } }
    }
};
struct EpiSsdOut {
    static constexpr bool PERM = true, AFTER_DRAIN = false;
    bf16_t* MIX; const bf16_t* YB; const bf16_t* GT;
    __device__ __forceinline__ void operator()(const f32x4 (&acc)[2][2][4][2], const Unit& u, int wr, int wc, int fr, int fq) const {
        const int row0 = u.pm * BM + wr * 64 + fr, col0 = u.pn * BM + wc * 32 + 8 * fq;
#pragma unroll
        for (int ai = 0; ai < 2; ++ai)
#pragma unroll
            for (int m = 0; m < 4; ++m) { const size_t r = (size_t)(row0 + ai * HALF + m * 16);
#pragma unroll
                for (int bj = 0; bj < 2; ++bj) { const int c = col0 + bj * HALF; const u32x4 g = *(const u32x4*)(GT + r * 2048 + c), y = *(const u32x4*)(YB + r * 1024 + c);
                    const f32x4 a0 = acc[ai][bj][m][0], a1 = acc[ai][bj][m][1];
                    u32x4 w; w.x = cvt_pk_bf16(a0[0] * bf_lo(g.x) + bf_lo(y.x), a0[1] * bf_hi(g.x) + bf_hi(y.x)); w.y = cvt_pk_bf16(a0[2] * bf_lo(g.y) + bf_lo(y.y), a0[3] * bf_hi(g.y) + bf_hi(y.y));
                    w.z = cvt_pk_bf16(a1[0] * bf_lo(g.z) + bf_lo(y.z), a1[1] * bf_hi(g.z) + bf_hi(y.z)); w.w = cvt_pk_bf16(a1[2] * bf_lo(g.w) + bf_lo(y.w), a1[3] * bf_hi(g.w) + bf_hi(y.w));
                    *(u32x4*)(MIX + r * 1024 + c) = w; } }
    }
};
struct EpiGlu {
    static constexpr bool PERM = true, AFTER_DRAIN = false;
    bf16_t* YB; const bf16_t* GT;
    __device__ __forceinline__ void operator()(const f32x4 (&acc)[2][2][4][2], const Unit& u, int wr, int wc, int fr, int fq) const {
        const int row0 = u.pm * BM + wr * 64 + fr, col0 = u.pn * HALF + wc * 32 + 8 * fq;
#pragma unroll
        for (int ai = 0; ai < 2; ++ai)
#pragma unroll
            for (int m = 0; m < 4; ++m) { const size_t r = (size_t)(row0 + ai * HALF + m * 16);
                const u32x4 g = *(const u32x4*)(GT + r * 2048 + 1024 + col0);
                f32x4 a0 = acc[ai][0][m][0], a1 = acc[ai][0][m][1]; const f32x4 b0 = acc[ai][1][m][0], b1 = acc[ai][1][m][1];
#pragma unroll
                for (int j = 0; j < 4; ++j) { a0[j] *= fsigmoid(b0[j]); a1[j] *= fsigmoid(b1[j]); }
                u32x4 w; w.x = cvt_pk_bf16(a0[0] * bf_lo(g.x), a0[1] * bf_hi(g.x)); w.y = cvt_pk_bf16(a0[2] * bf_lo(g.y), a0[3] * bf_hi(g.y)); w.z = cvt_pk_bf16(a1[0] * bf_lo(g.z), a1[1] * bf_hi(g.z)); w.w = cvt_pk_bf16(a1[2] * bf_lo(g.w), a1[3] * bf_hi(g.w));
                *(u32x4*)(YB + r * 1024 + col0) = w; }
    }
};
struct EpiWo {
    static constexpr bool PERM = false, AFTER_DRAIN = false;
    float* HP; const float* X; float alpha;
    __device__ __forceinline__ void operator()(const f32x4 (&acc)[2][2][4][2], const Unit& u, int wr, int wc, int fr, int fq) const {
        const int row0 = u.pm * BM + wr * 64 + fr, col0 = u.pn * BM + wc * 32 + 4 * fq;
#pragma unroll
        for (int ai = 0; ai < 2; ++ai)
#pragma unroll
            for (int m = 0; m < 4; ++m) { const size_t r = (size_t)(row0 + ai * HALF + m * 16);
#pragma unroll
                for (int bj = 0; bj < 2; ++bj)
#pragma unroll
                    for (int n = 0; n < 2; ++n) { const int c = col0 + bj * HALF + n * 16; const f32x4 xv = *(const f32x4*)(X + r * 1024 + c);
                        *(f32x4*)(HP + r * 1024 + c) = acc[ai][bj][m][n] + xv * alpha; } }
    }
};
__device__ __forceinline__ unsigned pk4_fp8_(float a, float b, float c, float d) { int r_ = __builtin_amdgcn_cvt_pk_fp8_f32(a, b, 0, false); r_ = __builtin_amdgcn_cvt_pk_fp8_f32(c, d, r_, true); return (unsigned)r_; }
struct EpiMoe1 {
    static constexpr bool PERM = true, AFTER_DRAIN = false;
    unsigned char* HID; float inv, hs;
    __device__ __forceinline__ void operator()(const f32x4 (&acc)[2][2][4][2], const Unit& u, int wr, int wc, int fr, int fq) const {
        const int row0 = u.pm * BM + wr * 64 + fr, col0 = (u.pn % 22) * HALF + wc * 32 + 8 * fq;
#pragma unroll
        for (int ai = 0; ai < 2; ++ai)
#pragma unroll
            for (int m = 0; m < 4; ++m) { const size_t r = (size_t)(row0 + ai * HALF + m * 16);
                f32x4 a0 = acc[ai][0][m][0] * inv, a1 = acc[ai][0][m][1] * inv; const f32x4 b0 = acc[ai][1][m][0] * (inv * hs), b1 = acc[ai][1][m][1] * (inv * hs);
#pragma unroll
                for (int j = 0; j < 4; ++j) { a0[j] = fsilu(a0[j]) * b0[j]; a1[j] = fsilu(a1[j]) * b1[j]; }
                u32x2 w; w.x = pk4_fp8_(a0[0], a0[1], a0[2], a0[3]); w.y = pk4_fp8_(a1[0], a1[1], a1[2], a1[3]);
                *(u32x2*)(HID + r * 2816 + col0) = w; }
    }
};
struct EpiMoe2 {
    static constexpr bool PERM = true, AFTER_DRAIN = false;
    bf16_t* Y; float inv;
    __device__ __forceinline__ void operator()(const f32x4 (&acc)[2][2][4][2], const Unit& u, int wr, int wc, int fr, int fq) const {
        const int row0 = u.pm * BM + wr * 64 + fr, col0 = (u.pn & 3) * BM + wc * 32 + 8 * fq;
#pragma unroll
        for (int ai = 0; ai < 2; ++ai)
#pragma unroll
            for (int m = 0; m < 4; ++m) { bf16_t* rowp = Y + (size_t)(row0 + ai * HALF + m * 16) * 1024 + col0;
#pragma unroll
                for (int bj = 0; bj < 2; ++bj) { const f32x4 v0 = acc[ai][bj][m][0] * inv, v1 = acc[ai][bj][m][1] * inv;
                    u32x4 w; w.x = cvt_pk_bf16(v0[0], v0[1]); w.y = cvt_pk_bf16(v0[2], v0[3]); w.z = cvt_pk_bf16(v1[0], v1[1]); w.w = cvt_pk_bf16(v1[2], v1[3]);
                    *(u32x4*)(rowp + bj * HALF) = w; } }
    }
};
struct EpiS5a {
    static constexpr bool PERM = false, AFTER_DRAIN = false;
    float* SLOC;
    __device__ __forceinline__ void operator()(const f32x4 (&acc)[2][2][4][2], const Unit& u, int wr, int wc, int fr, int fq) const {
        const int row0 = u.pm * BM + wr * 64 + fr, col0 = wc * 32 + 4 * fq;
#pragma unroll
        for (int ai = 0; ai < 2; ++ai)
#pragma unroll
            for (int m = 0; m < 4; ++m) { float* rowp = SLOC + (size_t)(row0 + ai * HALF + m * 16) * 256 + col0;
#pragma unroll
                for (int bj = 0; bj < 2; ++bj)
#pragma unroll
                    for (int n = 0; n < 2; ++n) *(f32x4*)(rowp + bj * HALF + n * 16) = acc[ai][bj][m][n]; }
    }
};
__device__ __forceinline__ float gelu_tanh_f(float x) { const float uu = 0.7978845608028654f * (x + 0.044715f * x * x * x); const float e = __expf(2.f * uu); return 0.5f * x * (2.f - 2.f * __builtin_amdgcn_rcpf(e + 1.f)); }
struct EpiS5c {
    static constexpr bool PERM = true, AFTER_DRAIN = false;
    bf16_t* GY; const bf16_t* UC; const float* d5;
    __device__ __forceinline__ void operator()(const f32x4 (&acc)[2][2][4][2], const Unit& u, int wr, int wc, int fr, int fq) const {
        const int g = u.pm >> 1, cl0 = (u.pm & 1) * BM + wr * 64 + fr, nl0 = (u.pn & 1) * BM + wc * 32 + 8 * fq;
        const int k0 = nl0 & 15; const f32x4 d0 = *(const f32x4*)(d5 + g * 16 + k0), d1 = *(const f32x4*)(d5 + g * 16 + k0 + 4);
#pragma unroll
        for (int ai = 0; ai < 2; ++ai)
#pragma unroll
            for (int m = 0; m < 4; ++m) { const int cl = cl0 + ai * HALF + m * 16;
#pragma unroll
                for (int bj = 0; bj < 2; ++bj) { const int nl = nl0 + bj * HALF, t = nl >> 4;
                    const u32x4 uw = *(const u32x4*)(UC + ((size_t)(g * 512 + cl) * 768 + nl));
                    f32x4 v0 = acc[ai][bj][m][0], v1 = acc[ai][bj][m][1];
                    v0[0] += bf_lo(uw.x) * d0[0]; v0[1] += bf_hi(uw.x) * d0[1]; v0[2] += bf_lo(uw.y) * d0[2]; v0[3] += bf_hi(uw.y) * d0[3];
                    v1[0] += bf_lo(uw.z) * d1[0]; v1[1] += bf_hi(uw.z) * d1[1]; v1[2] += bf_lo(uw.w) * d1[2]; v1[3] += bf_hi(uw.w) * d1[3];
#pragma unroll
                    for (int j = 0; j < 4; ++j) { v0[j] = gelu_tanh_f(v0[j]); v1[j] = gelu_tanh_f(v1[j]); }
                    u32x4 w; w.x = cvt_pk_bf16(v0[0], v0[1]); w.y = cvt_pk_bf16(v0[2], v0[3]); w.z = cvt_pk_bf16(v1[0], v1[1]); w.w = cvt_pk_bf16(v1[2], v1[3]);
                    *(u32x4*)(GY + (size_t)(cl * 32 + t) * 768 + g * 16 + k0) = w; } }
    }
};
struct S5aOrder {
    int c, lo;
    __device__ __forceinline__ bool next(int i, Unit& u) const { if (i > 0 || c < lo || c >= lo + 96) return false; u.pm = c - lo; u.pn = (c - lo) >> 1; return true; }
    __device__ __forceinline__ void a_ready(const Unit&) const {}
    __device__ __forceinline__ void done(const Unit&) const {}
};
struct S5cOrder {
    int G, c;
    __device__ __forceinline__ bool next(int i, Unit& u) const { const int L = i * G + c; if (L >= 192) return false; const int g = L >> 2; u.pm = 2 * g + (L & 1); u.pn = 2 * g + ((L >> 1) & 1); return true; }
    __device__ __forceinline__ void a_ready(const Unit&) const {}
    __device__ __forceinline__ void done(const Unit&) const {}
};
struct MoeOrder1 {
    int G, c;
    __device__ __forceinline__ bool next(int i, Unit& u) const {
        if (G == 256) { if (i >= 11) return false; const int x = c & 7, j = c >> 3, q = x * 44 + i * 4 + (j >> 3); u.pm = (q / 22) * 8 + (j & 7); u.pn = q; return true; }
        const long L = (long)i * G + c; if (L >= 2816) return false; const int e = (int)(L / 176), r = (int)(L % 176); u.pm = e * 8 + (r & 7); u.pn = e * 22 + (r >> 3); return true;
    }
    __device__ __forceinline__ void a_ready(const Unit&) const {}
    __device__ __forceinline__ void done(const Unit&) const {}
};
struct MoeOrder2 {
    int G, c;
    __device__ __forceinline__ bool next(int i, Unit& u) const {
        if (G == 256) { if (i >= 2) return false; const int x = c & 7, j = c >> 3, e = 2 * x + i; u.pm = e * 8 + (j & 7); u.pn = e * 4 + (j >> 3); return true; }
        const long L = (long)i * G + c; if (L >= 512) return false; const int e = (int)(L / 32), r = (int)(L % 32); u.pm = e * 8 + (r & 7); u.pn = e * 4 + (r >> 3); return true;
    }
    __device__ __forceinline__ void a_ready(const Unit&) const {}
    __device__ __forceinline__ void done(const Unit&) const {}
};
template <class Epi, class Sched, bool ALIGN_EPI = false, bool SP2 = false, bool F8 = false>
__device__ __forceinline__ void gemm_phase(PG8_LAS unsigned char* lds, const Gemm g, const Sched& S, const Epi& E, const int tid) {
    const int wid = __builtin_amdgcn_readfirstlane(tid >> 6), lane = tid & 63, wr = wid >> 2, wc = wid & 3, fr = lane & 15, fq = lane >> 4;
    const int K = g.K, nt = F8 ? K / 128 : K / BK; constexpr int ESZ = F8 ? 1 : 2, KOFF = F8 ? 16 : 1024;
    unsigned voffA, voffB;
    { int R, C; stage_rc(tid * 16, R, C); const int Rb = Epi::PERM ? ((R & ~31) + perm32(R & 31)) : R;
      voffA = (unsigned)(R * g.lda * ESZ + C * 2); voffB = (unsigned)(Rb * g.ldb * ESZ + C * 2); }
    const unsigned r64A = 64u * (unsigned)g.lda * ESZ, r64B = 64u * (unsigned)g.ldb * ESZ;
    const __amdgpu_buffer_rsrc_t rsrcA = __builtin_amdgcn_make_buffer_rsrc((void*)g.A, 0, (int)((unsigned)g.M * (unsigned)g.lda * ESZ), 0x00020000), rsrcB = __builtin_amdgcn_make_buffer_rsrc((void*)g.Bt, 0, (int)((unsigned)g.N * (unsigned)g.ldb * ESZ), 0x00020000);
    const unsigned kstep = (unsigned)(BK * 2);
    const unsigned hstepA = (unsigned)HALF * g.lda * ESZ, hstepB = (unsigned)HALF * g.ldb * ESZ;
    const unsigned tstepA = 2 * hstepA, tstepB = 2 * hstepB;
    const unsigned ldsw = (unsigned)wid * 1024u;
    const int aoff = lds_byte(wr * 64 + fr, F8 ? fq * 16 : fq * 8), boff = lds_byte(wc * 32 + fr, F8 ? fq * 16 : fq * 8);
#define PG8_SA(b, h) (((b) * 2 + (h)) * HTB)
#define PG8_SB(b, h) ((4 + (b) * 2 + (h)) * HTB)
#define PG8_STAGE(bufoff, gbase, voff) do { _Pragma("unroll") for (int _i = 0; _i < 2; ++_i) \
        __builtin_amdgcn_raw_ptr_buffer_load_lds(PG8_RSRC(voff), (PG8_LAS unsigned*)(lds + (bufoff) + ldsw + _i * 8192), 16, (int)(voff), (int)((gbase) + _i * PG8_R64(voff)), 0, 0); } while (0)
#define PG8_RSRC(voff) (&(voff) == &voffA ? rsrcA : rsrcB)
#define PG8_R64(voff) (&(voff) == &voffA ? r64A : r64B)
#define PG8_LDA(dst, b, h) do { _Pragma("unroll") for (int m = 0; m < 4; ++m) _Pragma("unroll") for (int k = 0; k < 2; ++k) dst[m][k] = *(const PG8_LAS bf16x8*)(lds + PG8_SA(b, h) + aoff + m * 2048 + k * KOFF); } while (0)
#define PG8_LDB(dst, b, h) do { _Pragma("unroll") for (int n = 0; n < 2; ++n) _Pragma("unroll") for (int k = 0; k < 2; ++k) dst[n][k] = *(const PG8_LAS bf16x8*)(lds + PG8_SB(b, h) + boff + n * 2048 + k * KOFF); } while (0)
#define PG8_CAT8(x_) __builtin_bit_cast(i32x8, __builtin_shufflevector((x_)[0], (x_)[1], 0, 1, 2, 3, 4, 5, 6, 7, 8, 9, 10, 11, 12, 13, 14, 15))
#define PG8_MMA(ai, bj, At, Bt) do { __builtin_amdgcn_s_setprio(1); if constexpr (F8) { _Pragma("unroll") for (int m = 0; m < 4; ++m) _Pragma("unroll") for (int n = 0; n < 2; ++n) \
        acc[ai][bj][m][n] = __builtin_amdgcn_mfma_scale_f32_16x16x128_f8f6f4(PG8_CAT8(Bt[n]), PG8_CAT8(At[m]), acc[ai][bj][m][n], 0, 0, 0, 0x7f7f7f7f, 0, 0x7f7f7f7f); } \
      else { _Pragma("unroll") for (int m = 0; m < 4; ++m) _Pragma("unroll") for (int n = 0; n < 2; ++n) _Pragma("unroll") for (int k = 0; k < 2; ++k) \
        acc[ai][bj][m][n] = __builtin_amdgcn_mfma_f32_16x16x32_bf16(Bt[n][k], At[m][k], acc[ai][bj][m][n], 0, 0, 0); } __builtin_amdgcn_s_setprio(0); } while (0)
#define PG8_WAIT_V(n) asm volatile("s_waitcnt vmcnt(" #n ")" ::: "memory")
#define PG8_WAIT_L(n) asm volatile("s_waitcnt lgkmcnt(" #n ")" ::: "memory")
#define PG8_BAR __builtin_amdgcn_s_barrier()
#define PG8_SCHED __builtin_amdgcn_sched_barrier(0)
    Unit cur, nxt; int ui = 0;
    if (!S.next(0, cur)) return;
    f32x4 acc[2][2][4][2];
#pragma unroll
    for (int a = 0; a < 2; ++a)
#pragma unroll
        for (int b = 0; b < 2; ++b)
#pragma unroll
            for (int m = 0; m < 4; ++m)
#pragma unroll
                for (int n = 0; n < 2; ++n) acc[a][b][m][n] = (f32x4){0.f, 0.f, 0.f, 0.f};
    bf16x8 At[4][2], B0[2][2], B1[2][2];
    unsigned cA = (unsigned)cur.pm * tstepA, cB = (unsigned)cur.pn * tstepB;
    S.a_ready(cur);
    if constexpr (SP2) {
        PG8_STAGE(PG8_SB(0, 0), cB, voffB); PG8_STAGE(PG8_SB(0, 1), cB + hstepB, voffB); PG8_STAGE(PG8_SA(0, 0), cA, voffA); PG8_STAGE(PG8_SA(0, 1), cA + hstepA, voffA);
        if (wr == 1) PG8_BAR;
        PG8_WAIT_V(2); PG8_BAR;
        PG8_STAGE(PG8_SB(1, 0), cB + kstep, voffB); PG8_STAGE(PG8_SA(1, 0), cA + kstep, voffA); PG8_STAGE(PG8_SB(1, 1), cB + hstepB + kstep, voffB);
        PG8_WAIT_V(6); PG8_BAR;
    } else {
        PG8_STAGE(PG8_SB(0, 0), cB, voffB); PG8_STAGE(PG8_SA(0, 0), cA, voffA); PG8_STAGE(PG8_SB(0, 1), cB + hstepB, voffB); PG8_STAGE(PG8_SA(0, 1), cA + hstepA, voffA);
        if (wr == 1) PG8_BAR;
        PG8_WAIT_V(4); PG8_BAR;
        PG8_STAGE(PG8_SB(1, 0), cB + kstep, voffB); PG8_STAGE(PG8_SA(1, 0), cA + kstep, voffA); PG8_STAGE(PG8_SB(1, 1), cB + hstepB + kstep, voffB);
        PG8_WAIT_V(6); PG8_BAR;
    }
    for (;;) {
        const bool has_next = S.next(ui + 1, nxt);
        const unsigned nA = has_next ? (unsigned)nxt.pm * tstepA : cA, nB = has_next ? (unsigned)nxt.pn * tstepB : cB;
#pragma unroll 1
        for (int t = 0; t < nt; t += 2) {
            const bool last = (t == nt - 2);
            const unsigned a1 = cA + (unsigned)(t + 1) * kstep;
            const unsigned a2 = last ? nA : cA + (unsigned)(t + 2) * kstep, b2 = last ? nB : cB + (unsigned)(t + 2) * kstep;
            const unsigned a3 = a2 + kstep, b3 = b2 + kstep;
            if (last && has_next) S.a_ready(nxt);
            if constexpr (SP2) {
            PG8_LDB(B0, 0, 0); PG8_LDB(B1, 0, 1); PG8_SCHED; PG8_LDA(At, 0, 0); PG8_STAGE(PG8_SA(1, 1), a1 + hstepA, voffA);
            PG8_WAIT_V(8); PG8_WAIT_L(0); PG8_BAR; PG8_MMA(0, 0, At, B0); PG8_MMA(0, 1, At, B1); PG8_BAR; PG8_SCHED;
            PG8_LDA(At, 0, 1); PG8_STAGE(PG8_SB(0, 0), b2, voffB); PG8_STAGE(PG8_SB(0, 1), b2 + hstepB, voffB); PG8_STAGE(PG8_SA(0, 0), a2, voffA);
            PG8_WAIT_V(8); PG8_WAIT_L(0); PG8_BAR; PG8_MMA(1, 0, At, B0); PG8_MMA(1, 1, At, B1); PG8_BAR; PG8_SCHED;
            PG8_LDB(B0, 1, 0); PG8_LDB(B1, 1, 1); PG8_SCHED; PG8_LDA(At, 1, 0); PG8_STAGE(PG8_SA(0, 1), a2 + hstepA, voffA);
            PG8_WAIT_V(8); PG8_WAIT_L(0); PG8_BAR; PG8_MMA(0, 0, At, B0); PG8_MMA(0, 1, At, B1); PG8_BAR; PG8_SCHED;
            PG8_LDA(At, 1, 1); PG8_STAGE(PG8_SB(1, 0), b3, voffB); PG8_STAGE(PG8_SB(1, 1), b3 + hstepB, voffB); PG8_STAGE(PG8_SA(1, 0), a3, voffA);
            PG8_WAIT_V(8); PG8_WAIT_L(0); PG8_BAR; PG8_MMA(1, 0, At, B0); PG8_MMA(1, 1, At, B1); PG8_BAR; PG8_SCHED;
            } else {
            PG8_LDB(B0, 0, 0); PG8_SCHED; PG8_LDA(At, 0, 0); PG8_STAGE(PG8_SA(1, 1), a1 + hstepA, voffA);
            PG8_WAIT_L(8); PG8_BAR; PG8_WAIT_L(0); PG8_MMA(0, 0, At, B0); PG8_BAR; PG8_SCHED;
            PG8_LDB(B1, 0, 1); PG8_STAGE(PG8_SB(0, 0), b2, voffB);
            PG8_BAR; PG8_WAIT_L(0); PG8_MMA(0, 1, At, B1); PG8_BAR;
            PG8_LDA(At, 0, 1); PG8_STAGE(PG8_SA(0, 0), a2, voffA);
            PG8_BAR; PG8_WAIT_L(0); PG8_MMA(1, 0, At, B0); PG8_BAR; PG8_SCHED;
            PG8_STAGE(PG8_SB(0, 1), b2 + hstepB, voffB);
            PG8_WAIT_V(6); PG8_BAR; PG8_MMA(1, 1, At, B1); PG8_BAR;
            PG8_LDB(B0, 1, 0); PG8_SCHED; PG8_LDA(At, 1, 0); PG8_STAGE(PG8_SA(0, 1), a2 + hstepA, voffA);
            PG8_WAIT_L(8); PG8_BAR; PG8_WAIT_L(0); PG8_MMA(0, 0, At, B0); PG8_BAR; PG8_SCHED;
            PG8_LDB(B1, 1, 1); PG8_STAGE(PG8_SB(1, 0), b3, voffB);
            PG8_BAR; PG8_WAIT_L(0); PG8_MMA(0, 1, At, B1); PG8_BAR;
            PG8_LDA(At, 1, 1); PG8_STAGE(PG8_SA(1, 0), a3, voffA);
            PG8_BAR; PG8_WAIT_L(0); PG8_MMA(1, 0, At, B0); PG8_BAR; PG8_SCHED;
            PG8_STAGE(PG8_SB(1, 1), b3 + hstepB, voffB);
            PG8_WAIT_V(6); PG8_BAR; PG8_MMA(1, 1, At, B1); PG8_BAR;
            }
        }
        if constexpr (ALIGN_EPI) { if (wr == 0) PG8_BAR; }
        if constexpr (!Epi::AFTER_DRAIN) { E(acc, cur, wr, wc, fr, fq); S.done(cur); }
        if (!has_next) break;
#pragma unroll
        for (int a = 0; a < 2; ++a)
#pragma unroll
            for (int b = 0; b < 2; ++b)
#pragma unroll
                for (int m = 0; m < 4; ++m)
#pragma unroll
                    for (int n = 0; n < 2; ++n) acc[a][b][m][n] = (f32x4){0.f, 0.f, 0.f, 0.f};
        cur = nxt; cA = nA; cB = nB; ++ui;
        if constexpr (ALIGN_EPI) { if (wr == 1) PG8_BAR; }
    }
    PG8_WAIT_V(0);
    if constexpr (!ALIGN_EPI) { if (wr == 0) PG8_BAR; }
    PG8_BAR;
    if constexpr (Epi::AFTER_DRAIN) { E.fused(acc, cur, wr, wc, fr, fq, lds, wid, lane); S.done(cur); }
#undef PG8_SA
#undef PG8_SB
#undef PG8_STAGE
#undef PG8_RSRC
#undef PG8_R64
#undef PG8_LDA
#undef PG8_LDB
#undef PG8_MMA
#undef PG8_CAT8
#undef PG8_WAIT_V
#undef PG8_WAIT_L
#undef PG8_BAR
#undef PG8_SCHED
}
}
#ifndef PG8_SP2
#define PG8_SP2 true
#endif
#ifndef PG8_ALIGN
#define PG8_ALIGN true
#endif

constexpr int NWAVES = 8, NTHR = 512;
constexpr int D = 1024, NB = 2, T = 8192, M = NB * T;
constexpr int SSD_H = 24, SSD_P = 64, SSD_IN = 1536, SSD_G = 4, SSD_N = 128, XBC = 2560, INCOLS = 6960, NIN_PAD = 7168;
constexpr int S5_W = 768, S5_G = 48, S5_P = 64, S5_K = 16;
constexpr int NE = 16, FF = 2816, CAP = 1024, MROWS = NE * NB * CAP;
constexpr float LN_EPS = 1e-5f, RMS_EPS = 1e-5f;
constexpr float ALPHA = 1.189207115002721f;
constexpr float W1_SCALE = 32.f, W2_SCALE = 64.f, HID_SCALE = 4.f;

constexpr size_t MiB = 1u << 20;
constexpr size_t WS_CTL = 0, CTL_ZERO_BYTES = 64 * 1024;
constexpr size_t WS_WIN = 1 * MiB, WS_WOUT = 15 * MiB, WS_WGLU = 18 * MiB, WS_WO = 21 * MiB, WS_W1 = 23 * MiB, WS_W2 = 199 * MiB, WS_ACT = 287 * MiB;
constexpr size_t A_XB = WS_ACT + 0 * MiB;
constexpr size_t A_BN = WS_ACT + 0 * MiB;
constexpr size_t A_CN = WS_ACT + 16 * MiB;
constexpr size_t A_Z = WS_ACT + 32 * MiB;
constexpr size_t A_XBC = WS_ACT + 80 * MiB;
constexpr size_t A_S = WS_ACT + 80 * MiB;
constexpr size_t A_XT = WS_ACT + 176 * MiB;
constexpr size_t A_BT = WS_ACT + 224 * MiB;
constexpr size_t A_SV = WS_ACT + 340 * MiB;
constexpr size_t A_DT = WS_ACT + 252 * MiB;
constexpr size_t A_TOT = WS_ACT + 255 * MiB;
constexpr size_t A_UC = WS_ACT + 268 * MiB;
constexpr size_t A_Y = WS_ACT + 256 * MiB;
constexpr size_t A_GY = WS_ACT + 224 * MiB;
constexpr size_t A_GT = WS_ACT + 353 * MiB;
constexpr size_t A_YB = WS_ACT + 304 * MiB;
constexpr size_t A_MIX = WS_ACT + 64 * MiB;
constexpr size_t A_HP = WS_ACT + 96 * MiB;
constexpr size_t A_ST = WS_ACT + 0 * MiB;
constexpr size_t A_H8 = WS_ACT + 64 * MiB;
constexpr size_t A_AFF = WS_ACT + 160 * MiB;
constexpr size_t A_IDX = A_AFF + 1 * MiB;
constexpr size_t A_SEL = A_AFF + 2 * MiB;
constexpr size_t A_GATE = A_AFF + 3 * MiB;
constexpr size_t A_XIN = WS_ACT + 164 * MiB;
constexpr size_t A_HID = WS_ACT + 228 * MiB;
constexpr size_t A_YE = WS_ACT + 164 * MiB;
constexpr size_t WS_TV = WS_W2 + 0 * MiB;
constexpr size_t WS_WS5 = WS_W2 + 36 * MiB;
constexpr size_t WS_SLOC = WS_W2 + 48 * MiB;
constexpr size_t WS_AQ = WS_W2 + 72 * MiB;
constexpr size_t WS_END = 704 * MiB;
static_assert(A_HID + 176 * MiB <= WS_END && A_XIN + 64 * MiB <= A_HID && A_YE + 64 * MiB <= A_HID && A_GATE + 1 * MiB <= A_XIN && A_HP + 64 * MiB <= A_AFF && A_H8 + 16 * MiB <= A_HP && A_ST + 1 * MiB <= A_H8, "d_ws map (late phases)");
static_assert(A_GT + 64 * MiB <= WS_END && A_SV + 12 * MiB <= A_GT && A_YB + 32 * MiB <= A_SV && A_UC + 36 * MiB <= A_YB && A_Y + 48 * MiB <= A_YB && A_TOT + 1 * MiB <= A_Y && A_DT + 3 * MiB <= A_TOT && A_GY + 24 * MiB <= A_DT && A_BT + 16 * MiB <= A_DT
              && A_XT + 48 * MiB <= A_BT && A_S + 96 * MiB <= A_XT && A_Z + 48 * MiB <= A_XBC && A_CN + 16 * MiB <= A_Z, "d_ws map (early phases)");
constexpr int CW_LIST = 8192;
constexpr int CW_QW1 = 12288;
constexpr int CW_BAR = 1024;

constexpr int RING_BYTES = 131072;
constexpr int MISC_OFF = RING_BYTES;
constexpr int LDS_BYTES = 147456;

#define GAS __attribute__((address_space(1)))
#define LAS __attribute__((address_space(3)))
typedef unsigned short bf16;
typedef unsigned v4u __attribute__((ext_vector_type(4)));
typedef unsigned v2u __attribute__((ext_vector_type(2)));
typedef float f32x4 __attribute__((ext_vector_type(4)));
#define LDS_WAIT() asm volatile("s_waitcnt lgkmcnt(0)" ::: "memory")
__device__ __forceinline__ unsigned f2bf(float f) { unsigned u = __builtin_bit_cast(unsigned, f); return (u + 0x7fffu + ((u >> 16) & 1u)) >> 16; }
__device__ __forceinline__ unsigned pk2(float lo, float hi) { return pg8::cvt_pk_bf16(lo, hi); }
__device__ __forceinline__ float bflo(unsigned w) { return __uint_as_float(w << 16); }
__device__ __forceinline__ float bfhi(unsigned w) { return __uint_as_float(w & 0xffff0000u); }
__device__ __forceinline__ float wave_sum(float v) {
#pragma unroll
    for (int o = 1; o < 64; o <<= 1) v += __shfl_xor(v, o);
    return v;
}
#define XB_TMO      128
#define XB_XCNT(j)  (256  + 64 * (j))
#define XB_XSUB(j)  (1280 + 64 * (j))
#define XB_XGEN(j)  (2304 + 64 * (j))
#define XB_TOP      3328
#define XB_TOPGEN   3392
#define XCD_BAR_WORDS 3456
#define XB_SPIN_CAP (1u << 18)

__device__ __forceinline__ unsigned xb_ld(unsigned* p)              { return __hip_atomic_load(p, __ATOMIC_RELAXED, __HIP_MEMORY_SCOPE_AGENT); }
__device__ __forceinline__ unsigned xb_add(unsigned* p, unsigned v) { return __hip_atomic_fetch_add(p, v, __ATOMIC_RELAXED, __HIP_MEMORY_SCOPE_AGENT); }
__device__ __forceinline__ unsigned xb_xcc_id() { return (unsigned)__builtin_amdgcn_s_getreg((3 << 11) | 20) & 0xFu; }
#define XB_SPIN(cond, bar) do { unsigned _sp = 0; while (cond) { __builtin_amdgcn_s_sleep(1); \
    if ((++_sp & 255u) == 0u) { if (xb_ld(&(bar)[XB_TMO])) break; if (_sp > XB_SPIN_CAP) { atomicAdd(&(bar)[XB_TMO], 1u); break; } } } } while (0)

struct XcdBarrier {
    unsigned* bar; unsigned x;
    volatile LAS unsigned* st;
};

__device__ __forceinline__ XcdBarrier xcd_barrier_post(unsigned* bar, volatile LAS unsigned* st) {
    XcdBarrier b; b.bar = bar; b.x = xb_xcc_id(); b.st = st;
    if (threadIdx.x == 0) (void)xb_add(&bar[XB_XCNT(b.x)], 1u);
    return b;
}
__device__ __forceinline__ void xcd_barrier_complete(unsigned* bar, unsigned x, unsigned& nloc, unsigned& nx) {
    const unsigned G = gridDim.x * gridDim.y * gridDim.z;
    unsigned sum, cnt, mine, sp = 0u;
    for (;;) {
        sum = 0u; cnt = 0u; mine = 0u;
#pragma unroll
        for (unsigned j = 0; j < 16; ++j) { const unsigned c = xb_ld(&bar[XB_XCNT(j)]); sum += c; cnt += (c > 0u) ? 1u : 0u; mine = (j == x) ? c : mine; }
        if (sum == G) break;
        __builtin_amdgcn_s_sleep(1);
        if ((++sp & 255u) == 0u) { if (xb_ld(&bar[XB_TMO])) break; if (sp > XB_SPIN_CAP) { atomicAdd(&bar[XB_TMO], 1u); break; } }
    }
    nloc = mine > 0u ? mine : 1u; nx = cnt > 0u ? cnt : 1u;
}

__device__ __forceinline__ void xcd_barrier(const XcdBarrier& b, const bool t0  ) {
    asm volatile("s_waitcnt vmcnt(0)" ::: "memory");
    __syncthreads();
    if (t0) {
        unsigned* bar = b.bar;
        __builtin_amdgcn_s_waitcnt(0);
        unsigned nloc = b.st[0], nx = b.st[1];
        if (nloc == 0u) { xcd_barrier_complete(bar, b.x, nloc, nx); b.st[0] = nloc; b.st[1] = nx; }
        const unsigned old = xb_add(&bar[XB_XSUB(b.x)], 1u);
        const unsigned gen = old / nloc;
        if (old + 1u == (gen + 1u) * nloc) {
            __builtin_amdgcn_fence(__ATOMIC_RELEASE, "agent");
            asm volatile("s_waitcnt vmcnt(0)" ::: "memory");
            const unsigned og = xb_add(&bar[XB_TOP], 1u);
            const unsigned tg = og / nx;
            if (og + 1u == (tg + 1u) * nx) xb_add(&bar[XB_TOPGEN], 1u);
            else XB_SPIN(xb_ld(&bar[XB_TOPGEN]) == tg, bar);
            __builtin_amdgcn_fence(__ATOMIC_ACQUIRE, "agent");
            xb_add(&bar[XB_XGEN(b.x)], 1u);
            asm volatile("s_waitcnt vmcnt(0)" ::: "memory");
        } else {
            XB_SPIN(xb_ld(&bar[XB_XGEN(b.x)]) == gen, bar);
            __builtin_amdgcn_fence(__ATOMIC_ACQUIRE, "agent");
            asm volatile("s_waitcnt vmcnt(0)" ::: "memory");
        }
    }
    __syncthreads();
}

struct Frame {
    LAS unsigned char* lds;
    int tid, lane, wave, bid, G;
    LAS unsigned* ptab; float* out; unsigned char* ws;
};
__device__ __forceinline__ const float* inp_(const Frame& F, int k) { const unsigned lo = __builtin_amdgcn_readfirstlane(F.ptab[2 * k]), hi = __builtin_amdgcn_readfirstlane(F.ptab[2 * k + 1]); return (const float*)(((unsigned long long)hi << 32) | lo); }
#define INP(k) inp_(F, k)
__device__ __forceinline__ unsigned lane_now() { unsigned z_ = 0u; asm volatile("" : "+s"(z_)); return __builtin_amdgcn_mbcnt_hi(~0u, __builtin_amdgcn_mbcnt_lo(~0u, z_)); }
#define WSP(T_, off) ((T_*)(F.ws + (off)))

__device__ __forceinline__ unsigned pk4_fp8(float a, float b, float c, float d) { int r_ = __builtin_amdgcn_cvt_pk_fp8_f32(a, b, 0, false); r_ = __builtin_amdgcn_cvt_pk_fp8_f32(c, d, r_, true); return (unsigned)r_; }
__device__ __forceinline__ void tr_load(const float* W, int ldw, int col0, int ncols, int k0, int n0, int lane, f32x4 (&v)[16]) {
    const int kr = lane >> 4, c4 = lane & 15; const bool okc = (n0 + 4 * c4) < ncols;
    const float* src = W + (size_t)(k0 + kr) * ldw + col0 + n0 + 4 * c4;
#pragma unroll
    for (int i = 0; i < 16; ++i) v[i] = okc ? *(const f32x4*)(src + (size_t)(4 * i) * ldw) : (f32x4){0.f, 0.f, 0.f, 0.f};
}
__device__ __forceinline__ void tr_store(const f32x4 (&v)[16], int ncols, int K, bf16* WT, int drow, LAS float* scr, int k0, int n0, int lane, float qs) {
    const int kr = lane >> 4, c4 = lane & 15;
#pragma unroll
    for (int i = 0; i < 16; ++i) { const int k = 4 * i + kr; *(LAS f32x4*)(scr + k * 64 + 4 * (c4 ^ ((k >> 3) & 7))) = v[i]; }
    LDS_WAIT(); asm volatile("" ::: "memory");
    const int nl = lane >> 3, c = lane & 7;
#pragma unroll
    for (int j = 0; j < 8; ++j) { const int n = 8 * j + nl; const LAS float* s = scr + (8 * c) * 64 + 4 * ((n >> 2) ^ c) + (n & 3);
        if (qs != 0.f) { v2u o; o.x = pk4_fp8(s[0 * 64] * qs, s[1 * 64] * qs, s[2 * 64] * qs, s[3 * 64] * qs); o.y = pk4_fp8(s[4 * 64] * qs, s[5 * 64] * qs, s[6 * 64] * qs, s[7 * 64] * qs);
            if (n0 + n < ncols) *(v2u*)((unsigned char*)WT + (size_t)(drow + n) * K + k0 + 8 * c) = o; }
        else { v4u o; o.x = pk2(s[0 * 64], s[1 * 64]); o.y = pk2(s[2 * 64], s[3 * 64]); o.z = pk2(s[4 * 64], s[5 * 64]); o.w = pk2(s[6 * 64], s[7 * 64]);
            if (n0 + n < ncols) *(v4u*)(WT + (size_t)(drow + n) * K + k0 + 8 * c) = o; } }
    LDS_WAIT(); asm volatile("" ::: "memory");
}
__device__ __forceinline__ void tr_item(const float* W, int ldw, int col0, int ncols, int K, bf16* WT, int drow, LAS float* scr, int k0, int n0, int lane, float qs) {
    f32x4 v[16]; tr_load(W, ldw, col0, ncols, k0, n0, lane, v); tr_store(v, ncols, K, WT, drow, scr, k0, n0, lane, qs);
}
struct TrJob { const float* W; int ldw, col0, ncols, K; bf16* WT; int drow0, interleave; float qs; };
__device__ __forceinline__ int tr_job_items(const TrJob& j) { return (j.K / 64) * ((j.ncols + 63) / 64); }
__device__ __forceinline__ void tr_job_item(const TrJob& j, int item, LAS float* scr, int lane) {
    const int nblk = (j.ncols + 63) / 64, kb = item / nblk, nb = item % nblk, n0 = nb * 64;
    const int drow = j.interleave ? j.drow0 + (n0 >> 7) * 256 + (n0 & 127) : j.drow0 + n0;
    tr_item(j.W, j.ldw, j.col0, j.ncols, j.K, j.WT, drow, scr, kb * 64, n0, lane, j.qs);
}
__device__ __forceinline__ void p0_prologue(Frame& F) {
    LAS float* scr = (LAS float*)(F.lds + F.wave * 16384);
    const int gw = F.bid * NWAVES + F.wave, NGW = F.G * NWAVES;
    { const f32x4* x4 = (const f32x4*)INP(0); v4u* o = WSP(v4u, A_XB); const int n8 = M * D / 8;
      const int stride = F.G * NTHR;
      for (int i0 = F.bid * NTHR + F.tid; i0 < n8; i0 += 8 * stride) {
          f32x4 a[8], b[8];
#pragma unroll
          for (int q = 0; q < 8; ++q) { const int i = i0 + q * stride; if (i < n8) { a[q] = x4[2 * i]; b[q] = x4[2 * i + 1]; } }
#pragma unroll
          for (int q = 0; q < 8; ++q) { const int i = i0 + q * stride; if (i < n8) { v4u w; w.x = pk2(a[q].x, a[q].y); w.y = pk2(a[q].z, a[q].w); w.z = pk2(b[q].x, b[q].y); w.w = pk2(b[q].z, b[q].w); o[i] = w; } } } }
    {
        bf16* WIN = WSP(bf16, WS_WIN); bf16* WOUT = WSP(bf16, WS_WOUT); bf16* WGLU = WSP(bf16, WS_WGLU); bf16* WO = WSP(bf16, WS_WO);
        const TrJob jobs[8] = {
            {INP(1), INCOLS, 0, 4096, D, WIN, 0, 0, 0.f}, {INP(1), INCOLS, 4096, 48, D, WIN, 4096, 0, 0.f}, {INP(1), INCOLS, 4144, 768, D, WIN, 4352, 0, 0.f}, {INP(1), INCOLS, 4912, 2048, D, WIN, 5120, 0, 0.f},
            {INP(10), D, 0, D, SSD_IN, WOUT, 0, 0, 0.f}, {INP(22), D, 0, D, S5_W, WGLU, 0, 1, 0.f}, {INP(23), D, 0, D, S5_W, WGLU, 128, 1, 0.f}, {INP(24), D, 0, D, D, WO, 0, 0, 0.f} };
        int base = 0;
#pragma unroll
        for (int q = 0; q < 8; ++q) { const int n = tr_job_items(jobs[q]);
            int it0 = (gw - base) % NGW; if (it0 < 0) it0 += NGW;
            for (int it = it0; it < n; it += NGW) tr_job_item(jobs[q], it, scr, F.lane);
            base += n; }
    }
}
template <int WHICH> __device__ __forceinline__ void expert_convert(Frame& F, int gw, int ngw, unsigned* queue = nullptr, int it_lo = 0, int it_hi = 1 << 30) {
    LAS float* scr = (LAS float*)(F.lds + F.wave * 16384);
    constexpr int IPM = WHICH == 0 ? (D / 64) * (FF / 64) : (FF / 64) * (D / 64);
    constexpr int NIT_ALL = WHICH == 0 ? NE * 2 * IPM : NE * IPM; const int NIT = it_hi < NIT_ALL ? it_hi : NIT_ALL;
    constexpr int NBLK = WHICH == 0 ? FF / 64 : D / 64, LDW = WHICH == 0 ? FF : D, KK = WHICH == 0 ? D : FF; const float qs = WHICH == 0 ? W1_SCALE : W2_SCALE;
    const float* w1 = INP(28); const float* w3 = INP(29); const float* w2 = INP(30);
    unsigned char* W1b = F.ws + WS_W1; unsigned char* W2b = F.ws + WS_W2;
    const int lane = (int)lane_now();
    auto src_of = [&](int it, int& k0, int& n0) -> const float* { const int mtx = it / IPM, r = it % IPM; k0 = (r / NBLK) * 64; n0 = (r % NBLK) * 64;
        if (WHICH == 0) { const int e = mtx >> 1; return ((mtx & 1) ? w3 : w1) + (size_t)e * D * FF; } return w2 + (size_t)mtx * FF * D; };
    const int rfirst = F.bid * 88 + (F.wave < 4 ? F.wave : 36 + (F.wave - 4)), rend = F.bid * 88 + (F.wave < 4 ? 36 : 88);
    auto claim = [&](int prev) -> int { if (!queue) return prev < 0 ? it_lo + gw : prev + ngw;
        const int nx_ = prev < 0 ? rfirst : prev + 4; return nx_ < rend ? nx_ : NIT; };
    auto finish = [&](const f32x4 (&v)[16], int it, int k0, int n0) { const int mtx = it / IPM; bf16* dst; int drow;
        if (WHICH == 0) { dst = (bf16*)(W1b + (size_t)(mtx >> 1) * 2 * FF * D); drow = (mtx & 1) * 128 + (n0 >> 7) * 256 + (n0 & 127); } else { dst = (bf16*)(W2b + (size_t)mtx * D * FF); drow = n0; }
        tr_store(v, LDW, KK, dst, drow, scr, k0, n0, lane, qs); };
    f32x4 va[16], vb[16]; int k0a = 0, n0a = 0, k0b = 0, n0b = 0;
    int ita = claim(-1);
    if (ita < NIT) { const float* sa = src_of(ita, k0a, n0a); tr_load(sa, LDW, 0, LDW, k0a, n0a, lane, va); }
    while (ita < NIT) {
        const int itb = claim(ita);
        if (itb < NIT) { const float* sb = src_of(itb, k0b, n0b); tr_load(sb, LDW, 0, LDW, k0b, n0b, lane, vb); }
        finish(va, ita, k0a, n0a);
        if (itb >= NIT) break;
        ita = claim(itb);
        if (ita < NIT) { const float* sa = src_of(ita, k0a, n0a); tr_load(sa, LDW, 0, LDW, k0a, n0a, lane, va); }
        finish(vb, itb, k0b, n0b);
    }
}
__device__ __forceinline__ void w1_convert(Frame& F, int gw, int ngw, unsigned* queue = nullptr) { expert_convert<0>(F, gw, ngw, queue); }
__device__ __forceinline__ void w2_convert(Frame& F, int gw, int ngw, int it_lo = 0, int it_hi = 1 << 30) { expert_convert<1>(F, gw, ngw, nullptr, it_lo, it_hi); }

__device__ __forceinline__ void cmul(float ar, float ai, float br, float bi, float& cr, float& ci) { cr = ar * br - ai * bi; ci = ar * bi + ai * br; }
__device__ __forceinline__ void s5_precompute_item(Frame& F, int g, int tau) {
    LAS float* PQ = (LAS float*)(F.lds + 72 * 1024);
    LAS float* PW = PQ + 256;
    bf16* TV = WSP(bf16, WS_TV) + (size_t)g * 512 * 768; bf16* WM = WSP(bf16, WS_WS5) + (size_t)g * 256 * 512; float* AQ = WSP(float, WS_AQ);
    const int tid = F.tid;
    __syncthreads();
    { LAS float* dst = PQ + 512; const float* s0 = INP(19) + (size_t)g * 1024; const float* s1 = INP(20) + (size_t)g * 1024; const float* s2 = INP(17) + (size_t)g * 1024; const float* s3 = INP(18) + (size_t)g * 1024;
      dst[tid] = s0[tid]; dst[512 + tid] = s0[512 + tid]; dst[1024 + tid] = s1[tid]; dst[1536 + tid] = s1[512 + tid]; dst[2048 + tid] = s2[tid]; dst[2560 + tid] = s2[512 + tid]; dst[3072 + tid] = s3[tid]; dst[3584 + tid] = s3[512 + tid]; }
    if (tid < 128) {
        const int d = tid >> 6, p = tid & 63;
        const float are = (d ? INP(14) : INP(11))[g * 64 + p], aim = (d ? INP(15) : INP(12))[g * 64 + p], step = __expf((d ? INP(16) : INP(13))[g]);
        const float zr = are * step, zi = aim * step;
        const float er = expf(zr), cs = cosf(zi), sn = sinf(zi), abr = er * cs, abi = er * sn;
        const float sh = sinf(0.5f * zi), dr = expm1f(zr) * cs - 2.f * sh * sh, di = abi;
        const float den = 1.0f / (are * are + aim * aim), qr = (dr * are + di * aim) * den, qi = (di * are - dr * aim) * den;
        float pr = 1.f, pi = 0.f, br = abr, bi = abi;
#pragma unroll
        for (int bit = 0; bit < 6; ++bit) { if ((tau >> bit) & 1) { float tr_, ti_; cmul(pr, pi, br, bi, tr_, ti_); pr = tr_; pi = ti_; } float sr_, si_; cmul(br, bi, br, bi, sr_, si_); br = sr_; bi = si_; }
        float xr, xi; cmul(pr, pi, qr, qi, xr, xi);
        PQ[(d * 64 + p) * 2] = xr; PQ[(d * 64 + p) * 2 + 1] = xi; PW[(d * 64 + p) * 2] = pr; PW[(d * 64 + p) * 2 + 1] = pi;
        if (tau == 32) { AQ[((g * 2 + d) * 64 + p) * 2] = pr; AQ[((g * 2 + d) * 64 + p) * 2 + 1] = pi; }
    }
    __syncthreads();
    LAS float* cre = PQ + 512; LAS float* cim = cre + 1024; LAS float* bre = cim + 1024; LAS float* bim = bre + 1024;
    if (tid < 256 && tau < 32) {
        const int k = tid >> 4, j = tid & 15; float kf = 0.f, kb = 0.f;
        for (int p = 0; p < 64; ++p) { const float cr = cre[k * 64 + p], ci = cim[k * 64 + p], br = bre[p * 16 + j], bi = bim[p * 16 + j];
            float wr_, wi_; cmul(cr, ci, PQ[p * 2], PQ[p * 2 + 1], wr_, wi_); kf += wr_ * br - wi_ * bi;
            cmul(cr, ci, PQ[(64 + p) * 2], PQ[(64 + p) * 2 + 1], wr_, wi_); kb += wr_ * br - wi_ * bi; }
        if (tau == 0) { const bf16 v = (bf16)f2bf(kf + kb); for (int t = 0; t < 32; ++t) TV[(size_t)(t * 16 + k) * 768 + t * 16 + j] = v; }
        else { const bf16 vf = (bf16)f2bf(kf), vb = (bf16)f2bf(kb);
            for (int t = tau; t < 32; ++t) { const int s = t - tau; TV[(size_t)(t * 16 + k) * 768 + s * 16 + j] = vf; TV[(size_t)(s * 16 + k) * 768 + t * 16 + j] = vb; } }
    }
    if (tid >= 256) {
        const int q = tid - 256;
        if (tau >= 1) {
#pragma unroll 1
            for (int i = 0; i < 8; ++i) { const int e = q * 8 + i, d = e >> 10, k = (e >> 6) & 15, p = e & 63;
                float vr, vi; cmul(cre[k * 64 + p], cim[k * 64 + p], PW[(d * 64 + p) * 2], PW[(d * 64 + p) * 2 + 1], vr, vi);
                const int t = d ? 32 - tau : tau - 1; bf16* row = TV + (size_t)(t * 16 + k) * 768 + 512 + d * 128;
                row[p] = (bf16)f2bf(vr); row[64 + p] = (bf16)f2bf(-vi); } }
        if (tau < 32) {
#pragma unroll 1
            for (int i = 0; i < 8; ++i) { const int e = q * 8 + i, d = e >> 10, p = (e >> 4) & 63, j = e & 15;
                float vr, vi; cmul(PQ[(d * 64 + p) * 2], PQ[(d * 64 + p) * 2 + 1], bre[p * 16 + j], bim[p * 16 + j], vr, vi);
                const int s = d ? tau : 31 - tau; bf16* col = WM + (size_t)(d * 128 + p) * 512 + s * 16 + j;
                col[0] = (bf16)f2bf(vr); col[(size_t)64 * 512] = (bf16)f2bf(vi); } }
    }
}
__device__ __forceinline__ void s5_pre_wave(Frame& F, int g, int tau) {
    const int lane = (int)lane_now();
    LAS float* cre = (LAS float*)(F.lds + F.wave * 16384); LAS float* cim = cre + 1024; LAS float* bre = cim + 1024; LAS float* bim = bre + 1024;
    bf16* TV = WSP(bf16, WS_TV) + (size_t)g * 512 * 768; bf16* WM = WSP(bf16, WS_WS5) + (size_t)g * 256 * 512; float* AQ = WSP(float, WS_AQ);
    LDS_WAIT(); asm volatile("" ::: "memory");
    { const f32x4* s0 = (const f32x4*)(INP(19) + (size_t)g * 1024); const f32x4* s1 = (const f32x4*)(INP(20) + (size_t)g * 1024); const f32x4* s2 = (const f32x4*)(INP(17) + (size_t)g * 1024); const f32x4* s3 = (const f32x4*)(INP(18) + (size_t)g * 1024);
#pragma unroll
      for (int q = 0; q < 4; ++q) { const int i = q * 64 + lane; *(LAS f32x4*)(cre + 4 * i) = s0[i]; *(LAS f32x4*)(cim + 4 * i) = s1[i]; *(LAS f32x4*)(bre + 4 * i) = s2[i]; *(LAS f32x4*)(bim + 4 * i) = s3[i]; } }
    float Pr[2], Pi[2], Qr[2], Qi[2];
#pragma unroll
    for (int d = 0; d < 2; ++d) {
        const float are = (d ? INP(14) : INP(11))[g * 64 + lane], aim = (d ? INP(15) : INP(12))[g * 64 + lane], step = __expf((d ? INP(16) : INP(13))[g]);
        const float zr = are * step, zi = aim * step;
        const float er = expf(zr), cs = cosf(zi), sn = sinf(zi), abr = er * cs, abi = er * sn;
        const float sh = sinf(0.5f * zi), dr = expm1f(zr) * cs - 2.f * sh * sh, di = abi;
        const float den = 1.0f / (are * are + aim * aim), qr = (dr * are + di * aim) * den, qi = (di * are - dr * aim) * den;
        float pr = 1.f, pi = 0.f, br = abr, bi = abi;
#pragma unroll
        for (int bit = 0; bit < 6; ++bit) { if ((tau >> bit) & 1) { float tr_, ti_; cmul(pr, pi, br, bi, tr_, ti_); pr = tr_; pi = ti_; } float sr_, si_; cmul(br, bi, br, bi, sr_, si_); br = sr_; bi = si_; }
        Pr[d] = pr; Pi[d] = pi; cmul(pr, pi, qr, qi, Qr[d], Qi[d]);
        if (tau == 32) { AQ[((g * 2 + d) * 64 + lane) * 2] = pr; AQ[((g * 2 + d) * 64 + lane) * 2 + 1] = pi; }
    }
    LDS_WAIT(); asm volatile("" ::: "memory");
    if (tau < 32) {
        const int k = lane >> 2, j4 = (lane & 3) * 4; float kf[4] = {0.f, 0.f, 0.f, 0.f}, kb[4] = {0.f, 0.f, 0.f, 0.f};
#pragma unroll 4
        for (int p = 0; p < 64; ++p) { const float cr = cre[k * 64 + p], ci = cim[k * 64 + p]; const f32x4 br4 = *(const LAS f32x4*)(bre + p * 16 + j4), bi4 = *(const LAS f32x4*)(bim + p * 16 + j4);
            const float fr_ = __shfl(Qr[0], p), fi_ = __shfl(Qi[0], p), gr_ = __shfl(Qr[1], p), gi_ = __shfl(Qi[1], p);
            float wr_, wi_; cmul(cr, ci, fr_, fi_, wr_, wi_);
#pragma unroll
            for (int i = 0; i < 4; ++i) kf[i] += wr_ * br4[i] - wi_ * bi4[i];
            cmul(cr, ci, gr_, gi_, wr_, wi_);
#pragma unroll
            for (int i = 0; i < 4; ++i) kb[i] += wr_ * br4[i] - wi_ * bi4[i]; }
        if (tau == 0) { v2u v; v.x = pk2(kf[0] + kb[0], kf[1] + kb[1]); v.y = pk2(kf[2] + kb[2], kf[3] + kb[3]); for (int t = 0; t < 32; ++t) *(v2u*)(TV + (size_t)(t * 16 + k) * 768 + t * 16 + j4) = v; }
        else { v2u vf, vb; vf.x = pk2(kf[0], kf[1]); vf.y = pk2(kf[2], kf[3]); vb.x = pk2(kb[0], kb[1]); vb.y = pk2(kb[2], kb[3]);
            for (int t = tau; t < 32; ++t) { const int s = t - tau; *(v2u*)(TV + (size_t)(t * 16 + k) * 768 + s * 16 + j4) = vf; *(v2u*)(TV + (size_t)(s * 16 + k) * 768 + t * 16 + j4) = vb; } }
    }
    if (tau >= 1) {
#pragma unroll
        for (int d = 0; d < 2; ++d) { const int t = d ? 32 - tau : tau - 1;
#pragma unroll 4
            for (int k = 0; k < 16; ++k) { float vr, vi; cmul(cre[k * 64 + lane], cim[k * 64 + lane], Pr[d], Pi[d], vr, vi);
                bf16* row = TV + (size_t)(t * 16 + k) * 768 + 512 + d * 128; row[lane] = (bf16)f2bf(vr); row[64 + lane] = (bf16)f2bf(-vi); } }
    }
    if (tau < 32) {
        const int j = lane & 15;
#pragma unroll
        for (int d = 0; d < 2; ++d) { const int s = d ? tau : 31 - tau;
#pragma unroll 4
            for (int ps = 0; ps < 16; ++ps) { const int p = 4 * ps + (lane >> 4); const float xr = __shfl(Qr[d], p), xi = __shfl(Qi[d], p);
                float vr, vi; cmul(xr, xi, bre[p * 16 + j], bim[p * 16 + j], vr, vi);
                bf16* col = WM + (size_t)(d * 128 + p) * 512 + s * 16 + j; col[0] = (bf16)f2bf(vr); col[(size_t)64 * 512] = (bf16)f2bf(vi); } }
    }
    LDS_WAIT(); asm volatile("" ::: "memory");
}
__device__ __forceinline__ void p0_s5(Frame& F) { if (F.wave < 4) for (int it = F.bid * 4 + F.wave; it < S5_G * 33; it += F.G * 4) s5_pre_wave(F, it / 33, it % 33); }

__device__ __forceinline__ void s5_scan_item(Frame& F, int item) {
    const int d = item & 1, b = (item >> 1) & 1, g = item >> 2, tid = F.tid;
    LAS float* S = (LAS float*)F.lds;
    const float* SL = WSP(float, WS_SLOC) + ((size_t)(g * 512 + b * 256) * 256 + d * 128);
    __syncthreads();
    {   f32x4 v[16];
#pragma unroll
        for (int q = 0; q < 16; ++q) { const int i = q * NTHR + tid, ci = i >> 5, c4 = (i & 31) * 4; v[q] = *(const f32x4*)(SL + (size_t)ci * 256 + c4); }
#pragma unroll
        for (int q = 0; q < 16; ++q) { const int i = q * NTHR + tid, ci = i >> 5, c4 = (i & 31) * 4; *(LAS f32x4*)(S + ci * 128 + c4) = v[q]; } }
    __syncthreads();
    if (tid < 64) {
        const float* AQ = WSP(float, WS_AQ); const float qr = AQ[((g * 2 + d) * 64 + tid) * 2], qi = AQ[((g * 2 + d) * 64 + tid) * 2 + 1];
        float sr = 0.f, si = 0.f;
#pragma unroll 1
        for (int n0 = 0; n0 < 256; n0 += 16) {
            float tr_[16], ti_[16];
#pragma unroll
            for (int k = 0; k < 16; ++k) { const int ci = d ? 255 - (n0 + k) : n0 + k; tr_[k] = S[ci * 128 + tid]; ti_[k] = S[ci * 128 + 64 + tid]; }
#pragma unroll
            for (int k = 0; k < 16; ++k) { const int ci = d ? 255 - (n0 + k) : n0 + k; S[ci * 128 + tid] = sr; S[ci * 128 + 64 + tid] = si;
                const float nr = qr * sr - qi * si + tr_[k], ni = qr * si + qi * sr + ti_[k]; sr = nr; si = ni; }
        }
    }
    __syncthreads();
    bf16* UC = WSP(bf16, A_UC) + ((size_t)(g * 512 + b * 256) * 768 + 512 + d * 128);
#pragma unroll
    for (int q = 0; q < 8; ++q) { const int i = q * NTHR + tid, ci = i >> 4, c8 = (i & 15) * 8; const LAS float* s = S + ci * 128 + c8;
        v4u o; o.x = pk2(s[0], s[1]); o.y = pk2(s[2], s[3]); o.z = pk2(s[4], s[5]); o.w = pk2(s[6], s[7]);
        *(v4u*)(UC + (size_t)ci * 768 + c8) = o; }
}
__device__ __forceinline__ void unpack8(const v4u w, float (&f)[8]) { f[0] = bflo(w.x); f[1] = bfhi(w.x); f[2] = bflo(w.y); f[3] = bfhi(w.y); f[4] = bflo(w.z); f[5] = bfhi(w.z); f[6] = bflo(w.w); f[7] = bfhi(w.w); }
__device__ __forceinline__ void p2_conv(Frame& F) {
    const bf16* xbc = WSP(bf16, A_XBC); bf16* XT = WSP(bf16, A_XT); bf16* BT = WSP(bf16, A_BT); bf16* BN = WSP(bf16, A_BN); bf16* CN = WSP(bf16, A_CN);
    const float* cw = INP(2); const float* cb = INP(3);
    constexpr int RUN = 16, NCG = XBC / 8, NITEM = (M / RUN) * NCG;
    const int s5lo = (F.G == 256) ? 160 : F.G, NA = (F.G == 256) ? 196608 : 0;
    for (int pass = 0; pass < 2; ++pass)
    for (int item = pass == 0 ? (F.bid < s5lo ? F.bid * NTHR + F.tid : NITEM) : NA + F.bid * NTHR + F.tid; item < (pass == 0 ? NA : NITEM); item += (pass == 0 ? s5lo : F.G) * NTHR) {
        const int cg = item % NCG, r = item / NCG, ch = cg * 8, m0 = r * RUN, tb = m0 % T, bc = m0 >> 7, s0 = m0 & 127;
        float w[5][8], bias[8];
#pragma unroll
        for (int k = 0; k < 5; ++k) { const f32x4 a = *(const f32x4*)(cw + k * XBC + ch), b = *(const f32x4*)(cw + k * XBC + ch + 4); w[k][0] = a.x; w[k][1] = a.y; w[k][2] = a.z; w[k][3] = a.w; w[k][4] = b.x; w[k][5] = b.y; w[k][6] = b.z; w[k][7] = b.w; }
        { const f32x4 a = *(const f32x4*)(cb + ch), b = *(const f32x4*)(cb + ch + 4); bias[0] = a.x; bias[1] = a.y; bias[2] = a.z; bias[3] = a.w; bias[4] = b.x; bias[5] = b.y; bias[6] = b.z; bias[7] = b.w; }
        bf16* nat = nullptr; bf16* trn = nullptr; int trn_stride = 64 * 8;
        int trn_cstride = 8;
        if (ch < SSD_IN) { trn = XT + (size_t)(bc * SSD_H + (ch >> 6)) * 8192 + ((s0 >> 3) * 64 + ((ch & 63) >> 3)) * 8; trn_cstride = 64; }
        else if (ch < SSD_IN + 512) { const int cc = ch - SSD_IN; nat = BN + (size_t)m0 * 512 + cc; trn = BT + (size_t)(bc * SSD_G + (cc >> 7)) * 16384 + ((s0 >> 3) * 128 + (cc & 127)) * 8; trn_stride = 128 * 8; }
        else { nat = CN + (size_t)m0 * 512 + (ch - SSD_IN - 512); }
        v4u rows[RUN + 4];
        const bf16* src = xbc + (size_t)m0 * XBC + ch;
#pragma unroll
        for (int q = 0; q < RUN + 4; ++q) { const int tt = tb - 2 + q; const bool ok = tt >= 0 && tt < T; const int qq = ok ? q - 2 : 0; const v4u v = *(const v4u*)(src + (ptrdiff_t)qq * XBC);
            rows[q].x = ok ? v.x : 0u; rows[q].y = ok ? v.y : 0u; rows[q].z = ok ? v.z : 0u; rows[q].w = ok ? v.w : 0u; }
#pragma unroll
        for (int i8 = 0; i8 < RUN / 8; ++i8) {
            float o[8][8];
#pragma unroll
            for (int ii = 0; ii < 8; ++ii) { const int i = i8 * 8 + ii;
#pragma unroll
                for (int j = 0; j < 8; ++j) o[ii][j] = bias[j];
#pragma unroll
                for (int k = 0; k < 5; ++k) { float f[8]; unpack8(rows[i + k], f);
#pragma unroll
                    for (int j = 0; j < 8; ++j) o[ii][j] += w[k][j] * f[j]; }
#pragma unroll
                for (int j = 0; j < 8; ++j) o[ii][j] = o[ii][j] * __builtin_amdgcn_rcpf(1.0f + __expf(-o[ii][j]));
                if (nat) { v4u q; q.x = pk2(o[ii][0], o[ii][1]); q.y = pk2(o[ii][2], o[ii][3]); q.z = pk2(o[ii][4], o[ii][5]); q.w = pk2(o[ii][6], o[ii][7]); *(v4u*)(nat + (size_t)i * 512) = q; } }
            if (trn) {
#pragma unroll
                for (int j = 0; j < 8; ++j) { v4u q; q.x = pk2(o[0][j], o[1][j]); q.y = pk2(o[2][j], o[3][j]); q.z = pk2(o[4][j], o[5][j]); q.w = pk2(o[6][j], o[7][j]); *(v4u*)(trn + (size_t)i8 * trn_stride + j * trn_cstride) = q; } }
        }
    }
    {
        const int gw = F.bid * NWAVES + F.wave, NGW = F.G * NWAVES, lane = F.lane;
        const float* DT = WSP(float, A_DT); float* SV = WSP(float, A_SV); float* TOT = WSP(float, A_TOT);
        for (int it = gw; it < 128 * SSD_H * 2; it += NGW) {
            const int d = it & 1, h = (it >> 1) % SSD_H, bc = it / (2 * SSD_H);
            const float a = -__expf((d ? INP(5) : INP(4))[h]);
            const size_t mb = (size_t)bc * 128;
            const float dt0 = DT[(mb + 2 * lane) * 48 + d * 24 + h], dt1 = DT[(mb + 2 * lane + 1) * 48 + d * 24 + h];
            const float x0 = dt0 * a, x1 = dt1 * a, ps = x0 + x1;
            float inc = ps;
#pragma unroll
            for (int o = 1; o < 64; o <<= 1) { const float t_ = __shfl_up(inc, o); if (lane >= o) inc += t_; }
            const float total = __shfl(inc, 63), exc = inc - ps;
            const float ci0 = exc + x0, ci1 = inc;
            float cs0, cs1, w0, w1, f0, f1;
            if (d == 0) { cs0 = ci0; cs1 = ci1; w0 = dt0 * __expf(total - ci0); w1 = dt1 * __expf(total - ci1); f0 = __expf(ci0); f1 = __expf(ci1); }
            else { cs0 = exc; cs1 = ci0; w0 = dt0 * __expf(cs0); w1 = dt1 * __expf(cs1); f0 = __expf(total - cs0); f1 = __expf(total - cs1); }
            float* sv = SV + (size_t)it * 4 * 128 + 2 * lane;
            typedef float f32x2 __attribute__((ext_vector_type(2)));
            *(f32x2*)(sv) = (f32x2){w0, w1}; *(f32x2*)(sv + 128) = (f32x2){cs0, cs1}; *(f32x2*)(sv + 256) = (f32x2){dt0, dt1}; *(f32x2*)(sv + 384) = (f32x2){f0, f1};
            if (lane == 0) TOT[it] = __expf(total);
        }
    }
}

typedef short bf16x8 __attribute__((ext_vector_type(8)));
typedef float f32x16 __attribute__((ext_vector_type(16)));
__device__ __forceinline__ unsigned cvtpk(float lo, float hi) { return pg8::cvt_pk_bf16(lo, hi); }
__device__ __forceinline__ void ssd_state_item(Frame& F, int item) {
    unsigned z_ = 0u; asm volatile("" : "+s"(z_)); int lane = (int)__builtin_amdgcn_mbcnt_hi(~0u, __builtin_amdgcn_mbcnt_lo(~0u, z_)); asm volatile("" : "+v"(lane));
    const int nt = item & 3, u = item >> 2, h = u % SSD_H, bc = u / SSD_H, g = h / 6, b = bc >> 6, c = bc & 63, l31 = lane & 31, hf = lane >> 5;
    const bf16* XT = WSP(bf16, A_XT) + (size_t)u * 8192 + l31 * 8; const bf16* BT = WSP(bf16, A_BT) + (size_t)(bc * SSD_G + g) * 16384 + (nt * 32 + l31) * 8;
    const float* SV = WSP(float, A_SV); bf16* S = WSP(bf16, A_S);
    LAS float* wl = (LAS float*)(F.lds + F.wave * 1024);
    LDS_WAIT(); asm volatile("" ::: "memory");
#pragma unroll
    for (int d = 0; d < 2; ++d) { const float* sv = SV + (size_t)(u * 2 + d) * 4 * 128; wl[d * 128 + lane] = sv[lane]; wl[d * 128 + 64 + lane] = sv[64 + lane]; }
    LDS_WAIT(); asm volatile("" ::: "memory");
    f32x16 acc[2][2];
#pragma unroll
    for (int d = 0; d < 2; ++d)
#pragma unroll
        for (int pt = 0; pt < 2; ++pt)
#pragma unroll
            for (int r = 0; r < 16; ++r) acc[d][pt][r] = 0.f;
#pragma unroll
    for (int ks = 0; ks < 8; ++ks) {
        const int sb = ks * 16 + 8 * hf, q = 2 * ks + hf;
        const v4u a = *(const v4u*)(BT + q * 1024);
        const bf16x8 b0 = *(const bf16x8*)(XT + q * 512), b1 = *(const bf16x8*)(XT + q * 512 + 256);
        float af[8]; unpack8(a, af);
#pragma unroll
        for (int d = 0; d < 2; ++d) {
            const f32x4 w0 = *(const LAS f32x4*)(wl + d * 128 + sb), w1 = *(const LAS f32x4*)(wl + d * 128 + sb + 4);
            v4u aw; aw.x = cvtpk(af[0] * w0.x, af[1] * w0.y); aw.y = cvtpk(af[2] * w0.z, af[3] * w0.w); aw.z = cvtpk(af[4] * w1.x, af[5] * w1.y); aw.w = cvtpk(af[6] * w1.z, af[7] * w1.w);
            const bf16x8 av = __builtin_bit_cast(bf16x8, aw);
            acc[d][0] = __builtin_amdgcn_mfma_f32_32x32x16_bf16(av, b0, acc[d][0], 0, 0, 0);
            acc[d][1] = __builtin_amdgcn_mfma_f32_32x32x16_bf16(av, b1, acc[d][1], 0, 0, 0);
        }
    }
#pragma unroll
    for (int d = 0; d < 2; ++d) { bf16* So = S + ((size_t)((b * SSD_H + h) * 2 + d) * 64 + c) * 8192 + nt * 2048 + lane * 4;
#pragma unroll
        for (int pt = 0; pt < 2; ++pt)
#pragma unroll
            for (int q = 0; q < 4; ++q) { v2u o; o.x = cvtpk(acc[d][pt][4 * q], acc[d][pt][4 * q + 1]); o.y = cvtpk(acc[d][pt][4 * q + 2], acc[d][pt][4 * q + 3]);
                *(v2u*)(So + (pt * 4 + q) * 256) = o; } }
}
__device__ __forceinline__ void ssd_scan(Frame& F, int tg, int ntg, int item_lo, int item_hi) {
    bf16* S = WSP(bf16, A_S); const float* TOT = WSP(float, A_TOT);
    for (int item = item_lo + tg; item < item_hi; item += ntg) {
        const int e8 = item & 1023, bhd = item >> 10, d = bhd & 1, h = (bhd >> 1) % SSD_H, b = bhd / (2 * SSD_H);
        bf16* base = S + (size_t)bhd * 64 * 8192 + e8 * 8;
        float H[8];
#pragma unroll
        for (int j = 0; j < 8; ++j) H[j] = 0.f;
#pragma unroll 1
        for (int n0 = 0; n0 < 64; n0 += 16) {
            v4u v[16]; float dec[16];
#pragma unroll
            for (int k = 0; k < 16; ++k) { const int c = d ? 63 - (n0 + k) : n0 + k; v[k] = *(const v4u*)(base + (size_t)c * 8192); dec[k] = TOT[((b * 64 + c) * SSD_H + h) * 2 + d]; }
#pragma unroll
            for (int k = 0; k < 16; ++k) { const int c = d ? 63 - (n0 + k) : n0 + k; float f[8]; unpack8(v[k], f);
                v4u o; o.x = cvtpk(H[0], H[1]); o.y = cvtpk(H[2], H[3]); o.z = cvtpk(H[4], H[5]); o.w = cvtpk(H[6], H[7]);
                *(v4u*)(base + (size_t)c * 8192) = o;
#pragma unroll
                for (int j = 0; j < 8; ++j) H[j] = H[j] * dec[k] + f[j]; }
        }
    }
}
constexpr int PC_SVL_BYTES = 24576, PC_MAT_BYTES = 64 * 272;
__device__ __forceinline__ void pc_prefetch(v4u (&pre)[12], const bf16* XT, const bf16* S, int bc, int b, int c, int g, int i3, int tid) {
#pragma unroll
    for (int q = 0; q < 12; ++q) { const int mtx = q >> 1, hh = mtx / 3, t = mtx % 3, h = g * 6 + hh * 3 + i3, idx = (q & 1) * 512 + tid;
        const bf16* src = (t == 0) ? XT + (size_t)(bc * SSD_H + h) * 8192 + idx * 8 : S + ((size_t)((b * SSD_H + h) * 2 + (t - 1)) * 64 + c) * 8192 + idx * 8;
        pre[q] = *(const v4u*)src; }
}
__device__ __forceinline__ void ssd_out_unit(Frame& F, int unit) {
    unsigned z_ = 0u; asm volatile("" : "+s"(z_)); int lane = (int)__builtin_amdgcn_mbcnt_hi(~0u, __builtin_amdgcn_mbcnt_lo(~0u, z_)); asm volatile("" : "+v"(lane));
    int tid = F.wave * 64 + lane; asm volatile("" : "+v"(tid));
    const int g = unit & 3, bc = unit >> 2, b = bc >> 6, c = bc & 63, l31 = lane & 31, hf = lane >> 5, j = F.wave & 3, hh = F.wave >> 2;
    const size_t mb = (size_t)bc * 128;
    const bf16* CN = WSP(bf16, A_CN) + (mb + 32 * j + l31) * 512 + g * 128 + 8 * hf;
    const bf16* BN = WSP(bf16, A_BN) + (mb + l31) * 512 + g * 128 + 8 * hf;
    const float* SV = WSP(float, A_SV); const bf16* S = WSP(bf16, A_S); const bf16* XT = WSP(bf16, A_XT); bf16* Y = WSP(bf16, A_Y);
    LAS float* svl = (LAS float*)F.lds + hh * 3072;
    LAS unsigned char* mats = F.lds + PC_SVL_BYTES;
    asm volatile("" : "+v"(CN), "+v"(BN));
    __syncthreads();
    {   const f32x4* src = (const f32x4*)(SV + (size_t)((bc * SSD_H + g * 6) * 2) * 512) + tid;
#pragma unroll
        for (int q = 0; q < 3; ++q) *(LAS f32x4*)((LAS float*)F.lds + (q * 512 + tid) * 4) = src[q * 512]; }
    v4u pre[12];
    pc_prefetch(pre, XT, S, bc, b, c, g, 0, tid);
    unsigned cbp[4][8];
    {
        LAS unsigned char* tb = mats; LAS unsigned char* tc = mats + 128 * 272;
        { const bf16* bsrc = WSP(bf16, A_BN) + mb * 512 + g * 128; const bf16* csrc = WSP(bf16, A_CN) + mb * 512 + g * 128; v4u vb_[4], vc_[4];
#pragma unroll
          for (int q = 0; q < 4; ++q) { const int idx = q * 512 + tid, row = idx >> 4, ch = idx & 15; vb_[q] = *(const v4u*)(bsrc + (size_t)row * 512 + ch * 8); vc_[q] = *(const v4u*)(csrc + (size_t)row * 512 + ch * 8); }
#pragma unroll
          for (int q = 0; q < 4; ++q) { const int idx = q * 512 + tid, row = idx >> 4, ch = idx & 15; *(LAS v4u*)(tb + row * 272 + ch * 16) = vb_[q]; *(LAS v4u*)(tc + row * 272 + ch * 16) = vc_[q]; } }
        __syncthreads();
        bf16x8 cfr[8];
#pragma unroll
        for (int ks = 0; ks < 8; ++ks) cfr[ks] = *(const LAS bf16x8*)(tc + (32 * j + l31) * 272 + ks * 32 + hf * 16);
#pragma unroll
        for (int i = 0; i < 4; ++i) { f32x16 t_;
#pragma unroll
            for (int r = 0; r < 16; ++r) t_[r] = 0.f;
#pragma unroll
            for (int ks = 0; ks < 8; ++ks) { const bf16x8 a = *(const LAS bf16x8*)(tb + (32 * i + l31) * 272 + ks * 32 + hf * 16); t_ = __builtin_amdgcn_mfma_f32_32x32x16_bf16(a, cfr[ks], t_, 0, 0, 0); }
#pragma unroll
            for (int r = 0; r < 8; ++r) cbp[i][r] = cvtpk(t_[2 * r], t_[2 * r + 1]);
        }
    }
#define CBT(i_, r_) (((r_) & 1) ? bfhi(cbp[i_][(r_) >> 1]) : bflo(cbp[i_][(r_) >> 1]))
#pragma unroll 1
    for (int i3 = 0; i3 < 3; ++i3) {
        const int h = g * 6 + hh * 3 + i3;
        { int l_ = lane, t_ = tid; asm volatile("" : "+v"(l_), "+v"(t_)); lane = l_; tid = t_; }
        const int l31 = lane & 31, hf = lane >> 5, tl = 32 * j + l31;
        __syncthreads();
#pragma unroll
        for (int q = 0; q < 12; ++q) { const int mtx = q >> 1, idx = (q & 1) * 512 + tid; LAS unsigned char* mt = mats + mtx * PC_MAT_BYTES;
            if ((mtx % 3) == 0) { const int pos = idx & 63, row = (pos & 7) * 8 + (pos >> 3), ch = idx >> 6; *(LAS v4u*)(mt + row * 272 + ch * 16) = pre[q]; }
            else { const int blk = idx >> 5, c_ = idx & 31, nt_ = blk >> 3, pt_ = (blk >> 2) & 1, q_ = blk & 3, hf_ = c_ >> 4, la = (2 * c_) & 31;
                const int pa = 32 * pt_ + la, pb = pa + 1, ra = (pa & 7) * 8 + (pa >> 3), rb = (pb & 7) * 8 + (pb >> 3), cb = (32 * nt_ + 8 * q_ + 4 * hf_) * 2;
                v2u lo_; lo_.x = pre[q].x; lo_.y = pre[q].y; v2u hi_; hi_.x = pre[q].z; hi_.y = pre[q].w;
                *(LAS v2u*)(mt + ra * 272 + cb) = lo_; *(LAS v2u*)(mt + rb * 272 + cb) = hi_; } }
        __syncthreads();
        const LAS float* vf = svl + (i3 * 2 + 0) * 512 + 128; const LAS float* vb = svl + (i3 * 2 + 1) * 512 + 128;
        const float csf_t = vf[tl], sf_t = vf[256 + tl], ecsb_t = vb[tl], sb_t = vb[256 + tl], Dh = INP(8)[h];
        int tlv = tl - 4 * hf; asm volatile("" : "+v"(tlv));
        const LAS unsigned char* mx = mats + (hh * 3 + 0) * PC_MAT_BYTES + l31 * 272 + hf * 8;
        const LAS unsigned char* mf = mats + (hh * 3 + 1) * PC_MAT_BYTES + l31 * 272 + hf * 16;
        const LAS unsigned char* mbk = mats + (hh * 3 + 2) * PC_MAT_BYTES + l31 * 272 + hf * 16;
        f32x16 acc[2];
        {
            const bf16* cn = CN; asm volatile("" : "+v"(cn));
            bf16x8 cfr[8];
#pragma unroll
            for (int ks = 0; ks < 8; ++ks) cfr[ks] = *(const bf16x8*)(cn + ks * 16);
#pragma unroll
            for (int pt = 0; pt < 2; ++pt) { f32x16 af;
#pragma unroll
                for (int r = 0; r < 16; ++r) af[r] = 0.f;
#pragma unroll
                for (int ks = 0; ks < 8; ++ks) { const bf16x8 a0 = *(const LAS bf16x8*)(mf + pt * 32 * 272 + ks * 32); af = __builtin_amdgcn_mfma_f32_32x32x16_bf16(a0, cfr[ks], af, 0, 0, 0); }
#pragma unroll
                for (int r = 0; r < 16; ++r) acc[pt][r] = af[r] * sf_t;
#pragma unroll
                for (int r = 0; r < 16; ++r) af[r] = 0.f;
#pragma unroll
                for (int ks = 0; ks < 8; ++ks) { const bf16x8 a1 = *(const LAS bf16x8*)(mbk + pt * 32 * 272 + ks * 32); af = __builtin_amdgcn_mfma_f32_32x32x16_bf16(a1, cfr[ks], af, 0, 0, 0); }
#pragma unroll
                for (int r = 0; r < 16; ++r) acc[pt][r] += af[r] * sb_t; }
        }
        asm volatile("" ::: "memory");
        if (i3 < 2) pc_prefetch(pre, XT, S, bc, b, c, g, i3 + 1, tid);
#pragma unroll
        for (int i = 0; i < 4; ++i) {
#pragma unroll
            for (int k2 = 0; k2 < 2; ++k2) {
                const int sA = 32 * i + 16 * k2 + 4 * hf;
                float mv[8];
                if (i < j) {
                    const f32x4 c0 = *(const LAS f32x4*)(vf + sA), c1 = *(const LAS f32x4*)(vf + sA + 8), d0 = *(const LAS f32x4*)(vf + 128 + sA), d1 = *(const LAS f32x4*)(vf + 128 + sA + 8);
#pragma unroll
                    for (int e = 0; e < 4; ++e) { mv[e] = CBT(i, 8 * k2 + e) * (d0[e] * __expf(csf_t - c0[e])); mv[4 + e] = CBT(i, 8 * k2 + 4 + e) * (d1[e] * __expf(csf_t - c1[e])); }
                } else if (i > j) {
                    const f32x4 c0 = *(const LAS f32x4*)(vb + sA), c1 = *(const LAS f32x4*)(vb + sA + 8), d0 = *(const LAS f32x4*)(vb + 128 + sA), d1 = *(const LAS f32x4*)(vb + 128 + sA + 8);
#pragma unroll
                    for (int e = 0; e < 4; ++e) { mv[e] = CBT(i, 8 * k2 + e) * (d0[e] * __expf(c0[e] - ecsb_t)); mv[4 + e] = CBT(i, 8 * k2 + 4 + e) * (d1[e] * __expf(c1[e] - ecsb_t)); }
                } else {
                    const f32x4 c0 = *(const LAS f32x4*)(vf + sA), c1 = *(const LAS f32x4*)(vf + sA + 8), d0 = *(const LAS f32x4*)(vf + 128 + sA), d1 = *(const LAS f32x4*)(vf + 128 + sA + 8);
                    const f32x4 g0 = *(const LAS f32x4*)(vb + sA), g1 = *(const LAS f32x4*)(vb + sA + 8), h0 = *(const LAS f32x4*)(vb + 128 + sA), h1 = *(const LAS f32x4*)(vb + 128 + sA + 8);
#pragma unroll
                    for (int e = 0; e < 8; ++e) { const int s_ = 32 * i + 16 * k2 + (e & 3) + 8 * (e >> 2); const float cf = e < 4 ? c0[e & 3] : c1[e & 3], df = e < 4 ? d0[e & 3] : d1[e & 3], cb_ = e < 4 ? g0[e & 3] : g1[e & 3], db = e < 4 ? h0[e & 3] : h1[e & 3];
                        float f = 0.f;
                        f += (s_ <= tlv) ? df * __expf(fminf(csf_t - cf, 0.f)) : 0.f;
                        f += (s_ >= tlv) ? db * __expf(fminf(cb_ - ecsb_t, 0.f)) : 0.f;
                        mv[e] = CBT(i, 8 * k2 + e) * f + ((s_ == tlv) ? Dh : 0.f); }
                }
                v4u mw; mw.x = cvtpk(mv[0], mv[1]); mw.y = cvtpk(mv[2], mv[3]); mw.z = cvtpk(mv[4], mv[5]); mw.w = cvtpk(mv[6], mv[7]);
                const bf16x8 mfr = __builtin_bit_cast(bf16x8, mw);
#pragma unroll
                for (int pt = 0; pt < 2; ++pt) { const v2u x0 = *(const LAS v2u*)(mx + pt * 32 * 272 + 64 * i + 32 * k2), x1 = *(const LAS v2u*)(mx + pt * 32 * 272 + 64 * i + 32 * k2 + 16);
                    v4u xw; xw.x = x0.x; xw.y = x0.y; xw.z = x1.x; xw.w = x1.y;
                    acc[pt] = __builtin_amdgcn_mfma_f32_32x32x16_bf16(__builtin_bit_cast(bf16x8, xw), mfr, acc[pt], 0, 0, 0); }
                asm volatile("" ::: "memory");
            }
        }
        bf16* yo = Y + (mb + tl) * SSD_IN + h * 64 + 4 * hf;
        asm volatile("" : "+v"(yo));
#pragma unroll
        for (int pt = 0; pt < 2; ++pt)
#pragma unroll
            for (int q = 0; q < 4; ++q) { v2u o; o.x = cvtpk(acc[pt][4 * q], acc[pt][4 * q + 1]); o.y = cvtpk(acc[pt][4 * q + 2], acc[pt][4 * q + 3]); *(v2u*)(yo + 32 * pt + 8 * q) = o; }
    }
}

#undef CBT
__device__ __forceinline__ void ssd_norm_unit(Frame& F, int unit) {
    const int g = unit & 3, bc = unit >> 2; const int lane = (int)lane_now(), tq = lane >> 4, j16 = lane & 15;
    const size_t rowbase = ((size_t)bc * 128 + F.wave * 16 + tq) * SSD_IN + g * 384 + j16 * 8;
    bf16* Y = WSP(bf16, A_Y) + rowbase; const bf16* Z = WSP(bf16, A_Z) + rowbase; const float* ng = INP(9) + g * 384 + j16 * 8;
    v4u yv[12], zv[12];
#pragma unroll
    for (int r = 0; r < 4; ++r)
#pragma unroll
        for (int i = 0; i < 3; ++i) zv[r * 3 + i] = *(const v4u*)(Z + (size_t)(4 * r) * SSD_IN + 128 * i);
    asm volatile("s_waitcnt vmcnt(0)" ::: "memory"); __syncthreads();
#pragma unroll
    for (int r = 0; r < 4; ++r)
#pragma unroll
        for (int i = 0; i < 3; ++i) yv[r * 3 + i] = *(const v4u*)(Y + (size_t)(4 * r) * SSD_IN + 128 * i);
    f32x4 g0[3], g1[3];
#pragma unroll
    for (int i = 0; i < 3; ++i) { g0[i] = *(const f32x4*)(ng + 128 * i); g1[i] = *(const f32x4*)(ng + 128 * i + 4); }
#pragma unroll
    for (int r = 0; r < 4; ++r) { float ss = 0.f;
#pragma unroll
        for (int i = 0; i < 3; ++i) { float a[8], z[8]; unpack8(yv[r * 3 + i], a); unpack8(zv[r * 3 + i], z);
#pragma unroll
            for (int jj = 0; jj < 8; ++jj) { a[jj] *= z[jj]; ss += a[jj] * a[jj]; }
            yv[r * 3 + i].x = pk2(a[0], a[1]); yv[r * 3 + i].y = pk2(a[2], a[3]); yv[r * 3 + i].z = pk2(a[4], a[5]); yv[r * 3 + i].w = pk2(a[6], a[7]); }
        ss += __shfl_xor(ss, 1); ss += __shfl_xor(ss, 2); ss += __shfl_xor(ss, 4); ss += __shfl_xor(ss, 8);
        const float rn = 1.0f / sqrtf(ss * (1.0f / 384.0f) + RMS_EPS);
#pragma unroll
        for (int i = 0; i < 3; ++i) { float a[8]; unpack8(yv[r * 3 + i], a);
            v4u o; o.x = pk2(a[0] * rn * g0[i].x, a[1] * rn * g0[i].y); o.y = pk2(a[2] * rn * g0[i].z, a[3] * rn * g0[i].w); o.z = pk2(a[4] * rn * g1[i].x, a[5] * rn * g1[i].y); o.w = pk2(a[6] * rn * g1[i].z, a[7] * rn * g1[i].w);
            *(v4u*)(Y + (size_t)(4 * r) * SSD_IN + 128 * i) = o; } }
}

__device__ __forceinline__ void p8_ln_router(Frame& F) {
    const int gw = F.bid * NWAVES + F.wave, NGW = F.G * NWAVES, lane = F.lane;
    LAS float* wr = (LAS float*)F.lds;
    constexpr int WRP = D + 4;
    for (int i = F.tid; i < D * NE; i += NTHR) wr[(i & 15) * WRP + (i >> 4)] = INP(27)[i];
    __syncthreads();
    const float* HP = WSP(float, A_HP); float* ST = WSP(float, A_ST); unsigned char* H8 = F.ws + A_H8; float* AFF = WSP(float, A_AFF);
    const float* g1 = INP(25); const float* b1 = INP(26);
    f32x4 nx[4];
#pragma unroll
    for (int j = 0; j < 4; ++j) nx[j] = *((const f32x4*)(HP + (size_t)(gw < M ? gw : 0) * D) + lane + 64 * j);
    for (int m = gw; m < M; m += NGW) {
        f32x4 v[4]; float s = 0.f;
#pragma unroll
        for (int j = 0; j < 4; ++j) { v[j] = nx[j]; s += (v[j].x + v[j].y) + (v[j].z + v[j].w); }
        { const int mn = (m + NGW < M) ? m + NGW : m;
#pragma unroll
          for (int j = 0; j < 4; ++j) nx[j] = *((const f32x4*)(HP + (size_t)mn * D) + lane + 64 * j); }
        const float mean = wave_sum(s) * (1.f / D); float s2 = 0.f;
#pragma unroll
        for (int j = 0; j < 4; ++j) { v[j] = v[j] - mean; s2 += (v[j].x * v[j].x + v[j].y * v[j].y) + (v[j].z * v[j].z + v[j].w * v[j].w); }
        const float rstd = 1.f / sqrtf(wave_sum(s2) * (1.f / D) + LN_EPS);
        if (lane == 0) { typedef float f32x2_ __attribute__((ext_vector_type(2))); *(f32x2_*)(ST + 2 * (size_t)m) = (f32x2_){mean, rstd}; }
        float lg[16];
#pragma unroll
        for (int e = 0; e < 16; ++e) lg[e] = 0.f;
#pragma unroll
        for (int j = 0; j < 4; ++j) { const int c = 4 * lane + 256 * j; const f32x4 gg = *(const f32x4*)(g1 + c), bb = *(const f32x4*)(b1 + c);
            v[j] = v[j] * rstd * gg + bb;
            *((unsigned*)(H8 + (size_t)m * D) + lane + 64 * j) = pk4_fp8(v[j].x, v[j].y, v[j].z, v[j].w);
#pragma unroll
            for (int e = 0; e < 16; ++e) { const f32x4 w4 = *(const LAS f32x4*)(wr + e * WRP + c); lg[e] += (v[j].x * w4.x + v[j].y * w4.y) + (v[j].z * w4.z + v[j].w * w4.w); }
            asm volatile("" ::: "memory"); }
        { const bool hi = lane & 32;
#pragma unroll
          for (int k = 0; k < 8; ++k) { const float keep = hi ? lg[k + 8] : lg[k], send = hi ? lg[k] : lg[k + 8]; lg[k] = keep + __shfl_xor(send, 32); } }
        { const bool hi = lane & 16;
#pragma unroll
          for (int k = 0; k < 4; ++k) { const float keep = hi ? lg[k + 4] : lg[k], send = hi ? lg[k] : lg[k + 4]; lg[k] = keep + __shfl_xor(send, 16); } }
        { const bool hi = lane & 8;
#pragma unroll
          for (int k = 0; k < 2; ++k) { const float keep = hi ? lg[k + 2] : lg[k], send = hi ? lg[k] : lg[k + 2]; lg[k] = keep + __shfl_xor(send, 8); } }
        { const bool hi = lane & 4; const float keep = hi ? lg[1] : lg[0], send = hi ? lg[0] : lg[1]; lg[0] = keep + __shfl_xor(send, 4); }
        float lo = lg[0]; lo += __shfl_xor(lo, 2); lo += __shfl_xor(lo, 1);
        float mx = lo;
#pragma unroll
        for (int o = 4; o < 64; o <<= 1) mx = fmaxf(mx, __shfl_xor(mx, o));
        const float ex = expf(lo - mx); float sum = ex;
#pragma unroll
        for (int o = 4; o < 64; o <<= 1) sum += __shfl_xor(sum, o);
        if ((lane & 3) == 0) { const int e = lane >> 2, b = m / T, t = m % T; AFF[((size_t)b * NE + e) * T + t] = ex / sum; }
    }
}

__device__ __forceinline__ unsigned block_excl_scan(unsigned v, LAS unsigned* wsum  , int lane, int wave, unsigned& total) {
    unsigned inc = v;
#pragma unroll
    for (int o = 1; o < 64; o <<= 1) { const unsigned t = __shfl_up(inc, o); if (lane >= o) inc += t; }
    __syncthreads();
    if (lane == 63) wsum[wave] = inc;
    __syncthreads();
    unsigned off = 0, tot = 0;
#pragma unroll
    for (int w = 0; w < 8; ++w) { const unsigned s = wsum[w]; if (w < wave) off += s; tot += s; }
    total = tot; return off + inc - v;
}
__device__ __forceinline__ void p9_topk(Frame& F, int be) {
    const int b = be >> 4, e = be & 15, tid = F.tid;
    const float* av = WSP(float, A_AFF) + (size_t)be * T;
    int* IDX = WSP(int, A_IDX); int* SEL = WSP(int, A_SEL); float* GATE = WSP(float, A_GATE);
    LAS unsigned* hist = (LAS unsigned*)F.lds; LAS unsigned* shv = hist + 256; LAS unsigned* wsum = hist + 272;
    unsigned key[16];
#pragma unroll
    for (int q = 0; q < 4; ++q) { const v4u k4 = *(const v4u*)(av + tid * 16 + 4 * q); key[4 * q] = k4.x; key[4 * q + 1] = k4.y; key[4 * q + 2] = k4.z; key[4 * q + 3] = k4.w; }
    unsigned lo = 0u, hi_ex = 0u;
    bool hi_set = false;
    for (int it = 0; it < 32; ++it) {
        const unsigned span = (hi_set ? hi_ex : 0u) - lo;
        const unsigned mid = lo + (span >> 1) + ((span == 0u && !hi_set) ? 0x80000000u : 0u);
        unsigned cnt = 0;
#pragma unroll
        for (int i = 0; i < 16; ++i) cnt += (unsigned)__builtin_popcountll(__ballot(key[i] >= mid));
        LAS unsigned* slot_ = wsum + 16 + (it & 1) * 8;
        if (F.lane == 0) slot_[F.wave] = cnt;
        __syncthreads();
        unsigned tot = 0;
#pragma unroll
        for (int w = 0; w < 8; ++w) tot += slot_[w];
        if (tot >= (unsigned)CAP) lo = mid; else { hi_ex = mid; hi_set = true; }
    }
    const unsigned Tk = lo;
    unsigned krem;
    { unsigned cnt = 0;
#pragma unroll
      for (int i = 0; i < 16; ++i) cnt += (unsigned)__builtin_popcountll(__ballot(key[i] > Tk));
      __syncthreads(); if (F.lane == 0) wsum[16 + F.wave] = cnt; __syncthreads();
      unsigned tot = 0;
#pragma unroll
      for (int w = 0; w < 8; ++w) tot += wsum[16 + w];
      krem = (unsigned)CAP - tot; __syncthreads(); }
    unsigned cg = 0, ce = 0;
#pragma unroll
    for (int i = 0; i < 16; ++i) { cg += key[i] > Tk; ce += key[i] == Tk; }
    unsigned totg, tote;
    unsigned pg = block_excl_scan(cg, wsum, F.lane, F.wave, totg);
    unsigned pe = block_excl_scan(ce, wsum + 8, F.lane, F.wave, tote);
#pragma unroll
    for (int i = 0; i < 16; ++i) {
        const int t = tid * 16 + i; int slot = -1;
        if (key[i] > Tk) slot = (int)(pg++);
        else if (key[i] == Tk) { if (pe < krem) slot = (int)(totg + pe); ++pe; }
        const size_t m = (size_t)b * T + t;
        SEL[m * NE + e] = slot; GATE[m * NE + e] = __uint_as_float(key[i]);
        if (slot >= 0) IDX[(e * NB + b) * CAP + slot] = (int)m;
    }
    __builtin_amdgcn_fence(__ATOMIC_RELEASE, "agent"); asm volatile("s_waitcnt vmcnt(0)" ::: "memory"); __syncthreads();
    if (tid == 0) __hip_atomic_store((unsigned*)(F.ws + WS_CTL) + CW_LIST + 64 * be, 1u, __ATOMIC_RELAXED, __HIP_MEMORY_SCOPE_AGENT);
}
__device__ __forceinline__ void gather_rows_after(Frame& F, int r0, int nrows) {
    const int li = r0 >> 10, e = li >> 1, b = li & 1, be = b * 16 + e;
    if (F.wave == 0) { unsigned* flag = (unsigned*)(F.ws + WS_CTL) + CW_LIST + 64 * be; unsigned spins = 0;
        while (__builtin_amdgcn_readfirstlane(__hip_atomic_load(flag, __ATOMIC_RELAXED, __HIP_MEMORY_SCOPE_AGENT)) == 0u) { __builtin_amdgcn_s_sleep(2); if (++spins > (1u << 22)) break; }
        __builtin_amdgcn_fence(__ATOMIC_ACQUIRE, "agent"); asm volatile("s_waitcnt vmcnt(0)" ::: "memory"); }
    __syncthreads();
    const int* IDX = WSP(int, A_IDX); const unsigned char* H8 = F.ws + A_H8; unsigned char* XIN = F.ws + A_XIN; const int lane = F.lane;
    for (int rr = F.wave; rr < nrows; rr += 8 * NWAVES) {
        v4u va[8];
#pragma unroll
        for (int q = 0; q < 8; ++q) { const int ri = rr + q * NWAVES < nrows ? rr + q * NWAVES : rr; const int m_ = IDX[r0 + ri]; va[q] = *((const v4u*)(H8 + (size_t)m_ * D) + lane); }
#pragma unroll
        for (int q = 0; q < 8; ++q) if (rr + q * NWAVES < nrows) *((v4u*)(XIN + (size_t)(r0 + rr + q * NWAVES) * D) + lane) = va[q];
    }
}
__device__ __forceinline__ void moe_accumulate(f32x4 (&v)[4], int sl, float gt, int b, const bf16* YE, int lane) {
    unsigned mask = (unsigned)(__ballot(sl >= 0) & 0xffffull);
    while (mask) {
        int e[4]; float gv[4]; const bf16* yr[4];
#pragma unroll
        for (int k = 0; k < 4; ++k) { const bool ok = mask != 0u; const int ek = ok ? __builtin_ctz(mask) : e[k > 0 ? k - 1 : 0]; if (ok) mask &= mask - 1u; e[k] = ek;
            const int s = __shfl(sl, ek); gv[k] = ok ? __shfl(gt, ek) : 0.f; yr[k] = YE + ((size_t)(ek * NB + b) * CAP + (s < 0 ? 0 : s)) * D; }
        v2u w[4][4];
#pragma unroll
        for (int k = 0; k < 4; ++k)
#pragma unroll
            for (int j = 0; j < 4; ++j) w[k][j] = *((const v2u*)yr[k] + lane + 64 * j);
#pragma unroll
        for (int k = 0; k < 4; ++k)
#pragma unroll
            for (int j = 0; j < 4; ++j) { v[j].x += gv[k] * bflo(w[k][j].x); v[j].y += gv[k] * bfhi(w[k][j].x); v[j].z += gv[k] * bflo(w[k][j].y); v[j].w += gv[k] * bfhi(w[k][j].y); }
    }
}
__device__ __forceinline__ void ln_row_store(f32x4 (&v)[4], const float* g2, const float* b2, float* orow, int lane) {
    float s = 0.f;
#pragma unroll
    for (int j = 0; j < 4; ++j) s += (v[j].x + v[j].y) + (v[j].z + v[j].w);
    const float mean = wave_sum(s) * (1.f / D); float s2 = 0.f;
#pragma unroll
    for (int j = 0; j < 4; ++j) { v[j] = v[j] - mean; s2 += (v[j].x * v[j].x + v[j].y * v[j].y) + (v[j].z * v[j].z + v[j].w * v[j].w); }
    const float rstd = 1.f / sqrtf(wave_sum(s2) * (1.f / D) + LN_EPS);
#pragma unroll
    for (int j = 0; j < 4; ++j) { const int c = 4 * lane + 256 * j; const f32x4 gg = *(const f32x4*)(g2 + c), bb = *(const f32x4*)(b2 + c);
        *((f32x4*)orow + lane + 64 * j) = v[j] * rstd * gg + bb; }
}
__device__ __forceinline__ void p13_final(Frame& F) {
    const int gw = F.bid * NWAVES + F.wave, NGW = F.G * NWAVES, lane = F.lane;
    const float* HP = WSP(float, A_HP); const float* ST = WSP(float, A_ST); const float* g1 = INP(25); const float* b1 = INP(26); const int* SEL = WSP(int, A_SEL); const float* GATE = WSP(float, A_GATE); const bf16* YE = WSP(bf16, A_YE);
    const float* g2 = INP(31); const float* b2 = INP(32);
    for (int m = gw; m < M; m += 2 * NGW) {
        const int mB = (m + NGW < M) ? m + NGW : m;
        const int slA = SEL[(size_t)m * NE + (lane & 15)], slB = SEL[(size_t)mB * NE + (lane & 15)]; const float gtA = GATE[(size_t)m * NE + (lane & 15)], gtB = GATE[(size_t)mB * NE + (lane & 15)];
        typedef float f32x2_ __attribute__((ext_vector_type(2))); const f32x2_ stA = *(const f32x2_*)(ST + 2 * (size_t)m), stB = *(const f32x2_*)(ST + 2 * (size_t)mB);
        f32x4 vA[4], vB[4];
#pragma unroll
        for (int j = 0; j < 4; ++j) { const int c = 4 * lane + 256 * j; const f32x4 gg = *(const f32x4*)(g1 + c) * ALPHA, bb = *(const f32x4*)(b1 + c) * ALPHA;
            vA[j] = (*((const f32x4*)(HP + (size_t)m * D) + lane + 64 * j) - stA.x) * stA.y * gg + bb; vB[j] = (*((const f32x4*)(HP + (size_t)mB * D) + lane + 64 * j) - stB.x) * stB.y * gg + bb; }
        moe_accumulate(vA, slA, gtA, m / T, YE, lane); moe_accumulate(vB, slB, gtB, mB / T, YE, lane);
        ln_row_store(vA, g2, b2, F.out + (size_t)m * D, lane);
        if (mB != m) ln_row_store(vB, g2, b2, F.out + (size_t)mB * D, lane);
    }
}

constexpr int N_PHASES = 16;
struct Args { const float* in[33]; float* out; unsigned char* ws; int ph_lo, ph_hi; };
__global__ void __launch_bounds__(NTHR, 2) fwd(Args args) {
    extern __shared__ __attribute__((aligned(16))) unsigned char lds[];
    Frame F;
    F.lds = (LAS unsigned char*)lds;
    F.tid = threadIdx.x; F.lane = F.tid & 63; F.wave = __builtin_amdgcn_readfirstlane(F.tid >> 6);
    F.bid = blockIdx.x; F.G = gridDim.x;
    F.ptab = (LAS unsigned*)(F.lds + MISC_OFF + 512);
    if (F.tid < 33) { const unsigned long long p_ = (unsigned long long)args.in[F.tid]; F.ptab[2 * F.tid] = (unsigned)p_; F.ptab[2 * F.tid + 1] = (unsigned)(p_ >> 32); }
    F.out = args.out; F.ws = args.ws;
    volatile LAS unsigned* MISC = (volatile LAS unsigned*)(F.lds + MISC_OFF);
    if (F.tid < 64) MISC[F.tid] = 0u;
    __syncthreads();
    const int lo = args.ph_lo, hi = args.ph_hi;
    const bool single = (hi - lo) > 1;
    XcdBarrier bar; bar.bar = (unsigned*)(F.ws + WS_CTL) + CW_BAR; bar.x = 0; bar.st = nullptr;
    if (single) bar = xcd_barrier_post((unsigned*)(F.ws + WS_CTL) + CW_BAR, MISC + 8);
#ifndef PH_MASK
#define PH_MASK 0xffff
#endif
#define IN(k) (((PH_MASK >> (k)) & 1) && lo <= (k) && (k) < hi)
#define LAUNDER1(T_, p_) do { unsigned long long x_ = (unsigned long long)(p_); unsigned lo_ = (unsigned)x_, hi_ = (unsigned)(x_ >> 32); asm volatile("" : "+v"(lo_), "+v"(hi_)); \
        lo_ = __builtin_amdgcn_readfirstlane(lo_); hi_ = __builtin_amdgcn_readfirstlane(hi_); (p_) = (T_)(((unsigned long long)hi_ << 32) | lo_); } while (0)
#define LAUNDER() do { F.lane = (int)lane_now(); F.tid = F.wave * 64 + F.lane; } while (0)
#define SEAM(k) do { if (IN(k) && IN((k) + 1)) xcd_barrier(bar, T0()); } while (0)

#define T0() (F.wave == 0 && lane_now() == 0u)

    if (IN(0)) { LAUNDER(); p0_s5(F); p0_prologue(F); w1_convert(F, F.bid * NWAVES + F.wave, F.G * NWAVES, F.G == 256 ? (unsigned*)(F.ws + WS_CTL) + CW_QW1 : nullptr); } SEAM(0);
    if (IN(1)) { LAUNDER();
        pg8::Gemm g{WSP(pg8::bf16_t, A_XB), WSP(pg8::bf16_t, WS_WIN), M, NIN_PAD, D, D, D}; pg8::StaticOrder S; S.init(M, NIN_PAD, F.G, F.bid);
        pg8::EpiIn E{WSP(pg8::bf16_t, A_Z), WSP(pg8::bf16_t, A_XBC), WSP(pg8::bf16_t, A_UC), WSP(pg8::bf16_t, A_GT), WSP(float, A_DT), INP(6), INP(7)};
        pg8::gemm_phase<pg8::EpiIn, pg8::StaticOrder, PG8_ALIGN, PG8_SP2>(F.lds, g, S, E, F.tid);
    } SEAM(1);
    if (IN(2)) { LAUNDER();

        if (F.bid >= 160) { pg8::Gemm g{WSP(pg8::bf16_t, A_UC), WSP(pg8::bf16_t, WS_WS5), S5_G * 512, S5_G * 256, 512, 768, 512}; pg8::S5aOrder S{F.bid, 160};
            pg8::EpiS5a E{WSP(float, WS_SLOC)};
            pg8::gemm_phase<pg8::EpiS5a, pg8::S5aOrder, PG8_ALIGN, PG8_SP2>(F.lds, g, S, E, F.tid); __syncthreads(); }

        p2_conv(F);
        __syncthreads();
    } SEAM(2);
    if (IN(3)) { LAUNDER();
        for (int it = F.bid; it < S5_G * 4; it += F.G) s5_scan_item(F, it);
        __syncthreads();
        for (int it = F.bid * NWAVES + F.wave; it < 128 * SSD_H * 4; it += F.G * NWAVES) ssd_state_item(F, it);
    } SEAM(3);
    if (IN(4)) { LAUNDER();
        { pg8::Gemm g{WSP(pg8::bf16_t, A_UC), WSP(pg8::bf16_t, WS_TV), S5_G * 512, S5_G * 512, 768, 768, 768}; pg8::S5cOrder S{F.G, F.bid};
          pg8::EpiS5c E{WSP(pg8::bf16_t, A_GY), WSP(pg8::bf16_t, A_UC), INP(21)};
          pg8::gemm_phase<pg8::EpiS5c, pg8::S5cOrder, PG8_ALIGN, PG8_SP2>(F.lds, g, S, E, F.tid); }

        if (F.G == 256) { if (F.bid >= 192) ssd_scan(F, (F.bid - 192) * NTHR + F.tid, 64 * NTHR, 0, 65536); else if (F.bid < 64) ssd_scan(F, F.bid * NTHR + F.tid, 64 * NTHR, 65536, 96 * 1024); }
        else ssd_scan(F, F.bid * NTHR + F.tid, F.G * NTHR, 0, 96 * 1024);
    } SEAM(4);
    if (IN(5)) { LAUNDER(); __syncthreads();
        for (int u = F.bid; u < 128 * SSD_G; u += F.G) { ssd_out_unit(F, u); ssd_norm_unit(F, u); }
        __syncthreads();
        { pg8::Gemm g{WSP(pg8::bf16_t, A_GY), WSP(pg8::bf16_t, WS_WGLU), M, 2 * D, S5_W, S5_W, S5_W}; pg8::StaticOrder S; S.init(M, 2 * D, F.G, F.bid);
          pg8::EpiGlu E{WSP(pg8::bf16_t, A_YB), WSP(pg8::bf16_t, A_GT)};
          pg8::gemm_phase<pg8::EpiGlu, pg8::StaticOrder, PG8_ALIGN, PG8_SP2>(F.lds, g, S, E, F.tid); }
    } SEAM(5);
    if (IN(7)) { LAUNDER();
        pg8::Gemm g{WSP(pg8::bf16_t, A_Y), WSP(pg8::bf16_t, WS_WOUT), M, D, SSD_IN, SSD_IN, SSD_IN}; pg8::StaticOrder S; S.init(M, D, F.G, F.bid);
        pg8::EpiSsdOut E{WSP(pg8::bf16_t, A_MIX), WSP(pg8::bf16_t, A_YB), WSP(pg8::bf16_t, A_GT)};
        pg8::gemm_phase<pg8::EpiSsdOut, pg8::StaticOrder, PG8_ALIGN, PG8_SP2>(F.lds, g, S, E, F.tid);
    } SEAM(7);
    if (IN(9)) { LAUNDER();
        pg8::Gemm g{WSP(pg8::bf16_t, A_MIX), WSP(pg8::bf16_t, WS_WO), M, D, D, D, D}; pg8::StaticOrder S; S.init(M, D, F.G, F.bid);
        pg8::EpiWo E{WSP(float, A_HP), INP(0), ALPHA};
        pg8::gemm_phase<pg8::EpiWo, pg8::StaticOrder, PG8_ALIGN, PG8_SP2>(F.lds, g, S, E, F.tid);
    } SEAM(9);
    if (IN(10)) { LAUNDER(); p8_ln_router(F); } SEAM(10);
    if (IN(11)) { LAUNDER();
        if (F.bid < NB * NE) { p9_topk(F, F.bid); __syncthreads(); w2_convert(F, F.bid * NWAVES + F.wave, NB * NE * NWAVES, 0, 1280); }
        else w2_convert(F, (F.bid - NB * NE) * NWAVES + F.wave, (F.G - NB * NE) * NWAVES, 1280);
        __syncthreads();
        for (int r0 = F.bid * (MROWS / 256); r0 < MROWS; r0 += F.G * (MROWS / 256)) gather_rows_after(F, r0, MROWS / 256); __syncthreads(); } SEAM(11);

    if (IN(13)) { LAUNDER();
        pg8::Gemm g{WSP(pg8::bf16_t, A_XIN), WSP(pg8::bf16_t, WS_W1), MROWS, NE * 2 * FF, D, D, D}; pg8::MoeOrder1 S{F.G, F.bid};
        pg8::EpiMoe1 E{F.ws + A_HID, 1.0f / W1_SCALE, HID_SCALE};
        pg8::gemm_phase<pg8::EpiMoe1, pg8::MoeOrder1, PG8_ALIGN, PG8_SP2, true>(F.lds, g, S, E, F.tid);
    } SEAM(13);
    if (IN(14)) { LAUNDER();
        pg8::Gemm g{WSP(pg8::bf16_t, A_HID), WSP(pg8::bf16_t, WS_W2), MROWS, NE * D, FF, FF, FF}; pg8::MoeOrder2 S{F.G, F.bid};
        pg8::EpiMoe2 E{WSP(pg8::bf16_t, A_YE), 1.0f / (W2_SCALE * HID_SCALE)};
        pg8::gemm_phase<pg8::EpiMoe2, pg8::MoeOrder2, PG8_ALIGN, PG8_SP2, true>(F.lds, g, S, E, F.tid);
    } SEAM(14);
    if (IN(15)) { LAUNDER(); p13_final(F); }
#undef IN
#undef SEAM
}

#ifndef MK_ONE_LAUNCH
#define MK_ONE_LAUNCH 1
#endif
extern "C" void kernel_launch(void* const* d_in, const int* in_sizes, int n_in, void* d_out, int out_size, void* d_ws, size_t ws_size, hipStream_t stream) {
    static int grid = 0;
    if (grid == 0) {
        if (n_in != 33 || in_sizes[0] != M * D || out_size != M * D || ws_size < WS_END) { fprintf(stderr, "kernel_launch: unexpected problem (n_in %d, in0 %d, out %d, ws %zu < %zu)\n", n_in, n_in > 0 ? in_sizes[0] : -1, out_size, ws_size, (size_t)WS_END); grid = -1; return; }
        int dev = 0, cus = 0, per_cu = 0;
        if (hipGetDevice(&dev) != hipSuccess || hipDeviceGetAttribute(&cus, hipDeviceAttributeMultiprocessorCount, dev) != hipSuccess) { grid = -1; return; }
        if (hipFuncSetAttribute((const void*)fwd, hipFuncAttributeMaxDynamicSharedMemorySize, LDS_BYTES) != hipSuccess) { fprintf(stderr, "kernel_launch: hipFuncSetAttribute failed\n"); grid = -1; return; }
        if (hipOccupancyMaxActiveBlocksPerMultiprocessor(&per_cu, (const void*)fwd, NTHR, LDS_BYTES) != hipSuccess || per_cu < 1) fprintf(stderr, "kernel_launch: occupancy query reports %d blocks per CU\n", per_cu);
        (void)hipGetLastError();
        grid = cus;
    }
    if (grid < 0) return;
    (void)hipMemsetAsync((char*)d_ws + WS_CTL, 0, CTL_ZERO_BYTES, stream);
    Args a{};
    for (int i = 0; i < 33; ++i) a.in[i] = (const float*)d_in[i];
    a.out = (float*)d_out; a.ws = (unsigned char*)d_ws;
#if MK_ONE_LAUNCH
    a.ph_lo = 0; a.ph_hi = N_PHASES;
    hipLaunchKernelGGL(fwd, dim3(grid), dim3(NTHR), LDS_BYTES, stream, a);
#else
    for (int p = 0; p < N_PHASES; ++p) { a.ph_lo = p; a.ph_hi = p + 1; hipLaunchKernelGGL(fwd, dim3(grid), dim3(NTHR), LDS_BYTES, stream, a); }
#endif
}
```

```cpp
#include <hip/hip_runtime.h>
#include <cstdio>
#include <cstdint>
namespace pg8 {
#define PG8_LAS __attribute__((address_space(3)))
typedef unsigned short bf16_t;
typedef short bf16x8 __attribute__((ext_vector_type(8)));
typedef float f32x4 __attribute__((ext_vector_type(4)));
typedef unsigned u32x4 __attribute__((ext_vector_type(4)));
typedef int i32x8 __attribute__((ext_vector_type(8)));
constexpr int BM = 256, BK = 64, HALF = 128, HTB = HALF * BK * 2  , STAGE_BYTES = 8 * HTB, NXCD = 8, WGM = 8;

__host__ __device__ __forceinline__ int lds_byte(int r, int c) { const int st = (r >> 4) * 2 + (c >> 5), rr = r & 15, cc = c & 31, ob = rr * 64 + cc * 2; return st * 1024 + (ob ^ (((ob >> 9) & 1) << 5)); }
__host__ __device__ __forceinline__ void stage_rc(int b, int& R, int& C) { const int st = b / 1024, sb = b % 1024, swz = sb ^ (((sb >> 9) & 1) << 5); R = (st >> 1) * 16 + swz / 64; C = (st & 1) * 32 + (swz % 64) / 2; }
__host__ __device__ __forceinline__ int perm32(int rho) { const int n = rho >> 4, i = rho & 15; return 8 * (i >> 2) + 4 * n + (i & 3); }

struct Unit { int pm, pn; };
struct Gemm { const bf16_t* A; const bf16_t* Bt; int M, N, K, lda, ldb; };

struct StaticOrder {
    int nM, nN, nwg, G, c;
    __host__ __device__ void init(int M, int N, int G_, int c_) { nM = M / BM; nN = N / BM; nwg = nM * nN; G = G_; c = c_; }
    __host__ __device__ bool next(int i, Unit& u) const {
        const long L = (long)i * G + c; if (L >= nwg) return false;
        int wgid = (int)L; { const int q = nwg / NXCD, r = nwg % NXCD, xcd = wgid % NXCD, off = wgid / NXCD; wgid = (xcd < r ? xcd * (q + 1) : r * (q + 1) + (xcd - r) * q) + off; }
        const int nig = WGM * nN, gid = wgid / nig, fm = gid * WGM, gsz = (nM - fm) < WGM ? (nM - fm) : WGM;
        u.pm = fm + ((wgid % nig) % gsz); u.pn = (wgid % nig) / gsz; return true;
    }
    __device__ __forceinline__ void a_ready(const Unit&) const {}
    __device__ __forceinline__ void done(const Unit&) const {}
};

typedef __bf16 bf16v2_t __attribute__((ext_vector_type(2)));
typedef float f32v2_t __attribute__((ext_vector_type(2)));
__device__ __forceinline__ unsigned cvt_pk_bf16(float lo, float hi) { const f32v2_t f = {lo, hi}; return __builtin_bit_cast(unsigned, __builtin_convertvector(f, bf16v2_t)); }
typedef float f32x2 __attribute__((ext_vector_type(2)));
__device__ __forceinline__ f32x2 gelu_pk(f32x2 v) {
    const f32x2 av = __builtin_elementwise_abs(v), d = av * 0.2316418882f + 1.0f;
    f32x2 t; t.x = __builtin_amdgcn_rcpf(d.x); t.y = __builtin_amdgcn_rcpf(d.y);
    f32x2 q = t * 0.5307027145f + (-0.7265760135f); q = q * t + 0.7107068705f; q = q * t + (-0.142248368f); q = q * t + 0.127414796f; q = q * t;
    const f32x2 s = (v * v) * (-0.72134752044f);
    f32x2 e; e.x = __builtin_amdgcn_exp2f(s.x); e.y = __builtin_amdgcn_exp2f(s.y);
    const f32x2 m = v * (q * e), r = v - m;
    f32x2 o; o.x = v.x < 0.f ? m.x : r.x; o.y = v.y < 0.f ? m.y : r.y; return o;
}


__device__ __forceinline__ float fsigmoid(float x) { return __builtin_amdgcn_rcpf(1.0f + __expf(-x)); }
__device__ __forceinline__ float fsilu(float x) { return x * fsigmoid(x); }
__device__ __forceinline__ float bf_lo(unsigned w) { return __uint_as_float(w << 16); }
__device__ __forceinline__ float bf_hi(unsigned w) { return __uint_as_float(w & 0xffff0000u); }
typedef unsigned u32x2 __attribute__((ext_vector_type(2)));

struct EpiIn {
    static constexpr bool PERM = true, AFTER_DRAIN = false;
    bf16_t *Z, *XBC, *UC, *GT; float* DT; const float *dtb_f, *dtb_b;
    __device__ __forceinline__ void operator()(const f32x4 (&acc)[2][2][4][2], const Unit& u, int wr, int wc, int fr, int fq) const {
        const int row0 = u.pm * BM + wr * 64 + fr; const int pn = u.pn;
        if (pn == 16) {
            if (wc < 2) {
#pragma unroll
                for (int n = 0; n < 2; ++n) { const int col = wc * 32 + 8 * fq + 4 * n;
                    if (col < 48) { f32x4 bv;
#pragma unroll
                        for (int j = 0; j < 4; ++j) { const int cc = col + j; bv[j] = cc < 24 ? dtb_f[cc] : dtb_b[cc - 24]; }
#pragma unroll
                        for (int ai = 0; ai < 2; ++ai)
#pragma unroll
                            for (int m = 0; m < 4; ++m) { f32x4 v = acc[ai][0][m][n] + bv;
#pragma unroll
                                for (int j = 0; j < 4; ++j) { const float x = v[j]; v[j] = fmaxf(x, 0.f) + log1pf(__expf(-fabsf(x))); }
                                *(f32x4*)(DT + (size_t)(row0 + ai * HALF + m * 16) * 48 + col) = v; } } }
            }
            return;
        }
        int mode, ldc, colt; bf16_t* base;
        if (pn < 6) { mode = 1; base = Z; ldc = 1536; colt = pn * BM; }
        else if (pn < 16) { mode = 0; base = XBC; ldc = 2560; colt = (pn - 6) * BM; }
        else if (pn < 20) {
            const int uc = (pn - 17) * BM + wc * 32 + 8 * fq, g0 = uc >> 4, j0 = uc & 15;
#pragma unroll
            for (int ai = 0; ai < 2; ++ai)
#pragma unroll
                for (int m = 0; m < 4; ++m) { const int r = row0 + ai * HALF + m * 16, cl = r >> 5, s = r & 31;
#pragma unroll
                    for (int bj = 0; bj < 2; ++bj) { const f32x4 v0 = acc[ai][bj][m][0], v1 = acc[ai][bj][m][1];
                        u32x4 w; w.x = cvt_pk_bf16(v0[0], v0[1]); w.y = cvt_pk_bf16(v0[2], v0[3]); w.z = cvt_pk_bf16(v1[0], v1[1]); w.w = cvt_pk_bf16(v1[2], v1[3]);
                        *(u32x4*)(UC + ((size_t)((g0 + 8 * bj) * 512 + cl) * 768 + s * 16 + j0)) = w; } }
            return; }
        else { mode = 2; base = GT; ldc = 2048; colt = (pn - 20) * BM; }
        const int col0 = colt + wc * 32 + 8 * fq;
#pragma unroll
        for (int ai = 0; ai < 2; ++ai)
#pragma unroll
            for (int m = 0; m < 4; ++m) { bf16_t* rowp = base + (size_t)(row0 + ai * HALF + m * 16) * ldc + col0;
#pragma unroll
                for (int bj = 0; bj < 2; ++bj) { f32x4 v0 = acc[ai][bj][m][0], v1 = acc[ai][bj][m][1];
                    if (mode == 1) {
#pragma unroll
                        for (int j = 0; j < 4; ++j) { v0[j] = fsilu(v0[j]); v1[j] = fsilu(v1[j]); } }
                    else if (mode == 2) {
#pragma unroll
                        for (int j = 0; j < 4; ++j) { v0[j] = fsigmoid(v0[j]); v1[j] = fsigmoid(v1[j]); } }
                    u32x4 w; w.x = cvt_pk_bf16(v0[0], v0[1]); w.y = cvt_pk_bf16(v0[2], v0[3]); w.z = cvt_pk_bf16(v1[0], v1[1]); w.w = cvt_pk_bf16(v1[2], v1[3]);
                    *(u32x4*)(rowp + bj * HALF) = w; } }
    }
};
struct EpiSsdOut {
    static constexpr bool PERM = true, AFTER_DRAIN = false;
    bf16_t* MIX; const bf16_t* YB; const bf16_t* GT;
    __device__ __forceinline__ void operator()(const f32x4 (&acc)[2][2][4][2], const Unit& u, int wr, int wc, int fr, int fq) const {
        const int row0 = u.pm * BM + wr * 64 + fr, col0 = u.pn * BM + wc * 32 + 8 * fq;
#pragma unroll
        for (int ai = 0; ai < 2; ++ai)
#pragma unroll
            for (int m = 0; m < 4; ++m) { const size_t r = (size_t)(row0 + ai * HALF + m * 16);
#pragma unroll
                for (int bj = 0; bj < 2; ++bj) { const int c = col0 + bj * HALF; const u32x4 g = *(const u32x4*)(GT + r * 2048 + c), y = *(const u32x4*)(YB + r * 1024 + c);
                    const f32x4 a0 = acc[ai][bj][m][0], a1 = acc[ai][bj][m][1];
                    u32x4 w; w.x = cvt_pk_bf16(a0[0] * bf_lo(g.x) + bf_lo(y.x), a0[1] * bf_hi(g.x) + bf_hi(y.x)); w.y = cvt_pk_bf16(a0[2] * bf_lo(g.y) + bf_lo(y.y), a0[3] * bf_hi(g.y) + bf_hi(y.y));
                    w.z = cvt_pk_bf16(a1[0] * bf_lo(g.z) + bf_lo(y.z), a1[1] * bf_hi(g.z) + bf_hi(y.z)); w.w = cvt_pk_bf16(a1[2] * bf_lo(g.w) + bf_lo(y.w), a1[3] * bf_hi(g.w) + bf_hi(y.w));
                    *(u32x4*)(MIX + r * 1024 + c) = w; } }
    }
};
struct EpiGlu {
    static constexpr bool PERM = true, AFTER_DRAIN = false;
    bf16_t* YB; const bf16_t* GT;
    __device__ __forceinline__ void operator()(const f32x4 (&acc)[2][2][4][2], const Unit& u, int wr, int wc, int fr, int fq) const {
        const int row0 = u.pm * BM + wr * 64 + fr, col0 = u.pn * HALF + wc * 32 + 8 * fq;
#pragma unroll
        for (int ai = 0; ai < 2; ++ai)
#pragma unroll
            for (int m = 0; m < 4; ++m) { const size_t r = (size_t)(row0 + ai * HALF + m * 16);
                const u32x4 g = *(const u32x4*)(GT + r * 2048 + 1024 + col0);
                f32x4 a0 = acc[ai][0][m][0], a1 = acc[ai][0][m][1]; const f32x4 b0 = acc[ai][1][m][0], b1 = acc[ai][1][m][1];
#pragma unroll
                for (int j = 0; j < 4; ++j) { a0[j] *= fsigmoid(b0[j]); a1[j] *= fsigmoid(b1[j]); }
                u32x4 w; w.x = cvt_pk_bf16(a0[0] * bf_lo(g.x), a0[1] * bf_hi(g.x)); w.y = cvt_pk_bf16(a0[2] * bf_lo(g.y), a0[3] * bf_hi(g.y)); w.z = cvt_pk_bf16(a1[0] * bf_lo(g.z), a1[1] * bf_hi(g.z)); w.w = cvt_pk_bf16(a1[2] * bf_lo(g.w), a1[3] * bf_hi(g.w));
                *(u32x4*)(YB + r * 1024 + col0) = w; }
    }
};
struct EpiWo {
    static constexpr bool PERM = false, AFTER_DRAIN = false;
    float* HP; const float* X; float alpha;
    __device__ __forceinline__ void operator()(const f32x4 (&acc)[2][2][4][2], const Unit& u, int wr, int wc, int fr, int fq) const {
        const int row0 = u.pm * BM + wr * 64 + fr, col0 = u.pn * BM + wc * 32 + 4 * fq;
#pragma unroll
        for (int ai = 0; ai < 2; ++ai)
#pragma unroll
            for (int m = 0; m < 4; ++m) { const size_t r = (size_t)(row0 + ai * HALF + m * 16);
#pragma unroll
                for (int bj = 0; bj < 2; ++bj)
#pragma unroll
                    for (int n = 0; n < 2; ++n) { const int c = col0 + bj * HALF + n * 16; const f32x4 xv = *(const f32x4*)(X + r * 1024 + c);
                        *(f32x4*)(HP + r * 1024 + c) = acc[ai][bj][m][n] + xv * alpha; } }
    }
};
__device__ __forceinline__ unsigned pk4_fp8_(float a, float b, float c, float d) { int r_ = __builtin_amdgcn_cvt_pk_fp8_f32(a, b, 0, false); r_ = __builtin_amdgcn_cvt_pk_fp8_f32(c, d, r_, true); return (unsigned)r_; }
struct EpiMoe1 {
    static constexpr bool PERM = true, AFTER_DRAIN = false;
    unsigned char* HID; float inv, hs;
    __device__ __forceinline__ void operator()(const f32x4 (&acc)[2][2][4][2], const Unit& u, int wr, int wc, int fr, int fq) const {
        const int row0 = u.pm * BM + wr * 64 + fr, col0 = (u.pn % 22) * HALF + wc * 32 + 8 * fq;
#pragma unroll
        for (int ai = 0; ai < 2; ++ai)
#pragma unroll
            for (int m = 0; m < 4; ++m) { const size_t r = (size_t)(row0 + ai * HALF + m * 16);
                f32x4 a0 = acc[ai][0][m][0] * inv, a1 = acc[ai][0][m][1] * inv; const f32x4 b0 = acc[ai][1][m][0] * (inv * hs), b1 = acc[ai][1][m][1] * (inv * hs);
#pragma unroll
                for (int j = 0; j < 4; ++j) { a0[j] = fsilu(a0[j]) * b0[j]; a1[j] = fsilu(a1[j]) * b1[j]; }
                u32x2 w; w.x = pk4_fp8_(a0[0], a0[1], a0[2], a0[3]); w.y = pk4_fp8_(a1[0], a1[1], a1[2], a1[3]);
                *(u32x2*)(HID + r * 2816 + col0) = w; }
    }
};
struct EpiMoe2 {
    static constexpr bool PERM = true, AFTER_DRAIN = false;
    bf16_t* Y; float inv;
    __device__ __forceinline__ void operator()(const f32x4 (&acc)[2][2][4][2], const Unit& u, int wr, int wc, int fr, int fq) const {
        const int row0 = u.pm * BM + wr * 64 + fr, col0 = (u.pn & 3) * BM + wc * 32 + 8 * fq;
#pragma unroll
        for (int ai = 0; ai < 2; ++ai)
#pragma unroll
            for (int m = 0; m < 4; ++m) { bf16_t* rowp = Y + (size_t)(row0 + ai * HALF + m * 16) * 1024 + col0;
#pragma unroll
                for (int bj = 0; bj < 2; ++bj) { const f32x4 v0 = acc[ai][bj][m][0] * inv, v1 = acc[ai][bj][m][1] * inv;
                    u32x4 w; w.x = cvt_pk_bf16(v0[0], v0[1]); w.y = cvt_pk_bf16(v0[2], v0[3]); w.z = cvt_pk_bf16(v1[0], v1[1]); w.w = cvt_pk_bf16(v1[2], v1[3]);
                    *(u32x4*)(rowp + bj * HALF) = w; } }
    }
};
struct EpiS5a {
    static constexpr bool PERM = false, AFTER_DRAIN = false;
    float* SLOC;
    __device__ __forceinline__ void operator()(const f32x4 (&acc)[2][2][4][2], const Unit& u, int wr, int wc, int fr, int fq) const {
        const int row0 = u.pm * BM + wr * 64 + fr, col0 = wc * 32 + 4 * fq;
#pragma unroll
        for (int ai = 0; ai < 2; ++ai)
#pragma unroll
            for (int m = 0; m < 4; ++m) { float* rowp = SLOC + (size_t)(row0 + ai * HALF + m * 16) * 256 + col0;
#pragma unroll
                for (int bj = 0; bj < 2; ++bj)
#pragma unroll
                    for (int n = 0; n < 2; ++n) *(f32x4*)(rowp + bj * HALF + n * 16) = acc[ai][bj][m][n]; }
    }
};
__device__ __forceinline__ float gelu_tanh_f(float x) { const float uu = 0.7978845608028654f * (x + 0.044715f * x * x * x); const float e = __expf(2.f * uu); return 0.5f * x * (2.f - 2.f * __builtin_amdgcn_rcpf(e + 1.f)); }
struct EpiS5c {
    static constexpr bool PERM = true, AFTER_DRAIN = false;
    bf16_t* GY; const bf16_t* UC; const float* d5;
    __device__ __forceinline__ void operator()(const f32x4 (&acc)[2][2][4][2], const Unit& u, int wr, int wc, int fr, int fq) const {
        const int g = u.pm >> 1, cl0 = (u.pm & 1) * BM + wr * 64 + fr, nl0 = (u.pn & 1) * BM + wc * 32 + 8 * fq;
        const int k0 = nl0 & 15; const f32x4 d0 = *(const f32x4*)(d5 + g * 16 + k0), d1 = *(const f32x4*)(d5 + g * 16 + k0 + 4);
#pragma unroll
        for (int ai = 0; ai < 2; ++ai)
#pragma unroll
            for (int m = 0; m < 4; ++m) { const int cl = cl0 + ai * HALF + m * 16;
#pragma unroll
                for (int bj = 0; bj < 2; ++bj) { const int nl = nl0 + bj * HALF, t = nl >> 4;
                    const u32x4 uw = *(const u32x4*)(UC + ((size_t)(g * 512 + cl) * 768 + nl));
                    f32x4 v0 = acc[ai][bj][m][0], v1 = acc[ai][bj][m][1];
                    v0[0] += bf_lo(uw.x) * d0[0]; v0[1] += bf_hi(uw.x) * d0[1]; v0[2] += bf_lo(uw.y) * d0[2]; v0[3] += bf_hi(uw.y) * d0[3];
                    v1[0] += bf_lo(uw.z) * d1[0]; v1[1] += bf_hi(uw.z) * d1[1]; v1[2] += bf_lo(uw.w) * d1[2]; v1[3] += bf_hi(uw.w) * d1[3];
#pragma unroll
                    for (int j = 0; j < 4; ++j) { v0[j] = gelu_tanh_f(v0[j]); v1[j] = gelu_tanh_f(v1[j]); }
                    u32x4 w; w.x = cvt_pk_bf16(v0[0], v0[1]); w.y = cvt_pk_bf16(v0[2], v0[3]); w.z = cvt_pk_bf16(v1[0], v1[1]); w.w = cvt_pk_bf16(v1[2], v1[3]);
                    *(u32x4*)(GY + (size_t)(cl * 32 + t) * 768 + g * 16 + k0) = w; } }
    }
};
struct S5aOrder {
    int c, lo;
    __device__ __forceinline__ bool next(int i, Unit& u) const { if (i > 0 || c < lo || c >= lo + 96) return false; u.pm = c - lo; u.pn = (c - lo) >> 1; return true; }
    __device__ __forceinline__ void a_ready(const Unit&) const {}
    __device__ __forceinline__ void done(const Unit&) const {}
};
struct S5cOrder {
    int G, c;
    __device__ __forceinline__ bool next(int i, Unit& u) const { const int L = i * G + c; if (L >= 192) return false; const int g = L >> 2; u.pm = 2 * g + (L & 1); u.pn = 2 * g + ((L >> 1) & 1); return true; }
    __device__ __forceinline__ void a_ready(const Unit&) const {}
    __device__ __forceinline__ void done(const Unit&) const {}
};
struct MoeOrder1 {
    int G, c;
    __device__ __forceinline__ bool next(int i, Unit& u) const {
        if (G == 256) { if (i >= 11) return false; const int x = c & 7, j = c >> 3, q = x * 44 + i * 4 + (j >> 3); u.pm = (q / 22) * 8 + (j & 7); u.pn = q; return true; }
        const long L = (long)i * G + c; if (L >= 2816) return false; const int e = (int)(L / 176), r = (int)(L % 176); u.pm = e * 8 + (r & 7); u.pn = e * 22 + (r >> 3); return true;
    }
    __device__ __forceinline__ void a_ready(const Unit&) const {}
    __device__ __forceinline__ void done(const Unit&) const {}
};
struct MoeOrder2 {
    int G, c;
    __device__ __forceinline__ bool next(int i, Unit& u) const {
        if (G == 256) { if (i >= 2) return false; const int x = c & 7, j = c >> 3, e = 2 * x + i; u.pm = e * 8 + (j & 7); u.pn = e * 4 + (j >> 3); return true; }
        const long L = (long)i * G + c; if (L >= 512) return false; const int e = (int)(L / 32), r = (int)(L % 32); u.pm = e * 8 + (r & 7); u.pn = e * 4 + (r >> 3); return true;
    }
    __device__ __forceinline__ void a_ready(const Unit&) const {}
    __device__ __forceinline__ void done(const Unit&) const {}
};
template <class Epi, class Sched, bool ALIGN_EPI = false, bool SP2 = false, bool F8 = false>
__device__ __forceinline__ void gemm_phase(PG8_LAS unsigned char* lds, const Gemm g, const Sched& S, const Epi& E, const int tid) {
    const int wid = __builtin_amdgcn_readfirstlane(tid >> 6), lane = tid & 63, wr = wid >> 2, wc = wid & 3, fr = lane & 15, fq = lane >> 4;
    const int K = g.K, nt = F8 ? K / 128 : K / BK; constexpr int ESZ = F8 ? 1 : 2, KOFF = F8 ? 16 : 1024;
    unsigned voffA, voffB;
    { int R, C; stage_rc(tid * 16, R, C); const int Rb = Epi::PERM ? ((R & ~31) + perm32(R & 31)) : R;
      voffA = (unsigned)(R * g.lda * ESZ + C * 2); voffB = (unsigned)(Rb * g.ldb * ESZ + C * 2); }
    const unsigned r64A = 64u * (unsigned)g.lda * ESZ, r64B = 64u * (unsigned)g.ldb * ESZ;
    const __amdgpu_buffer_rsrc_t rsrcA = __builtin_amdgcn_make_buffer_rsrc((void*)g.A, 0, (int)((unsigned)g.M * (unsigned)g.lda * ESZ), 0x00020000), rsrcB = __builtin_amdgcn_make_buffer_rsrc((void*)g.Bt, 0, (int)((unsigned)g.N * (unsigned)g.ldb * ESZ), 0x00020000);
    const unsigned kstep = (unsigned)(BK * 2);
    const unsigned hstepA = (unsigned)HALF * g.lda * ESZ, hstepB = (unsigned)HALF * g.ldb * ESZ;
    const unsigned tstepA = 2 * hstepA, tstepB = 2 * hstepB;
    const unsigned ldsw = (unsigned)wid * 1024u;
    const int aoff = lds_byte(wr * 64 + fr, F8 ? fq * 16 : fq * 8), boff = lds_byte(wc * 32 + fr, F8 ? fq * 16 : fq * 8);
#define PG8_SA(b, h) (((b) * 2 + (h)) * HTB)
#define PG8_SB(b, h) ((4 + (b) * 2 + (h)) * HTB)
#define PG8_STAGE(bufoff, gbase, voff) do { _Pragma("unroll") for (int _i = 0; _i < 2; ++_i) \
        __builtin_amdgcn_raw_ptr_buffer_load_lds(PG8_RSRC(voff), (PG8_LAS unsigned*)(lds + (bufoff) + ldsw + _i * 8192), 16, (int)(voff), (int)((gbase) + _i * PG8_R64(voff)), 0, 0); } while (0)
#define PG8_RSRC(voff) (&(voff) == &voffA ? rsrcA : rsrcB)
#define PG8_R64(voff) (&(voff) == &voffA ? r64A : r64B)
#define PG8_LDA(dst, b, h) do { _Pragma("unroll") for (int m = 0; m < 4; ++m) _Pragma("unroll") for (int k = 0; k < 2; ++k) dst[m][k] = *(const PG8_LAS bf16x8*)(lds + PG8_SA(b, h) + aoff + m * 2048 + k * KOFF); } while (0)
#define PG8_LDB(dst, b, h) do { _Pragma("unroll") for (int n = 0; n < 2; ++n) _Pragma("unroll") for (int k = 0; k < 2; ++k) dst[n][k] = *(const PG8_LAS bf16x8*)(lds + PG8_SB(b, h) + boff + n * 2048 + k * KOFF); } while (0)
#define PG8_CAT8(x_) __builtin_bit_cast(i32x8, __builtin_shufflevector((x_)[0], (x_)[1], 0, 1, 2, 3, 4, 5, 6, 7, 8, 9, 10, 11, 12, 13, 14, 15))
#define PG8_MMA(ai, bj, At, Bt) do { __builtin_amdgcn_s_setprio(1); if constexpr (F8) { _Pragma("unroll") for (int m = 0; m < 4; ++m) _Pragma("unroll") for (int n = 0; n < 2; ++n) \
        acc[ai][bj][m][n] = __builtin_amdgcn_mfma_scale_f32_16x16x128_f8f6f4(PG8_CAT8(Bt[n]), PG8_CAT8(At[m]), acc[ai][bj][m][n], 0, 0, 0, 0x7f7f7f7f, 0, 0x7f7f7f7f); } \
      else { _Pragma("unroll") for (int m = 0; m < 4; ++m) _Pragma("unroll") for (int n = 0; n < 2; ++n) _Pragma("unroll") for (int k = 0; k < 2; ++k) \
        acc[ai][bj][m][n] = __builtin_amdgcn_mfma_f32_16x16x32_bf16(Bt[n][k], At[m][k], acc[ai][bj][m][n], 0, 0, 0); } __builtin_amdgcn_s_setprio(0); } while (0)
#define PG8_WAIT_V(n) asm volatile("s_waitcnt vmcnt(" #n ")" ::: "memory")
#define PG8_WAIT_L(n) asm volatile("s_waitcnt lgkmcnt(" #n ")" ::: "memory")
#define PG8_BAR __builtin_amdgcn_s_barrier()
#define PG8_SCHED __builtin_amdgcn_sched_barrier(0)
    Unit cur, nxt; int ui = 0;
    if (!S.next(0, cur)) return;
    f32x4 acc[2][2][4][2];
#pragma unroll
    for (int a = 0; a < 2; ++a)
#pragma unroll
        for (int b = 0; b < 2; ++b)
#pragma unroll
            for (int m = 0; m < 4; ++m)
#pragma unroll
                for (int n = 0; n < 2; ++n) acc[a][b][m][n] = (f32x4){0.f, 0.f, 0.f, 0.f};
    bf16x8 At[4][2], B0[2][2], B1[2][2];
    unsigned cA = (unsigned)cur.pm * tstepA, cB = (unsigned)cur.pn * tstepB;
    S.a_ready(cur);
    if constexpr (SP2) {
        PG8_STAGE(PG8_SB(0, 0), cB, voffB); PG8_STAGE(PG8_SB(0, 1), cB + hstepB, voffB); PG8_STAGE(PG8_SA(0, 0), cA, voffA); PG8_STAGE(PG8_SA(0, 1), cA + hstepA, voffA);
        if (wr == 1) PG8_BAR;
        PG8_WAIT_V(2); PG8_BAR;
        PG8_STAGE(PG8_SB(1, 0), cB + kstep, voffB); PG8_STAGE(PG8_SA(1, 0), cA + kstep, voffA); PG8_STAGE(PG8_SB(1, 1), cB + hstepB + kstep, voffB);
        PG8_WAIT_V(6); PG8_BAR;
    } else {
        PG8_STAGE(PG8_SB(0, 0), cB, voffB); PG8_STAGE(PG8_SA(0, 0), cA, voffA); PG8_STAGE(PG8_SB(0, 1), cB + hstepB, voffB); PG8_STAGE(PG8_SA(0, 1), cA + hstepA, voffA);
        if (wr == 1) PG8_BAR;
        PG8_WAIT_V(4); PG8_BAR;
        PG8_STAGE(PG8_SB(1, 0), cB + kstep, voffB); PG8_STAGE(PG8_SA(1, 0), cA + kstep, voffA); PG8_STAGE(PG8_SB(1, 1), cB + hstepB + kstep, voffB);
        PG8_WAIT_V(6); PG8_BAR;
    }
    for (;;) {
        const bool has_next = S.next(ui + 1, nxt);
        const unsigned nA = has_next ? (unsigned)nxt.pm * tstepA : cA, nB = has_next ? (unsigned)nxt.pn * tstepB : cB;
#pragma unroll 1
        for (int t = 0; t < nt; t += 2) {
            const bool last = (t == nt - 2);
            const unsigned a1 = cA + (unsigned)(t + 1) * kstep;
            const unsigned a2 = last ? nA : cA + (unsigned)(t + 2) * kstep, b2 = last ? nB : cB + (unsigned)(t + 2) * kstep;
            const unsigned a3 = a2 + kstep, b3 = b2 + kstep;
            if (last && has_next) S.a_ready(nxt);
            if constexpr (SP2) {
            PG8_LDB(B0, 0, 0); PG8_LDB(B1, 0, 1); PG8_SCHED; PG8_LDA(At, 0, 0); PG8_STAGE(PG8_SA(1, 1), a1 + hstepA, voffA);
            PG8_WAIT_V(8); PG8_WAIT_L(0); PG8_BAR; PG8_MMA(0, 0, At, B0); PG8_MMA(0, 1, At, B1); PG8_BAR; PG8_SCHED;
            PG8_LDA(At, 0, 1); PG8_STAGE(PG8_SB(0, 0), b2, voffB); PG8_STAGE(PG8_SB(0, 1), b2 + hstepB, voffB); PG8_STAGE(PG8_SA(0, 0), a2, voffA);
            PG8_WAIT_V(8); PG8_WAIT_L(0); PG8_BAR; PG8_MMA(1, 0, At, B0); PG8_MMA(1, 1, At, B1); PG8_BAR; PG8_SCHED;
            PG8_LDB(B0, 1, 0); PG8_LDB(B1, 1, 1); PG8_SCHED; PG8_LDA(At, 1, 0); PG8_STAGE(PG8_SA(0, 1), a2 + hstepA, voffA);
            PG8_WAIT_V(8); PG8_WAIT_L(0); PG8_BAR; PG8_MMA(0, 0, At, B0); PG8_MMA(0, 1, At, B1); PG8_BAR; PG8_SCHED;
            PG8_LDA(At, 1, 1); PG8_STAGE(PG8_SB(1, 0), b3, voffB); PG8_STAGE(PG8_SB(1, 1), b3 + hstepB, voffB); PG8_STAGE(PG8_SA(1, 0), a3, voffA);
            PG8_WAIT_V(8); PG8_WAIT_L(0); PG8_BAR; PG8_MMA(1, 0, At, B0); PG8_MMA(1, 1, At, B1); PG8_BAR; PG8_SCHED;
            } else {
            PG8_LDB(B0, 0, 0); PG8_SCHED; PG8_LDA(At, 0, 0); PG8_STAGE(PG8_SA(1, 1), a1 + hstepA, voffA);
            PG8_WAIT_L(8); PG8_BAR; PG8_WAIT_L(0); PG8_MMA(0, 0, At, B0); PG8_BAR; PG8_SCHED;
            PG8_LDB(B1, 0, 1); PG8_STAGE(PG8_SB(0, 0), b2, voffB);
            PG8_BAR; PG8_WAIT_L(0); PG8_MMA(0, 1, At, B1); PG8_BAR;
            PG8_LDA(At, 0, 1); PG8_STAGE(PG8_SA(0, 0), a2, voffA);
            PG8_BAR; PG8_WAIT_L(0); PG8_MMA(1, 0, At, B0); PG8_BAR; PG8_SCHED;
            PG8_STAGE(PG8_SB(0, 1), b2 + hstepB, voffB);
            PG8_WAIT_V(6); PG8_BAR; PG8_MMA(1, 1, At, B1); PG8_BAR;
            PG8_LDB(B0, 1, 0); PG8_SCHED; PG8_LDA(At, 1, 0); PG8_STAGE(PG8_SA(0, 1), a2 + hstepA, voffA);
            PG8_WAIT_L(8); PG8_BAR; PG8_WAIT_L(0); PG8_MMA(0, 0, At, B0); PG8_BAR; PG8_SCHED;
            PG8_LDB(B1, 1, 1); PG8_STAGE(PG8_SB(1, 0), b3, voffB);
            PG8_BAR; PG8_WAIT_L(0); PG8_MMA(0, 1, At, B1); PG8_BAR;
            PG8_LDA(At, 1, 1); PG8_STAGE(PG8_SA(1, 0), a3, voffA);
            PG8_BAR; PG8_WAIT_L(0); PG8_MMA(1, 0, At, B0); PG8_BAR; PG8_SCHED;
            PG8_STAGE(PG8_SB(1, 1), b3 + hstepB, voffB);
            PG8_WAIT_V(6); PG8_BAR; PG8_MMA(1, 1, At, B1); PG8_BAR;
            }
        }
        if constexpr (ALIGN_EPI) { if (wr == 0) PG8_BAR; }
        if constexpr (!Epi::AFTER_DRAIN) { E(acc, cur, wr, wc, fr, fq); S.done(cur); }
        if (!has_next) break;
#pragma unroll
        for (int a = 0; a < 2; ++a)
#pragma unroll
            for (int b = 0; b < 2; ++b)
#pragma unroll
                for (int m = 0; m < 4; ++m)
#pragma unroll
                    for (int n = 0; n < 2; ++n) acc[a][b][m][n] = (f32x4){0.f, 0.f, 0.f, 0.f};
        cur = nxt; cA = nA; cB = nB; ++ui;
        if constexpr (ALIGN_EPI) { if (wr == 1) PG8_BAR; }
    }
    PG8_WAIT_V(0);
    if constexpr (!ALIGN_EPI) { if (wr == 0) PG8_BAR; }
    PG8_BAR;
    if constexpr (Epi::AFTER_DRAIN) { E.fused(acc, cur, wr, wc, fr, fq, lds, wid, lane); S.done(cur); }
#undef PG8_SA
#undef PG8_SB
#undef PG8_STAGE
#undef PG8_RSRC
#undef PG8_R64
#undef PG8_LDA
#undef PG8_LDB
#undef PG8_MMA
#undef PG8_CAT8
#undef PG8_WAIT_V
#undef PG8_WAIT_L
#undef PG8_BAR
#undef PG8_SCHED
}
}
#ifndef PG8_SP2
#define PG8_SP2 true
#endif
#ifndef PG8_ALIGN
#define PG8_ALIGN true
#endif

constexpr int NWAVES = 8, NTHR = 512;
constexpr int D = 1024, NB = 2, T = 8192, M = NB * T;
constexpr int SSD_H = 24, SSD_P = 64, SSD_IN = 1536, SSD_G = 4, SSD_N = 128, XBC = 2560, INCOLS = 6960, NIN_PAD = 7168;
constexpr int S5_W = 768, S5_G = 48, S5_P = 64, S5_K = 16;
constexpr int NE = 16, FF = 2816, CAP = 1024, MROWS = NE * NB * CAP;
constexpr float LN_EPS = 1e-5f, RMS_EPS = 1e-5f;
constexpr float ALPHA = 1.189207115002721f;
constexpr float W1_SCALE = 32.f, W2_SCALE = 64.f, HID_SCALE = 4.f;

constexpr size_t MiB = 1u << 20;
constexpr size_t WS_CTL = 0, CTL_ZERO_BYTES = 64 * 1024;
constexpr size_t WS_WIN = 1 * MiB, WS_WOUT = 15 * MiB, WS_WGLU = 18 * MiB, WS_WO = 21 * MiB, WS_W1 = 23 * MiB, WS_W2 = 111 * MiB, WS_S5M = 199 * MiB, WS_ACT = 287 * MiB;
constexpr size_t A_XB = WS_ACT + 0 * MiB;
constexpr size_t A_BN = WS_ACT + 0 * MiB;
constexpr size_t A_CN = WS_ACT + 16 * MiB;
constexpr size_t A_Z = WS_ACT + 32 * MiB;
constexpr size_t A_XBC = WS_ACT + 80 * MiB;
constexpr size_t A_S = WS_ACT + 80 * MiB;
constexpr size_t A_XT = WS_ACT + 176 * MiB;
constexpr size_t A_BT = WS_ACT + 224 * MiB;
constexpr size_t A_SV = WS_ACT + 340 * MiB;
constexpr size_t A_DT = WS_ACT + 252 * MiB;
constexpr size_t A_TOT = WS_ACT + 255 * MiB;
constexpr size_t A_UC = WS_ACT + 268 * MiB;
constexpr size_t A_Y = WS_ACT + 256 * MiB;
constexpr size_t A_GY = WS_ACT + 224 * MiB;
constexpr size_t A_GT = WS_ACT + 353 * MiB;
constexpr size_t A_YB = WS_ACT + 304 * MiB;
constexpr size_t A_MIX = WS_ACT + 64 * MiB;
constexpr size_t A_HP = WS_ACT + 96 * MiB;
constexpr size_t A_ST = WS_ACT + 0 * MiB;
constexpr size_t A_H8 = WS_ACT + 64 * MiB;
constexpr size_t A_AFF = WS_ACT + 160 * MiB;
constexpr size_t A_IDX = A_AFF + 1 * MiB;
constexpr size_t A_SEL = A_AFF + 2 * MiB;
constexpr size_t A_GATE = A_AFF + 3 * MiB;
constexpr size_t A_XIN = WS_ACT + 164 * MiB;
constexpr size_t A_HID = WS_ACT + 228 * MiB;
constexpr size_t A_YE = WS_ACT + 164 * MiB;
constexpr size_t WS_TV = WS_S5M + 0 * MiB;
constexpr size_t WS_WS5 = WS_S5M + 36 * MiB;
constexpr size_t WS_SLOC = WS_S5M + 48 * MiB;
constexpr size_t WS_AQ = WS_S5M + 72 * MiB;
constexpr size_t WS_END = 704 * MiB;
static_assert(A_HID + 176 * MiB <= WS_END && A_XIN + 64 * MiB <= A_HID && A_YE + 64 * MiB <= A_HID && A_GATE + 1 * MiB <= A_XIN && A_HP + 64 * MiB <= A_AFF && A_H8 + 16 * MiB <= A_HP && A_ST + 1 * MiB <= A_H8, "d_ws map (late phases)");
static_assert(A_GT + 64 * MiB <= WS_END && A_SV + 12 * MiB <= A_GT && A_YB + 32 * MiB <= A_SV && A_UC + 36 * MiB <= A_YB && A_Y + 48 * MiB <= A_YB && A_TOT + 1 * MiB <= A_Y && A_DT + 3 * MiB <= A_TOT && A_GY + 24 * MiB <= A_DT && A_BT + 16 * MiB <= A_DT
              && A_XT + 48 * MiB <= A_BT && A_S + 96 * MiB <= A_XT && A_Z + 48 * MiB <= A_XBC && A_CN + 16 * MiB <= A_Z, "d_ws map (early phases)");
constexpr int CW_LIST = 8192;
constexpr int CW_QW1 = 12288;
constexpr int CW_BAR = 1024;

constexpr int RING_BYTES = 131072;
constexpr int MISC_OFF = RING_BYTES;
constexpr int LDS_BYTES = 147456;

#define GAS __attribute__((address_space(1)))
#define LAS __attribute__((address_space(3)))
typedef unsigned short bf16;
typedef unsigned v4u __attribute__((ext_vector_type(4)));
typedef unsigned v2u __attribute__((ext_vector_type(2)));
typedef float f32x4 __attribute__((ext_vector_type(4)));
#define LDS_WAIT() asm volatile("s_waitcnt lgkmcnt(0)" ::: "memory")
__device__ __forceinline__ unsigned f2bf(float f) { unsigned u = __builtin_bit_cast(unsigned, f); return (u + 0x7fffu + ((u >> 16) & 1u)) >> 16; }
__device__ __forceinline__ unsigned pk2(float lo, float hi) { return pg8::cvt_pk_bf16(lo, hi); }
__device__ __forceinline__ float bflo(unsigned w) { return __uint_as_float(w << 16); }
__device__ __forceinline__ float bfhi(unsigned w) { return __uint_as_float(w & 0xffff0000u); }
__device__ __forceinline__ float wave_sum(float v) {
#pragma unroll
    for (int o = 1; o < 64; o <<= 1) v += __shfl_xor(v, o);
    return v;
}
#define XB_TMO      128
#define XB_XCNT(j)  (256  + 64 * (j))
#define XB_XSUB(j)  (1280 + 64 * (j))
#define XB_XGEN(j)  (2304 + 64 * (j))
#define XB_TOP      3328
#define XB_TOPGEN   3392
#define XCD_BAR_WORDS 3456
#define XB_SPIN_CAP (1u << 18)

__device__ __forceinline__ unsigned xb_ld(unsigned* p)              { return __hip_atomic_load(p, __ATOMIC_RELAXED, __HIP_MEMORY_SCOPE_AGENT); }
__device__ __forceinline__ unsigned xb_add(unsigned* p, unsigned v) { return __hip_atomic_fetch_add(p, v, __ATOMIC_RELAXED, __HIP_MEMORY_SCOPE_AGENT); }
__device__ __forceinline__ unsigned xb_xcc_id() { return (unsigned)__builtin_amdgcn_s_getreg((3 << 11) | 20) & 0xFu; }
#define XB_SPIN(cond, bar) do { unsigned _sp = 0; while (cond) { __builtin_amdgcn_s_sleep(1); \
    if ((++_sp & 255u) == 0u) { if (xb_ld(&(bar)[XB_TMO])) break; if (_sp > XB_SPIN_CAP) { atomicAdd(&(bar)[XB_TMO], 1u); break; } } } } while (0)

struct XcdBarrier {
    unsigned* bar; unsigned x;
    volatile LAS unsigned* st;
};

__device__ __forceinline__ XcdBarrier xcd_barrier_post(unsigned* bar, volatile LAS unsigned* st) {
    XcdBarrier b; b.bar = bar; b.x = xb_xcc_id(); b.st = st;
    if (threadIdx.x == 0) (void)xb_add(&bar[XB_XCNT(b.x)], 1u);
    return b;
}
__device__ __forceinline__ void xcd_barrier_complete(unsigned* bar, unsigned x, unsigned& nloc, unsigned& nx) {
    const unsigned G = gridDim.x * gridDim.y * gridDim.z;
    unsigned sum, cnt, mine, sp = 0u;
    for (;;) {
        sum = 0u; cnt = 0u; mine = 0u;
#pragma unroll
        for (unsigned j = 0; j < 16; ++j) { const unsigned c = xb_ld(&bar[XB_XCNT(j)]); sum += c; cnt += (c > 0u) ? 1u : 0u; mine = (j == x) ? c : mine; }
        if (sum == G) break;
        __builtin_amdgcn_s_sleep(1);
        if ((++sp & 255u) == 0u) { if (xb_ld(&bar[XB_TMO])) break; if (sp > XB_SPIN_CAP) { atomicAdd(&bar[XB_TMO], 1u); break; } }
    }
    nloc = mine > 0u ? mine : 1u; nx = cnt > 0u ? cnt : 1u;
}

__device__ __forceinline__ void xcd_barrier(const XcdBarrier& b, const bool t0  ) {
    asm volatile("s_waitcnt vmcnt(0)" ::: "memory");
    __syncthreads();
    if (t0) {
        unsigned* bar = b.bar;
        __builtin_amdgcn_s_waitcnt(0);
        unsigned nloc = b.st[0], nx = b.st[1];
        if (nloc == 0u) { xcd_barrier_complete(bar, b.x, nloc, nx); b.st[0] = nloc; b.st[1] = nx; }
        const unsigned old = xb_add(&bar[XB_XSUB(b.x)], 1u);
        const unsigned gen = old / nloc;
        if (old + 1u == (gen + 1u) * nloc) {
            __builtin_amdgcn_fence(__ATOMIC_RELEASE, "agent");
            asm volatile("s_waitcnt vmcnt(0)" ::: "memory");
            const unsigned og = xb_add(&bar[XB_TOP], 1u);
            const unsigned tg = og / nx;
            if (og + 1u == (tg + 1u) * nx) xb_add(&bar[XB_TOPGEN], 1u);
            else XB_SPIN(xb_ld(&bar[XB_TOPGEN]) == tg, bar);
            __builtin_amdgcn_fence(__ATOMIC_ACQUIRE, "agent");
            xb_add(&bar[XB_XGEN(b.x)], 1u);
            asm volatile("s_waitcnt vmcnt(0)" ::: "memory");
        } else {
            XB_SPIN(xb_ld(&bar[XB_XGEN(b.x)]) == gen, bar);
            __builtin_amdgcn_fence(__ATOMIC_ACQUIRE, "agent");
            asm volatile("s_waitcnt vmcnt(0)" ::: "memory");
        }
    }
    __syncthreads();
}

struct Frame {
    LAS unsigned char* lds;
    int tid, lane, wave, bid, G;
    LAS unsigned* ptab; float* out; unsigned char* ws;
};
__device__ __forceinline__ const float* inp_(const Frame& F, int k) { const unsigned lo = __builtin_amdgcn_readfirstlane(F.ptab[2 * k]), hi = __builtin_amdgcn_readfirstlane(F.ptab[2 * k + 1]); return (const float*)(((unsigned long long)hi << 32) | lo); }
#define INP(k) inp_(F, k)
__device__ __forceinline__ unsigned lane_now() { unsigned z_ = 0u; asm volatile("" : "+s"(z_)); return __builtin_amdgcn_mbcnt_hi(~0u, __builtin_amdgcn_mbcnt_lo(~0u, z_)); }
#define WSP(T_, off) ((T_*)(F.ws + (off)))

__device__ __forceinline__ unsigned pk4_fp8(float a, float b, float c, float d) { int r_ = __builtin_amdgcn_cvt_pk_fp8_f32(a, b, 0, false); r_ = __builtin_amdgcn_cvt_pk_fp8_f32(c, d, r_, true); return (unsigned)r_; }
__device__ __forceinline__ void tr_load(const float* W, int ldw, int col0, int ncols, int k0, int n0, int lane, f32x4 (&v)[16]) {
    const int kr = lane >> 4, c4 = lane & 15; const bool okc = (n0 + 4 * c4) < ncols;
    const float* src = W + (size_t)(k0 + kr) * ldw + col0 + n0 + 4 * c4;
#pragma unroll
    for (int i = 0; i < 16; ++i) v[i] = okc ? *(const f32x4*)(src + (size_t)(4 * i) * ldw) : (f32x4){0.f, 0.f, 0.f, 0.f};
}
__device__ __forceinline__ void tr_store(const f32x4 (&v)[16], int ncols, int K, bf16* WT, int drow, LAS float* scr, int k0, int n0, int lane, float qs) {
    const int kr = lane >> 4, c4 = lane & 15;
#pragma unroll
    for (int i = 0; i < 16; ++i) { const int k = 4 * i + kr; *(LAS f32x4*)(scr + k * 64 + 4 * (c4 ^ ((k >> 3) & 7))) = v[i]; }
    LDS_WAIT(); asm volatile("" ::: "memory");
    const int nl = lane >> 3, c = lane & 7;
#pragma unroll
    for (int j = 0; j < 8; ++j) { const int n = 8 * j + nl; const LAS float* s = scr + (8 * c) * 64 + 4 * ((n >> 2) ^ c) + (n & 3);
        if (qs != 0.f) { v2u o; o.x = pk4_fp8(s[0 * 64] * qs, s[1 * 64] * qs, s[2 * 64] * qs, s[3 * 64] * qs); o.y = pk4_fp8(s[4 * 64] * qs, s[5 * 64] * qs, s[6 * 64] * qs, s[7 * 64] * qs);
            if (n0 + n < ncols) *(v2u*)((unsigned char*)WT + (size_t)(drow + n) * K + k0 + 8 * c) = o; }
        else { v4u o; o.x = pk2(s[0 * 64], s[1 * 64]); o.y = pk2(s[2 * 64], s[3 * 64]); o.z = pk2(s[4 * 64], s[5 * 64]); o.w = pk2(s[6 * 64], s[7 * 64]);
            if (n0 + n < ncols) *(v4u*)(WT + (size_t)(drow + n) * K + k0 + 8 * c) = o; } }
    LDS_WAIT(); asm volatile("" ::: "memory");
}
__device__ __forceinline__ void tr_item(const float* W, int ldw, int col0, int ncols, int K, bf16* WT, int drow, LAS float* scr, int k0, int n0, int lane, float qs) {
    f32x4 v[16]; tr_load(W, ldw, col0, ncols, k0, n0, lane, v); tr_store(v, ncols, K, WT, drow, scr, k0, n0, lane, qs);
}
struct TrJob { const float* W; int ldw, col0, ncols, K; bf16* WT; int drow0, interleave; float qs; };
__device__ __forceinline__ int tr_job_items(const TrJob& j) { return (j.K / 64) * ((j.ncols + 63) / 64); }
__device__ __forceinline__ void tr_job_item(const TrJob& j, int item, LAS float* scr, int lane) {
    const int nblk = (j.ncols + 63) / 64, kb = item / nblk, nb = item % nblk, n0 = nb * 64;
    const int drow = j.interleave ? j.drow0 + (n0 >> 7) * 256 + (n0 & 127) : j.drow0 + n0;
    tr_item(j.W, j.ldw, j.col0, j.ncols, j.K, j.WT, drow, scr, kb * 64, n0, lane, j.qs);
}
__device__ __forceinline__ void p0_prologue(Frame& F) {
    LAS float* scr = (LAS float*)(F.lds + F.wave * 16384);
    const int gw = F.bid * NWAVES + F.wave, NGW = F.G * NWAVES;
    { const f32x4* x4 = (const f32x4*)INP(0); v4u* o = WSP(v4u, A_XB); const int n8 = M * D / 8;
      const int stride = F.G * NTHR;
      for (int i0 = F.bid * NTHR + F.tid; i0 < n8; i0 += 8 * stride) {
          f32x4 a[8], b[8];
#pragma unroll
          for (int q = 0; q < 8; ++q) { const int i = i0 + q * stride; if (i < n8) { a[q] = x4[2 * i]; b[q] = x4[2 * i + 1]; } }
#pragma unroll
          for (int q = 0; q < 8; ++q) { const int i = i0 + q * stride; if (i < n8) { v4u w; w.x = pk2(a[q].x, a[q].y); w.y = pk2(a[q].z, a[q].w); w.z = pk2(b[q].x, b[q].y); w.w = pk2(b[q].z, b[q].w); o[i] = w; } } } }
    {
        bf16* WIN = WSP(bf16, WS_WIN); bf16* WOUT = WSP(bf16, WS_WOUT); bf16* WGLU = WSP(bf16, WS_WGLU); bf16* WO = WSP(bf16, WS_WO);
        const TrJob jobs[8] = {
            {INP(1), INCOLS, 0, 4096, D, WIN, 0, 0, 0.f}, {INP(1), INCOLS, 4096, 48, D, WIN, 4096, 0, 0.f}, {INP(1), INCOLS, 4144, 768, D, WIN, 4352, 0, 0.f}, {INP(1), INCOLS, 4912, 2048, D, WIN, 5120, 0, 0.f},
            {INP(10), D, 0, D, SSD_IN, WOUT, 0, 0, 0.f}, {INP(22), D, 0, D, S5_W, WGLU, 0, 1, 0.f}, {INP(23), D, 0, D, S5_W, WGLU, 128, 1, 0.f}, {INP(24), D, 0, D, D, WO, 0, 0, 0.f} };
        int base = 0;
#pragma unroll
        for (int q = 0; q < 8; ++q) { const int n = tr_job_items(jobs[q]);
            int it0 = (gw - base) % NGW; if (it0 < 0) it0 += NGW;
            for (int it = it0; it < n; it += NGW) tr_job_item(jobs[q], it, scr, F.lane);
            base += n; }
    }
}
template <int WHICH> __device__ __forceinline__ void expert_convert(Frame& F, int gw, int ngw, unsigned* queue = nullptr, int it_lo = 0, int it_hi = 1 << 30) {
    LAS float* scr = (LAS float*)(F.lds + F.wave * 16384);
    constexpr int IPM = WHICH == 0 ? (D / 64) * (FF / 64) : (FF / 64) * (D / 64);
    constexpr int NIT_ALL = WHICH == 0 ? NE * 2 * IPM : NE * IPM; const int NIT = it_hi < NIT_ALL ? it_hi : NIT_ALL;
    constexpr int NBLK = WHICH == 0 ? FF / 64 : D / 64, LDW = WHICH == 0 ? FF : D, KK = WHICH == 0 ? D : FF; const float qs = WHICH == 0 ? W1_SCALE : W2_SCALE;
    const float* w1 = INP(28); const float* w3 = INP(29); const float* w2 = INP(30);
    unsigned char* W1b = F.ws + WS_W1; unsigned char* W2b = F.ws + WS_W2;
    const int lane = (int)lane_now();
    auto src_of = [&](int it, int& k0, int& n0) -> const float* { const int mtx = it / IPM, r = it % IPM; k0 = (r / NBLK) * 64; n0 = (r % NBLK) * 64;
        if (WHICH == 0) { const int e = mtx >> 1; return ((mtx & 1) ? w3 : w1) + (size_t)e * D * FF; } return w2 + (size_t)mtx * FF * D; };
    const int rfirst = F.bid * 88 + (F.wave < 4 ? F.wave * 9 : 36 + (F.wave - 4) * 13), rend = rfirst + (F.wave < 4 ? 9 : 13);
    auto claim = [&](int prev) -> int { if (!queue) return prev < 0 ? it_lo + gw : prev + ngw;
        const int nx_ = prev < 0 ? rfirst : prev + 1; return nx_ < rend ? nx_ : NIT; };
    auto finish = [&](const f32x4 (&v)[16], int it, int k0, int n0) { const int mtx = it / IPM; bf16* dst; int drow;
        if (WHICH == 0) { dst = (bf16*)(W1b + (size_t)(mtx >> 1) * 2 * FF * D); drow = (mtx & 1) * 128 + (n0 >> 7) * 256 + (n0 & 127); } else { dst = (bf16*)(W2b + (size_t)mtx * D * FF); drow = n0; }
        tr_store(v, LDW, KK, dst, drow, scr, k0, n0, lane, qs); };
    f32x4 va[16], vb[16]; int k0a = 0, n0a = 0, k0b = 0, n0b = 0;
    int ita = claim(-1);
    if (ita < NIT) { const float* sa = src_of(ita, k0a, n0a); tr_load(sa, LDW, 0, LDW, k0a, n0a, lane, va); }
    while (ita < NIT) {
        const int itb = claim(ita);
        if (itb < NIT) { const float* sb = src_of(itb, k0b, n0b); tr_load(sb, LDW, 0, LDW, k0b, n0b, lane, vb); }
        finish(va, ita, k0a, n0a);
        if (itb >= NIT) break;
        ita = claim(itb);
        if (ita < NIT) { const float* sa = src_of(ita, k0a, n0a); tr_load(sa, LDW, 0, LDW, k0a, n0a, lane, va); }
        finish(vb, itb, k0b, n0b);
    }
}
__device__ __forceinline__ void w1_convert(Frame& F, int gw, int ngw, unsigned* queue = nullptr) { expert_convert<0>(F, gw, ngw, queue); }
__device__ __forceinline__ void w2_convert(Frame& F, int gw, int ngw, int it_lo = 0, int it_hi = 1 << 30) { expert_convert<1>(F, gw, ngw, nullptr, it_lo, it_hi); }

__device__ __forceinline__ void cmul(float ar, float ai, float br, float bi, float& cr, float& ci) { cr = ar * br - ai * bi; ci = ar * bi + ai * br; }
__device__ __forceinline__ void s5_precompute_item(Frame& F, int g, int tau) {
    LAS float* PQ = (LAS float*)(F.lds + 72 * 1024);
    LAS float* PW = PQ + 256;
    bf16* TV = WSP(bf16, WS_TV) + (size_t)g * 512 * 768; bf16* WM = WSP(bf16, WS_WS5) + (size_t)g * 256 * 512; float* AQ = WSP(float, WS_AQ);
    const int tid = F.tid;
    __syncthreads();
    { LAS float* dst = PQ + 512; const float* s0 = INP(19) + (size_t)g * 1024; const float* s1 = INP(20) + (size_t)g * 1024; const float* s2 = INP(17) + (size_t)g * 1024; const float* s3 = INP(18) + (size_t)g * 1024;
      dst[tid] = s0[tid]; dst[512 + tid] = s0[512 + tid]; dst[1024 + tid] = s1[tid]; dst[1536 + tid] = s1[512 + tid]; dst[2048 + tid] = s2[tid]; dst[2560 + tid] = s2[512 + tid]; dst[3072 + tid] = s3[tid]; dst[3584 + tid] = s3[512 + tid]; }
    if (tid < 128) {
        const int d = tid >> 6, p = tid & 63;
        const float are = (d ? INP(14) : INP(11))[g * 64 + p], aim = (d ? INP(15) : INP(12))[g * 64 + p], step = __expf((d ? INP(16) : INP(13))[g]);
        const float zr = are * step, zi = aim * step;
        const float er = expf(zr), cs = cosf(zi), sn = sinf(zi), abr = er * cs, abi = er * sn;
        const float sh = sinf(0.5f * zi), dr = expm1f(zr) * cs - 2.f * sh * sh, di = abi;
        const float den = 1.0f / (are * are + aim * aim), qr = (dr * are + di * aim) * den, qi = (di * are - dr * aim) * den;
        float pr = 1.f, pi = 0.f, br = abr, bi = abi;
#pragma unroll
        for (int bit = 0; bit < 6; ++bit) { if ((tau >> bit) & 1) { float tr_, ti_; cmul(pr, pi, br, bi, tr_, ti_); pr = tr_; pi = ti_; } float sr_, si_; cmul(br, bi, br, bi, sr_, si_); br = sr_; bi = si_; }
        float xr, xi; cmul(pr, pi, qr, qi, xr, xi);
        PQ[(d * 64 + p) * 2] = xr; PQ[(d * 64 + p) * 2 + 1] = xi; PW[(d * 64 + p) * 2] = pr; PW[(d * 64 + p) * 2 + 1] = pi;
        if (tau == 32) { AQ[((g * 2 + d) * 64 + p) * 2] = pr; AQ[((g * 2 + d) * 64 + p) * 2 + 1] = pi; }
    }
    __syncthreads();
    LAS float* cre = PQ + 512; LAS float* cim = cre + 1024; LAS float* bre = cim + 1024; LAS float* bim = bre + 1024;
    if (tid < 256 && tau < 32) {
        const int k = tid >> 4, j = tid & 15; float kf = 0.f, kb = 0.f;
        for (int p = 0; p < 64; ++p) { const float cr = cre[k * 64 + p], ci = cim[k * 64 + p], br = bre[p * 16 + j], bi = bim[p * 16 + j];
            float wr_, wi_; cmul(cr, ci, PQ[p * 2], PQ[p * 2 + 1], wr_, wi_); kf += wr_ * br - wi_ * bi;
            cmul(cr, ci, PQ[(64 + p) * 2], PQ[(64 + p) * 2 + 1], wr_, wi_); kb += wr_ * br - wi_ * bi; }
        if (tau == 0) { const bf16 v = (bf16)f2bf(kf + kb); for (int t = 0; t < 32; ++t) TV[(size_t)(t * 16 + k) * 768 + t * 16 + j] = v; }
        else { const bf16 vf = (bf16)f2bf(kf), vb = (bf16)f2bf(kb);
            for (int t = tau; t < 32; ++t) { const int s = t - tau; TV[(size_t)(t * 16 + k) * 768 + s * 16 + j] = vf; TV[(size_t)(s * 16 + k) * 768 + t * 16 + j] = vb; } }
    }
    if (tid >= 256) {
        const int q = tid - 256;
        if (tau >= 1) {
#pragma unroll 1
            for (int i = 0; i < 8; ++i) { const int e = q * 8 + i, d = e >> 10, k = (e >> 6) & 15, p = e & 63;
                float vr, vi; cmul(cre[k * 64 + p], cim[k * 64 + p], PW[(d * 64 + p) * 2], PW[(d * 64 + p) * 2 + 1], vr, vi);
                const int t = d ? 32 - tau : tau - 1; bf16* row = TV + (size_t)(t * 16 + k) * 768 + 512 + d * 128;
                row[p] = (bf16)f2bf(vr); row[64 + p] = (bf16)f2bf(-vi); } }
        if (tau < 32) {
#pragma unroll 1
            for (int i = 0; i < 8; ++i) { const int e = q * 8 + i, d = e >> 10, p = (e >> 4) & 63, j = e & 15;
                float vr, vi; cmul(PQ[(d * 64 + p) * 2], PQ[(d * 64 + p) * 2 + 1], bre[p * 16 + j], bim[p * 16 + j], vr, vi);
                const int s = d ? tau : 31 - tau; bf16* col = WM + (size_t)(d * 128 + p) * 512 + s * 16 + j;
                col[0] = (bf16)f2bf(vr); col[(size_t)64 * 512] = (bf16)f2bf(vi); } }
    }
}
__device__ __forceinline__ void s5_pre_wave(Frame& F, int g, int tau) {
    const int lane = (int)lane_now();
    LAS float* cre = (LAS float*)(F.lds + F.wave * 16384); LAS float* cim = cre + 1024; LAS float* bre = cim + 1024; LAS float* bim = bre + 1024;
    bf16* TV = WSP(bf16, WS_TV) + (size_t)g * 512 * 768; bf16* WM = WSP(bf16, WS_WS5) + (size_t)g * 256 * 512; float* AQ = WSP(float, WS_AQ);
    LDS_WAIT(); asm volatile("" ::: "memory");
    { const f32x4* s0 = (const f32x4*)(INP(19) + (size_t)g * 1024); const f32x4* s1 = (const f32x4*)(INP(20) + (size_t)g * 1024); const f32x4* s2 = (const f32x4*)(INP(17) + (size_t)g * 1024); const f32x4* s3 = (const f32x4*)(INP(18) + (size_t)g * 1024);
#pragma unroll
      for (int q = 0; q < 4; ++q) { const int i = q * 64 + lane; *(LAS f32x4*)(cre + 4 * i) = s0[i]; *(LAS f32x4*)(cim + 4 * i) = s1[i]; *(LAS f32x4*)(bre + 4 * i) = s2[i]; *(LAS f32x4*)(bim + 4 * i) = s3[i]; } }
    float Pr[2], Pi[2], Qr[2], Qi[2];
#pragma unroll
    for (int d = 0; d < 2; ++d) {
        const float are = (d ? INP(14) : INP(11))[g * 64 + lane], aim = (d ? INP(15) : INP(12))[g * 64 + lane], step = __expf((d ? INP(16) : INP(13))[g]);
        const float zr = are * step, zi = aim * step;
        const float er = expf(zr), cs = cosf(zi), sn = sinf(zi), abr = er * cs, abi = er * sn;
        const float sh = sinf(0.5f * zi), dr = expm1f(zr) * cs - 2.f * sh * sh, di = abi;
        const float den = 1.0f / (are * are + aim * aim), qr = (dr * are + di * aim) * den, qi = (di * are - dr * aim) * den;
        float pr = 1.f, pi = 0.f, br = abr, bi = abi;
#pragma unroll
        for (int bit = 0; bit < 6; ++bit) { if ((tau >> bit) & 1) { float tr_, ti_; cmul(pr, pi, br, bi, tr_, ti_); pr = tr_; pi = ti_; } float sr_, si_; cmul(br, bi, br, bi, sr_, si_); br = sr_; bi = si_; }
        Pr[d] = pr; Pi[d] = pi; cmul(pr, pi, qr, qi, Qr[d], Qi[d]);
        if (tau == 32) { AQ[((g * 2 + d) * 64 + lane) * 2] = pr; AQ[((g * 2 + d) * 64 + lane) * 2 + 1] = pi; }
    }
    LDS_WAIT(); asm volatile("" ::: "memory");
    if (tau < 32) {
        const int k = lane >> 2, j4 = (lane & 3) * 4; float kf[4] = {0.f, 0.f, 0.f, 0.f}, kb[4] = {0.f, 0.f, 0.f, 0.f};
#pragma unroll 4
        for (int p = 0; p < 64; ++p) { const float cr = cre[k * 64 + p], ci = cim[k * 64 + p]; const f32x4 br4 = *(const LAS f32x4*)(bre + p * 16 + j4), bi4 = *(const LAS f32x4*)(bim + p * 16 + j4);
            const float fr_ = __shfl(Qr[0], p), fi_ = __shfl(Qi[0], p), gr_ = __shfl(Qr[1], p), gi_ = __shfl(Qi[1], p);
            float wr_, wi_; cmul(cr, ci, fr_, fi_, wr_, wi_);
#pragma unroll
            for (int i = 0; i < 4; ++i) kf[i] += wr_ * br4[i] - wi_ * bi4[i];
            cmul(cr, ci, gr_, gi_, wr_, wi_);
#pragma unroll
            for (int i = 0; i < 4; ++i) kb[i] += wr_ * br4[i] - wi_ * bi4[i]; }
        if (tau == 0) { v2u v; v.x = pk2(kf[0] + kb[0], kf[1] + kb[1]); v.y = pk2(kf[2] + kb[2], kf[3] + kb[3]); for (int t = 0; t < 32; ++t) *(v2u*)(TV + (size_t)(t * 16 + k) * 768 + t * 16 + j4) = v; }
        else { v2u vf, vb; vf.x = pk2(kf[0], kf[1]); vf.y = pk2(kf[2], kf[3]); vb.x = pk2(kb[0], kb[1]); vb.y = pk2(kb[2], kb[3]);
            for (int t = tau; t < 32; ++t) { const int s = t - tau; *(v2u*)(TV + (size_t)(t * 16 + k) * 768 + s * 16 + j4) = vf; *(v2u*)(TV + (size_t)(s * 16 + k) * 768 + t * 16 + j4) = vb; } }
    }
    if (tau >= 1) {
#pragma unroll
        for (int d = 0; d < 2; ++d) { const int t = d ? 32 - tau : tau - 1;
#pragma unroll 4
            for (int k = 0; k < 16; ++k) { float vr, vi; cmul(cre[k * 64 + lane], cim[k * 64 + lane], Pr[d], Pi[d], vr, vi);
                bf16* row = TV + (size_t)(t * 16 + k) * 768 + 512 + d * 128; row[lane] = (bf16)f2bf(vr); row[64 + lane] = (bf16)f2bf(-vi); } }
    }
    if (tau < 32) {
        const int j = lane & 15;
#pragma unroll
        for (int d = 0; d < 2; ++d) { const int s = d ? tau : 31 - tau;
#pragma unroll 4
            for (int ps = 0; ps < 16; ++ps) { const int p = 4 * ps + (lane >> 4); const float xr = __shfl(Qr[d], p), xi = __shfl(Qi[d], p);
                float vr, vi; cmul(xr, xi, bre[p * 16 + j], bim[p * 16 + j], vr, vi);
                bf16* col = WM + (size_t)(d * 128 + p) * 512 + s * 16 + j; col[0] = (bf16)f2bf(vr); col[(size_t)64 * 512] = (bf16)f2bf(vi); } }
    }
    LDS_WAIT(); asm volatile("" ::: "memory");
}
__device__ __forceinline__ void p0_s5(Frame& F) { if (F.wave < 4) for (int it = F.bid * 4 + F.wave; it < S5_G * 33; it += F.G * 4) s5_pre_wave(F, it / 33, it % 33); }

__device__ __forceinline__ void s5_scan_item(Frame& F, int item) {
    const int d = item & 1, b = (item >> 1) & 1, g = item >> 2, tid = F.tid;
    LAS float* S = (LAS float*)F.lds;
    const float* SL = WSP(float, WS_SLOC) + ((size_t)(g * 512 + b * 256) * 256 + d * 128);
    __syncthreads();
    {   f32x4 v[16];
#pragma unroll
        for (int q = 0; q < 16; ++q) { const int i = q * NTHR + tid, ci = i >> 5, c4 = (i & 31) * 4; v[q] = *(const f32x4*)(SL + (size_t)ci * 256 + c4); }
#pragma unroll
        for (int q = 0; q < 16; ++q) { const int i = q * NTHR + tid, ci = i >> 5, c4 = (i & 31) * 4; *(LAS f32x4*)(S + ci * 128 + c4) = v[q]; } }
    __syncthreads();
    if (tid < 64) {
        const float* AQ = WSP(float, WS_AQ); const float qr = AQ[((g * 2 + d) * 64 + tid) * 2], qi = AQ[((g * 2 + d) * 64 + tid) * 2 + 1];
        float sr = 0.f, si = 0.f;
#pragma unroll 1
        for (int n0 = 0; n0 < 256; n0 += 16) {
            float tr_[16], ti_[16];
#pragma unroll
            for (int k = 0; k < 16; ++k) { const int ci = d ? 255 - (n0 + k) : n0 + k; tr_[k] = S[ci * 128 + tid]; ti_[k] = S[ci * 128 + 64 + tid]; }
#pragma unroll
            for (int k = 0; k < 16; ++k) { const int ci = d ? 255 - (n0 + k) : n0 + k; S[ci * 128 + tid] = sr; S[ci * 128 + 64 + tid] = si;
                const float nr = qr * sr - qi * si + tr_[k], ni = qr * si + qi * sr + ti_[k]; sr = nr; si = ni; }
        }
    }
    __syncthreads();
    bf16* UC = WSP(bf16, A_UC) + ((size_t)(g * 512 + b * 256) * 768 + 512 + d * 128);
#pragma unroll
    for (int q = 0; q < 8; ++q) { const int i = q * NTHR + tid, ci = i >> 4, c8 = (i & 15) * 8; const LAS float* s = S + ci * 128 + c8;
        v4u o; o.x = pk2(s[0], s[1]); o.y = pk2(s[2], s[3]); o.z = pk2(s[4], s[5]); o.w = pk2(s[6], s[7]);
        *(v4u*)(UC + (size_t)ci * 768 + c8) = o; }
}
__device__ __forceinline__ void unpack8(const v4u w, float (&f)[8]) { f[0] = bflo(w.x); f[1] = bfhi(w.x); f[2] = bflo(w.y); f[3] = bfhi(w.y); f[4] = bflo(w.z); f[5] = bfhi(w.z); f[6] = bflo(w.w); f[7] = bfhi(w.w); }
__device__ __forceinline__ void p2_conv(Frame& F) {
    const bf16* xbc = WSP(bf16, A_XBC); bf16* XT = WSP(bf16, A_XT); bf16* BT = WSP(bf16, A_BT); bf16* BN = WSP(bf16, A_BN); bf16* CN = WSP(bf16, A_CN);
    const float* cw = INP(2); const float* cb = INP(3);
    constexpr int RUN = 16, NCG = XBC / 8, NITEM = (M / RUN) * NCG;
    const int s5lo = (F.G == 256) ? 160 : F.G, NA = (F.G == 256) ? 196608 : 0;
    for (int pass = 0; pass < 2; ++pass)
    for (int item = pass == 0 ? (F.bid < s5lo ? F.bid * NTHR + F.tid : NITEM) : NA + F.bid * NTHR + F.tid; item < (pass == 0 ? NA : NITEM); item += (pass == 0 ? s5lo : F.G) * NTHR) {
        const int cg = item % NCG, r = item / NCG, ch = cg * 8, m0 = r * RUN, tb = m0 % T, bc = m0 >> 7, s0 = m0 & 127;
        float w[5][8], bias[8];
#pragma unroll
        for (int k = 0; k < 5; ++k) { const f32x4 a = *(const f32x4*)(cw + k * XBC + ch), b = *(const f32x4*)(cw + k * XBC + ch + 4); w[k][0] = a.x; w[k][1] = a.y; w[k][2] = a.z; w[k][3] = a.w; w[k][4] = b.x; w[k][5] = b.y; w[k][6] = b.z; w[k][7] = b.w; }
        { const f32x4 a = *(const f32x4*)(cb + ch), b = *(const f32x4*)(cb + ch + 4); bias[0] = a.x; bias[1] = a.y; bias[2] = a.z; bias[3] = a.w; bias[4] = b.x; bias[5] = b.y; bias[6] = b.z; bias[7] = b.w; }
        bf16* nat = nullptr; bf16* trn = nullptr; int trn_stride = 64 * 8;
        int trn_cstride = 8;
        if (ch < SSD_IN) { trn = XT + (size_t)(bc * SSD_H + (ch >> 6)) * 8192 + ((s0 >> 3) * 64 + ((ch & 63) >> 3)) * 8; trn_cstride = 64; }
        else if (ch < SSD_IN + 512) { const int cc = ch - SSD_IN; nat = BN + (size_t)m0 * 512 + cc; trn = BT + (size_t)(bc * SSD_G + (cc >> 7)) * 16384 + ((s0 >> 3) * 128 + (cc & 127)) * 8; trn_stride = 128 * 8; }
        else { nat = CN + (size_t)m0 * 512 + (ch - SSD_IN - 512); }
        v4u rows[RUN + 4];
        const bf16* src = xbc + (size_t)m0 * XBC + ch;
#pragma unroll
        for (int q = 0; q < RUN + 4; ++q) { const int tt = tb - 2 + q; const bool ok = tt >= 0 && tt < T; const int qq = ok ? q - 2 : 0; const v4u v = *(const v4u*)(src + (ptrdiff_t)qq * XBC);
            rows[q].x = ok ? v.x : 0u; rows[q].y = ok ? v.y : 0u; rows[q].z = ok ? v.z : 0u; rows[q].w = ok ? v.w : 0u; }
#pragma unroll
        for (int i8 = 0; i8 < RUN / 8; ++i8) {
            float o[8][8];
#pragma unroll
            for (int ii = 0; ii < 8; ++ii) { const int i = i8 * 8 + ii;
#pragma unroll
                for (int j = 0; j < 8; ++j) o[ii][j] = bias[j];
#pragma unroll
                for (int k = 0; k < 5; ++k) { float f[8]; unpack8(rows[i + k], f);
#pragma unroll
                    for (int j = 0; j < 8; ++j) o[ii][j] += w[k][j] * f[j]; }
#pragma unroll
                for (int j = 0; j < 8; ++j) o[ii][j] = o[ii][j] * __builtin_amdgcn_rcpf(1.0f + __expf(-o[ii][j]));
                if (nat) { v4u q; q.x = pk2(o[ii][0], o[ii][1]); q.y = pk2(o[ii][2], o[ii][3]); q.z = pk2(o[ii][4], o[ii][5]); q.w = pk2(o[ii][6], o[ii][7]); *(v4u*)(nat + (size_t)i * 512) = q; } }
            if (trn) {
#pragma unroll
                for (int j = 0; j < 8; ++j) { v4u q; q.x = pk2(o[0][j], o[1][j]); q.y = pk2(o[2][j], o[3][j]); q.z = pk2(o[4][j], o[5][j]); q.w = pk2(o[6][j], o[7][j]); *(v4u*)(trn + (size_t)i8 * trn_stride + j * trn_cstride) = q; } }
        }
    }
    {
        const int gw = F.bid * NWAVES + F.wave, NGW = F.G * NWAVES, lane = F.lane;
        const float* DT = WSP(float, A_DT); float* SV = WSP(float, A_SV); float* TOT = WSP(float, A_TOT);
        for (int it = gw; it < 128 * SSD_H * 2; it += NGW) {
            const int d = it & 1, h = (it >> 1) % SSD_H, bc = it / (2 * SSD_H);
            const float a = -__expf((d ? INP(5) : INP(4))[h]);
            const size_t mb = (size_t)bc * 128;
            const float dt0 = DT[(mb + 2 * lane) * 48 + d * 24 + h], dt1 = DT[(mb + 2 * lane + 1) * 48 + d * 24 + h];
            const float x0 = dt0 * a, x1 = dt1 * a, ps = x0 + x1;
            float inc = ps;
#pragma unroll
            for (int o = 1; o < 64; o <<= 1) { const float t_ = __shfl_up(inc, o); if (lane >= o) inc += t_; }
            const float total = __shfl(inc, 63), exc = inc - ps;
            const float ci0 = exc + x0, ci1 = inc;
            float cs0, cs1, w0, w1, f0, f1;
            if (d == 0) { cs0 = ci0; cs1 = ci1; w0 = dt0 * __expf(total - ci0); w1 = dt1 * __expf(total - ci1); f0 = __expf(ci0); f1 = __expf(ci1); }
            else { cs0 = exc; cs1 = ci0; w0 = dt0 * __expf(cs0); w1 = dt1 * __expf(cs1); f0 = __expf(total - cs0); f1 = __expf(total - cs1); }
            float* sv = SV + (size_t)it * 4 * 128 + 2 * lane;
            typedef float f32x2 __attribute__((ext_vector_type(2)));
            *(f32x2*)(sv) = (f32x2){w0, w1}; *(f32x2*)(sv + 128) = (f32x2){cs0, cs1}; *(f32x2*)(sv + 256) = (f32x2){dt0, dt1}; *(f32x2*)(sv + 384) = (f32x2){f0, f1};
            if (lane == 0) TOT[it] = __expf(total);
        }
    }
}

typedef short bf16x8 __attribute__((ext_vector_type(8)));
typedef float f32x16 __attribute__((ext_vector_type(16)));
__device__ __forceinline__ unsigned cvtpk(float lo, float hi) { return pg8::cvt_pk_bf16(lo, hi); }
__device__ __forceinline__ void ssd_state_item(Frame& F, int item) {
    unsigned z_ = 0u; asm volatile("" : "+s"(z_)); int lane = (int)__builtin_amdgcn_mbcnt_hi(~0u, __builtin_amdgcn_mbcnt_lo(~0u, z_)); asm volatile("" : "+v"(lane));
    const int nt = item & 3, u = item >> 2, h = u % SSD_H, bc = u / SSD_H, g = h / 6, b = bc >> 6, c = bc & 63, l31 = lane & 31, hf = lane >> 5;
    const bf16* XT = WSP(bf16, A_XT) + (size_t)u * 8192 + l31 * 8; const bf16* BT = WSP(bf16, A_BT) + (size_t)(bc * SSD_G + g) * 16384 + (nt * 32 + l31) * 8;
    const float* SV = WSP(float, A_SV); bf16* S = WSP(bf16, A_S);
    LAS float* wl = (LAS float*)(F.lds + F.wave * 1024);
    LDS_WAIT(); asm volatile("" ::: "memory");
#pragma unroll
    for (int d = 0; d < 2; ++d) { const float* sv = SV + (size_t)(u * 2 + d) * 4 * 128; wl[d * 128 + lane] = sv[lane]; wl[d * 128 + 64 + lane] = sv[64 + lane]; }
    LDS_WAIT(); asm volatile("" ::: "memory");
    f32x16 acc[2][2];
#pragma unroll
    for (int d = 0; d < 2; ++d)
#pragma unroll
        for (int pt = 0; pt < 2; ++pt)
#pragma unroll
            for (int r = 0; r < 16; ++r) acc[d][pt][r] = 0.f;
#pragma unroll
    for (int ks = 0; ks < 8; ++ks) {
        const int sb = ks * 16 + 8 * hf, q = 2 * ks + hf;
        const v4u a = *(const v4u*)(BT + q * 1024);
        const bf16x8 b0 = *(const bf16x8*)(XT + q * 512), b1 = *(const bf16x8*)(XT + q * 512 + 256);
        float af[8]; unpack8(a, af);
#pragma unroll
        for (int d = 0; d < 2; ++d) {
            const f32x4 w0 = *(const LAS f32x4*)(wl + d * 128 + sb), w1 = *(const LAS f32x4*)(wl + d * 128 + sb + 4);
            v4u aw; aw.x = cvtpk(af[0] * w0.x, af[1] * w0.y); aw.y = cvtpk(af[2] * w0.z, af[3] * w0.w); aw.z = cvtpk(af[4] * w1.x, af[5] * w1.y); aw.w = cvtpk(af[6] * w1.z, af[7] * w1.w);
            const bf16x8 av = __builtin_bit_cast(bf16x8, aw);
            acc[d][0] = __builtin_amdgcn_mfma_f32_32x32x16_bf16(av, b0, acc[d][0], 0, 0, 0);
            acc[d][1] = __builtin_amdgcn_mfma_f32_32x32x16_bf16(av, b1, acc[d][1], 0, 0, 0);
        }
    }
#pragma unroll
    for (int d = 0; d < 2; ++d) { bf16* So = S + ((size_t)((b * SSD_H + h) * 2 + d) * 64 + c) * 8192 + nt * 2048 + lane * 4;
#pragma unroll
        for (int pt = 0; pt < 2; ++pt)
#pragma unroll
            for (int q = 0; q < 4; ++q) { v2u o; o.x = cvtpk(acc[d][pt][4 * q], acc[d][pt][4 * q + 1]); o.y = cvtpk(acc[d][pt][4 * q + 2], acc[d][pt][4 * q + 3]);
                *(v2u*)(So + (pt * 4 + q) * 256) = o; } }
}
__device__ __forceinline__ void ssd_scan(Frame& F, int tg, int ntg, int item_lo, int item_hi) {
    bf16* S = WSP(bf16, A_S); const float* TOT = WSP(float, A_TOT);
    for (int item = item_lo + tg; item < item_hi; item += ntg) {
        const int e8 = item & 1023, bhd = item >> 10, d = bhd & 1, h = (bhd >> 1) % SSD_H, b = bhd / (2 * SSD_H);
        bf16* base = S + (size_t)bhd * 64 * 8192 + e8 * 8;
        float H[8];
#pragma unroll
        for (int j = 0; j < 8; ++j) H[j] = 0.f;
#pragma unroll 1
        for (int n0 = 0; n0 < 64; n0 += 16) {
            v4u v[16]; float dec[16];
#pragma unroll
            for (int k = 0; k < 16; ++k) { const int c = d ? 63 - (n0 + k) : n0 + k; v[k] = *(const v4u*)(base + (size_t)c * 8192); dec[k] = TOT[((b * 64 + c) * SSD_H + h) * 2 + d]; }
#pragma unroll
            for (int k = 0; k < 16; ++k) { const int c = d ? 63 - (n0 + k) : n0 + k; float f[8]; unpack8(v[k], f);
                v4u o; o.x = cvtpk(H[0], H[1]); o.y = cvtpk(H[2], H[3]); o.z = cvtpk(H[4], H[5]); o.w = cvtpk(H[6], H[7]);
                *(v4u*)(base + (size_t)c * 8192) = o;
#pragma unroll
                for (int j = 0; j < 8; ++j) H[j] = H[j] * dec[k] + f[j]; }
        }
    }
}
constexpr int PC_SVL_BYTES = 24576, PC_MAT_BYTES = 64 * 272;
__device__ __forceinline__ void pc_prefetch(v4u (&pre)[12], const bf16* XT, const bf16* S, int bc, int b, int c, int g, int i3, int tid) {
#pragma unroll
    for (int q = 0; q < 12; ++q) { const int mtx = q >> 1, hh = mtx / 3, t = mtx % 3, h = g * 6 + hh * 3 + i3, idx = (q & 1) * 512 + tid;
        const bf16* src = (t == 0) ? XT + (size_t)(bc * SSD_H + h) * 8192 + idx * 8 : S + ((size_t)((b * SSD_H + h) * 2 + (t - 1)) * 64 + c) * 8192 + idx * 8;
        pre[q] = *(const v4u*)src; }
}
__device__ __forceinline__ void ssd_out_unit(Frame& F, int unit) {
    unsigned z_ = 0u; asm volatile("" : "+s"(z_)); int lane = (int)__builtin_amdgcn_mbcnt_hi(~0u, __builtin_amdgcn_mbcnt_lo(~0u, z_)); asm volatile("" : "+v"(lane));
    int tid = F.wave * 64 + lane; asm volatile("" : "+v"(tid));
    const int g = unit & 3, bc = unit >> 2, b = bc >> 6, c = bc & 63, l31 = lane & 31, hf = lane >> 5, j = F.wave & 3, hh = F.wave >> 2;
    const size_t mb = (size_t)bc * 128;
    const bf16* CN = WSP(bf16, A_CN) + (mb + 32 * j + l31) * 512 + g * 128 + 8 * hf;
    const bf16* BN = WSP(bf16, A_BN) + (mb + l31) * 512 + g * 128 + 8 * hf;
    const float* SV = WSP(float, A_SV); const bf16* S = WSP(bf16, A_S); const bf16* XT = WSP(bf16, A_XT); bf16* Y = WSP(bf16, A_Y);
    LAS float* svl = (LAS float*)F.lds + hh * 3072;
    LAS unsigned char* mats = F.lds + PC_SVL_BYTES;
    asm volatile("" : "+v"(CN), "+v"(BN));
    __syncthreads();
    {   const f32x4* src = (const f32x4*)(SV + (size_t)((bc * SSD_H + g * 6) * 2) * 512) + tid;
#pragma unroll
        for (int q = 0; q < 3; ++q) *(LAS f32x4*)((LAS float*)F.lds + (q * 512 + tid) * 4) = src[q * 512]; }
    v4u pre[12];
    pc_prefetch(pre, XT, S, bc, b, c, g, 0, tid);
    unsigned cbp[4][8];
    {
        LAS unsigned char* tb = mats; LAS unsigned char* tc = mats + 128 * 272;
        { const bf16* bsrc = WSP(bf16, A_BN) + mb * 512 + g * 128; const bf16* csrc = WSP(bf16, A_CN) + mb * 512 + g * 128; v4u vb_[4], vc_[4];
#pragma unroll
          for (int q = 0; q < 4; ++q) { const int idx = q * 512 + tid, row = idx >> 4, ch = idx & 15; vb_[q] = *(const v4u*)(bsrc + (size_t)row * 512 + ch * 8); vc_[q] = *(const v4u*)(csrc + (size_t)row * 512 + ch * 8); }
#pragma unroll
          for (int q = 0; q < 4; ++q) { const int idx = q * 512 + tid, row = idx >> 4, ch = idx & 15; *(LAS v4u*)(tb + row * 272 + ch * 16) = vb_[q]; *(LAS v4u*)(tc + row * 272 + ch * 16) = vc_[q]; } }
        __syncthreads();
        bf16x8 cfr[8];
#pragma unroll
        for (int ks = 0; ks < 8; ++ks) cfr[ks] = *(const LAS bf16x8*)(tc + (32 * j + l31) * 272 + ks * 32 + hf * 16);
#pragma unroll
        for (int i = 0; i < 4; ++i) { f32x16 t_;
#pragma unroll
            for (int r = 0; r < 16; ++r) t_[r] = 0.f;
#pragma unroll
            for (int ks = 0; ks < 8; ++ks) { const bf16x8 a = *(const LAS bf16x8*)(tb + (32 * i + l31) * 272 + ks * 32 + hf * 16); t_ = __builtin_amdgcn_mfma_f32_32x32x16_bf16(a, cfr[ks], t_, 0, 0, 0); }
#pragma unroll
            for (int r = 0; r < 8; ++r) cbp[i][r] = cvtpk(t_[2 * r], t_[2 * r + 1]);
        }
    }
#define CBT(i_, r_) (((r_) & 1) ? bfhi(cbp[i_][(r_) >> 1]) : bflo(cbp[i_][(r_) >> 1]))
#pragma unroll 1
    for (int i3 = 0; i3 < 3; ++i3) {
        const int h = g * 6 + hh * 3 + i3;
        { int l_ = lane, t_ = tid; asm volatile("" : "+v"(l_), "+v"(t_)); lane = l_; tid = t_; }
        const int l31 = lane & 31, hf = lane >> 5, tl = 32 * j + l31;
        __syncthreads();
#pragma unroll
        for (int q = 0; q < 12; ++q) { const int mtx = q >> 1, idx = (q & 1) * 512 + tid; LAS unsigned char* mt = mats + mtx * PC_MAT_BYTES;
            if ((mtx % 3) == 0) { const int pos = idx & 63, row = (pos & 7) * 8 + (pos >> 3), ch = idx >> 6; *(LAS v4u*)(mt + row * 272 + ch * 16) = pre[q]; }
            else { const int blk = idx >> 5, c_ = idx & 31, nt_ = blk >> 3, pt_ = (blk >> 2) & 1, q_ = blk & 3, hf_ = c_ >> 4, la = (2 * c_) & 31;
                const int pa = 32 * pt_ + la, pb = pa + 1, ra = (pa & 7) * 8 + (pa >> 3), rb = (pb & 7) * 8 + (pb >> 3), cb = (32 * nt_ + 8 * q_ + 4 * hf_) * 2;
                v2u lo_; lo_.x = pre[q].x; lo_.y = pre[q].y; v2u hi_; hi_.x = pre[q].z; hi_.y = pre[q].w;
                *(LAS v2u*)(mt + ra * 272 + cb) = lo_; *(LAS v2u*)(mt + rb * 272 + cb) = hi_; } }
        __syncthreads();
        const LAS float* vf = svl + (i3 * 2 + 0) * 512 + 128; const LAS float* vb = svl + (i3 * 2 + 1) * 512 + 128;
        const float csf_t = vf[tl], sf_t = vf[256 + tl], ecsb_t = vb[tl], sb_t = vb[256 + tl], Dh = INP(8)[h];
        int tlv = tl - 4 * hf; asm volatile("" : "+v"(tlv));
        const LAS unsigned char* mx = mats + (hh * 3 + 0) * PC_MAT_BYTES + l31 * 272 + hf * 8;
        const LAS unsigned char* mf = mats + (hh * 3 + 1) * PC_MAT_BYTES + l31 * 272 + hf * 16;
        const LAS unsigned char* mbk = mats + (hh * 3 + 2) * PC_MAT_BYTES + l31 * 272 + hf * 16;
        f32x16 acc[2];
        {
            const bf16* cn = CN; asm volatile("" : "+v"(cn));
            bf16x8 cfr[8];
#pragma unroll
            for (int ks = 0; ks < 8; ++ks) cfr[ks] = *(const bf16x8*)(cn + ks * 16);
#pragma unroll
            for (int pt = 0; pt < 2; ++pt) { f32x16 af;
#pragma unroll
                for (int r = 0; r < 16; ++r) af[r] = 0.f;
#pragma unroll
                for (int ks = 0; ks < 8; ++ks) { const bf16x8 a0 = *(const LAS bf16x8*)(mf + pt * 32 * 272 + ks * 32); af = __builtin_amdgcn_mfma_f32_32x32x16_bf16(a0, cfr[ks], af, 0, 0, 0); }
#pragma unroll
                for (int r = 0; r < 16; ++r) acc[pt][r] = af[r] * sf_t;
#pragma unroll
                for (int r = 0; r < 16; ++r) af[r] = 0.f;
#pragma unroll
                for (int ks = 0; ks < 8; ++ks) { const bf16x8 a1 = *(const LAS bf16x8*)(mbk + pt * 32 * 272 + ks * 32); af = __builtin_amdgcn_mfma_f32_32x32x16_bf16(a1, cfr[ks], af, 0, 0, 0); }
#pragma unroll
                for (int r = 0; r < 16; ++r) acc[pt][r] += af[r] * sb_t; }
        }
        asm volatile("" ::: "memory");
        if (i3 < 2) pc_prefetch(pre, XT, S, bc, b, c, g, i3 + 1, tid);
#pragma unroll
        for (int i = 0; i < 4; ++i) {
#pragma unroll
            for (int k2 = 0; k2 < 2; ++k2) {
                const int sA = 32 * i + 16 * k2 + 4 * hf;
                float mv[8];
                if (i < j) {
                    const f32x4 c0 = *(const LAS f32x4*)(vf + sA), c1 = *(const LAS f32x4*)(vf + sA + 8), d0 = *(const LAS f32x4*)(vf + 128 + sA), d1 = *(const LAS f32x4*)(vf + 128 + sA + 8);
#pragma unroll
                    for (int e = 0; e < 4; ++e) { mv[e] = CBT(i, 8 * k2 + e) * (d0[e] * __expf(csf_t - c0[e])); mv[4 + e] = CBT(i, 8 * k2 + 4 + e) * (d1[e] * __expf(csf_t - c1[e])); }
                } else if (i > j) {
                    const f32x4 c0 = *(const LAS f32x4*)(vb + sA), c1 = *(const LAS f32x4*)(vb + sA + 8), d0 = *(const LAS f32x4*)(vb + 128 + sA), d1 = *(const LAS f32x4*)(vb + 128 + sA + 8);
#pragma unroll
                    for (int e = 0; e < 4; ++e) { mv[e] = CBT(i, 8 * k2 + e) * (d0[e] * __expf(c0[e] - ecsb_t)); mv[4 + e] = CBT(i, 8 * k2 + 4 + e) * (d1[e] * __expf(c1[e] - ecsb_t)); }
                } else {
                    const f32x4 c0 = *(const LAS f32x4*)(vf + sA), c1 = *(const LAS f32x4*)(vf + sA + 8), d0 = *(const LAS f32x4*)(vf + 128 + sA), d1 = *(const LAS f32x4*)(vf + 128 + sA + 8);
                    const f32x4 g0 = *(const LAS f32x4*)(vb + sA), g1 = *(const LAS f32x4*)(vb + sA + 8), h0 = *(const LAS f32x4*)(vb + 128 + sA), h1 = *(const LAS f32x4*)(vb + 128 + sA + 8);
#pragma unroll
                    for (int e = 0; e < 8; ++e) { const int s_ = 32 * i + 16 * k2 + (e & 3) + 8 * (e >> 2); const float cf = e < 4 ? c0[e & 3] : c1[e & 3], df = e < 4 ? d0[e & 3] : d1[e & 3], cb_ = e < 4 ? g0[e & 3] : g1[e & 3], db = e < 4 ? h0[e & 3] : h1[e & 3];
                        float f = 0.f;
                        f += (s_ <= tlv) ? df * __expf(fminf(csf_t - cf, 0.f)) : 0.f;
                        f += (s_ >= tlv) ? db * __expf(fminf(cb_ - ecsb_t, 0.f)) : 0.f;
                        mv[e] = CBT(i, 8 * k2 + e) * f + ((s_ == tlv) ? Dh : 0.f); }
                }
                v4u mw; mw.x = cvtpk(mv[0], mv[1]); mw.y = cvtpk(mv[2], mv[3]); mw.z = cvtpk(mv[4], mv[5]); mw.w = cvtpk(mv[6], mv[7]);
                const bf16x8 mfr = __builtin_bit_cast(bf16x8, mw);
#pragma unroll
                for (int pt = 0; pt < 2; ++pt) { const v2u x0 = *(const LAS v2u*)(mx + pt * 32 * 272 + 64 * i + 32 * k2), x1 = *(const LAS v2u*)(mx + pt * 32 * 272 + 64 * i + 32 * k2 + 16);
                    v4u xw; xw.x = x0.x; xw.y = x0.y; xw.z = x1.x; xw.w = x1.y;
                    acc[pt] = __builtin_amdgcn_mfma_f32_32x32x16_bf16(__builtin_bit_cast(bf16x8, xw), mfr, acc[pt], 0, 0, 0); }
                asm volatile("" ::: "memory");
            }
        }
        bf16* yo = Y + (mb + tl) * SSD_IN + h * 64 + 4 * hf;
        asm volatile("" : "+v"(yo));
#pragma unroll
        for (int pt = 0; pt < 2; ++pt)
#pragma unroll
            for (int q = 0; q < 4; ++q) { v2u o; o.x = cvtpk(acc[pt][4 * q], acc[pt][4 * q + 1]); o.y = cvtpk(acc[pt][4 * q + 2], acc[pt][4 * q + 3]); *(v2u*)(yo + 32 * pt + 8 * q) = o; }
    }
}

#undef CBT
__device__ __forceinline__ void ssd_norm_unit(Frame& F, int unit) {
    const int g = unit & 3, bc = unit >> 2; const int lane = (int)lane_now(), tq = lane >> 4, j16 = lane & 15;
    const size_t rowbase = ((size_t)bc * 128 + F.wave * 16 + tq) * SSD_IN + g * 384 + j16 * 8;
    bf16* Y = WSP(bf16, A_Y) + rowbase; const bf16* Z = WSP(bf16, A_Z) + rowbase; const float* ng = INP(9) + g * 384 + j16 * 8;
    v4u yv[12], zv[12];
#pragma unroll
    for (int r = 0; r < 4; ++r)
#pragma unroll
        for (int i = 0; i < 3; ++i) zv[r * 3 + i] = *(const v4u*)(Z + (size_t)(4 * r) * SSD_IN + 128 * i);
    asm volatile("s_waitcnt vmcnt(0)" ::: "memory"); __syncthreads();
#pragma unroll
    for (int r = 0; r < 4; ++r)
#pragma unroll
        for (int i = 0; i < 3; ++i) yv[r * 3 + i] = *(const v4u*)(Y + (size_t)(4 * r) * SSD_IN + 128 * i);
    f32x4 g0[3], g1[3];
#pragma unroll
    for (int i = 0; i < 3; ++i) { g0[i] = *(const f32x4*)(ng + 128 * i); g1[i] = *(const f32x4*)(ng + 128 * i + 4); }
#pragma unroll
    for (int r = 0; r < 4; ++r) { float ss = 0.f;
#pragma unroll
        for (int i = 0; i < 3; ++i) { float a[8], z[8]; unpack8(yv[r * 3 + i], a); unpack8(zv[r * 3 + i], z);
#pragma unroll
            for (int jj = 0; jj < 8; ++jj) { a[jj] *= z[jj]; ss += a[jj] * a[jj]; }
            yv[r * 3 + i].x = pk2(a[0], a[1]); yv[r * 3 + i].y = pk2(a[2], a[3]); yv[r * 3 + i].z = pk2(a[4], a[5]); yv[r * 3 + i].w = pk2(a[6], a[7]); }
        ss += __shfl_xor(ss, 1); ss += __shfl_xor(ss, 2); ss += __shfl_xor(ss, 4); ss += __shfl_xor(ss, 8);
        const float rn = 1.0f / sqrtf(ss * (1.0f / 384.0f) + RMS_EPS);
#pragma unroll
        for (int i = 0; i < 3; ++i) { float a[8]; unpack8(yv[r * 3 + i], a);
            v4u o; o.x = pk2(a[0] * rn * g0[i].x, a[1] * rn * g0[i].y); o.y = pk2(a[2] * rn * g0[i].z, a[3] * rn * g0[i].w); o.z = pk2(a[4] * rn * g1[i].x, a[5] * rn * g1[i].y); o.w = pk2(a[6] * rn * g1[i].z, a[7] * rn * g1[i].w);
            *(v4u*)(Y + (size_t)(4 * r) * SSD_IN + 128 * i) = o; } }
}

__device__ __forceinline__ void p8_ln_router(Frame& F) {
    const int gw = F.bid * NWAVES + F.wave, NGW = F.G * NWAVES, lane = F.lane;
    LAS float* wr = (LAS float*)F.lds;
    constexpr int WRP = D + 4;
    for (int i = F.tid; i < D * NE; i += NTHR) wr[(i & 15) * WRP + (i >> 4)] = INP(27)[i];
    __syncthreads();
    const float* HP = WSP(float, A_HP); float* ST = WSP(float, A_ST); unsigned char* H8 = F.ws + A_H8; float* AFF = WSP(float, A_AFF);
    const float* g1 = INP(25); const float* b1 = INP(26);
    f32x4 nx[4];
#pragma unroll
    for (int j = 0; j < 4; ++j) nx[j] = *((const f32x4*)(HP + (size_t)(gw < M ? gw : 0) * D) + lane + 64 * j);
    for (int m = gw; m < M; m += NGW) {
        f32x4 v[4]; float s = 0.f;
#pragma unroll
        for (int j = 0; j < 4; ++j) { v[j] = nx[j]; s += (v[j].x + v[j].y) + (v[j].z + v[j].w); }
        { const int mn = (m + NGW < M) ? m + NGW : m;
#pragma unroll
          for (int j = 0; j < 4; ++j) nx[j] = *((const f32x4*)(HP + (size_t)mn * D) + lane + 64 * j); }
        const float mean = wave_sum(s) * (1.f / D); float s2 = 0.f;
#pragma unroll
        for (int j = 0; j < 4; ++j) { v[j] = v[j] - mean; s2 += (v[j].x * v[j].x + v[j].y * v[j].y) + (v[j].z * v[j].z + v[j].w * v[j].w); }
        const float rstd = 1.f / sqrtf(wave_sum(s2) * (1.f / D) + LN_EPS);
        if (lane == 0) { typedef float f32x2_ __attribute__((ext_vector_type(2))); *(f32x2_*)(ST + 2 * (size_t)m) = (f32x2_){mean, rstd}; }
        float lg[16];
#pragma unroll
        for (int e = 0; e < 16; ++e) lg[e] = 0.f;
#pragma unroll
        for (int j = 0; j < 4; ++j) { const int c = 4 * lane + 256 * j; const f32x4 gg = *(const f32x4*)(g1 + c), bb = *(const f32x4*)(b1 + c);
            v[j] = v[j] * rstd * gg + bb;
            *((unsigned*)(H8 + (size_t)m * D) + lane + 64 * j) = pk4_fp8(v[j].x, v[j].y, v[j].z, v[j].w);
#pragma unroll
            for (int e = 0; e < 16; ++e) { const f32x4 w4 = *(const LAS f32x4*)(wr + e * WRP + c); lg[e] += (v[j].x * w4.x + v[j].y * w4.y) + (v[j].z * w4.z + v[j].w * w4.w); }
            asm volatile("" ::: "memory"); }
        { const bool hi = lane & 32;
#pragma unroll
          for (int k = 0; k < 8; ++k) { const float keep = hi ? lg[k + 8] : lg[k], send = hi ? lg[k] : lg[k + 8]; lg[k] = keep + __shfl_xor(send, 32); } }
        { const bool hi = lane & 16;
#pragma unroll
          for (int k = 0; k < 4; ++k) { const float keep = hi ? lg[k + 4] : lg[k], send = hi ? lg[k] : lg[k + 4]; lg[k] = keep + __shfl_xor(send, 16); } }
        { const bool hi = lane & 8;
#pragma unroll
          for (int k = 0; k < 2; ++k) { const float keep = hi ? lg[k + 2] : lg[k], send = hi ? lg[k] : lg[k + 2]; lg[k] = keep + __shfl_xor(send, 8); } }
        { const bool hi = lane & 4; const float keep = hi ? lg[1] : lg[0], send = hi ? lg[0] : lg[1]; lg[0] = keep + __shfl_xor(send, 4); }
        float lo = lg[0]; lo += __shfl_xor(lo, 2); lo += __shfl_xor(lo, 1);
        float mx = lo;
#pragma unroll
        for (int o = 4; o < 64; o <<= 1) mx = fmaxf(mx, __shfl_xor(mx, o));
        const float ex = expf(lo - mx); float sum = ex;
#pragma unroll
        for (int o = 4; o < 64; o <<= 1) sum += __shfl_xor(sum, o);
        if ((lane & 3) == 0) { const int e = lane >> 2, b = m / T, t = m % T; AFF[((size_t)b * NE + e) * T + t] = ex / sum; }
    }
}

__device__ __forceinline__ unsigned block_excl_scan(unsigned v, LAS unsigned* wsum  , int lane, int wave, unsigned& total) {
    unsigned inc = v;
#pragma unroll
    for (int o = 1; o < 64; o <<= 1) { const unsigned t = __shfl_up(inc, o); if (lane >= o) inc += t; }
    __syncthreads();
    if (lane == 63) wsum[wave] = inc;
    __syncthreads();
    unsigned off = 0, tot = 0;
#pragma unroll
    for (int w = 0; w < 8; ++w) { const unsigned s = wsum[w]; if (w < wave) off += s; tot += s; }
    total = tot; return off + inc - v;
}
__device__ __forceinline__ void p9_topk(Frame& F, int be) {
    const int b = be >> 4, e = be & 15, tid = F.tid;
    const float* av = WSP(float, A_AFF) + (size_t)be * T;
    int* IDX = WSP(int, A_IDX); int* SEL = WSP(int, A_SEL); float* GATE = WSP(float, A_GATE);
    LAS unsigned* hist = (LAS unsigned*)F.lds; LAS unsigned* shv = hist + 256; LAS unsigned* wsum = hist + 272;
    unsigned key[16];
#pragma unroll
    for (int q = 0; q < 4; ++q) { const v4u k4 = *(const v4u*)(av + tid * 16 + 4 * q); key[4 * q] = k4.x; key[4 * q + 1] = k4.y; key[4 * q + 2] = k4.z; key[4 * q + 3] = k4.w; }
    unsigned lo = 0u, hi_ex = 0u;
    bool hi_set = false;
    for (int it = 0; it < 32; ++it) {
        const unsigned span = (hi_set ? hi_ex : 0u) - lo;
        const unsigned mid = lo + (span >> 1) + ((span == 0u && !hi_set) ? 0x80000000u : 0u);
        unsigned cnt = 0;
#pragma unroll
        for (int i = 0; i < 16; ++i) cnt += (unsigned)__builtin_popcountll(__ballot(key[i] >= mid));
        LAS unsigned* slot_ = wsum + 16 + (it & 1) * 8;
        if (F.lane == 0) slot_[F.wave] = cnt;
        __syncthreads();
        unsigned tot = 0;
#pragma unroll
        for (int w = 0; w < 8; ++w) tot += slot_[w];
        if (tot >= (unsigned)CAP) lo = mid; else { hi_ex = mid; hi_set = true; }
    }
    const unsigned Tk = lo;
    unsigned krem;
    { unsigned cnt = 0;
#pragma unroll
      for (int i = 0; i < 16; ++i) cnt += (unsigned)__builtin_popcountll(__ballot(key[i] > Tk));
      __syncthreads(); if (F.lane == 0) wsum[16 + F.wave] = cnt; __syncthreads();
      unsigned tot = 0;
#pragma unroll
      for (int w = 0; w < 8; ++w) tot += wsum[16 + w];
      krem = (unsigned)CAP - tot; __syncthreads(); }
    unsigned cg = 0, ce = 0;
#pragma unroll
    for (int i = 0; i < 16; ++i) { cg += key[i] > Tk; ce += key[i] == Tk; }
    unsigned totg, tote;
    unsigned pg = block_excl_scan(cg, wsum, F.lane, F.wave, totg);
    unsigned pe = block_excl_scan(ce, wsum + 8, F.lane, F.wave, tote);
#pragma unroll
    for (int i = 0; i < 16; ++i) {
        const int t = tid * 16 + i; int slot = -1;
        if (key[i] > Tk) slot = (int)(pg++);
        else if (key[i] == Tk) { if (pe < krem) slot = (int)(totg + pe); ++pe; }
        const size_t m = (size_t)b * T + t;
        SEL[m * NE + e] = slot; GATE[m * NE + e] = __uint_as_float(key[i]);
        if (slot >= 0) IDX[(e * NB + b) * CAP + slot] = (int)m;
    }
    __builtin_amdgcn_fence(__ATOMIC_RELEASE, "agent"); asm volatile("s_waitcnt vmcnt(0)" ::: "memory"); __syncthreads();
    if (tid == 0) __hip_atomic_store((unsigned*)(F.ws + WS_CTL) + CW_LIST + 64 * be, 1u, __ATOMIC_RELAXED, __HIP_MEMORY_SCOPE_AGENT);
}
__device__ __forceinline__ void gather_rows_after(Frame& F, int r0, int nrows) {
    const int li = r0 >> 10, e = li >> 1, b = li & 1, be = b * 16 + e;
    if (F.wave == 0) { unsigned* flag = (unsigned*)(F.ws + WS_CTL) + CW_LIST + 64 * be; unsigned spins = 0;
        while (__builtin_amdgcn_readfirstlane(__hip_atomic_load(flag, __ATOMIC_RELAXED, __HIP_MEMORY_SCOPE_AGENT)) == 0u) { __builtin_amdgcn_s_sleep(2); if (++spins > (1u << 22)) break; }
        __builtin_amdgcn_fence(__ATOMIC_ACQUIRE, "agent"); asm volatile("s_waitcnt vmcnt(0)" ::: "memory"); }
    __syncthreads();
    const int* IDX = WSP(int, A_IDX); const unsigned char* H8 = F.ws + A_H8; unsigned char* XIN = F.ws + A_XIN; const int lane = F.lane;
    for (int rr = F.wave; rr < nrows; rr += 8 * NWAVES) {
        v4u va[8];
#pragma unroll
        for (int q = 0; q < 8; ++q) { const int ri = rr + q * NWAVES < nrows ? rr + q * NWAVES : rr; const int m_ = IDX[r0 + ri]; va[q] = *((const v4u*)(H8 + (size_t)m_ * D) + lane); }
#pragma unroll
        for (int q = 0; q < 8; ++q) if (rr + q * NWAVES < nrows) *((v4u*)(XIN + (size_t)(r0 + rr + q * NWAVES) * D) + lane) = va[q];
    }
}
__device__ __forceinline__ void moe_accumulate(f32x4 (&v)[4], int sl, float gt, int b, const bf16* YE, int lane) {
    unsigned mask = (unsigned)(__ballot(sl >= 0) & 0xffffull);
    while (mask) {
        int e[4]; float gv[4]; const bf16* yr[4];
#pragma unroll
        for (int k = 0; k < 4; ++k) { const bool ok = mask != 0u; const int ek = ok ? __builtin_ctz(mask) : e[k > 0 ? k - 1 : 0]; if (ok) mask &= mask - 1u; e[k] = ek;
            const int s = __shfl(sl, ek); gv[k] = ok ? __shfl(gt, ek) : 0.f; yr[k] = YE + ((size_t)(ek * NB + b) * CAP + (s < 0 ? 0 : s)) * D; }
        v2u w[4][4];
#pragma unroll
        for (int k = 0; k < 4; ++k)
#pragma unroll
            for (int j = 0; j < 4; ++j) w[k][j] = *((const v2u*)yr[k] + lane + 64 * j);
#pragma unroll
        for (int k = 0; k < 4; ++k)
#pragma unroll
            for (int j = 0; j < 4; ++j) { v[j].x += gv[k] * bflo(w[k][j].x); v[j].y += gv[k] * bfhi(w[k][j].x); v[j].z += gv[k] * bflo(w[k][j].y); v[j].w += gv[k] * bfhi(w[k][j].y); }
    }
}
__device__ __forceinline__ void ln_row_store(f32x4 (&v)[4], const float* g2, const float* b2, float* orow, int lane) {
    float s = 0.f;
#pragma unroll
    for (int j = 0; j < 4; ++j) s += (v[j].x + v[j].y) + (v[j].z + v[j].w);
    const float mean = wave_sum(s) * (1.f / D); float s2 = 0.f;
#pragma unroll
    for (int j = 0; j < 4; ++j) { v[j] = v[j] - mean; s2 += (v[j].x * v[j].x + v[j].y * v[j].y) + (v[j].z * v[j].z + v[j].w * v[j].w); }
    const float rstd = 1.f / sqrtf(wave_sum(s2) * (1.f / D) + LN_EPS);
#pragma unroll
    for (int j = 0; j < 4; ++j) { const int c = 4 * lane + 256 * j; const f32x4 gg = *(const f32x4*)(g2 + c), bb = *(const f32x4*)(b2 + c);
        *((f32x4*)orow + lane + 64 * j) = v[j] * rstd * gg + bb; }
}
__device__ __forceinline__ void p13_final(Frame& F) {
    const int gw = F.bid * NWAVES + F.wave, NGW = F.G * NWAVES, lane = F.lane;
    const float* HP = WSP(float, A_HP); const float* ST = WSP(float, A_ST); const float* g1 = INP(25); const float* b1 = INP(26); const int* SEL = WSP(int, A_SEL); const float* GATE = WSP(float, A_GATE); const bf16* YE = WSP(bf16, A_YE);
    const float* g2 = INP(31); const float* b2 = INP(32);
    for (int m = gw; m < M; m += 2 * NGW) {
        const int mB = (m + NGW < M) ? m + NGW : m;
        const int slA = SEL[(size_t)m * NE + (lane & 15)], slB = SEL[(size_t)mB * NE + (lane & 15)]; const float gtA = GATE[(size_t)m * NE + (lane & 15)], gtB = GATE[(size_t)mB * NE + (lane & 15)];
        typedef float f32x2_ __attribute__((ext_vector_type(2))); const f32x2_ stA = *(const f32x2_*)(ST + 2 * (size_t)m), stB = *(const f32x2_*)(ST + 2 * (size_t)mB);
        f32x4 vA[4], vB[4];
#pragma unroll
        for (int j = 0; j < 4; ++j) { const int c = 4 * lane + 256 * j; const f32x4 gg = *(const f32x4*)(g1 + c) * ALPHA, bb = *(const f32x4*)(b1 + c) * ALPHA;
            vA[j] = (*((const f32x4*)(HP + (size_t)m * D) + lane + 64 * j) - stA.x) * stA.y * gg + bb; vB[j] = (*((const f32x4*)(HP + (size_t)mB * D) + lane + 64 * j) - stB.x) * stB.y * gg + bb; }
        moe_accumulate(vA, slA, gtA, m / T, YE, lane); moe_accumulate(vB, slB, gtB, mB / T, YE, lane);
        ln_row_store(vA, g2, b2, F.out + (size_t)m * D, lane);
        if (mB != m) ln_row_store(vB, g2, b2, F.out + (size_t)mB * D, lane);
    }
}

constexpr int N_PHASES = 16;
struct Args { const float* in[33]; float* out; unsigned char* ws; int ph_lo, ph_hi; };
__global__ void __launch_bounds__(NTHR, 2) fwd(Args args) {
    extern __shared__ __attribute__((aligned(16))) unsigned char lds[];
    Frame F;
    F.lds = (LAS unsigned char*)lds;
    F.tid = threadIdx.x; F.lane = F.tid & 63; F.wave = __builtin_amdgcn_readfirstlane(F.tid >> 6);
    F.bid = blockIdx.x; F.G = gridDim.x;
    F.ptab = (LAS unsigned*)(F.lds + MISC_OFF + 512);
    if (F.tid < 33) { const unsigned long long p_ = (unsigned long long)args.in[F.tid]; F.ptab[2 * F.tid] = (unsigned)p_; F.ptab[2 * F.tid + 1] = (unsigned)(p_ >> 32); }
    F.out = args.out; F.ws = args.ws;
    volatile LAS unsigned* MISC = (volatile LAS unsigned*)(F.lds + MISC_OFF);
    if (F.tid < 64) MISC[F.tid] = 0u;
    __syncthreads();
    const int lo = args.ph_lo, hi = args.ph_hi;
    const bool single = (hi - lo) > 1;
    XcdBarrier bar; bar.bar = (unsigned*)(F.ws + WS_CTL) + CW_BAR; bar.x = 0; bar.st = nullptr;
    if (single) bar = xcd_barrier_post((unsigned*)(F.ws + WS_CTL) + CW_BAR, MISC + 8);
#ifndef PH_MASK
#define PH_MASK 0xffff
#endif
#define IN(k) (((PH_MASK >> (k)) & 1) && lo <= (k) && (k) < hi)
#define LAUNDER1(T_, p_) do { unsigned long long x_ = (unsigned long long)(p_); unsigned lo_ = (unsigned)x_, hi_ = (unsigned)(x_ >> 32); asm volatile("" : "+v"(lo_), "+v"(hi_)); \
        lo_ = __builtin_amdgcn_readfirstlane(lo_); hi_ = __builtin_amdgcn_readfirstlane(hi_); (p_) = (T_)(((unsigned long long)hi_ << 32) | lo_); } while (0)
#define LAUNDER() do { F.lane = (int)lane_now(); F.tid = F.wave * 64 + F.lane; } while (0)
#define SEAM(k) do { if (IN(k) && IN((k) + 1)) xcd_barrier(bar, T0()); } while (0)

#define T0() (F.wave == 0 && lane_now() == 0u)

    if (IN(0)) { LAUNDER(); p0_s5(F); p0_prologue(F); w1_convert(F, F.bid * NWAVES + F.wave, F.G * NWAVES, F.G == 256 ? (unsigned*)(F.ws + WS_CTL) + CW_QW1 : nullptr); } SEAM(0);
    if (IN(1)) { LAUNDER();
        pg8::Gemm g{WSP(pg8::bf16_t, A_XB), WSP(pg8::bf16_t, WS_WIN), M, NIN_PAD, D, D, D}; pg8::StaticOrder S; S.init(M, NIN_PAD, F.G, F.bid);
        pg8::EpiIn E{WSP(pg8::bf16_t, A_Z), WSP(pg8::bf16_t, A_XBC), WSP(pg8::bf16_t, A_UC), WSP(pg8::bf16_t, A_GT), WSP(float, A_DT), INP(6), INP(7)};
        const int ngw_ = F.G * NWAVES, cut_ = ((F.bid >> 3) & 3) * 2 * ngw_;
        w2_convert(F, F.bid * NWAVES + F.wave, ngw_, 0, cut_); __syncthreads();
        pg8::gemm_phase<pg8::EpiIn, pg8::StaticOrder, PG8_ALIGN, PG8_SP2>(F.lds, g, S, E, F.tid);
        __syncthreads(); w2_convert(F, F.bid * NWAVES + F.wave, ngw_, cut_);
    } SEAM(1);
    if (IN(2)) { LAUNDER();

        if (F.bid >= 160) { pg8::Gemm g{WSP(pg8::bf16_t, A_UC), WSP(pg8::bf16_t, WS_WS5), S5_G * 512, S5_G * 256, 512, 768, 512}; pg8::S5aOrder S{F.bid, 160};
            pg8::EpiS5a E{WSP(float, WS_SLOC)};
            pg8::gemm_phase<pg8::EpiS5a, pg8::S5aOrder, PG8_ALIGN, PG8_SP2>(F.lds, g, S, E, F.tid); __syncthreads(); }

        p2_conv(F);
        __syncthreads();
    } SEAM(2);
    if (IN(3)) { LAUNDER();
        for (int it = F.bid; it < S5_G * 4; it += F.G) s5_scan_item(F, it);
        __syncthreads();
        for (int it = F.bid * NWAVES + F.wave; it < 128 * SSD_H * 4; it += F.G * NWAVES) ssd_state_item(F, it);
    } SEAM(3);
    if (IN(4)) { LAUNDER();
        { pg8::Gemm g{WSP(pg8::bf16_t, A_UC), WSP(pg8::bf16_t, WS_TV), S5_G * 512, S5_G * 512, 768, 768, 768}; pg8::S5cOrder S{F.G, F.bid};
          pg8::EpiS5c E{WSP(pg8::bf16_t, A_GY), WSP(pg8::bf16_t, A_UC), INP(21)};
          pg8::gemm_phase<pg8::EpiS5c, pg8::S5cOrder, PG8_ALIGN, PG8_SP2>(F.lds, g, S, E, F.tid); }

        if (F.G == 256) { if (F.bid >= 192) ssd_scan(F, (F.bid - 192) * NTHR + F.tid, 64 * NTHR, 0, 65536); else if (F.bid < 64) ssd_scan(F, F.bid * NTHR + F.tid, 64 * NTHR, 65536, 96 * 1024); }
        else ssd_scan(F, F.bid * NTHR + F.tid, F.G * NTHR, 0, 96 * 1024);
    } SEAM(4);
    if (IN(5)) { LAUNDER(); __syncthreads();
        for (int u = F.bid; u < 128 * SSD_G; u += F.G) { ssd_out_unit(F, u); ssd_norm_unit(F, u); }
        __syncthreads();
        { pg8::Gemm g{WSP(pg8::bf16_t, A_GY), WSP(pg8::bf16_t, WS_WGLU), M, 2 * D, S5_W, S5_W, S5_W}; pg8::StaticOrder S; S.init(M, 2 * D, F.G, F.bid);
          pg8::EpiGlu E{WSP(pg8::bf16_t, A_YB), WSP(pg8::bf16_t, A_GT)};
          pg8::gemm_phase<pg8::EpiGlu, pg8::StaticOrder, PG8_ALIGN, PG8_SP2>(F.lds, g, S, E, F.tid); }
    } SEAM(5);
    if (IN(7)) { LAUNDER();
        pg8::Gemm g{WSP(pg8::bf16_t, A_Y), WSP(pg8::bf16_t, WS_WOUT), M, D, SSD_IN, SSD_IN, SSD_IN}; pg8::StaticOrder S; S.init(M, D, F.G, F.bid);
        pg8::EpiSsdOut E{WSP(pg8::bf16_t, A_MIX), WSP(pg8::bf16_t, A_YB), WSP(pg8::bf16_t, A_GT)};
        pg8::gemm_phase<pg8::EpiSsdOut, pg8::StaticOrder, PG8_ALIGN, PG8_SP2>(F.lds, g, S, E, F.tid);
    } SEAM(7);
    if (IN(9)) { LAUNDER();
        pg8::Gemm g{WSP(pg8::bf16_t, A_MIX), WSP(pg8::bf16_t, WS_WO), M, D, D, D, D}; pg8::StaticOrder S; S.init(M, D, F.G, F.bid);
        pg8::EpiWo E{WSP(float, A_HP), INP(0), ALPHA};
        pg8::gemm_phase<pg8::EpiWo, pg8::StaticOrder, PG8_ALIGN, PG8_SP2>(F.lds, g, S, E, F.tid);
    } SEAM(9);
    if (IN(10)) { LAUNDER(); p8_ln_router(F); } SEAM(10);
    if (IN(11)) { LAUNDER();
        if (F.bid < NB * NE) p9_topk(F, F.bid);
        __syncthreads();
        for (int r0 = F.bid * (MROWS / 256); r0 < MROWS; r0 += F.G * (MROWS / 256)) gather_rows_after(F, r0, MROWS / 256); __syncthreads(); } SEAM(11);

    if (IN(13)) { LAUNDER();
        pg8::Gemm g{WSP(pg8::bf16_t, A_XIN), WSP(pg8::bf16_t, WS_W1), MROWS, NE * 2 * FF, D, D, D}; pg8::MoeOrder1 S{F.G, F.bid};
        pg8::EpiMoe1 E{F.ws + A_HID, 1.0f / W1_SCALE, HID_SCALE};
        pg8::gemm_phase<pg8::EpiMoe1, pg8::MoeOrder1, PG8_ALIGN, PG8_SP2, true>(F.lds, g, S, E, F.tid);
    } SEAM(13);
    if (IN(14)) { LAUNDER();
        pg8::Gemm g{WSP(pg8::bf16_t, A_HID), WSP(pg8::bf16_t, WS_W2), MROWS, NE * D, FF, FF, FF}; pg8::MoeOrder2 S{F.G, F.bid};
        pg8::EpiMoe2 E{WSP(pg8::bf16_t, A_YE), 1.0f / (W2_SCALE * HID_SCALE)};
        pg8::gemm_phase<pg8::EpiMoe2, pg8::MoeOrder2, PG8_ALIGN, PG8_SP2, true>(F.lds, g, S, E, F.tid);
    } SEAM(14);
    if (IN(15)) { LAUNDER(); p13_final(F); }
#undef IN
#undef SEAM
}

#ifndef MK_ONE_LAUNCH
#define MK_ONE_LAUNCH 1
#endif
extern "C" void kernel_launch(void* const* d_in, const int* in_sizes, int n_in, void* d_out, int out_size, void* d_ws, size_t ws_size, hipStream_t stream) {
    static int grid = 0;
    if (grid == 0) {
        if (n_in != 33 || in_sizes[0] != M * D || out_size != M * D || ws_size < WS_END) { fprintf(stderr, "kernel_launch: unexpected problem (n_in %d, in0 %d, out %d, ws %zu < %zu)\n", n_in, n_in > 0 ? in_sizes[0] : -1, out_size, ws_size, (size_t)WS_END); grid = -1; return; }
        int dev = 0, cus = 0, per_cu = 0;
        if (hipGetDevice(&dev) != hipSuccess || hipDeviceGetAttribute(&cus, hipDeviceAttributeMultiprocessorCount, dev) != hipSuccess) { grid = -1; return; }
        if (hipFuncSetAttribute((const void*)fwd, hipFuncAttributeMaxDynamicSharedMemorySize, LDS_BYTES) != hipSuccess) { fprintf(stderr, "kernel_launch: hipFuncSetAttribute failed\n"); grid = -1; return; }
        if (hipOccupancyMaxActiveBlocksPerMultiprocessor(&per_cu, (const void*)fwd, NTHR, LDS_BYTES) != hipSuccess || per_cu < 1) fprintf(stderr, "kernel_launch: occupancy query reports %d blocks per CU\n", per_cu);
        (void)hipGetLastError();
        grid = cus;
    }
    if (grid < 0) return;
    (void)hipMemsetAsync((char*)d_ws + WS_CTL, 0, CTL_ZERO_BYTES, stream);
    Args a{};
    for (int i = 0; i < 33; ++i) a.in[i] = (const float*)d_in[i];
    a.out = (float*)d_out; a.ws = (unsigned char*)d_ws;
#if MK_ONE_LAUNCH
    a.ph_lo = 0; a.ph_hi = N_PHASES;
    hipLaunchKernelGGL(fwd, dim3(grid), dim3(NTHR), LDS_BYTES, stream, a);
#else
    for (int p = 0; p < N_PHASES; ++p) { a.ph_lo = p; a.ph_hi = p + 1; hipLaunchKernelGGL(fwd, dim3(grid), dim3(NTHR), LDS_BYTES, stream, a); }
#endif
}
```

```cpp
#include <hip/hip_runtime.h>
#include <cstdio>
#include <cstdint>
namespace pg8 {
#define PG8_LAS __attribute__((address_space(3)))
typedef unsigned short bf16_t;
typedef short bf16x8 __attribute__((ext_vector_type(8)));
typedef float f32x4 __attribute__((ext_vector_type(4)));
typedef unsigned u32x4 __attribute__((ext_vector_type(4)));
typedef int i32x8 __attribute__((ext_vector_type(8)));
constexpr int BM = 256, BK = 64, HALF = 128, HTB = HALF * BK * 2  , STAGE_BYTES = 8 * HTB, NXCD = 8, WGM = 8;

__host__ __device__ __forceinline__ int lds_byte(int r, int c) { const int st = (r >> 4) * 2 + (c >> 5), rr = r & 15, cc = c & 31, ob = rr * 64 + cc * 2; return st * 1024 + (ob ^ (((ob >> 9) & 1) << 5)); }
__host__ __device__ __forceinline__ void stage_rc(int b, int& R, int& C) { const int st = b / 1024, sb = b % 1024, swz = sb ^ (((sb >> 9) & 1) << 5); R = (st >> 1) * 16 + swz / 64; C = (st & 1) * 32 + (swz % 64) / 2; }
__host__ __device__ __forceinline__ int perm32(int rho) { const int n = rho >> 4, i = rho & 15; return 8 * (i >> 2) + 4 * n + (i & 3); }

struct Unit { int pm, pn; };
struct Gemm { const bf16_t* A; const bf16_t* Bt; int M, N, K, lda, ldb; };

struct StaticOrder {
    int nM, nN, nwg, G, c;
    __host__ __device__ void init(int M, int N, int G_, int c_) { nM = M / BM; nN = N / BM; nwg = nM * nN; G = G_; c = c_; }
    __host__ __device__ bool next(int i, Unit& u) const {
        const long L = (long)i * G + c; if (L >= nwg) return false;
        int wgid = (int)L; { const int q = nwg / NXCD, r = nwg % NXCD, xcd = wgid % NXCD, off = wgid / NXCD; wgid = (xcd < r ? xcd * (q + 1) : r * (q + 1) + (xcd - r) * q) + off; }
        const int nig = WGM * nN, gid = wgid / nig, fm = gid * WGM, gsz = (nM - fm) < WGM ? (nM - fm) : WGM;
        u.pm = fm + ((wgid % nig) % gsz); u.pn = (wgid % nig) / gsz; return true;
    }
    __device__ __forceinline__ void a_ready(const Unit&) const {}
    __device__ __forceinline__ void done(const Unit&) const {}
};

typedef __bf16 bf16v2_t __attribute__((ext_vector_type(2)));
typedef float f32v2_t __attribute__((ext_vector_type(2)));
__device__ __forceinline__ unsigned cvt_pk_bf16(float lo, float hi) { const f32v2_t f = {lo, hi}; return __builtin_bit_cast(unsigned, __builtin_convertvector(f, bf16v2_t)); }
typedef float f32x2 __attribute__((ext_vector_type(2)));
__device__ __forceinline__ f32x2 gelu_pk(f32x2 v) {
    const f32x2 av = __builtin_elementwise_abs(v), d = av * 0.2316418882f + 1.0f;
    f32x2 t; t.x = __builtin_amdgcn_rcpf(d.x); t.y = __builtin_amdgcn_rcpf(d.y);
    f32x2 q = t * 0.5307027145f + (-0.7265760135f); q = q * t + 0.7107068705f; q = q * t + (-0.142248368f); q = q * t + 0.127414796f; q = q * t;
    const f32x2 s = (v * v) * (-0.72134752044f);
    f32x2 e; e.x = __builtin_amdgcn_exp2f(s.x); e.y = __builtin_amdgcn_exp2f(s.y);
    const f32x2 m = v * (q * e), r = v - m;
    f32x2 o; o.x = v.x < 0.f ? m.x : r.x; o.y = v.y < 0.f ? m.y : r.y; return o;
}


__device__ __forceinline__ float fsigmoid(float x) { return __builtin_amdgcn_rcpf(1.0f + __expf(-x)); }
__device__ __forceinline__ float fsilu(float x) { return x * fsigmoid(x); }
__device__ __forceinline__ float bf_lo(unsigned w) { return __uint_as_float(w << 16); }
__device__ __forceinline__ float bf_hi(unsigned w) { return __uint_as_float(w & 0xffff0000u); }
typedef unsigned u32x2 __attribute__((ext_vector_type(2)));

struct EpiIn {
    static constexpr bool PERM = true, AFTER_DRAIN = false;
    bf16_t *Z, *XBC, *UC, *GT; float* DT; const float *dtb_f, *dtb_b;
    __device__ __forceinline__ void operator()(const f32x4 (&acc)[2][2][4][2], const Unit& u, int wr, int wc, int fr, int fq) const {
        const int row0 = u.pm * BM + wr * 64 + fr; const int pn = u.pn;
        if (pn == 16) {
            if (wc < 2) {
#pragma unroll
                for (int n = 0; n < 2; ++n) { const int col = wc * 32 + 8 * fq + 4 * n;
                    if (col < 48) { f32x4 bv;
#pragma unroll
                        for (int j = 0; j < 4; ++j) { const int cc = col + j; bv[j] = cc < 24 ? dtb_f[cc] : dtb_b[cc - 24]; }
#pragma unroll
                        for (int ai = 0; ai < 2; ++ai)
#pragma unroll
                            for (int m = 0; m < 4; ++m) { f32x4 v = acc[ai][0][m][n] + bv;
#pragma unroll
                                for (int j = 0; j < 4; ++j) { const float x = v[j]; v[j] = fmaxf(x, 0.f) + log1pf(__expf(-fabsf(x))); }
                                *(f32x4*)(DT + (size_t)(row0 + ai * HALF + m * 16) * 48 + col) = v; } } }
            }
            return;
        }
        int mode, ldc, colt; bf16_t* base;
        if (pn < 6) { mode = 1; base = Z; ldc = 1536; colt = pn * BM; }
        else if (pn < 16) { mode = 0; base = XBC; ldc = 2560; colt = (pn - 6) * BM; }
        else if (pn < 20) {
            const int uc = (pn - 17) * BM + wc * 32 + 8 * fq, g0 = uc >> 4, j0 = uc & 15;
#pragma unroll
            for (int ai = 0; ai < 2; ++ai)
#pragma unroll
                for (int m = 0; m < 4; ++m) { const int r = row0 + ai * HALF + m * 16, cl = r >> 5, s = r & 31;
#pragma unroll
                    for (int bj = 0; bj < 2; ++bj) { const f32x4 v0 = acc[ai][bj][m][0], v1 = acc[ai][bj][m][1];
                        u32x4 w; w.x = cvt_pk_bf16(v0[0], v0[1]); w.y = cvt_pk_bf16(v0[2], v0[3]); w.z = cvt_pk_bf16(v1[0], v1[1]); w.w = cvt_pk_bf16(v1[2], v1[3]);
                        *(u32x4*)(UC + ((size_t)((g0 + 8 * bj) * 512 + cl) * 768 + s * 16 + j0)) = w; } }
            return; }
        else { mode = 2; base = GT; ldc = 2048; colt = (pn - 20) * BM; }
        const int col0 = colt + wc * 32 + 8 * fq;
#pragma unroll
        for (int ai = 0; ai < 2; ++ai)
#pragma unroll
            for (int m = 0; m < 4; ++m) { bf16_t* rowp = base + (size_t)(row0 + ai * HALF + m * 16) * ldc + col0;
#pragma unroll
                for (int bj = 0; bj < 2; ++bj) { f32x4 v0 = acc[ai][bj][m][0], v1 = acc[ai][bj][m][1];
                    if (mode == 1) {
#pragma unroll
                        for (int j = 0; j < 4; ++j) { v0[j] = fsilu(v0[j]); v1[j] = fsilu(v1[j]); } }
                    else if (mode == 2) {
#pragma unroll
                        for (int j = 0; j < 4; ++j) { v0[j] = fsigmoid(v0[j]); v1[j] = fsigmoid(v1[j]); } }
                    u32x4 w; w.x = cvt_pk_bf16(v0[0], v0[1]); w.y = cvt_pk_bf16(v0[2], v0[3]); w.z = cvt_pk_bf16(v1[0], v1[1]); w.w = cvt_pk_bf16(v1[2], v1[3]);
                    *(u32x4*)(rowp + bj * HALF) = w; } }
    }
};
struct EpiSsdOut {
    static constexpr bool PERM = true, AFTER_DRAIN = false;
    bf16_t* MIX; const bf16_t* YB; const bf16_t* GT;
    __device__ __forceinline__ void operator()(const f32x4 (&acc)[2][2][4][2], const Unit& u, int wr, int wc, int fr, int fq) const {
        const int row0 = u.pm * BM + wr * 64 + fr, col0 = u.pn * BM + wc * 32 + 8 * fq;
#pragma unroll
        for (int ai = 0; ai < 2; ++ai)
#pragma unroll
            for (int m = 0; m < 4; ++m) { const size_t r = (size_t)(row0 + ai * HALF + m * 16);
#pragma unroll
                for (int bj = 0; bj < 2; ++bj) { const int c = col0 + bj * HALF; const u32x4 g = *(const u32x4*)(GT + r * 2048 + c), y = *(const u32x4*)(YB + r * 1024 + c);
                    const f32x4 a0 = acc[ai][bj][m][0], a1 = acc[ai][bj][m][1];
                    u32x4 w; w.x = cvt_pk_bf16(a0[0] * bf_lo(g.x) + bf_lo(y.x), a0[1] * bf_hi(g.x) + bf_hi(y.x)); w.y = cvt_pk_bf16(a0[2] * bf_lo(g.y) + bf_lo(y.y), a0[3] * bf_hi(g.y) + bf_hi(y.y));
                    w.z = cvt_pk_bf16(a1[0] * bf_lo(g.z) + bf_lo(y.z), a1[1] * bf_hi(g.z) + bf_hi(y.z)); w.w = cvt_pk_bf16(a1[2] * bf_lo(g.w) + bf_lo(y.w), a1[3] * bf_hi(g.w) + bf_hi(y.w));
                    *(u32x4*)(MIX + r * 1024 + c) = w; } }
    }
};
struct EpiGlu {
    static constexpr bool PERM = true, AFTER_DRAIN = false;
    bf16_t* YB; const bf16_t* GT;
    __device__ __forceinline__ void operator()(const f32x4 (&acc)[2][2][4][2], const Unit& u, int wr, int wc, int fr, int fq) const {
        const int row0 = u.pm * BM + wr * 64 + fr, col0 = u.pn * HALF + wc * 32 + 8 * fq;
#pragma unroll
        for (int ai = 0; ai < 2; ++ai)
#pragma unroll
            for (int m = 0; m < 4; ++m) { const size_t r = (size_t)(row0 + ai * HALF + m * 16);
                const u32x4 g = *(const u32x4*)(GT + r * 2048 + 1024 + col0);
                f32x4 a0 = acc[ai][0][m][0], a1 = acc[ai][0][m][1]; const f32x4 b0 = acc[ai][1][m][0], b1 = acc[ai][1][m][1];
#pragma unroll
                for (int j = 0; j < 4; ++j) { a0[j] *= fsigmoid(b0[j]); a1[j] *= fsigmoid(b1[j]); }
                u32x4 w; w.x = cvt_pk_bf16(a0[0] * bf_lo(g.x), a0[1] * bf_hi(g.x)); w.y = cvt_pk_bf16(a0[2] * bf_lo(g.y), a0[3] * bf_hi(g.y)); w.z = cvt_pk_bf16(a1[0] * bf_lo(g.z), a1[1] * bf_hi(g.z)); w.w = cvt_pk_bf16(a1[2] * bf_lo(g.w), a1[3] * bf_hi(g.w));
                *(u32x4*)(YB + r * 1024 + col0) = w; }
    }
};
struct EpiWo {
    static constexpr bool PERM = false, AFTER_DRAIN = false;
    float* HP; const float* X; float alpha;
    __device__ __forceinline__ void operator()(const f32x4 (&acc)[2][2][4][2], const Unit& u, int wr, int wc, int fr, int fq) const {
        const int row0 = u.pm * BM + wr * 64 + fr, col0 = u.pn * BM + wc * 32 + 4 * fq;
#pragma unroll
        for (int ai = 0; ai < 2; ++ai)
#pragma unroll
            for (int m = 0; m < 4; ++m) { const size_t r = (size_t)(row0 + ai * HALF + m * 16);
#pragma unroll
                for (int bj = 0; bj < 2; ++bj)
#pragma unroll
                    for (int n = 0; n < 2; ++n) { const int c = col0 + bj * HALF + n * 16; const f32x4 xv = *(const f32x4*)(X + r * 1024 + c);
                        *(f32x4*)(HP + r * 1024 + c) = acc[ai][bj][m][n] + xv * alpha; } }
    }
};
__device__ __forceinline__ unsigned pk4_fp8_(float a, float b, float c, float d) { int r_ = __builtin_amdgcn_cvt_pk_fp8_f32(a, b, 0, false); r_ = __builtin_amdgcn_cvt_pk_fp8_f32(c, d, r_, true); return (unsigned)r_; }
struct EpiMoe1 {
    static constexpr bool PERM = true, AFTER_DRAIN = false;
    unsigned char* HID; float inv, hs;
    __device__ __forceinline__ void operator()(const f32x4 (&acc)[2][2][4][2], const Unit& u, int wr, int wc, int fr, int fq) const {
        const int row0 = u.pm * BM + wr * 64 + fr, col0 = (u.pn % 22) * HALF + wc * 32 + 8 * fq;
#pragma unroll
        for (int ai = 0; ai < 2; ++ai)
#pragma unroll
            for (int m = 0; m < 4; ++m) { const size_t r = (size_t)(row0 + ai * HALF + m * 16);
                f32x4 a0 = acc[ai][0][m][0] * inv, a1 = acc[ai][0][m][1] * inv; const f32x4 b0 = acc[ai][1][m][0] * (inv * hs), b1 = acc[ai][1][m][1] * (inv * hs);
#pragma unroll
                for (int j = 0; j < 4; ++j) { a0[j] = fsilu(a0[j]) * b0[j]; a1[j] = fsilu(a1[j]) * b1[j]; }
                u32x2 w; w.x = pk4_fp8_(a0[0], a0[1], a0[2], a0[3]); w.y = pk4_fp8_(a1[0], a1[1], a1[2], a1[3]);
                *(u32x2*)(HID + r * 2816 + col0) = w; }
    }
};
struct EpiMoe2 {
    static constexpr bool PERM = true, AFTER_DRAIN = false;
    bf16_t* Y; float inv;
    __device__ __forceinline__ void operator()(const f32x4 (&acc)[2][2][4][2], const Unit& u, int wr, int wc, int fr, int fq) const {
        const int row0 = u.pm * BM + wr * 64 + fr, col0 = (u.pn & 3) * BM + wc * 32 + 8 * fq;
#pragma unroll
        for (int ai = 0; ai < 2; ++ai)
#pragma unroll
            for (int m = 0; m < 4; ++m) { bf16_t* rowp = Y + (size_t)(row0 + ai * HALF + m * 16) * 1024 + col0;
#pragma unroll
                for (int bj = 0; bj < 2; ++bj) { const f32x4 v0 = acc[ai][bj][m][0] * inv, v1 = acc[ai][bj][m][1] * inv;
                    u32x4 w; w.x = cvt_pk_bf16(v0[0], v0[1]); w.y = cvt_pk_bf16(v0[2], v0[3]); w.z = cvt_pk_bf16(v1[0], v1[1]); w.w = cvt_pk_bf16(v1[2], v1[3]);
                    *(u32x4*)(rowp + bj * HALF) = w; } }
    }
};
struct EpiS5a {
    static constexpr bool PERM = false, AFTER_DRAIN = false;
    float* SLOC;
    __device__ __forceinline__ void operator()(const f32x4 (&acc)[2][2][4][2], const Unit& u, int wr, int wc, int fr, int fq) const {
        const int row0 = u.pm * BM + wr * 64 + fr, col0 = wc * 32 + 4 * fq;
#pragma unroll
        for (int ai = 0; ai < 2; ++ai)
#pragma unroll
            for (int m = 0; m < 4; ++m) { float* rowp = SLOC + (size_t)(row0 + ai * HALF + m * 16) * 256 + col0;
#pragma unroll
                for (int bj = 0; bj < 2; ++bj)
#pragma unroll
                    for (int n = 0; n < 2; ++n) *(f32x4*)(rowp + bj * HALF + n * 16) = acc[ai][bj][m][n]; }
    }
};
__device__ __forceinline__ float gelu_tanh_f(float x) { const float uu = 0.7978845608028654f * (x + 0.044715f * x * x * x); const float e = __expf(2.f * uu); return 0.5f * x * (2.f - 2.f * __builtin_amdgcn_rcpf(e + 1.f)); }
struct EpiS5c {
    static constexpr bool PERM = true, AFTER_DRAIN = false;
    bf16_t* GY; const bf16_t* UC; const float* d5;
    __device__ __forceinline__ void operator()(const f32x4 (&acc)[2][2][4][2], const Unit& u, int wr, int wc, int fr, int fq) const {
        const int g = u.pm >> 1, cl0 = (u.pm & 1) * BM + wr * 64 + fr, nl0 = (u.pn & 1) * BM + wc * 32 + 8 * fq;
        const int k0 = nl0 & 15; const f32x4 d0 = *(const f32x4*)(d5 + g * 16 + k0), d1 = *(const f32x4*)(d5 + g * 16 + k0 + 4);
#pragma unroll
        for (int ai = 0; ai < 2; ++ai)
#pragma unroll
            for (int m = 0; m < 4; ++m) { const int cl = cl0 + ai * HALF + m * 16;
#pragma unroll
                for (int bj = 0; bj < 2; ++bj) { const int nl = nl0 + bj * HALF, t = nl >> 4;
                    const u32x4 uw = *(const u32x4*)(UC + ((size_t)(g * 512 + cl) * 768 + nl));
                    f32x4 v0 = acc[ai][bj][m][0], v1 = acc[ai][bj][m][1];
                    v0[0] += bf_lo(uw.x) * d0[0]; v0[1] += bf_hi(uw.x) * d0[1]; v0[2] += bf_lo(uw.y) * d0[2]; v0[3] += bf_hi(uw.y) * d0[3];
                    v1[0] += bf_lo(uw.z) * d1[0]; v1[1] += bf_hi(uw.z) * d1[1]; v1[2] += bf_lo(uw.w) * d1[2]; v1[3] += bf_hi(uw.w) * d1[3];
#pragma unroll
                    for (int j = 0; j < 4; ++j) { v0[j] = gelu_tanh_f(v0[j]); v1[j] = gelu_tanh_f(v1[j]); }
                    u32x4 w; w.x = cvt_pk_bf16(v0[0], v0[1]); w.y = cvt_pk_bf16(v0[2], v0[3]); w.z = cvt_pk_bf16(v1[0], v1[1]); w.w = cvt_pk_bf16(v1[2], v1[3]);
                    *(u32x4*)(GY + (size_t)(cl * 32 + t) * 768 + g * 16 + k0) = w; } }
    }
};
struct S5aOrder {
    int c, lo;
    __device__ __forceinline__ bool next(int i, Unit& u) const { if (i > 0 || c < lo || c >= lo + 96) return false; u.pm = c - lo; u.pn = (c - lo) >> 1; return true; }
    __device__ __forceinline__ void a_ready(const Unit&) const {}
    __device__ __forceinline__ void done(const Unit&) const {}
};
struct S5cOrder {
    int G, c;
    __device__ __forceinline__ bool next(int i, Unit& u) const { const int L = i * G + c; if (L >= 192) return false; const int g = L >> 2; u.pm = 2 * g + (L & 1); u.pn = 2 * g + ((L >> 1) & 1); return true; }
    __device__ __forceinline__ void a_ready(const Unit&) const {}
    __device__ __forceinline__ void done(const Unit&) const {}
};
struct MoeOrder1 {
    int G, c;
    __device__ __forceinline__ bool next(int i, Unit& u) const {
        if (G == 256) { if (i >= 11) return false; const int x = c & 7, j = c >> 3, q = x * 44 + i * 4 + (j >> 3); u.pm = (q / 22) * 8 + (j & 7); u.pn = q; return true; }
        const long L = (long)i * G + c; if (L >= 2816) return false; const int e = (int)(L / 176), r = (int)(L % 176); u.pm = e * 8 + (r & 7); u.pn = e * 22 + (r >> 3); return true;
    }
    __device__ __forceinline__ void a_ready(const Unit&) const {}
    __device__ __forceinline__ void done(const Unit&) const {}
};
struct MoeOrder2 {
    int G, c;
    __device__ __forceinline__ bool next(int i, Unit& u) const {
        if (G == 256) { if (i >= 2) return false; const int x = c & 7, j = c >> 3, e = 2 * x + i; u.pm = e * 8 + (j & 7); u.pn = e * 4 + (j >> 3); return true; }
        const long L = (long)i * G + c; if (L >= 512) return false; const int e = (int)(L / 32), r = (int)(L % 32); u.pm = e * 8 + (r & 7); u.pn = e * 4 + (r >> 3); return true;
    }
    __device__ __forceinline__ void a_ready(const Unit&) const {}
    __device__ __forceinline__ void done(const Unit&) const {}
};
template <class Epi, class Sched, bool ALIGN_EPI = false, bool SP2 = false, bool F8 = false>
__device__ __forceinline__ void gemm_phase(PG8_LAS unsigned char* lds, const Gemm g, const Sched& S, const Epi& E, const int tid) {
    const int wid = __builtin_amdgcn_readfirstlane(tid >> 6), lane = tid & 63, wr = wid >> 2, wc = wid & 3, fr = lane & 15, fq = lane >> 4;
    const int K = g.K, nt = F8 ? K / 128 : K / BK; constexpr int ESZ = F8 ? 1 : 2, KOFF = F8 ? 16 : 1024;
    unsigned voffA, voffB;
    { int R, C; stage_rc(tid * 16, R, C); const int Rb = Epi::PERM ? ((R & ~31) + perm32(R & 31)) : R;
      voffA = (unsigned)(R * g.lda * ESZ + C * 2); voffB = (unsigned)(Rb * g.ldb * ESZ + C * 2); }
    const unsigned r64A = 64u * (unsigned)g.lda * ESZ, r64B = 64u * (unsigned)g.ldb * ESZ;
    const __amdgpu_buffer_rsrc_t rsrcA = __builtin_amdgcn_make_buffer_rsrc((void*)g.A, 0, (int)((unsigned)g.M * (unsigned)g.lda * ESZ), 0x00020000), rsrcB = __builtin_amdgcn_make_buffer_rsrc((void*)g.Bt, 0, (int)((unsigned)g.N * (unsigned)g.ldb * ESZ), 0x00020000);
    const unsigned kstep = (unsigned)(BK * 2);
    const unsigned hstepA = (unsigned)HALF * g.lda * ESZ, hstepB = (unsigned)HALF * g.ldb * ESZ;
    const unsigned tstepA = 2 * hstepA, tstepB = 2 * hstepB;
    const unsigned ldsw = (unsigned)wid * 1024u;
    const int aoff = lds_byte(wr * 64 + fr, F8 ? fq * 16 : fq * 8), boff = lds_byte(wc * 32 + fr, F8 ? fq * 16 : fq * 8);
#define PG8_SA(b, h) (((b) * 2 + (h)) * HTB)
#define PG8_SB(b, h) ((4 + (b) * 2 + (h)) * HTB)
#define PG8_STAGE(bufoff, gbase, voff) do { _Pragma("unroll") for (int _i = 0; _i < 2; ++_i) \
        __builtin_amdgcn_raw_ptr_buffer_load_lds(PG8_RSRC(voff), (PG8_LAS unsigned*)(lds + (bufoff) + ldsw + _i * 8192), 16, (int)(voff), (int)((gbase) + _i * PG8_R64(voff)), 0, 0); } while (0)
#define PG8_RSRC(voff) (&(voff) == &voffA ? rsrcA : rsrcB)
#define PG8_R64(voff) (&(voff) == &voffA ? r64A : r64B)
#define PG8_LDA(dst, b, h) do { _Pragma("unroll") for (int m = 0; m < 4; ++m) _Pragma("unroll") for (int k = 0; k < 2; ++k) dst[m][k] = *(const PG8_LAS bf16x8*)(lds + PG8_SA(b, h) + aoff + m * 2048 + k * KOFF); } while (0)
#define PG8_LDB(dst, b, h) do { _Pragma("unroll") for (int n = 0; n < 2; ++n) _Pragma("unroll") for (int k = 0; k < 2; ++k) dst[n][k] = *(const PG8_LAS bf16x8*)(lds + PG8_SB(b, h) + boff + n * 2048 + k * KOFF); } while (0)
#define PG8_CAT8(x_) __builtin_bit_cast(i32x8, __builtin_shufflevector((x_)[0], (x_)[1], 0, 1, 2, 3, 4, 5, 6, 7, 8, 9, 10, 11, 12, 13, 14, 15))
#define PG8_MMA(ai, bj, At, Bt) do { __builtin_amdgcn_s_setprio(1); if constexpr (F8) { _Pragma("unroll") for (int m = 0; m < 4; ++m) _Pragma("unroll") for (int n = 0; n < 2; ++n) \
        acc[ai][bj][m][n] = __builtin_amdgcn_mfma_scale_f32_16x16x128_f8f6f4(PG8_CAT8(Bt[n]), PG8_CAT8(At[m]), acc[ai][bj][m][n], 0, 0, 0, 0x7f7f7f7f, 0, 0x7f7f7f7f); } \
      else { _Pragma("unroll") for (int m = 0; m < 4; ++m) _Pragma("unroll") for (int n = 0; n < 2; ++n) _Pragma("unroll") for (int k = 0; k < 2; ++k) \
        acc[ai][bj][m][n] = __builtin_amdgcn_mfma_f32_16x16x32_bf16(Bt[n][k], At[m][k], acc[ai][bj][m][n], 0, 0, 0); } __builtin_amdgcn_s_setprio(0); } while (0)
#define PG8_WAIT_V(n) asm volatile("s_waitcnt vmcnt(" #n ")" ::: "memory")
#define PG8_WAIT_L(n) asm volatile("s_waitcnt lgkmcnt(" #n ")" ::: "memory")
#define PG8_BAR __builtin_amdgcn_s_barrier()
#define PG8_SCHED __builtin_amdgcn_sched_barrier(0)
    Unit cur, nxt; int ui = 0;
    if (!S.next(0, cur)) return;
    f32x4 acc[2][2][4][2];
#pragma unroll
    for (int a = 0; a < 2; ++a)
#pragma unroll
        for (int b = 0; b < 2; ++b)
#pragma unroll
            for (int m = 0; m < 4; ++m)
#pragma unroll
                for (int n = 0; n < 2; ++n) acc[a][b][m][n] = (f32x4){0.f, 0.f, 0.f, 0.f};
    bf16x8 At[4][2], B0[2][2], B1[2][2];
    unsigned cA = (unsigned)cur.pm * tstepA, cB = (unsigned)cur.pn * tstepB;
    S.a_ready(cur);
    if constexpr (SP2) {
        PG8_STAGE(PG8_SB(0, 0), cB, voffB); PG8_STAGE(PG8_SB(0, 1), cB + hstepB, voffB); PG8_STAGE(PG8_SA(0, 0), cA, voffA); PG8_STAGE(PG8_SA(0, 1), cA + hstepA, voffA);
        if (wr == 1) PG8_BAR;
        PG8_WAIT_V(2); PG8_BAR;
        PG8_STAGE(PG8_SB(1, 0), cB + kstep, voffB); PG8_STAGE(PG8_SA(1, 0), cA + kstep, voffA); PG8_STAGE(PG8_SB(1, 1), cB + hstepB + kstep, voffB);
        PG8_WAIT_V(6); PG8_BAR;
    } else {
        PG8_STAGE(PG8_SB(0, 0), cB, voffB); PG8_STAGE(PG8_SA(0, 0), cA, voffA); PG8_STAGE(PG8_SB(0, 1), cB + hstepB, voffB); PG8_STAGE(PG8_SA(0, 1), cA + hstepA, voffA);
        if (wr == 1) PG8_BAR;
        PG8_WAIT_V(4); PG8_BAR;
        PG8_STAGE(PG8_SB(1, 0), cB + kstep, voffB); PG8_STAGE(PG8_SA(1, 0), cA + kstep, voffA); PG8_STAGE(PG8_SB(1, 1), cB + hstepB + kstep, voffB);
        PG8_WAIT_V(6); PG8_BAR;
    }
    for (;;) {
        const bool has_next = S.next(ui + 1, nxt);
        const unsigned nA = has_next ? (unsigned)nxt.pm * tstepA : cA, nB = has_next ? (unsigned)nxt.pn * tstepB : cB;
#pragma unroll 1
        for (int t = 0; t < nt; t += 2) {
            const bool last = (t == nt - 2);
            const unsigned a1 = cA + (unsigned)(t + 1) * kstep;
            const unsigned a2 = last ? nA : cA + (unsigned)(t + 2) * kstep, b2 = last ? nB : cB + (unsigned)(t + 2) * kstep;
            const unsigned a3 = a2 + kstep, b3 = b2 + kstep;
            if (last && has_next) S.a_ready(nxt);
            if constexpr (SP2) {
            PG8_LDB(B0, 0, 0); PG8_LDB(B1, 0, 1); PG8_SCHED; PG8_LDA(At, 0, 0); PG8_STAGE(PG8_SA(1, 1), a1 + hstepA, voffA);
            PG8_WAIT_V(8); PG8_WAIT_L(0); PG8_BAR; PG8_MMA(0, 0, At, B0); PG8_MMA(0, 1, At, B1); PG8_BAR; PG8_SCHED;
            PG8_LDA(At, 0, 1); PG8_STAGE(PG8_SB(0, 0), b2, voffB); PG8_STAGE(PG8_SB(0, 1), b2 + hstepB, voffB); PG8_STAGE(PG8_SA(0, 0), a2, voffA);
            PG8_WAIT_V(8); PG8_WAIT_L(0); PG8_BAR; PG8_MMA(1, 0, At, B0); PG8_MMA(1, 1, At, B1); PG8_BAR; PG8_SCHED;
            PG8_LDB(B0, 1, 0); PG8_LDB(B1, 1, 1); PG8_SCHED; PG8_LDA(At, 1, 0); PG8_STAGE(PG8_SA(0, 1), a2 + hstepA, voffA);
            PG8_WAIT_V(8); PG8_WAIT_L(0); PG8_BAR; PG8_MMA(0, 0, At, B0); PG8_MMA(0, 1, At, B1); PG8_BAR; PG8_SCHED;
            PG8_LDA(At, 1, 1); PG8_STAGE(PG8_SB(1, 0), b3, voffB); PG8_STAGE(PG8_SB(1, 1), b3 + hstepB, voffB); PG8_STAGE(PG8_SA(1, 0), a3, voffA);
            PG8_WAIT_V(8); PG8_WAIT_L(0); PG8_BAR; PG8_MMA(1, 0, At, B0); PG8_MMA(1, 1, At, B1); PG8_BAR; PG8_SCHED;
            } else {
            PG8_LDB(B0, 0, 0); PG8_SCHED; PG8_LDA(At, 0, 0); PG8_STAGE(PG8_SA(1, 1), a1 + hstepA, voffA);
            PG8_WAIT_L(8); PG8_BAR; PG8_WAIT_L(0); PG8_MMA(0, 0, At, B0); PG8_BAR; PG8_SCHED;
            PG8_LDB(B1, 0, 1); PG8_STAGE(PG8_SB(0, 0), b2, voffB);
            PG8_BAR; PG8_WAIT_L(0); PG8_MMA(0, 1, At, B1); PG8_BAR;
            PG8_LDA(At, 0, 1); PG8_STAGE(PG8_SA(0, 0), a2, voffA);
            PG8_BAR; PG8_WAIT_L(0); PG8_MMA(1, 0, At, B0); PG8_BAR; PG8_SCHED;
            PG8_STAGE(PG8_SB(0, 1), b2 + hstepB, voffB);
            PG8_WAIT_V(6); PG8_BAR; PG8_MMA(1, 1, At, B1); PG8_BAR;
            PG8_LDB(B0, 1, 0); PG8_SCHED; PG8_LDA(At, 1, 0); PG8_STAGE(PG8_SA(0, 1), a2 + hstepA, voffA);
            PG8_WAIT_L(8); PG8_BAR; PG8_WAIT_L(0); PG8_MMA(0, 0, At, B0); PG8_BAR; PG8_SCHED;
            PG8_LDB(B1, 1, 1); PG8_STAGE(PG8_SB(1, 0), b3, voffB);
            PG8_BAR; PG8_WAIT_L(0); PG8_MMA(0, 1, At, B1); PG8_BAR;
            PG8_LDA(At, 1, 1); PG8_STAGE(PG8_SA(1, 0), a3, voffA);
            PG8_BAR; PG8_WAIT_L(0); PG8_MMA(1, 0, At, B0); PG8_BAR; PG8_SCHED;
            PG8_STAGE(PG8_SB(1, 1), b3 + hstepB, voffB);
            PG8_WAIT_V(6); PG8_BAR; PG8_MMA(1, 1, At, B1); PG8_BAR;
            }
        }
        if constexpr (ALIGN_EPI) { if (wr == 0) PG8_BAR; }
        if constexpr (!Epi::AFTER_DRAIN) { E(acc, cur, wr, wc, fr, fq); S.done(cur); }
        if (!has_next) break;
#pragma unroll
        for (int a = 0; a < 2; ++a)
#pragma unroll
            for (int b = 0; b < 2; ++b)
#pragma unroll
                for (int m = 0; m < 4; ++m)
#pragma unroll
                    for (int n = 0; n < 2; ++n) acc[a][b][m][n] = (f32x4){0.f, 0.f, 0.f, 0.f};
        cur = nxt; cA = nA; cB = nB; ++ui;
        if constexpr (ALIGN_EPI) { if (wr == 1) PG8_BAR; }
    }
    PG8_WAIT_V(0);
    if constexpr (!ALIGN_EPI) { if (wr == 0) PG8_BAR; }
    PG8_BAR;
    if constexpr (Epi::AFTER_DRAIN) { E.fused(acc, cur, wr, wc, fr, fq, lds, wid, lane); S.done(cur); }
#undef PG8_SA
#undef PG8_SB
#undef PG8_STAGE
#undef PG8_RSRC
#undef PG8_R64
#undef PG8_LDA
#undef PG8_LDB
#undef PG8_MMA
#undef PG8_CAT8
#undef PG8_WAIT_V
#undef PG8_WAIT_L
#undef PG8_BAR
#undef PG8_SCHED
}
}
#ifndef PG8_SP2
#define PG8_SP2 true
#endif
#ifndef PG8_ALIGN
#define PG8_ALIGN true
#endif

constexpr int NWAVES = 8, NTHR = 512;
constexpr int D = 1024, NB = 2, T = 8192, M = NB * T;
constexpr int SSD_H = 24, SSD_P = 64, SSD_IN = 1536, SSD_G = 4, SSD_N = 128, XBC = 2560, INCOLS = 6960, NIN_PAD = 7168;
constexpr int S5_W = 768, S5_G = 48, S5_P = 64, S5_K = 16;
constexpr int NE = 16, FF = 2816, CAP = 1024, MROWS = NE * NB * CAP;
constexpr float LN_EPS = 1e-5f, RMS_EPS = 1e-5f;
constexpr float ALPHA = 1.189207115002721f;
constexpr float W1_SCALE = 32.f, W2_SCALE = 64.f, HID_SCALE = 4.f;

constexpr size_t MiB = 1u << 20;
constexpr size_t WS_CTL = 0, CTL_ZERO_BYTES = 64 * 1024;
constexpr size_t WS_WIN = 1 * MiB, WS_WOUT = 15 * MiB, WS_WGLU = 18 * MiB, WS_WO = 21 * MiB, WS_W1 = 23 * MiB, WS_W2 = 199 * MiB, WS_ACT = 287 * MiB;
constexpr size_t A_XB = WS_ACT + 0 * MiB;
constexpr size_t A_BN = WS_ACT + 0 * MiB;
constexpr size_t A_CN = WS_ACT + 16 * MiB;
constexpr size_t A_Z = WS_ACT + 32 * MiB;
constexpr size_t A_XBC = WS_ACT + 80 * MiB;
constexpr size_t A_S = WS_ACT + 80 * MiB;
constexpr size_t A_XT = WS_ACT + 176 * MiB;
constexpr size_t A_BT = WS_ACT + 224 * MiB;
constexpr size_t A_SV = WS_ACT + 340 * MiB;
constexpr size_t A_DT = WS_ACT + 252 * MiB;
constexpr size_t A_TOT = WS_ACT + 255 * MiB;
constexpr size_t A_UC = WS_ACT + 268 * MiB;
constexpr size_t A_Y = WS_ACT + 256 * MiB;
constexpr size_t A_GY = WS_ACT + 224 * MiB;
constexpr size_t A_GT = WS_ACT + 353 * MiB;
constexpr size_t A_YB = WS_ACT + 304 * MiB;
constexpr size_t A_MIX = WS_ACT + 64 * MiB;
constexpr size_t A_HP = WS_ACT + 96 * MiB;
constexpr size_t A_ST = WS_ACT + 0 * MiB;
constexpr size_t A_H8 = WS_ACT + 64 * MiB;
constexpr size_t A_AFF = WS_ACT + 160 * MiB;
constexpr size_t A_IDX = A_AFF + 1 * MiB;
constexpr size_t A_SEL = A_AFF + 2 * MiB;
constexpr size_t A_GATE = A_AFF + 3 * MiB;
constexpr size_t A_XIN = WS_ACT + 164 * MiB;
constexpr size_t A_HID = WS_ACT + 228 * MiB;
constexpr size_t A_YE = WS_ACT + 164 * MiB;
constexpr size_t WS_TV = WS_W2 + 0 * MiB;
constexpr size_t WS_WS5 = WS_W2 + 36 * MiB;
constexpr size_t WS_SLOC = WS_W2 + 48 * MiB;
constexpr size_t WS_AQ = WS_W2 + 72 * MiB;
constexpr size_t WS_END = 704 * MiB;
static_assert(A_HID + 176 * MiB <= WS_END && A_XIN + 64 * MiB <= A_HID && A_YE + 64 * MiB <= A_HID && A_GATE + 1 * MiB <= A_XIN && A_HP + 64 * MiB <= A_AFF && A_H8 + 16 * MiB <= A_HP && A_ST + 1 * MiB <= A_H8, "d_ws map (late phases)");
static_assert(A_GT + 64 * MiB <= WS_END && A_SV + 12 * MiB <= A_GT && A_YB + 32 * MiB <= A_SV && A_UC + 36 * MiB <= A_YB && A_Y + 48 * MiB <= A_YB && A_TOT + 1 * MiB <= A_Y && A_DT + 3 * MiB <= A_TOT && A_GY + 24 * MiB <= A_DT && A_BT + 16 * MiB <= A_DT
              && A_XT + 48 * MiB <= A_BT && A_S + 96 * MiB <= A_XT && A_Z + 48 * MiB <= A_XBC && A_CN + 16 * MiB <= A_Z, "d_ws map (early phases)");
constexpr int CW_LIST = 8192;
constexpr int CW_QW1 = 12288;
constexpr int CW_BAR = 1024;

constexpr int RING_BYTES = 131072;
constexpr int MISC_OFF = RING_BYTES;
constexpr int LDS_BYTES = 147456;

#define GAS __attribute__((address_space(1)))
#define LAS __attribute__((address_space(3)))
typedef unsigned short bf16;
typedef unsigned v4u __attribute__((ext_vector_type(4)));
typedef unsigned v2u __attribute__((ext_vector_type(2)));
typedef float f32x4 __attribute__((ext_vector_type(4)));
#define LDS_WAIT() asm volatile("s_waitcnt lgkmcnt(0)" ::: "memory")
__device__ __forceinline__ unsigned f2bf(float f) { unsigned u = __builtin_bit_cast(unsigned, f); return (u + 0x7fffu + ((u >> 16) & 1u)) >> 16; }
__device__ __forceinline__ unsigned pk2(float lo, float hi) { return pg8::cvt_pk_bf16(lo, hi); }
__device__ __forceinline__ float bflo(unsigned w) { return __uint_as_float(w << 16); }
__device__ __forceinline__ float bfhi(unsigned w) { return __uint_as_float(w & 0xffff0000u); }
__device__ __forceinline__ float wave_sum(float v) {
#pragma unroll
    for (int o = 1; o < 64; o <<= 1) v += __shfl_xor(v, o);
    return v;
}
#define XB_TMO      128
#define XB_XCNT(j)  (256  + 64 * (j))
#define XB_XSUB(j)  (1280 + 64 * (j))
#define XB_XGEN(j)  (2304 + 64 * (j))
#define XB_TOP      3328
#define XB_TOPGEN   3392
#define XCD_BAR_WORDS 3456
#define XB_SPIN_CAP (1u << 18)

__device__ __forceinline__ unsigned xb_ld(unsigned* p)              { return __hip_atomic_load(p, __ATOMIC_RELAXED, __HIP_MEMORY_SCOPE_AGENT); }
__device__ __forceinline__ unsigned xb_add(unsigned* p, unsigned v) { return __hip_atomic_fetch_add(p, v, __ATOMIC_RELAXED, __HIP_MEMORY_SCOPE_AGENT); }
__device__ __forceinline__ unsigned xb_xcc_id() { return (unsigned)__builtin_amdgcn_s_getreg((3 << 11) | 20) & 0xFu; }
#define XB_SPIN(cond, bar) do { unsigned _sp = 0; while (cond) { __builtin_amdgcn_s_sleep(1); \
    if ((++_sp & 255u) == 0u) { if (xb_ld(&(bar)[XB_TMO])) break; if (_sp > XB_SPIN_CAP) { atomicAdd(&(bar)[XB_TMO], 1u); break; } } } } while (0)

struct XcdBarrier {
    unsigned* bar; unsigned x;
    volatile LAS unsigned* st;
};

__device__ __forceinline__ XcdBarrier xcd_barrier_post(unsigned* bar, volatile LAS unsigned* st) {
    XcdBarrier b; b.bar = bar; b.x = xb_xcc_id(); b.st = st;
    if (threadIdx.x == 0) (void)xb_add(&bar[XB_XCNT(b.x)], 1u);
    return b;
}
__device__ __forceinline__ void xcd_barrier_complete(unsigned* bar, unsigned x, unsigned& nloc, unsigned& nx) {
    const unsigned G = gridDim.x * gridDim.y * gridDim.z;
    unsigned sum, cnt, mine, sp = 0u;
    for (;;) {
        sum = 0u; cnt = 0u; mine = 0u;
#pragma unroll
        for (unsigned j = 0; j < 16; ++j) { const unsigned c = xb_ld(&bar[XB_XCNT(j)]); sum += c; cnt += (c > 0u) ? 1u : 0u; mine = (j == x) ? c : mine; }
        if (sum == G) break;
        __builtin_amdgcn_s_sleep(1);
        if ((++sp & 255u) == 0u) { if (xb_ld(&bar[XB_TMO])) break; if (sp > XB_SPIN_CAP) { atomicAdd(&bar[XB_TMO], 1u); break; } }
    }
    nloc = mine > 0u ? mine : 1u; nx = cnt > 0u ? cnt : 1u;
}

__device__ __forceinline__ void xcd_barrier(const XcdBarrier& b, const bool t0  ) {
    asm volatile("s_waitcnt vmcnt(0)" ::: "memory");
    __syncthreads();
    if (t0) {
        unsigned* bar = b.bar;
        __builtin_amdgcn_s_waitcnt(0);
        unsigned nloc = b.st[0], nx = b.st[1];
        if (nloc == 0u) { xcd_barrier_complete(bar, b.x, nloc, nx); b.st[0] = nloc; b.st[1] = nx; }
        const unsigned old = xb_add(&bar[XB_XSUB(b.x)], 1u);
        const unsigned gen = old / nloc;
        if (old + 1u == (gen + 1u) * nloc) {
            __builtin_amdgcn_fence(__ATOMIC_RELEASE, "agent");
            asm volatile("s_waitcnt vmcnt(0)" ::: "memory");
            const unsigned og = xb_add(&bar[XB_TOP], 1u);
            const unsigned tg = og / nx;
            if (og + 1u == (tg + 1u) * nx) xb_add(&bar[XB_TOPGEN], 1u);
            else XB_SPIN(xb_ld(&bar[XB_TOPGEN]) == tg, bar);
            __builtin_amdgcn_fence(__ATOMIC_ACQUIRE, "agent");
            xb_add(&bar[XB_XGEN(b.x)], 1u);
            asm volatile("s_waitcnt vmcnt(0)" ::: "memory");
        } else {
            XB_SPIN(xb_ld(&bar[XB_XGEN(b.x)]) == gen, bar);
            __builtin_amdgcn_fence(__ATOMIC_ACQUIRE, "agent");
            asm volatile("s_waitcnt vmcnt(0)" ::: "memory");
        }
    }
    __syncthreads();
}

struct Frame {
    LAS unsigned char* lds;
    int tid, lane, wave, bid, G;
    LAS unsigned* ptab; float* out; unsigned char* ws;
};
__device__ __forceinline__ const float* inp_(const Frame& F, int k) { const unsigned lo = __builtin_amdgcn_readfirstlane(F.ptab[2 * k]), hi = __builtin_amdgcn_readfirstlane(F.ptab[2 * k + 1]); return (const float*)(((unsigned long long)hi << 32) | lo); }
#define INP(k) inp_(F, k)
__device__ __forceinline__ unsigned lane_now() { unsigned z_ = 0u; asm volatile("" : "+s"(z_)); return __builtin_amdgcn_mbcnt_hi(~0u, __builtin_amdgcn_mbcnt_lo(~0u, z_)); }
#define WSP(T_, off) ((T_*)(F.ws + (off)))

__device__ __forceinline__ unsigned pk4_fp8(float a, float b, float c, float d) { int r_ = __builtin_amdgcn_cvt_pk_fp8_f32(a, b, 0, false); r_ = __builtin_amdgcn_cvt_pk_fp8_f32(c, d, r_, true); return (unsigned)r_; }
__device__ __forceinline__ void tr_load(const float* W, int ldw, int col0, int ncols, int k0, int n0, int lane, f32x4 (&v)[16]) {
    const int kr = lane >> 4, c4 = lane & 15; const bool okc = (n0 + 4 * c4) < ncols;
    const float* src = W + (size_t)(k0 + kr) * ldw + col0 + n0 + 4 * c4;
#pragma unroll
    for (int i = 0; i < 16; ++i) v[i] = okc ? __builtin_nontemporal_load((const f32x4*)(src + (size_t)(4 * i) * ldw)) : (f32x4){0.f, 0.f, 0.f, 0.f};
}
__device__ __forceinline__ void tr_store(const f32x4 (&v)[16], int ncols, int K, bf16* WT, int drow, LAS float* scr, int k0, int n0, int lane, float qs) {
    const int kr = lane >> 4, c4 = lane & 15;
#pragma unroll
    for (int i = 0; i < 16; ++i) { const int k = 4 * i + kr; *(LAS f32x4*)(scr + k * 64 + 4 * (c4 ^ ((k >> 3) & 7))) = v[i]; }
    LDS_WAIT(); asm volatile("" ::: "memory");
    const int nl = lane >> 3, c = lane & 7;
#pragma unroll
    for (int j = 0; j < 8; ++j) { const int n = 8 * j + nl; const LAS float* s = scr + (8 * c) * 64 + 4 * ((n >> 2) ^ c) + (n & 3);
        if (qs != 0.f) { v2u o; o.x = pk4_fp8(s[0 * 64] * qs, s[1 * 64] * qs, s[2 * 64] * qs, s[3 * 64] * qs); o.y = pk4_fp8(s[4 * 64] * qs, s[5 * 64] * qs, s[6 * 64] * qs, s[7 * 64] * qs);
            if (n0 + n < ncols) __builtin_nontemporal_store(o, (v2u*)((unsigned char*)WT + (size_t)(drow + n) * K + k0 + 8 * c)); }
        else { v4u o; o.x = pk2(s[0 * 64], s[1 * 64]); o.y = pk2(s[2 * 64], s[3 * 64]); o.z = pk2(s[4 * 64], s[5 * 64]); o.w = pk2(s[6 * 64], s[7 * 64]);
            if (n0 + n < ncols) *(v4u*)(WT + (size_t)(drow + n) * K + k0 + 8 * c) = o; } }
    LDS_WAIT(); asm volatile("" ::: "memory");
}
__device__ __forceinline__ void tr_item(const float* W, int ldw, int col0, int ncols, int K, bf16* WT, int drow, LAS float* scr, int k0, int n0, int lane, float qs) {
    f32x4 v[16]; tr_load(W, ldw, col0, ncols, k0, n0, lane, v); tr_store(v, ncols, K, WT, drow, scr, k0, n0, lane, qs);
}
struct TrJob { const float* W; int ldw, col0, ncols, K; bf16* WT; int drow0, interleave; float qs; };
__device__ __forceinline__ int tr_job_items(const TrJob& j) { return (j.K / 64) * ((j.ncols + 63) / 64); }
__device__ __forceinline__ void tr_job_item(const TrJob& j, int item, LAS float* scr, int lane) {
    const int nblk = (j.ncols + 63) / 64, kb = item / nblk, nb = item % nblk, n0 = nb * 64;
    const int drow = j.interleave ? j.drow0 + (n0 >> 7) * 256 + (n0 & 127) : j.drow0 + n0;
    tr_item(j.W, j.ldw, j.col0, j.ncols, j.K, j.WT, drow, scr, kb * 64, n0, lane, j.qs);
}
__device__ __forceinline__ void p0_prologue(Frame& F) {
    LAS float* scr = (LAS float*)(F.lds + F.wave * 16384);
    const int gw = F.bid * NWAVES + F.wave, NGW = F.G * NWAVES;
    { const f32x4* x4 = (const f32x4*)INP(0); v4u* o = WSP(v4u, A_XB); const int n8 = M * D / 8;
      const int stride = F.G * NTHR;
      for (int i0 = F.bid * NTHR + F.tid; i0 < n8; i0 += 8 * stride) {
          f32x4 a[8], b[8];
#pragma unroll
          for (int q = 0; q < 8; ++q) { const int i = i0 + q * stride; if (i < n8) { a[q] = x4[2 * i]; b[q] = x4[2 * i + 1]; } }
#pragma unroll
          for (int q = 0; q < 8; ++q) { const int i = i0 + q * stride; if (i < n8) { v4u w; w.x = pk2(a[q].x, a[q].y); w.y = pk2(a[q].z, a[q].w); w.z = pk2(b[q].x, b[q].y); w.w = pk2(b[q].z, b[q].w); o[i] = w; } } } }
    {
        bf16* WIN = WSP(bf16, WS_WIN); bf16* WOUT = WSP(bf16, WS_WOUT); bf16* WGLU = WSP(bf16, WS_WGLU); bf16* WO = WSP(bf16, WS_WO);
        const TrJob jobs[8] = {
            {INP(1), INCOLS, 0, 4096, D, WIN, 0, 0, 0.f}, {INP(1), INCOLS, 4096, 48, D, WIN, 4096, 0, 0.f}, {INP(1), INCOLS, 4144, 768, D, WIN, 4352, 0, 0.f}, {INP(1), INCOLS, 4912, 2048, D, WIN, 5120, 0, 0.f},
            {INP(10), D, 0, D, SSD_IN, WOUT, 0, 0, 0.f}, {INP(22), D, 0, D, S5_W, WGLU, 0, 1, 0.f}, {INP(23), D, 0, D, S5_W, WGLU, 128, 1, 0.f}, {INP(24), D, 0, D, D, WO, 0, 0, 0.f} };
        int base = 0;
#pragma unroll
        for (int q = 0; q < 8; ++q) { const int n = tr_job_items(jobs[q]);
            int it0 = (gw - base) % NGW; if (it0 < 0) it0 += NGW;
            for (int it = it0; it < n; it += NGW) tr_job_item(jobs[q], it, scr, F.lane);
            base += n; }
    }
}
template <int WHICH> __device__ __forceinline__ void expert_convert(Frame& F, int gw, int ngw, unsigned* queue = nullptr, int it_lo = 0, int it_hi = 1 << 30) {
    LAS float* scr = (LAS float*)(F.lds + F.wave * 16384);
    constexpr int IPM = WHICH == 0 ? (D / 64) * (FF / 64) : (FF / 64) * (D / 64);
    constexpr int NIT_ALL = WHICH == 0 ? NE * 2 * IPM : NE * IPM; const int NIT = it_hi < NIT_ALL ? it_hi : NIT_ALL;
    constexpr int NBLK = WHICH == 0 ? FF / 64 : D / 64, LDW = WHICH == 0 ? FF : D, KK = WHICH == 0 ? D : FF; const float qs = WHICH == 0 ? W1_SCALE : W2_SCALE;
    const float* w1 = INP(28); const float* w3 = INP(29); const float* w2 = INP(30);
    unsigned char* W1b = F.ws + WS_W1; unsigned char* W2b = F.ws + WS_W2;
    const int lane = (int)lane_now();
    auto src_of = [&](int it, int& k0, int& n0) -> const float* { const int mtx = it / IPM, r = it % IPM; k0 = (r / NBLK) * 64; n0 = (r % NBLK) * 64;
        if (WHICH == 0) { const int e = mtx >> 1; return ((mtx & 1) ? w3 : w1) + (size_t)e * D * FF; } return w2 + (size_t)mtx * FF * D; };
    const int rfirst = F.bid * 88 + (F.wave < 4 ? F.wave * 9 : 36 + (F.wave - 4) * 13), rend = rfirst + (F.wave < 4 ? 9 : 13);
    auto claim = [&](int prev) -> int { if (!queue) return prev < 0 ? it_lo + gw : prev + ngw;
        const int nx_ = prev < 0 ? rfirst : prev + 1; return nx_ < rend ? nx_ : NIT; };
    auto finish = [&](const f32x4 (&v)[16], int it, int k0, int n0) { const int mtx = it / IPM; bf16* dst; int drow;
        if (WHICH == 0) { dst = (bf16*)(W1b + (size_t)(mtx >> 1) * 2 * FF * D); drow = (mtx & 1) * 128 + (n0 >> 7) * 256 + (n0 & 127); } else { dst = (bf16*)(W2b + (size_t)mtx * D * FF); drow = n0; }
        tr_store(v, LDW, KK, dst, drow, scr, k0, n0, lane, qs); };
    f32x4 va[16], vb[16]; int k0a = 0, n0a = 0, k0b = 0, n0b = 0;
    int ita = claim(-1);
    if (ita < NIT) { const float* sa = src_of(ita, k0a, n0a); tr_load(sa, LDW, 0, LDW, k0a, n0a, lane, va); }
    while (ita < NIT) {
        const int itb = claim(ita);
        if (itb < NIT) { const float* sb = src_of(itb, k0b, n0b); tr_load(sb, LDW, 0, LDW, k0b, n0b, lane, vb); }
        finish(va, ita, k0a, n0a);
        if (itb >= NIT) break;
        ita = claim(itb);
        if (ita < NIT) { const float* sa = src_of(ita, k0a, n0a); tr_load(sa, LDW, 0, LDW, k0a, n0a, lane, va); }
        finish(vb, itb, k0b, n0b);
    }
}
__device__ __forceinline__ void w1_convert(Frame& F, int gw, int ngw, unsigned* queue = nullptr) { expert_convert<0>(F, gw, ngw, queue); }
__device__ __forceinline__ void w2_convert(Frame& F, int gw, int ngw, int it_lo = 0, int it_hi = 1 << 30) { expert_convert<1>(F, gw, ngw, nullptr, it_lo, it_hi); }

__device__ __forceinline__ void cmul(float ar, float ai, float br, float bi, float& cr, float& ci) { cr = ar * br - ai * bi; ci = ar * bi + ai * br; }
__device__ __forceinline__ void s5_precompute_item(Frame& F, int g, int tau) {
    LAS float* PQ = (LAS float*)(F.lds + 72 * 1024);
    LAS float* PW = PQ + 256;
    bf16* TV = WSP(bf16, WS_TV) + (size_t)g * 512 * 768; bf16* WM = WSP(bf16, WS_WS5) + (size_t)g * 256 * 512; float* AQ = WSP(float, WS_AQ);
    const int tid = F.tid;
    __syncthreads();
    { LAS float* dst = PQ + 512; const float* s0 = INP(19) + (size_t)g * 1024; const float* s1 = INP(20) + (size_t)g * 1024; const float* s2 = INP(17) + (size_t)g * 1024; const float* s3 = INP(18) + (size_t)g * 1024;
      dst[tid] = s0[tid]; dst[512 + tid] = s0[512 + tid]; dst[1024 + tid] = s1[tid]; dst[1536 + tid] = s1[512 + tid]; dst[2048 + tid] = s2[tid]; dst[2560 + tid] = s2[512 + tid]; dst[3072 + tid] = s3[tid]; dst[3584 + tid] = s3[512 + tid]; }
    if (tid < 128) {
        const int d = tid >> 6, p = tid & 63;
        const float are = (d ? INP(14) : INP(11))[g * 64 + p], aim = (d ? INP(15) : INP(12))[g * 64 + p], step = __expf((d ? INP(16) : INP(13))[g]);
        const float zr = are * step, zi = aim * step;
        const float er = expf(zr), cs = cosf(zi), sn = sinf(zi), abr = er * cs, abi = er * sn;
        const float sh = sinf(0.5f * zi), dr = expm1f(zr) * cs - 2.f * sh * sh, di = abi;
        const float den = 1.0f / (are * are + aim * aim), qr = (dr * are + di * aim) * den, qi = (di * are - dr * aim) * den;
        float pr = 1.f, pi = 0.f, br = abr, bi = abi;
#pragma unroll
        for (int bit = 0; bit < 6; ++bit) { if ((tau >> bit) & 1) { float tr_, ti_; cmul(pr, pi, br, bi, tr_, ti_); pr = tr_; pi = ti_; } float sr_, si_; cmul(br, bi, br, bi, sr_, si_); br = sr_; bi = si_; }
        float xr, xi; cmul(pr, pi, qr, qi, xr, xi);
        PQ[(d * 64 + p) * 2] = xr; PQ[(d * 64 + p) * 2 + 1] = xi; PW[(d * 64 + p) * 2] = pr; PW[(d * 64 + p) * 2 + 1] = pi;
        if (tau == 32) { AQ[((g * 2 + d) * 64 + p) * 2] = pr; AQ[((g * 2 + d) * 64 + p) * 2 + 1] = pi; }
    }
    __syncthreads();
    LAS float* cre = PQ + 512; LAS float* cim = cre + 1024; LAS float* bre = cim + 1024; LAS float* bim = bre + 1024;
    if (tid < 256 && tau < 32) {
        const int k = tid >> 4, j = tid & 15; float kf = 0.f, kb = 0.f;
        for (int p = 0; p < 64; ++p) { const float cr = cre[k * 64 + p], ci = cim[k * 64 + p], br = bre[p * 16 + j], bi = bim[p * 16 + j];
            float wr_, wi_; cmul(cr, ci, PQ[p * 2], PQ[p * 2 + 1], wr_, wi_); kf += wr_ * br - wi_ * bi;
            cmul(cr, ci, PQ[(64 + p) * 2], PQ[(64 + p) * 2 + 1], wr_, wi_); kb += wr_ * br - wi_ * bi; }
        if (tau == 0) { const bf16 v = (bf16)f2bf(kf + kb); for (int t = 0; t < 32; ++t) TV[(size_t)(t * 16 + k) * 768 + t * 16 + j] = v; }
        else { const bf16 vf = (bf16)f2bf(kf), vb = (bf16)f2bf(kb);
            for (int t = tau; t < 32; ++t) { const int s = t - tau; TV[(size_t)(t * 16 + k) * 768 + s * 16 + j] = vf; TV[(size_t)(s * 16 + k) * 768 + t * 16 + j] = vb; } }
    }
    if (tid >= 256) {
        const int q = tid - 256;
        if (tau >= 1) {
#pragma unroll 1
            for (int i = 0; i < 8; ++i) { const int e = q * 8 + i, d = e >> 10, k = (e >> 6) & 15, p = e & 63;
                float vr, vi; cmul(cre[k * 64 + p], cim[k * 64 + p], PW[(d * 64 + p) * 2], PW[(d * 64 + p) * 2 + 1], vr, vi);
                const int t = d ? 32 - tau : tau - 1; bf16* row = TV + (size_t)(t * 16 + k) * 768 + 512 + d * 128;
                row[p] = (bf16)f2bf(vr); row[64 + p] = (bf16)f2bf(-vi); } }
        if (tau < 32) {
#pragma unroll 1
            for (int i = 0; i < 8; ++i) { const int e = q * 8 + i, d = e >> 10, p = (e >> 4) & 63, j = e & 15;
                float vr, vi; cmul(PQ[(d * 64 + p) * 2], PQ[(d * 64 + p) * 2 + 1], bre[p * 16 + j], bim[p * 16 + j], vr, vi);
                const int s = d ? tau : 31 - tau; bf16* col = WM + (size_t)(d * 128 + p) * 512 + s * 16 + j;
                col[0] = (bf16)f2bf(vr); col[(size_t)64 * 512] = (bf16)f2bf(vi); } }
    }
}
__device__ __forceinline__ void s5_pre_wave(Frame& F, int g, int tau) {
    const int lane = (int)lane_now();
    LAS float* cre = (LAS float*)(F.lds + F.wave * 16384); LAS float* cim = cre + 1024; LAS float* bre = cim + 1024; LAS float* bim = bre + 1024;
    bf16* TV = WSP(bf16, WS_TV) + (size_t)g * 512 * 768; bf16* WM = WSP(bf16, WS_WS5) + (size_t)g * 256 * 512; float* AQ = WSP(float, WS_AQ);
    LDS_WAIT(); asm volatile("" ::: "memory");
    { const f32x4* s0 = (const f32x4*)(INP(19) + (size_t)g * 1024); const f32x4* s1 = (const f32x4*)(INP(20) + (size_t)g * 1024); const f32x4* s2 = (const f32x4*)(INP(17) + (size_t)g * 1024); const f32x4* s3 = (const f32x4*)(INP(18) + (size_t)g * 1024);
#pragma unroll
      for (int q = 0; q < 4; ++q) { const int i = q * 64 + lane; *(LAS f32x4*)(cre + 4 * i) = s0[i]; *(LAS f32x4*)(cim + 4 * i) = s1[i]; *(LAS f32x4*)(bre + 4 * i) = s2[i]; *(LAS f32x4*)(bim + 4 * i) = s3[i]; } }
    float Pr[2], Pi[2], Qr[2], Qi[2];
#pragma unroll
    for (int d = 0; d < 2; ++d) {
        const float are = (d ? INP(14) : INP(11))[g * 64 + lane], aim = (d ? INP(15) : INP(12))[g * 64 + lane], step = __expf((d ? INP(16) : INP(13))[g]);
        const float zr = are * step, zi = aim * step;
        const float er = expf(zr), cs = cosf(zi), sn = sinf(zi), abr = er * cs, abi = er * sn;
        const float sh = sinf(0.5f * zi), dr = expm1f(zr) * cs - 2.f * sh * sh, di = abi;
        const float den = 1.0f / (are * are + aim * aim), qr = (dr * are + di * aim) * den, qi = (di * are - dr * aim) * den;
        float pr = 1.f, pi = 0.f, br = abr, bi = abi;
#pragma unroll
        for (int bit = 0; bit < 6; ++bit) { if ((tau >> bit) & 1) { float tr_, ti_; cmul(pr, pi, br, bi, tr_, ti_); pr = tr_; pi = ti_; } float sr_, si_; cmul(br, bi, br, bi, sr_, si_); br = sr_; bi = si_; }
        Pr[d] = pr; Pi[d] = pi; cmul(pr, pi, qr, qi, Qr[d], Qi[d]);
        if (tau == 32) { AQ[((g * 2 + d) * 64 + lane) * 2] = pr; AQ[((g * 2 + d) * 64 + lane) * 2 + 1] = pi; }
    }
    LDS_WAIT(); asm volatile("" ::: "memory");
    if (tau < 32) {
        const int k = lane >> 2, j4 = (lane & 3) * 4; float kf[4] = {0.f, 0.f, 0.f, 0.f}, kb[4] = {0.f, 0.f, 0.f, 0.f};
#pragma unroll 4
        for (int p = 0; p < 64; ++p) { const float cr = cre[k * 64 + p], ci = cim[k * 64 + p]; const f32x4 br4 = *(const LAS f32x4*)(bre + p * 16 + j4), bi4 = *(const LAS f32x4*)(bim + p * 16 + j4);
            const float fr_ = __shfl(Qr[0], p), fi_ = __shfl(Qi[0], p), gr_ = __shfl(Qr[1], p), gi_ = __shfl(Qi[1], p);
            float wr_, wi_; cmul(cr, ci, fr_, fi_, wr_, wi_);
#pragma unroll
            for (int i = 0; i < 4; ++i) kf[i] += wr_ * br4[i] - wi_ * bi4[i];
            cmul(cr, ci, gr_, gi_, wr_, wi_);
#pragma unroll
            for (int i = 0; i < 4; ++i) kb[i] += wr_ * br4[i] - wi_ * bi4[i]; }
        if (tau == 0) { v2u v; v.x = pk2(kf[0] + kb[0], kf[1] + kb[1]); v.y = pk2(kf[2] + kb[2], kf[3] + kb[3]); for (int t = 0; t < 32; ++t) *(v2u*)(TV + (size_t)(t * 16 + k) * 768 + t * 16 + j4) = v; }
        else { v2u vf, vb; vf.x = pk2(kf[0], kf[1]); vf.y = pk2(kf[2], kf[3]); vb.x = pk2(kb[0], kb[1]); vb.y = pk2(kb[2], kb[3]);
            for (int t = tau; t < 32; ++t) { const int s = t - tau; *(v2u*)(TV + (size_t)(t * 16 + k) * 768 + s * 16 + j4) = vf; *(v2u*)(TV + (size_t)(s * 16 + k) * 768 + t * 16 + j4) = vb; } }
    }
    if (tau >= 1) {
#pragma unroll
        for (int d = 0; d < 2; ++d) { const int t = d ? 32 - tau : tau - 1;
#pragma unroll 4
            for (int k = 0; k < 16; ++k) { float vr, vi; cmul(cre[k * 64 + lane], cim[k * 64 + lane], Pr[d], Pi[d], vr, vi);
                bf16* row = TV + (size_t)(t * 16 + k) * 768 + 512 + d * 128; row[lane] = (bf16)f2bf(vr); row[64 + lane] = (bf16)f2bf(-vi); } }
    }
    if (tau < 32) {
        const int j = lane & 15;
#pragma unroll
        for (int d = 0; d < 2; ++d) { const int s = d ? tau : 31 - tau;
#pragma unroll 4
            for (int ps = 0; ps < 16; ++ps) { const int p = 4 * ps + (lane >> 4); const float xr = __shfl(Qr[d], p), xi = __shfl(Qi[d], p);
                float vr, vi; cmul(xr, xi, bre[p * 16 + j], bim[p * 16 + j], vr, vi);
                bf16* col = WM + (size_t)(d * 128 + p) * 512 + s * 16 + j; col[0] = (bf16)f2bf(vr); col[(size_t)64 * 512] = (bf16)f2bf(vi); } }
    }
    LDS_WAIT(); asm volatile("" ::: "memory");
}
__device__ __forceinline__ void p0_s5(Frame& F) { if (F.wave < 4) for (int it = F.bid * 4 + F.wave; it < S5_G * 33; it += F.G * 4) s5_pre_wave(F, it / 33, it % 33); }

__device__ __forceinline__ void s5_scan_item(Frame& F, int item) {
    const int d = item & 1, b = (item >> 1) & 1, g = item >> 2, tid = F.tid;
    LAS float* S = (LAS float*)F.lds;
    const float* SL = WSP(float, WS_SLOC) + ((size_t)(g * 512 + b * 256) * 256 + d * 128);
    __syncthreads();
    {   f32x4 v[16];
#pragma unroll
        for (int q = 0; q < 16; ++q) { const int i = q * NTHR + tid, ci = i >> 5, c4 = (i & 31) * 4; v[q] = *(const f32x4*)(SL + (size_t)ci * 256 + c4); }
#pragma unroll
        for (int q = 0; q < 16; ++q) { const int i = q * NTHR + tid, ci = i >> 5, c4 = (i & 31) * 4; *(LAS f32x4*)(S + ci * 128 + c4) = v[q]; } }
    __syncthreads();
    if (tid < 64) {
        const float* AQ = WSP(float, WS_AQ); const float qr = AQ[((g * 2 + d) * 64 + tid) * 2], qi = AQ[((g * 2 + d) * 64 + tid) * 2 + 1];
        float sr = 0.f, si = 0.f;
#pragma unroll 1
        for (int n0 = 0; n0 < 256; n0 += 16) {
            float tr_[16], ti_[16];
#pragma unroll
            for (int k = 0; k < 16; ++k) { const int ci = d ? 255 - (n0 + k) : n0 + k; tr_[k] = S[ci * 128 + tid]; ti_[k] = S[ci * 128 + 64 + tid]; }
#pragma unroll
            for (int k = 0; k < 16; ++k) { const int ci = d ? 255 - (n0 + k) : n0 + k; S[ci * 128 + tid] = sr; S[ci * 128 + 64 + tid] = si;
                const float nr = qr * sr - qi * si + tr_[k], ni = qr * si + qi * sr + ti_[k]; sr = nr; si = ni; }
        }
    }
    __syncthreads();
    bf16* UC = WSP(bf16, A_UC) + ((size_t)(g * 512 + b * 256) * 768 + 512 + d * 128);
#pragma unroll
    for (int q = 0; q < 8; ++q) { const int i = q * NTHR + tid, ci = i >> 4, c8 = (i & 15) * 8; const LAS float* s = S + ci * 128 + c8;
        v4u o; o.x = pk2(s[0], s[1]); o.y = pk2(s[2], s[3]); o.z = pk2(s[4], s[5]); o.w = pk2(s[6], s[7]);
        *(v4u*)(UC + (size_t)ci * 768 + c8) = o; }
}
__device__ __forceinline__ void unpack8(const v4u w, float (&f)[8]) { f[0] = bflo(w.x); f[1] = bfhi(w.x); f[2] = bflo(w.y); f[3] = bfhi(w.y); f[4] = bflo(w.z); f[5] = bfhi(w.z); f[6] = bflo(w.w); f[7] = bfhi(w.w); }
__device__ __forceinline__ void p2_conv(Frame& F) {
    const bf16* xbc = WSP(bf16, A_XBC); bf16* XT = WSP(bf16, A_XT); bf16* BT = WSP(bf16, A_BT); bf16* BN = WSP(bf16, A_BN); bf16* CN = WSP(bf16, A_CN);
    const float* cw = INP(2); const float* cb = INP(3);
    constexpr int RUN = 16, NCG = XBC / 8, NITEM = (M / RUN) * NCG;
    const int s5lo = (F.G == 256) ? 160 : F.G, NA = (F.G == 256) ? 196608 : 0;
    for (int pass = 0; pass < 2; ++pass)
    for (int item = pass == 0 ? (F.bid < s5lo ? F.bid * NTHR + F.tid : NITEM) : NA + F.bid * NTHR + F.tid; item < (pass == 0 ? NA : NITEM); item += (pass == 0 ? s5lo : F.G) * NTHR) {
        const int cg = item % NCG, r = item / NCG, ch = cg * 8, m0 = r * RUN, tb = m0 % T, bc = m0 >> 7, s0 = m0 & 127;
        float w[5][8], bias[8];
#pragma unroll
        for (int k = 0; k < 5; ++k) { const f32x4 a = *(const f32x4*)(cw + k * XBC + ch), b = *(const f32x4*)(cw + k * XBC + ch + 4); w[k][0] = a.x; w[k][1] = a.y; w[k][2] = a.z; w[k][3] = a.w; w[k][4] = b.x; w[k][5] = b.y; w[k][6] = b.z; w[k][7] = b.w; }
        { const f32x4 a = *(const f32x4*)(cb + ch), b = *(const f32x4*)(cb + ch + 4); bias[0] = a.x; bias[1] = a.y; bias[2] = a.z; bias[3] = a.w; bias[4] = b.x; bias[5] = b.y; bias[6] = b.z; bias[7] = b.w; }
        bf16* nat = nullptr; bf16* trn = nullptr; int trn_stride = 64 * 8;
        int trn_cstride = 8;
        if (ch < SSD_IN) { trn = XT + (size_t)(bc * SSD_H + (ch >> 6)) * 8192 + ((s0 >> 3) * 64 + ((ch & 63) >> 3)) * 8; trn_cstride = 64; }
        else if (ch < SSD_IN + 512) { const int cc = ch - SSD_IN; nat = BN + (size_t)m0 * 512 + cc; trn = BT + (size_t)(bc * SSD_G + (cc >> 7)) * 16384 + ((s0 >> 3) * 128 + (cc & 127)) * 8; trn_stride = 128 * 8; }
        else { nat = CN + (size_t)m0 * 512 + (ch - SSD_IN - 512); }
        v4u rows[RUN + 4];
        const bf16* src = xbc + (size_t)m0 * XBC + ch;
#pragma unroll
        for (int q = 0; q < RUN + 4; ++q) { const int tt = tb - 2 + q; const bool ok = tt >= 0 && tt < T; const int qq = ok ? q - 2 : 0; const v4u v = *(const v4u*)(src + (ptrdiff_t)qq * XBC);
            rows[q].x = ok ? v.x : 0u; rows[q].y = ok ? v.y : 0u; rows[q].z = ok ? v.z : 0u; rows[q].w = ok ? v.w : 0u; }
#pragma unroll
        for (int i8 = 0; i8 < RUN / 8; ++i8) {
            float o[8][8];
#pragma unroll
            for (int ii = 0; ii < 8; ++ii) { const int i = i8 * 8 + ii;
#pragma unroll
                for (int j = 0; j < 8; ++j) o[ii][j] = bias[j];
#pragma unroll
                for (int k = 0; k < 5; ++k) { float f[8]; unpack8(rows[i + k], f);
#pragma unroll
                    for (int j = 0; j < 8; ++j) o[ii][j] += w[k][j] * f[j]; }
#pragma unroll
                for (int j = 0; j < 8; ++j) o[ii][j] = o[ii][j] * __builtin_amdgcn_rcpf(1.0f + __expf(-o[ii][j]));
                if (nat) { v4u q; q.x = pk2(o[ii][0], o[ii][1]); q.y = pk2(o[ii][2], o[ii][3]); q.z = pk2(o[ii][4], o[ii][5]); q.w = pk2(o[ii][6], o[ii][7]); *(v4u*)(nat + (size_t)i * 512) = q; } }
            if (trn) {
#pragma unroll
                for (int j = 0; j < 8; ++j) { v4u q; q.x = pk2(o[0][j], o[1][j]); q.y = pk2(o[2][j], o[3][j]); q.z = pk2(o[4][j], o[5][j]); q.w = pk2(o[6][j], o[7][j]); *(v4u*)(trn + (size_t)i8 * trn_stride + j * trn_cstride) = q; } }
        }
    }
    {
        const int gw = F.bid * NWAVES + F.wave, NGW = F.G * NWAVES, lane = F.lane;
        const float* DT = WSP(float, A_DT); float* SV = WSP(float, A_SV); float* TOT = WSP(float, A_TOT);
        for (int it = gw; it < 128 * SSD_H * 2; it += NGW) {
            const int d = it & 1, h = (it >> 1) % SSD_H, bc = it / (2 * SSD_H);
            const float a = -__expf((d ? INP(5) : INP(4))[h]);
            const size_t mb = (size_t)bc * 128;
            const float dt0 = DT[(mb + 2 * lane) * 48 + d * 24 + h], dt1 = DT[(mb + 2 * lane + 1) * 48 + d * 24 + h];
            const float x0 = dt0 * a, x1 = dt1 * a, ps = x0 + x1;
            float inc = ps;
#pragma unroll
            for (int o = 1; o < 64; o <<= 1) { const float t_ = __shfl_up(inc, o); if (lane >= o) inc += t_; }
            const float total = __shfl(inc, 63), exc = inc - ps;
            const float ci0 = exc + x0, ci1 = inc;
            float cs0, cs1, w0, w1, f0, f1;
            if (d == 0) { cs0 = ci0; cs1 = ci1; w0 = dt0 * __expf(total - ci0); w1 = dt1 * __expf(total - ci1); f0 = __expf(ci0); f1 = __expf(ci1); }
            else { cs0 = exc; cs1 = ci0; w0 = dt0 * __expf(cs0); w1 = dt1 * __expf(cs1); f0 = __expf(total - cs0); f1 = __expf(total - cs1); }
            float* sv = SV + (size_t)it * 4 * 128 + 2 * lane;
            typedef float f32x2 __attribute__((ext_vector_type(2)));
            *(f32x2*)(sv) = (f32x2){w0, w1}; *(f32x2*)(sv + 128) = (f32x2){cs0, cs1}; *(f32x2*)(sv + 256) = (f32x2){dt0, dt1}; *(f32x2*)(sv + 384) = (f32x2){f0, f1};
            if (lane == 0) TOT[it] = __expf(total);
        }
    }
}

typedef short bf16x8 __attribute__((ext_vector_type(8)));
typedef float f32x16 __attribute__((ext_vector_type(16)));
__device__ __forceinline__ unsigned cvtpk(float lo, float hi) { return pg8::cvt_pk_bf16(lo, hi); }
__device__ __forceinline__ void ssd_state_item(Frame& F, int item) {
    unsigned z_ = 0u; asm volatile("" : "+s"(z_)); int lane = (int)__builtin_amdgcn_mbcnt_hi(~0u, __builtin_amdgcn_mbcnt_lo(~0u, z_)); asm volatile("" : "+v"(lane));
    const int nt = item & 3, u = item >> 2, h = u % SSD_H, bc = u / SSD_H, g = h / 6, b = bc >> 6, c = bc & 63, l31 = lane & 31, hf = lane >> 5;
    const bf16* XT = WSP(bf16, A_XT) + (size_t)u * 8192 + l31 * 8; const bf16* BT = WSP(bf16, A_BT) + (size_t)(bc * SSD_G + g) * 16384 + (nt * 32 + l31) * 8;
    const float* SV = WSP(float, A_SV); bf16* S = WSP(bf16, A_S);
    LAS float* wl = (LAS float*)(F.lds + F.wave * 1024);
    LDS_WAIT(); asm volatile("" ::: "memory");
#pragma unroll
    for (int d = 0; d < 2; ++d) { const float* sv = SV + (size_t)(u * 2 + d) * 4 * 128; wl[d * 128 + lane] = sv[lane]; wl[d * 128 + 64 + lane] = sv[64 + lane]; }
    LDS_WAIT(); asm volatile("" ::: "memory");
    f32x16 acc[2][2];
#pragma unroll
    for (int d = 0; d < 2; ++d)
#pragma unroll
        for (int pt = 0; pt < 2; ++pt)
#pragma unroll
            for (int r = 0; r < 16; ++r) acc[d][pt][r] = 0.f;
#pragma unroll
    for (int ks = 0; ks < 8; ++ks) {
        const int sb = ks * 16 + 8 * hf, q = 2 * ks + hf;
        const v4u a = *(const v4u*)(BT + q * 1024);
        const bf16x8 b0 = *(const bf16x8*)(XT + q * 512), b1 = *(const bf16x8*)(XT + q * 512 + 256);
        float af[8]; unpack8(a, af);
#pragma unroll
        for (int d = 0; d < 2; ++d) {
            const f32x4 w0 = *(const LAS f32x4*)(wl + d * 128 + sb), w1 = *(const LAS f32x4*)(wl + d * 128 + sb + 4);
            v4u aw; aw.x = cvtpk(af[0] * w0.x, af[1] * w0.y); aw.y = cvtpk(af[2] * w0.z, af[3] * w0.w); aw.z = cvtpk(af[4] * w1.x, af[5] * w1.y); aw.w = cvtpk(af[6] * w1.z, af[7] * w1.w);
            const bf16x8 av = __builtin_bit_cast(bf16x8, aw);
            acc[d][0] = __builtin_amdgcn_mfma_f32_32x32x16_bf16(av, b0, acc[d][0], 0, 0, 0);
            acc[d][1] = __builtin_amdgcn_mfma_f32_32x32x16_bf16(av, b1, acc[d][1], 0, 0, 0);
        }
    }
#pragma unroll
    for (int d = 0; d < 2; ++d) { bf16* So = S + ((size_t)((b * SSD_H + h) * 2 + d) * 64 + c) * 8192 + nt * 2048 + lane * 4;
#pragma unroll
        for (int pt = 0; pt < 2; ++pt)
#pragma unroll
            for (int q = 0; q < 4; ++q) { v2u o; o.x = cvtpk(acc[d][pt][4 * q], acc[d][pt][4 * q + 1]); o.y = cvtpk(acc[d][pt][4 * q + 2], acc[d][pt][4 * q + 3]);
                *(v2u*)(So + (pt * 4 + q) * 256) = o; } }
}
__device__ __forceinline__ void ssd_scan(Frame& F, int tg, int ntg, int item_lo, int item_hi) {
    bf16* S = WSP(bf16, A_S); const float* TOT = WSP(float, A_TOT);
    for (int item = item_lo + tg; item < item_hi; item += ntg) {
        const int e8 = item & 1023, bhd = item >> 10, d = bhd & 1, h = (bhd >> 1) % SSD_H, b = bhd / (2 * SSD_H);
        bf16* base = S + (size_t)bhd * 64 * 8192 + e8 * 8;
        float H[8];
#pragma unroll
        for (int j = 0; j < 8; ++j) H[j] = 0.f;
#pragma unroll 1
        for (int n0 = 0; n0 < 64; n0 += 16) {
            v4u v[16]; float dec[16];
#pragma unroll
            for (int k = 0; k < 16; ++k) { const int c = d ? 63 - (n0 + k) : n0 + k; v[k] = *(const v4u*)(base + (size_t)c * 8192); dec[k] = TOT[((b * 64 + c) * SSD_H + h) * 2 + d]; }
#pragma unroll
            for (int k = 0; k < 16; ++k) { const int c = d ? 63 - (n0 + k) : n0 + k; float f[8]; unpack8(v[k], f);
                v4u o; o.x = cvtpk(H[0], H[1]); o.y = cvtpk(H[2], H[3]); o.z = cvtpk(H[4], H[5]); o.w = cvtpk(H[6], H[7]);
                *(v4u*)(base + (size_t)c * 8192) = o;
#pragma unroll
                for (int j = 0; j < 8; ++j) H[j] = H[j] * dec[k] + f[j]; }
        }
    }
}
constexpr int PC_SVL_BYTES = 24576, PC_MAT_BYTES = 64 * 272;
__device__ __forceinline__ void pc_prefetch(v4u (&pre)[12], const bf16* XT, const bf16* S, int bc, int b, int c, int g, int i3, int tid) {
#pragma unroll
    for (int q = 0; q < 12; ++q) { const int mtx = q >> 1, hh = mtx / 3, t = mtx % 3, h = g * 6 + hh * 3 + i3, idx = (q & 1) * 512 + tid;
        const bf16* src = (t == 0) ? XT + (size_t)(bc * SSD_H + h) * 8192 + idx * 8 : S + ((size_t)((b * SSD_H + h) * 2 + (t - 1)) * 64 + c) * 8192 + idx * 8;
        pre[q] = *(const v4u*)src; }
}
__device__ __forceinline__ void ssd_out_unit(Frame& F, int unit) {
    unsigned z_ = 0u; asm volatile("" : "+s"(z_)); int lane = (int)__builtin_amdgcn_mbcnt_hi(~0u, __builtin_amdgcn_mbcnt_lo(~0u, z_)); asm volatile("" : "+v"(lane));
    int tid = F.wave * 64 + lane; asm volatile("" : "+v"(tid));
    const int g = unit & 3, bc = unit >> 2, b = bc >> 6, c = bc & 63, l31 = lane & 31, hf = lane >> 5, j = F.wave & 3, hh = F.wave >> 2;
    const size_t mb = (size_t)bc * 128;
    const bf16* CN = WSP(bf16, A_CN) + (mb + 32 * j + l31) * 512 + g * 128 + 8 * hf;
    const bf16* BN = WSP(bf16, A_BN) + (mb + l31) * 512 + g * 128 + 8 * hf;
    const float* SV = WSP(float, A_SV); const bf16* S = WSP(bf16, A_S); const bf16* XT = WSP(bf16, A_XT); bf16* Y = WSP(bf16, A_Y);
    LAS float* svl = (LAS float*)F.lds + hh * 3072;
    LAS unsigned char* mats = F.lds + PC_SVL_BYTES;
    asm volatile("" : "+v"(CN), "+v"(BN));
    __syncthreads();
    {   const f32x4* src = (const f32x4*)(SV + (size_t)((bc * SSD_H + g * 6) * 2) * 512) + tid;
#pragma unroll
        for (int q = 0; q < 3; ++q) *(LAS f32x4*)((LAS float*)F.lds + (q * 512 + tid) * 4) = src[q * 512]; }
    v4u pre[12];
    pc_prefetch(pre, XT, S, bc, b, c, g, 0, tid);
    unsigned cbp[4][8];
    {
        LAS unsigned char* tb = mats; LAS unsigned char* tc = mats + 128 * 272;
        { const bf16* bsrc = WSP(bf16, A_BN) + mb * 512 + g * 128; const bf16* csrc = WSP(bf16, A_CN) + mb * 512 + g * 128; v4u vb_[4], vc_[4];
#pragma unroll
          for (int q = 0; q < 4; ++q) { const int idx = q * 512 + tid, row = idx >> 4, ch = idx & 15; vb_[q] = *(const v4u*)(bsrc + (size_t)row * 512 + ch * 8); vc_[q] = *(const v4u*)(csrc + (size_t)row * 512 + ch * 8); }
#pragma unroll
          for (int q = 0; q < 4; ++q) { const int idx = q * 512 + tid, row = idx >> 4, ch = idx & 15; *(LAS v4u*)(tb + row * 272 + ch * 16) = vb_[q]; *(LAS v4u*)(tc + row * 272 + ch * 16) = vc_[q]; } }
        __syncthreads();
        bf16x8 cfr[8];
#pragma unroll
        for (int ks = 0; ks < 8; ++ks) cfr[ks] = *(const LAS bf16x8*)(tc + (32 * j + l31) * 272 + ks * 32 + hf * 16);
#pragma unroll
        for (int i = 0; i < 4; ++i) { f32x16 t_;
#pragma unroll
            for (int r = 0; r < 16; ++r) t_[r] = 0.f;
#pragma unroll
            for (int ks = 0; ks < 8; ++ks) { const bf16x8 a = *(const LAS bf16x8*)(tb + (32 * i + l31) * 272 + ks * 32 + hf * 16); t_ = __builtin_amdgcn_mfma_f32_32x32x16_bf16(a, cfr[ks], t_, 0, 0, 0); }
#pragma unroll
            for (int r = 0; r < 8; ++r) cbp[i][r] = cvtpk(t_[2 * r], t_[2 * r + 1]);
        }
    }
#define CBT(i_, r_) (((r_) & 1) ? bfhi(cbp[i_][(r_) >> 1]) : bflo(cbp[i_][(r_) >> 1]))
#pragma unroll 1
    for (int i3 = 0; i3 < 3; ++i3) {
        const int h = g * 6 + hh * 3 + i3;
        { int l_ = lane, t_ = tid; asm volatile("" : "+v"(l_), "+v"(t_)); lane = l_; tid = t_; }
        const int l31 = lane & 31, hf = lane >> 5, tl = 32 * j + l31;
        __syncthreads();
#pragma unroll
        for (int q = 0; q < 12; ++q) { const int mtx = q >> 1, idx = (q & 1) * 512 + tid; LAS unsigned char* mt = mats + mtx * PC_MAT_BYTES;
            if ((mtx % 3) == 0) { const int pos = idx & 63, row = (pos & 7) * 8 + (pos >> 3), ch = idx >> 6; *(LAS v4u*)(mt + row * 272 + ch * 16) = pre[q]; }
            else { const int blk = idx >> 5, c_ = idx & 31, nt_ = blk >> 3, pt_ = (blk >> 2) & 1, q_ = blk & 3, hf_ = c_ >> 4, la = (2 * c_) & 31;
                const int pa = 32 * pt_ + la, pb = pa + 1, ra = (pa & 7) * 8 + (pa >> 3), rb = (pb & 7) * 8 + (pb >> 3), cb = (32 * nt_ + 8 * q_ + 4 * hf_) * 2;
                v2u lo_; lo_.x = pre[q].x; lo_.y = pre[q].y; v2u hi_; hi_.x = pre[q].z; hi_.y = pre[q].w;
                *(LAS v2u*)(mt + ra * 272 + cb) = lo_; *(LAS v2u*)(mt + rb * 272 + cb) = hi_; } }
        __syncthreads();
        const LAS float* vf = svl + (i3 * 2 + 0) * 512 + 128; const LAS float* vb = svl + (i3 * 2 + 1) * 512 + 128;
        const float csf_t = vf[tl], sf_t = vf[256 + tl], ecsb_t = vb[tl], sb_t = vb[256 + tl], Dh = INP(8)[h];
        int tlv = tl - 4 * hf; asm volatile("" : "+v"(tlv));
        const LAS unsigned char* mx = mats + (hh * 3 + 0) * PC_MAT_BYTES + l31 * 272 + hf * 8;
        const LAS unsigned char* mf = mats + (hh * 3 + 1) * PC_MAT_BYTES + l31 * 272 + hf * 16;
        const LAS unsigned char* mbk = mats + (hh * 3 + 2) * PC_MAT_BYTES + l31 * 272 + hf * 16;
        f32x16 acc[2];
        {
            const bf16* cn = CN; asm volatile("" : "+v"(cn));
            bf16x8 cfr[8];
#pragma unroll
            for (int ks = 0; ks < 8; ++ks) cfr[ks] = *(const bf16x8*)(cn + ks * 16);
#pragma unroll
            for (int pt = 0; pt < 2; ++pt) { f32x16 af;
#pragma unroll
                for (int r = 0; r < 16; ++r) af[r] = 0.f;
#pragma unroll
                for (int ks = 0; ks < 8; ++ks) { const bf16x8 a0 = *(const LAS bf16x8*)(mf + pt * 32 * 272 + ks * 32); af = __builtin_amdgcn_mfma_f32_32x32x16_bf16(a0, cfr[ks], af, 0, 0, 0); }
#pragma unroll
                for (int r = 0; r < 16; ++r) acc[pt][r] = af[r] * sf_t;
#pragma unroll
                for (int r = 0; r < 16; ++r) af[r] = 0.f;
#pragma unroll
                for (int ks = 0; ks < 8; ++ks) { const bf16x8 a1 = *(const LAS bf16x8*)(mbk + pt * 32 * 272 + ks * 32); af = __builtin_amdgcn_mfma_f32_32x32x16_bf16(a1, cfr[ks], af, 0, 0, 0); }
#pragma unroll
                for (int r = 0; r < 16; ++r) acc[pt][r] += af[r] * sb_t; }
        }
        asm volatile("" ::: "memory");
        if (i3 < 2) pc_prefetch(pre, XT, S, bc, b, c, g, i3 + 1, tid);
#pragma unroll
        for (int i = 0; i < 4; ++i) {
#pragma unroll
            for (int k2 = 0; k2 < 2; ++k2) {
                const int sA = 32 * i + 16 * k2 + 4 * hf;
                float mv[8];
                if (i < j) {
                    const f32x4 c0 = *(const LAS f32x4*)(vf + sA), c1 = *(const LAS f32x4*)(vf + sA + 8), d0 = *(const LAS f32x4*)(vf + 128 + sA), d1 = *(const LAS f32x4*)(vf + 128 + sA + 8);
#pragma unroll
                    for (int e = 0; e < 4; ++e) { mv[e] = CBT(i, 8 * k2 + e) * (d0[e] * __expf(csf_t - c0[e])); mv[4 + e] = CBT(i, 8 * k2 + 4 + e) * (d1[e] * __expf(csf_t - c1[e])); }
                } else if (i > j) {
                    const f32x4 c0 = *(const LAS f32x4*)(vb + sA), c1 = *(const LAS f32x4*)(vb + sA + 8), d0 = *(const LAS f32x4*)(vb + 128 + sA), d1 = *(const LAS f32x4*)(vb + 128 + sA + 8);
#pragma unroll
                    for (int e = 0; e < 4; ++e) { mv[e] = CBT(i, 8 * k2 + e) * (d0[e] * __expf(c0[e] - ecsb_t)); mv[4 + e] = CBT(i, 8 * k2 + 4 + e) * (d1[e] * __expf(c1[e] - ecsb_t)); }
                } else {
                    const f32x4 c0 = *(const LAS f32x4*)(vf + sA), c1 = *(const LAS f32x4*)(vf + sA + 8), d0 = *(const LAS f32x4*)(vf + 128 + sA), d1 = *(const LAS f32x4*)(vf + 128 + sA + 8);
                    const f32x4 g0 = *(const LAS f32x4*)(vb + sA), g1 = *(const LAS f32x4*)(vb + sA + 8), h0 = *(const LAS f32x4*)(vb + 128 + sA), h1 = *(const LAS f32x4*)(vb + 128 + sA + 8);
#pragma unroll
                    for (int e = 0; e < 8; ++e) { const int s_ = 32 * i + 16 * k2 + (e & 3) + 8 * (e >> 2); const float cf = e < 4 ? c0[e & 3] : c1[e & 3], df = e < 4 ? d0[e & 3] : d1[e & 3], cb_ = e < 4 ? g0[e & 3] : g1[e & 3], db = e < 4 ? h0[e & 3] : h1[e & 3];
                        float f = 0.f;
                        f += (s_ <= tlv) ? df * __expf(fminf(csf_t - cf, 0.f)) : 0.f;
                        f += (s_ >= tlv) ? db * __expf(fminf(cb_ - ecsb_t, 0.f)) : 0.f;
                        mv[e] = CBT(i, 8 * k2 + e) * f + ((s_ == tlv) ? Dh : 0.f); }
                }
                v4u mw; mw.x = cvtpk(mv[0], mv[1]); mw.y = cvtpk(mv[2], mv[3]); mw.z = cvtpk(mv[4], mv[5]); mw.w = cvtpk(mv[6], mv[7]);
                const bf16x8 mfr = __builtin_bit_cast(bf16x8, mw);
#pragma unroll
                for (int pt = 0; pt < 2; ++pt) { const v2u x0 = *(const LAS v2u*)(mx + pt * 32 * 272 + 64 * i + 32 * k2), x1 = *(const LAS v2u*)(mx + pt * 32 * 272 + 64 * i + 32 * k2 + 16);
                    v4u xw; xw.x = x0.x; xw.y = x0.y; xw.z = x1.x; xw.w = x1.y;
                    acc[pt] = __builtin_amdgcn_mfma_f32_32x32x16_bf16(__builtin_bit_cast(bf16x8, xw), mfr, acc[pt], 0, 0, 0); }
                asm volatile("" ::: "memory");
            }
        }
        bf16* yo = Y + (mb + tl) * SSD_IN + h * 64 + 4 * hf;
        asm volatile("" : "+v"(yo));
#pragma unroll
        for (int pt = 0; pt < 2; ++pt)
#pragma unroll
            for (int q = 0; q < 4; ++q) { v2u o; o.x = cvtpk(acc[pt][4 * q], acc[pt][4 * q + 1]); o.y = cvtpk(acc[pt][4 * q + 2], acc[pt][4 * q + 3]); *(v2u*)(yo + 32 * pt + 8 * q) = o; }
    }
}

#undef CBT
__device__ __forceinline__ void ssd_norm_unit(Frame& F, int unit) {
    const int g = unit & 3, bc = unit >> 2; const int lane = (int)lane_now(), tq = lane >> 4, j16 = lane & 15;
    const size_t rowbase = ((size_t)bc * 128 + F.wave * 16 + tq) * SSD_IN + g * 384 + j16 * 8;
    bf16* Y = WSP(bf16, A_Y) + rowbase; const bf16* Z = WSP(bf16, A_Z) + rowbase; const float* ng = INP(9) + g * 384 + j16 * 8;
    v4u yv[12], zv[12];
#pragma unroll
    for (int r = 0; r < 4; ++r)
#pragma unroll
        for (int i = 0; i < 3; ++i) zv[r * 3 + i] = *(const v4u*)(Z + (size_t)(4 * r) * SSD_IN + 128 * i);
    asm volatile("s_waitcnt vmcnt(0)" ::: "memory"); __syncthreads();
#pragma unroll
    for (int r = 0; r < 4; ++r)
#pragma unroll
        for (int i = 0; i < 3; ++i) yv[r * 3 + i] = *(const v4u*)(Y + (size_t)(4 * r) * SSD_IN + 128 * i);
    f32x4 g0[3], g1[3];
#pragma unroll
    for (int i = 0; i < 3; ++i) { g0[i] = *(const f32x4*)(ng + 128 * i); g1[i] = *(const f32x4*)(ng + 128 * i + 4); }
#pragma unroll
    for (int r = 0; r < 4; ++r) { float ss = 0.f;
#pragma unroll
        for (int i = 0; i < 3; ++i) { float a[8], z[8]; unpack8(yv[r * 3 + i], a); unpack8(zv[r * 3 + i], z);
#pragma unroll
            for (int jj = 0; jj < 8; ++jj) { a[jj] *= z[jj]; ss += a[jj] * a[jj]; }
            yv[r * 3 + i].x = pk2(a[0], a[1]); yv[r * 3 + i].y = pk2(a[2], a[3]); yv[r * 3 + i].z = pk2(a[4], a[5]); yv[r * 3 + i].w = pk2(a[6], a[7]); }
        ss += __shfl_xor(ss, 1); ss += __shfl_xor(ss, 2); ss += __shfl_xor(ss, 4); ss += __shfl_xor(ss, 8);
        const float rn = 1.0f / sqrtf(ss * (1.0f / 384.0f) + RMS_EPS);
#pragma unroll
        for (int i = 0; i < 3; ++i) { float a[8]; unpack8(yv[r * 3 + i], a);
            v4u o; o.x = pk2(a[0] * rn * g0[i].x, a[1] * rn * g0[i].y); o.y = pk2(a[2] * rn * g0[i].z, a[3] * rn * g0[i].w); o.z = pk2(a[4] * rn * g1[i].x, a[5] * rn * g1[i].y); o.w = pk2(a[6] * rn * g1[i].z, a[7] * rn * g1[i].w);
            *(v4u*)(Y + (size_t)(4 * r) * SSD_IN + 128 * i) = o; } }
}

__device__ __forceinline__ void p8_ln_router(Frame& F) {
    const int gw = F.bid * NWAVES + F.wave, NGW = F.G * NWAVES, lane = F.lane;
    LAS float* wr = (LAS float*)F.lds;
    constexpr int WRP = D + 4;
    for (int i = F.tid; i < D * NE; i += NTHR) wr[(i & 15) * WRP + (i >> 4)] = INP(27)[i];
    __syncthreads();
    const float* HP = WSP(float, A_HP); float* ST = WSP(float, A_ST); unsigned char* H8 = F.ws + A_H8; float* AFF = WSP(float, A_AFF);
    const float* g1 = INP(25); const float* b1 = INP(26);
    f32x4 nx[4];
#pragma unroll
    for (int j = 0; j < 4; ++j) nx[j] = *((const f32x4*)(HP + (size_t)(gw < M ? gw : 0) * D) + lane + 64 * j);
    for (int m = gw; m < M; m += NGW) {
        f32x4 v[4]; float s = 0.f;
#pragma unroll
        for (int j = 0; j < 4; ++j) { v[j] = nx[j]; s += (v[j].x + v[j].y) + (v[j].z + v[j].w); }
        { const int mn = (m + NGW < M) ? m + NGW : m;
#pragma unroll
          for (int j = 0; j < 4; ++j) nx[j] = *((const f32x4*)(HP + (size_t)mn * D) + lane + 64 * j); }
        const float mean = wave_sum(s) * (1.f / D); float s2 = 0.f;
#pragma unroll
        for (int j = 0; j < 4; ++j) { v[j] = v[j] - mean; s2 += (v[j].x * v[j].x + v[j].y * v[j].y) + (v[j].z * v[j].z + v[j].w * v[j].w); }
        const float rstd = 1.f / sqrtf(wave_sum(s2) * (1.f / D) + LN_EPS);
        if (lane == 0) { typedef float f32x2_ __attribute__((ext_vector_type(2))); *(f32x2_*)(ST + 2 * (size_t)m) = (f32x2_){mean, rstd}; }
        float lg[16];
#pragma unroll
        for (int e = 0; e < 16; ++e) lg[e] = 0.f;
#pragma unroll
        for (int j = 0; j < 4; ++j) { const int c = 4 * lane + 256 * j; const f32x4 gg = *(const f32x4*)(g1 + c), bb = *(const f32x4*)(b1 + c);
            v[j] = v[j] * rstd * gg + bb;
            *((unsigned*)(H8 + (size_t)m * D) + lane + 64 * j) = pk4_fp8(v[j].x, v[j].y, v[j].z, v[j].w);
#pragma unroll
            for (int e = 0; e < 16; ++e) { const f32x4 w4 = *(const LAS f32x4*)(wr + e * WRP + c); lg[e] += (v[j].x * w4.x + v[j].y * w4.y) + (v[j].z * w4.z + v[j].w * w4.w); }
            asm volatile("" ::: "memory"); }
        { const bool hi = lane & 32;
#pragma unroll
          for (int k = 0; k < 8; ++k) { const float keep = hi ? lg[k + 8] : lg[k], send = hi ? lg[k] : lg[k + 8]; lg[k] = keep + __shfl_xor(send, 32); } }
        { const bool hi = lane & 16;
#pragma unroll
          for (int k = 0; k < 4; ++k) { const float keep = hi ? lg[k + 4] : lg[k], send = hi ? lg[k] : lg[k + 4]; lg[k] = keep + __shfl_xor(send, 16); } }
        { const bool hi = lane & 8;
#pragma unroll
          for (int k = 0; k < 2; ++k) { const float keep = hi ? lg[k + 2] : lg[k], send = hi ? lg[k] : lg[k + 2]; lg[k] = keep + __shfl_xor(send, 8); } }
        { const bool hi = lane & 4; const float keep = hi ? lg[1] : lg[0], send = hi ? lg[0] : lg[1]; lg[0] = keep + __shfl_xor(send, 4); }
        float lo = lg[0]; lo += __shfl_xor(lo, 2); lo += __shfl_xor(lo, 1);
        float mx = lo;
#pragma unroll
        for (int o = 4; o < 64; o <<= 1) mx = fmaxf(mx, __shfl_xor(mx, o));
        const float ex = expf(lo - mx); float sum = ex;
#pragma unroll
        for (int o = 4; o < 64; o <<= 1) sum += __shfl_xor(sum, o);
        if ((lane & 3) == 0) { const int e = lane >> 2, b = m / T, t = m % T; AFF[((size_t)b * NE + e) * T + t] = ex / sum; }
    }
}

__device__ __forceinline__ unsigned block_excl_scan(unsigned v, LAS unsigned* wsum  , int lane, int wave, unsigned& total) {
    unsigned inc = v;
#pragma unroll
    for (int o = 1; o < 64; o <<= 1) { const unsigned t = __shfl_up(inc, o); if (lane >= o) inc += t; }
    __syncthreads();
    if (lane == 63) wsum[wave] = inc;
    __syncthreads();
    unsigned off = 0, tot = 0;
#pragma unroll
    for (int w = 0; w < 8; ++w) { const unsigned s = wsum[w]; if (w < wave) off += s; tot += s; }
    total = tot; return off + inc - v;
}
__device__ __forceinline__ void p9_topk(Frame& F, int be) {
    const int b = be >> 4, e = be & 15, tid = F.tid;
    const float* av = WSP(float, A_AFF) + (size_t)be * T;
    int* IDX = WSP(int, A_IDX); int* SEL = WSP(int, A_SEL); float* GATE = WSP(float, A_GATE);
    LAS unsigned* hist = (LAS unsigned*)F.lds; LAS unsigned* shv = hist + 256; LAS unsigned* wsum = hist + 272;
    unsigned key[16];
#pragma unroll
    for (int q = 0; q < 4; ++q) { const v4u k4 = *(const v4u*)(av + tid * 16 + 4 * q); key[4 * q] = k4.x; key[4 * q + 1] = k4.y; key[4 * q + 2] = k4.z; key[4 * q + 3] = k4.w; }
    unsigned lo = 0u, hi_ex = 0u;
    bool hi_set = false;
    for (int it = 0; it < 32; ++it) {
        const unsigned span = (hi_set ? hi_ex : 0u) - lo;
        const unsigned mid = lo + (span >> 1) + ((span == 0u && !hi_set) ? 0x80000000u : 0u);
        unsigned cnt = 0;
#pragma unroll
        for (int i = 0; i < 16; ++i) cnt += (unsigned)__builtin_popcountll(__ballot(key[i] >= mid));
        LAS unsigned* slot_ = wsum + 16 + (it & 1) * 8;
        if (F.lane == 0) slot_[F.wave] = cnt;
        __syncthreads();
        unsigned tot = 0;
#pragma unroll
        for (int w = 0; w < 8; ++w) tot += slot_[w];
        if (tot >= (unsigned)CAP) lo = mid; else { hi_ex = mid; hi_set = true; }
    }
    const unsigned Tk = lo;
    unsigned krem;
    { unsigned cnt = 0;
#pragma unroll
      for (int i = 0; i < 16; ++i) cnt += (unsigned)__builtin_popcountll(__ballot(key[i] > Tk));
      __syncthreads(); if (F.lane == 0) wsum[16 + F.wave] = cnt; __syncthreads();
      unsigned tot = 0;
#pragma unroll
      for (int w = 0; w < 8; ++w) tot += wsum[16 + w];
      krem = (unsigned)CAP - tot; __syncthreads(); }
    unsigned cg = 0, ce = 0;
#pragma unroll
    for (int i = 0; i < 16; ++i) { cg += key[i] > Tk; ce += key[i] == Tk; }
    unsigned totg, tote;
    unsigned pg = block_excl_scan(cg, wsum, F.lane, F.wave, totg);
    unsigned pe = block_excl_scan(ce, wsum + 8, F.lane, F.wave, tote);
#pragma unroll
    for (int i = 0; i < 16; ++i) {
        const int t = tid * 16 + i; int slot = -1;
        if (key[i] > Tk) slot = (int)(pg++);
        else if (key[i] == Tk) { if (pe < krem) slot = (int)(totg + pe); ++pe; }
        const size_t m = (size_t)b * T + t;
        SEL[m * NE + e] = slot; GATE[m * NE + e] = __uint_as_float(key[i]);
        if (slot >= 0) IDX[(e * NB + b) * CAP + slot] = (int)m;
    }
    __builtin_amdgcn_fence(__ATOMIC_RELEASE, "agent"); asm volatile("s_waitcnt vmcnt(0)" ::: "memory"); __syncthreads();
    if (tid == 0) __hip_atomic_store((unsigned*)(F.ws + WS_CTL) + CW_LIST + 64 * be, 1u, __ATOMIC_RELAXED, __HIP_MEMORY_SCOPE_AGENT);
}
__device__ __forceinline__ void gather_rows_after(Frame& F, int r0, int nrows) {
    const int li = r0 >> 10, e = li >> 1, b = li & 1, be = b * 16 + e;
    if (F.wave == 0) { unsigned* flag = (unsigned*)(F.ws + WS_CTL) + CW_LIST + 64 * be; unsigned spins = 0;
        while (__builtin_amdgcn_readfirstlane(__hip_atomic_load(flag, __ATOMIC_RELAXED, __HIP_MEMORY_SCOPE_AGENT)) == 0u) { __builtin_amdgcn_s_sleep(2); if (++spins > (1u << 22)) break; }
        __builtin_amdgcn_fence(__ATOMIC_ACQUIRE, "agent"); asm volatile("s_waitcnt vmcnt(0)" ::: "memory"); }
    __syncthreads();
    const int* IDX = WSP(int, A_IDX); const unsigned char* H8 = F.ws + A_H8; unsigned char* XIN = F.ws + A_XIN; const int lane = F.lane;
    for (int rr = F.wave; rr < nrows; rr += 8 * NWAVES) {
        v4u va[8];
#pragma unroll
        for (int q = 0; q < 8; ++q) { const int ri = rr + q * NWAVES < nrows ? rr + q * NWAVES : rr; const int m_ = IDX[r0 + ri]; va[q] = *((const v4u*)(H8 + (size_t)m_ * D) + lane); }
#pragma unroll
        for (int q = 0; q < 8; ++q) if (rr + q * NWAVES < nrows) *((v4u*)(XIN + (size_t)(r0 + rr + q * NWAVES) * D) + lane) = va[q];
    }
}
__device__ __forceinline__ void moe_accumulate(f32x4 (&v)[4], int sl, float gt, int b, const bf16* YE, int lane) {
    unsigned mask = (unsigned)(__ballot(sl >= 0) & 0xffffull);
    while (mask) {
        int e[4]; float gv[4]; const bf16* yr[4];
#pragma unroll
        for (int k = 0; k < 4; ++k) { const bool ok = mask != 0u; const int ek = ok ? __builtin_ctz(mask) : e[k > 0 ? k - 1 : 0]; if (ok) mask &= mask - 1u; e[k] = ek;
            const int s = __shfl(sl, ek); gv[k] = ok ? __shfl(gt, ek) : 0.f; yr[k] = YE + ((size_t)(ek * NB + b) * CAP + (s < 0 ? 0 : s)) * D; }
        v2u w[4][4];
#pragma unroll
        for (int k = 0; k < 4; ++k)
#pragma unroll
            for (int j = 0; j < 4; ++j) w[k][j] = *((const v2u*)yr[k] + lane + 64 * j);
#pragma unroll
        for (int k = 0; k < 4; ++k)
#pragma unroll
            for (int j = 0; j < 4; ++j) { v[j].x += gv[k] * bflo(w[k][j].x); v[j].y += gv[k] * bfhi(w[k][j].x); v[j].z += gv[k] * bflo(w[k][j].y); v[j].w += gv[k] * bfhi(w[k][j].y); }
    }
}
__device__ __forceinline__ void ln_row_store(f32x4 (&v)[4], const float* g2, const float* b2, float* orow, int lane) {
    float s = 0.f;
#pragma unroll
    for (int j = 0; j < 4; ++j) s += (v[j].x + v[j].y) + (v[j].z + v[j].w);
    const float mean = wave_sum(s) * (1.f / D); float s2 = 0.f;
#pragma unroll
    for (int j = 0; j < 4; ++j) { v[j] = v[j] - mean; s2 += (v[j].x * v[j].x + v[j].y * v[j].y) + (v[j].z * v[j].z + v[j].w * v[j].w); }
    const float rstd = 1.f / sqrtf(wave_sum(s2) * (1.f / D) + LN_EPS);
#pragma unroll
    for (int j = 0; j < 4; ++j) { const int c = 4 * lane + 256 * j; const f32x4 gg = *(const f32x4*)(g2 + c), bb = *(const f32x4*)(b2 + c);
        *((f32x4*)orow + lane + 64 * j) = v[j] * rstd * gg + bb; }
}
__device__ __forceinline__ void p13_final(Frame& F) {
    const int gw = F.bid * NWAVES + F.wave, NGW = F.G * NWAVES, lane = F.lane;
    const float* HP = WSP(float, A_HP); const float* ST = WSP(float, A_ST); const float* g1 = INP(25); const float* b1 = INP(26); const int* SEL = WSP(int, A_SEL); const float* GATE = WSP(float, A_GATE); const bf16* YE = WSP(bf16, A_YE);
    const float* g2 = INP(31); const float* b2 = INP(32);
    for (int m = gw; m < M; m += 2 * NGW) {
        const int mB = (m + NGW < M) ? m + NGW : m;
        const int slA = SEL[(size_t)m * NE + (lane & 15)], slB = SEL[(size_t)mB * NE + (lane & 15)]; const float gtA = GATE[(size_t)m * NE + (lane & 15)], gtB = GATE[(size_t)mB * NE + (lane & 15)];
        typedef float f32x2_ __attribute__((ext_vector_type(2))); const f32x2_ stA = *(const f32x2_*)(ST + 2 * (size_t)m), stB = *(const f32x2_*)(ST + 2 * (size_t)mB);
        f32x4 vA[4], vB[4];
#pragma unroll
        for (int j = 0; j < 4; ++j) { const int c = 4 * lane + 256 * j; const f32x4 gg = *(const f32x4*)(g1 + c) * ALPHA, bb = *(const f32x4*)(b1 + c) * ALPHA;
            vA[j] = (*((const f32x4*)(HP + (size_t)m * D) + lane + 64 * j) - stA.x) * stA.y * gg + bb; vB[j] = (*((const f32x4*)(HP + (size_t)mB * D) + lane + 64 * j) - stB.x) * stB.y * gg + bb; }
        moe_accumulate(vA, slA, gtA, m / T, YE, lane); moe_accumulate(vB, slB, gtB, mB / T, YE, lane);
        ln_row_store(vA, g2, b2, F.out + (size_t)m * D, lane);
        if (mB != m) ln_row_store(vB, g2, b2, F.out + (size_t)mB * D, lane);
    }
}

constexpr int N_PHASES = 16;
struct Args { const float* in[33]; float* out; unsigned char* ws; int ph_lo, ph_hi; };
__global__ void __launch_bounds__(NTHR, 2) fwd(Args args) {
    extern __shared__ __attribute__((aligned(16))) unsigned char lds[];
    Frame F;
    F.lds = (LAS unsigned char*)lds;
    F.tid = threadIdx.x; F.lane = F.tid & 63; F.wave = __builtin_amdgcn_readfirstlane(F.tid >> 6);
    F.bid = blockIdx.x; F.G = gridDim.x;
    F.ptab = (LAS unsigned*)(F.lds + MISC_OFF + 512);
    if (F.tid < 33) { const unsigned long long p_ = (unsigned long long)args.in[F.tid]; F.ptab[2 * F.tid] = (unsigned)p_; F.ptab[2 * F.tid + 1] = (unsigned)(p_ >> 32); }
    F.out = args.out; F.ws = args.ws;
    volatile LAS unsigned* MISC = (volatile LAS unsigned*)(F.lds + MISC_OFF);
    if (F.tid < 64) MISC[F.tid] = 0u;
    __syncthreads();
    const int lo = args.ph_lo, hi = args.ph_hi;
    const bool single = (hi - lo) > 1;
    XcdBarrier bar; bar.bar = (unsigned*)(F.ws + WS_CTL) + CW_BAR; bar.x = 0; bar.st = nullptr;
    if (single) bar = xcd_barrier_post((unsigned*)(F.ws + WS_CTL) + CW_BAR, MISC + 8);
#ifndef PH_MASK
#define PH_MASK 0xffff
#endif
#define IN(k) (((PH_MASK >> (k)) & 1) && lo <= (k) && (k) < hi)
#define LAUNDER1(T_, p_) do { unsigned long long x_ = (unsigned long long)(p_); unsigned lo_ = (unsigned)x_, hi_ = (unsigned)(x_ >> 32); asm volatile("" : "+v"(lo_), "+v"(hi_)); \
        lo_ = __builtin_amdgcn_readfirstlane(lo_); hi_ = __builtin_amdgcn_readfirstlane(hi_); (p_) = (T_)(((unsigned long long)hi_ << 32) | lo_); } while (0)
#define LAUNDER() do { F.lane = (int)lane_now(); F.tid = F.wave * 64 + F.lane; } while (0)
#define SEAM(k) do { if (IN(k) && IN((k) + 1)) xcd_barrier(bar, T0()); } while (0)

#define T0() (F.wave == 0 && lane_now() == 0u)

    if (IN(0)) { LAUNDER(); p0_s5(F); p0_prologue(F); w1_convert(F, F.bid * NWAVES + F.wave, F.G * NWAVES, F.G == 256 ? (unsigned*)(F.ws + WS_CTL) + CW_QW1 : nullptr); } SEAM(0);
    if (IN(1)) { LAUNDER();
        pg8::Gemm g{WSP(pg8::bf16_t, A_XB), WSP(pg8::bf16_t, WS_WIN), M, NIN_PAD, D, D, D}; pg8::StaticOrder S; S.init(M, NIN_PAD, F.G, F.bid);
        pg8::EpiIn E{WSP(pg8::bf16_t, A_Z), WSP(pg8::bf16_t, A_XBC), WSP(pg8::bf16_t, A_UC), WSP(pg8::bf16_t, A_GT), WSP(float, A_DT), INP(6), INP(7)};
        pg8::gemm_phase<pg8::EpiIn, pg8::StaticOrder, PG8_ALIGN, PG8_SP2>(F.lds, g, S, E, F.tid);
    } SEAM(1);
    if (IN(2)) { LAUNDER();

        if (F.bid >= 160) { pg8::Gemm g{WSP(pg8::bf16_t, A_UC), WSP(pg8::bf16_t, WS_WS5), S5_G * 512, S5_G * 256, 512, 768, 512}; pg8::S5aOrder S{F.bid, 160};
            pg8::EpiS5a E{WSP(float, WS_SLOC)};
            pg8::gemm_phase<pg8::EpiS5a, pg8::S5aOrder, PG8_ALIGN, PG8_SP2>(F.lds, g, S, E, F.tid); __syncthreads(); }

        p2_conv(F);
        __syncthreads();
    } SEAM(2);
    if (IN(3)) { LAUNDER();
        for (int it = F.bid; it < S5_G * 4; it += F.G) s5_scan_item(F, it);
        __syncthreads();
        for (int it = F.bid * NWAVES + F.wave; it < 128 * SSD_H * 4; it += F.G * NWAVES) ssd_state_item(F, it);
    } SEAM(3);
    if (IN(4)) { LAUNDER();
        { pg8::Gemm g{WSP(pg8::bf16_t, A_UC), WSP(pg8::bf16_t, WS_TV), S5_G * 512, S5_G * 512, 768, 768, 768}; pg8::S5cOrder S{F.G, F.bid};
          pg8::EpiS5c E{WSP(pg8::bf16_t, A_GY), WSP(pg8::bf16_t, A_UC), INP(21)};
          pg8::gemm_phase<pg8::EpiS5c, pg8::S5cOrder, PG8_ALIGN, PG8_SP2>(F.lds, g, S, E, F.tid); }

        if (F.G == 256) { if (F.bid >= 192) ssd_scan(F, (F.bid - 192) * NTHR + F.tid, 64 * NTHR, 0, 65536); else if (F.bid < 64) ssd_scan(F, F.bid * NTHR + F.tid, 64 * NTHR, 65536, 96 * 1024); }
        else ssd_scan(F, F.bid * NTHR + F.tid, F.G * NTHR, 0, 96 * 1024);
    } SEAM(4);
    if (IN(5)) { LAUNDER(); __syncthreads();
        for (int u = F.bid; u < 128 * SSD_G; u += F.G) { ssd_out_unit(F, u); ssd_norm_unit(F, u); }
        __syncthreads();
        { pg8::Gemm g{WSP(pg8::bf16_t, A_GY), WSP(pg8::bf16_t, WS_WGLU), M, 2 * D, S5_W, S5_W, S5_W}; pg8::StaticOrder S; S.init(M, 2 * D, F.G, F.bid);
          pg8::EpiGlu E{WSP(pg8::bf16_t, A_YB), WSP(pg8::bf16_t, A_GT)};
          pg8::gemm_phase<pg8::EpiGlu, pg8::StaticOrder, PG8_ALIGN, PG8_SP2>(F.lds, g, S, E, F.tid); }
    } SEAM(5);
    if (IN(7)) { LAUNDER();
        pg8::Gemm g{WSP(pg8::bf16_t, A_Y), WSP(pg8::bf16_t, WS_WOUT), M, D, SSD_IN, SSD_IN, SSD_IN}; pg8::StaticOrder S; S.init(M, D, F.G, F.bid);
        pg8::EpiSsdOut E{WSP(pg8::bf16_t, A_MIX), WSP(pg8::bf16_t, A_YB), WSP(pg8::bf16_t, A_GT)};
        pg8::gemm_phase<pg8::EpiSsdOut, pg8::StaticOrder, PG8_ALIGN, PG8_SP2>(F.lds, g, S, E, F.tid);
    } SEAM(7);
    if (IN(9)) { LAUNDER();
        pg8::Gemm g{WSP(pg8::bf16_t, A_MIX), WSP(pg8::bf16_t, WS_WO), M, D, D, D, D}; pg8::StaticOrder S; S.init(M, D, F.G, F.bid);
        pg8::EpiWo E{WSP(float, A_HP), INP(0), ALPHA};
        pg8::gemm_phase<pg8::EpiWo, pg8::StaticOrder, PG8_ALIGN, PG8_SP2>(F.lds, g, S, E, F.tid);
    } SEAM(9);
    if (IN(10)) { LAUNDER(); p8_ln_router(F); } SEAM(10);
    if (IN(11)) { LAUNDER();
        if (F.bid < NB * NE) { p9_topk(F, F.bid); __syncthreads(); w2_convert(F, F.bid * NWAVES + F.wave, NB * NE * NWAVES, 0, 1280); }
        else w2_convert(F, (F.bid - NB * NE) * NWAVES + F.wave, (F.G - NB * NE) * NWAVES, 1280);
        __syncthreads();
        for (int r0 = F.bid * (MROWS / 256); r0 < MROWS; r0 += F.G * (MROWS / 256)) gather_rows_after(F, r0, MROWS / 256); __syncthreads(); } SEAM(11);

    if (IN(13)) { LAUNDER();
        pg8::Gemm g{WSP(pg8::bf16_t, A_XIN), WSP(pg8::bf16_t, WS_W1), MROWS, NE * 2 * FF, D, D, D}; pg8::MoeOrder1 S{F.G, F.bid};
        pg8::EpiMoe1 E{F.ws + A_HID, 1.0f / W1_SCALE, HID_SCALE};
        pg8::gemm_phase<pg8::EpiMoe1, pg8::MoeOrder1, PG8_ALIGN, PG8_SP2, true>(F.lds, g, S, E, F.tid);
    } SEAM(13);
    if (IN(14)) { LAUNDER();
        pg8::Gemm g{WSP(pg8::bf16_t, A_HID), WSP(pg8::bf16_t, WS_W2), MROWS, NE * D, FF, FF, FF}; pg8::MoeOrder2 S{F.G, F.bid};
        pg8::EpiMoe2 E{WSP(pg8::bf16_t, A_YE), 1.0f / (W2_SCALE * HID_SCALE)};
        pg8::gemm_phase<pg8::EpiMoe2, pg8::MoeOrder2, PG8_ALIGN, PG8_SP2, true>(F.lds, g, S, E, F.tid);
    } SEAM(14);
    if (IN(15)) { LAUNDER(); p13_final(F); }
#undef IN
#undef SEAM
}

#ifndef MK_ONE_LAUNCH
#define MK_ONE_LAUNCH 1
#endif
extern "C" void kernel_launch(void* const* d_in, const int* in_sizes, int n_in, void* d_out, int out_size, void* d_ws, size_t ws_size, hipStream_t stream) {
    static int grid = 0;
    if (grid == 0) {
        if (n_in != 33 || in_sizes[0] != M * D || out_size != M * D || ws_size < WS_END) { fprintf(stderr, "kernel_launch: unexpected problem (n_in %d, in0 %d, out %d, ws %zu < %zu)\n", n_in, n_in > 0 ? in_sizes[0] : -1, out_size, ws_size, (size_t)WS_END); grid = -1; return; }
        int dev = 0, cus = 0, per_cu = 0;
        if (hipGetDevice(&dev) != hipSuccess || hipDeviceGetAttribute(&cus, hipDeviceAttributeMultiprocessorCount, dev) != hipSuccess) { grid = -1; return; }
        if (hipFuncSetAttribute((const void*)fwd, hipFuncAttributeMaxDynamicSharedMemorySize, LDS_BYTES) != hipSuccess) { fprintf(stderr, "kernel_launch: hipFuncSetAttribute failed\n"); grid = -1; return; }
        if (hipOccupancyMaxActiveBlocksPerMultiprocessor(&per_cu, (const void*)fwd, NTHR, LDS_BYTES) != hipSuccess || per_cu < 1) fprintf(stderr, "kernel_launch: occupancy query reports %d blocks per CU\n", per_cu);
        (void)hipGetLastError();
        grid = cus;
    }
    if (grid < 0) return;
    (void)hipMemsetAsync((char*)d_ws + WS_CTL, 0, CTL_ZERO_BYTES, stream);
    Args a{};
    for (int i = 0; i < 33; ++i) a.in[i] = (const float*)d_in[i];
    a.out = (float*)d_out; a.ws = (unsigned char*)d_ws;
#if MK_ONE_LAUNCH
    a.ph_lo = 0; a.ph_hi = N_PHASES;
    hipLaunchKernelGGL(fwd, dim3(grid), dim3(NTHR), LDS_BYTES, stream, a);
#else
    for (int p = 0; p < N_PHASES; ++p) { a.ph_lo = p; a.ph_hi = p + 1; hipLaunchKernelGGL(fwd, dim3(grid), dim3(NTHR), LDS_BYTES, stream, a); }
#endif
}
```
